# Optimizing an MI355X kernel written in HIP

```python
import math
import jax, jax.numpy as jnp
from jax import lax
import numpy as np

D_MODEL = 1024
BATCH = 8
SEQ = 4096
DEPTH = 1

RET_HEADS = 8
RET_DK = 64
RET_DV = 64
RET_WIDTH = RET_HEADS * RET_DV
CHUNK = 128
ROPE_BASE = 10000.0
DIFF_HEADS = 4
DIFF_DK = 64
DIFF_DV = 2 * DIFF_DK
DIFF_WIDTH = DIFF_HEADS * DIFF_DV
Q_BLOCK = 128
REL_BUCKETS = 32
REL_MAX_DIST = 128
PEER_HEADS = 8
PEER_NKEYS = 128
PEER_EXPERTS = PEER_NKEYS * PEER_NKEYS
PEER_DQ = 256
PEER_TOPK = 16
TOKEN_BLOCK = 128
EPS = 1e-6

MIX_WIDTH = RET_WIDTH + DIFF_WIDTH
IN_SIZES = [RET_HEADS * RET_DK, RET_HEADS * RET_DK, RET_WIDTH, RET_WIDTH,
            DIFF_HEADS * 2 * DIFF_DK, DIFF_HEADS * 2 * DIFF_DK, DIFF_WIDTH]
IN_WIDTH = sum(IN_SIZES)
IN_OFFSETS = [int(o) for o in np.cumsum(IN_SIZES)[:-1]]

kernel_name = "hymba_retention_diffattn_peer"


def rmsnorm(x, g):
    xf = x.astype(jnp.float32)
    y = xf * lax.rsqrt(jnp.mean(xf * xf, axis=-1, keepdims=True) + EPS)
    return (y * g.astype(jnp.float32)).astype(x.dtype)


def rotary(x, pos):
    half = x.shape[-1] // 2
    freqs = ROPE_BASE ** (-jnp.arange(half, dtype=jnp.float32) / half)
    ang = pos.astype(jnp.float32)[:, None] * freqs[None, :]
    cos, sin = jnp.cos(ang).astype(x.dtype), jnp.sin(ang).astype(x.dtype)
    x1, x2 = x[..., :half], x[..., half:]
    return jnp.concatenate([x1 * cos - x2 * sin, x2 * cos + x1 * sin], axis=-1)


def retention(q, k, v):
    B, H, S, dk = q.shape
    dv = v.shape[-1]
    C = S // CHUNK
    log_gamma = jnp.log(1.0 - 2.0 ** (-5.0 - jnp.arange(H, dtype=jnp.float32)))
    idx = jnp.arange(CHUNK, dtype=jnp.float32)
    dist = idx[:, None] - idx[None, :]
    decay = jnp.where(dist >= 0, jnp.exp(log_gamma[:, None, None] * jnp.maximum(dist, 0.0)), 0.0)
    qc = q.astype(jnp.float32).reshape(B, H, C, CHUNK, dk)
    kc = k.astype(jnp.float32).reshape(B, H, C, CHUNK, dk)
    vc = v.astype(jnp.float32).reshape(B, H, C, CHUNK, dv)
    scores = jnp.einsum('bhcld,bhcmd->bhclm', qc, kc) * decay[None, :, None]
    inner = jnp.einsum('bhclm,bhcme->bhcle', scores, vc)
    k_decay = jnp.exp(log_gamma[:, None] * (CHUNK - 1 - idx)[None, :])
    kv = jnp.einsum('bhcld,bhcle->cbhde', kc * k_decay[None, :, None, :, None], vc)
    chunk_decay = jnp.exp(log_gamma * CHUNK)[None, :, None, None]

    def step(R, kv_c):
        return R * chunk_decay + kv_c, R

    _, R_prev = lax.scan(step, jnp.zeros((B, H, dk, dv), jnp.float32), kv)
    q_decay = jnp.exp(log_gamma[:, None] * (idx + 1.0)[None, :])
    cross = jnp.einsum('bhcld,cbhde->bhcle', qc, R_prev) * q_decay[None, :, None, :, None]
    return (inner + cross).reshape(B, H, S, dv)


def t5_bucket(n):
    n = jnp.maximum(n, 0)
    max_exact = REL_BUCKETS // 2
    large = max_exact + (jnp.log(jnp.maximum(n, 1).astype(jnp.float32) / max_exact)
                         / math.log(REL_MAX_DIST / max_exact)
                         * (REL_BUCKETS - max_exact)).astype(jnp.int32)
    large = jnp.minimum(large, REL_BUCKETS - 1)
    return jnp.where(n < max_exact, n, large)


def diff_attention(q1, q2, k1, k2, v, lam, rel_bias):
    B, H, S, _ = q1.shape
    dv = v.shape[-1]
    nb = S // Q_BLOCK
    kpos = jnp.arange(S, dtype=jnp.int32)
    scale = DIFF_DK ** -0.5
    vf = v.astype(jnp.float32)

    def block(i):
        start = i * Q_BLOCK
        qb1 = lax.dynamic_slice_in_dim(q1, start, Q_BLOCK, axis=2)
        qb2 = lax.dynamic_slice_in_dim(q2, start, Q_BLOCK, axis=2)
        qpos = start + jnp.arange(Q_BLOCK, dtype=jnp.int32)
        rel = qpos[:, None] - kpos[None, :]
        bias = jnp.take(rel_bias.astype(jnp.float32), t5_bucket(rel), axis=0)
        bias = jnp.transpose(bias, (2, 0, 1))[None]
        mask = (rel >= 0)[None, None]

        def probs(qb, k):
            s = jnp.einsum('bhqd,bhkd->bhqk', qb, k).astype(jnp.float32) * scale + bias
            return jax.nn.softmax(jnp.where(mask, s, -jnp.inf), axis=-1)

        p = probs(qb1, k1) - lam * probs(qb2, k2)
        return jnp.einsum('bhqk,bhkd->bhqd', p, vf)

    out = lax.map(block, jnp.arange(nb))
    return jnp.transpose(out, (1, 2, 0, 3, 4)).reshape(B, H, S, dv)


def peer(h, w_pq, sub_keys, w_down, w_up):
    B, S, D = h.shape
    hb = h.reshape((B * S) // TOKEN_BLOCK, TOKEN_BLOCK, D)

    def block(hx):
        q = (hx @ w_pq).reshape(TOKEN_BLOCK, PEER_HEADS, 2, PEER_DQ // 2)
        s = jnp.einsum('nhpd,hpkd->nhpk', q, sub_keys).astype(jnp.float32)
        sv, si = lax.top_k(s, PEER_TOPK)
        cand = (sv[:, :, 0, :, None] + sv[:, :, 1, None, :]).reshape(TOKEN_BLOCK, PEER_HEADS, PEER_TOPK * PEER_TOPK)
        cidx = (si[:, :, 0, :, None] * PEER_NKEYS + si[:, :, 1, None, :]).reshape(TOKEN_BLOCK, PEER_HEADS, PEER_TOPK * PEER_TOPK)
        top, pos = lax.top_k(cand, PEER_TOPK)
        experts = jnp.take_along_axis(cidx, pos, axis=-1)
        g = jax.nn.softmax(top, axis=-1)
        u = w_down[experts]
        a = jnp.einsum('nd,nhkd->nhk', hx, u).astype(jnp.float32)
        act = (jax.nn.gelu(a, approximate=False) * g).astype(hx.dtype)
        vsel = w_up[experts]
        return jnp.einsum('nhk,nhkd->nd', act, vsel)

    return lax.map(block, hb).reshape(B, S, D)


def setup_inputs(seed: int = 0) -> dict:
    key = jax.random.key(seed)
    ks = jax.random.split(key, 20)
    f32 = jnp.float32
    nrm = lambda k, shape, s: jax.random.normal(k, shape, f32) * s
    return {
        "x": nrm(ks[0], (BATCH, SEQ, D_MODEL), 1.0),
        "norm_mix": 1.0 + nrm(ks[1], (DEPTH, D_MODEL), 0.01),
        "w_in": nrm(ks[2], (DEPTH, D_MODEL, IN_WIDTH), D_MODEL ** -0.5),
        "ret_gn": 1.0 + nrm(ks[3], (DEPTH, RET_WIDTH), 0.01),
        "diff_lambda_q1": nrm(ks[4], (DEPTH, DIFF_DK), 0.1),
        "diff_lambda_k1": nrm(ks[5], (DEPTH, DIFF_DK), 0.1),
        "diff_lambda_q2": nrm(ks[6], (DEPTH, DIFF_DK), 0.1),
        "diff_lambda_k2": nrm(ks[7], (DEPTH, DIFF_DK), 0.1),
        "diff_subln": 1.0 + nrm(ks[8], (DEPTH, DIFF_DV), 0.01),
        "rel_bias": nrm(ks[9], (REL_BUCKETS, DIFF_HEADS), 0.5),
        "w_out": nrm(ks[10], (DEPTH, MIX_WIDTH, D_MODEL), MIX_WIDTH ** -0.5),
        "norm_ffn": 1.0 + nrm(ks[11], (DEPTH, D_MODEL), 0.01),
        "peer_query": nrm(ks[12], (DEPTH, D_MODEL, PEER_HEADS * PEER_DQ), D_MODEL ** -0.5),
        "peer_keys": nrm(ks[13], (DEPTH, PEER_HEADS, 2, PEER_NKEYS, PEER_DQ // 2), (PEER_DQ // 2) ** -0.5),
        "peer_down": nrm(ks[14], (DEPTH, PEER_EXPERTS, D_MODEL), D_MODEL ** -0.5),
        "peer_up": nrm(ks[15], (DEPTH, PEER_EXPERTS, D_MODEL), PEER_HEADS ** -0.5),
        "norm_final": 1.0 + nrm(ks[16], (D_MODEL,), 0.01),
    }


def reference(x, norm_mix, w_in, ret_gn, diff_lambda_q1, diff_lambda_k1, diff_lambda_q2,
              diff_lambda_k2, diff_subln, rel_bias, w_out, norm_ffn, peer_query, peer_keys,
              peer_down, peer_up, norm_final):
    B, S, _ = x.shape
    pos = jnp.arange(S, dtype=jnp.int32)

    def heads(t, H):
        return t.reshape(B, S, H, -1).transpose(0, 2, 1, 3)

    for l in range(DEPTH):
        lambda_init = 0.8 - 0.6 * math.exp(-0.3 * l)
        h = rmsnorm(x, norm_mix[l])
        proj = h @ w_in[l]
        rq, rk, rv, rg, dq, dk, dvv = jnp.split(proj, IN_OFFSETS, axis=-1)

        rq = rotary(heads(rq, RET_HEADS), pos)
        rk = rotary(heads(rk, RET_HEADS), pos) * (RET_DK ** -0.5)
        ro = retention(rq, rk, heads(rv, RET_HEADS))
        mu = jnp.mean(ro, axis=-1, keepdims=True)
        var = jnp.mean(jnp.square(ro - mu), axis=-1, keepdims=True)
        ro = ((ro - mu) * lax.rsqrt(var + EPS)).transpose(0, 2, 1, 3).reshape(B, S, RET_WIDTH)
        ro = jax.nn.silu(rg.astype(jnp.float32)) * (ro * ret_gn[l].astype(jnp.float32))

        dq = dq.reshape(B, S, DIFF_HEADS, 2, DIFF_DK)
        dk = dk.reshape(B, S, DIFF_HEADS, 2, DIFF_DK)
        q1 = dq[..., 0, :].transpose(0, 2, 1, 3)
        q2 = dq[..., 1, :].transpose(0, 2, 1, 3)
        k1 = dk[..., 0, :].transpose(0, 2, 1, 3)
        k2 = dk[..., 1, :].transpose(0, 2, 1, 3)
        lam = (jnp.exp(jnp.sum(diff_lambda_q1[l].astype(jnp.float32) * diff_lambda_k1[l].astype(jnp.float32)))
               - jnp.exp(jnp.sum(diff_lambda_q2[l].astype(jnp.float32) * diff_lambda_k2[l].astype(jnp.float32)))
               + lambda_init)
        do = diff_attention(q1, q2, k1, k2, heads(dvv, DIFF_HEADS), lam, rel_bias)
        do = do * lax.rsqrt(jnp.mean(do * do, axis=-1, keepdims=True) + EPS)
        do = do * diff_subln[l].astype(jnp.float32) * (1.0 - lambda_init)
        do = do.transpose(0, 2, 1, 3).reshape(B, S, DIFF_WIDTH)

        mix = jnp.concatenate([ro, do], axis=-1).astype(x.dtype)
        x = x + mix @ w_out[l]

        h2 = rmsnorm(x, norm_ffn[l])
        x = x + peer(h2, peer_query[l], peer_keys[l], peer_down[l], peer_up[l]).astype(x.dtype)

    return rmsnorm(x, norm_final)
```

```cpp
#include <hip/hip_runtime.h>
#include <cstdio>
#include <cstdint>

namespace pg8 {
#define PG8_LAS __attribute__((address_space(3)))
typedef unsigned short bf16_t;
typedef short bf16x8 __attribute__((ext_vector_type(8)));
typedef float f32x4 __attribute__((ext_vector_type(4)));
typedef unsigned u32x4 __attribute__((ext_vector_type(4)));
constexpr int BM = 256, BK = 64, HALF = 128, HTB = HALF * BK * 2  , STAGE_BYTES = 8 * HTB, NXCD = 8, WGM = 8;

__host__ __device__ __forceinline__ int lds_byte(int r, int c) { const int st = (r >> 4) * 2 + (c >> 5), rr = r & 15, cc = c & 31, ob = rr * 64 + cc * 2; return st * 1024 + (ob ^ (((ob >> 9) & 1) << 5)); }
__host__ __device__ __forceinline__ void stage_rc(int b, int& R, int& C) { const int st = b / 1024, sb = b % 1024, swz = sb ^ (((sb >> 9) & 1) << 5); R = (st >> 1) * 16 + swz / 64; C = (st & 1) * 32 + (swz % 64) / 2; }
__host__ __device__ __forceinline__ int perm32(int rho) { const int n = rho >> 4, i = rho & 15; return 8 * (i >> 2) + 4 * n + (i & 3); }

struct Unit { int pm, pn; };
struct Gemm { const bf16_t* A; const bf16_t* Bt; int M, N, K; };

struct StaticOrder {
    int nM, nN, nwg, G, c;
    __host__ __device__ void init(int M, int N, int G_, int c_) { nM = M / BM; nN = N / BM; nwg = nM * nN; G = G_; c = c_; }
    __host__ __device__ bool next(int i, Unit& u) const {
        const long L = (long)i * G + c; if (L >= nwg) return false;
        int wgid = (int)L; { const int q = nwg / NXCD, r = nwg % NXCD, xcd = wgid % NXCD, off = wgid / NXCD; wgid = (xcd < r ? xcd * (q + 1) : r * (q + 1) + (xcd - r) * q) + off; }
        const int nig = WGM * nN, gid = wgid / nig, fm = gid * WGM, gsz = (nM - fm) < WGM ? (nM - fm) : WGM;
        u.pm = fm + ((wgid % nig) % gsz); u.pn = (wgid % nig) / gsz; return true;
    }
    __device__ __forceinline__ void a_ready(const Unit&) const {}
    __device__ __forceinline__ void done(const Unit&) const {}
};
__device__ __forceinline__ unsigned cvt_pk_bf16(float lo, float hi) { unsigned r; asm volatile("v_cvt_pk_bf16_f32 %0, %1, %2" : "=v"(r) : "v"(lo), "v"(hi)); return r; }
template <class Epi, class Sched>
__device__ __forceinline__ void gemm_phase(PG8_LAS unsigned char* lds, const Gemm g, const Sched& S, const Epi& E) {
    const int tid = threadIdx.x, wid = __builtin_amdgcn_readfirstlane(tid >> 6), lane = tid & 63, wr = wid >> 2, wc = wid & 3, fr = lane & 15, fq = lane >> 4;
    const int K = g.K, nt = K / BK;
    unsigned voffA[2], voffB[2];
#pragma unroll
    for (int i = 0; i < 2; ++i) { int R, C; stage_rc(tid * 16 + i * 8192, R, C); const int Rb = Epi::PERM ? ((R & ~31) + perm32(R & 31)) : R;
        voffA[i] = (unsigned)(R * K + C) * 2u; voffB[i] = (unsigned)(Rb * K + C) * 2u; }
    const size_t kstep = (size_t)(BK * 2);
    const size_t hstep = (size_t)HALF * K * 2;
    const size_t tstep = 2 * hstep;
    const unsigned ldsw = (unsigned)wid * 1024u;
    const int aoff = lds_byte(wr * 64 + fr, fq * 8), boff = lds_byte(wc * 32 + fr, fq * 8);
#define PG8_SA(b, h) (((b) * 2 + (h)) * HTB)
#define PG8_SB(b, h) ((4 + (b) * 2 + (h)) * HTB)
#define PG8_STAGE(bufoff, gbase, voff) do { _Pragma("unroll") for (int _i = 0; _i < 2; ++_i) \
        __builtin_amdgcn_global_load_lds((const unsigned*)((const char*)(gbase) + (voff)[_i]), (PG8_LAS unsigned*)(lds + (bufoff) + ldsw + _i * 8192), 16, 0, 0); } while (0)
#define PG8_LDA(dst, b, h) do { _Pragma("unroll") for (int m = 0; m < 4; ++m) _Pragma("unroll") for (int k = 0; k < 2; ++k) dst[m][k] = *(const PG8_LAS bf16x8*)(lds + PG8_SA(b, h) + aoff + m * 2048 + k * 1024); } while (0)
#define PG8_LDB(dst, b, h) do { _Pragma("unroll") for (int n = 0; n < 2; ++n) _Pragma("unroll") for (int k = 0; k < 2; ++k) dst[n][k] = *(const PG8_LAS bf16x8*)(lds + PG8_SB(b, h) + boff + n * 2048 + k * 1024); } while (0)
#define PG8_MMA(ai, bj, At, Bt) do { __builtin_amdgcn_s_setprio(1); _Pragma("unroll") for (int m = 0; m < 4; ++m) _Pragma("unroll") for (int n = 0; n < 2; ++n) _Pragma("unroll") for (int k = 0; k < 2; ++k) \
        acc[ai][bj][m][n] = __builtin_amdgcn_mfma_f32_16x16x32_bf16(Bt[n][k], At[m][k], acc[ai][bj][m][n], 0, 0, 0); __builtin_amdgcn_s_setprio(0); } while (0)
#define PG8_WAIT_V(n) asm volatile("s_waitcnt vmcnt(" #n ")" ::: "memory")
#define PG8_WAIT_L(n) asm volatile("s_waitcnt lgkmcnt(" #n ")" ::: "memory")
#define PG8_BAR __builtin_amdgcn_s_barrier()
#define PG8_SCHED __builtin_amdgcn_sched_barrier(0)
    Unit cur, nxt; int ui = 0;
    if (!S.next(0, cur)) return;
    f32x4 acc[2][2][4][2];
#pragma unroll
    for (int a = 0; a < 2; ++a)
#pragma unroll
        for (int b = 0; b < 2; ++b)
#pragma unroll
            for (int m = 0; m < 4; ++m)
#pragma unroll
                for (int n = 0; n < 2; ++n) acc[a][b][m][n] = (f32x4){0.f, 0.f, 0.f, 0.f};
    bf16x8 At[4][2], B0[2][2], B1[2][2];
    const char* cA = (const char*)g.A + (size_t)cur.pm * tstep; const char* cB = (const char*)g.Bt + (size_t)cur.pn * tstep;
    S.a_ready(cur);
    PG8_STAGE(PG8_SB(0, 0), cB, voffB); PG8_STAGE(PG8_SA(0, 0), cA, voffA); PG8_STAGE(PG8_SB(0, 1), cB + hstep, voffB); PG8_STAGE(PG8_SA(0, 1), cA + hstep, voffA);
    if (wr == 1) PG8_BAR;
    PG8_WAIT_V(4); PG8_BAR;
    PG8_STAGE(PG8_SB(1, 0), cB + kstep, voffB); PG8_STAGE(PG8_SA(1, 0), cA + kstep, voffA); PG8_STAGE(PG8_SB(1, 1), cB + hstep + kstep, voffB);
    PG8_WAIT_V(6); PG8_BAR;
    for (;;) {
        const bool has_next = S.next(ui + 1, nxt);
        const char* nA = has_next ? (const char*)g.A + (size_t)nxt.pm * tstep : cA; const char* nB = has_next ? (const char*)g.Bt + (size_t)nxt.pn * tstep : cB;
        for (int t = 0; t < nt; t += 2) {
            const bool last = (t == nt - 2);
            const char* a1 = cA + (size_t)(t + 1) * kstep;
            const char* a2 = last ? nA : cA + (size_t)(t + 2) * kstep; const char* b2 = last ? nB : cB + (size_t)(t + 2) * kstep;
            const char* a3 = a2 + kstep; const char* b3 = b2 + kstep;
            if (last && has_next) S.a_ready(nxt);
            PG8_LDB(B0, 0, 0); PG8_SCHED; PG8_LDA(At, 0, 0); PG8_STAGE(PG8_SA(1, 1), a1 + hstep, voffA);
            PG8_WAIT_L(8); PG8_BAR; PG8_WAIT_L(0); PG8_MMA(0, 0, At, B0); PG8_BAR; PG8_SCHED;
            PG8_LDB(B1, 0, 1); PG8_STAGE(PG8_SB(0, 0), b2, voffB);
            PG8_BAR; PG8_WAIT_L(0); PG8_MMA(0, 1, At, B1); PG8_BAR;
            PG8_LDA(At, 0, 1); PG8_STAGE(PG8_SA(0, 0), a2, voffA);
            PG8_BAR; PG8_WAIT_L(0); PG8_MMA(1, 0, At, B0); PG8_BAR; PG8_SCHED;
            PG8_STAGE(PG8_SB(0, 1), b2 + hstep, voffB);
            PG8_WAIT_V(6); PG8_BAR; PG8_MMA(1, 1, At, B1); PG8_BAR;
            PG8_LDB(B0, 1, 0); PG8_SCHED; PG8_LDA(At, 1, 0); PG8_STAGE(PG8_SA(0, 1), a2 + hstep, voffA);
            PG8_WAIT_L(8); PG8_BAR; PG8_WAIT_L(0); PG8_MMA(0, 0, At, B0); PG8_BAR; PG8_SCHED;
            PG8_LDB(B1, 1, 1); PG8_STAGE(PG8_SB(1, 0), b3, voffB);
            PG8_BAR; PG8_WAIT_L(0); PG8_MMA(0, 1, At, B1); PG8_BAR;
            PG8_LDA(At, 1, 1); PG8_STAGE(PG8_SA(1, 0), a3, voffA);
            PG8_BAR; PG8_WAIT_L(0); PG8_MMA(1, 0, At, B0); PG8_BAR; PG8_SCHED;
            PG8_STAGE(PG8_SB(1, 1), b3 + hstep, voffB);
            PG8_WAIT_V(6); PG8_BAR; PG8_MMA(1, 1, At, B1); PG8_BAR;
        }
        if constexpr (!Epi::AFTER_DRAIN) { E(acc, cur, wr, wc, fr, fq); S.done(cur); }
        if (!has_next) break;
#pragma unroll
        for (int a = 0; a < 2; ++a)
#pragma unroll
            for (int b = 0; b < 2; ++b)
#pragma unroll
                for (int m = 0; m < 4; ++m)
#pragma unroll
                    for (int n = 0; n < 2; ++n) acc[a][b][m][n] = (f32x4){0.f, 0.f, 0.f, 0.f};
        cur = nxt; cA = nA; cB = nB; ++ui;
    }
    PG8_WAIT_V(0);
    if (wr == 0) PG8_BAR;
    PG8_BAR;
    if constexpr (Epi::AFTER_DRAIN) { E.fused(acc, cur, wr, wc, fr, fq, lds, wid, lane); S.done(cur); }
#undef PG8_SA
#undef PG8_SB
#undef PG8_STAGE
#undef PG8_LDA
#undef PG8_LDB
#undef PG8_MMA
#undef PG8_WAIT_V
#undef PG8_WAIT_L
#undef PG8_BAR
#undef PG8_SCHED
}
}

#define XB_TMO      128
#define XB_XCNT(j)  (256  + 64 * (j))
#define XB_XSUB(j)  (1280 + 64 * (j))
#define XB_XGEN(j)  (2304 + 64 * (j))
#define XB_TOP      3328
#define XB_TOPGEN   3392
#define XCD_BAR_WORDS 3456
#define XB_SPIN_CAP (1u << 18)
#define LAS __attribute__((address_space(3)))

__device__ __forceinline__ unsigned xb_ld(unsigned* p)              { return __hip_atomic_load(p, __ATOMIC_RELAXED, __HIP_MEMORY_SCOPE_AGENT); }
__device__ __forceinline__ unsigned xb_add(unsigned* p, unsigned v) { return __hip_atomic_fetch_add(p, v, __ATOMIC_RELAXED, __HIP_MEMORY_SCOPE_AGENT); }
__device__ __forceinline__ unsigned xb_xcc_id() { return (unsigned)__builtin_amdgcn_s_getreg((3 << 11) | 20) & 0xFu; }
#define XB_SPIN(cond, bar) do { unsigned _sp = 0; while (cond) { __builtin_amdgcn_s_sleep(1); \
    if ((++_sp & 255u) == 0u) { if (xb_ld(&(bar)[XB_TMO])) break; if (_sp > XB_SPIN_CAP) { atomicAdd(&(bar)[XB_TMO], 1u); break; } } } } while (0)

struct XcdBarrier {
    unsigned* bar; unsigned x;
    volatile LAS unsigned* st;
};

__device__ __forceinline__ XcdBarrier xcd_barrier_post(unsigned* bar, volatile LAS unsigned* st) {
    XcdBarrier b; b.bar = bar; b.x = xb_xcc_id(); b.st = st;
    if (threadIdx.x == 0) (void)xb_add(&bar[XB_XCNT(b.x)], 1u);
    return b;
}
__device__ __forceinline__ void xcd_barrier_complete(unsigned* bar, unsigned x, unsigned& nloc, unsigned& nx) {
    const unsigned G = gridDim.x * gridDim.y * gridDim.z;
    unsigned sum, cnt, mine, sp = 0u;
    for (;;) {
        sum = 0u; cnt = 0u; mine = 0u;
#pragma unroll
        for (unsigned j = 0; j < 16; ++j) { const unsigned c = xb_ld(&bar[XB_XCNT(j)]); sum += c; cnt += (c > 0u) ? 1u : 0u; mine = (j == x) ? c : mine; }
        if (sum == G) break;
        __builtin_amdgcn_s_sleep(1);
        if ((++sp & 255u) == 0u) { if (xb_ld(&bar[XB_TMO])) break; if (sp > XB_SPIN_CAP) { atomicAdd(&bar[XB_TMO], 1u); break; } }
    }
    nloc = mine > 0u ? mine : 1u; nx = cnt > 0u ? cnt : 1u;
}

__device__ __forceinline__ void xcd_barrier(const XcdBarrier& b) {
    asm volatile("s_waitcnt vmcnt(0)" ::: "memory");
    __syncthreads();
    if (threadIdx.x == 0) {
        unsigned* bar = b.bar;
        __builtin_amdgcn_s_waitcnt(0);
        unsigned nloc = b.st[0], nx = b.st[1];
        if (nloc == 0u) { xcd_barrier_complete(bar, b.x, nloc, nx); b.st[0] = nloc; b.st[1] = nx; }
        const unsigned old = xb_add(&bar[XB_XSUB(b.x)], 1u);
        const unsigned gen = old / nloc;
        if (old + 1u == (gen + 1u) * nloc) {
            __builtin_amdgcn_fence(__ATOMIC_RELEASE, "agent");
            asm volatile("s_waitcnt vmcnt(0)" ::: "memory");
            const unsigned og = xb_add(&bar[XB_TOP], 1u);
            const unsigned tg = og / nx;
            if (og + 1u == (tg + 1u) * nx) xb_add(&bar[XB_TOPGEN], 1u);
            else XB_SPIN(xb_ld(&bar[XB_TOPGEN]) == tg, bar);
            __builtin_amdgcn_fence(__ATOMIC_ACQUIRE, "agent");
            xb_add(&bar[XB_XGEN(b.x)], 1u);
            asm volatile("s_waitcnt vmcnt(0)" ::: "memory");
        } else {
            XB_SPIN(xb_ld(&bar[XB_XGEN(b.x)]) == gen, bar);
            __builtin_amdgcn_fence(__ATOMIC_ACQUIRE, "agent");
            asm volatile("s_waitcnt vmcnt(0)" ::: "memory");
        }
    }
    __syncthreads();
}

#define GAS __attribute__((address_space(1)))
typedef unsigned short bf16_t;
typedef short bf16x8 __attribute__((ext_vector_type(8)));
typedef short s16x4 __attribute__((ext_vector_type(4)));
typedef float f32x4 __attribute__((ext_vector_type(4)));
typedef float f32x2 __attribute__((ext_vector_type(2)));
typedef float f32x16 __attribute__((ext_vector_type(16)));
typedef unsigned u32x4 __attribute__((ext_vector_type(4)));
typedef unsigned u32x2 __attribute__((ext_vector_type(2)));
typedef LAS unsigned char lds_u8;

constexpr int MTOK = 32768, DM = 1024, SEQ = 4096, NBATCH = 8, NIN = 3584;
constexpr int OFF_RQ = 0, OFF_RK = 512, OFF_RV = 1024, OFF_RG = 1536, OFF_DQ = 2048, OFF_DK = 2560, OFF_DV = 3072;
constexpr int NEXP = 16384, NQ = 2048;
constexpr float EPSF = 1e-6f, LOG2E = 1.4426950408889634f;
constexpr int NWAVES = 8, NTHR = 512;

constexpr size_t WS_CTL = 0, CTL_BYTES = 65536;
constexpr size_t CTL_Q_ATT = 16384, CTL_Q_P6 = 16384 + 1024;
constexpr size_t WS_R1 = WS_CTL + CTL_BYTES;
constexpr size_t WS_SSQ = WS_R1 + (size_t)MTOK * 4;
constexpr size_t WS_ROPE = WS_SSQ + (size_t)MTOK * 16 * 4;
constexpr size_t WS_DECAY = WS_ROPE + (size_t)SEQ * 32 * 8;
constexpr size_t WS_BTAB = WS_DECAY + 2 * 8 * 128 * 4;
constexpr size_t WS_LAM = WS_BTAB + 4 * 128 * 4;
constexpr size_t WS_WIN = 4u << 20;
constexpr size_t WS_WOUT = WS_WIN + (size_t)NIN * DM * 2;
constexpr size_t WS_WPQ = WS_WOUT + (size_t)DM * DM * 2;
constexpr size_t WS_KEYS = WS_WPQ + (size_t)NQ * DM * 2;
constexpr size_t WS_WD = WS_KEYS + (size_t)8 * 2 * 128 * 128 * 2;
constexpr size_t WS_WU = WS_WD + (size_t)NEXP * DM * 2;
constexpr size_t WS_XB = WS_WU + (size_t)NEXP * DM * 2;
constexpr size_t WS_PROJ = WS_XB + (size_t)MTOK * DM * 2;
constexpr size_t WS_MIX = WS_PROJ + (size_t)MTOK * NIN * 2;
constexpr size_t WS_IDX = WS_MIX, WS_GATE = WS_MIX + (size_t)MTOK * 128 * 4;
constexpr size_t WS_X1B = WS_PROJ + (size_t)MTOK * NQ * 2;
static_assert(WS_X1B + (size_t)MTOK * DM * 2 <= WS_MIX, "ws map");
constexpr size_t WS_END = WS_MIX + (size_t)MTOK * DM * 2;
static_assert(WS_LAM + 256 <= WS_WIN, "ws map");
static_assert(WS_END <= (size_t)512 << 20, "ws map");

constexpr int LDS_SCRATCH = 139264;
constexpr int MISC_OFF = LDS_SCRATCH;
constexpr int LDS_BYTES = 147456;

__device__ __forceinline__ float wave_sum(float v) {
#pragma unroll
    for (int o = 1; o < 64; o <<= 1) v += __shfl_xor(v, o);
    return v;
}
typedef __bf16 bf16v2_t __attribute__((ext_vector_type(2)));
__device__ __forceinline__ unsigned pk2(float lo, float hi) { const bf16v2_t v = {(__bf16)lo, (__bf16)hi}; return __builtin_bit_cast(unsigned, v); }
__device__ __forceinline__ float bf2f(unsigned short b) { return __uint_as_float(((unsigned)b) << 16); }
#define LDS_WAIT() asm volatile("s_waitcnt lgkmcnt(0)" ::: "memory")
#define VM_WAIT() asm volatile("s_waitcnt vmcnt(0)" ::: "memory")

struct Args {
    const float* in[17]; float* out; unsigned char* ws; int ph_lo, ph_hi;
};

template <int MODE>
__device__ __forceinline__ void p0_transpose_item(const float* W, const float* scale, int K, int N, bf16_t* WT, LAS float* scr, int item, int lane) {
    const int nblk = N / 32, kb = item / nblk, nb = item % nblk, k0 = 64 * kb, n0 = 32 * nb;
#pragma unroll 8
    for (int i = 0; i < 32; ++i) { const int kk = 2 * i + (lane >> 5); const float sc = scale ? scale[k0 + kk] : 1.0f; scr[kk * 33 + (lane & 31)] = W[(size_t)(k0 + kk) * N + n0 + (lane & 31)] * sc; }
    LDS_WAIT();
    const int c = lane & 7;
#pragma unroll
    for (int j = 0; j < 4; ++j) { const int n = (lane >> 3) + 8 * j; const LAS float* s = scr + (8 * c) * 33 + n;
        u32x4 o; o.x = pk2(s[0 * 33], s[1 * 33]); o.y = pk2(s[2 * 33], s[3 * 33]); o.z = pk2(s[4 * 33], s[5 * 33]); o.w = pk2(s[6 * 33], s[7 * 33]);
        int nn = n0 + n;
        if (MODE == 1 && nn < 1024) { const int d = nn & 63; nn = (nn & ~63) + ((d < 32) ? 2 * d : 2 * (d - 32) + 1); }
        *(GAS u32x4*)(WT + (size_t)nn * K + k0 + 8 * c) = o; }
    LDS_WAIT();
}

__device__ __forceinline__ int t5_bucket(int n) {
    if (n < 16) return n;
    const float v = logf((float)n / 16.0f) / 2.0794415416798357f * 16.0f;
    int b = 16 + (int)v; return b > 31 ? 31 : b;
}

__device__ __forceinline__ void p0_prologue(const Args& a, lds_u8* lds, int gw, int NGW, int lane, int wave) {
    unsigned char* ws = a.ws;
    const float* x = a.in[0];
    bf16_t* xb = (bf16_t*)(ws + WS_XB); float* r1 = (float*)(ws + WS_R1);
    for (int m = gw; m < MTOK; m += NGW) {
        const GAS f32x4* xr = (const GAS f32x4*)(x + (size_t)m * DM) + lane; f32x4 v[4]; float s = 0.f;
#pragma unroll
        for (int j = 0; j < 4; ++j) { v[j] = xr[64 * j]; s += (v[j].x * v[j].x + v[j].y * v[j].y) + (v[j].z * v[j].z + v[j].w * v[j].w); }
        s = wave_sum(s);
        GAS u32x2* o8 = (GAS u32x2*)(xb + (size_t)m * DM) + lane;
#pragma unroll
        for (int j = 0; j < 4; ++j) { u32x2 o; o.x = pk2(v[j].x, v[j].y); o.y = pk2(v[j].z, v[j].w); o8[64 * j] = o; }
        if (lane == 0) r1[m] = 1.0f / sqrtf(s * (1.0f / DM) + EPSF);
    }
    {
        LAS float* scr = (LAS float*)(lds + wave * 8704);
        constexpr int I_IN = (DM / 64) * (NIN / 32);
        for (int it = gw; it < I_IN; it += NGW) p0_transpose_item<1>(a.in[2], a.in[1], DM, NIN, (bf16_t*)(ws + WS_WIN), scr, it, lane);
    }
    const int gt = gw * 64 + lane, NGT = NGW * 64;
    {
        f32x2* rope = (f32x2*)(ws + WS_ROPE);
        for (int i = gt; i < SEQ * 32; i += NGT) { const int pos = i >> 5, j = i & 31; const float fr = (float)pow(10000.0, -(double)j / 32.0); const float ang = (float)pos * fr;
            rope[i] = (f32x2){(float)cos((double)ang), (float)sin((double)ang)}; }
        float* dec = (float*)(ws + WS_DECAY);
        for (int i = gt; i < 2 * 8 * 128; i += NGT) { const int l = i & 127, h = (i >> 7) & 7, kk = i >> 10; const double lg = log2(1.0 - exp2(-5.0 - (double)h));
            dec[i] = kk ? (float)(0.125 * exp2(-lg * (double)l)) : (float)exp2(lg * (double)l); }
        float* bt = (float*)(ws + WS_BTAB); const float* rb = a.in[9];
        for (int i = gt; i < 4 * 128; i += NGT) { const int n = i & 127, h = i >> 7; bt[i] = rb[t5_bucket(n) * 4 + h] * LOG2E; }
        if (gt == 0) { float s1 = 0.f, s2 = 0.f; for (int i = 0; i < 64; ++i) { s1 += a.in[4][i] * a.in[5][i]; s2 += a.in[6][i] * a.in[7][i]; }
            ((float*)(ws + WS_LAM))[0] = expf(s1) - expf(s2) + 0.2f; }
    }
}


constexpr int DEF_T0 = 192, DEF_T1 = 64, DEF_T2 = 512, DEF_T3 = 512, DEF_ITEMS = DEF_T0 + DEF_T1 + DEF_T2 + DEF_T3;
__device__ __forceinline__ void p0_deferred(const Args& a, lds_u8* lds, int item) {
    unsigned char* ws = a.ws;
    int tid_ = threadIdx.x; asm volatile("" : "+v"(tid_));
    const int tid = tid_, lane = tid & 63; const int wave = __builtin_amdgcn_readfirstlane(tid >> 6);
    if (item < DEF_T0) {
        LAS float* scr = (LAS float*)(lds + wave * 8704);
        constexpr int I_OUT = (DM / 64) * (DM / 32), I_PQ = (DM / 64) * (NQ / 32);
        static_assert(I_OUT + I_PQ == DEF_T0 * 8, "deferred transposes");
        const int r = item * 8 + wave;
        if (r < I_OUT) p0_transpose_item<0>(a.in[10], nullptr, DM, DM, (bf16_t*)(ws + WS_WOUT), scr, r, lane);
        else p0_transpose_item<0>(a.in[12], a.in[11], DM, NQ, (bf16_t*)(ws + WS_WPQ), scr, r - I_OUT, lane);
        return;
    }
    item -= DEF_T0;
    if (item < DEF_T1) {
        const float* pk = a.in[13]; bf16_t* kb = (bf16_t*)(ws + WS_KEYS);
        const int i = item * 512 + tid;
        const GAS f32x4* s = (const GAS f32x4*)(pk + (size_t)i * 8); const f32x4 p = s[0], q = s[1];
        u32x4 o; o.x = pk2(p.x, p.y); o.y = pk2(p.z, p.w); o.z = pk2(q.x, q.y); o.w = pk2(q.z, q.w); *(GAS u32x4*)(kb + (size_t)i * 8) = o;
        return;
    }
    item -= DEF_T1;
    const float* dn = a.in[14]; const float* up = a.in[15]; const float* gf = a.in[11];
    unsigned char* wd = ws + WS_WD; unsigned char* wu = ws + WS_WU;
    if (item < DEF_T2) {
#pragma unroll
        for (int rep = 0; rep < 2; ++rep) {
            const int i = (item * 2 + rep) * 512 + tid;
            const int e = i >> 5, c = i & 31;
            const GAS f32x4* s = (const GAS f32x4*)(up + (size_t)e * DM + c * 32);
            u32x4 o;
#pragma unroll
            for (int k = 0; k < 4; ++k) {
                unsigned w = 0u;
#pragma unroll
                for (int h2 = 0; h2 < 2; ++h2) { const f32x4 p = s[2 * k + h2] * 6.0f;
#pragma unroll
                    for (int j = 0; j < 4; ++j) { const float av = __builtin_fabsf(p[j]);
                        const unsigned code = (unsigned)(av > 0.25f) + (unsigned)(av > 0.75f) + (unsigned)(av > 1.25f) + (unsigned)(av > 1.75f) + (unsigned)(av > 2.5f) + (unsigned)(av > 3.5f) + (unsigned)(av > 5.0f);
                        w |= (code | (p[j] < 0.f ? 8u : 0u)) << (4 * (4 * h2 + j)); } }
                o[k] = w;
            }
            *(GAS u32x4*)(wu + (size_t)e * 512 + c * 16) = o;
        }
        return;
    }
    item -= DEF_T2;
#pragma unroll
    for (int rep = 0; rep < 2; ++rep) {
        const int i = (item * 2 + rep) * 512 + tid;
        const int e = i >> 5, c = i & 31, sl = c >> 3, j0 = (c & 7) * 16;
        const GAS f32x4* s = (const GAS f32x4*)(dn + (size_t)e * DM + c * 32); const GAS f32x4* gq = (const GAS f32x4*)(gf + c * 32);
        u32x4 o;
#pragma unroll
        for (int k = 0; k < 4; ++k) {
            unsigned w = 0u;
#pragma unroll
            for (int h2 = 0; h2 < 2; ++h2) { const f32x4 p = s[2 * k + h2] * gq[2 * k + h2] * 64.0f;
#pragma unroll
                for (int j = 0; j < 4; ++j) { const float av = __builtin_fabsf(p[j]);
                    const unsigned code = (unsigned)(av > 0.25f) + (unsigned)(av > 0.75f) + (unsigned)(av > 1.25f) + (unsigned)(av > 1.75f) + (unsigned)(av > 2.5f) + (unsigned)(av > 3.5f) + (unsigned)(av > 5.0f);
                    w |= (code | (p[j] < 0.f ? 8u : 0u)) << (4 * (4 * h2 + j)); } }
            o[k] = w;
        }
        *(GAS u32x4*)(wd + (size_t)sl * ((size_t)NEXP * 128) + (size_t)e * 128 + j0) = o;
    }
}

__device__ __forceinline__ f32x4 bf4_lo(u32x4 w) { return (f32x4){__uint_as_float(w.x << 16), __uint_as_float(w.x & 0xffff0000u), __uint_as_float(w.y << 16), __uint_as_float(w.y & 0xffff0000u)}; }
__device__ __forceinline__ f32x4 bf4_hi(u32x4 w) { return (f32x4){__uint_as_float(w.z << 16), __uint_as_float(w.z & 0xffff0000u), __uint_as_float(w.w << 16), __uint_as_float(w.w & 0xffff0000u)}; }
struct EpiProj {
    static constexpr bool PERM = true, AFTER_DRAIN = false;
    bf16_t* P; const float* r1; const f32x4* rope; const float* decay;
    __device__ __forceinline__ void operator()(const f32x4 (&acc)[2][2][4][2], const pg8::Unit& u, int wr, int wc, int fr, int fq) const {
        const int row0 = u.pm * 256 + wr * 64 + fr, seg = u.pn >> 1;
        float rsv[2][4];
#pragma unroll
        for (int ai = 0; ai < 2; ++ai)
#pragma unroll
            for (int m = 0; m < 4; ++m) rsv[ai][m] = *(const GAS float*)(r1 + row0 + ai * 128 + m * 16);
        if (seg <= 1) {
#pragma unroll
            for (int ai = 0; ai < 2; ++ai) {
                f32x4 ra[4][2], rb[4][2]; float ff[4][2];
#pragma unroll
                for (int m = 0; m < 4; ++m)
#pragma unroll
                    for (int bj = 0; bj < 2; ++bj) {
                        const int row = row0 + ai * 128 + m * 16, c0 = u.pn * 256 + bj * 128 + wc * 32 + 8 * fq;
                        const int pos = row & (SEQ - 1), l = row & 127, head = (c0 & 511) >> 6, jb = (c0 & 63) >> 1;
                        const GAS f32x4* rp = (const GAS f32x4*)rope + ((size_t)pos * 32 + jb) / 2; ra[m][bj] = rp[0]; rb[m][bj] = rp[1];
                        ff[m][bj] = *(const GAS float*)(decay + (seg * 8 + head) * 128 + l);
                    }
#pragma unroll
                for (int m = 0; m < 4; ++m)
#pragma unroll
                    for (int bj = 0; bj < 2; ++bj) {
                        const int row = row0 + ai * 128 + m * 16, c0 = u.pn * 256 + bj * 128 + wc * 32 + 8 * fq;
                        const f32x4 v0 = acc[ai][bj][m][0] * rsv[ai][m], v1 = acc[ai][bj][m][1] * rsv[ai][m];
                        const f32x4 a_ = ra[m][bj], b_ = rb[m][bj]; const float f = ff[m][bj];
                        f32x4 w0, w1;
                        w0.x = (v0.x * a_.x - v0.y * a_.y) * f; w0.y = (v0.y * a_.x + v0.x * a_.y) * f;
                        w0.z = (v0.z * a_.z - v0.w * a_.w) * f; w0.w = (v0.w * a_.z + v0.z * a_.w) * f;
                        w1.x = (v1.x * b_.x - v1.y * b_.y) * f; w1.y = (v1.y * b_.x + v1.x * b_.y) * f;
                        w1.z = (v1.z * b_.z - v1.w * b_.w) * f; w1.w = (v1.w * b_.z + v1.z * b_.w) * f;
                        u32x4 w; w.x = pk2(w0.x, w0.y); w.y = pk2(w0.z, w0.w); w.z = pk2(w1.x, w1.y); w.w = pk2(w1.z, w1.w);
                        *(GAS u32x4*)(P + (size_t)row * NIN + c0) = w;
                    }
            }
        } else {
#pragma unroll
            for (int ai = 0; ai < 2; ++ai)
#pragma unroll
                for (int m = 0; m < 4; ++m)
#pragma unroll
                    for (int bj = 0; bj < 2; ++bj) {
                        const int row = row0 + ai * 128 + m * 16, c0 = u.pn * 256 + bj * 128 + wc * 32 + 8 * fq;
                        f32x4 v0 = acc[ai][bj][m][0] * rsv[ai][m], v1 = acc[ai][bj][m][1] * rsv[ai][m];
                        if (seg == 3) {
#pragma unroll
                            for (int j = 0; j < 4; ++j) { v0[j] = v0[j] / (1.0f + __expf(-v0[j])); v1[j] = v1[j] / (1.0f + __expf(-v1[j])); }
                        } else if (seg == 4) { v0 = v0 * (0.125f * LOG2E); v1 = v1 * (0.125f * LOG2E); }
                        u32x4 w; w.x = pk2(v0.x, v0.y); w.y = pk2(v0.z, v0.w); w.z = pk2(v1.x, v1.y); w.w = pk2(v1.z, v1.w);
                        *(GAS u32x4*)(P + (size_t)row * NIN + c0) = w;
                    }
        }
    }
};
struct EpiX1 {
    static constexpr bool PERM = true, AFTER_DRAIN = false;
    const bf16_t* XB; bf16_t* X1B; bf16_t* ssq;
    __device__ __forceinline__ void operator()(const f32x4 (&acc)[2][2][4][2], const pg8::Unit& u, int wr, int wc, int fr, int fq) const {
        const int row0 = u.pm * 256 + wr * 64 + fr, c00 = u.pn * 256 + wc * 32 + 8 * fq;
        u32x4 xin[2][4][2];
#pragma unroll
        for (int ai = 0; ai < 2; ++ai)
#pragma unroll
            for (int m = 0; m < 4; ++m)
#pragma unroll
                for (int bj = 0; bj < 2; ++bj) xin[ai][m][bj] = *(const GAS u32x4*)(XB + (size_t)(row0 + ai * 128 + m * 16) * DM + c00 + bj * 128);
#pragma unroll
        for (int ai = 0; ai < 2; ++ai)
#pragma unroll
            for (int m = 0; m < 4; ++m) {
                const int row = row0 + ai * 128 + m * 16; float ss = 0.f;
#pragma unroll
                for (int bj = 0; bj < 2; ++bj) {
                    const f32x4 o0 = acc[ai][bj][m][0] + bf4_lo(xin[ai][m][bj]), o1 = acc[ai][bj][m][1] + bf4_hi(xin[ai][m][bj]);
                    u32x4 w; w.x = pk2(o0.x, o0.y); w.y = pk2(o0.z, o0.w); w.z = pk2(o1.x, o1.y); w.w = pk2(o1.z, o1.w);
                    *(GAS u32x4*)(X1B + (size_t)row * DM + c00 + bj * 128) = w;
                    ss += ((o0.x * o0.x + o0.y * o0.y) + (o0.z * o0.z + o0.w * o0.w)) + ((o1.x * o1.x + o1.y * o1.y) + (o1.z * o1.z + o1.w * o1.w));
                }
                ss += __shfl_xor(ss, 16); ss += __shfl_xor(ss, 32);
                if (fq == 0) *(GAS bf16_t*)(ssq + (size_t)row * 16 + u.pn * 4 + wc) = (bf16_t)(pk2(ss, 0.f) & 0xffffu);
            }
    }
};
__device__ __forceinline__ float rs2_from(u32x4 a, u32x4 b) {
    const f32x4 p = bf4_lo(a) + bf4_hi(a) + bf4_lo(b) + bf4_hi(b);
    return 1.0f / sqrtf(((p.x + p.y) + (p.z + p.w)) * (1.0f / DM) + EPSF);
}
__device__ __forceinline__ float row_rs2(const bf16_t* ssq, int row) {
    const GAS u32x4* p = (const GAS u32x4*)(ssq + (size_t)row * 16); return rs2_from(p[0], p[1]);
}
struct EpiQ {
    static constexpr bool PERM = true, AFTER_DRAIN = false;
    bf16_t* Q; const bf16_t* ssq;
    __device__ __forceinline__ void operator()(const f32x4 (&acc)[2][2][4][2], const pg8::Unit& u, int wr, int wc, int fr, int fq) const {
        const int row0 = u.pm * 256 + wr * 64 + fr;
        u32x4 sa[2][4], sb[2][4];
#pragma unroll
        for (int ai = 0; ai < 2; ++ai)
#pragma unroll
            for (int m = 0; m < 4; ++m) { const GAS u32x4* p = (const GAS u32x4*)(ssq + (size_t)(row0 + ai * 128 + m * 16) * 16); sa[ai][m] = p[0]; sb[ai][m] = p[1]; }
#pragma unroll
        for (int ai = 0; ai < 2; ++ai)
#pragma unroll
            for (int m = 0; m < 4; ++m) {
                const int row = row0 + ai * 128 + m * 16; const float rs = rs2_from(sa[ai][m], sb[ai][m]);
#pragma unroll
                for (int bj = 0; bj < 2; ++bj) {
                    const int c0 = u.pn * 256 + bj * 128 + wc * 32 + 8 * fq;
                    const f32x4 v0 = acc[ai][bj][m][0] * rs, v1 = acc[ai][bj][m][1] * rs;
                    u32x4 w; w.x = pk2(v0.x, v0.y); w.y = pk2(v0.z, v0.w); w.z = pk2(v1.x, v1.y); w.w = pk2(v1.z, v1.w);
                    *(GAS u32x4*)(Q + (size_t)row * NQ + c0) = w;
                }
            }
    }
};

#define MFMA32(a, b, c) __builtin_amdgcn_mfma_f32_32x32x16_bf16(a, b, c, 0, 0, 0)
typedef short v4i16_t __attribute__((ext_vector_type(4)));
__device__ __forceinline__ s16x4 vtr(const lds_u8* p) { return __builtin_bit_cast(s16x4, __builtin_amdgcn_ds_read_tr16_b64_v4i16((LAS v4i16_t*)p)); }
__device__ __forceinline__ bf16x8 vfrag(const lds_u8* p) { const s16x4 lo = vtr(p), hi = vtr(p + 512); return (bf16x8){lo[0], lo[1], lo[2], lo[3], hi[0], hi[1], hi[2], hi[3]}; }
__device__ __forceinline__ bf16x8 ldsb128(const lds_u8* p) { return *(const LAS bf16x8*)p; }
__device__ __forceinline__ int crow(int r, int hi) { return (r & 3) + 8 * (r >> 2) + 4 * hi; }
__device__ __forceinline__ void glds16(const void* g, lds_u8* l) {
    unsigned sv; const unsigned lb = (unsigned)__builtin_amdgcn_readfirstlane((int)(unsigned)(uintptr_t)l);
    asm volatile("s_mov_b32 %0, m0\n\ts_mov_b32 m0, %2\n\ts_nop 0\n\tglobal_load_lds_dwordx4 %1, off\n\ts_mov_b32 m0, %0" : "=&s"(sv) : "v"(g), "s"(lb) : "memory");
}
__device__ __forceinline__ float swap_sum(float v) { auto rr = __builtin_amdgcn_permlane32_swap(__float_as_uint(v), __float_as_uint(v), false, false); return __uint_as_float(rr[0]) + __uint_as_float(rr[1]); }
__device__ __forceinline__ float swap_max(float v) { auto rr = __builtin_amdgcn_permlane32_swap(__float_as_uint(v), __float_as_uint(v), false, false); return __builtin_fmaxf(__uint_as_float(rr[0]), __uint_as_float(rr[1])); }

constexpr int ATT_SLOT = 32768, ATT_NSLOT = 4, ATT_XCH = 0, ATT_XPITCH = 528, ATT_BTAB = ATT_NSLOT * ATT_SLOT;
static_assert(128 * ATT_XPITCH <= ATT_NSLOT * ATT_SLOT, "attention exchange");
static_assert(ATT_BTAB + 512 <= LDS_SCRATCH, "attention LDS");

template <int MODE>
__device__ __forceinline__ void attn_unit(const Args& a, lds_u8* lds, int b, int h, int qb) {
    int tid_ = threadIdx.x; asm volatile("" : "+v"(tid_));
    const int tid = tid_, lane = tid & 63, r32 = lane & 31, hi = lane >> 5; const int wid = __builtin_amdgcn_readfirstlane(tid >> 6);
    const int rgp = wid & 3, map = wid >> 2;
    const bf16_t* proj = (const bf16_t*)(a.ws + WS_PROJ);
    const size_t rowbase = (size_t)b * SEQ; const int q0 = qb * 128, NT = 2 * qb + 2;
    const float lam = ((const float*)(a.ws + WS_LAM))[0];
    if (tid < 128) ((LAS float*)(lds + ATT_BTAB))[tid] = ((const float*)(a.ws + WS_BTAB))[h * 128 + tid];
    bf16x8 qf[4];
    { const bf16_t* qp = proj + (rowbase + q0 + rgp * 32 + r32) * NIN + OFF_DQ + h * 128 + map * 64 + hi * 8;
#pragma unroll
      for (int s = 0; s < 4; ++s) qf[s] = *(const GAS bf16x8*)(qp + s * 16); }
    asm volatile("" : "+v"(qf[0]), "+v"(qf[1]), "+v"(qf[2]), "+v"(qf[3]));
    const int krow = 8 * wid + (lane >> 3);
    const bf16_t* k1src = proj + (rowbase + krow) * NIN + OFF_DK + h * 128 + ((lane & 7) ^ ((krow >> 1) & 7)) * 8;
    const bf16_t* k2src = k1src + 64;
    const bf16_t* vsrc0 = proj + (rowbase + 16 * ((2 * wid) & 3) + (lane >> 2)) * NIN + OFF_DV + h * 128 + 32 * ((2 * wid) >> 2) + (lane & 3) * 8;
    const bf16_t* vsrc1 = proj + (rowbase + 16 * ((2 * wid + 1) & 3) + (lane >> 2)) * NIN + OFF_DV + h * 128 + 32 * ((2 * wid + 1) >> 2) + (lane & 3) * 8;
#define ATT_DMA(t, slot) do { const size_t go = (size_t)(t) * 64 * NIN; lds_u8* sb = lds + (slot) * ATT_SLOT; \
        glds16(k1src + go, sb + wid * 1024); glds16(k2src + go, sb + 8192 + wid * 1024); \
        glds16(vsrc0 + go, sb + 16384 + (2 * wid) * 1024); glds16(vsrc1 + go, sb + 16384 + (2 * wid + 1) * 1024); } while (0)
    const int koff = map * 8192 + r32 * 128, ksw = (r32 >> 1) & 7;
    const int voff = 16384 + ((lane >> 4) & 1) * 32 + (lane & 3) * 8 + (4 * hi + ((lane & 15) >> 2)) * 64;
    f32x16 o[4];
#pragma unroll
    for (int d = 0; d < 4; ++d) o[d] = f32x16{};
    float mrun = -INFINITY, lrun = 0.f;
    const int qpos = q0 + rgp * 32 + r32;
    float b31 = ((const float*)(a.ws + WS_BTAB))[h * 128 + 127]; asm volatile("" : "+v"(b31));
    u32x4 pw[4];
#pragma unroll
    for (int i = 0; i < 4; ++i) pw[i] = (u32x4){0u, 0u, 0u, 0u};
#define ATT_PV(sbv) do { const lds_u8* sv_ = (sbv);     \
            bf16x8 vfa[4], vfb[4]; \
            _Pragma("unroll") for (int d = 0; d < 4; ++d) vfa[d] = vfrag(sv_ + voff + d * 4096); \
            __builtin_amdgcn_sched_group_barrier(0x100, 8, 0); \
            _Pragma("unroll") for (int ks = 0; ks < 4; ks += 2) { \
                _Pragma("unroll") for (int d = 0; d < 4; ++d) vfb[d] = vfrag(sv_ + voff + d * 4096 + (ks + 1) * 1024); \
                __builtin_amdgcn_sched_group_barrier(0x100, 8, 0); \
                { const bf16x8 pb = __builtin_bit_cast(bf16x8, pw[ks]); \
                  _Pragma("unroll") for (int d = 0; d < 4; ++d) o[d] = MFMA32(vfa[d], pb, o[d]); } \
                __builtin_amdgcn_sched_group_barrier(0x8, 4, 0); \
                if (ks + 2 < 4) { \
                    _Pragma("unroll") for (int d = 0; d < 4; ++d) vfa[d] = vfrag(sv_ + voff + d * 4096 + (ks + 2) * 1024); \
                    __builtin_amdgcn_sched_group_barrier(0x100, 8, 0); \
                } \
                { const bf16x8 pb = __builtin_bit_cast(bf16x8, pw[ks + 1]); \
                  _Pragma("unroll") for (int d = 0; d < 4; ++d) o[d] = MFMA32(vfb[d], pb, o[d]); } \
                __builtin_amdgcn_sched_group_barrier(0x8, 4, 0); \
            } } while (0)
    const int qlast = q0 + rgp * 32 + 31;
    ATT_DMA(0, 0); ATT_DMA(1, 1);
    for (int t = 0; t <= NT; ++t) {
        if (t + 1 < NT) asm volatile("s_waitcnt vmcnt(4)" ::: "memory"); else VM_WAIT();
        __syncthreads();
        if (t + 2 < NT) ATT_DMA(t + 2, (t + 2) & 3);
        if ((MODE & 2) && map == 1 && t > 0 && !(64 * (t - 1) > qlast)) ATT_PV(lds + ((t - 1) & 3) * ATT_SLOT);
        if (t == NT || 64 * t > qlast) continue;
        const lds_u8* sb = lds + (t & 3) * ATT_SLOT;
        const bool nearT = (64 * t + 176 > q0);
        const float cb = nearT ? 0.f : b31;
        f32x16 sA, sB;
        { const float c0 = (t == 0) ? 0.f : cb - mrun;
#pragma unroll
          for (int r = 0; r < 16; ++r) { sA[r] = c0; sB[r] = c0; } }
        if (MODE & 1) {
            bf16x8 kf[8];
#pragma unroll
            for (int d0 = 0; d0 < 4; ++d0) { const int kc = koff + (((2 * d0 + hi) ^ ksw) << 4); kf[2 * d0] = ldsb128(sb + kc); kf[2 * d0 + 1] = ldsb128(sb + kc + 4096); }
            __builtin_amdgcn_sched_group_barrier(0x100, 8, 0);
#pragma unroll
            for (int d0 = 0; d0 < 4; ++d0) { sA = MFMA32(kf[2 * d0], qf[d0], sA); sB = MFMA32(kf[2 * d0 + 1], qf[d0], sB); }
            __builtin_amdgcn_sched_group_barrier(0x8, 8, 0);
        }
        if (MODE & 4) {
        if (nearT) {
            const LAS float* bt = (const LAS float*)(lds + ATT_BTAB);
#pragma unroll
            for (int r = 0; r < 16; ++r) {
                const int kp = 64 * t + crow(r, hi); int d0 = qpos - kp, d1 = d0 - 32;
                const float b0 = bt[d0 < 0 ? 0 : (d0 > 127 ? 127 : d0)], b1 = bt[d1 < 0 ? 0 : (d1 > 127 ? 127 : d1)];
                sA[r] = d0 < 0 ? -INFINITY : sA[r] + b0; sB[r] = d1 < 0 ? -INFINITY : sB[r] + b1;
            }
        }
#define MX3(a_, b_, c_) __builtin_fmaxf(__builtin_fmaxf((a_), (b_)), (c_))
        float mxa = MX3(sA[0], sA[1], sB[0]), mxb = MX3(sA[2], sA[3], sB[1]); mxa = MX3(mxa, sB[2], sB[3]);
#pragma unroll
        for (int r = 4; r < 16; r += 4) { mxa = MX3(mxa, sA[r], sA[r + 1]); mxb = MX3(mxb, sA[r + 2], sA[r + 3]); mxa = MX3(mxa, sB[r], sB[r + 1]); mxb = MX3(mxb, sB[r + 2], sB[r + 3]); }
#undef MX3
        const float mx = swap_max(__builtin_fmaxf(mxa, mxb));
        if (t == 0 || __any(mx > 6.0f)) {
            const float up = (t == 0) ? mx : __builtin_fmaxf(mx, 0.f), alpha = (t == 0) ? 0.f : __builtin_amdgcn_exp2f(-up);
            mrun = (t == 0) ? mx + cb : mrun + up; lrun *= alpha;
#pragma unroll
            for (int d = 0; d < 4; ++d)
#pragma unroll
                for (int r = 0; r < 16; ++r) o[d][r] *= alpha;
            const float sh = (t == 0) ? mx : up;
#pragma unroll
            for (int r = 0; r < 16; ++r) { sA[r] -= sh; sB[r] -= sh; }
        }
        float ps = 0.f;
#pragma unroll
        for (int r = 0; r < 16; ++r) { sA[r] = __builtin_amdgcn_exp2f(sA[r]); sB[r] = __builtin_amdgcn_exp2f(sB[r]); ps += sA[r] + sB[r]; }
        lrun += ps;
        } else { asm volatile("" : "+v"(sA), "+v"(sB)); }
        pw[0] = (u32x4){pk2(sA[0], sA[1]), pk2(sA[2], sA[3]), pk2(sA[4], sA[5]), pk2(sA[6], sA[7])};
        pw[1] = (u32x4){pk2(sA[8], sA[9]), pk2(sA[10], sA[11]), pk2(sA[12], sA[13]), pk2(sA[14], sA[15])};
        pw[2] = (u32x4){pk2(sB[0], sB[1]), pk2(sB[2], sB[3]), pk2(sB[4], sB[5]), pk2(sB[6], sB[7])};
        pw[3] = (u32x4){pk2(sB[8], sB[9]), pk2(sB[10], sB[11]), pk2(sB[12], sB[13]), pk2(sB[14], sB[15])};
        if (!(MODE & 2)) { asm volatile("" :: "v"(pw[0]), "v"(pw[1]), "v"(pw[2]), "v"(pw[3])); continue; }
        if (map == 0) ATT_PV(sb);
    }
#undef ATT_PV
    const float inv = 1.0f / swap_sum(lrun);
    LAS float* xch = (LAS float*)(lds + ATT_XCH + (rgp * 32 + r32) * ATT_XPITCH);
    __syncthreads();
    if (map == 1) {
        const float sc = inv * lam;
#pragma unroll
        for (int d = 0; d < 4; ++d)
#pragma unroll
            for (int g = 0; g < 4; ++g) *(LAS f32x4*)(xch + 32 * d + 8 * g + 4 * hi) = (f32x4){o[d][4 * g] * sc, o[d][4 * g + 1] * sc, o[d][4 * g + 2] * sc, o[d][4 * g + 3] * sc};
    }
    __syncthreads();
    if (map == 0) {
        float ss = 0.f;
#pragma unroll
        for (int d = 0; d < 4; ++d)
#pragma unroll
            for (int g = 0; g < 4; ++g) { const f32x4 o2 = *(const LAS f32x4*)(xch + 32 * d + 8 * g + 4 * hi);
#pragma unroll
                for (int j = 0; j < 4; ++j) { const float v = o[d][4 * g + j] * inv - o2[j]; o[d][4 * g + j] = v; ss += v * v; } }
        ss = swap_sum(ss);
        const float rn = 0.8f / sqrtf(ss * (1.0f / 128.0f) + EPSF);
        const float* sub = a.in[8];
        bf16_t* mixp = (bf16_t*)(a.ws + WS_MIX) + (rowbase + qpos) * DM + 512 + h * 128;
#pragma unroll
        for (int d = 0; d < 4; ++d)
#pragma unroll
            for (int g = 0; g < 4; ++g) { const int dd = 32 * d + 8 * g + 4 * hi; const f32x4 sv = *(const GAS f32x4*)(sub + dd);
                u32x2 w; w.x = pk2(o[d][4 * g] * rn * sv.x, o[d][4 * g + 1] * rn * sv.y); w.y = pk2(o[d][4 * g + 2] * rn * sv.z, o[d][4 * g + 3] * rn * sv.w);
                *(GAS u32x2*)(mixp + dd) = w; }
    }
    __syncthreads();
#undef ATT_DMA
}

constexpr int RET_BUF = 49152, RET_RT = 2 * RET_BUF, RET_GN = RET_RT + 8192;
static_assert(RET_GN + 2048 <= LDS_SCRATCH, "retention LDS");

__device__ __forceinline__ void ret_unit(const Args& a, lds_u8* lds, int b, int h) {
    int tid_ = threadIdx.x; asm volatile("" : "+v"(tid_));
    const int tid = tid_, lane = tid & 63, r32 = lane & 31, hi = lane >> 5; const int wid = __builtin_amdgcn_readfirstlane(tid >> 6);
    const int rgp = wid & 3, eh = wid >> 2;
    const bf16_t* proj = (const bf16_t*)(a.ws + WS_PROJ);
    const size_t rowbase = (size_t)b * SEQ;
    const double lg = log2(1.0 - exp2(-5.0 - (double)h));
    const float gam = (float)exp2(lg), g127 = (float)exp2(lg * 127.0), g128 = (float)exp2(lg * 128.0);
#define RET_DMA(c, buf) do { const size_t ro = (rowbase + (size_t)(c) * 128) * NIN; lds_u8* bb = lds + (buf) * RET_BUF; \
        _Pragma("unroll") for (int i_ = 0; i_ < 2; ++i_) { const int p_ = 2 * wid + i_; \
            { const int ch = p_ >> 1, rh = p_ & 1; glds16(proj + ro + (size_t)(rh * 64 + lane) * NIN + OFF_RK + h * 64 + ch * 8, bb + ch * 2048 + rh * 1024); } \
            { const int db = p_ >> 3, rg_ = p_ & 7; glds16(proj + ro + (size_t)(rg_ * 16 + (lane >> 2)) * NIN + OFF_RK + h * 64 + db * 32 + (lane & 3) * 8, bb + 16384 + db * 8192 + rg_ * 1024); \
              glds16(proj + ro + (size_t)(rg_ * 16 + (lane >> 2)) * NIN + OFF_RV + h * 64 + db * 32 + (lane & 3) * 8, bb + 32768 + db * 8192 + rg_ * 1024); } } } while (0)
    const int koff = hi * 2048 + r32 * 16;
    const int troff = ((lane >> 4) & 1) * 32 + (lane & 3) * 8 + (4 * hi + ((lane & 15) >> 2)) * 64;
    f32x16 R = f32x16{};
    for (int i = tid; i < 8192 / 16; i += NTHR) *(LAS u32x4*)(lds + RET_RT + i * 16) = (u32x4){0u, 0u, 0u, 0u};
    const float* gn = a.in[3];
    RET_DMA(0, 0);
    for (int c = 0; c < 32; ++c) {
        VM_WAIT(); __syncthreads();
        if (c + 1 < 32) RET_DMA(c + 1, (c + 1) & 1);
        const lds_u8* bb = lds + (c & 1) * RET_BUF;
        const size_t tok = rowbase + (size_t)c * 128 + rgp * 32 + r32;
        bf16x8 qf[4];
        { const bf16_t* qp = proj + tok * NIN + OFF_RQ + h * 64 + hi * 8;
#pragma unroll
          for (int s = 0; s < 4; ++s) qf[s] = *(const GAS bf16x8*)(qp + s * 16); }
        f32x16 O = f32x16{};
#pragma unroll
        for (int s = 0; s < 4; ++s) { const bf16x8 rt = ldsb128(lds + RET_RT + (2 * s + hi) * 1024 + (eh * 32 + r32) * 16); O = MFMA32(rt, qf[s], O); }
        for (int kb = 0; kb <= rgp; ++kb) {
            f32x16 S = f32x16{};
#pragma unroll
            for (int s = 0; s < 4; ++s) { const bf16x8 ka = ldsb128(bb + koff + s * 4096 + (kb * 32) * 16); S = MFMA32(ka, qf[s], S); }
            if (kb == rgp) {
#pragma unroll
                for (int r = 0; r < 16; ++r) S[r] = (crow(r, hi) > r32) ? 0.f : S[r];
            }
            const u32x4 p0 = (u32x4){pk2(S[0], S[1]), pk2(S[2], S[3]), pk2(S[4], S[5]), pk2(S[6], S[7])};
            const u32x4 p1 = (u32x4){pk2(S[8], S[9]), pk2(S[10], S[11]), pk2(S[12], S[13]), pk2(S[14], S[15])};
            const bf16x8 v0 = vfrag(bb + 32768 + eh * 8192 + troff + (2 * kb) * 1024), v1 = vfrag(bb + 32768 + eh * 8192 + troff + (2 * kb + 1) * 1024);
            O = MFMA32(v0, __builtin_bit_cast(bf16x8, p0), O); O = MFMA32(v1, __builtin_bit_cast(bf16x8, p1), O);
        }
        if (rgp < 2) {
            f32x16 T = f32x16{};
#pragma unroll
            for (int ks = 0; ks < 8; ++ks) { const bf16x8 kt = vfrag(bb + 16384 + rgp * 8192 + troff + ks * 1024), vv = vfrag(bb + 32768 + eh * 8192 + troff + ks * 1024); T = MFMA32(kt, vv, T); }
#pragma unroll
            for (int r = 0; r < 16; ++r) R[r] = R[r] * g128 + T[r] * g127;
        }
        float s1 = 0.f, s2 = 0.f;
#pragma unroll
        for (int r = 0; r < 16; ++r) { s1 += O[r]; s2 += O[r] * O[r]; }
        s1 = swap_sum(s1); s2 = swap_sum(s2);
        LAS f32x2* gx = (LAS f32x2*)(lds + RET_GN);
        if (hi == 0) gx[(rgp * 32 + r32) * 2 + eh] = (f32x2){s1, s2};
        __syncthreads();
        if (rgp < 2) {
#pragma unroll
            for (int g = 0; g < 4; ++g) { u32x2 w; w.x = pk2(R[4 * g] * gam, R[4 * g + 1] * gam); w.y = pk2(R[4 * g + 2] * gam, R[4 * g + 3] * gam);
                *(LAS u32x2*)(lds + RET_RT + (rgp * 4 + g) * 1024 + (eh * 32 + r32) * 16 + hi * 8) = w; }
        }
        const f32x2 ga = gx[(rgp * 32 + r32) * 2], gb = gx[(rgp * 32 + r32) * 2 + 1];
        const float mean = (ga.x + gb.x) * (1.0f / 64.0f), var = (ga.y + gb.y) * (1.0f / 64.0f) - mean * mean;
        const float rstd = 1.0f / sqrtf(__builtin_fmaxf(var, 0.f) + EPSF);
        const bf16_t* sg = proj + tok * NIN + OFF_RG + h * 64 + eh * 32;
        bf16_t* mixp = (bf16_t*)(a.ws + WS_MIX) + tok * DM + h * 64 + eh * 32;
#pragma unroll
        for (int g = 0; g < 4; ++g) { const int e = 8 * g + 4 * hi; const u32x2 sv = *(const GAS u32x2*)(sg + e); const f32x4 gv = *(const GAS f32x4*)(gn + h * 64 + eh * 32 + e);
            const float y0 = (O[4 * g] - mean) * rstd * gv.x * __uint_as_float(sv.x << 16), y1 = (O[4 * g + 1] - mean) * rstd * gv.y * __uint_as_float(sv.x & 0xffff0000u);
            const float y2 = (O[4 * g + 2] - mean) * rstd * gv.z * __uint_as_float(sv.y << 16), y3 = (O[4 * g + 3] - mean) * rstd * gv.w * __uint_as_float(sv.y & 0xffff0000u);
            u32x2 w; w.x = pk2(y0, y1); w.y = pk2(y2, y3); *(GAS u32x2*)(mixp + e) = w; }
    }
    __syncthreads();
#undef RET_DMA
}


#define CAS_DESC(x, y) do { const float hi_ = __builtin_fmaxf(x, y), lo_ = __builtin_fminf(x, y); x = hi_; y = lo_; } while (0)
#define CAS_ASC(x, y) do { const float hi_ = __builtin_fmaxf(x, y), lo_ = __builtin_fminf(x, y); x = lo_; y = hi_; } while (0)
__device__ __forceinline__ void sort16_desc(float (&v)[16]) {
#pragma unroll
    for (int k = 2; k <= 16; k <<= 1)
#pragma unroll
        for (int j = k >> 1; j > 0; j >>= 1)
#pragma unroll
            for (int i = 0; i < 16; ++i) { const int l = i ^ j; if (l > i) { if ((i & k) == 0) CAS_DESC(v[i], v[l]); else CAS_ASC(v[i], v[l]); } }
}
__device__ __forceinline__ void bitonic_merge16_desc(float (&v)[16]) {
#pragma unroll
    for (int j = 8; j > 0; j >>= 1)
#pragma unroll
        for (int i = 0; i < 16; ++i) { const int l = i ^ j; if (l > i) CAS_DESC(v[i], v[l]); }
}
__device__ __forceinline__ void merge_top16(float (&a)[16], const float (&b)[16]) {
#pragma unroll
    for (int i = 0; i < 16; ++i) a[i] = __builtin_fmaxf(a[i], b[15 - i]);
    bitonic_merge16_desc(a);
}
__device__ __forceinline__ unsigned pack_idx4(const float (&v)[16], int w) {
    return (__float_as_uint(v[4 * w]) & 127u) | ((__float_as_uint(v[4 * w + 1]) & 127u) << 8) | ((__float_as_uint(v[4 * w + 2]) & 127u) << 16) | ((__float_as_uint(v[4 * w + 3]) & 127u) << 24);
}
__device__ __forceinline__ unsigned lookup_idx(const unsigned (&pk)[4], unsigned i) {
    const unsigned w = i >> 2; unsigned s = w == 0 ? pk[0] : (w == 1 ? pk[1] : (w == 2 ? pk[2] : pk[3]));
    return (s >> ((i & 3u) * 8u)) & 127u;
}

constexpr int P5_KEYB = 32768;
__device__ __forceinline__ void p5_topk(const Args& a, lds_u8* lds) {
    const int tid = threadIdx.x, lane = tid & 63, r32 = lane & 31, hi = lane >> 5; const int wid = __builtin_amdgcn_readfirstlane(tid >> 6);
    const int hp = blockIdx.x & 3, wgi = blockIdx.x >> 2, nwg = (gridDim.x + 3 - hp) / 4;
    const bf16_t* keys = (const bf16_t*)(a.ws + WS_KEYS) + (size_t)hp * 4 * 128 * 128;
    for (int i = tid; i < 4 * 128 * 16; i += NTHR) { const int t = i >> 11, key = (i >> 4) & 127, c = i & 15;
        *(LAS u32x4*)(lds + t * P5_KEYB + c * 2048 + key * 16) = *(const GAS u32x4*)(keys + ((size_t)t * 128 + key) * 128 + c * 8); }
    __syncthreads();
    const bf16_t* Q = (const bf16_t*)(a.ws + WS_PROJ);
    int* IDX = (int*)(a.ws + WS_IDX); float* GATE = (float*)(a.ws + WS_GATE);
    const int tg0 = wgi * NWAVES + wid, tgs = nwg * NWAVES;
    const int ntask = (tg0 < MTOK / 32) ? 4 * ((MTOK / 32 - 1 - tg0) / tgs + 1) : 0;
#define P5_QLOAD(QF, k_) do { const int tg_ = tg0 + ((k_) >> 2) * tgs, t_ = (k_) & 3; \
        const bf16_t* qp = Q + (size_t)(tg_ * 32 + r32) * NQ + (2 * hp + (t_ >> 1)) * 256 + (t_ & 1) * 128 + hi * 8; \
        _Pragma("unroll") for (int s = 0; s < 8; ++s) QF[s] = *(const GAS bf16x8*)(qp + s * 16); } while (0)
    float la[16], lb[16];
#pragma unroll
    for (int r = 0; r < 16; ++r) { la[r] = 0.f; lb[r] = 0.f; }
    bf16x8 qf[8], qn[8];
    if (ntask > 0) P5_QLOAD(qf, 0);
#pragma unroll 1
    for (int k = 0; k < ntask; ++k) {
      {
        const int tg = tg0 + (k >> 2) * tgs, t = k & 3;
        if (k + 1 < ntask) P5_QLOAD(qn, k + 1);
        {
            float top[16];
#pragma unroll
            for (int kb = 0; kb < 4; ++kb) {
                f32x16 S = f32x16{};
#pragma unroll
                for (int s = 0; s < 8; ++s) { const bf16x8 kf = ldsb128(lds + t * P5_KEYB + (2 * s + hi) * 2048 + (kb * 32 + r32) * 16); S = MFMA32(kf, qf[s], S); }
                float v[16];
#pragma unroll
                for (int r = 0; r < 16; ++r) v[r] = __uint_as_float((__float_as_uint(S[r]) & ~127u) | (unsigned)(kb * 32 + (r & 3) + 8 * (r >> 2)) | ((unsigned)hi << 2));
                sort16_desc(v);
                if (kb == 0) {
#pragma unroll
                    for (int r = 0; r < 16; ++r) top[r] = v[r];
                } else merge_top16(top, v);
            }
            float oth[16];
#pragma unroll
            for (int r = 0; r < 16; ++r) { auto rr = __builtin_amdgcn_permlane32_swap(__float_as_uint(top[r]), __float_as_uint(top[r]), false, false); top[r] = __uint_as_float(rr[0]); oth[r] = __uint_as_float(rr[1]); }
            merge_top16(top, oth);
            const bool ka = ((t >> 1) == hi) && ((t & 1) == 0), kb2 = ((t >> 1) == hi) && ((t & 1) == 1);
#pragma unroll
            for (int r = 0; r < 16; ++r) { la[r] = ka ? top[r] : la[r]; lb[r] = kb2 ? top[r] : lb[r]; }
        }
#pragma unroll
        for (int s2 = 0; s2 < 8; ++s2) qf[s2] = qn[s2];
        if (t != 3) continue;
        unsigned pa[4], pb[4];
#pragma unroll
        for (int w = 0; w < 4; ++w) { pa[w] = pack_idx4(la, w); pb[w] = pack_idx4(lb, w); }
        float c0[16], c1[16];
#define CAND(i, j) __uint_as_float((__float_as_uint(la[i] + lb[j]) & ~255u) | (unsigned)((i) * 16 + (j)))
        const float NEG = -INFINITY;
        c0[0] = CAND(0, 0); c0[1] = CAND(0, 1); c0[2] = CAND(0, 2); c0[3] = CAND(0, 3); c0[4] = CAND(0, 4); c0[5] = CAND(0, 5); c0[6] = CAND(0, 6); c0[7] = CAND(0, 7);
        c0[8] = CAND(0, 8); c0[9] = CAND(0, 9); c0[10] = CAND(0, 10); c0[11] = CAND(0, 11); c0[12] = CAND(0, 12); c0[13] = CAND(0, 13); c0[14] = CAND(0, 14); c0[15] = CAND(0, 15);
        sort16_desc(c0);
        c1[0] = CAND(1, 0); c1[1] = CAND(1, 1); c1[2] = CAND(1, 2); c1[3] = CAND(1, 3); c1[4] = CAND(1, 4); c1[5] = CAND(1, 5); c1[6] = CAND(1, 6); c1[7] = CAND(1, 7);
        c1[8] = CAND(2, 0); c1[9] = CAND(2, 1); c1[10] = CAND(2, 2); c1[11] = CAND(2, 3); c1[12] = CAND(2, 4); c1[13] = CAND(3, 0); c1[14] = CAND(3, 1); c1[15] = CAND(3, 2);
        sort16_desc(c1); merge_top16(c0, c1);
        asm volatile("" : "+v"(c0[0]), "+v"(c0[15]));
        c1[0] = CAND(3, 3); c1[1] = CAND(4, 0); c1[2] = CAND(4, 1); c1[3] = CAND(4, 2); c1[4] = CAND(5, 0); c1[5] = CAND(5, 1); c1[6] = CAND(6, 0); c1[7] = CAND(6, 1);
        c1[8] = CAND(7, 0); c1[9] = CAND(7, 1); c1[10] = CAND(8, 0); c1[11] = CAND(9, 0); c1[12] = CAND(10, 0); c1[13] = CAND(11, 0); c1[14] = CAND(12, 0); c1[15] = CAND(13, 0);
        sort16_desc(c1); merge_top16(c0, c1);
        asm volatile("" : "+v"(c0[0]), "+v"(c0[15]));
        c1[0] = CAND(14, 0); c1[1] = CAND(15, 0);
#pragma unroll
        for (int r = 2; r < 16; ++r) c1[r] = NEG;
#undef CAND
        sort16_desc(c1); merge_top16(c0, c1);
        float gsum = 0.f, gv[16]; int ex[16];
        const float mx = __uint_as_float(__float_as_uint(c0[0]) & ~255u);
#pragma unroll
        for (int r = 0; r < 16; ++r) { const unsigned bits = __float_as_uint(c0[r]); const float val = __uint_as_float(bits & ~255u);
            gv[r] = __expf(val - mx); gsum += gv[r];
            ex[r] = (int)(lookup_idx(pa, (bits >> 4) & 15u) * 128u + lookup_idx(pb, bits & 15u)); }
        const float ginv = 1.0f / gsum;
        const size_t ob = (size_t)(tg * 32 + r32) * 128 + (2 * hp + hi) * 16;
#pragma unroll
        for (int r = 0; r < 16; r += 4) { *(GAS u32x4*)(IDX + ob + r) = (u32x4){(unsigned)ex[r], (unsigned)ex[r + 1], (unsigned)ex[r + 2], (unsigned)ex[r + 3]};
            *(GAS f32x4*)(GATE + ob + r) = (f32x4){gv[r] * ginv, gv[r + 1] * ginv, gv[r + 2] * ginv, gv[r + 3] * ginv}; }
      }
    }
#undef P5_QLOAD
    __syncthreads();
}

typedef long i64_t;
typedef int v8i_t __attribute__((ext_vector_type(8)));
#define MFMA16F8(a, b, c) __builtin_amdgcn_mfma_f32_16x16x32_fp8_fp8(a, b, c, 0, 0, 0)
constexpr float P6_SD = 64.f, P6_SX = 8.f, P6_SU = 16.f, P6_SA = 64.f, P6_SU4 = 6.f;
constexpr size_t P6_SLICEB = (size_t)NEXP * 128;
__device__ __forceinline__ unsigned pk4_fp8(float a, float b, float c, float d) { int w = __builtin_amdgcn_cvt_pk_fp8_f32(a, b, 0, false); w = __builtin_amdgcn_cvt_pk_fp8_f32(c, d, w, true); return (unsigned)w; }
__device__ __forceinline__ float fp8_byte0(unsigned w) { return __builtin_amdgcn_cvt_f32_fp8((int)w, 0); }
constexpr int P6_WSCR = 3328;
__device__ __forceinline__ void p6_token(const Args& a, lds_u8* wl, int tok, int lane, float* OUTW) {
    const int n = lane & 15, g = lane >> 4;
    const unsigned char* ws = a.ws;
    const unsigned char* WD = ws + WS_WD; const unsigned char* WU = ws + WS_WU;
    const int* IDX = (const int*)(ws + WS_IDX) + (size_t)tok * 128; const float* GATE = (const float*)(ws + WS_GATE) + (size_t)tok * 128;
    const bf16_t* X1 = (const bf16_t*)(ws + WS_X1B) + (size_t)tok * DM;
    {
#pragma unroll
        for (int j = 0; j < 4; ++j) {
            const u32x2 xw_ = *(const GAS u32x2*)(X1 + 256 * j + 4 * lane); const f32x4 v = (f32x4){__uint_as_float(xw_.x << 16), __uint_as_float(xw_.x & 0xffff0000u), __uint_as_float(xw_.y << 16), __uint_as_float(xw_.y & 0xffff0000u)} * P6_SX;
            const unsigned hw = pk4_fp8(v.x, v.y, v.z, v.w);
            const float r0 = v.x - __builtin_amdgcn_cvt_f32_fp8((int)hw, 0), r1 = v.y - __builtin_amdgcn_cvt_f32_fp8((int)hw, 1), r2 = v.z - __builtin_amdgcn_cvt_f32_fp8((int)hw, 2), r3 = v.w - __builtin_amdgcn_cvt_f32_fp8((int)hw, 3);
            const unsigned lw = pk4_fp8(r0 * 16.f, r1 * 16.f, r2 * 16.f, r3 * 16.f);
            *(LAS unsigned*)(wl + 256 * j + 4 * lane) = hw; *(LAS unsigned*)(wl + 1024 + 256 * j + 4 * lane) = lw;
        }
        const u32x2 iv = *(const GAS u32x2*)(IDX + lane * 2); *(LAS u32x2*)(wl + 2048 + lane * 8) = iv;
    }
    const float rs2 = row_rs2((const bf16_t*)(ws + WS_SSQ), tok);
    LDS_WAIT();
    const LAS int* idxl = (const LAS int*)(wl + 2048); LAS unsigned short* actl = (LAS unsigned short*)(wl + 2560);
    const int xoff = (n & 1) * 1024 + 16 * g;
#pragma unroll 1
    for (int eg = 0; eg < 8; ++eg) {
        const int e = idxl[eg * 16 + n];
        const unsigned char* rp = WD + (size_t)e * 128 + 16 * g;
        f32x4 acc = (f32x4){0.f, 0.f, 0.f, 0.f};
        u32x4 bq[16];
#pragma unroll
        for (int sl = 0; sl < 8; ++sl) { bq[2 * sl] = *(const GAS u32x4*)(rp + sl * P6_SLICEB); bq[2 * sl + 1] = *(const GAS u32x4*)(rp + sl * P6_SLICEB + 64); }
#pragma unroll
        for (int sl = 0; sl < 8; ++sl)
#pragma unroll
            for (int hf = 0; hf < 2; ++hf) {
                const u32x4 xa = *(const LAS u32x4*)(wl + xoff + sl * 128 + hf * 64); const u32x4 bb = bq[2 * sl + hf];
                acc = MFMA16F8((i64_t)(((unsigned long long)xa.y << 32) | xa.x), (i64_t)(((unsigned long long)bb.y << 32) | bb.x), acc);
                acc = MFMA16F8((i64_t)(((unsigned long long)xa.w << 32) | xa.z), (i64_t)(((unsigned long long)bb.w << 32) | bb.z), acc);
            }
        const float av = (acc[0] + acc[1] * 0.0625f) * (rs2 * (1.0f / (P6_SD * P6_SX)));
        const float act = 0.5f * av * (1.0f + erff(av * 0.70710678118654752f)) * GATE[eg * 16 + n] * P6_SA;
        const unsigned hb = pk4_fp8(act, 0.f, 0.f, 0.f) & 0xffu;
        const unsigned lb = pk4_fp8((act - fp8_byte0(hb)) * 16.f, 0.f, 0.f, 0.f) & 0xffu;
        if (g == 0) actl[eg * 16 + n] = (unsigned short)(hb | (lb << 8));
    }
    LDS_WAIT();
    const int pos = n & 7, sel = n >> 3;
    float ss = 0.f;
    const bool owner = (n < 8) && (g < 2);
#pragma unroll 1
    for (int sl = 0; sl < 8; ++sl) {
        f32x4 ah[2], al[2];
#pragma unroll
        for (int s = 0; s < 2; ++s) { ah[s] = (f32x4){0.f, 0.f, 0.f, 0.f}; al[s] = (f32x4){0.f, 0.f, 0.f, 0.f}; }
        u32x4 bq[16]; unsigned av[16];
#pragma unroll
        for (int q = 0; q < 16; ++q) { const int ei = 8 * q + 4 * sel + g; const int e = idxl[ei]; av[q] = actl[ei];
            bq[q] = *(const GAS u32x4*)(WU + sl * P6_SLICEB + (size_t)e * 128 + 16 * pos); }
#pragma unroll
        for (int q = 0; q < 16; ++q) {
            const unsigned long long ahv = (unsigned long long)(av[q] & 0xffu) << (8 * pos), alv = (unsigned long long)(av[q] >> 8) << (8 * pos);
            const u32x4 bb = bq[q];
            const i64_t b0 = (i64_t)(((unsigned long long)bb.y << 32) | bb.x), b1 = (i64_t)(((unsigned long long)bb.w << 32) | bb.z);
            ah[0] = MFMA16F8((i64_t)ahv, b0, ah[0]); al[0] = MFMA16F8((i64_t)alv, b0, al[0]);
            ah[1] = MFMA16F8((i64_t)ahv, b1, ah[1]); al[1] = MFMA16F8((i64_t)alv, b1, al[1]);
        }
#pragma unroll
        for (int s = 0; s < 2; ++s) {
            f32x4 t = ah[s] + al[s] * 0.0625f, u;
#pragma unroll
            for (int r = 0; r < 4; ++r) u[r] = __shfl(t[r], (lane + 40) & 63);
            const int col = 128 * sl + 16 * pos + 8 * s + 4 * (g & 1);
            const u32x2 xq_ = *(const GAS u32x2*)(X1 + col); const f32x4 xv = (f32x4){__uint_as_float(xq_.x << 16), __uint_as_float(xq_.x & 0xffff0000u), __uint_as_float(xq_.y << 16), __uint_as_float(xq_.y & 0xffff0000u)};
            const f32x4 x2 = xv + (t + u) * (1.0f / (P6_SA * P6_SU));
            if (owner) { ss += (x2.x * x2.x + x2.y * x2.y) + (x2.z * x2.z + x2.w * x2.w); *(GAS f32x4*)(OUTW + (size_t)tok * DM + col) = x2; }
        }
    }
    ss = wave_sum(ss);
    const float rn = 1.0f / sqrtf(ss * (1.0f / DM) + EPSF);
    const float* nf = a.in[16];
    if (owner) {
#pragma unroll
        for (int sl = 0; sl < 8; ++sl)
#pragma unroll
            for (int s = 0; s < 2; ++s) { const int col = 128 * sl + 16 * pos + 8 * s + 4 * g; const f32x4 gv = *(const GAS f32x4*)(nf + col);
                GAS f32x4* op = (GAS f32x4*)(OUTW + (size_t)tok * DM + col); *op = *op * rn * gv; }
    }
}

constexpr int P6S_WAVE = 16384 + 512 + 128;
static_assert(NWAVES * P6S_WAVE <= LDS_SCRATCH, "P6 LDS");
__device__ __forceinline__ float gelu_as(float v) {
    const float av = __builtin_fabsf(v), t = __builtin_amdgcn_rcpf(av * 0.2316418882f + 1.0f);
    float q = t * 0.5307027145f + (-0.7265760135f); q = q * t + 0.7107068705f; q = q * t + (-0.142248368f); q = q * t + 0.127414796f; q = q * t;
    const float e = __builtin_amdgcn_exp2f((v * v) * (-0.72134752044f));
    const float m = v * (q * e);
    return v < 0.f ? m : v - m;
}
template <int EMASK, int PARTS>
__device__ __forceinline__ void p6_slices(const Args& a, lds_u8* wl, int tok0, int lane) {
    const int n = lane & 15, g = lane >> 4;
    const unsigned char* ws = a.ws;
    const unsigned char* WD = ws + WS_WD; const unsigned char* WU = ws + WS_WU;
    LAS float* aacc = (LAS float*)wl; LAS unsigned short* idl = (LAS unsigned short*)(wl + 8192); LAS unsigned short* actl = (LAS unsigned short*)(wl + 12288);
    lds_u8* xs = wl + 16384; LAS float* ssl = (LAS float*)(wl + 16384 + 512); LAS float* r2l = ssl + 16;
#pragma unroll 1
    for (int t = 0; t < 16; ++t) {
        const u32x2 iv = *(const GAS u32x2*)((const int*)(ws + WS_IDX) + (size_t)(tok0 + t) * 128 + lane * 2);
        *(LAS unsigned*)(wl + 8192 + t * 256 + lane * 4) = (iv.x & 0xffffu) | (iv.y << 16);
        *(LAS f32x2*)(wl + t * 512 + lane * 8) = (f32x2){0.f, 0.f};
    }
    if (lane < 16) { ssl[lane] = 0.f; r2l[lane] = row_rs2((const bf16_t*)(ws + WS_SSQ), tok0 + lane); }
    unsigned char* X4 = (unsigned char*)a.ws + WS_XB;
#pragma unroll 1
    for (int t = 0; t < 16; ++t) {
        const bf16_t* xr = (const bf16_t*)(ws + WS_X1B) + (size_t)(tok0 + t) * DM + 16 * lane;
        const u32x4 xw0 = *(const GAS u32x4*)xr, xw1 = *(const GAS u32x4*)(xr + 8);
        float rr[16];
#pragma unroll
        for (int j = 0; j < 4; ++j) { rr[2 * j] = __uint_as_float(xw0[j] << 16); rr[2 * j + 1] = __uint_as_float(xw0[j] & 0xffff0000u); rr[8 + 2 * j] = __uint_as_float(xw1[j] << 16); rr[9 + 2 * j] = __uint_as_float(xw1[j] & 0xffff0000u); }
#pragma unroll
        for (int st = 0; st < 4; ++st) {
            unsigned w0 = 0u, w1 = 0u;
#define P6_Q4(p_) do { w0 = __builtin_amdgcn_cvt_scalef32_pk_fp4_f32(w0, rr[2 * (p_)], rr[2 * (p_) + 1], 1.0f, p_); w1 = __builtin_amdgcn_cvt_scalef32_pk_fp4_f32(w1, rr[8 + 2 * (p_)], rr[9 + 2 * (p_)], 1.0f, p_); } while (0)
            P6_Q4(0); P6_Q4(1); P6_Q4(2); P6_Q4(3);
#undef P6_Q4
#define P6_D4(p_) do { const f32x2 d0 = __builtin_amdgcn_cvt_scalef32_pk_f32_fp4(w0, 1.0f, p_), d1 = __builtin_amdgcn_cvt_scalef32_pk_f32_fp4(w1, 1.0f, p_); \
                rr[2 * (p_)] = (rr[2 * (p_)] - d0.x) * 4.0f; rr[2 * (p_) + 1] = (rr[2 * (p_) + 1] - d0.y) * 4.0f; rr[8 + 2 * (p_)] = (rr[8 + 2 * (p_)] - d1.x) * 4.0f; rr[9 + 2 * (p_)] = (rr[9 + 2 * (p_)] - d1.y) * 4.0f; } while (0)
            P6_D4(0); P6_D4(1); P6_D4(2); P6_D4(3);
#undef P6_D4
            *(GAS u32x2*)(X4 + (size_t)(tok0 + t) * 2048 + st * 512 + 8 * lane) = (u32x2){w0, w1};
        }
    }
    LDS_WAIT(); VM_WAIT();
    const int xoff = (n & 3) * 128 + 16 * g;
    const int bpa = 4 * (4 * (lane & 15) + (lane >> 4));
#define MFMA4(a_, b_, c_) __builtin_amdgcn_mfma_scale_f32_16x16x128_f8f6f4(a_, b_, c_, 4  , 4  , 0, 0, 0, 0)
#define P6_DLOAD(BQ, XV, it_) do { const int sl_ = (it_) >> 4, t_ = (it_) & 15; \
        _Pragma("unroll") for (int eg = 0; eg < 8; ++eg) { const int e_ = idl[t_ * 128 + eg * 16 + (lane >> 2)] & EMASK; const unsigned char* rp_ = WD + sl_ * P6_SLICEB + (size_t)e_ * 128 + 16 * (lane & 3); \
            BQ[2 * eg] = *(const GAS u32x4*)rp_; BQ[2 * eg + 1] = *(const GAS u32x4*)(rp_ + 64); } \
        XV = *(const GAS u32x2*)(X4 + (size_t)(tok0 + t_) * 2048 + (lane >> 4) * 512 + sl_ * 128 + 8 * (lane & 15)); } while (0)
#define P6_DCOMP(BQ, XV, it_) do { const int t_ = (it_) & 15; \
        *(LAS u32x2*)(xs + (lane >> 4) * 128 + 8 * (lane & 15)) = XV; \
        LDS_WAIT(); \
        const u32x4 xa0 = *(const LAS u32x4*)(xs + xoff), xa1 = *(const LAS u32x4*)(xs + xoff + 64); \
        const v8i_t A0 = (v8i_t){(int)xa0.x, (int)xa0.y, (int)xa0.z, (int)xa0.w, 0, 0, 0, 0}; \
        const v8i_t A1 = (v8i_t){(int)xa1.x, (int)xa1.y, (int)xa1.z, (int)xa1.w, 0, 0, 0, 0}; \
        _Pragma("unroll") for (int eg = 0; eg < 8; ++eg) { f32x4 acc = (f32x4){0.f, 0.f, 0.f, 0.f}; v8i_t b0 = (v8i_t){0, 0, 0, 0, 0, 0, 0, 0}, b1 = (v8i_t){0, 0, 0, 0, 0, 0, 0, 0}; \
            _Pragma("unroll") for (int w_ = 0; w_ < 4; ++w_) { b0[w_] = __builtin_amdgcn_ds_bpermute(bpa, (int)BQ[2 * eg][w_]); b1[w_] = __builtin_amdgcn_ds_bpermute(bpa, (int)BQ[2 * eg + 1][w_]); } \
            acc = MFMA4(A0, b0, acc); acc = MFMA4(A1, b1, acc); \
            float r_ = (acc[0] + acc[1] * 0.25f) + (acc[2] * 0.0625f + acc[3] * 0.015625f); asm volatile("" : "+v"(r_)); \
            if (g == 0) aacc[t_ * 128 + eg * 16 + n] += r_; } \
        LDS_WAIT(); } while (0)
    if (PARTS & 1) {
        u32x4 bqA[16], bqB[16]; u32x2 xvA, xvB;
        P6_DLOAD(bqA, xvA, 0);
#pragma unroll 1
        for (int it = 0; it < 64; it += 2) {
            P6_DLOAD(bqB, xvB, it + 1);
            P6_DCOMP(bqA, xvA, it);
            if (it + 2 < 64) P6_DLOAD(bqA, xvA, it + 2);
            P6_DCOMP(bqB, xvB, it + 1);
        }
    }
#undef MFMA4
#undef P6_DLOAD
#undef P6_DCOMP
    int lane_g = lane; asm volatile("" : "+v"(lane_g));
#pragma unroll 1
    for (int t = 0; t < 16; ++t) {
        const float sc = r2l[t] * (1.0f / P6_SD);
#pragma unroll
        for (int j = 0; j < 2; ++j) { const int ei = lane_g + 64 * j; const float av = aacc[t * 128 + ei] * sc;
            const float act = gelu_as(av) * ((const float*)(ws + WS_GATE))[(size_t)(tok0 + t) * 128 + ei];
            const unsigned ab = __float_as_uint(act), eb = (ab >> 23) & 255u;
            unsigned pk = 0u;
            if (eb > 4u) {
                const float m = __uint_as_float((ab & 0x807fffffu) | (128u << 23));
                const unsigned w0 = __builtin_amdgcn_cvt_scalef32_pk_fp4_f32(0u, m, 0.f, 1.0f, 0);
                const f32x2 d0 = __builtin_amdgcn_cvt_scalef32_pk_f32_fp4(w0, 1.0f, 0);
                const unsigned w1 = __builtin_amdgcn_cvt_scalef32_pk_fp4_f32(0u, (m - d0.x) * 4.0f, 0.f, 1.0f, 0);
                pk = (w0 & 15u) | ((w1 & 15u) << 4) | ((eb - 1u) << 8);
            }
            actl[t * 128 + ei] = (unsigned short)pk; }
    }
    LDS_WAIT();
    int lane_u = lane; asm volatile("" : "+v"(lane_u));
    const float* nf = a.in[16];
    const int ui = lane_u & 31, ug = lane_u >> 5, ush = 4 * (ui & 7);
    const unsigned uk0 = (ui >> 3) == 0 ? 0xffffffffu : 0u, uk1 = (ui >> 3) == 1 ? 0xffffffffu : 0u, uk2 = (ui >> 3) == 2 ? 0xffffffffu : 0u, uk3 = (ui >> 3) == 3 ? 0xffffffffu : 0u;
#define MFMA32S(a_, b_, c_, sa_) __builtin_amdgcn_mfma_scale_f32_32x32x64_f8f6f4(a_, b_, c_, 4, 4, 0, sa_, 0, 127)
#define P6_ULOAD(BQ, sq_) do { const int t_ = (sq_) >> 3, qs_ = (sq_) & 7; \
        _Pragma("unroll") for (int q = 0; q < 8; ++q) { const int e_ = idl[t_ * 128 + 2 * (8 * qs_ + q) + ug] & EMASK; \
            BQ[q] = *(const GAS u32x4*)(WU + (size_t)e_ * 512 + 16 * ui); } } while (0)
#define P6_UMMA(BQ, sq_) do { const int t_ = (sq_) >> 3, qs_ = (sq_) & 7; \
        _Pragma("unroll") for (int q = 0; q < 8; ++q) { \
            const unsigned av_ = actl[t_ * 128 + 2 * (8 * qs_ + q) + ug]; \
            const unsigned w0_ = (av_ & 15u) << ush, w1_ = ((av_ >> 4) & 15u) << ush; const int s0_ = (int)(av_ >> 8), s1_ = s0_ - 2; \
            const u32x4 bb = BQ[q]; const v8i_t B_ = (v8i_t){(int)bb.x, (int)bb.y, (int)bb.z, (int)bb.w, 0, 0, 0, 0}; \
            uacc = MFMA32S(((v8i_t){(int)(w0_ & uk0), (int)(w0_ & uk1), (int)(w0_ & uk2), (int)(w0_ & uk3), 0, 0, 0, 0}), B_, uacc, s0_); \
            uacc = MFMA32S(((v8i_t){(int)(w1_ & uk0), (int)(w1_ & uk1), (int)(w1_ & uk2), (int)(w1_ & uk3), 0, 0, 0, 0}), B_, uacc, s1_); } } while (0)
#define P6_UEPI(sq_) do { const int t_ = (sq_) >> 3; \
        float* orow = a.out + (size_t)(tok0 + t_) * DM + 32 * ui + 4 * ug; const bf16_t* xrow = (const bf16_t*)(ws + WS_X1B) + (size_t)(tok0 + t_) * DM + 32 * ui + 4 * ug; \
        f32x4 x2[4]; float ss = 0.f; \
        _Pragma("unroll") for (int gq = 0; gq < 4; ++gq) { \
            const u32x2 xq_ = *(const GAS u32x2*)(xrow + 8 * gq); \
            x2[gq] = (f32x4){__uint_as_float(xq_.x << 16), __uint_as_float(xq_.x & 0xffff0000u), __uint_as_float(xq_.y << 16), __uint_as_float(xq_.y & 0xffff0000u)} \
                + (f32x4){uacc[4 * gq], uacc[4 * gq + 1], uacc[4 * gq + 2], uacc[4 * gq + 3]} * (1.0f / P6_SU4); \
            ss += (x2[gq].x * x2[gq].x + x2[gq].y * x2[gq].y) + (x2[gq].z * x2[gq].z + x2[gq].w * x2[gq].w); } \
        const float rn = 1.0f / sqrtf(wave_sum(ss) * (1.0f / DM) + EPSF);     \
        _Pragma("unroll") for (int gq = 0; gq < 4; ++gq) { const f32x4 gv = *(const GAS f32x4*)(nf + 32 * ui + 4 * ug + 8 * gq); *(GAS f32x4*)(orow + 8 * gq) = x2[gq] * rn * gv; } \
        uacc = f32x16{}; } while (0)
    if (PARTS & 2) {
        u32x4 bqA[8], bqB[8]; f32x16 uacc = f32x16{};
        P6_ULOAD(bqA, 0);
#pragma unroll 1
        for (int sq = 0; sq < 128; sq += 2) {
            P6_ULOAD(bqB, sq + 1);
            P6_UMMA(bqA, sq);
            if (sq + 2 < 128) P6_ULOAD(bqA, sq + 2);
            P6_UMMA(bqB, sq + 1);
            if (((sq + 1) & 7) == 7) P6_UEPI(sq + 1);
        }
    }
#undef P6_ULOAD
#undef P6_UMMA
#undef P6_UEPI
#undef MFMA32S
}

#ifndef MK_N_LAUNCHES
#define MK_N_LAUNCHES 1
#endif
constexpr int NPHASE = 7;

__device__ __forceinline__ int queue_next(unsigned* ctr, volatile LAS unsigned* slot) {
    __syncthreads();
    if (threadIdx.x == 0) *slot = __hip_atomic_fetch_add(ctr, 1u, __ATOMIC_RELAXED, __HIP_MEMORY_SCOPE_AGENT);
    __syncthreads();
    return (int)*slot;
}

__global__ void __launch_bounds__(NTHR, 2) hymba_fwd(Args a) {
    extern __shared__ __attribute__((aligned(16))) unsigned char lds_raw[];
    lds_u8* lds = (lds_u8*)lds_raw;
    volatile LAS unsigned* MISC = (volatile LAS unsigned*)(lds + MISC_OFF);
    const int tid = threadIdx.x, lane = tid & 63; const int wave = __builtin_amdgcn_readfirstlane(tid >> 6);
    const int G = gridDim.x; const int bx = blockIdx.x;
    const int vcu = (G % 8 == 0) ? (bx % 8) * (G / 8) + bx / 8 : bx;
    const int gw = vcu * NWAVES + wave, NGW = G * NWAVES;
    for (int u = tid; u < (LDS_BYTES - MISC_OFF) / 4; u += NTHR) MISC[u] = 0u;
    __syncthreads();
    const int lo = a.ph_lo, hi = a.ph_hi;
    const bool use_bar = (hi - lo) > 1;
    XcdBarrier bar; bar.bar = (unsigned*)(a.ws + WS_CTL); bar.x = 0; bar.st = MISC + 8;
    if (use_bar) bar = xcd_barrier_post((unsigned*)(a.ws + WS_CTL), MISC + 8);
#ifndef PH_MASK
#define PH_MASK 127
#endif
#define IN(k) (((PH_MASK >> (k)) & 1) && lo <= (k) && (k) < hi)
#define SEAM(k) do { if (IN(k) && IN((k) + 1)) xcd_barrier(bar); } while (0)
    unsigned char* ws = a.ws;

    if (IN(0)) { p0_prologue(a, lds, gw, NGW, lane, wave);
#ifdef DBL_P0
        __syncthreads(); p0_prologue(a, lds, gw, NGW, lane, wave);
#endif
    }
    SEAM(0);
    if (IN(1)) {
        pg8::Gemm g{(const bf16_t*)(ws + WS_XB), (const bf16_t*)(ws + WS_WIN), MTOK, NIN, DM}; pg8::StaticOrder S; S.init(MTOK, NIN, G, bx);
        EpiProj E{(bf16_t*)(ws + WS_PROJ), (const float*)(ws + WS_R1), (const f32x4*)(ws + WS_ROPE), (const float*)(ws + WS_DECAY)};
        pg8::gemm_phase<EpiProj, pg8::StaticOrder>(lds, g, S, E);
#ifdef DBL_P1
        pg8::gemm_phase<EpiProj, pg8::StaticOrder>(lds, g, S, E);
#endif
    }
    SEAM(1);
    if (IN(2)) {
#ifdef DBL_P2
        for (int rep = 0; rep < 2; ++rep) {
        unsigned* ctr = (unsigned*)(ws + WS_CTL + CTL_Q_ATT + rep * 256);
#else
        {
        unsigned* ctr = (unsigned*)(ws + WS_CTL + CTL_Q_ATT);
#endif
        for (;;) {
            const int u = queue_next(ctr, MISC + 16);
            if (u >= 64 + 1024 + DEF_ITEMS) break;
            if (u >= 64 + 1024) { p0_deferred(a, lds, u - (64 + 1024)); continue; }
#ifdef PROBE_P2
            if (rep == 0) { if (u < 64) { if (PROBE_P2 & 1) ret_unit(a, lds, u >> 3, u & 7); } else if (PROBE_P2 & 2) { const int v = u - 64; attn_unit<PROBE_ATT>(a, lds, (v & 31) >> 2, v & 3, 31 - (v >> 5)); } continue; }
#endif
            if (u < 64) ret_unit(a, lds, u >> 3, u & 7);
            else { const int v = u - 64; attn_unit<7>(a, lds, (v & 31) >> 2, v & 3, 31 - (v >> 5)); }
        }
        }
    }
    SEAM(2);
    if (IN(3)) {
        pg8::Gemm g{(const bf16_t*)(ws + WS_MIX), (const bf16_t*)(ws + WS_WOUT), MTOK, DM, DM}; pg8::StaticOrder S; S.init(MTOK, DM, G, bx);
        EpiX1 E{(const bf16_t*)(ws + WS_XB), (bf16_t*)(ws + WS_X1B), (bf16_t*)(ws + WS_SSQ)};
        pg8::gemm_phase<EpiX1, pg8::StaticOrder>(lds, g, S, E);
    }
    SEAM(3);
    if (IN(4)) {
        pg8::Gemm g{(const bf16_t*)(ws + WS_X1B), (const bf16_t*)(ws + WS_WPQ), MTOK, NQ, DM}; pg8::StaticOrder S; S.init(MTOK, NQ, G, bx);
        EpiQ E{(bf16_t*)(ws + WS_PROJ), (const bf16_t*)(ws + WS_SSQ)};
        pg8::gemm_phase<EpiQ, pg8::StaticOrder>(lds, g, S, E);
#ifdef DBL_P4
        pg8::gemm_phase<EpiQ, pg8::StaticOrder>(lds, g, S, E);
#endif
    }
    SEAM(4);
    if (IN(5)) { p5_topk(a, lds);
#ifdef DBL_P5
        p5_topk(a, lds);
#endif
    }
    SEAM(5);
    if (IN(6)) {
#ifdef P6_TOKEN_MAJOR
        lds_u8* wl = lds + wave * P6_WSCR;
        for (int tok = gw; tok < MTOK; tok += NGW) p6_token(a, wl, tok, lane, a.out);
#else
#ifdef PROBE_EMASK
        for (int tb = gw; tb < MTOK / 16; tb += NGW) p6_slices<PROBE_EMASK, PROBE_PARTS>(a, lds + wave * P6S_WAVE, tb * 16, lane);
#endif
        for (int tb = gw; tb < MTOK / 16; tb += NGW) p6_slices<0xffff, 3>(a, lds + wave * P6S_WAVE, tb * 16, lane);
#endif
    }
#ifdef DBG_DUMP
    if (hi - lo > 1) xcd_barrier(bar);
    {
        for (int m = gw; m < MTOK; m += NGW) {
            for (int c = lane; c < DM; c += 64) {
                float v = 0.f;
#if DBG_DUMP == 1
                v = bf2f(((const bf16_t*)(ws + WS_PROJ))[(size_t)m * NIN + DBG_COL + c]);
#elif DBG_DUMP == 2
                v = (c >= DBG_C0 && c < DBG_C1) ? bf2f(((const bf16_t*)(ws + WS_MIX))[(size_t)m * DM + c]) : 0.f;
#endif
                a.out[(size_t)m * DM + c] = v;
            }
        }
    }
#endif
#undef IN
#undef SEAM
}

extern "C" void kernel_launch(void* const* d_in, const int* in_sizes, int n_in, void* d_out, int out_size, void* d_ws, size_t ws_size, hipStream_t stream) {
    static int grid = 0;
    if (grid == 0) {
        if (n_in != 17 || in_sizes[0] != MTOK * DM || out_size != MTOK * DM || ws_size < WS_END) {
            fprintf(stderr, "kernel_launch: unexpected shapes (n_in %d, in0 %d, out %d, ws %zu < %zu); nothing launched\n", n_in, n_in > 0 ? in_sizes[0] : -1, out_size, ws_size, (size_t)WS_END); grid = -1; return; }
        int dev = 0, cus = 0, per_cu = 0;
        if (hipGetDevice(&dev) != hipSuccess || hipDeviceGetAttribute(&cus, hipDeviceAttributeMultiprocessorCount, dev) != hipSuccess) { fprintf(stderr, "kernel_launch: device query failed\n"); grid = -1; return; }
        if (hipFuncSetAttribute((const void*)hymba_fwd, hipFuncAttributeMaxDynamicSharedMemorySize, LDS_BYTES) != hipSuccess) { fprintf(stderr, "kernel_launch: hipFuncSetAttribute failed\n"); grid = -1; return; }
        if (hipOccupancyMaxActiveBlocksPerMultiprocessor(&per_cu, (const void*)hymba_fwd, NTHR, LDS_BYTES) != hipSuccess || per_cu < 1)
            fprintf(stderr, "kernel_launch: note: occupancy query reports %d workgroups per CU\n", per_cu);
        (void)hipGetLastError();
        grid = cus;
    }
    if (grid < 0) return;
    if (hipMemsetAsync((char*)d_ws + WS_CTL, 0, CTL_BYTES, stream) != hipSuccess) { fprintf(stderr, "kernel_launch: memset failed\n"); return; }
    Args a{};
    for (int i = 0; i < 17; ++i) a.in[i] = (const float*)d_in[i];
    a.out = (float*)d_out; a.ws = (unsigned char*)d_ws;
#if MK_N_LAUNCHES == 1
#ifdef DBG_STOP
    a.ph_lo = 0; a.ph_hi = DBG_STOP + 1;
#else
    a.ph_lo = 0; a.ph_hi = NPHASE;
#endif
    hipLaunchKernelGGL(hymba_fwd, dim3(grid), dim3(NTHR), LDS_BYTES, stream, a);
#else
    for (int p = 0; p < NPHASE; ++p) { a.ph_lo = p; a.ph_hi = p + 1; hipLaunchKernelGGL(hymba_fwd, dim3(grid), dim3(NTHR), LDS_BYTES, stream, a); }
#endif
    const hipError_t le = hipPeekAtLastError();
    if (le != hipSuccess) fprintf(stderr, "kernel_launch: launch failed: %s\n", hipGetErrorName(le));
}
```

```cpp
#include <hip/hip_runtime.h>
#include <cstdio>
#include <cstdint>

namespace pg8 {
#define PG8_LAS __attribute__((address_space(3)))
typedef unsigned short bf16_t;
typedef short bf16x8 __attribute__((ext_vector_type(8)));
typedef float f32x4 __attribute__((ext_vector_type(4)));
typedef unsigned u32x4 __attribute__((ext_vector_type(4)));
constexpr int BM = 256, BK = 64, HALF = 128, HTB = HALF * BK * 2  , STAGE_BYTES = 8 * HTB, NXCD = 8, WGM = 8;

__host__ __device__ __forceinline__ int lds_byte(int r, int c) { const int st = (r >> 4) * 2 + (c >> 5), rr = r & 15, cc = c & 31, ob = rr * 64 + cc * 2; return st * 1024 + (ob ^ (((ob >> 9) & 1) << 5)); }
__host__ __device__ __forceinline__ void stage_rc(int b, int& R, int& C) { const int st = b / 1024, sb = b % 1024, swz = sb ^ (((sb >> 9) & 1) << 5); R = (st >> 1) * 16 + swz / 64; C = (st & 1) * 32 + (swz % 64) / 2; }
__host__ __device__ __forceinline__ int perm32(int rho) { const int n = rho >> 4, i = rho & 15; return 8 * (i >> 2) + 4 * n + (i & 3); }

struct Unit { int pm, pn; };
struct Gemm { const bf16_t* A; const bf16_t* Bt; int M, N, K; };

struct StaticOrder {
    int nM, nN, nwg, G, c;
    __host__ __device__ void init(int M, int N, int G_, int c_) { nM = M / BM; nN = N / BM; nwg = nM * nN; G = G_; c = c_; }
    __host__ __device__ bool next(int i, Unit& u) const {
        const long L = (long)i * G + c; if (L >= nwg) return false;
        int wgid = (int)L; { const int q = nwg / NXCD, r = nwg % NXCD, xcd = wgid % NXCD, off = wgid / NXCD; wgid = (xcd < r ? xcd * (q + 1) : r * (q + 1) + (xcd - r) * q) + off; }
        const int nig = WGM * nN, gid = wgid / nig, fm = gid * WGM, gsz = (nM - fm) < WGM ? (nM - fm) : WGM;
        u.pm = fm + ((wgid % nig) % gsz); u.pn = (wgid % nig) / gsz; return true;
    }
    __device__ __forceinline__ void a_ready(const Unit&) const {}
    __device__ __forceinline__ void done(const Unit&) const {}
};
__device__ __forceinline__ unsigned cvt_pk_bf16(float lo, float hi) { unsigned r; asm volatile("v_cvt_pk_bf16_f32 %0, %1, %2" : "=v"(r) : "v"(lo), "v"(hi)); return r; }
template <class Epi, class Sched>
__device__ __forceinline__ void gemm_phase(PG8_LAS unsigned char* lds, const Gemm g, const Sched& S, const Epi& E) {
    const int tid = threadIdx.x, wid = __builtin_amdgcn_readfirstlane(tid >> 6), lane = tid & 63, wr = wid >> 2, wc = wid & 3, fr = lane & 15, fq = lane >> 4;
    const int K = g.K, nt = K / BK;
    unsigned voffA[2], voffB[2];
#pragma unroll
    for (int i = 0; i < 2; ++i) { int R, C; stage_rc(tid * 16 + i * 8192, R, C); const int Rb = Epi::PERM ? ((R & ~31) + perm32(R & 31)) : R;
        voffA[i] = (unsigned)(R * K + C) * 2u; voffB[i] = (unsigned)(Rb * K + C) * 2u; }
    const size_t kstep = (size_t)(BK * 2);
    const size_t hstep = (size_t)HALF * K * 2;
    const size_t tstep = 2 * hstep;
    const unsigned ldsw = (unsigned)wid * 1024u;
    const int aoff = lds_byte(wr * 64 + fr, fq * 8), boff = lds_byte(wc * 32 + fr, fq * 8);
#define PG8_SA(b, h) (((b) * 2 + (h)) * HTB)
#define PG8_SB(b, h) ((4 + (b) * 2 + (h)) * HTB)
#define PG8_STAGE(bufoff, gbase, voff) do { _Pragma("unroll") for (int _i = 0; _i < 2; ++_i) \
        __builtin_amdgcn_global_load_lds((const unsigned*)((const char*)(gbase) + (voff)[_i]), (PG8_LAS unsigned*)(lds + (bufoff) + ldsw + _i * 8192), 16, 0, 0); } while (0)
#define PG8_LDA(dst, b, h) do { _Pragma("unroll") for (int m = 0; m < 4; ++m) _Pragma("unroll") for (int k = 0; k < 2; ++k) dst[m][k] = *(const PG8_LAS bf16x8*)(lds + PG8_SA(b, h) + aoff + m * 2048 + k * 1024); } while (0)
#define PG8_LDB(dst, b, h) do { _Pragma("unroll") for (int n = 0; n < 2; ++n) _Pragma("unroll") for (int k = 0; k < 2; ++k) dst[n][k] = *(const PG8_LAS bf16x8*)(lds + PG8_SB(b, h) + boff + n * 2048 + k * 1024); } while (0)
#define PG8_MMA(ai, bj, At, Bt) do { __builtin_amdgcn_s_setprio(1); _Pragma("unroll") for (int m = 0; m < 4; ++m) _Pragma("unroll") for (int n = 0; n < 2; ++n) _Pragma("unroll") for (int k = 0; k < 2; ++k) \
        acc[ai][bj][m][n] = __builtin_amdgcn_mfma_f32_16x16x32_bf16(Bt[n][k], At[m][k], acc[ai][bj][m][n], 0, 0, 0); __builtin_amdgcn_s_setprio(0); } while (0)
#define PG8_WAIT_V(n) asm volatile("s_waitcnt vmcnt(" #n ")" ::: "memory")
#define PG8_WAIT_L(n) asm volatile("s_waitcnt lgkmcnt(" #n ")" ::: "memory")
#define PG8_BAR __builtin_amdgcn_s_barrier()
#define PG8_SCHED __builtin_amdgcn_sched_barrier(0)
    Unit cur, nxt; int ui = 0;
    if (!S.next(0, cur)) return;
    f32x4 acc[2][2][4][2];
#pragma unroll
    for (int a = 0; a < 2; ++a)
#pragma unroll
        for (int b = 0; b < 2; ++b)
#pragma unroll
            for (int m = 0; m < 4; ++m)
#pragma unroll
                for (int n = 0; n < 2; ++n) acc[a][b][m][n] = (f32x4){0.f, 0.f, 0.f, 0.f};
    bf16x8 At[4][2], B0[2][2], B1[2][2];
    const char* cA = (const char*)g.A + (size_t)cur.pm * tstep; const char* cB = (const char*)g.Bt + (size_t)cur.pn * tstep;
    S.a_ready(cur);
    PG8_STAGE(PG8_SB(0, 0), cB, voffB); PG8_STAGE(PG8_SA(0, 0), cA, voffA); PG8_STAGE(PG8_SB(0, 1), cB + hstep, voffB); PG8_STAGE(PG8_SA(0, 1), cA + hstep, voffA);
    if (wr == 1) PG8_BAR;
    PG8_WAIT_V(4); PG8_BAR;
    PG8_STAGE(PG8_SB(1, 0), cB + kstep, voffB); PG8_STAGE(PG8_SA(1, 0), cA + kstep, voffA); PG8_STAGE(PG8_SB(1, 1), cB + hstep + kstep, voffB);
    PG8_WAIT_V(6); PG8_BAR;
    for (;;) {
        const bool has_next = S.next(ui + 1, nxt);
        const char* nA = has_next ? (const char*)g.A + (size_t)nxt.pm * tstep : cA; const char* nB = has_next ? (const char*)g.Bt + (size_t)nxt.pn * tstep : cB;
        for (int t = 0; t < nt; t += 2) {
            const bool last = (t == nt - 2);
            const char* a1 = cA + (size_t)(t + 1) * kstep;
            const char* a2 = last ? nA : cA + (size_t)(t + 2) * kstep; const char* b2 = last ? nB : cB + (size_t)(t + 2) * kstep;
            const char* a3 = a2 + kstep; const char* b3 = b2 + kstep;
            if (last && has_next) S.a_ready(nxt);
            PG8_LDB(B0, 0, 0); PG8_SCHED; PG8_LDA(At, 0, 0); PG8_STAGE(PG8_SA(1, 1), a1 + hstep, voffA);
            PG8_WAIT_L(8); PG8_BAR; PG8_WAIT_L(0); PG8_MMA(0, 0, At, B0); PG8_BAR; PG8_SCHED;
            PG8_LDB(B1, 0, 1); PG8_STAGE(PG8_SB(0, 0), b2, voffB);
            PG8_BAR; PG8_WAIT_L(0); PG8_MMA(0, 1, At, B1); PG8_BAR;
            PG8_LDA(At, 0, 1); PG8_STAGE(PG8_SA(0, 0), a2, voffA);
            PG8_BAR; PG8_WAIT_L(0); PG8_MMA(1, 0, At, B0); PG8_BAR; PG8_SCHED;
            PG8_STAGE(PG8_SB(0, 1), b2 + hstep, voffB);
            PG8_WAIT_V(6); PG8_BAR; PG8_MMA(1, 1, At, B1); PG8_BAR;
            PG8_LDB(B0, 1, 0); PG8_SCHED; PG8_LDA(At, 1, 0); PG8_STAGE(PG8_SA(0, 1), a2 + hstep, voffA);
            PG8_WAIT_L(8); PG8_BAR; PG8_WAIT_L(0); PG8_MMA(0, 0, At, B0); PG8_BAR; PG8_SCHED;
            PG8_LDB(B1, 1, 1); PG8_STAGE(PG8_SB(1, 0), b3, voffB);
            PG8_BAR; PG8_WAIT_L(0); PG8_MMA(0, 1, At, B1); PG8_BAR;
            PG8_LDA(At, 1, 1); PG8_STAGE(PG8_SA(1, 0), a3, voffA);
            PG8_BAR; PG8_WAIT_L(0); PG8_MMA(1, 0, At, B0); PG8_BAR; PG8_SCHED;
            PG8_STAGE(PG8_SB(1, 1), b3 + hstep, voffB);
            PG8_WAIT_V(6); PG8_BAR; PG8_MMA(1, 1, At, B1); PG8_BAR;
        }
        if constexpr (!Epi::AFTER_DRAIN) { E(acc, cur, wr, wc, fr, fq); S.done(cur); }
        if (!has_next) break;
#pragma unroll
        for (int a = 0; a < 2; ++a)
#pragma unroll
            for (int b = 0; b < 2; ++b)
#pragma unroll
                for (int m = 0; m < 4; ++m)
#pragma unroll
                    for (int n = 0; n < 2; ++n) acc[a][b][m][n] = (f32x4){0.f, 0.f, 0.f, 0.f};
        cur = nxt; cA = nA; cB = nB; ++ui;
    }
    PG8_WAIT_V(0);
    if (wr == 0) PG8_BAR;
    PG8_BAR;
    if constexpr (Epi::AFTER_DRAIN) { E.fused(acc, cur, wr, wc, fr, fq, lds, wid, lane); S.done(cur); }
#undef PG8_SA
#undef PG8_SB
#undef PG8_STAGE
#undef PG8_LDA
#undef PG8_LDB
#undef PG8_MMA
#undef PG8_WAIT_V
#undef PG8_WAIT_L
#undef PG8_BAR
#undef PG8_SCHED
}
}

#define XB_TMO      128
#define XB_XCNT(j)  (256  + 64 * (j))
#define XB_XSUB(j)  (1280 + 64 * (j))
#define XB_XGEN(j)  (2304 + 64 * (j))
#define XB_TOP      3328
#define XB_TOPGEN   3392
#define XCD_BAR_WORDS 3456
#define XB_SPIN_CAP (1u << 18)
#define LAS __attribute__((address_space(3)))

__device__ __forceinline__ unsigned xb_ld(unsigned* p)              { return __hip_atomic_load(p, __ATOMIC_RELAXED, __HIP_MEMORY_SCOPE_AGENT); }
__device__ __forceinline__ unsigned xb_add(unsigned* p, unsigned v) { return __hip_atomic_fetch_add(p, v, __ATOMIC_RELAXED, __HIP_MEMORY_SCOPE_AGENT); }
__device__ __forceinline__ unsigned xb_xcc_id() { return (unsigned)__builtin_amdgcn_s_getreg((3 << 11) | 20) & 0xFu; }
#define XB_SPIN(cond, bar) do { unsigned _sp = 0; while (cond) { __builtin_amdgcn_s_sleep(1); \
    if ((++_sp & 255u) == 0u) { if (xb_ld(&(bar)[XB_TMO])) break; if (_sp > XB_SPIN_CAP) { atomicAdd(&(bar)[XB_TMO], 1u); break; } } } } while (0)

struct XcdBarrier {
    unsigned* bar; unsigned x;
    volatile LAS unsigned* st;
};

__device__ __forceinline__ XcdBarrier xcd_barrier_post(unsigned* bar, volatile LAS unsigned* st) {
    XcdBarrier b; b.bar = bar; b.x = xb_xcc_id(); b.st = st;
    if (threadIdx.x == 0) (void)xb_add(&bar[XB_XCNT(b.x)], 1u);
    return b;
}
__device__ __forceinline__ void xcd_barrier_complete(unsigned* bar, unsigned x, unsigned& nloc, unsigned& nx) {
    const unsigned G = gridDim.x * gridDim.y * gridDim.z;
    unsigned sum, cnt, mine, sp = 0u;
    for (;;) {
        sum = 0u; cnt = 0u; mine = 0u;
#pragma unroll
        for (unsigned j = 0; j < 16; ++j) { const unsigned c = xb_ld(&bar[XB_XCNT(j)]); sum += c; cnt += (c > 0u) ? 1u : 0u; mine = (j == x) ? c : mine; }
        if (sum == G) break;
        __builtin_amdgcn_s_sleep(1);
        if ((++sp & 255u) == 0u) { if (xb_ld(&bar[XB_TMO])) break; if (sp > XB_SPIN_CAP) { atomicAdd(&bar[XB_TMO], 1u); break; } }
    }
    nloc = mine > 0u ? mine : 1u; nx = cnt > 0u ? cnt : 1u;
}

__device__ __forceinline__ void xcd_barrier(const XcdBarrier& b) {
    asm volatile("s_waitcnt vmcnt(0)" ::: "memory");
    __syncthreads();
    if (threadIdx.x == 0) {
        unsigned* bar = b.bar;
        __builtin_amdgcn_s_waitcnt(0);
        unsigned nloc = b.st[0], nx = b.st[1];
        if (nloc == 0u) { xcd_barrier_complete(bar, b.x, nloc, nx); b.st[0] = nloc; b.st[1] = nx; }
        const unsigned old = xb_add(&bar[XB_XSUB(b.x)], 1u);
        const unsigned gen = old / nloc;
        if (old + 1u == (gen + 1u) * nloc) {
            __builtin_amdgcn_fence(__ATOMIC_RELEASE, "agent");
            asm volatile("s_waitcnt vmcnt(0)" ::: "memory");
            const unsigned og = xb_add(&bar[XB_TOP], 1u);
            const unsigned tg = og / nx;
            if (og + 1u == (tg + 1u) * nx) xb_add(&bar[XB_TOPGEN], 1u);
            else XB_SPIN(xb_ld(&bar[XB_TOPGEN]) == tg, bar);
            __builtin_amdgcn_fence(__ATOMIC_ACQUIRE, "agent");
            xb_add(&bar[XB_XGEN(b.x)], 1u);
            asm volatile("s_waitcnt vmcnt(0)" ::: "memory");
        } else {
            XB_SPIN(xb_ld(&bar[XB_XGEN(b.x)]) == gen, bar);
            __builtin_amdgcn_fence(__ATOMIC_ACQUIRE, "agent");
            asm volatile("s_waitcnt vmcnt(0)" ::: "memory");
        }
    }
    __syncthreads();
}

#define GAS __attribute__((address_space(1)))
typedef unsigned short bf16_t;
typedef short bf16x8 __attribute__((ext_vector_type(8)));
typedef short s16x4 __attribute__((ext_vector_type(4)));
typedef float f32x4 __attribute__((ext_vector_type(4)));
typedef float f32x2 __attribute__((ext_vector_type(2)));
typedef float f32x16 __attribute__((ext_vector_type(16)));
typedef unsigned u32x4 __attribute__((ext_vector_type(4)));
typedef unsigned u32x2 __attribute__((ext_vector_type(2)));
typedef LAS unsigned char lds_u8;

constexpr int MTOK = 32768, DM = 1024, SEQ = 4096, NBATCH = 8, NIN = 3584;
constexpr int OFF_RQ = 0, OFF_RK = 512, OFF_RV = 1024, OFF_RG = 1536, OFF_DQ = 2048, OFF_DK = 2560, OFF_DV = 3072;
constexpr int NEXP = 16384, NQ = 2048;
constexpr float EPSF = 1e-6f, LOG2E = 1.4426950408889634f;
constexpr int NWAVES = 8, NTHR = 512;

constexpr size_t WS_CTL = 0, CTL_BYTES = 65536;
constexpr size_t CTL_Q_ATT = 16384, CTL_Q_P6 = 16384 + 1024;
constexpr size_t WS_R1 = WS_CTL + CTL_BYTES;
constexpr size_t WS_SSQ = WS_R1 + (size_t)MTOK * 4;
constexpr size_t WS_ROPE = WS_SSQ + (size_t)MTOK * 16 * 4;
constexpr size_t WS_DECAY = WS_ROPE + (size_t)SEQ * 32 * 8;
constexpr size_t WS_BTAB = WS_DECAY + 2 * 8 * 128 * 4;
constexpr size_t WS_LAM = WS_BTAB + 4 * 128 * 4;
constexpr size_t WS_WIN = 4u << 20;
constexpr size_t WS_WOUT = WS_WIN + (size_t)NIN * DM * 2;
constexpr size_t WS_WPQ = WS_WOUT + (size_t)DM * DM * 2;
constexpr size_t WS_KEYS = WS_WPQ + (size_t)NQ * DM * 2;
constexpr size_t WS_WD = WS_KEYS + (size_t)8 * 2 * 128 * 128 * 2;
constexpr size_t WS_WU = WS_WD + (size_t)NEXP * DM * 2;
constexpr size_t WS_XB = WS_WU + (size_t)NEXP * DM * 2;
constexpr size_t WS_PROJ = WS_XB + (size_t)MTOK * DM * 2;
constexpr size_t WS_MIX = WS_PROJ + (size_t)MTOK * NIN * 2;
constexpr size_t WS_IDX = WS_MIX, WS_GATE = WS_MIX + (size_t)MTOK * 128 * 4;
constexpr size_t WS_X1B = WS_PROJ + (size_t)MTOK * NQ * 2;
static_assert(WS_X1B + (size_t)MTOK * DM * 2 <= WS_MIX, "ws map");
constexpr size_t WS_END = WS_MIX + (size_t)MTOK * DM * 2;
static_assert(WS_LAM + 256 <= WS_WIN, "ws map");
static_assert(WS_END <= (size_t)512 << 20, "ws map");

constexpr int LDS_SCRATCH = 139264;
constexpr int MISC_OFF = LDS_SCRATCH;
constexpr int LDS_BYTES = 147456;

__device__ __forceinline__ float wave_sum(float v) {
#pragma unroll
    for (int o = 1; o < 64; o <<= 1) v += __shfl_xor(v, o);
    return v;
}
typedef __bf16 bf16v2_t __attribute__((ext_vector_type(2)));
__device__ __forceinline__ unsigned pk2(float lo, float hi) { const bf16v2_t v = {(__bf16)lo, (__bf16)hi}; return __builtin_bit_cast(unsigned, v); }
__device__ __forceinline__ float bf2f(unsigned short b) { return __uint_as_float(((unsigned)b) << 16); }
#define LDS_WAIT() asm volatile("s_waitcnt lgkmcnt(0)" ::: "memory")
#define VM_WAIT() asm volatile("s_waitcnt vmcnt(0)" ::: "memory")

struct Args {
    const float* in[17]; float* out; unsigned char* ws; int ph_lo, ph_hi;
};

template <int MODE>
__device__ __forceinline__ void p0_transpose_item(const float* W, const float* scale, int K, int N, bf16_t* WT, LAS float* scr, int item, int lane) {
    const int nblk = N / 32, kb = item / nblk, nb = item % nblk, k0 = 64 * kb, n0 = 32 * nb;
#pragma unroll 8
    for (int i = 0; i < 32; ++i) { const int kk = 2 * i + (lane >> 5); const float sc = scale ? scale[k0 + kk] : 1.0f; scr[kk * 33 + (lane & 31)] = W[(size_t)(k0 + kk) * N + n0 + (lane & 31)] * sc; }
    LDS_WAIT();
    const int c = lane & 7;
#pragma unroll
    for (int j = 0; j < 4; ++j) { const int n = (lane >> 3) + 8 * j; const LAS float* s = scr + (8 * c) * 33 + n;
        u32x4 o; o.x = pk2(s[0 * 33], s[1 * 33]); o.y = pk2(s[2 * 33], s[3 * 33]); o.z = pk2(s[4 * 33], s[5 * 33]); o.w = pk2(s[6 * 33], s[7 * 33]);
        int nn = n0 + n;
        if (MODE == 1 && nn < 1024) { const int d = nn & 63; nn = (nn & ~63) + ((d < 32) ? 2 * d : 2 * (d - 32) + 1); }
        *(GAS u32x4*)(WT + (size_t)nn * K + k0 + 8 * c) = o; }
    LDS_WAIT();
}

__device__ __forceinline__ int t5_bucket(int n) {
    if (n < 16) return n;
    const float v = logf((float)n / 16.0f) / 2.0794415416798357f * 16.0f;
    int b = 16 + (int)v; return b > 31 ? 31 : b;
}

__device__ __forceinline__ void p0_prologue(const Args& a, lds_u8* lds, int gw, int NGW, int lane, int wave) {
    unsigned char* ws = a.ws;
    const float* x = a.in[0];
    bf16_t* xb = (bf16_t*)(ws + WS_XB); float* r1 = (float*)(ws + WS_R1);
    for (int m = gw; m < MTOK; m += NGW) {
        const GAS f32x4* xr = (const GAS f32x4*)(x + (size_t)m * DM) + lane; f32x4 v[4]; float s = 0.f;
#pragma unroll
        for (int j = 0; j < 4; ++j) { v[j] = xr[64 * j]; s += (v[j].x * v[j].x + v[j].y * v[j].y) + (v[j].z * v[j].z + v[j].w * v[j].w); }
        s = wave_sum(s);
        GAS u32x2* o8 = (GAS u32x2*)(xb + (size_t)m * DM) + lane;
#pragma unroll
        for (int j = 0; j < 4; ++j) { u32x2 o; o.x = pk2(v[j].x, v[j].y); o.y = pk2(v[j].z, v[j].w); o8[64 * j] = o; }
        if (lane == 0) r1[m] = 1.0f / sqrtf(s * (1.0f / DM) + EPSF);
    }
    {
        LAS float* scr = (LAS float*)(lds + wave * 8704);
        constexpr int I_IN = (DM / 64) * (NIN / 32);
        for (int it = gw; it < I_IN; it += NGW) p0_transpose_item<1>(a.in[2], a.in[1], DM, NIN, (bf16_t*)(ws + WS_WIN), scr, it, lane);
    }
    const int gt = gw * 64 + lane, NGT = NGW * 64;
    {
        f32x2* rope = (f32x2*)(ws + WS_ROPE);
        for (int i = gt; i < SEQ * 32; i += NGT) { const int pos = i >> 5, j = i & 31; const float fr = (float)pow(10000.0, -(double)j / 32.0); const float ang = (float)pos * fr;
            rope[i] = (f32x2){(float)cos((double)ang), (float)sin((double)ang)}; }
        float* dec = (float*)(ws + WS_DECAY);
        for (int i = gt; i < 2 * 8 * 128; i += NGT) { const int l = i & 127, h = (i >> 7) & 7, kk = i >> 10; const double lg = log2(1.0 - exp2(-5.0 - (double)h));
            dec[i] = kk ? (float)(0.125 * exp2(-lg * (double)l)) : (float)exp2(lg * (double)l); }
        float* bt = (float*)(ws + WS_BTAB); const float* rb = a.in[9];
        for (int i = gt; i < 4 * 128; i += NGT) { const int n = i & 127, h = i >> 7; bt[i] = rb[t5_bucket(n) * 4 + h] * LOG2E; }
        if (gt == 0) { float s1 = 0.f, s2 = 0.f; for (int i = 0; i < 64; ++i) { s1 += a.in[4][i] * a.in[5][i]; s2 += a.in[6][i] * a.in[7][i]; }
            ((float*)(ws + WS_LAM))[0] = expf(s1) - expf(s2) + 0.2f; }
    }
}


constexpr int DEF_T0 = 192, DEF_T1 = 64, DEF_T2 = 512, DEF_T3 = 512, DEF_ITEMS = DEF_T0 + DEF_T1 + DEF_T2 + DEF_T3;
__device__ __forceinline__ void p0_deferred(const Args& a, lds_u8* lds, int item) {
    unsigned char* ws = a.ws;
    int tid_ = threadIdx.x; asm volatile("" : "+v"(tid_));
    const int tid = tid_, lane = tid & 63; const int wave = __builtin_amdgcn_readfirstlane(tid >> 6);
    if (item < DEF_T0) {
        LAS float* scr = (LAS float*)(lds + wave * 8704);
        constexpr int I_OUT = (DM / 64) * (DM / 32), I_PQ = (DM / 64) * (NQ / 32);
        static_assert(I_OUT + I_PQ == DEF_T0 * 8, "deferred transposes");
        const int r = item * 8 + wave;
        if (r < I_OUT) p0_transpose_item<0>(a.in[10], nullptr, DM, DM, (bf16_t*)(ws + WS_WOUT), scr, r, lane);
        else p0_transpose_item<0>(a.in[12], a.in[11], DM, NQ, (bf16_t*)(ws + WS_WPQ), scr, r - I_OUT, lane);
        return;
    }
    item -= DEF_T0;
    if (item < DEF_T1) {
        const float* pk = a.in[13]; bf16_t* kb = (bf16_t*)(ws + WS_KEYS);
        const int i = item * 512 + tid;
        const GAS f32x4* s = (const GAS f32x4*)(pk + (size_t)i * 8); const f32x4 p = s[0], q = s[1];
        u32x4 o; o.x = pk2(p.x, p.y); o.y = pk2(p.z, p.w); o.z = pk2(q.x, q.y); o.w = pk2(q.z, q.w); *(GAS u32x4*)(kb + (size_t)i * 8) = o;
        return;
    }
    item -= DEF_T1;
    const float* dn = a.in[14]; const float* up = a.in[15]; const float* gf = a.in[11];
    unsigned char* wd = ws + WS_WD; unsigned char* wu = ws + WS_WU;
    if (item < DEF_T2) {
#pragma unroll
        for (int rep = 0; rep < 2; ++rep) {
            const int i = (item * 2 + rep) * 512 + tid;
            const int e = i >> 5, c = i & 31;
            const GAS f32x4* s = (const GAS f32x4*)(up + (size_t)e * DM + c * 32);
            u32x4 o;
#pragma unroll
            for (int k = 0; k < 4; ++k) {
                unsigned w = 0u;
#pragma unroll
                for (int h2 = 0; h2 < 2; ++h2) { const f32x4 p = s[2 * k + h2] * 6.0f;
#pragma unroll
                    for (int j = 0; j < 4; ++j) { const float av = __builtin_fabsf(p[j]);
                        const unsigned code = (unsigned)(av > 0.25f) + (unsigned)(av > 0.75f) + (unsigned)(av > 1.25f) + (unsigned)(av > 1.75f) + (unsigned)(av > 2.5f) + (unsigned)(av > 3.5f) + (unsigned)(av > 5.0f);
                        w |= (code | (p[j] < 0.f ? 8u : 0u)) << (4 * (4 * h2 + j)); } }
                o[k] = w;
            }
            *(GAS u32x4*)(wu + (size_t)e * 512 + c * 16) = o;
        }
        return;
    }
    item -= DEF_T2;
#pragma unroll
    for (int rep = 0; rep < 2; ++rep) {
        const int i = (item * 2 + rep) * 512 + tid;
        const int e = i >> 5, c = i & 31, sl = c >> 3, j0 = (c & 7) * 16;
        const GAS f32x4* s = (const GAS f32x4*)(dn + (size_t)e * DM + c * 32); const GAS f32x4* gq = (const GAS f32x4*)(gf + c * 32);
        u32x4 o;
#pragma unroll
        for (int k = 0; k < 4; ++k) {
            unsigned w = 0u;
#pragma unroll
            for (int h2 = 0; h2 < 2; ++h2) { const f32x4 p = s[2 * k + h2] * gq[2 * k + h2] * 64.0f;
#pragma unroll
                for (int j = 0; j < 4; ++j) { const float av = __builtin_fabsf(p[j]);
                    const unsigned code = (unsigned)(av > 0.25f) + (unsigned)(av > 0.75f) + (unsigned)(av > 1.25f) + (unsigned)(av > 1.75f) + (unsigned)(av > 2.5f) + (unsigned)(av > 3.5f) + (unsigned)(av > 5.0f);
                    w |= (code | (p[j] < 0.f ? 8u : 0u)) << (4 * (4 * h2 + j)); } }
            o[k] = w;
        }
        *(GAS u32x4*)(wd + (size_t)sl * ((size_t)NEXP * 128) + (size_t)e * 128 + j0) = o;
    }
}

__device__ __forceinline__ f32x4 bf4_lo(u32x4 w) { return (f32x4){__uint_as_float(w.x << 16), __uint_as_float(w.x & 0xffff0000u), __uint_as_float(w.y << 16), __uint_as_float(w.y & 0xffff0000u)}; }
__device__ __forceinline__ f32x4 bf4_hi(u32x4 w) { return (f32x4){__uint_as_float(w.z << 16), __uint_as_float(w.z & 0xffff0000u), __uint_as_float(w.w << 16), __uint_as_float(w.w & 0xffff0000u)}; }
struct EpiProj {
    static constexpr bool PERM = true, AFTER_DRAIN = false;
    bf16_t* P; const float* r1; const f32x4* rope; const float* decay;
    __device__ __forceinline__ void operator()(const f32x4 (&acc)[2][2][4][2], const pg8::Unit& u, int wr, int wc, int fr, int fq) const {
        const int row0 = u.pm * 256 + wr * 64 + fr, seg = u.pn >> 1;
        float rsv[2][4];
#pragma unroll
        for (int ai = 0; ai < 2; ++ai)
#pragma unroll
            for (int m = 0; m < 4; ++m) rsv[ai][m] = *(const GAS float*)(r1 + row0 + ai * 128 + m * 16);
        if (seg <= 1) {
#pragma unroll
            for (int ai = 0; ai < 2; ++ai) {
                f32x4 ra[4][2], rb[4][2]; float ff[4][2];
#pragma unroll
                for (int m = 0; m < 4; ++m)
#pragma unroll
                    for (int bj = 0; bj < 2; ++bj) {
                        const int row = row0 + ai * 128 + m * 16, c0 = u.pn * 256 + bj * 128 + wc * 32 + 8 * fq;
                        const int pos = row & (SEQ - 1), l = row & 127, head = (c0 & 511) >> 6, jb = (c0 & 63) >> 1;
                        const GAS f32x4* rp = (const GAS f32x4*)rope + ((size_t)pos * 32 + jb) / 2; ra[m][bj] = rp[0]; rb[m][bj] = rp[1];
                        ff[m][bj] = *(const GAS float*)(decay + (seg * 8 + head) * 128 + l);
                    }
#pragma unroll
                for (int m = 0; m < 4; ++m)
#pragma unroll
                    for (int bj = 0; bj < 2; ++bj) {
                        const int row = row0 + ai * 128 + m * 16, c0 = u.pn * 256 + bj * 128 + wc * 32 + 8 * fq;
                        const f32x4 v0 = acc[ai][bj][m][0] * rsv[ai][m], v1 = acc[ai][bj][m][1] * rsv[ai][m];
                        const f32x4 a_ = ra[m][bj], b_ = rb[m][bj]; const float f = ff[m][bj];
                        f32x4 w0, w1;
                        w0.x = (v0.x * a_.x - v0.y * a_.y) * f; w0.y = (v0.y * a_.x + v0.x * a_.y) * f;
                        w0.z = (v0.z * a_.z - v0.w * a_.w) * f; w0.w = (v0.w * a_.z + v0.z * a_.w) * f;
                        w1.x = (v1.x * b_.x - v1.y * b_.y) * f; w1.y = (v1.y * b_.x + v1.x * b_.y) * f;
                        w1.z = (v1.z * b_.z - v1.w * b_.w) * f; w1.w = (v1.w * b_.z + v1.z * b_.w) * f;
                        u32x4 w; w.x = pk2(w0.x, w0.y); w.y = pk2(w0.z, w0.w); w.z = pk2(w1.x, w1.y); w.w = pk2(w1.z, w1.w);
                        *(GAS u32x4*)(P + (size_t)row * NIN + c0) = w;
                    }
            }
        } else {
#pragma unroll
            for (int ai = 0; ai < 2; ++ai)
#pragma unroll
                for (int m = 0; m < 4; ++m)
#pragma unroll
                    for (int bj = 0; bj < 2; ++bj) {
                        const int row = row0 + ai * 128 + m * 16, c0 = u.pn * 256 + bj * 128 + wc * 32 + 8 * fq;
                        f32x4 v0 = acc[ai][bj][m][0] * rsv[ai][m], v1 = acc[ai][bj][m][1] * rsv[ai][m];
                        if (seg == 3) {
#pragma unroll
                            for (int j = 0; j < 4; ++j) { v0[j] = v0[j] / (1.0f + __expf(-v0[j])); v1[j] = v1[j] / (1.0f + __expf(-v1[j])); }
                        } else if (seg == 4) { v0 = v0 * (0.125f * LOG2E); v1 = v1 * (0.125f * LOG2E); }
                        u32x4 w; w.x = pk2(v0.x, v0.y); w.y = pk2(v0.z, v0.w); w.z = pk2(v1.x, v1.y); w.w = pk2(v1.z, v1.w);
                        *(GAS u32x4*)(P + (size_t)row * NIN + c0) = w;
                    }
        }
    }
};
struct EpiX1 {
    static constexpr bool PERM = true, AFTER_DRAIN = false;
    const bf16_t* XB; bf16_t* X1B; bf16_t* ssq;
    __device__ __forceinline__ void operator()(const f32x4 (&acc)[2][2][4][2], const pg8::Unit& u, int wr, int wc, int fr, int fq) const {
        const int row0 = u.pm * 256 + wr * 64 + fr, c00 = u.pn * 256 + wc * 32 + 8 * fq;
        u32x4 xin[2][4][2];
#pragma unroll
        for (int ai = 0; ai < 2; ++ai)
#pragma unroll
            for (int m = 0; m < 4; ++m)
#pragma unroll
                for (int bj = 0; bj < 2; ++bj) xin[ai][m][bj] = *(const GAS u32x4*)(XB + (size_t)(row0 + ai * 128 + m * 16) * DM + c00 + bj * 128);
#pragma unroll
        for (int ai = 0; ai < 2; ++ai)
#pragma unroll
            for (int m = 0; m < 4; ++m) {
                const int row = row0 + ai * 128 + m * 16; float ss = 0.f;
#pragma unroll
                for (int bj = 0; bj < 2; ++bj) {
                    const f32x4 o0 = acc[ai][bj][m][0] + bf4_lo(xin[ai][m][bj]), o1 = acc[ai][bj][m][1] + bf4_hi(xin[ai][m][bj]);
                    u32x4 w; w.x = pk2(o0.x, o0.y); w.y = pk2(o0.z, o0.w); w.z = pk2(o1.x, o1.y); w.w = pk2(o1.z, o1.w);
                    *(GAS u32x4*)(X1B + (size_t)row * DM + c00 + bj * 128) = w;
                    ss += ((o0.x * o0.x + o0.y * o0.y) + (o0.z * o0.z + o0.w * o0.w)) + ((o1.x * o1.x + o1.y * o1.y) + (o1.z * o1.z + o1.w * o1.w));
                }
                ss += __shfl_xor(ss, 16); ss += __shfl_xor(ss, 32);
                if (fq == 0) *(GAS bf16_t*)(ssq + (size_t)row * 16 + u.pn * 4 + wc) = (bf16_t)(pk2(ss, 0.f) & 0xffffu);
            }
    }
};
__device__ __forceinline__ float rs2_from(u32x4 a, u32x4 b) {
    const f32x4 p = bf4_lo(a) + bf4_hi(a) + bf4_lo(b) + bf4_hi(b);
    return 1.0f / sqrtf(((p.x + p.y) + (p.z + p.w)) * (1.0f / DM) + EPSF);
}
__device__ __forceinline__ float row_rs2(const bf16_t* ssq, int row) {
    const GAS u32x4* p = (const GAS u32x4*)(ssq + (size_t)row * 16); return rs2_from(p[0], p[1]);
}
struct EpiQ {
    static constexpr bool PERM = true, AFTER_DRAIN = false;
    bf16_t* Q; const bf16_t* ssq;
    __device__ __forceinline__ void operator()(const f32x4 (&acc)[2][2][4][2], const pg8::Unit& u, int wr, int wc, int fr, int fq) const {
        const int row0 = u.pm * 256 + wr * 64 + fr;
        u32x4 sa[2][4], sb[2][4];
#pragma unroll
        for (int ai = 0; ai < 2; ++ai)
#pragma unroll
            for (int m = 0; m < 4; ++m) { const GAS u32x4* p = (const GAS u32x4*)(ssq + (size_t)(row0 + ai * 128 + m * 16) * 16); sa[ai][m] = p[0]; sb[ai][m] = p[1]; }
#pragma unroll
        for (int ai = 0; ai < 2; ++ai)
#pragma unroll
            for (int m = 0; m < 4; ++m) {
                const int row = row0 + ai * 128 + m * 16; const float rs = rs2_from(sa[ai][m], sb[ai][m]);
#pragma unroll
                for (int bj = 0; bj < 2; ++bj) {
                    const int c0 = u.pn * 256 + bj * 128 + wc * 32 + 8 * fq;
                    const f32x4 v0 = acc[ai][bj][m][0] * rs, v1 = acc[ai][bj][m][1] * rs;
                    u32x4 w; w.x = pk2(v0.x, v0.y); w.y = pk2(v0.z, v0.w); w.z = pk2(v1.x, v1.y); w.w = pk2(v1.z, v1.w);
                    *(GAS u32x4*)(Q + (size_t)row * NQ + c0) = w;
                }
            }
    }
};

#define MFMA32(a, b, c) __builtin_amdgcn_mfma_f32_32x32x16_bf16(a, b, c, 0, 0, 0)
typedef short v4i16_t __attribute__((ext_vector_type(4)));
__device__ __forceinline__ s16x4 vtr(const lds_u8* p) { return __builtin_bit_cast(s16x4, __builtin_amdgcn_ds_read_tr16_b64_v4i16((LAS v4i16_t*)p)); }
__device__ __forceinline__ bf16x8 vfrag(const lds_u8* p) { const s16x4 lo = vtr(p), hi = vtr(p + 512); return (bf16x8){lo[0], lo[1], lo[2], lo[3], hi[0], hi[1], hi[2], hi[3]}; }
__device__ __forceinline__ bf16x8 ldsb128(const lds_u8* p) { return *(const LAS bf16x8*)p; }
__device__ __forceinline__ int crow(int r, int hi) { return (r & 3) + 8 * (r >> 2) + 4 * hi; }
__device__ __forceinline__ void glds16(const void* g, lds_u8* l) {
    unsigned sv; const unsigned lb = (unsigned)__builtin_amdgcn_readfirstlane((int)(unsigned)(uintptr_t)l);
    asm volatile("s_mov_b32 %0, m0\n\ts_mov_b32 m0, %2\n\ts_nop 0\n\tglobal_load_lds_dwordx4 %1, off\n\ts_mov_b32 m0, %0" : "=&s"(sv) : "v"(g), "s"(lb) : "memory");
}
__device__ __forceinline__ float swap_sum(float v) { auto rr = __builtin_amdgcn_permlane32_swap(__float_as_uint(v), __float_as_uint(v), false, false); return __uint_as_float(rr[0]) + __uint_as_float(rr[1]); }
__device__ __forceinline__ float swap_max(float v) { auto rr = __builtin_amdgcn_permlane32_swap(__float_as_uint(v), __float_as_uint(v), false, false); return __builtin_fmaxf(__uint_as_float(rr[0]), __uint_as_float(rr[1])); }

constexpr int ATT_SLOT = 32768, ATT_XCH = 65536, ATT_XPITCH = 528, ATT_BTAB = ATT_XCH + 128 * ATT_XPITCH;
static_assert(ATT_BTAB + 512 <= LDS_SCRATCH, "attention LDS");

template <int MODE>
__device__ __forceinline__ void attn_unit(const Args& a, lds_u8* lds, int b, int h, int qb) {
    int tid_ = threadIdx.x; asm volatile("" : "+v"(tid_));
    const int tid = tid_, lane = tid & 63, r32 = lane & 31, hi = lane >> 5; const int wid = __builtin_amdgcn_readfirstlane(tid >> 6);
    const int rgp = wid & 3, map = wid >> 2;
    const bf16_t* proj = (const bf16_t*)(a.ws + WS_PROJ);
    const size_t rowbase = (size_t)b * SEQ; const int q0 = qb * 128, NT = 2 * qb + 2;
    const float lam = ((const float*)(a.ws + WS_LAM))[0];
    if (tid < 128) ((LAS float*)(lds + ATT_BTAB))[tid] = ((const float*)(a.ws + WS_BTAB))[h * 128 + tid];
    bf16x8 qf[4];
    { const bf16_t* qp = proj + (rowbase + q0 + rgp * 32 + r32) * NIN + OFF_DQ + h * 128 + map * 64 + hi * 8;
#pragma unroll
      for (int s = 0; s < 4; ++s) qf[s] = *(const GAS bf16x8*)(qp + s * 16); }
    asm volatile("" : "+v"(qf[0]), "+v"(qf[1]), "+v"(qf[2]), "+v"(qf[3]));
    const int krow = 8 * wid + (lane >> 3);
    const bf16_t* k1src = proj + (rowbase + krow) * NIN + OFF_DK + h * 128 + ((lane & 7) ^ ((krow >> 1) & 7)) * 8;
    const bf16_t* k2src = k1src + 64;
    const bf16_t* vsrc0 = proj + (rowbase + 16 * ((2 * wid) & 3) + (lane >> 2)) * NIN + OFF_DV + h * 128 + 32 * ((2 * wid) >> 2) + (lane & 3) * 8;
    const bf16_t* vsrc1 = proj + (rowbase + 16 * ((2 * wid + 1) & 3) + (lane >> 2)) * NIN + OFF_DV + h * 128 + 32 * ((2 * wid + 1) >> 2) + (lane & 3) * 8;
#define ATT_DMA(t, slot) do { const size_t go = (size_t)(t) * 64 * NIN; lds_u8* sb = lds + (slot) * ATT_SLOT; \
        glds16(k1src + go, sb + wid * 1024); glds16(k2src + go, sb + 8192 + wid * 1024); \
        glds16(vsrc0 + go, sb + 16384 + (2 * wid) * 1024); glds16(vsrc1 + go, sb + 16384 + (2 * wid + 1) * 1024); } while (0)
    const int koff = map * 8192 + r32 * 128, ksw = (r32 >> 1) & 7;
    const int voff = 16384 + ((lane >> 4) & 1) * 32 + (lane & 3) * 8 + (4 * hi + ((lane & 15) >> 2)) * 64;
    f32x16 o[4];
#pragma unroll
    for (int d = 0; d < 4; ++d) o[d] = f32x16{};
    float mrun = -INFINITY, lrun = 0.f;
    const int qpos = q0 + rgp * 32 + r32;
    float b31 = ((const float*)(a.ws + WS_BTAB))[h * 128 + 127]; asm volatile("" : "+v"(b31));
    ATT_DMA(0, 0);
    for (int t = 0; t < NT; ++t) {
        VM_WAIT(); __syncthreads();
        if (t + 1 < NT && (!(MODE & 8) || t + 1 < 2)) ATT_DMA(t + 1, (t + 1) & 1);
        if (64 * t > q0 + rgp * 32 + 31) continue;
        const lds_u8* sb = lds + (t & 1) * ATT_SLOT;
        const bool nearT = (64 * t + 176 > q0);
        const float cb = nearT ? 0.f : b31;
        f32x16 sA, sB;
        { const float c0 = (t == 0) ? 0.f : cb - mrun;
#pragma unroll
          for (int r = 0; r < 16; ++r) { sA[r] = c0; sB[r] = c0; } }
        if (MODE & 1) {
            bf16x8 kf[8];
#pragma unroll
            for (int d0 = 0; d0 < 4; ++d0) { const int kc = koff + (((2 * d0 + hi) ^ ksw) << 4); if (MODE & 16) { kf[2 * d0] = qf[d0]; kf[2 * d0 + 1] = qf[3 - d0]; } else { kf[2 * d0] = ldsb128(sb + kc); kf[2 * d0 + 1] = ldsb128(sb + kc + 4096); } }
            __builtin_amdgcn_sched_group_barrier(0x100, 8, 0);
#pragma unroll
            for (int d0 = 0; d0 < 4; ++d0) { sA = MFMA32(kf[2 * d0], qf[d0], sA); sB = MFMA32(kf[2 * d0 + 1], qf[d0], sB); }
            __builtin_amdgcn_sched_group_barrier(0x8, 8, 0);
        }
        if (MODE & 4) {
        if (nearT) {
            const LAS float* bt = (const LAS float*)(lds + ATT_BTAB);
#pragma unroll
            for (int r = 0; r < 16; ++r) {
                const int kp = 64 * t + crow(r, hi); int d0 = qpos - kp, d1 = d0 - 32;
                const float b0 = bt[d0 < 0 ? 0 : (d0 > 127 ? 127 : d0)], b1 = bt[d1 < 0 ? 0 : (d1 > 127 ? 127 : d1)];
                sA[r] = d0 < 0 ? -INFINITY : sA[r] + b0; sB[r] = d1 < 0 ? -INFINITY : sB[r] + b1;
            }
        }
#define MX3(a_, b_, c_) __builtin_fmaxf(__builtin_fmaxf((a_), (b_)), (c_))
        float mxa = MX3(sA[0], sA[1], sB[0]), mxb = MX3(sA[2], sA[3], sB[1]); mxa = MX3(mxa, sB[2], sB[3]);
#pragma unroll
        for (int r = 4; r < 16; r += 4) { mxa = MX3(mxa, sA[r], sA[r + 1]); mxb = MX3(mxb, sA[r + 2], sA[r + 3]); mxa = MX3(mxa, sB[r], sB[r + 1]); mxb = MX3(mxb, sB[r + 2], sB[r + 3]); }
#undef MX3
        const float mx = swap_max(__builtin_fmaxf(mxa, mxb));
        if (t == 0 || __any(mx > 6.0f)) {
            const float up = (t == 0) ? mx : __builtin_fmaxf(mx, 0.f), alpha = (t == 0) ? 0.f : __builtin_amdgcn_exp2f(-up);
            mrun = (t == 0) ? mx + cb : mrun + up; lrun *= alpha;
#pragma unroll
            for (int d = 0; d < 4; ++d)
#pragma unroll
                for (int r = 0; r < 16; ++r) o[d][r] *= alpha;
            const float sh = (t == 0) ? mx : up;
#pragma unroll
            for (int r = 0; r < 16; ++r) { sA[r] -= sh; sB[r] -= sh; }
        }
        float ps = 0.f;
#pragma unroll
        for (int r = 0; r < 16; ++r) { sA[r] = __builtin_amdgcn_exp2f(sA[r]); sB[r] = __builtin_amdgcn_exp2f(sB[r]); ps += sA[r] + sB[r]; }
        lrun += ps;
        } else { asm volatile("" : "+v"(sA), "+v"(sB)); }
        u32x4 pw[4];
        pw[0] = (u32x4){pk2(sA[0], sA[1]), pk2(sA[2], sA[3]), pk2(sA[4], sA[5]), pk2(sA[6], sA[7])};
        pw[1] = (u32x4){pk2(sA[8], sA[9]), pk2(sA[10], sA[11]), pk2(sA[12], sA[13]), pk2(sA[14], sA[15])};
        pw[2] = (u32x4){pk2(sB[0], sB[1]), pk2(sB[2], sB[3]), pk2(sB[4], sB[5]), pk2(sB[6], sB[7])};
        pw[3] = (u32x4){pk2(sB[8], sB[9]), pk2(sB[10], sB[11]), pk2(sB[12], sB[13]), pk2(sB[14], sB[15])};
        if (!(MODE & 2)) { asm volatile("" :: "v"(pw[0]), "v"(pw[1]), "v"(pw[2]), "v"(pw[3])); continue; }
        {
            bf16x8 vfa[4], vfb[4];
#pragma unroll
            for (int d = 0; d < 4; ++d) vfa[d] = (MODE & 16) ? qf[d] : vfrag(sb + voff + d * 4096);
            __builtin_amdgcn_sched_group_barrier(0x100, 8, 0);
#pragma unroll
            for (int ks = 0; ks < 4; ks += 2) {
#pragma unroll
                for (int d = 0; d < 4; ++d) vfb[d] = (MODE & 16) ? qf[3 - d] : vfrag(sb + voff + d * 4096 + (ks + 1) * 1024);
                __builtin_amdgcn_sched_group_barrier(0x100, 8, 0);
                { const bf16x8 pb = __builtin_bit_cast(bf16x8, pw[ks]);
#pragma unroll
                  for (int d = 0; d < 4; ++d) o[d] = MFMA32(vfa[d], pb, o[d]); }
                __builtin_amdgcn_sched_group_barrier(0x8, 4, 0);
                if (ks + 2 < 4) {
#pragma unroll
                    for (int d = 0; d < 4; ++d) vfa[d] = (MODE & 16) ? qf[d] : vfrag(sb + voff + d * 4096 + (ks + 2) * 1024);
                    __builtin_amdgcn_sched_group_barrier(0x100, 8, 0);
                }
                { const bf16x8 pb = __builtin_bit_cast(bf16x8, pw[ks + 1]);
#pragma unroll
                  for (int d = 0; d < 4; ++d) o[d] = MFMA32(vfb[d], pb, o[d]); }
                __builtin_amdgcn_sched_group_barrier(0x8, 4, 0);
            }
        }
    }
    const float inv = 1.0f / swap_sum(lrun);
    LAS float* xch = (LAS float*)(lds + ATT_XCH + (rgp * 32 + r32) * ATT_XPITCH);
    if (map == 1) {
        const float sc = inv * lam;
#pragma unroll
        for (int d = 0; d < 4; ++d)
#pragma unroll
            for (int g = 0; g < 4; ++g) *(LAS f32x4*)(xch + 32 * d + 8 * g + 4 * hi) = (f32x4){o[d][4 * g] * sc, o[d][4 * g + 1] * sc, o[d][4 * g + 2] * sc, o[d][4 * g + 3] * sc};
    }
    __syncthreads();
    if (map == 0) {
        float ss = 0.f;
#pragma unroll
        for (int d = 0; d < 4; ++d)
#pragma unroll
            for (int g = 0; g < 4; ++g) { const f32x4 o2 = *(const LAS f32x4*)(xch + 32 * d + 8 * g + 4 * hi);
#pragma unroll
                for (int j = 0; j < 4; ++j) { const float v = o[d][4 * g + j] * inv - o2[j]; o[d][4 * g + j] = v; ss += v * v; } }
        ss = swap_sum(ss);
        const float rn = 0.8f / sqrtf(ss * (1.0f / 128.0f) + EPSF);
        const float* sub = a.in[8];
        bf16_t* mixp = (bf16_t*)(a.ws + WS_MIX) + (rowbase + qpos) * DM + 512 + h * 128;
#pragma unroll
        for (int d = 0; d < 4; ++d)
#pragma unroll
            for (int g = 0; g < 4; ++g) { const int dd = 32 * d + 8 * g + 4 * hi; const f32x4 sv = *(const GAS f32x4*)(sub + dd);
                u32x2 w; w.x = pk2(o[d][4 * g] * rn * sv.x, o[d][4 * g + 1] * rn * sv.y); w.y = pk2(o[d][4 * g + 2] * rn * sv.z, o[d][4 * g + 3] * rn * sv.w);
                *(GAS u32x2*)(mixp + dd) = w; }
    }
    __syncthreads();
#undef ATT_DMA
}

constexpr int RET_BUF = 49152, RET_RT = 2 * RET_BUF, RET_GN = RET_RT + 8192;
static_assert(RET_GN + 2048 <= LDS_SCRATCH, "retention LDS");

__device__ __forceinline__ void ret_unit(const Args& a, lds_u8* lds, int b, int h) {
    int tid_ = threadIdx.x; asm volatile("" : "+v"(tid_));
    const int tid = tid_, lane = tid & 63, r32 = lane & 31, hi = lane >> 5; const int wid = __builtin_amdgcn_readfirstlane(tid >> 6);
    const int rgp = wid & 3, eh = wid >> 2;
    const bf16_t* proj = (const bf16_t*)(a.ws + WS_PROJ);
    const size_t rowbase = (size_t)b * SEQ;
    const double lg = log2(1.0 - exp2(-5.0 - (double)h));
    const float gam = (float)exp2(lg), g127 = (float)exp2(lg * 127.0), g128 = (float)exp2(lg * 128.0);
#define RET_DMA(c, buf) do { const size_t ro = (rowbase + (size_t)(c) * 128) * NIN; lds_u8* bb = lds + (buf) * RET_BUF; \
        _Pragma("unroll") for (int i_ = 0; i_ < 2; ++i_) { const int p_ = 2 * wid + i_; \
            { const int ch = p_ >> 1, rh = p_ & 1; glds16(proj + ro + (size_t)(rh * 64 + lane) * NIN + OFF_RK + h * 64 + ch * 8, bb + ch * 2048 + rh * 1024); } \
            { const int db = p_ >> 3, rg_ = p_ & 7; glds16(proj + ro + (size_t)(rg_ * 16 + (lane >> 2)) * NIN + OFF_RK + h * 64 + db * 32 + (lane & 3) * 8, bb + 16384 + db * 8192 + rg_ * 1024); \
              glds16(proj + ro + (size_t)(rg_ * 16 + (lane >> 2)) * NIN + OFF_RV + h * 64 + db * 32 + (lane & 3) * 8, bb + 32768 + db * 8192 + rg_ * 1024); } } } while (0)
    const int koff = hi * 2048 + r32 * 16;
    const int troff = ((lane >> 4) & 1) * 32 + (lane & 3) * 8 + (4 * hi + ((lane & 15) >> 2)) * 64;
    f32x16 R = f32x16{};
    for (int i = tid; i < 8192 / 16; i += NTHR) *(LAS u32x4*)(lds + RET_RT + i * 16) = (u32x4){0u, 0u, 0u, 0u};
    const float* gn = a.in[3];
    RET_DMA(0, 0);
    for (int c = 0; c < 32; ++c) {
        VM_WAIT(); __syncthreads();
        if (c + 1 < 32) RET_DMA(c + 1, (c + 1) & 1);
        const lds_u8* bb = lds + (c & 1) * RET_BUF;
        const size_t tok = rowbase + (size_t)c * 128 + rgp * 32 + r32;
        bf16x8 qf[4];
        { const bf16_t* qp = proj + tok * NIN + OFF_RQ + h * 64 + hi * 8;
#pragma unroll
          for (int s = 0; s < 4; ++s) qf[s] = *(const GAS bf16x8*)(qp + s * 16); }
        f32x16 O = f32x16{};
#pragma unroll
        for (int s = 0; s < 4; ++s) { const bf16x8 rt = ldsb128(lds + RET_RT + (2 * s + hi) * 1024 + (eh * 32 + r32) * 16); O = MFMA32(rt, qf[s], O); }
        for (int kb = 0; kb <= rgp; ++kb) {
            f32x16 S = f32x16{};
#pragma unroll
            for (int s = 0; s < 4; ++s) { const bf16x8 ka = ldsb128(bb + koff + s * 4096 + (kb * 32) * 16); S = MFMA32(ka, qf[s], S); }
            if (kb == rgp) {
#pragma unroll
                for (int r = 0; r < 16; ++r) S[r] = (crow(r, hi) > r32) ? 0.f : S[r];
            }
            const u32x4 p0 = (u32x4){pk2(S[0], S[1]), pk2(S[2], S[3]), pk2(S[4], S[5]), pk2(S[6], S[7])};
            const u32x4 p1 = (u32x4){pk2(S[8], S[9]), pk2(S[10], S[11]), pk2(S[12], S[13]), pk2(S[14], S[15])};
            const bf16x8 v0 = vfrag(bb + 32768 + eh * 8192 + troff + (2 * kb) * 1024), v1 = vfrag(bb + 32768 + eh * 8192 + troff + (2 * kb + 1) * 1024);
            O = MFMA32(v0, __builtin_bit_cast(bf16x8, p0), O); O = MFMA32(v1, __builtin_bit_cast(bf16x8, p1), O);
        }
        if (rgp < 2) {
            f32x16 T = f32x16{};
#pragma unroll
            for (int ks = 0; ks < 8; ++ks) { const bf16x8 kt = vfrag(bb + 16384 + rgp * 8192 + troff + ks * 1024), vv = vfrag(bb + 32768 + eh * 8192 + troff + ks * 1024); T = MFMA32(kt, vv, T); }
#pragma unroll
            for (int r = 0; r < 16; ++r) R[r] = R[r] * g128 + T[r] * g127;
        }
        float s1 = 0.f, s2 = 0.f;
#pragma unroll
        for (int r = 0; r < 16; ++r) { s1 += O[r]; s2 += O[r] * O[r]; }
        s1 = swap_sum(s1); s2 = swap_sum(s2);
        LAS f32x2* gx = (LAS f32x2*)(lds + RET_GN);
        if (hi == 0) gx[(rgp * 32 + r32) * 2 + eh] = (f32x2){s1, s2};
        __syncthreads();
        if (rgp < 2) {
#pragma unroll
            for (int g = 0; g < 4; ++g) { u32x2 w; w.x = pk2(R[4 * g] * gam, R[4 * g + 1] * gam); w.y = pk2(R[4 * g + 2] * gam, R[4 * g + 3] * gam);
                *(LAS u32x2*)(lds + RET_RT + (rgp * 4 + g) * 1024 + (eh * 32 + r32) * 16 + hi * 8) = w; }
        }
        const f32x2 ga = gx[(rgp * 32 + r32) * 2], gb = gx[(rgp * 32 + r32) * 2 + 1];
        const float mean = (ga.x + gb.x) * (1.0f / 64.0f), var = (ga.y + gb.y) * (1.0f / 64.0f) - mean * mean;
        const float rstd = 1.0f / sqrtf(__builtin_fmaxf(var, 0.f) + EPSF);
        const bf16_t* sg = proj + tok * NIN + OFF_RG + h * 64 + eh * 32;
        bf16_t* mixp = (bf16_t*)(a.ws + WS_MIX) + tok * DM + h * 64 + eh * 32;
#pragma unroll
        for (int g = 0; g < 4; ++g) { const int e = 8 * g + 4 * hi; const u32x2 sv = *(const GAS u32x2*)(sg + e); const f32x4 gv = *(const GAS f32x4*)(gn + h * 64 + eh * 32 + e);
            const float y0 = (O[4 * g] - mean) * rstd * gv.x * __uint_as_float(sv.x << 16), y1 = (O[4 * g + 1] - mean) * rstd * gv.y * __uint_as_float(sv.x & 0xffff0000u);
            const float y2 = (O[4 * g + 2] - mean) * rstd * gv.z * __uint_as_float(sv.y << 16), y3 = (O[4 * g + 3] - mean) * rstd * gv.w * __uint_as_float(sv.y & 0xffff0000u);
            u32x2 w; w.x = pk2(y0, y1); w.y = pk2(y2, y3); *(GAS u32x2*)(mixp + e) = w; }
    }
    __syncthreads();
#undef RET_DMA
}


#define CAS_DESC(x, y) do { const float hi_ = __builtin_fmaxf(x, y), lo_ = __builtin_fminf(x, y); x = hi_; y = lo_; } while (0)
#define CAS_ASC(x, y) do { const float hi_ = __builtin_fmaxf(x, y), lo_ = __builtin_fminf(x, y); x = lo_; y = hi_; } while (0)
__device__ __forceinline__ void sort16_desc(float (&v)[16]) {
#pragma unroll
    for (int k = 2; k <= 16; k <<= 1)
#pragma unroll
        for (int j = k >> 1; j > 0; j >>= 1)
#pragma unroll
            for (int i = 0; i < 16; ++i) { const int l = i ^ j; if (l > i) { if ((i & k) == 0) CAS_DESC(v[i], v[l]); else CAS_ASC(v[i], v[l]); } }
}
__device__ __forceinline__ void bitonic_merge16_desc(float (&v)[16]) {
#pragma unroll
    for (int j = 8; j > 0; j >>= 1)
#pragma unroll
        for (int i = 0; i < 16; ++i) { const int l = i ^ j; if (l > i) CAS_DESC(v[i], v[l]); }
}
__device__ __forceinline__ void merge_top16(float (&a)[16], const float (&b)[16]) {
#pragma unroll
    for (int i = 0; i < 16; ++i) a[i] = __builtin_fmaxf(a[i], b[15 - i]);
    bitonic_merge16_desc(a);
}
__device__ __forceinline__ unsigned pack_idx4(const float (&v)[16], int w) {
    return (__float_as_uint(v[4 * w]) & 127u) | ((__float_as_uint(v[4 * w + 1]) & 127u) << 8) | ((__float_as_uint(v[4 * w + 2]) & 127u) << 16) | ((__float_as_uint(v[4 * w + 3]) & 127u) << 24);
}
__device__ __forceinline__ unsigned lookup_idx(const unsigned (&pk)[4], unsigned i) {
    const unsigned w = i >> 2; unsigned s = w == 0 ? pk[0] : (w == 1 ? pk[1] : (w == 2 ? pk[2] : pk[3]));
    return (s >> ((i & 3u) * 8u)) & 127u;
}

constexpr int P5_KEYB = 32768;
__device__ __forceinline__ void p5_topk(const Args& a, lds_u8* lds) {
    const int tid = threadIdx.x, lane = tid & 63, r32 = lane & 31, hi = lane >> 5; const int wid = __builtin_amdgcn_readfirstlane(tid >> 6);
    const int hp = blockIdx.x & 3, wgi = blockIdx.x >> 2, nwg = (gridDim.x + 3 - hp) / 4;
    const bf16_t* keys = (const bf16_t*)(a.ws + WS_KEYS) + (size_t)hp * 4 * 128 * 128;
    for (int i = tid; i < 4 * 128 * 16; i += NTHR) { const int t = i >> 11, key = (i >> 4) & 127, c = i & 15;
        *(LAS u32x4*)(lds + t * P5_KEYB + c * 2048 + key * 16) = *(const GAS u32x4*)(keys + ((size_t)t * 128 + key) * 128 + c * 8); }
    __syncthreads();
    const bf16_t* Q = (const bf16_t*)(a.ws + WS_PROJ);
    int* IDX = (int*)(a.ws + WS_IDX); float* GATE = (float*)(a.ws + WS_GATE);
    const int tg0 = wgi * NWAVES + wid, tgs = nwg * NWAVES;
    const int ntask = (tg0 < MTOK / 32) ? 4 * ((MTOK / 32 - 1 - tg0) / tgs + 1) : 0;
#define P5_QLOAD(QF, k_) do { const int tg_ = tg0 + ((k_) >> 2) * tgs, t_ = (k_) & 3; \
        const bf16_t* qp = Q + (size_t)(tg_ * 32 + r32) * NQ + (2 * hp + (t_ >> 1)) * 256 + (t_ & 1) * 128 + hi * 8; \
        _Pragma("unroll") for (int s = 0; s < 8; ++s) QF[s] = *(const GAS bf16x8*)(qp + s * 16); } while (0)
    float la[16], lb[16];
#pragma unroll
    for (int r = 0; r < 16; ++r) { la[r] = 0.f; lb[r] = 0.f; }
    bf16x8 qf[8], qn[8];
    if (ntask > 0) P5_QLOAD(qf, 0);
#pragma unroll 1
    for (int k = 0; k < ntask; ++k) {
      {
        const int tg = tg0 + (k >> 2) * tgs, t = k & 3;
        if (k + 1 < ntask) P5_QLOAD(qn, k + 1);
        {
            float top[16];
#pragma unroll
            for (int kb = 0; kb < 4; ++kb) {
                f32x16 S = f32x16{};
#pragma unroll
                for (int s = 0; s < 8; ++s) { const bf16x8 kf = ldsb128(lds + t * P5_KEYB + (2 * s + hi) * 2048 + (kb * 32 + r32) * 16); S = MFMA32(kf, qf[s], S); }
                float v[16];
#pragma unroll
                for (int r = 0; r < 16; ++r) v[r] = __uint_as_float((__float_as_uint(S[r]) & ~127u) | (unsigned)(kb * 32 + (r & 3) + 8 * (r >> 2)) | ((unsigned)hi << 2));
                sort16_desc(v);
                if (kb == 0) {
#pragma unroll
                    for (int r = 0; r < 16; ++r) top[r] = v[r];
                } else merge_top16(top, v);
            }
            float oth[16];
#pragma unroll
            for (int r = 0; r < 16; ++r) { auto rr = __builtin_amdgcn_permlane32_swap(__float_as_uint(top[r]), __float_as_uint(top[r]), false, false); top[r] = __uint_as_float(rr[0]); oth[r] = __uint_as_float(rr[1]); }
            merge_top16(top, oth);
            const bool ka = ((t >> 1) == hi) && ((t & 1) == 0), kb2 = ((t >> 1) == hi) && ((t & 1) == 1);
#pragma unroll
            for (int r = 0; r < 16; ++r) { la[r] = ka ? top[r] : la[r]; lb[r] = kb2 ? top[r] : lb[r]; }
        }
#pragma unroll
        for (int s2 = 0; s2 < 8; ++s2) qf[s2] = qn[s2];
        if (t != 3) continue;
        unsigned pa[4], pb[4];
#pragma unroll
        for (int w = 0; w < 4; ++w) { pa[w] = pack_idx4(la, w); pb[w] = pack_idx4(lb, w); }
        float c0[16], c1[16];
#define CAND(i, j) __uint_as_float((__float_as_uint(la[i] + lb[j]) & ~255u) | (unsigned)((i) * 16 + (j)))
        const float NEG = -INFINITY;
        c0[0] = CAND(0, 0); c0[1] = CAND(0, 1); c0[2] = CAND(0, 2); c0[3] = CAND(0, 3); c0[4] = CAND(0, 4); c0[5] = CAND(0, 5); c0[6] = CAND(0, 6); c0[7] = CAND(0, 7);
        c0[8] = CAND(0, 8); c0[9] = CAND(0, 9); c0[10] = CAND(0, 10); c0[11] = CAND(0, 11); c0[12] = CAND(0, 12); c0[13] = CAND(0, 13); c0[14] = CAND(0, 14); c0[15] = CAND(0, 15);
        sort16_desc(c0);
        c1[0] = CAND(1, 0); c1[1] = CAND(1, 1); c1[2] = CAND(1, 2); c1[3] = CAND(1, 3); c1[4] = CAND(1, 4); c1[5] = CAND(1, 5); c1[6] = CAND(1, 6); c1[7] = CAND(1, 7);
        c1[8] = CAND(2, 0); c1[9] = CAND(2, 1); c1[10] = CAND(2, 2); c1[11] = CAND(2, 3); c1[12] = CAND(2, 4); c1[13] = CAND(3, 0); c1[14] = CAND(3, 1); c1[15] = CAND(3, 2);
        sort16_desc(c1); merge_top16(c0, c1);
        asm volatile("" : "+v"(c0[0]), "+v"(c0[15]));
        c1[0] = CAND(3, 3); c1[1] = CAND(4, 0); c1[2] = CAND(4, 1); c1[3] = CAND(4, 2); c1[4] = CAND(5, 0); c1[5] = CAND(5, 1); c1[6] = CAND(6, 0); c1[7] = CAND(6, 1);
        c1[8] = CAND(7, 0); c1[9] = CAND(7, 1); c1[10] = CAND(8, 0); c1[11] = CAND(9, 0); c1[12] = CAND(10, 0); c1[13] = CAND(11, 0); c1[14] = CAND(12, 0); c1[15] = CAND(13, 0);
        sort16_desc(c1); merge_top16(c0, c1);
        asm volatile("" : "+v"(c0[0]), "+v"(c0[15]));
        c1[0] = CAND(14, 0); c1[1] = CAND(15, 0);
#pragma unroll
        for (int r = 2; r < 16; ++r) c1[r] = NEG;
#undef CAND
        sort16_desc(c1); merge_top16(c0, c1);
        float gsum = 0.f, gv[16]; int ex[16];
        const float mx = __uint_as_float(__float_as_uint(c0[0]) & ~255u);
#pragma unroll
        for (int r = 0; r < 16; ++r) { const unsigned bits = __float_as_uint(c0[r]); const float val = __uint_as_float(bits & ~255u);
            gv[r] = __expf(val - mx); gsum += gv[r];
            ex[r] = (int)(lookup_idx(pa, (bits >> 4) & 15u) * 128u + lookup_idx(pb, bits & 15u)); }
        const float ginv = 1.0f / gsum;
        const size_t ob = (size_t)(tg * 32 + r32) * 128 + (2 * hp + hi) * 16;
#pragma unroll
        for (int r = 0; r < 16; r += 4) { *(GAS u32x4*)(IDX + ob + r) = (u32x4){(unsigned)ex[r], (unsigned)ex[r + 1], (unsigned)ex[r + 2], (unsigned)ex[r + 3]};
            *(GAS f32x4*)(GATE + ob + r) = (f32x4){gv[r] * ginv, gv[r + 1] * ginv, gv[r + 2] * ginv, gv[r + 3] * ginv}; }
      }
    }
#undef P5_QLOAD
    __syncthreads();
}

typedef long i64_t;
typedef int v8i_t __attribute__((ext_vector_type(8)));
#define MFMA16F8(a, b, c) __builtin_amdgcn_mfma_f32_16x16x32_fp8_fp8(a, b, c, 0, 0, 0)
constexpr float P6_SD = 64.f, P6_SX = 8.f, P6_SU = 16.f, P6_SA = 64.f, P6_SU4 = 6.f;
constexpr size_t P6_SLICEB = (size_t)NEXP * 128;
__device__ __forceinline__ unsigned pk4_fp8(float a, float b, float c, float d) { int w = __builtin_amdgcn_cvt_pk_fp8_f32(a, b, 0, false); w = __builtin_amdgcn_cvt_pk_fp8_f32(c, d, w, true); return (unsigned)w; }
__device__ __forceinline__ float fp8_byte0(unsigned w) { return __builtin_amdgcn_cvt_f32_fp8((int)w, 0); }
constexpr int P6_WSCR = 3328;
__device__ __forceinline__ void p6_token(const Args& a, lds_u8* wl, int tok, int lane, float* OUTW) {
    const int n = lane & 15, g = lane >> 4;
    const unsigned char* ws = a.ws;
    const unsigned char* WD = ws + WS_WD; const unsigned char* WU = ws + WS_WU;
    const int* IDX = (const int*)(ws + WS_IDX) + (size_t)tok * 128; const float* GATE = (const float*)(ws + WS_GATE) + (size_t)tok * 128;
    const bf16_t* X1 = (const bf16_t*)(ws + WS_X1B) + (size_t)tok * DM;
    {
#pragma unroll
        for (int j = 0; j < 4; ++j) {
            const u32x2 xw_ = *(const GAS u32x2*)(X1 + 256 * j + 4 * lane); const f32x4 v = (f32x4){__uint_as_float(xw_.x << 16), __uint_as_float(xw_.x & 0xffff0000u), __uint_as_float(xw_.y << 16), __uint_as_float(xw_.y & 0xffff0000u)} * P6_SX;
            const unsigned hw = pk4_fp8(v.x, v.y, v.z, v.w);
            const float r0 = v.x - __builtin_amdgcn_cvt_f32_fp8((int)hw, 0), r1 = v.y - __builtin_amdgcn_cvt_f32_fp8((int)hw, 1), r2 = v.z - __builtin_amdgcn_cvt_f32_fp8((int)hw, 2), r3 = v.w - __builtin_amdgcn_cvt_f32_fp8((int)hw, 3);
            const unsigned lw = pk4_fp8(r0 * 16.f, r1 * 16.f, r2 * 16.f, r3 * 16.f);
            *(LAS unsigned*)(wl + 256 * j + 4 * lane) = hw; *(LAS unsigned*)(wl + 1024 + 256 * j + 4 * lane) = lw;
        }
        const u32x2 iv = *(const GAS u32x2*)(IDX + lane * 2); *(LAS u32x2*)(wl + 2048 + lane * 8) = iv;
    }
    const float rs2 = row_rs2((const bf16_t*)(ws + WS_SSQ), tok);
    LDS_WAIT();
    const LAS int* idxl = (const LAS int*)(wl + 2048); LAS unsigned short* actl = (LAS unsigned short*)(wl + 2560);
    const int xoff = (n & 1) * 1024 + 16 * g;
#pragma unroll 1
    for (int eg = 0; eg < 8; ++eg) {
        const int e = idxl[eg * 16 + n];
        const unsigned char* rp = WD + (size_t)e * 128 + 16 * g;
        f32x4 acc = (f32x4){0.f, 0.f, 0.f, 0.f};
        u32x4 bq[16];
#pragma unroll
        for (int sl = 0; sl < 8; ++sl) { bq[2 * sl] = *(const GAS u32x4*)(rp + sl * P6_SLICEB); bq[2 * sl + 1] = *(const GAS u32x4*)(rp + sl * P6_SLICEB + 64); }
#pragma unroll
        for (int sl = 0; sl < 8; ++sl)
#pragma unroll
            for (int hf = 0; hf < 2; ++hf) {
                const u32x4 xa = *(const LAS u32x4*)(wl + xoff + sl * 128 + hf * 64); const u32x4 bb = bq[2 * sl + hf];
                acc = MFMA16F8((i64_t)(((unsigned long long)xa.y << 32) | xa.x), (i64_t)(((unsigned long long)bb.y << 32) | bb.x), acc);
                acc = MFMA16F8((i64_t)(((unsigned long long)xa.w << 32) | xa.z), (i64_t)(((unsigned long long)bb.w << 32) | bb.z), acc);
            }
        const float av = (acc[0] + acc[1] * 0.0625f) * (rs2 * (1.0f / (P6_SD * P6_SX)));
        const float act = 0.5f * av * (1.0f + erff(av * 0.70710678118654752f)) * GATE[eg * 16 + n] * P6_SA;
        const unsigned hb = pk4_fp8(act, 0.f, 0.f, 0.f) & 0xffu;
        const unsigned lb = pk4_fp8((act - fp8_byte0(hb)) * 16.f, 0.f, 0.f, 0.f) & 0xffu;
        if (g == 0) actl[eg * 16 + n] = (unsigned short)(hb | (lb << 8));
    }
    LDS_WAIT();
    const int pos = n & 7, sel = n >> 3;
    float ss = 0.f;
    const bool owner = (n < 8) && (g < 2);
#pragma unroll 1
    for (int sl = 0; sl < 8; ++sl) {
        f32x4 ah[2], al[2];
#pragma unroll
        for (int s = 0; s < 2; ++s) { ah[s] = (f32x4){0.f, 0.f, 0.f, 0.f}; al[s] = (f32x4){0.f, 0.f, 0.f, 0.f}; }
        u32x4 bq[16]; unsigned av[16];
#pragma unroll
        for (int q = 0; q < 16; ++q) { const int ei = 8 * q + 4 * sel + g; const int e = idxl[ei]; av[q] = actl[ei];
            bq[q] = *(const GAS u32x4*)(WU + sl * P6_SLICEB + (size_t)e * 128 + 16 * pos); }
#pragma unroll
        for (int q = 0; q < 16; ++q) {
            const unsigned long long ahv = (unsigned long long)(av[q] & 0xffu) << (8 * pos), alv = (unsigned long long)(av[q] >> 8) << (8 * pos);
            const u32x4 bb = bq[q];
            const i64_t b0 = (i64_t)(((unsigned long long)bb.y << 32) | bb.x), b1 = (i64_t)(((unsigned long long)bb.w << 32) | bb.z);
            ah[0] = MFMA16F8((i64_t)ahv, b0, ah[0]); al[0] = MFMA16F8((i64_t)alv, b0, al[0]);
            ah[1] = MFMA16F8((i64_t)ahv, b1, ah[1]); al[1] = MFMA16F8((i64_t)alv, b1, al[1]);
        }
#pragma unroll
        for (int s = 0; s < 2; ++s) {
            f32x4 t = ah[s] + al[s] * 0.0625f, u;
#pragma unroll
            for (int r = 0; r < 4; ++r) u[r] = __shfl(t[r], (lane + 40) & 63);
            const int col = 128 * sl + 16 * pos + 8 * s + 4 * (g & 1);
            const u32x2 xq_ = *(const GAS u32x2*)(X1 + col); const f32x4 xv = (f32x4){__uint_as_float(xq_.x << 16), __uint_as_float(xq_.x & 0xffff0000u), __uint_as_float(xq_.y << 16), __uint_as_float(xq_.y & 0xffff0000u)};
            const f32x4 x2 = xv + (t + u) * (1.0f / (P6_SA * P6_SU));
            if (owner) { ss += (x2.x * x2.x + x2.y * x2.y) + (x2.z * x2.z + x2.w * x2.w); *(GAS f32x4*)(OUTW + (size_t)tok * DM + col) = x2; }
        }
    }
    ss = wave_sum(ss);
    const float rn = 1.0f / sqrtf(ss * (1.0f / DM) + EPSF);
    const float* nf = a.in[16];
    if (owner) {
#pragma unroll
        for (int sl = 0; sl < 8; ++sl)
#pragma unroll
            for (int s = 0; s < 2; ++s) { const int col = 128 * sl + 16 * pos + 8 * s + 4 * g; const f32x4 gv = *(const GAS f32x4*)(nf + col);
                GAS f32x4* op = (GAS f32x4*)(OUTW + (size_t)tok * DM + col); *op = *op * rn * gv; }
    }
}

constexpr int P6S_WAVE = 16384 + 512 + 128;
static_assert(NWAVES * P6S_WAVE <= LDS_SCRATCH, "P6 LDS");
__device__ __forceinline__ float gelu_as(float v) {
    const float av = __builtin_fabsf(v), t = __builtin_amdgcn_rcpf(av * 0.2316418882f + 1.0f);
    float q = t * 0.5307027145f + (-0.7265760135f); q = q * t + 0.7107068705f; q = q * t + (-0.142248368f); q = q * t + 0.127414796f; q = q * t;
    const float e = __builtin_amdgcn_exp2f((v * v) * (-0.72134752044f));
    const float m = v * (q * e);
    return v < 0.f ? m : v - m;
}
template <int EMASK, int PARTS>
__device__ __forceinline__ void p6_slices(const Args& a, lds_u8* wl, int tok0, int lane) {
    const int n = lane & 15, g = lane >> 4;
    const unsigned char* ws = a.ws;
    const unsigned char* WD = ws + WS_WD; const unsigned char* WU = ws + WS_WU;
    LAS float* aacc = (LAS float*)wl; LAS unsigned short* idl = (LAS unsigned short*)(wl + 8192); LAS unsigned short* actl = (LAS unsigned short*)(wl + 12288);
    lds_u8* xs = wl + 16384; LAS float* ssl = (LAS float*)(wl + 16384 + 512); LAS float* r2l = ssl + 16;
#pragma unroll 1
    for (int t = 0; t < 16; ++t) {
        const u32x2 iv = *(const GAS u32x2*)((const int*)(ws + WS_IDX) + (size_t)(tok0 + t) * 128 + lane * 2);
        *(LAS unsigned*)(wl + 8192 + t * 256 + lane * 4) = (iv.x & 0xffffu) | (iv.y << 16);
        *(LAS f32x2*)(wl + t * 512 + lane * 8) = (f32x2){0.f, 0.f};
    }
    if (lane < 16) { ssl[lane] = 0.f; r2l[lane] = row_rs2((const bf16_t*)(ws + WS_SSQ), tok0 + lane); }
    unsigned char* X4 = (unsigned char*)a.ws + WS_XB;
#pragma unroll 1
    for (int t = 0; t < 16; ++t) {
        const bf16_t* xr = (const bf16_t*)(ws + WS_X1B) + (size_t)(tok0 + t) * DM + 16 * lane;
        const u32x4 xw0 = *(const GAS u32x4*)xr, xw1 = *(const GAS u32x4*)(xr + 8);
        float rr[16];
#pragma unroll
        for (int j = 0; j < 4; ++j) { rr[2 * j] = __uint_as_float(xw0[j] << 16); rr[2 * j + 1] = __uint_as_float(xw0[j] & 0xffff0000u); rr[8 + 2 * j] = __uint_as_float(xw1[j] << 16); rr[9 + 2 * j] = __uint_as_float(xw1[j] & 0xffff0000u); }
#pragma unroll
        for (int st = 0; st < 4; ++st) {
            unsigned w0 = 0u, w1 = 0u;
#define P6_Q4(p_) do { w0 = __builtin_amdgcn_cvt_scalef32_pk_fp4_f32(w0, rr[2 * (p_)], rr[2 * (p_) + 1], 1.0f, p_); w1 = __builtin_amdgcn_cvt_scalef32_pk_fp4_f32(w1, rr[8 + 2 * (p_)], rr[9 + 2 * (p_)], 1.0f, p_); } while (0)
            P6_Q4(0); P6_Q4(1); P6_Q4(2); P6_Q4(3);
#undef P6_Q4
#define P6_D4(p_) do { const f32x2 d0 = __builtin_amdgcn_cvt_scalef32_pk_f32_fp4(w0, 1.0f, p_), d1 = __builtin_amdgcn_cvt_scalef32_pk_f32_fp4(w1, 1.0f, p_); \
                rr[2 * (p_)] = (rr[2 * (p_)] - d0.x) * 4.0f; rr[2 * (p_) + 1] = (rr[2 * (p_) + 1] - d0.y) * 4.0f; rr[8 + 2 * (p_)] = (rr[8 + 2 * (p_)] - d1.x) * 4.0f; rr[9 + 2 * (p_)] = (rr[9 + 2 * (p_)] - d1.y) * 4.0f; } while (0)
            P6_D4(0); P6_D4(1); P6_D4(2); P6_D4(3);
#undef P6_D4
            *(GAS u32x2*)(X4 + (size_t)(tok0 + t) * 2048 + st * 512 + 8 * lane) = (u32x2){w0, w1};
        }
    }
    LDS_WAIT(); VM_WAIT();
    const int xoff = (n & 3) * 128 + 16 * g;
    const int bpa = 4 * (4 * (lane & 15) + (lane >> 4));
#define MFMA4(a_, b_, c_) __builtin_amdgcn_mfma_scale_f32_16x16x128_f8f6f4(a_, b_, c_, 4  , 4  , 0, 0, 0, 0)
#define P6_DLOAD(BQ, XV, it_) do { const int sl_ = (it_) >> 4, t_ = (it_) & 15; \
        _Pragma("unroll") for (int eg = 0; eg < 8; ++eg) { const int e_ = idl[t_ * 128 + eg * 16 + (lane >> 2)] & EMASK; const unsigned char* rp_ = WD + sl_ * P6_SLICEB + (size_t)e_ * 128 + 16 * (lane & 3); \
            BQ[2 * eg] = *(const GAS u32x4*)rp_; BQ[2 * eg + 1] = *(const GAS u32x4*)(rp_ + 64); } \
        XV = *(const GAS u32x2*)(X4 + (size_t)(tok0 + t_) * 2048 + (lane >> 4) * 512 + sl_ * 128 + 8 * (lane & 15)); } while (0)
#define P6_DCOMP(BQ, XV, it_) do { const int t_ = (it_) & 15; \
        *(LAS u32x2*)(xs + (lane >> 4) * 128 + 8 * (lane & 15)) = XV; \
        LDS_WAIT(); \
        const u32x4 xa0 = *(const LAS u32x4*)(xs + xoff), xa1 = *(const LAS u32x4*)(xs + xoff + 64); \
        const v8i_t A0 = (v8i_t){(int)xa0.x, (int)xa0.y, (int)xa0.z, (int)xa0.w, 0, 0, 0, 0}; \
        const v8i_t A1 = (v8i_t){(int)xa1.x, (int)xa1.y, (int)xa1.z, (int)xa1.w, 0, 0, 0, 0}; \
        _Pragma("unroll") for (int eg = 0; eg < 8; ++eg) { f32x4 acc = (f32x4){0.f, 0.f, 0.f, 0.f}; v8i_t b0 = (v8i_t){0, 0, 0, 0, 0, 0, 0, 0}, b1 = (v8i_t){0, 0, 0, 0, 0, 0, 0, 0}; \
            _Pragma("unroll") for (int w_ = 0; w_ < 4; ++w_) { b0[w_] = __builtin_amdgcn_ds_bpermute(bpa, (int)BQ[2 * eg][w_]); b1[w_] = __builtin_amdgcn_ds_bpermute(bpa, (int)BQ[2 * eg + 1][w_]); } \
            acc = MFMA4(A0, b0, acc); acc = MFMA4(A1, b1, acc); \
            float r_ = (acc[0] + acc[1] * 0.25f) + (acc[2] * 0.0625f + acc[3] * 0.015625f); asm volatile("" : "+v"(r_)); \
            if (g == 0) aacc[t_ * 128 + eg * 16 + n] += r_; } \
        LDS_WAIT(); } while (0)
    if (PARTS & 1) {
        u32x4 bqA[16], bqB[16]; u32x2 xvA, xvB;
        P6_DLOAD(bqA, xvA, 0);
#pragma unroll 1
        for (int it = 0; it < 64; it += 2) {
            P6_DLOAD(bqB, xvB, it + 1);
            P6_DCOMP(bqA, xvA, it);
            if (it + 2 < 64) P6_DLOAD(bqA, xvA, it + 2);
            P6_DCOMP(bqB, xvB, it + 1);
        }
    }
#undef MFMA4
#undef P6_DLOAD
#undef P6_DCOMP
    int lane_g = lane; asm volatile("" : "+v"(lane_g));
#pragma unroll 1
    for (int t = 0; t < 16; ++t) {
        const float sc = r2l[t] * (1.0f / P6_SD);
#pragma unroll
        for (int j = 0; j < 2; ++j) { const int ei = lane_g + 64 * j; const float av = aacc[t * 128 + ei] * sc;
            const float act = gelu_as(av) * ((const float*)(ws + WS_GATE))[(size_t)(tok0 + t) * 128 + ei];
            const unsigned ab = __float_as_uint(act), eb = (ab >> 23) & 255u;
            unsigned pk = 0u;
            if (eb > 4u) {
                const float m = __uint_as_float((ab & 0x807fffffu) | (128u << 23));
                const unsigned w0 = __builtin_amdgcn_cvt_scalef32_pk_fp4_f32(0u, m, 0.f, 1.0f, 0);
                const f32x2 d0 = __builtin_amdgcn_cvt_scalef32_pk_f32_fp4(w0, 1.0f, 0);
                const unsigned w1 = __builtin_amdgcn_cvt_scalef32_pk_fp4_f32(0u, (m - d0.x) * 4.0f, 0.f, 1.0f, 0);
                pk = (w0 & 15u) | ((w1 & 15u) << 4) | ((eb - 1u) << 8);
            }
            actl[t * 128 + ei] = (unsigned short)pk; }
    }
    LDS_WAIT();
    int lane_u = lane; asm volatile("" : "+v"(lane_u));
    const float* nf = a.in[16];
    const int ui = lane_u & 31, ug = lane_u >> 5, ush = 4 * (ui & 7);
    const unsigned uk0 = (ui >> 3) == 0 ? 0xffffffffu : 0u, uk1 = (ui >> 3) == 1 ? 0xffffffffu : 0u, uk2 = (ui >> 3) == 2 ? 0xffffffffu : 0u, uk3 = (ui >> 3) == 3 ? 0xffffffffu : 0u;
#define MFMA32S(a_, b_, c_, sa_) __builtin_amdgcn_mfma_scale_f32_32x32x64_f8f6f4(a_, b_, c_, 4, 4, 0, sa_, 0, 127)
#define P6_ULOAD(BQ, sq_) do { const int t_ = (sq_) >> 3, qs_ = (sq_) & 7; \
        _Pragma("unroll") for (int q = 0; q < 8; ++q) { const int e_ = idl[t_ * 128 + 2 * (8 * qs_ + q) + ug] & EMASK; \
            BQ[q] = *(const GAS u32x4*)(WU + (size_t)e_ * 512 + 16 * ui); } } while (0)
#define P6_UMMA(BQ, sq_) do { const int t_ = (sq_) >> 3, qs_ = (sq_) & 7; \
        _Pragma("unroll") for (int q = 0; q < 8; ++q) { \
            const unsigned av_ = actl[t_ * 128 + 2 * (8 * qs_ + q) + ug]; \
            const unsigned w0_ = (av_ & 15u) << ush, w1_ = ((av_ >> 4) & 15u) << ush; const int s0_ = (int)(av_ >> 8), s1_ = s0_ - 2; \
            const u32x4 bb = BQ[q]; const v8i_t B_ = (v8i_t){(int)bb.x, (int)bb.y, (int)bb.z, (int)bb.w, 0, 0, 0, 0}; \
            uacc = MFMA32S(((v8i_t){(int)(w0_ & uk0), (int)(w0_ & uk1), (int)(w0_ & uk2), (int)(w0_ & uk3), 0, 0, 0, 0}), B_, uacc, s0_); \
            uacc = MFMA32S(((v8i_t){(int)(w1_ & uk0), (int)(w1_ & uk1), (int)(w1_ & uk2), (int)(w1_ & uk3), 0, 0, 0, 0}), B_, uacc, s1_); } } while (0)
#define P6_UEPI(sq_) do { const int t_ = (sq_) >> 3; \
        float* orow = a.out + (size_t)(tok0 + t_) * DM + 32 * ui + 4 * ug; const bf16_t* xrow = (const bf16_t*)(ws + WS_X1B) + (size_t)(tok0 + t_) * DM + 32 * ui + 4 * ug; \
        f32x4 x2[4]; float ss = 0.f; \
        _Pragma("unroll") for (int gq = 0; gq < 4; ++gq) { \
            const u32x2 xq_ = *(const GAS u32x2*)(xrow + 8 * gq); \
            x2[gq] = (f32x4){__uint_as_float(xq_.x << 16), __uint_as_float(xq_.x & 0xffff0000u), __uint_as_float(xq_.y << 16), __uint_as_float(xq_.y & 0xffff0000u)} \
                + (f32x4){uacc[4 * gq], uacc[4 * gq + 1], uacc[4 * gq + 2], uacc[4 * gq + 3]} * (1.0f / P6_SU4); \
            ss += (x2[gq].x * x2[gq].x + x2[gq].y * x2[gq].y) + (x2[gq].z * x2[gq].z + x2[gq].w * x2[gq].w); } \
        const float rn = 1.0f / sqrtf(wave_sum(ss) * (1.0f / DM) + EPSF);     \
        _Pragma("unroll") for (int gq = 0; gq < 4; ++gq) { const f32x4 gv = *(const GAS f32x4*)(nf + 32 * ui + 4 * ug + 8 * gq); *(GAS f32x4*)(orow + 8 * gq) = x2[gq] * rn * gv; } \
        uacc = f32x16{}; } while (0)
    if (PARTS & 2) {
        u32x4 bqA[8], bqB[8]; f32x16 uacc = f32x16{};
        P6_ULOAD(bqA, 0);
#pragma unroll 1
        for (int sq = 0; sq < 128; sq += 2) {
            P6_ULOAD(bqB, sq + 1);
            P6_UMMA(bqA, sq);
            if (sq + 2 < 128) P6_ULOAD(bqA, sq + 2);
            P6_UMMA(bqB, sq + 1);
            if (((sq + 1) & 7) == 7) P6_UEPI(sq + 1);
        }
    }
#undef P6_ULOAD
#undef P6_UMMA
#undef P6_UEPI
#undef MFMA32S
}

#ifndef MK_N_LAUNCHES
#define MK_N_LAUNCHES 1
#endif
constexpr int NPHASE = 7;

__device__ __forceinline__ int queue_next(unsigned* ctr, volatile LAS unsigned* slot) {
    __syncthreads();
    if (threadIdx.x == 0) *slot = __hip_atomic_fetch_add(ctr, 1u, __ATOMIC_RELAXED, __HIP_MEMORY_SCOPE_AGENT);
    __syncthreads();
    return (int)*slot;
}

__global__ void __launch_bounds__(NTHR, 2) hymba_fwd(Args a) {
    extern __shared__ __attribute__((aligned(16))) unsigned char lds_raw[];
    lds_u8* lds = (lds_u8*)lds_raw;
    volatile LAS unsigned* MISC = (volatile LAS unsigned*)(lds + MISC_OFF);
    const int tid = threadIdx.x, lane = tid & 63; const int wave = __builtin_amdgcn_readfirstlane(tid >> 6);
    const int G = gridDim.x; const int bx = blockIdx.x;
    const int vcu = (G % 8 == 0) ? (bx % 8) * (G / 8) + bx / 8 : bx;
    const int gw = vcu * NWAVES + wave, NGW = G * NWAVES;
    for (int u = tid; u < (LDS_BYTES - MISC_OFF) / 4; u += NTHR) MISC[u] = 0u;
    __syncthreads();
    const int lo = a.ph_lo, hi = a.ph_hi;
    const bool use_bar = (hi - lo) > 1;
    XcdBarrier bar; bar.bar = (unsigned*)(a.ws + WS_CTL); bar.x = 0; bar.st = MISC + 8;
    if (use_bar) bar = xcd_barrier_post((unsigned*)(a.ws + WS_CTL), MISC + 8);
#ifndef PH_MASK
#define PH_MASK 127
#endif
#define IN(k) (((PH_MASK >> (k)) & 1) && lo <= (k) && (k) < hi)
#define SEAM(k) do { if (IN(k) && IN((k) + 1)) xcd_barrier(bar); } while (0)
    unsigned char* ws = a.ws;

    if (IN(0)) { p0_prologue(a, lds, gw, NGW, lane, wave);
#ifdef DBL_P0
        __syncthreads(); p0_prologue(a, lds, gw, NGW, lane, wave);
#endif
    }
    SEAM(0);
    if (IN(1)) {
        pg8::Gemm g{(const bf16_t*)(ws + WS_XB), (const bf16_t*)(ws + WS_WIN), MTOK, NIN, DM}; pg8::StaticOrder S; S.init(MTOK, NIN, G, bx);
        EpiProj E{(bf16_t*)(ws + WS_PROJ), (const float*)(ws + WS_R1), (const f32x4*)(ws + WS_ROPE), (const float*)(ws + WS_DECAY)};
        pg8::gemm_phase<EpiProj, pg8::StaticOrder>(lds, g, S, E);
#ifdef DBL_P1
        pg8::gemm_phase<EpiProj, pg8::StaticOrder>(lds, g, S, E);
#endif
    }
    SEAM(1);
    if (IN(2)) {
#ifdef DBL_P2
        for (int rep = 0; rep < 2; ++rep) {
        unsigned* ctr = (unsigned*)(ws + WS_CTL + CTL_Q_ATT + rep * 256);
#else
        {
        unsigned* ctr = (unsigned*)(ws + WS_CTL + CTL_Q_ATT);
#endif
        for (;;) {
            int u = queue_next(ctr, MISC + 16);
            if (u >= 64 + 1024 + DEF_ITEMS) break;
            if (u >= 64) { const int i9 = (u - 64) / 9, r9 = (u - 64) % 9; u = (r9 < 4) ? 64 + i9 * 4 + r9 : 64 + 1024 + i9 * 5 + (r9 - 4); }
#ifdef PROBE_P2
            if (rep == 0 && u >= 64 + 1024) continue;
#endif
            if (u >= 64 + 1024) { p0_deferred(a, lds, u - (64 + 1024)); continue; }
#ifdef PROBE_P2
            if (rep == 0) { if (u < 64) { if (PROBE_P2 & 1) ret_unit(a, lds, u >> 3, u & 7); } else if (PROBE_P2 & 2) { const int v = u - 64; attn_unit<PROBE_ATT>(a, lds, (v & 31) >> 2, v & 3, 31 - (v >> 5)); } continue; }
#endif
            if (u < 64) ret_unit(a, lds, u >> 3, u & 7);
            else { const int v = u - 64; attn_unit<7>(a, lds, (v & 31) >> 2, v & 3, 31 - (v >> 5)); }
        }
        }
    }
    SEAM(2);
    if (IN(3)) {
        pg8::Gemm g{(const bf16_t*)(ws + WS_MIX), (const bf16_t*)(ws + WS_WOUT), MTOK, DM, DM}; pg8::StaticOrder S; S.init(MTOK, DM, G, bx);
        EpiX1 E{(const bf16_t*)(ws + WS_XB), (bf16_t*)(ws + WS_X1B), (bf16_t*)(ws + WS_SSQ)};
        pg8::gemm_phase<EpiX1, pg8::StaticOrder>(lds, g, S, E);
    }
    SEAM(3);
    if (IN(4)) {
        pg8::Gemm g{(const bf16_t*)(ws + WS_X1B), (const bf16_t*)(ws + WS_WPQ), MTOK, NQ, DM}; pg8::StaticOrder S; S.init(MTOK, NQ, G, bx);
        EpiQ E{(bf16_t*)(ws + WS_PROJ), (const bf16_t*)(ws + WS_SSQ)};
        pg8::gemm_phase<EpiQ, pg8::StaticOrder>(lds, g, S, E);
#ifdef DBL_P4
        pg8::gemm_phase<EpiQ, pg8::StaticOrder>(lds, g, S, E);
#endif
    }
    SEAM(4);
    if (IN(5)) { p5_topk(a, lds);
#ifdef DBL_P5
        p5_topk(a, lds);
#endif
    }
    SEAM(5);
    if (IN(6)) {
#ifdef P6_TOKEN_MAJOR
        lds_u8* wl = lds + wave * P6_WSCR;
        for (int tok = gw; tok < MTOK; tok += NGW) p6_token(a, wl, tok, lane, a.out);
#else
#ifdef PROBE_EMASK
        for (int tb = gw; tb < MTOK / 16; tb += NGW) p6_slices<PROBE_EMASK, PROBE_PARTS>(a, lds + wave * P6S_WAVE, tb * 16, lane);
#endif
        for (int tb = gw; tb < MTOK / 16; tb += NGW) p6_slices<0xffff, 3>(a, lds + wave * P6S_WAVE, tb * 16, lane);
#endif
    }
#ifdef DBG_DUMP
    if (hi - lo > 1) xcd_barrier(bar);
    {
        for (int m = gw; m < MTOK; m += NGW) {
            for (int c = lane; c < DM; c += 64) {
                float v = 0.f;
#if DBG_DUMP == 1
                v = bf2f(((const bf16_t*)(ws + WS_PROJ))[(size_t)m * NIN + DBG_COL + c]);
#elif DBG_DUMP == 2
                v = (c >= DBG_C0 && c < DBG_C1) ? bf2f(((const bf16_t*)(ws + WS_MIX))[(size_t)m * DM + c]) : 0.f;
#endif
                a.out[(size_t)m * DM + c] = v;
            }
        }
    }
#endif
#undef IN
#undef SEAM
}

extern "C" void kernel_launch(void* const* d_in, const int* in_sizes, int n_in, void* d_out, int out_size, void* d_ws, size_t ws_size, hipStream_t stream) {
    static int grid = 0;
    if (grid == 0) {
        if (n_in != 17 || in_sizes[0] != MTOK * DM || out_size != MTOK * DM || ws_size < WS_END) {
            fprintf(stderr, "kernel_launch: unexpected shapes (n_in %d, in0 %d, out %d, ws %zu < %zu); nothing launched\n", n_in, n_in > 0 ? in_sizes[0] : -1, out_size, ws_size, (size_t)WS_END); grid = -1; return; }
        int dev = 0, cus = 0, per_cu = 0;
        if (hipGetDevice(&dev) != hipSuccess || hipDeviceGetAttribute(&cus, hipDeviceAttributeMultiprocessorCount, dev) != hipSuccess) { fprintf(stderr, "kernel_launch: device query failed\n"); grid = -1; return; }
        if (hipFuncSetAttribute((const void*)hymba_fwd, hipFuncAttributeMaxDynamicSharedMemorySize, LDS_BYTES) != hipSuccess) { fprintf(stderr, "kernel_launch: hipFuncSetAttribute failed\n"); grid = -1; return; }
        if (hipOccupancyMaxActiveBlocksPerMultiprocessor(&per_cu, (const void*)hymba_fwd, NTHR, LDS_BYTES) != hipSuccess || per_cu < 1)
            fprintf(stderr, "kernel_launch: note: occupancy query reports %d workgroups per CU\n", per_cu);
        (void)hipGetLastError();
        grid = cus;
    }
    if (grid < 0) return;
    if (hipMemsetAsync((char*)d_ws + WS_CTL, 0, CTL_BYTES, stream) != hipSuccess) { fprintf(stderr, "kernel_launch: memset failed\n"); return; }
    Args a{};
    for (int i = 0; i < 17; ++i) a.in[i] = (const float*)d_in[i];
    a.out = (float*)d_out; a.ws = (unsigned char*)d_ws;
#if MK_N_LAUNCHES == 1
#ifdef DBG_STOP
    a.ph_lo = 0; a.ph_hi = DBG_STOP + 1;
#else
    a.ph_lo = 0; a.ph_hi = NPHASE;
#endif
    hipLaunchKernelGGL(hymba_fwd, dim3(grid), dim3(NTHR), LDS_BYTES, stream, a);
#else
    for (int p = 0; p < NPHASE; ++p) { a.ph_lo = p; a.ph_hi = p + 1; hipLaunchKernelGGL(hymba_fwd, dim3(grid), dim3(NTHR), LDS_BYTES, stream, a); }
#endif
    const hipError_t le = hipPeekAtLastError();
    if (le != hipSuccess) fprintf(stderr, "kernel_launch: launch failed: %s\n", hipGetErrorName(le));
}
```

```cpp
#include <hip/hip_runtime.h>
#include <cstdio>
#include <cstdint>

namespace pg8 {
#define PG8_LAS __attribute__((address_space(3)))
typedef unsigned short bf16_t;
typedef short bf16x8 __attribute__((ext_vector_type(8)));
typedef float f32x4 __attribute__((ext_vector_type(4)));
typedef unsigned u32x4 __attribute__((ext_vector_type(4)));
constexpr int BM = 256, BK = 64, HALF = 128, HTB = HALF * BK * 2  , STAGE_BYTES = 8 * HTB, NXCD = 8, WGM = 8;

__host__ __device__ __forceinline__ int lds_byte(int r, int c) { const int st = (r >> 4) * 2 + (c >> 5), rr = r & 15, cc = c & 31, ob = rr * 64 + cc * 2; return st * 1024 + (ob ^ (((ob >> 9) & 1) << 5)); }
__host__ __device__ __forceinline__ void stage_rc(int b, int& R, int& C) { const int st = b / 1024, sb = b % 1024, swz = sb ^ (((sb >> 9) & 1) << 5); R = (st >> 1) * 16 + swz / 64; C = (st & 1) * 32 + (swz % 64) / 2; }
__host__ __device__ __forceinline__ int perm32(int rho) { const int n = rho >> 4, i = rho & 15; return 8 * (i >> 2) + 4 * n + (i & 3); }

struct Unit { int pm, pn; };
struct Gemm { const bf16_t* A; const bf16_t* Bt; int M, N, K; };

struct StaticOrder {
    int nM, nN, nwg, G, c;
    __host__ __device__ void init(int M, int N, int G_, int c_) { nM = M / BM; nN = N / BM; nwg = nM * nN; G = G_; c = c_; }
    __host__ __device__ bool next(int i, Unit& u) const {
        const long L = (long)i * G + c; if (L >= nwg) return false;
        int wgid = (int)L; { const int q = nwg / NXCD, r = nwg % NXCD, xcd = wgid % NXCD, off = wgid / NXCD; wgid = (xcd < r ? xcd * (q + 1) : r * (q + 1) + (xcd - r) * q) + off; }
        const int nig = WGM * nN, gid = wgid / nig, fm = gid * WGM, gsz = (nM - fm) < WGM ? (nM - fm) : WGM;
        u.pm = fm + ((wgid % nig) % gsz); u.pn = (wgid % nig) / gsz; return true;
    }
    __device__ __forceinline__ void a_ready(const Unit&) const {}
    __device__ __forceinline__ void done(const Unit&) const {}
};
__device__ __forceinline__ unsigned cvt_pk_bf16(float lo, float hi) { unsigned r; asm volatile("v_cvt_pk_bf16_f32 %0, %1, %2" : "=v"(r) : "v"(lo), "v"(hi)); return r; }
template <class Epi, class Sched>
__device__ __forceinline__ void gemm_phase(PG8_LAS unsigned char* lds, const Gemm g, const Sched& S, const Epi& E) {
    const int tid = threadIdx.x, wid = __builtin_amdgcn_readfirstlane(tid >> 6), lane = tid & 63, wr = wid >> 2, wc = wid & 3, fr = lane & 15, fq = lane >> 4;
    const int K = g.K, nt = K / BK;
    unsigned voffA[2], voffB[2];
#pragma unroll
    for (int i = 0; i < 2; ++i) { int R, C; stage_rc(tid * 16 + i * 8192, R, C); const int Rb = Epi::PERM ? ((R & ~31) + perm32(R & 31)) : R;
        voffA[i] = (unsigned)(R * K + C) * 2u; voffB[i] = (unsigned)(Rb * K + C) * 2u; }
    const size_t kstep = (size_t)(BK * 2);
    const size_t hstep = (size_t)HALF * K * 2;
    const size_t tstep = 2 * hstep;
    const unsigned ldsw = (unsigned)wid * 1024u;
    const int aoff = lds_byte(wr * 64 + fr, fq * 8), boff = lds_byte(wc * 32 + fr, fq * 8);
#define PG8_SA(b, h) (((b) * 2 + (h)) * HTB)
#define PG8_SB(b, h) ((4 + (b) * 2 + (h)) * HTB)
#define PG8_STAGE(bufoff, gbase, voff) do { _Pragma("unroll") for (int _i = 0; _i < 2; ++_i) \
        __builtin_amdgcn_global_load_lds((const unsigned*)((const char*)(gbase) + (voff)[_i]), (PG8_LAS unsigned*)(lds + (bufoff) + ldsw + _i * 8192), 16, 0, 0); } while (0)
#define PG8_LDA(dst, b, h) do { _Pragma("unroll") for (int m = 0; m < 4; ++m) _Pragma("unroll") for (int k = 0; k < 2; ++k) dst[m][k] = *(const PG8_LAS bf16x8*)(lds + PG8_SA(b, h) + aoff + m * 2048 + k * 1024); } while (0)
#define PG8_LDB(dst, b, h) do { _Pragma("unroll") for (int n = 0; n < 2; ++n) _Pragma("unroll") for (int k = 0; k < 2; ++k) dst[n][k] = *(const PG8_LAS bf16x8*)(lds + PG8_SB(b, h) + boff + n * 2048 + k * 1024); } while (0)
#define PG8_MMA(ai, bj, At, Bt) do { __builtin_amdgcn_s_setprio(1); _Pragma("unroll") for (int m = 0; m < 4; ++m) _Pragma("unroll") for (int n = 0; n < 2; ++n) _Pragma("unroll") for (int k = 0; k < 2; ++k) \
        acc[ai][bj][m][n] = __builtin_amdgcn_mfma_f32_16x16x32_bf16(Bt[n][k], At[m][k], acc[ai][bj][m][n], 0, 0, 0); __builtin_amdgcn_s_setprio(0); } while (0)
#define PG8_WAIT_V(n) asm volatile("s_waitcnt vmcnt(" #n ")" ::: "memory")
#define PG8_WAIT_L(n) asm volatile("s_waitcnt lgkmcnt(" #n ")" ::: "memory")
#define PG8_BAR __builtin_amdgcn_s_barrier()
#define PG8_SCHED __builtin_amdgcn_sched_barrier(0)
    Unit cur, nxt; int ui = 0;
    if (!S.next(0, cur)) return;
    f32x4 acc[2][2][4][2];
#pragma unroll
    for (int a = 0; a < 2; ++a)
#pragma unroll
        for (int b = 0; b < 2; ++b)
#pragma unroll
            for (int m = 0; m < 4; ++m)
#pragma unroll
                for (int n = 0; n < 2; ++n) acc[a][b][m][n] = (f32x4){0.f, 0.f, 0.f, 0.f};
    bf16x8 At[4][2], B0[2][2], B1[2][2];
    const char* cA = (const char*)g.A + (size_t)cur.pm * tstep; const char* cB = (const char*)g.Bt + (size_t)cur.pn * tstep;
    S.a_ready(cur);
    PG8_STAGE(PG8_SB(0, 0), cB, voffB); PG8_STAGE(PG8_SA(0, 0), cA, voffA); PG8_STAGE(PG8_SB(0, 1), cB + hstep, voffB); PG8_STAGE(PG8_SA(0, 1), cA + hstep, voffA);
    if (wr == 1) PG8_BAR;
    PG8_WAIT_V(4); PG8_BAR;
    PG8_STAGE(PG8_SB(1, 0), cB + kstep, voffB); PG8_STAGE(PG8_SA(1, 0), cA + kstep, voffA); PG8_STAGE(PG8_SB(1, 1), cB + hstep + kstep, voffB);
    PG8_WAIT_V(6); PG8_BAR;
    for (;;) {
        const bool has_next = S.next(ui + 1, nxt);
        const char* nA = has_next ? (const char*)g.A + (size_t)nxt.pm * tstep : cA; const char* nB = has_next ? (const char*)g.Bt + (size_t)nxt.pn * tstep : cB;
        for (int t = 0; t < nt; t += 2) {
            const bool last = (t == nt - 2);
            const char* a1 = cA + (size_t)(t + 1) * kstep;
            const char* a2 = last ? nA : cA + (size_t)(t + 2) * kstep; const char* b2 = last ? nB : cB + (size_t)(t + 2) * kstep;
            const char* a3 = a2 + kstep; const char* b3 = b2 + kstep;
            if (last && has_next) S.a_ready(nxt);
            PG8_LDB(B0, 0, 0); PG8_SCHED; PG8_LDA(At, 0, 0); PG8_STAGE(PG8_SA(1, 1), a1 + hstep, voffA);
            PG8_WAIT_L(8); PG8_BAR; PG8_WAIT_L(0); PG8_MMA(0, 0, At, B0); PG8_BAR; PG8_SCHED;
            PG8_LDB(B1, 0, 1); PG8_STAGE(PG8_SB(0, 0), b2, voffB);
            PG8_BAR; PG8_WAIT_L(0); PG8_MMA(0, 1, At, B1); PG8_BAR;
            PG8_LDA(At, 0, 1); PG8_STAGE(PG8_SA(0, 0), a2, voffA);
            PG8_BAR; PG8_WAIT_L(0); PG8_MMA(1, 0, At, B0); PG8_BAR; PG8_SCHED;
            PG8_STAGE(PG8_SB(0, 1), b2 + hstep, voffB);
            PG8_WAIT_V(6); PG8_BAR; PG8_MMA(1, 1, At, B1); PG8_BAR;
            PG8_LDB(B0, 1, 0); PG8_SCHED; PG8_LDA(At, 1, 0); PG8_STAGE(PG8_SA(0, 1), a2 + hstep, voffA);
            PG8_WAIT_L(8); PG8_BAR; PG8_WAIT_L(0); PG8_MMA(0, 0, At, B0); PG8_BAR; PG8_SCHED;
            PG8_LDB(B1, 1, 1); PG8_STAGE(PG8_SB(1, 0), b3, voffB);
            PG8_BAR; PG8_WAIT_L(0); PG8_MMA(0, 1, At, B1); PG8_BAR;
            PG8_LDA(At, 1, 1); PG8_STAGE(PG8_SA(1, 0), a3, voffA);
            PG8_BAR; PG8_WAIT_L(0); PG8_MMA(1, 0, At, B0); PG8_BAR; PG8_SCHED;
            PG8_STAGE(PG8_SB(1, 1), b3 + hstep, voffB);
            PG8_WAIT_V(6); PG8_BAR; PG8_MMA(1, 1, At, B1); PG8_BAR;
        }
        if constexpr (!Epi::AFTER_DRAIN) { E(acc, cur, wr, wc, fr, fq); S.done(cur); }
        if (!has_next) break;
#pragma unroll
        for (int a = 0; a < 2; ++a)
#pragma unroll
            for (int b = 0; b < 2; ++b)
#pragma unroll
                for (int m = 0; m < 4; ++m)
#pragma unroll
                    for (int n = 0; n < 2; ++n) acc[a][b][m][n] = (f32x4){0.f, 0.f, 0.f, 0.f};
        cur = nxt; cA = nA; cB = nB; ++ui;
    }
    PG8_WAIT_V(0);
    if (wr == 0) PG8_BAR;
    PG8_BAR;
    if constexpr (Epi::AFTER_DRAIN) { E.fused(acc, cur, wr, wc, fr, fq, lds, wid, lane); S.done(cur); }
#undef PG8_SA
#undef PG8_SB
#undef PG8_STAGE
#undef PG8_LDA
#undef PG8_LDB
#undef PG8_MMA
#undef PG8_WAIT_V
#undef PG8_WAIT_L
#undef PG8_BAR
#undef PG8_SCHED
}
}

#define XB_TMO      128
#define XB_XCNT(j)  (256  + 64 * (j))
#define XB_XSUB(j)  (1280 + 64 * (j))
#define XB_XGEN(j)  (2304 + 64 * (j))
#define XB_TOP      3328
#define XB_TOPGEN   3392
#define XCD_BAR_WORDS 3456
#define XB_SPIN_CAP (1u << 18)
#define LAS __attribute__((address_space(3)))

__device__ __forceinline__ unsigned xb_ld(unsigned* p)              { return __hip_atomic_load(p, __ATOMIC_RELAXED, __HIP_MEMORY_SCOPE_AGENT); }
__device__ __forceinline__ unsigned xb_add(unsigned* p, unsigned v) { return __hip_atomic_fetch_add(p, v, __ATOMIC_RELAXED, __HIP_MEMORY_SCOPE_AGENT); }
__device__ __forceinline__ unsigned xb_xcc_id() { return (unsigned)__builtin_amdgcn_s_getreg((3 << 11) | 20) & 0xFu; }
#define XB_SPIN(cond, bar) do { unsigned _sp = 0; while (cond) { __builtin_amdgcn_s_sleep(1); \
    if ((++_sp & 255u) == 0u) { if (xb_ld(&(bar)[XB_TMO])) break; if (_sp > XB_SPIN_CAP) { atomicAdd(&(bar)[XB_TMO], 1u); break; } } } } while (0)

struct XcdBarrier {
    unsigned* bar; unsigned x;
    volatile LAS unsigned* st;
};

__device__ __forceinline__ XcdBarrier xcd_barrier_post(unsigned* bar, volatile LAS unsigned* st) {
    XcdBarrier b; b.bar = bar; b.x = xb_xcc_id(); b.st = st;
    if (threadIdx.x == 0) (void)xb_add(&bar[XB_XCNT(b.x)], 1u);
    return b;
}
__device__ __forceinline__ void xcd_barrier_complete(unsigned* bar, unsigned x, unsigned& nloc, unsigned& nx) {
    const unsigned G = gridDim.x * gridDim.y * gridDim.z;
    unsigned sum, cnt, mine, sp = 0u;
    for (;;) {
        sum = 0u; cnt = 0u; mine = 0u;
#pragma unroll
        for (unsigned j = 0; j < 16; ++j) { const unsigned c = xb_ld(&bar[XB_XCNT(j)]); sum += c; cnt += (c > 0u) ? 1u : 0u; mine = (j == x) ? c : mine; }
        if (sum == G) break;
        __builtin_amdgcn_s_sleep(1);
        if ((++sp & 255u) == 0u) { if (xb_ld(&bar[XB_TMO])) break; if (sp > XB_SPIN_CAP) { atomicAdd(&bar[XB_TMO], 1u); break; } }
    }
    nloc = mine > 0u ? mine : 1u; nx = cnt > 0u ? cnt : 1u;
}

__device__ __forceinline__ void xcd_barrier(const XcdBarrier& b) {
    asm volatile("s_waitcnt vmcnt(0)" ::: "memory");
    __syncthreads();
    if (threadIdx.x == 0) {
        unsigned* bar = b.bar;
        __builtin_amdgcn_s_waitcnt(0);
        unsigned nloc = b.st[0], nx = b.st[1];
        if (nloc == 0u) { xcd_barrier_complete(bar, b.x, nloc, nx); b.st[0] = nloc; b.st[1] = nx; }
        const unsigned old = xb_add(&bar[XB_XSUB(b.x)], 1u);
        const unsigned gen = old / nloc;
        if (old + 1u == (gen + 1u) * nloc) {
            __builtin_amdgcn_fence(__ATOMIC_RELEASE, "agent");
            asm volatile("s_waitcnt vmcnt(0)" ::: "memory");
            const unsigned og = xb_add(&bar[XB_TOP], 1u);
            const unsigned tg = og / nx;
            if (og + 1u == (tg + 1u) * nx) xb_add(&bar[XB_TOPGEN], 1u);
            else XB_SPIN(xb_ld(&bar[XB_TOPGEN]) == tg, bar);
            __builtin_amdgcn_fence(__ATOMIC_ACQUIRE, "agent");
            xb_add(&bar[XB_XGEN(b.x)], 1u);
            asm volatile("s_waitcnt vmcnt(0)" ::: "memory");
        } else {
            XB_SPIN(xb_ld(&bar[XB_XGEN(b.x)]) == gen, bar);
            __builtin_amdgcn_fence(__ATOMIC_ACQUIRE, "agent");
            asm volatile("s_waitcnt vmcnt(0)" ::: "memory");
        }
    }
    __syncthreads();
}

#define GAS __attribute__((address_space(1)))
typedef unsigned short bf16_t;
typedef short bf16x8 __attribute__((ext_vector_type(8)));
typedef short s16x4 __attribute__((ext_vector_type(4)));
typedef float f32x4 __attribute__((ext_vector_type(4)));
typedef float f32x2 __attribute__((ext_vector_type(2)));
typedef float f32x16 __attribute__((ext_vector_type(16)));
typedef unsigned u32x4 __attribute__((ext_vector_type(4)));
typedef unsigned u32x2 __attribute__((ext_vector_type(2)));
typedef LAS unsigned char lds_u8;

constexpr int MTOK = 32768, DM = 1024, SEQ = 4096, NBATCH = 8, NIN = 3584;
constexpr int OFF_RQ = 0, OFF_RK = 512, OFF_RV = 1024, OFF_RG = 1536, OFF_DQ = 2048, OFF_DK = 2560, OFF_DV = 3072;
constexpr int NEXP = 16384, NQ = 2048;
constexpr float EPSF = 1e-6f, LOG2E = 1.4426950408889634f;
constexpr int NWAVES = 8, NTHR = 512;

constexpr size_t WS_CTL = 0, CTL_BYTES = 65536;
constexpr size_t CTL_Q_ATT = 16384, CTL_Q_P6 = 16384 + 1024;
constexpr size_t WS_R1 = WS_CTL + CTL_BYTES;
constexpr size_t WS_SSQ = WS_R1 + (size_t)MTOK * 4;
constexpr size_t WS_ROPE = WS_SSQ + (size_t)MTOK * 16 * 4;
constexpr size_t WS_DECAY = WS_ROPE + (size_t)SEQ * 32 * 8;
constexpr size_t WS_BTAB = WS_DECAY + 2 * 8 * 128 * 4;
constexpr size_t WS_LAM = WS_BTAB + 4 * 128 * 4;
constexpr size_t WS_WIN = 4u << 20;
constexpr size_t WS_WOUT = WS_WIN + (size_t)NIN * DM * 2;
constexpr size_t WS_WPQ = WS_WOUT + (size_t)DM * DM * 2;
constexpr size_t WS_KEYS = WS_WPQ + (size_t)NQ * DM * 2;
constexpr size_t WS_WD = WS_KEYS + (size_t)8 * 2 * 128 * 128 * 2;
constexpr size_t WS_WU = WS_WD + (size_t)NEXP * DM * 2;
constexpr size_t WS_XB = WS_WU + (size_t)NEXP * DM * 2;
constexpr size_t WS_PROJ = WS_XB + (size_t)MTOK * DM * 2;
constexpr size_t WS_MIX = WS_PROJ + (size_t)MTOK * NIN * 2;
constexpr size_t WS_IDX = WS_MIX, WS_GATE = WS_MIX + (size_t)MTOK * 128 * 4;
constexpr size_t WS_X1B = WS_PROJ + (size_t)MTOK * NQ * 2;
static_assert(WS_X1B + (size_t)MTOK * DM * 2 <= WS_MIX, "ws map");
constexpr size_t WS_END = WS_MIX + (size_t)MTOK * DM * 2;
static_assert(WS_LAM + 256 <= WS_WIN, "ws map");
static_assert(WS_END <= (size_t)512 << 20, "ws map");

constexpr int LDS_SCRATCH = 139264;
constexpr int MISC_OFF = LDS_SCRATCH;
constexpr int LDS_BYTES = 147456;

__device__ __forceinline__ float wave_sum(float v) {
#pragma unroll
    for (int o = 1; o < 64; o <<= 1) v += __shfl_xor(v, o);
    return v;
}
typedef __bf16 bf16v2_t __attribute__((ext_vector_type(2)));
__device__ __forceinline__ unsigned pk2(float lo, float hi) { const bf16v2_t v = {(__bf16)lo, (__bf16)hi}; return __builtin_bit_cast(unsigned, v); }
__device__ __forceinline__ float bf2f(unsigned short b) { return __uint_as_float(((unsigned)b) << 16); }
#define LDS_WAIT() asm volatile("s_waitcnt lgkmcnt(0)" ::: "memory")
#define VM_WAIT() asm volatile("s_waitcnt vmcnt(0)" ::: "memory")

struct Args {
    const float* in[17]; float* out; unsigned char* ws; int ph_lo, ph_hi;
};

template <int MODE>
__device__ __forceinline__ void p0_transpose_item(const float* W, const float* scale, int K, int N, bf16_t* WT, LAS float* scr, int item, int lane) {
    const int nblk = N / 32, kb = item / nblk, nb = item % nblk, k0 = 64 * kb, n0 = 32 * nb;
#pragma unroll 8
    for (int i = 0; i < 32; ++i) { const int kk = 2 * i + (lane >> 5); const float sc = scale ? scale[k0 + kk] : 1.0f; scr[kk * 33 + (lane & 31)] = W[(size_t)(k0 + kk) * N + n0 + (lane & 31)] * sc; }
    LDS_WAIT();
    const int c = lane & 7;
#pragma unroll
    for (int j = 0; j < 4; ++j) { const int n = (lane >> 3) + 8 * j; const LAS float* s = scr + (8 * c) * 33 + n;
        u32x4 o; o.x = pk2(s[0 * 33], s[1 * 33]); o.y = pk2(s[2 * 33], s[3 * 33]); o.z = pk2(s[4 * 33], s[5 * 33]); o.w = pk2(s[6 * 33], s[7 * 33]);
        int nn = n0 + n;
        if (MODE == 1 && nn < 1024) { const int d = nn & 63; nn = (nn & ~63) + ((d < 32) ? 2 * d : 2 * (d - 32) + 1); }
        *(GAS u32x4*)(WT + (size_t)nn * K + k0 + 8 * c) = o; }
    LDS_WAIT();
}

__device__ __forceinline__ int t5_bucket(int n) {
    if (n < 16) return n;
    const float v = logf((float)n / 16.0f) / 2.0794415416798357f * 16.0f;
    int b = 16 + (int)v; return b > 31 ? 31 : b;
}

__device__ __forceinline__ void p0_prologue(const Args& a, lds_u8* lds, int gw, int NGW, int lane, int wave) {
    unsigned char* ws = a.ws;
    const float* x = a.in[0];
    bf16_t* xb = (bf16_t*)(ws + WS_XB); float* r1 = (float*)(ws + WS_R1);
    for (int m = gw; m < MTOK; m += NGW) {
        const GAS f32x4* xr = (const GAS f32x4*)(x + (size_t)m * DM) + lane; f32x4 v[4]; float s = 0.f;
#pragma unroll
        for (int j = 0; j < 4; ++j) { v[j] = xr[64 * j]; s += (v[j].x * v[j].x + v[j].y * v[j].y) + (v[j].z * v[j].z + v[j].w * v[j].w); }
        s = wave_sum(s);
        GAS u32x2* o8 = (GAS u32x2*)(xb + (size_t)m * DM) + lane;
#pragma unroll
        for (int j = 0; j < 4; ++j) { u32x2 o; o.x = pk2(v[j].x, v[j].y); o.y = pk2(v[j].z, v[j].w); o8[64 * j] = o; }
        if (lane == 0) r1[m] = 1.0f / sqrtf(s * (1.0f / DM) + EPSF);
    }
    {
        LAS float* scr = (LAS float*)(lds + wave * 8704);
        constexpr int I_IN = (DM / 64) * (NIN / 32);
        for (int it = gw; it < I_IN; it += NGW) p0_transpose_item<1>(a.in[2], a.in[1], DM, NIN, (bf16_t*)(ws + WS_WIN), scr, it, lane);
    }
    const int gt = gw * 64 + lane, NGT = NGW * 64;
    {
        f32x2* rope = (f32x2*)(ws + WS_ROPE);
        for (int i = gt; i < SEQ * 32; i += NGT) { const int pos = i >> 5, j = i & 31; const float fr = (float)pow(10000.0, -(double)j / 32.0); const float ang = (float)pos * fr;
            rope[i] = (f32x2){(float)cos((double)ang), (float)sin((double)ang)}; }
        float* dec = (float*)(ws + WS_DECAY);
        for (int i = gt; i < 2 * 8 * 128; i += NGT) { const int l = i & 127, h = (i >> 7) & 7, kk = i >> 10; const double lg = log2(1.0 - exp2(-5.0 - (double)h));
            dec[i] = kk ? (float)(0.125 * exp2(-lg * (double)l)) : (float)exp2(lg * (double)l); }
        float* bt = (float*)(ws + WS_BTAB); const float* rb = a.in[9];
        for (int i = gt; i < 4 * 128; i += NGT) { const int n = i & 127, h = i >> 7; bt[i] = rb[t5_bucket(n) * 4 + h] * LOG2E; }
        if (gt == 0) { float s1 = 0.f, s2 = 0.f; for (int i = 0; i < 64; ++i) { s1 += a.in[4][i] * a.in[5][i]; s2 += a.in[6][i] * a.in[7][i]; }
            ((float*)(ws + WS_LAM))[0] = expf(s1) - expf(s2) + 0.2f; }
    }
}


constexpr int DEF_T0 = 192, DEF_T1 = 64, DEF_T2 = 512, DEF_T3 = 512, DEF_ITEMS = DEF_T0 + DEF_T1 + DEF_T2 + DEF_T3;
__device__ __forceinline__ void p0_deferred(const Args& a, lds_u8* lds, int item) {
    unsigned char* ws = a.ws;
    int tid_ = threadIdx.x; asm volatile("" : "+v"(tid_));
    const int tid = tid_, lane = tid & 63; const int wave = __builtin_amdgcn_readfirstlane(tid >> 6);
    if (item < DEF_T0) {
        LAS float* scr = (LAS float*)(lds + wave * 8704);
        constexpr int I_OUT = (DM / 64) * (DM / 32), I_PQ = (DM / 64) * (NQ / 32);
        static_assert(I_OUT + I_PQ == DEF_T0 * 8, "deferred transposes");
        const int r = item * 8 + wave;
        if (r < I_OUT) p0_transpose_item<0>(a.in[10], nullptr, DM, DM, (bf16_t*)(ws + WS_WOUT), scr, r, lane);
        else p0_transpose_item<0>(a.in[12], a.in[11], DM, NQ, (bf16_t*)(ws + WS_WPQ), scr, r - I_OUT, lane);
        return;
    }
    item -= DEF_T0;
    if (item < DEF_T1) {
        const float* pk = a.in[13]; bf16_t* kb = (bf16_t*)(ws + WS_KEYS);
        const int i = item * 512 + tid;
        const GAS f32x4* s = (const GAS f32x4*)(pk + (size_t)i * 8); const f32x4 p = s[0], q = s[1];
        u32x4 o; o.x = pk2(p.x, p.y); o.y = pk2(p.z, p.w); o.z = pk2(q.x, q.y); o.w = pk2(q.z, q.w); *(GAS u32x4*)(kb + (size_t)i * 8) = o;
        return;
    }
    item -= DEF_T1;
    const float* dn = a.in[14]; const float* up = a.in[15]; const float* gf = a.in[11];
    unsigned char* wd = ws + WS_WD; unsigned char* wu = ws + WS_WU;
    const bool isup = item < DEF_T2; if (!isup) item -= DEF_T2;
    const float* src = (isup ? up : dn) + (size_t)(item * 32 + wave * 4) * DM + lane * 4;
    f32x4 g[4];
#pragma unroll
    for (int k = 0; k < 4; ++k) g[k] = isup ? (f32x4){6.0f, 6.0f, 6.0f, 6.0f} : *(const GAS f32x4*)(gf + k * 256 + lane * 4) * 64.0f;
    f32x4 v[4][4];
#pragma unroll
    for (int r = 0; r < 4; ++r)
#pragma unroll
        for (int k = 0; k < 4; ++k) v[r][k] = *(const GAS f32x4*)(src + (size_t)r * DM + k * 256);
#pragma unroll
    for (int r = 0; r < 4; ++r) {
        const int e = item * 32 + wave * 4 + r;
#pragma unroll
        for (int k = 0; k < 4; ++k) {
            const f32x4 p = v[r][k] * g[k];
            unsigned w = __builtin_amdgcn_cvt_scalef32_pk_fp4_f32(0u, p.x, p.y, 1.0f, 0);
            w = __builtin_amdgcn_cvt_scalef32_pk_fp4_f32(w, p.z, p.w, 1.0f, 1);
            unsigned char* dst = isup ? wu + (size_t)e * 512 + k * 128 + lane * 2 : wd + (size_t)k * ((size_t)NEXP * 128) + (size_t)e * 128 + lane * 2;
            *(GAS unsigned short*)dst = (unsigned short)w;
        }
    }
}

__device__ __forceinline__ f32x4 bf4_lo(u32x4 w) { return (f32x4){__uint_as_float(w.x << 16), __uint_as_float(w.x & 0xffff0000u), __uint_as_float(w.y << 16), __uint_as_float(w.y & 0xffff0000u)}; }
__device__ __forceinline__ f32x4 bf4_hi(u32x4 w) { return (f32x4){__uint_as_float(w.z << 16), __uint_as_float(w.z & 0xffff0000u), __uint_as_float(w.w << 16), __uint_as_float(w.w & 0xffff0000u)}; }
struct EpiProj {
    static constexpr bool PERM = true, AFTER_DRAIN = false;
    bf16_t* P; const float* r1; const f32x4* rope; const float* decay;
    __device__ __forceinline__ void operator()(const f32x4 (&acc)[2][2][4][2], const pg8::Unit& u, int wr, int wc, int fr, int fq) const {
        const int row0 = u.pm * 256 + wr * 64 + fr, seg = u.pn >> 1;
        float rsv[2][4];
#pragma unroll
        for (int ai = 0; ai < 2; ++ai)
#pragma unroll
            for (int m = 0; m < 4; ++m) rsv[ai][m] = *(const GAS float*)(r1 + row0 + ai * 128 + m * 16);
        if (seg <= 1) {
#pragma unroll
            for (int ai = 0; ai < 2; ++ai) {
                f32x4 ra[4][2], rb[4][2]; float ff[4][2];
#pragma unroll
                for (int m = 0; m < 4; ++m)
#pragma unroll
                    for (int bj = 0; bj < 2; ++bj) {
                        const int row = row0 + ai * 128 + m * 16, c0 = u.pn * 256 + bj * 128 + wc * 32 + 8 * fq;
                        const int pos = row & (SEQ - 1), l = row & 127, head = (c0 & 511) >> 6, jb = (c0 & 63) >> 1;
                        const GAS f32x4* rp = (const GAS f32x4*)rope + ((size_t)pos * 32 + jb) / 2; ra[m][bj] = rp[0]; rb[m][bj] = rp[1];
                        ff[m][bj] = *(const GAS float*)(decay + (seg * 8 + head) * 128 + l);
                    }
#pragma unroll
                for (int m = 0; m < 4; ++m)
#pragma unroll
                    for (int bj = 0; bj < 2; ++bj) {
                        const int row = row0 + ai * 128 + m * 16, c0 = u.pn * 256 + bj * 128 + wc * 32 + 8 * fq;
                        const f32x4 v0 = acc[ai][bj][m][0] * rsv[ai][m], v1 = acc[ai][bj][m][1] * rsv[ai][m];
                        const f32x4 a_ = ra[m][bj], b_ = rb[m][bj]; const float f = ff[m][bj];
                        f32x4 w0, w1;
                        w0.x = (v0.x * a_.x - v0.y * a_.y) * f; w0.y = (v0.y * a_.x + v0.x * a_.y) * f;
                        w0.z = (v0.z * a_.z - v0.w * a_.w) * f; w0.w = (v0.w * a_.z + v0.z * a_.w) * f;
                        w1.x = (v1.x * b_.x - v1.y * b_.y) * f; w1.y = (v1.y * b_.x + v1.x * b_.y) * f;
                        w1.z = (v1.z * b_.z - v1.w * b_.w) * f; w1.w = (v1.w * b_.z + v1.z * b_.w) * f;
                        u32x4 w; w.x = pk2(w0.x, w0.y); w.y = pk2(w0.z, w0.w); w.z = pk2(w1.x, w1.y); w.w = pk2(w1.z, w1.w);
                        *(GAS u32x4*)(P + (size_t)row * NIN + c0) = w;
                    }
            }
        } else {
#pragma unroll
            for (int ai = 0; ai < 2; ++ai)
#pragma unroll
                for (int m = 0; m < 4; ++m)
#pragma unroll
                    for (int bj = 0; bj < 2; ++bj) {
                        const int row = row0 + ai * 128 + m * 16, c0 = u.pn * 256 + bj * 128 + wc * 32 + 8 * fq;
                        f32x4 v0 = acc[ai][bj][m][0] * rsv[ai][m], v1 = acc[ai][bj][m][1] * rsv[ai][m];
                        if (seg == 3) {
#pragma unroll
                            for (int j = 0; j < 4; ++j) { v0[j] = v0[j] / (1.0f + __expf(-v0[j])); v1[j] = v1[j] / (1.0f + __expf(-v1[j])); }
                        } else if (seg == 4) { v0 = v0 * (0.125f * LOG2E); v1 = v1 * (0.125f * LOG2E); }
                        u32x4 w; w.x = pk2(v0.x, v0.y); w.y = pk2(v0.z, v0.w); w.z = pk2(v1.x, v1.y); w.w = pk2(v1.z, v1.w);
                        *(GAS u32x4*)(P + (size_t)row * NIN + c0) = w;
                    }
        }
    }
};
struct EpiX1 {
    static constexpr bool PERM = true, AFTER_DRAIN = false;
    const bf16_t* XB; bf16_t* X1B; bf16_t* ssq;
    __device__ __forceinline__ void operator()(const f32x4 (&acc)[2][2][4][2], const pg8::Unit& u, int wr, int wc, int fr, int fq) const {
        const int row0 = u.pm * 256 + wr * 64 + fr, c00 = u.pn * 256 + wc * 32 + 8 * fq;
        u32x4 xin[2][4][2];
#pragma unroll
        for (int ai = 0; ai < 2; ++ai)
#pragma unroll
            for (int m = 0; m < 4; ++m)
#pragma unroll
                for (int bj = 0; bj < 2; ++bj) xin[ai][m][bj] = *(const GAS u32x4*)(XB + (size_t)(row0 + ai * 128 + m * 16) * DM + c00 + bj * 128);
#pragma unroll
        for (int ai = 0; ai < 2; ++ai)
#pragma unroll
            for (int m = 0; m < 4; ++m) {
                const int row = row0 + ai * 128 + m * 16; float ss = 0.f;
#pragma unroll
                for (int bj = 0; bj < 2; ++bj) {
                    const f32x4 o0 = acc[ai][bj][m][0] + bf4_lo(xin[ai][m][bj]), o1 = acc[ai][bj][m][1] + bf4_hi(xin[ai][m][bj]);
                    u32x4 w; w.x = pk2(o0.x, o0.y); w.y = pk2(o0.z, o0.w); w.z = pk2(o1.x, o1.y); w.w = pk2(o1.z, o1.w);
                    *(GAS u32x4*)(X1B + (size_t)row * DM + c00 + bj * 128) = w;
                    ss += ((o0.x * o0.x + o0.y * o0.y) + (o0.z * o0.z + o0.w * o0.w)) + ((o1.x * o1.x + o1.y * o1.y) + (o1.z * o1.z + o1.w * o1.w));
                }
                ss += __shfl_xor(ss, 16); ss += __shfl_xor(ss, 32);
                if (fq == 0) *(GAS bf16_t*)(ssq + (size_t)row * 16 + u.pn * 4 + wc) = (bf16_t)(pk2(ss, 0.f) & 0xffffu);
            }
    }
};
__device__ __forceinline__ float rs2_from(u32x4 a, u32x4 b) {
    const f32x4 p = bf4_lo(a) + bf4_hi(a) + bf4_lo(b) + bf4_hi(b);
    return 1.0f / sqrtf(((p.x + p.y) + (p.z + p.w)) * (1.0f / DM) + EPSF);
}
__device__ __forceinline__ float row_rs2(const bf16_t* ssq, int row) {
    const GAS u32x4* p = (const GAS u32x4*)(ssq + (size_t)row * 16); return rs2_from(p[0], p[1]);
}
struct EpiQ {
    static constexpr bool PERM = true, AFTER_DRAIN = false;
    bf16_t* Q; const bf16_t* ssq;
    __device__ __forceinline__ void operator()(const f32x4 (&acc)[2][2][4][2], const pg8::Unit& u, int wr, int wc, int fr, int fq) const {
        const int row0 = u.pm * 256 + wr * 64 + fr;
        u32x4 sa[2][4], sb[2][4];
#pragma unroll
        for (int ai = 0; ai < 2; ++ai)
#pragma unroll
            for (int m = 0; m < 4; ++m) { const GAS u32x4* p = (const GAS u32x4*)(ssq + (size_t)(row0 + ai * 128 + m * 16) * 16); sa[ai][m] = p[0]; sb[ai][m] = p[1]; }
#pragma unroll
        for (int ai = 0; ai < 2; ++ai)
#pragma unroll
            for (int m = 0; m < 4; ++m) {
                const int row = row0 + ai * 128 + m * 16; const float rs = rs2_from(sa[ai][m], sb[ai][m]);
#pragma unroll
                for (int bj = 0; bj < 2; ++bj) {
                    const int c0 = u.pn * 256 + bj * 128 + wc * 32 + 8 * fq;
                    const f32x4 v0 = acc[ai][bj][m][0] * rs, v1 = acc[ai][bj][m][1] * rs;
                    u32x4 w; w.x = pk2(v0.x, v0.y); w.y = pk2(v0.z, v0.w); w.z = pk2(v1.x, v1.y); w.w = pk2(v1.z, v1.w);
                    *(GAS u32x4*)(Q + (size_t)row * NQ + c0) = w;
                }
            }
    }
};

#define MFMA32(a, b, c) __builtin_amdgcn_mfma_f32_32x32x16_bf16(a, b, c, 0, 0, 0)
typedef short v4i16_t __attribute__((ext_vector_type(4)));
__device__ __forceinline__ s16x4 vtr(const lds_u8* p) { return __builtin_bit_cast(s16x4, __builtin_amdgcn_ds_read_tr16_b64_v4i16((LAS v4i16_t*)p)); }
__device__ __forceinline__ bf16x8 vfrag(const lds_u8* p) { const s16x4 lo = vtr(p), hi = vtr(p + 512); return (bf16x8){lo[0], lo[1], lo[2], lo[3], hi[0], hi[1], hi[2], hi[3]}; }
__device__ __forceinline__ bf16x8 ldsb128(const lds_u8* p) { return *(const LAS bf16x8*)p; }
__device__ __forceinline__ int crow(int r, int hi) { return (r & 3) + 8 * (r >> 2) + 4 * hi; }
__device__ __forceinline__ void glds16(const void* g, lds_u8* l) {
    unsigned sv; const unsigned lb = (unsigned)__builtin_amdgcn_readfirstlane((int)(unsigned)(uintptr_t)l);
    asm volatile("s_mov_b32 %0, m0\n\ts_mov_b32 m0, %2\n\ts_nop 0\n\tglobal_load_lds_dwordx4 %1, off\n\ts_mov_b32 m0, %0" : "=&s"(sv) : "v"(g), "s"(lb) : "memory");
}
__device__ __forceinline__ float swap_sum(float v) { auto rr = __builtin_amdgcn_permlane32_swap(__float_as_uint(v), __float_as_uint(v), false, false); return __uint_as_float(rr[0]) + __uint_as_float(rr[1]); }
__device__ __forceinline__ float swap_max(float v) { auto rr = __builtin_amdgcn_permlane32_swap(__float_as_uint(v), __float_as_uint(v), false, false); return __builtin_fmaxf(__uint_as_float(rr[0]), __uint_as_float(rr[1])); }

constexpr int ATT_SLOT = 32768, ATT_XCH = 65536, ATT_XPITCH = 528, ATT_BTAB = ATT_XCH + 128 * ATT_XPITCH;
static_assert(ATT_BTAB + 512 <= LDS_SCRATCH, "attention LDS");

template <int MODE>
__device__ __forceinline__ void attn_unit(const Args& a, lds_u8* lds, int b, int h, int qb) {
    int tid_ = threadIdx.x; asm volatile("" : "+v"(tid_));
    const int tid = tid_, lane = tid & 63, r32 = lane & 31, hi = lane >> 5; const int wid = __builtin_amdgcn_readfirstlane(tid >> 6);
    const int rgp = wid & 3, map = wid >> 2;
    const bf16_t* proj = (const bf16_t*)(a.ws + WS_PROJ);
    const size_t rowbase = (size_t)b * SEQ; const int q0 = qb * 128, NT = 2 * qb + 2;
    const float lam = ((const float*)(a.ws + WS_LAM))[0];
    if (tid < 128) ((LAS float*)(lds + ATT_BTAB))[tid] = ((const float*)(a.ws + WS_BTAB))[h * 128 + tid];
    bf16x8 qf[4];
    { const bf16_t* qp = proj + (rowbase + q0 + rgp * 32 + r32) * NIN + OFF_DQ + h * 128 + map * 64 + hi * 8;
#pragma unroll
      for (int s = 0; s < 4; ++s) qf[s] = *(const GAS bf16x8*)(qp + s * 16); }
    asm volatile("" : "+v"(qf[0]), "+v"(qf[1]), "+v"(qf[2]), "+v"(qf[3]));
    const int krow = 8 * wid + (lane >> 3);
    const bf16_t* k1src = proj + (rowbase + krow) * NIN + OFF_DK + h * 128 + ((lane & 7) ^ ((krow >> 1) & 7)) * 8;
    const bf16_t* k2src = k1src + 64;
    const bf16_t* vsrc0 = proj + (rowbase + 16 * ((2 * wid) & 3) + (lane >> 2)) * NIN + OFF_DV + h * 128 + 32 * ((2 * wid) >> 2) + (lane & 3) * 8;
    const bf16_t* vsrc1 = proj + (rowbase + 16 * ((2 * wid + 1) & 3) + (lane >> 2)) * NIN + OFF_DV + h * 128 + 32 * ((2 * wid + 1) >> 2) + (lane & 3) * 8;
#define ATT_DMA(t, slot) do { const size_t go = (size_t)(t) * 64 * NIN; lds_u8* sb = lds + (slot) * ATT_SLOT; \
        glds16(k1src + go, sb + wid * 1024); glds16(k2src + go, sb + 8192 + wid * 1024); \
        glds16(vsrc0 + go, sb + 16384 + (2 * wid) * 1024); glds16(vsrc1 + go, sb + 16384 + (2 * wid + 1) * 1024); } while (0)
    const int koff = map * 8192 + r32 * 128, ksw = (r32 >> 1) & 7;
    const int voff = 16384 + ((lane >> 4) & 1) * 32 + (lane & 3) * 8 + (4 * hi + ((lane & 15) >> 2)) * 64;
    f32x16 o[4];
#pragma unroll
    for (int d = 0; d < 4; ++d) o[d] = f32x16{};
    float mrun = -INFINITY, lrun = 0.f;
    const int qpos = q0 + rgp * 32 + r32;
    float b31 = ((const float*)(a.ws + WS_BTAB))[h * 128 + 127]; asm volatile("" : "+v"(b31));
    ATT_DMA(0, 0);
    for (int t = 0; t < NT; ++t) {
        VM_WAIT(); __syncthreads();
        if (t + 1 < NT && (!(MODE & 8) || t + 1 < 2)) ATT_DMA(t + 1, (t + 1) & 1);
        if (64 * t > q0 + rgp * 32 + 31) continue;
        const lds_u8* sb = lds + (t & 1) * ATT_SLOT;
        const bool nearT = (64 * t + 176 > q0);
        const float cb = nearT ? 0.f : b31;
        f32x16 sA, sB;
        { const float c0 = (t == 0) ? 0.f : cb - mrun;
#pragma unroll
          for (int r = 0; r < 16; ++r) { sA[r] = c0; sB[r] = c0; } }
        if (MODE & 1) {
            bf16x8 kf[8];
#pragma unroll
            for (int d0 = 0; d0 < 4; ++d0) { const int kc = koff + (((2 * d0 + hi) ^ ksw) << 4); if (MODE & 16) { kf[2 * d0] = qf[d0]; kf[2 * d0 + 1] = qf[3 - d0]; } else { kf[2 * d0] = ldsb128(sb + kc); kf[2 * d0 + 1] = ldsb128(sb + kc + 4096); } }
            __builtin_amdgcn_sched_group_barrier(0x100, 8, 0);
#pragma unroll
            for (int d0 = 0; d0 < 4; ++d0) { sA = MFMA32(kf[2 * d0], qf[d0], sA); sB = MFMA32(kf[2 * d0 + 1], qf[d0], sB); }
            __builtin_amdgcn_sched_group_barrier(0x8, 8, 0);
        }
        if (MODE & 4) {
        if (nearT) {
            const LAS float* bt = (const LAS float*)(lds + ATT_BTAB);
#pragma unroll
            for (int r = 0; r < 16; ++r) {
                const int kp = 64 * t + crow(r, hi); int d0 = qpos - kp, d1 = d0 - 32;
                const float b0 = bt[d0 < 0 ? 0 : (d0 > 127 ? 127 : d0)], b1 = bt[d1 < 0 ? 0 : (d1 > 127 ? 127 : d1)];
                sA[r] = d0 < 0 ? -INFINITY : sA[r] + b0; sB[r] = d1 < 0 ? -INFINITY : sB[r] + b1;
            }
        }
#define MX3(a_, b_, c_) __builtin_fmaxf(__builtin_fmaxf((a_), (b_)), (c_))
        float mxa = MX3(sA[0], sA[1], sB[0]), mxb = MX3(sA[2], sA[3], sB[1]); mxa = MX3(mxa, sB[2], sB[3]);
#pragma unroll
        for (int r = 4; r < 16; r += 4) { mxa = MX3(mxa, sA[r], sA[r + 1]); mxb = MX3(mxb, sA[r + 2], sA[r + 3]); mxa = MX3(mxa, sB[r], sB[r + 1]); mxb = MX3(mxb, sB[r + 2], sB[r + 3]); }
#undef MX3
        const float mx = swap_max(__builtin_fmaxf(mxa, mxb));
        if (t == 0 || __any(mx > 6.0f)) {
            const float up = (t == 0) ? mx : __builtin_fmaxf(mx, 0.f), alpha = (t == 0) ? 0.f : __builtin_amdgcn_exp2f(-up);
            mrun = (t == 0) ? mx + cb : mrun + up; lrun *= alpha;
#pragma unroll
            for (int d = 0; d < 4; ++d)
#pragma unroll
                for (int r = 0; r < 16; ++r) o[d][r] *= alpha;
            const float sh = (t == 0) ? mx : up;
#pragma unroll
            for (int r = 0; r < 16; ++r) { sA[r] -= sh; sB[r] -= sh; }
        }
        float ps = 0.f;
#pragma unroll
        for (int r = 0; r < 16; ++r) { sA[r] = __builtin_amdgcn_exp2f(sA[r]); sB[r] = __builtin_amdgcn_exp2f(sB[r]); ps += sA[r] + sB[r]; }
        lrun += ps;
        } else { asm volatile("" : "+v"(sA), "+v"(sB)); }
        u32x4 pw[4];
        pw[0] = (u32x4){pk2(sA[0], sA[1]), pk2(sA[2], sA[3]), pk2(sA[4], sA[5]), pk2(sA[6], sA[7])};
        pw[1] = (u32x4){pk2(sA[8], sA[9]), pk2(sA[10], sA[11]), pk2(sA[12], sA[13]), pk2(sA[14], sA[15])};
        pw[2] = (u32x4){pk2(sB[0], sB[1]), pk2(sB[2], sB[3]), pk2(sB[4], sB[5]), pk2(sB[6], sB[7])};
        pw[3] = (u32x4){pk2(sB[8], sB[9]), pk2(sB[10], sB[11]), pk2(sB[12], sB[13]), pk2(sB[14], sB[15])};
        if (!(MODE & 2)) { asm volatile("" :: "v"(pw[0]), "v"(pw[1]), "v"(pw[2]), "v"(pw[3])); continue; }
        {
            bf16x8 vfa[4], vfb[4];
#pragma unroll
            for (int d = 0; d < 4; ++d) vfa[d] = (MODE & 16) ? qf[d] : vfrag(sb + voff + d * 4096);
            __builtin_amdgcn_sched_group_barrier(0x100, 8, 0);
#pragma unroll
            for (int ks = 0; ks < 4; ks += 2) {
#pragma unroll
                for (int d = 0; d < 4; ++d) vfb[d] = (MODE & 16) ? qf[3 - d] : vfrag(sb + voff + d * 4096 + (ks + 1) * 1024);
                __builtin_amdgcn_sched_group_barrier(0x100, 8, 0);
                { const bf16x8 pb = __builtin_bit_cast(bf16x8, pw[ks]);
#pragma unroll
                  for (int d = 0; d < 4; ++d) o[d] = MFMA32(vfa[d], pb, o[d]); }
                __builtin_amdgcn_sched_group_barrier(0x8, 4, 0);
                if (ks + 2 < 4) {
#pragma unroll
                    for (int d = 0; d < 4; ++d) vfa[d] = (MODE & 16) ? qf[d] : vfrag(sb + voff + d * 4096 + (ks + 2) * 1024);
                    __builtin_amdgcn_sched_group_barrier(0x100, 8, 0);
                }
                { const bf16x8 pb = __builtin_bit_cast(bf16x8, pw[ks + 1]);
#pragma unroll
                  for (int d = 0; d < 4; ++d) o[d] = MFMA32(vfb[d], pb, o[d]); }
                __builtin_amdgcn_sched_group_barrier(0x8, 4, 0);
            }
        }
    }
    const float inv = 1.0f / swap_sum(lrun);
    LAS float* xch = (LAS float*)(lds + ATT_XCH + (rgp * 32 + r32) * ATT_XPITCH);
    if (map == 1) {
        const float sc = inv * lam;
#pragma unroll
        for (int d = 0; d < 4; ++d)
#pragma unroll
            for (int g = 0; g < 4; ++g) *(LAS f32x4*)(xch + 32 * d + 8 * g + 4 * hi) = (f32x4){o[d][4 * g] * sc, o[d][4 * g + 1] * sc, o[d][4 * g + 2] * sc, o[d][4 * g + 3] * sc};
    }
    __syncthreads();
    if (map == 0) {
        float ss = 0.f;
#pragma unroll
        for (int d = 0; d < 4; ++d)
#pragma unroll
            for (int g = 0; g < 4; ++g) { const f32x4 o2 = *(const LAS f32x4*)(xch + 32 * d + 8 * g + 4 * hi);
#pragma unroll
                for (int j = 0; j < 4; ++j) { const float v = o[d][4 * g + j] * inv - o2[j]; o[d][4 * g + j] = v; ss += v * v; } }
        ss = swap_sum(ss);
        const float rn = 0.8f / sqrtf(ss * (1.0f / 128.0f) + EPSF);
        const float* sub = a.in[8];
        bf16_t* mixp = (bf16_t*)(a.ws + WS_MIX) + (rowbase + qpos) * DM + 512 + h * 128;
#pragma unroll
        for (int d = 0; d < 4; ++d)
#pragma unroll
            for (int g = 0; g < 4; ++g) { const int dd = 32 * d + 8 * g + 4 * hi; const f32x4 sv = *(const GAS f32x4*)(sub + dd);
                u32x2 w; w.x = pk2(o[d][4 * g] * rn * sv.x, o[d][4 * g + 1] * rn * sv.y); w.y = pk2(o[d][4 * g + 2] * rn * sv.z, o[d][4 * g + 3] * rn * sv.w);
                *(GAS u32x2*)(mixp + dd) = w; }
    }
    __syncthreads();
#undef ATT_DMA
}

constexpr int RET_BUF = 49152, RET_RT = 2 * RET_BUF, RET_GN = RET_RT + 8192;
static_assert(RET_GN + 2048 <= LDS_SCRATCH, "retention LDS");

__device__ __forceinline__ void ret_unit(const Args& a, lds_u8* lds, int b, int h) {
    int tid_ = threadIdx.x; asm volatile("" : "+v"(tid_));
    const int tid = tid_, lane = tid & 63, r32 = lane & 31, hi = lane >> 5; const int wid = __builtin_amdgcn_readfirstlane(tid >> 6);
    const int rgp = wid & 3, eh = wid >> 2;
    const bf16_t* proj = (const bf16_t*)(a.ws + WS_PROJ);
    const size_t rowbase = (size_t)b * SEQ;
    const double lg = log2(1.0 - exp2(-5.0 - (double)h));
    const float gam = (float)exp2(lg), g127 = (float)exp2(lg * 127.0), g128 = (float)exp2(lg * 128.0);
#define RET_DMA(c, buf) do { const size_t ro = (rowbase + (size_t)(c) * 128) * NIN; lds_u8* bb = lds + (buf) * RET_BUF; \
        _Pragma("unroll") for (int i_ = 0; i_ < 2; ++i_) { const int p_ = 2 * wid + i_; \
            { const int ch = p_ >> 1, rh = p_ & 1; glds16(proj + ro + (size_t)(rh * 64 + lane) * NIN + OFF_RK + h * 64 + ch * 8, bb + ch * 2048 + rh * 1024); } \
            { const int db = p_ >> 3, rg_ = p_ & 7; glds16(proj + ro + (size_t)(rg_ * 16 + (lane >> 2)) * NIN + OFF_RK + h * 64 + db * 32 + (lane & 3) * 8, bb + 16384 + db * 8192 + rg_ * 1024); \
              glds16(proj + ro + (size_t)(rg_ * 16 + (lane >> 2)) * NIN + OFF_RV + h * 64 + db * 32 + (lane & 3) * 8, bb + 32768 + db * 8192 + rg_ * 1024); } } } while (0)
    const int koff = hi * 2048 + r32 * 16;
    const int troff = ((lane >> 4) & 1) * 32 + (lane & 3) * 8 + (4 * hi + ((lane & 15) >> 2)) * 64;
    f32x16 R = f32x16{};
    for (int i = tid; i < 8192 / 16; i += NTHR) *(LAS u32x4*)(lds + RET_RT + i * 16) = (u32x4){0u, 0u, 0u, 0u};
    const float* gn = a.in[3];
    RET_DMA(0, 0);
    for (int c = 0; c < 32; ++c) {
        VM_WAIT(); __syncthreads();
        if (c + 1 < 32) RET_DMA(c + 1, (c + 1) & 1);
        const lds_u8* bb = lds + (c & 1) * RET_BUF;
        const size_t tok = rowbase + (size_t)c * 128 + rgp * 32 + r32;
        bf16x8 qf[4];
        { const bf16_t* qp = proj + tok * NIN + OFF_RQ + h * 64 + hi * 8;
#pragma unroll
          for (int s = 0; s < 4; ++s) qf[s] = *(const GAS bf16x8*)(qp + s * 16); }
        f32x16 O = f32x16{};
#pragma unroll
        for (int s = 0; s < 4; ++s) { const bf16x8 rt = ldsb128(lds + RET_RT + (2 * s + hi) * 1024 + (eh * 32 + r32) * 16); O = MFMA32(rt, qf[s], O); }
        for (int kb = 0; kb <= rgp; ++kb) {
            f32x16 S = f32x16{};
#pragma unroll
            for (int s = 0; s < 4; ++s) { const bf16x8 ka = ldsb128(bb + koff + s * 4096 + (kb * 32) * 16); S = MFMA32(ka, qf[s], S); }
            if (kb == rgp) {
#pragma unroll
                for (int r = 0; r < 16; ++r) S[r] = (crow(r, hi) > r32) ? 0.f : S[r];
            }
            const u32x4 p0 = (u32x4){pk2(S[0], S[1]), pk2(S[2], S[3]), pk2(S[4], S[5]), pk2(S[6], S[7])};
            const u32x4 p1 = (u32x4){pk2(S[8], S[9]), pk2(S[10], S[11]), pk2(S[12], S[13]), pk2(S[14], S[15])};
            const bf16x8 v0 = vfrag(bb + 32768 + eh * 8192 + troff + (2 * kb) * 1024), v1 = vfrag(bb + 32768 + eh * 8192 + troff + (2 * kb + 1) * 1024);
            O = MFMA32(v0, __builtin_bit_cast(bf16x8, p0), O); O = MFMA32(v1, __builtin_bit_cast(bf16x8, p1), O);
        }
        if (rgp < 2) {
            f32x16 T = f32x16{};
#pragma unroll
            for (int ks = 0; ks < 8; ++ks) { const bf16x8 kt = vfrag(bb + 16384 + rgp * 8192 + troff + ks * 1024), vv = vfrag(bb + 32768 + eh * 8192 + troff + ks * 1024); T = MFMA32(kt, vv, T); }
#pragma unroll
            for (int r = 0; r < 16; ++r) R[r] = R[r] * g128 + T[r] * g127;
        }
        float s1 = 0.f, s2 = 0.f;
#pragma unroll
        for (int r = 0; r < 16; ++r) { s1 += O[r]; s2 += O[r] * O[r]; }
        s1 = swap_sum(s1); s2 = swap_sum(s2);
        LAS f32x2* gx = (LAS f32x2*)(lds + RET_GN);
        if (hi == 0) gx[(rgp * 32 + r32) * 2 + eh] = (f32x2){s1, s2};
        __syncthreads();
        if (rgp < 2) {
#pragma unroll
            for (int g = 0; g < 4; ++g) { u32x2 w; w.x = pk2(R[4 * g] * gam, R[4 * g + 1] * gam); w.y = pk2(R[4 * g + 2] * gam, R[4 * g + 3] * gam);
                *(LAS u32x2*)(lds + RET_RT + (rgp * 4 + g) * 1024 + (eh * 32 + r32) * 16 + hi * 8) = w; }
        }
        const f32x2 ga = gx[(rgp * 32 + r32) * 2], gb = gx[(rgp * 32 + r32) * 2 + 1];
        const float mean = (ga.x + gb.x) * (1.0f / 64.0f), var = (ga.y + gb.y) * (1.0f / 64.0f) - mean * mean;
        const float rstd = 1.0f / sqrtf(__builtin_fmaxf(var, 0.f) + EPSF);
        const bf16_t* sg = proj + tok * NIN + OFF_RG + h * 64 + eh * 32;
        bf16_t* mixp = (bf16_t*)(a.ws + WS_MIX) + tok * DM + h * 64 + eh * 32;
#pragma unroll
        for (int g = 0; g < 4; ++g) { const int e = 8 * g + 4 * hi; const u32x2 sv = *(const GAS u32x2*)(sg + e); const f32x4 gv = *(const GAS f32x4*)(gn + h * 64 + eh * 32 + e);
            const float y0 = (O[4 * g] - mean) * rstd * gv.x * __uint_as_float(sv.x << 16), y1 = (O[4 * g + 1] - mean) * rstd * gv.y * __uint_as_float(sv.x & 0xffff0000u);
            const float y2 = (O[4 * g + 2] - mean) * rstd * gv.z * __uint_as_float(sv.y << 16), y3 = (O[4 * g + 3] - mean) * rstd * gv.w * __uint_as_float(sv.y & 0xffff0000u);
            u32x2 w; w.x = pk2(y0, y1); w.y = pk2(y2, y3); *(GAS u32x2*)(mixp + e) = w; }
    }
    __syncthreads();
#undef RET_DMA
}


#define CAS_DESC(x, y) do { const float hi_ = __builtin_fmaxf(x, y), lo_ = __builtin_fminf(x, y); x = hi_; y = lo_; } while (0)
#define CAS_ASC(x, y) do { const float hi_ = __builtin_fmaxf(x, y), lo_ = __builtin_fminf(x, y); x = lo_; y = hi_; } while (0)
__device__ __forceinline__ void sort16_desc(float (&v)[16]) {
#pragma unroll
    for (int k = 2; k <= 16; k <<= 1)
#pragma unroll
        for (int j = k >> 1; j > 0; j >>= 1)
#pragma unroll
            for (int i = 0; i < 16; ++i) { const int l = i ^ j; if (l > i) { if ((i & k) == 0) CAS_DESC(v[i], v[l]); else CAS_ASC(v[i], v[l]); } }
}
__device__ __forceinline__ void bitonic_merge16_desc(float (&v)[16]) {
#pragma unroll
    for (int j = 8; j > 0; j >>= 1)
#pragma unroll
        for (int i = 0; i < 16; ++i) { const int l = i ^ j; if (l > i) CAS_DESC(v[i], v[l]); }
}
__device__ __forceinline__ void merge_top16(float (&a)[16], const float (&b)[16]) {
#pragma unroll
    for (int i = 0; i < 16; ++i) a[i] = __builtin_fmaxf(a[i], b[15 - i]);
    bitonic_merge16_desc(a);
}
__device__ __forceinline__ unsigned pack_idx4(const float (&v)[16], int w) {
    return (__float_as_uint(v[4 * w]) & 127u) | ((__float_as_uint(v[4 * w + 1]) & 127u) << 8) | ((__float_as_uint(v[4 * w + 2]) & 127u) << 16) | ((__float_as_uint(v[4 * w + 3]) & 127u) << 24);
}
__device__ __forceinline__ unsigned lookup_idx(const unsigned (&pk)[4], unsigned i) {
    const unsigned w = i >> 2; unsigned s = w == 0 ? pk[0] : (w == 1 ? pk[1] : (w == 2 ? pk[2] : pk[3]));
    return (s >> ((i & 3u) * 8u)) & 127u;
}

constexpr int P5_KEYB = 32768;
__device__ __forceinline__ void p5_topk(const Args& a, lds_u8* lds) {
    const int tid = threadIdx.x, lane = tid & 63, r32 = lane & 31, hi = lane >> 5; const int wid = __builtin_amdgcn_readfirstlane(tid >> 6);
    const int hp = blockIdx.x & 3, wgi = blockIdx.x >> 2, nwg = (gridDim.x + 3 - hp) / 4;
    const bf16_t* keys = (const bf16_t*)(a.ws + WS_KEYS) + (size_t)hp * 4 * 128 * 128;
    for (int i = tid; i < 4 * 128 * 16; i += NTHR) { const int t = i >> 11, key = (i >> 4) & 127, c = i & 15;
        *(LAS u32x4*)(lds + t * P5_KEYB + c * 2048 + key * 16) = *(const GAS u32x4*)(keys + ((size_t)t * 128 + key) * 128 + c * 8); }
    __syncthreads();
    const bf16_t* Q = (const bf16_t*)(a.ws + WS_PROJ);
    int* IDX = (int*)(a.ws + WS_IDX); float* GATE = (float*)(a.ws + WS_GATE);
    const int tg0 = wgi * NWAVES + wid, tgs = nwg * NWAVES;
    const int ntask = (tg0 < MTOK / 32) ? 4 * ((MTOK / 32 - 1 - tg0) / tgs + 1) : 0;
#define P5_QLOAD(QF, k_) do { const int tg_ = tg0 + ((k_) >> 2) * tgs, t_ = (k_) & 3; \
        const bf16_t* qp = Q + (size_t)(tg_ * 32 + r32) * NQ + (2 * hp + (t_ >> 1)) * 256 + (t_ & 1) * 128 + hi * 8; \
        _Pragma("unroll") for (int s = 0; s < 8; ++s) QF[s] = *(const GAS bf16x8*)(qp + s * 16); } while (0)
    float la[16], lb[16];
#pragma unroll
    for (int r = 0; r < 16; ++r) { la[r] = 0.f; lb[r] = 0.f; }
    bf16x8 qf[8], qn[8];
    if (ntask > 0) P5_QLOAD(qf, 0);
#pragma unroll 1
    for (int k = 0; k < ntask; ++k) {
      {
        const int tg = tg0 + (k >> 2) * tgs, t = k & 3;
        if (k + 1 < ntask) P5_QLOAD(qn, k + 1);
        {
            float top[16];
#pragma unroll
            for (int kb = 0; kb < 4; ++kb) {
                f32x16 S = f32x16{};
#pragma unroll
                for (int s = 0; s < 8; ++s) { const bf16x8 kf = ldsb128(lds + t * P5_KEYB + (2 * s + hi) * 2048 + (kb * 32 + r32) * 16); S = MFMA32(kf, qf[s], S); }
                float v[16];
#pragma unroll
                for (int r = 0; r < 16; ++r) v[r] = __uint_as_float((__float_as_uint(S[r]) & ~127u) | (unsigned)(kb * 32 + (r & 3) + 8 * (r >> 2)) | ((unsigned)hi << 2));
                sort16_desc(v);
                if (kb == 0) {
#pragma unroll
                    for (int r = 0; r < 16; ++r) top[r] = v[r];
                } else merge_top16(top, v);
            }
            float oth[16];
#pragma unroll
            for (int r = 0; r < 16; ++r) { auto rr = __builtin_amdgcn_permlane32_swap(__float_as_uint(top[r]), __float_as_uint(top[r]), false, false); top[r] = __uint_as_float(rr[0]); oth[r] = __uint_as_float(rr[1]); }
            merge_top16(top, oth);
            const bool ka = ((t >> 1) == hi) && ((t & 1) == 0), kb2 = ((t >> 1) == hi) && ((t & 1) == 1);
#pragma unroll
            for (int r = 0; r < 16; ++r) { la[r] = ka ? top[r] : la[r]; lb[r] = kb2 ? top[r] : lb[r]; }
        }
#pragma unroll
        for (int s2 = 0; s2 < 8; ++s2) qf[s2] = qn[s2];
        if (t != 3) continue;
        unsigned pa[4], pb[4];
#pragma unroll
        for (int w = 0; w < 4; ++w) { pa[w] = pack_idx4(la, w); pb[w] = pack_idx4(lb, w); }
        float c0[16], c1[16];
#define CAND(i, j) __uint_as_float((__float_as_uint(la[i] + lb[j]) & ~255u) | (unsigned)((i) * 16 + (j)))
        const float NEG = -INFINITY;
        c0[0] = CAND(0, 0); c0[1] = CAND(0, 1); c0[2] = CAND(0, 2); c0[3] = CAND(0, 3); c0[4] = CAND(0, 4); c0[5] = CAND(0, 5); c0[6] = CAND(0, 6); c0[7] = CAND(0, 7);
        c0[8] = CAND(0, 8); c0[9] = CAND(0, 9); c0[10] = CAND(0, 10); c0[11] = CAND(0, 11); c0[12] = CAND(0, 12); c0[13] = CAND(0, 13); c0[14] = CAND(0, 14); c0[15] = CAND(0, 15);
        sort16_desc(c0);
        c1[0] = CAND(1, 0); c1[1] = CAND(1, 1); c1[2] = CAND(1, 2); c1[3] = CAND(1, 3); c1[4] = CAND(1, 4); c1[5] = CAND(1, 5); c1[6] = CAND(1, 6); c1[7] = CAND(1, 7);
        c1[8] = CAND(2, 0); c1[9] = CAND(2, 1); c1[10] = CAND(2, 2); c1[11] = CAND(2, 3); c1[12] = CAND(2, 4); c1[13] = CAND(3, 0); c1[14] = CAND(3, 1); c1[15] = CAND(3, 2);
        sort16_desc(c1); merge_top16(c0, c1);
        asm volatile("" : "+v"(c0[0]), "+v"(c0[15]));
        c1[0] = CAND(3, 3); c1[1] = CAND(4, 0); c1[2] = CAND(4, 1); c1[3] = CAND(4, 2); c1[4] = CAND(5, 0); c1[5] = CAND(5, 1); c1[6] = CAND(6, 0); c1[7] = CAND(6, 1);
        c1[8] = CAND(7, 0); c1[9] = CAND(7, 1); c1[10] = CAND(8, 0); c1[11] = CAND(9, 0); c1[12] = CAND(10, 0); c1[13] = CAND(11, 0); c1[14] = CAND(12, 0); c1[15] = CAND(13, 0);
        sort16_desc(c1); merge_top16(c0, c1);
        asm volatile("" : "+v"(c0[0]), "+v"(c0[15]));
        c1[0] = CAND(14, 0); c1[1] = CAND(15, 0);
#pragma unroll
        for (int r = 2; r < 16; ++r) c1[r] = NEG;
#undef CAND
        sort16_desc(c1); merge_top16(c0, c1);
        float gsum = 0.f, gv[16]; int ex[16];
        const float mx = __uint_as_float(__float_as_uint(c0[0]) & ~255u);
#pragma unroll
        for (int r = 0; r < 16; ++r) { const unsigned bits = __float_as_uint(c0[r]); const float val = __uint_as_float(bits & ~255u);
            gv[r] = __expf(val - mx); gsum += gv[r];
            ex[r] = (int)(lookup_idx(pa, (bits >> 4) & 15u) * 128u + lookup_idx(pb, bits & 15u)); }
        const float ginv = 1.0f / gsum;
        const size_t ob = (size_t)(tg * 32 + r32) * 128 + (2 * hp + hi) * 16;
#pragma unroll
        for (int r = 0; r < 16; r += 4) { *(GAS u32x4*)(IDX + ob + r) = (u32x4){(unsigned)ex[r], (unsigned)ex[r + 1], (unsigned)ex[r + 2], (unsigned)ex[r + 3]};
            *(GAS f32x4*)(GATE + ob + r) = (f32x4){gv[r] * ginv, gv[r + 1] * ginv, gv[r + 2] * ginv, gv[r + 3] * ginv}; }
      }
    }
#undef P5_QLOAD
    __syncthreads();
}

typedef long i64_t;
typedef int v8i_t __attribute__((ext_vector_type(8)));
#define MFMA16F8(a, b, c) __builtin_amdgcn_mfma_f32_16x16x32_fp8_fp8(a, b, c, 0, 0, 0)
constexpr float P6_SD = 64.f, P6_SX = 8.f, P6_SU = 16.f, P6_SA = 64.f, P6_SU4 = 6.f;
constexpr size_t P6_SLICEB = (size_t)NEXP * 128;
__device__ __forceinline__ unsigned pk4_fp8(float a, float b, float c, float d) { int w = __builtin_amdgcn_cvt_pk_fp8_f32(a, b, 0, false); w = __builtin_amdgcn_cvt_pk_fp8_f32(c, d, w, true); return (unsigned)w; }
__device__ __forceinline__ float fp8_byte0(unsigned w) { return __builtin_amdgcn_cvt_f32_fp8((int)w, 0); }
constexpr int P6_WSCR = 3328;
__device__ __forceinline__ void p6_token(const Args& a, lds_u8* wl, int tok, int lane, float* OUTW) {
    const int n = lane & 15, g = lane >> 4;
    const unsigned char* ws = a.ws;
    const unsigned char* WD = ws + WS_WD; const unsigned char* WU = ws + WS_WU;
    const int* IDX = (const int*)(ws + WS_IDX) + (size_t)tok * 128; const float* GATE = (const float*)(ws + WS_GATE) + (size_t)tok * 128;
    const bf16_t* X1 = (const bf16_t*)(ws + WS_X1B) + (size_t)tok * DM;
    {
#pragma unroll
        for (int j = 0; j < 4; ++j) {
            const u32x2 xw_ = *(const GAS u32x2*)(X1 + 256 * j + 4 * lane); const f32x4 v = (f32x4){__uint_as_float(xw_.x << 16), __uint_as_float(xw_.x & 0xffff0000u), __uint_as_float(xw_.y << 16), __uint_as_float(xw_.y & 0xffff0000u)} * P6_SX;
            const unsigned hw = pk4_fp8(v.x, v.y, v.z, v.w);
            const float r0 = v.x - __builtin_amdgcn_cvt_f32_fp8((int)hw, 0), r1 = v.y - __builtin_amdgcn_cvt_f32_fp8((int)hw, 1), r2 = v.z - __builtin_amdgcn_cvt_f32_fp8((int)hw, 2), r3 = v.w - __builtin_amdgcn_cvt_f32_fp8((int)hw, 3);
            const unsigned lw = pk4_fp8(r0 * 16.f, r1 * 16.f, r2 * 16.f, r3 * 16.f);
            *(LAS unsigned*)(wl + 256 * j + 4 * lane) = hw; *(LAS unsigned*)(wl + 1024 + 256 * j + 4 * lane) = lw;
        }
        const u32x2 iv = *(const GAS u32x2*)(IDX + lane * 2); *(LAS u32x2*)(wl + 2048 + lane * 8) = iv;
    }
    const float rs2 = row_rs2((const bf16_t*)(ws + WS_SSQ), tok);
    LDS_WAIT();
    const LAS int* idxl = (const LAS int*)(wl + 2048); LAS unsigned short* actl = (LAS unsigned short*)(wl + 2560);
    const int xoff = (n & 1) * 1024 + 16 * g;
#pragma unroll 1
    for (int eg = 0; eg < 8; ++eg) {
        const int e = idxl[eg * 16 + n];
        const unsigned char* rp = WD + (size_t)e * 128 + 16 * g;
        f32x4 acc = (f32x4){0.f, 0.f, 0.f, 0.f};
        u32x4 bq[16];
#pragma unroll
        for (int sl = 0; sl < 8; ++sl) { bq[2 * sl] = *(const GAS u32x4*)(rp + sl * P6_SLICEB); bq[2 * sl + 1] = *(const GAS u32x4*)(rp + sl * P6_SLICEB + 64); }
#pragma unroll
        for (int sl = 0; sl < 8; ++sl)
#pragma unroll
            for (int hf = 0; hf < 2; ++hf) {
                const u32x4 xa = *(const LAS u32x4*)(wl + xoff + sl * 128 + hf * 64); const u32x4 bb = bq[2 * sl + hf];
                acc = MFMA16F8((i64_t)(((unsigned long long)xa.y << 32) | xa.x), (i64_t)(((unsigned long long)bb.y << 32) | bb.x), acc);
                acc = MFMA16F8((i64_t)(((unsigned long long)xa.w << 32) | xa.z), (i64_t)(((unsigned long long)bb.w << 32) | bb.z), acc);
            }
        const float av = (acc[0] + acc[1] * 0.0625f) * (rs2 * (1.0f / (P6_SD * P6_SX)));
        const float act = 0.5f * av * (1.0f + erff(av * 0.70710678118654752f)) * GATE[eg * 16 + n] * P6_SA;
        const unsigned hb = pk4_fp8(act, 0.f, 0.f, 0.f) & 0xffu;
        const unsigned lb = pk4_fp8((act - fp8_byte0(hb)) * 16.f, 0.f, 0.f, 0.f) & 0xffu;
        if (g == 0) actl[eg * 16 + n] = (unsigned short)(hb | (lb << 8));
    }
    LDS_WAIT();
    const int pos = n & 7, sel = n >> 3;
    float ss = 0.f;
    const bool owner = (n < 8) && (g < 2);
#pragma unroll 1
    for (int sl = 0; sl < 8; ++sl) {
        f32x4 ah[2], al[2];
#pragma unroll
        for (int s = 0; s < 2; ++s) { ah[s] = (f32x4){0.f, 0.f, 0.f, 0.f}; al[s] = (f32x4){0.f, 0.f, 0.f, 0.f}; }
        u32x4 bq[16]; unsigned av[16];
#pragma unroll
        for (int q = 0; q < 16; ++q) { const int ei = 8 * q + 4 * sel + g; const int e = idxl[ei]; av[q] = actl[ei];
            bq[q] = *(const GAS u32x4*)(WU + sl * P6_SLICEB + (size_t)e * 128 + 16 * pos); }
#pragma unroll
        for (int q = 0; q < 16; ++q) {
            const unsigned long long ahv = (unsigned long long)(av[q] & 0xffu) << (8 * pos), alv = (unsigned long long)(av[q] >> 8) << (8 * pos);
            const u32x4 bb = bq[q];
            const i64_t b0 = (i64_t)(((unsigned long long)bb.y << 32) | bb.x), b1 = (i64_t)(((unsigned long long)bb.w << 32) | bb.z);
            ah[0] = MFMA16F8((i64_t)ahv, b0, ah[0]); al[0] = MFMA16F8((i64_t)alv, b0, al[0]);
            ah[1] = MFMA16F8((i64_t)ahv, b1, ah[1]); al[1] = MFMA16F8((i64_t)alv, b1, al[1]);
        }
#pragma unroll
        for (int s = 0; s < 2; ++s) {
            f32x4 t = ah[s] + al[s] * 0.0625f, u;
#pragma unroll
            for (int r = 0; r < 4; ++r) u[r] = __shfl(t[r], (lane + 40) & 63);
            const int col = 128 * sl + 16 * pos + 8 * s + 4 * (g & 1);
            const u32x2 xq_ = *(const GAS u32x2*)(X1 + col); const f32x4 xv = (f32x4){__uint_as_float(xq_.x << 16), __uint_as_float(xq_.x & 0xffff0000u), __uint_as_float(xq_.y << 16), __uint_as_float(xq_.y & 0xffff0000u)};
            const f32x4 x2 = xv + (t + u) * (1.0f / (P6_SA * P6_SU));
            if (owner) { ss += (x2.x * x2.x + x2.y * x2.y) + (x2.z * x2.z + x2.w * x2.w); *(GAS f32x4*)(OUTW + (size_t)tok * DM + col) = x2; }
        }
    }
    ss = wave_sum(ss);
    const float rn = 1.0f / sqrtf(ss * (1.0f / DM) + EPSF);
    const float* nf = a.in[16];
    if (owner) {
#pragma unroll
        for (int sl = 0; sl < 8; ++sl)
#pragma unroll
            for (int s = 0; s < 2; ++s) { const int col = 128 * sl + 16 * pos + 8 * s + 4 * g; const f32x4 gv = *(const GAS f32x4*)(nf + col);
                GAS f32x4* op = (GAS f32x4*)(OUTW + (size_t)tok * DM + col); *op = *op * rn * gv; }
    }
}

constexpr int P6S_WAVE = 16384 + 512 + 128;
static_assert(NWAVES * P6S_WAVE <= LDS_SCRATCH, "P6 LDS");
__device__ __forceinline__ float gelu_as(float v) {
    const float av = __builtin_fabsf(v), t = __builtin_amdgcn_rcpf(av * 0.2316418882f + 1.0f);
    float q = t * 0.5307027145f + (-0.7265760135f); q = q * t + 0.7107068705f; q = q * t + (-0.142248368f); q = q * t + 0.127414796f; q = q * t;
    const float e = __builtin_amdgcn_exp2f((v * v) * (-0.72134752044f));
    const float m = v * (q * e);
    return v < 0.f ? m : v - m;
}
template <int EMASK, int PARTS>
__device__ __forceinline__ void p6_slices(const Args& a, lds_u8* wl, int tok0, int lane) {
    const int n = lane & 15, g = lane >> 4;
    const unsigned char* ws = a.ws;
    const unsigned char* WD = ws + WS_WD; const unsigned char* WU = ws + WS_WU;
    LAS float* aacc = (LAS float*)wl; LAS unsigned short* idl = (LAS unsigned short*)(wl + 8192); LAS unsigned short* actl = (LAS unsigned short*)(wl + 12288);
    lds_u8* xs = wl + 16384; LAS float* ssl = (LAS float*)(wl + 16384 + 512); LAS float* r2l = ssl + 16;
#pragma unroll 1
    for (int t = 0; t < 16; ++t) {
        const u32x2 iv = *(const GAS u32x2*)((const int*)(ws + WS_IDX) + (size_t)(tok0 + t) * 128 + lane * 2);
        *(LAS unsigned*)(wl + 8192 + t * 256 + lane * 4) = (iv.x & 0xffffu) | (iv.y << 16);
        *(LAS f32x2*)(wl + t * 512 + lane * 8) = (f32x2){0.f, 0.f};
    }
    if (lane < 16) { ssl[lane] = 0.f; r2l[lane] = row_rs2((const bf16_t*)(ws + WS_SSQ), tok0 + lane); }
    unsigned char* X4 = (unsigned char*)a.ws + WS_XB;
#pragma unroll 1
    for (int t = 0; t < 16; ++t) {
        const bf16_t* xr = (const bf16_t*)(ws + WS_X1B) + (size_t)(tok0 + t) * DM + 16 * lane;
        const u32x4 xw0 = *(const GAS u32x4*)xr, xw1 = *(const GAS u32x4*)(xr + 8);
        float rr[16];
#pragma unroll
        for (int j = 0; j < 4; ++j) { rr[2 * j] = __uint_as_float(xw0[j] << 16); rr[2 * j + 1] = __uint_as_float(xw0[j] & 0xffff0000u); rr[8 + 2 * j] = __uint_as_float(xw1[j] << 16); rr[9 + 2 * j] = __uint_as_float(xw1[j] & 0xffff0000u); }
#pragma unroll
        for (int st = 0; st < 4; ++st) {
            unsigned w0 = 0u, w1 = 0u;
#define P6_Q4(p_) do { w0 = __builtin_amdgcn_cvt_scalef32_pk_fp4_f32(w0, rr[2 * (p_)], rr[2 * (p_) + 1], 1.0f, p_); w1 = __builtin_amdgcn_cvt_scalef32_pk_fp4_f32(w1, rr[8 + 2 * (p_)], rr[9 + 2 * (p_)], 1.0f, p_); } while (0)
            P6_Q4(0); P6_Q4(1); P6_Q4(2); P6_Q4(3);
#undef P6_Q4
#define P6_D4(p_) do { const f32x2 d0 = __builtin_amdgcn_cvt_scalef32_pk_f32_fp4(w0, 1.0f, p_), d1 = __builtin_amdgcn_cvt_scalef32_pk_f32_fp4(w1, 1.0f, p_); \
                rr[2 * (p_)] = (rr[2 * (p_)] - d0.x) * 4.0f; rr[2 * (p_) + 1] = (rr[2 * (p_) + 1] - d0.y) * 4.0f; rr[8 + 2 * (p_)] = (rr[8 + 2 * (p_)] - d1.x) * 4.0f; rr[9 + 2 * (p_)] = (rr[9 + 2 * (p_)] - d1.y) * 4.0f; } while (0)
            P6_D4(0); P6_D4(1); P6_D4(2); P6_D4(3);
#undef P6_D4
            *(GAS u32x2*)(X4 + (size_t)(tok0 + t) * 2048 + st * 512 + 8 * lane) = (u32x2){w0, w1};
        }
    }
    LDS_WAIT(); VM_WAIT();
    const int xoff = (n & 3) * 128 + 16 * g;
    const int bpa = 4 * (4 * (lane & 15) + (lane >> 4));
#define MFMA4(a_, b_, c_) __builtin_amdgcn_mfma_scale_f32_16x16x128_f8f6f4(a_, b_, c_, 4  , 4  , 0, 0, 0, 0)
#define P6_DLOAD(BQ, XV, it_) do { const int sl_ = (it_) >> 4, t_ = (it_) & 15; \
        _Pragma("unroll") for (int eg = 0; eg < 8; ++eg) { const int e_ = idl[t_ * 128 + eg * 16 + (lane >> 2)] & EMASK; const unsigned char* rp_ = WD + sl_ * P6_SLICEB + (size_t)e_ * 128 + 16 * (lane & 3); \
            BQ[2 * eg] = *(const GAS u32x4*)rp_; BQ[2 * eg + 1] = *(const GAS u32x4*)(rp_ + 64); } \
        XV = *(const GAS u32x2*)(X4 + (size_t)(tok0 + t_) * 2048 + (lane >> 4) * 512 + sl_ * 128 + 8 * (lane & 15)); } while (0)
#define P6_DCOMP(BQ, XV, it_) do { const int t_ = (it_) & 15; \
        *(LAS u32x2*)(xs + (lane >> 4) * 128 + 8 * (lane & 15)) = XV; \
        LDS_WAIT(); \
        const u32x4 xa0 = *(const LAS u32x4*)(xs + xoff), xa1 = *(const LAS u32x4*)(xs + xoff + 64); \
        const v8i_t A0 = (v8i_t){(int)xa0.x, (int)xa0.y, (int)xa0.z, (int)xa0.w, 0, 0, 0, 0}; \
        const v8i_t A1 = (v8i_t){(int)xa1.x, (int)xa1.y, (int)xa1.z, (int)xa1.w, 0, 0, 0, 0}; \
        _Pragma("unroll") for (int eg = 0; eg < 8; ++eg) { f32x4 acc = (f32x4){0.f, 0.f, 0.f, 0.f}; v8i_t b0 = (v8i_t){0, 0, 0, 0, 0, 0, 0, 0}, b1 = (v8i_t){0, 0, 0, 0, 0, 0, 0, 0}; \
            _Pragma("unroll") for (int w_ = 0; w_ < 4; ++w_) { b0[w_] = __builtin_amdgcn_ds_bpermute(bpa, (int)BQ[2 * eg][w_]); b1[w_] = __builtin_amdgcn_ds_bpermute(bpa, (int)BQ[2 * eg + 1][w_]); } \
            acc = MFMA4(A0, b0, acc); acc = MFMA4(A1, b1, acc); \
            float r_ = (acc[0] + acc[1] * 0.25f) + (acc[2] * 0.0625f + acc[3] * 0.015625f); asm volatile("" : "+v"(r_)); \
            if (g == 0) aacc[t_ * 128 + eg * 16 + n] += r_; } \
        LDS_WAIT(); } while (0)
    if (PARTS & 1) {
        u32x4 bqA[16], bqB[16]; u32x2 xvA, xvB;
        P6_DLOAD(bqA, xvA, 0);
#pragma unroll 1
        for (int it = 0; it < 64; it += 2) {
            P6_DLOAD(bqB, xvB, it + 1);
            P6_DCOMP(bqA, xvA, it);
            if (it + 2 < 64) P6_DLOAD(bqA, xvA, it + 2);
            P6_DCOMP(bqB, xvB, it + 1);
        }
    }
#undef MFMA4
#undef P6_DLOAD
#undef P6_DCOMP
    int lane_g = lane; asm volatile("" : "+v"(lane_g));
#pragma unroll 1
    for (int t = 0; t < 16; ++t) {
        const float sc = r2l[t] * (1.0f / P6_SD);
#pragma unroll
        for (int j = 0; j < 2; ++j) { const int ei = lane_g + 64 * j; const float av = aacc[t * 128 + ei] * sc;
            const float act = gelu_as(av) * ((const float*)(ws + WS_GATE))[(size_t)(tok0 + t) * 128 + ei];
            const unsigned ab = __float_as_uint(act), eb = (ab >> 23) & 255u;
            unsigned pk = 0u;
            if (eb > 4u) {
                const float m = __uint_as_float((ab & 0x807fffffu) | (128u << 23));
                const unsigned w0 = __builtin_amdgcn_cvt_scalef32_pk_fp4_f32(0u, m, 0.f, 1.0f, 0);
                const f32x2 d0 = __builtin_amdgcn_cvt_scalef32_pk_f32_fp4(w0, 1.0f, 0);
                const unsigned w1 = __builtin_amdgcn_cvt_scalef32_pk_fp4_f32(0u, (m - d0.x) * 4.0f, 0.f, 1.0f, 0);
                pk = (w0 & 15u) | ((w1 & 15u) << 4) | ((eb - 1u) << 8);
            }
            actl[t * 128 + ei] = (unsigned short)pk; }
    }
    LDS_WAIT();
    int lane_u = lane; asm volatile("" : "+v"(lane_u));
    const float* nf = a.in[16];
    const int ui = lane_u & 31, ug = lane_u >> 5, ush = 4 * (ui & 7);
    const unsigned uk0 = (ui >> 3) == 0 ? 0xffffffffu : 0u, uk1 = (ui >> 3) == 1 ? 0xffffffffu : 0u, uk2 = (ui >> 3) == 2 ? 0xffffffffu : 0u, uk3 = (ui >> 3) == 3 ? 0xffffffffu : 0u;
#define MFMA32S(a_, b_, c_, sa_) __builtin_amdgcn_mfma_scale_f32_32x32x64_f8f6f4(a_, b_, c_, 4, 4, 0, sa_, 0, 127)
#define P6_ULOAD(BQ, sq_) do { const int t_ = (sq_) >> 3, qs_ = (sq_) & 7; \
        _Pragma("unroll") for (int q = 0; q < 8; ++q) { const int e_ = idl[t_ * 128 + 2 * (8 * qs_ + q) + ug] & EMASK; \
            BQ[q] = *(const GAS u32x4*)(WU + (size_t)e_ * 512 + 16 * ui); } } while (0)
#define P6_UMMA(BQ, sq_) do { const int t_ = (sq_) >> 3, qs_ = (sq_) & 7; \
        _Pragma("unroll") for (int q = 0; q < 8; ++q) { \
            const unsigned av_ = actl[t_ * 128 + 2 * (8 * qs_ + q) + ug]; \
            const unsigned w0_ = (av_ & 15u) << ush, w1_ = ((av_ >> 4) & 15u) << ush; const int s0_ = (int)(av_ >> 8), s1_ = s0_ - 2; \
            const u32x4 bb = BQ[q]; const v8i_t B_ = (v8i_t){(int)bb.x, (int)bb.y, (int)bb.z, (int)bb.w, 0, 0, 0, 0}; \
            uacc = MFMA32S(((v8i_t){(int)(w0_ & uk0), (int)(w0_ & uk1), (int)(w0_ & uk2), (int)(w0_ & uk3), 0, 0, 0, 0}), B_, uacc, s0_); \
            uacc = MFMA32S(((v8i_t){(int)(w1_ & uk0), (int)(w1_ & uk1), (int)(w1_ & uk2), (int)(w1_ & uk3), 0, 0, 0, 0}), B_, uacc, s1_); } } while (0)
#define P6_UEPI(sq_) do { const int t_ = (sq_) >> 3; \
        float* orow = a.out + (size_t)(tok0 + t_) * DM + 32 * ui + 4 * ug; const bf16_t* xrow = (const bf16_t*)(ws + WS_X1B) + (size_t)(tok0 + t_) * DM + 32 * ui + 4 * ug; \
        f32x4 x2[4]; float ss = 0.f; \
        _Pragma("unroll") for (int gq = 0; gq < 4; ++gq) { \
            const u32x2 xq_ = *(const GAS u32x2*)(xrow + 8 * gq); \
            x2[gq] = (f32x4){__uint_as_float(xq_.x << 16), __uint_as_float(xq_.x & 0xffff0000u), __uint_as_float(xq_.y << 16), __uint_as_float(xq_.y & 0xffff0000u)} \
                + (f32x4){uacc[4 * gq], uacc[4 * gq + 1], uacc[4 * gq + 2], uacc[4 * gq + 3]} * (1.0f / P6_SU4); \
            ss += (x2[gq].x * x2[gq].x + x2[gq].y * x2[gq].y) + (x2[gq].z * x2[gq].z + x2[gq].w * x2[gq].w); } \
        const float rn = 1.0f / sqrtf(wave_sum(ss) * (1.0f / DM) + EPSF);     \
        _Pragma("unroll") for (int gq = 0; gq < 4; ++gq) { const f32x4 gv = *(const GAS f32x4*)(nf + 32 * ui + 4 * ug + 8 * gq); *(GAS f32x4*)(orow + 8 * gq) = x2[gq] * rn * gv; } \
        uacc = f32x16{}; } while (0)
    if (PARTS & 2) {
        u32x4 bqA[8], bqB[8]; f32x16 uacc = f32x16{};
        P6_ULOAD(bqA, 0);
#pragma unroll 1
        for (int sq = 0; sq < 128; sq += 2) {
            P6_ULOAD(bqB, sq + 1);
            P6_UMMA(bqA, sq);
            if (sq + 2 < 128) P6_ULOAD(bqA, sq + 2);
            P6_UMMA(bqB, sq + 1);
            if (((sq + 1) & 7) == 7) P6_UEPI(sq + 1);
        }
    }
#undef P6_ULOAD
#undef P6_UMMA
#undef P6_UEPI
#undef MFMA32S
}

#ifndef MK_N_LAUNCHES
#define MK_N_LAUNCHES 1
#endif
constexpr int NPHASE = 7;

__device__ __forceinline__ int queue_next(unsigned* ctr, volatile LAS unsigned* slot) {
    __syncthreads();
    if (threadIdx.x == 0) *slot = __hip_atomic_fetch_add(ctr, 1u, __ATOMIC_RELAXED, __HIP_MEMORY_SCOPE_AGENT);
    __syncthreads();
    return (int)*slot;
}

__global__ void __launch_bounds__(NTHR, 2) hymba_fwd(Args a) {
    extern __shared__ __attribute__((aligned(16))) unsigned char lds_raw[];
    lds_u8* lds = (lds_u8*)lds_raw;
    volatile LAS unsigned* MISC = (volatile LAS unsigned*)(lds + MISC_OFF);
    const int tid = threadIdx.x, lane = tid & 63; const int wave = __builtin_amdgcn_readfirstlane(tid >> 6);
    const int G = gridDim.x; const int bx = blockIdx.x;
    const int vcu = (G % 8 == 0) ? (bx % 8) * (G / 8) + bx / 8 : bx;
    const int gw = vcu * NWAVES + wave, NGW = G * NWAVES;
    for (int u = tid; u < (LDS_BYTES - MISC_OFF) / 4; u += NTHR) MISC[u] = 0u;
    __syncthreads();
    const int lo = a.ph_lo, hi = a.ph_hi;
    const bool use_bar = (hi - lo) > 1;
    XcdBarrier bar; bar.bar = (unsigned*)(a.ws + WS_CTL); bar.x = 0; bar.st = MISC + 8;
    if (use_bar) bar = xcd_barrier_post((unsigned*)(a.ws + WS_CTL), MISC + 8);
#ifndef PH_MASK
#define PH_MASK 127
#endif
#define IN(k) (((PH_MASK >> (k)) & 1) && lo <= (k) && (k) < hi)
#define SEAM(k) do { if (IN(k) && IN((k) + 1)) xcd_barrier(bar); } while (0)
    unsigned char* ws = a.ws;

    if (IN(0)) { p0_prologue(a, lds, gw, NGW, lane, wave);
#ifdef DBL_P0
        __syncthreads(); p0_prologue(a, lds, gw, NGW, lane, wave);
#endif
    }
    SEAM(0);
    if (IN(1)) {
        pg8::Gemm g{(const bf16_t*)(ws + WS_XB), (const bf16_t*)(ws + WS_WIN), MTOK, NIN, DM}; pg8::StaticOrder S; S.init(MTOK, NIN, G, bx);
        EpiProj E{(bf16_t*)(ws + WS_PROJ), (const float*)(ws + WS_R1), (const f32x4*)(ws + WS_ROPE), (const float*)(ws + WS_DECAY)};
        pg8::gemm_phase<EpiProj, pg8::StaticOrder>(lds, g, S, E);
#ifdef DBL_P1
        pg8::gemm_phase<EpiProj, pg8::StaticOrder>(lds, g, S, E);
#endif
    }
    SEAM(1);
    if (IN(2)) {
#ifdef DBL_P2
        for (int rep = 0; rep < 2; ++rep) {
        unsigned* ctr = (unsigned*)(ws + WS_CTL + CTL_Q_ATT + rep * 256);
#else
        {
        unsigned* ctr = (unsigned*)(ws + WS_CTL + CTL_Q_ATT);
#endif
        for (;;) {
            int u = queue_next(ctr, MISC + 16);
            if (u >= 64 + 1024 + DEF_ITEMS) break;
            if (u >= 64) { const int i9 = (u - 64) / 9, r9 = (u - 64) % 9; u = (r9 < 4) ? 64 + i9 * 4 + r9 : 64 + 1024 + i9 * 5 + (r9 - 4); }
#ifdef PROBE_P2
            if (rep == 0 && u >= 64 + 1024) continue;
#endif
            if (u >= 64 + 1024) { p0_deferred(a, lds, u - (64 + 1024)); continue; }
#ifdef PROBE_P2
            if (rep == 0) { if (u < 64) { if (PROBE_P2 & 1) ret_unit(a, lds, u >> 3, u & 7); } else if (PROBE_P2 & 2) { const int v = u - 64; attn_unit<PROBE_ATT>(a, lds, (v & 31) >> 2, v & 3, 31 - (v >> 5)); } continue; }
#endif
            if (u < 64) ret_unit(a, lds, u >> 3, u & 7);
            else { const int v = u - 64; attn_unit<7>(a, lds, (v & 31) >> 2, v & 3, 31 - (v >> 5)); }
        }
        }
    }
    SEAM(2);
    if (IN(3)) {
        pg8::Gemm g{(const bf16_t*)(ws + WS_MIX), (const bf16_t*)(ws + WS_WOUT), MTOK, DM, DM}; pg8::StaticOrder S; S.init(MTOK, DM, G, bx);
        EpiX1 E{(const bf16_t*)(ws + WS_XB), (bf16_t*)(ws + WS_X1B), (bf16_t*)(ws + WS_SSQ)};
        pg8::gemm_phase<EpiX1, pg8::StaticOrder>(lds, g, S, E);
    }
    SEAM(3);
    if (IN(4)) {
        pg8::Gemm g{(const bf16_t*)(ws + WS_X1B), (const bf16_t*)(ws + WS_WPQ), MTOK, NQ, DM}; pg8::StaticOrder S; S.init(MTOK, NQ, G, bx);
        EpiQ E{(bf16_t*)(ws + WS_PROJ), (const bf16_t*)(ws + WS_SSQ)};
        pg8::gemm_phase<EpiQ, pg8::StaticOrder>(lds, g, S, E);
#ifdef DBL_P4
        pg8::gemm_phase<EpiQ, pg8::StaticOrder>(lds, g, S, E);
#endif
    }
    SEAM(4);
    if (IN(5)) { p5_topk(a, lds);
#ifdef DBL_P5
        p5_topk(a, lds);
#endif
    }
    SEAM(5);
    if (IN(6)) {
#ifdef P6_TOKEN_MAJOR
        lds_u8* wl = lds + wave * P6_WSCR;
        for (int tok = gw; tok < MTOK; tok += NGW) p6_token(a, wl, tok, lane, a.out);
#else
#ifdef PROBE_EMASK
        for (int tb = gw; tb < MTOK / 16; tb += NGW) p6_slices<PROBE_EMASK, PROBE_PARTS>(a, lds + wave * P6S_WAVE, tb * 16, lane);
#endif
        for (int tb = gw; tb < MTOK / 16; tb += NGW) p6_slices<0xffff, 3>(a, lds + wave * P6S_WAVE, tb * 16, lane);
#endif
    }
#ifdef DBG_DUMP
    if (hi - lo > 1) xcd_barrier(bar);
    {
        for (int m = gw; m < MTOK; m += NGW) {
            for (int c = lane; c < DM; c += 64) {
                float v = 0.f;
#if DBG_DUMP == 1
                v = bf2f(((const bf16_t*)(ws + WS_PROJ))[(size_t)m * NIN + DBG_COL + c]);
#elif DBG_DUMP == 2
                v = (c >= DBG_C0 && c < DBG_C1) ? bf2f(((const bf16_t*)(ws + WS_MIX))[(size_t)m * DM + c]) : 0.f;
#endif
                a.out[(size_t)m * DM + c] = v;
            }
        }
    }
#endif
#undef IN
#undef SEAM
}

extern "C" void kernel_launch(void* const* d_in, const int* in_sizes, int n_in, void* d_out, int out_size, void* d_ws, size_t ws_size, hipStream_t stream) {
    static int grid = 0;
    if (grid == 0) {
        if (n_in != 17 || in_sizes[0] != MTOK * DM || out_size != MTOK * DM || ws_size < WS_END) {
            fprintf(stderr, "kernel_launch: unexpected shapes (n_in %d, in0 %d, out %d, ws %zu < %zu); nothing launched\n", n_in, n_in > 0 ? in_sizes[0] : -1, out_size, ws_size, (size_t)WS_END); grid = -1; return; }
        int dev = 0, cus = 0, per_cu = 0;
        if (hipGetDevice(&dev) != hipSuccess || hipDeviceGetAttribute(&cus, hipDeviceAttributeMultiprocessorCount, dev) != hipSuccess) { fprintf(stderr, "kernel_launch: device query failed\n"); grid = -1; return; }
        if (hipFuncSetAttribute((const void*)hymba_fwd, hipFuncAttributeMaxDynamicSharedMemorySize, LDS_BYTES) != hipSuccess) { fprintf(stderr, "kernel_launch: hipFuncSetAttribute failed\n"); grid = -1; return; }
        if (hipOccupancyMaxActiveBlocksPerMultiprocessor(&per_cu, (const void*)hymba_fwd, NTHR, LDS_BYTES) != hipSuccess || per_cu < 1)
            fprintf(stderr, "kernel_launch: note: occupancy query reports %d workgroups per CU\n", per_cu);
        (void)hipGetLastError();
        grid = cus;
    }
    if (grid < 0) return;
    if (hipMemsetAsync((char*)d_ws + WS_CTL, 0, CTL_BYTES, stream) != hipSuccess) { fprintf(stderr, "kernel_launch: memset failed\n"); return; }
    Args a{};
    for (int i = 0; i < 17; ++i) a.in[i] = (const float*)d_in[i];
    a.out = (float*)d_out; a.ws = (unsigned char*)d_ws;
#if MK_N_LAUNCHES == 1
#ifdef DBG_STOP
    a.ph_lo = 0; a.ph_hi = DBG_STOP + 1;
#else
    a.ph_lo = 0; a.ph_hi = NPHASE;
#endif
    hipLaunchKernelGGL(hymba_fwd, dim3(grid), dim3(NTHR), LDS_BYTES, stream, a);
#else
    for (int p = 0; p < NPHASE; ++p) { a.ph_lo = p; a.ph_hi = p + 1; hipLaunchKernelGGL(hymba_fwd, dim3(grid), dim3(NTHR), LDS_BYTES, stream, a); }
#endif
    const hipError_t le = hipPeekAtLastError();
    if (le != hipSuccess) fprintf(stderr, "kernel_launch: launch failed: %s\n", hipGetErrorName(le));
}
```

```cpp
#include <hip/hip_runtime.h>
#include <cstdio>
#include <cstdint>

namespace pg8 {
#define PG8_LAS __attribute__((address_space(3)))
typedef unsigned short bf16_t;
typedef short bf16x8 __attribute__((ext_vector_type(8)));
typedef float f32x4 __attribute__((ext_vector_type(4)));
typedef unsigned u32x4 __attribute__((ext_vector_type(4)));
constexpr int BM = 256, BK = 64, HALF = 128, HTB = HALF * BK * 2  , STAGE_BYTES = 8 * HTB, NXCD = 8, WGM = 8;

__host__ __device__ __forceinline__ int lds_byte(int r, int c) { const int st = (r >> 4) * 2 + (c >> 5), rr = r & 15, cc = c & 31, ob = rr * 64 + cc * 2; return st * 1024 + (ob ^ (((ob >> 9) & 1) << 5)); }
__host__ __device__ __forceinline__ void stage_rc(int b, int& R, int& C) { const int st = b / 1024, sb = b % 1024, swz = sb ^ (((sb >> 9) & 1) << 5); R = (st >> 1) * 16 + swz / 64; C = (st & 1) * 32 + (swz % 64) / 2; }
__host__ __device__ __forceinline__ int perm32(int rho) { const int n = rho >> 4, i = rho & 15; return 8 * (i >> 2) + 4 * n + (i & 3); }

struct Unit { int pm, pn; };
struct Gemm { const bf16_t* A; const bf16_t* Bt; int M, N, K; };

struct StaticOrder {
    int nM, nN, nwg, G, c;
    __host__ __device__ void init(int M, int N, int G_, int c_) { nM = M / BM; nN = N / BM; nwg = nM * nN; G = G_; c = c_; }
    __host__ __device__ bool next(int i, Unit& u) const {
        const long L = (long)i * G + c; if (L >= nwg) return false;
        int wgid = (int)L; { const int q = nwg / NXCD, r = nwg % NXCD, xcd = wgid % NXCD, off = wgid / NXCD; wgid = (xcd < r ? xcd * (q + 1) : r * (q + 1) + (xcd - r) * q) + off; }
        const int nig = WGM * nN, gid = wgid / nig, fm = gid * WGM, gsz = (nM - fm) < WGM ? (nM - fm) : WGM;
        u.pm = fm + ((wgid % nig) % gsz); u.pn = (wgid % nig) / gsz; return true;
    }
    __device__ __forceinline__ void a_ready(const Unit&) const {}
    __device__ __forceinline__ void done(const Unit&) const {}
};
__device__ __forceinline__ unsigned cvt_pk_bf16(float lo, float hi) { unsigned r; asm volatile("v_cvt_pk_bf16_f32 %0, %1, %2" : "=v"(r) : "v"(lo), "v"(hi)); return r; }
template <class Epi, class Sched>
__device__ __forceinline__ void gemm_phase(PG8_LAS unsigned char* lds, const Gemm g, const Sched& S, const Epi& E) {
    const int tid = threadIdx.x, wid = __builtin_amdgcn_readfirstlane(tid >> 6), lane = tid & 63, wr = wid >> 2, wc = wid & 3, fr = lane & 15, fq = lane >> 4;
    const int K = g.K, nt = K / BK;
    unsigned voffA[2], voffB[2];
#pragma unroll
    for (int i = 0; i < 2; ++i) { int R, C; stage_rc(tid * 16 + i * 8192, R, C); const int Rb = Epi::PERM ? ((R & ~31) + perm32(R & 31)) : R;
        voffA[i] = (unsigned)(R * K + C) * 2u; voffB[i] = (unsigned)(Rb * K + C) * 2u; }
    const size_t kstep = (size_t)(BK * 2);
    const size_t hstep = (size_t)HALF * K * 2;
    const size_t tstep = 2 * hstep;
    const unsigned ldsw = (unsigned)wid * 1024u;
    const int aoff = lds_byte(wr * 64 + fr, fq * 8), boff = lds_byte(wc * 32 + fr, fq * 8);
#define PG8_SA(b, h) (((b) * 2 + (h)) * HTB)
#define PG8_SB(b, h) ((4 + (b) * 2 + (h)) * HTB)
#define PG8_STAGE(bufoff, gbase, voff) do { _Pragma("unroll") for (int _i = 0; _i < 2; ++_i) \
        __builtin_amdgcn_global_load_lds((const unsigned*)((const char*)(gbase) + (voff)[_i]), (PG8_LAS unsigned*)(lds + (bufoff) + ldsw + _i * 8192), 16, 0, 0); } while (0)
#define PG8_LDA(dst, b, h) do { _Pragma("unroll") for (int m = 0; m < 4; ++m) _Pragma("unroll") for (int k = 0; k < 2; ++k) dst[m][k] = *(const PG8_LAS bf16x8*)(lds + PG8_SA(b, h) + aoff + m * 2048 + k * 1024); } while (0)
#define PG8_LDB(dst, b, h) do { _Pragma("unroll") for (int n = 0; n < 2; ++n) _Pragma("unroll") for (int k = 0; k < 2; ++k) dst[n][k] = *(const PG8_LAS bf16x8*)(lds + PG8_SB(b, h) + boff + n * 2048 + k * 1024); } while (0)
#define PG8_MMA(ai, bj, At, Bt) do { __builtin_amdgcn_s_setprio(1); _Pragma("unroll") for (int m = 0; m < 4; ++m) _Pragma("unroll") for (int n = 0; n < 2; ++n) _Pragma("unroll") for (int k = 0; k < 2; ++k) \
        acc[ai][bj][m][n] = __builtin_amdgcn_mfma_f32_16x16x32_bf16(Bt[n][k], At[m][k], acc[ai][bj][m][n], 0, 0, 0); __builtin_amdgcn_s_setprio(0); } while (0)
#define PG8_WAIT_V(n) asm volatile("s_waitcnt vmcnt(" #n ")" ::: "memory")
#define PG8_WAIT_L(n) asm volatile("s_waitcnt lgkmcnt(" #n ")" ::: "memory")
#define PG8_BAR __builtin_amdgcn_s_barrier()
#define PG8_SCHED __builtin_amdgcn_sched_barrier(0)
    Unit cur, nxt; int ui = 0;
    if (!S.next(0, cur)) return;
    f32x4 acc[2][2][4][2];
#pragma unroll
    for (int a = 0; a < 2; ++a)
#pragma unroll
        for (int b = 0; b < 2; ++b)
#pragma unroll
            for (int m = 0; m < 4; ++m)
#pragma unroll
                for (int n = 0; n < 2; ++n) acc[a][b][m][n] = (f32x4){0.f, 0.f, 0.f, 0.f};
    bf16x8 At[4][2], B0[2][2], B1[2][2];
    const char* cA = (const char*)g.A + (size_t)cur.pm * tstep; const char* cB = (const char*)g.Bt + (size_t)cur.pn * tstep;
    S.a_ready(cur);
    PG8_STAGE(PG8_SB(0, 0), cB, voffB); PG8_STAGE(PG8_SA(0, 0), cA, voffA); PG8_STAGE(PG8_SB(0, 1), cB + hstep, voffB); PG8_STAGE(PG8_SA(0, 1), cA + hstep, voffA);
    if (wr == 1) PG8_BAR;
    PG8_WAIT_V(4); PG8_BAR;
    PG8_STAGE(PG8_SB(1, 0), cB + kstep, voffB); PG8_STAGE(PG8_SA(1, 0), cA + kstep, voffA); PG8_STAGE(PG8_SB(1, 1), cB + hstep + kstep, voffB);
    PG8_WAIT_V(6); PG8_BAR;
    for (;;) {
        const bool has_next = S.next(ui + 1, nxt);
        const char* nA = has_next ? (const char*)g.A + (size_t)nxt.pm * tstep : cA; const char* nB = has_next ? (const char*)g.Bt + (size_t)nxt.pn * tstep : cB;
        for (int t = 0; t < nt; t += 2) {
            const bool last = (t == nt - 2);
            const char* a1 = cA + (size_t)(t + 1) * kstep;
            const char* a2 = last ? nA : cA + (size_t)(t + 2) * kstep; const char* b2 = last ? nB : cB + (size_t)(t + 2) * kstep;
            const char* a3 = a2 + kstep; const char* b3 = b2 + kstep;
            if (last && has_next) S.a_ready(nxt);
            PG8_LDB(B0, 0, 0); PG8_SCHED; PG8_LDA(At, 0, 0); PG8_STAGE(PG8_SA(1, 1), a1 + hstep, voffA);
            PG8_WAIT_L(8); PG8_BAR; PG8_WAIT_L(0); PG8_MMA(0, 0, At, B0); PG8_BAR; PG8_SCHED;
            PG8_LDB(B1, 0, 1); PG8_STAGE(PG8_SB(0, 0), b2, voffB);
            PG8_BAR; PG8_WAIT_L(0); PG8_MMA(0, 1, At, B1); PG8_BAR;
            PG8_LDA(At, 0, 1); PG8_STAGE(PG8_SA(0, 0), a2, voffA);
            PG8_BAR; PG8_WAIT_L(0); PG8_MMA(1, 0, At, B0); PG8_BAR; PG8_SCHED;
            PG8_STAGE(PG8_SB(0, 1), b2 + hstep, voffB);
            PG8_WAIT_V(6); PG8_BAR; PG8_MMA(1, 1, At, B1); PG8_BAR;
            PG8_LDB(B0, 1, 0); PG8_SCHED; PG8_LDA(At, 1, 0); PG8_STAGE(PG8_SA(0, 1), a2 + hstep, voffA);
            PG8_WAIT_L(8); PG8_BAR; PG8_WAIT_L(0); PG8_MMA(0, 0, At, B0); PG8_BAR; PG8_SCHED;
            PG8_LDB(B1, 1, 1); PG8_STAGE(PG8_SB(1, 0), b3, voffB);
            PG8_BAR; PG8_WAIT_L(0); PG8_MMA(0, 1, At, B1); PG8_BAR;
            PG8_LDA(At, 1, 1); PG8_STAGE(PG8_SA(1, 0), a3, voffA);
            PG8_BAR; PG8_WAIT_L(0); PG8_MMA(1, 0, At, B0); PG8_BAR; PG8_SCHED;
            PG8_STAGE(PG8_SB(1, 1), b3 + hstep, voffB);
            PG8_WAIT_V(6); PG8_BAR; PG8_MMA(1, 1, At, B1); PG8_BAR;
        }
        if constexpr (!Epi::AFTER_DRAIN) { E(acc, cur, wr, wc, fr, fq); S.done(cur); }
        if (!has_next) break;
#pragma unroll
        for (int a = 0; a < 2; ++a)
#pragma unroll
            for (int b = 0; b < 2; ++b)
#pragma unroll
                for (int m = 0; m < 4; ++m)
#pragma unroll
                    for (int n = 0; n < 2; ++n) acc[a][b][m][n] = (f32x4){0.f, 0.f, 0.f, 0.f};
        cur = nxt; cA = nA; cB = nB; ++ui;
    }
    PG8_WAIT_V(0);
    if (wr == 0) PG8_BAR;
    PG8_BAR;
    if constexpr (Epi::AFTER_DRAIN) { E.fused(acc, cur, wr, wc, fr, fq, lds, wid, lane); S.done(cur); }
#undef PG8_SA
#undef PG8_SB
#undef PG8_STAGE
#undef PG8_LDA
#undef PG8_LDB
#undef PG8_MMA
#undef PG8_WAIT_V
#undef PG8_WAIT_L
#undef PG8_BAR
#undef PG8_SCHED
}
}

#define XB_TMO      128
#define XB_XCNT(j)  (256  + 64 * (j))
#define XB_XSUB(j)  (1280 + 64 * (j))
#define XB_XGEN(j)  (2304 + 64 * (j))
#define XB_TOP      3328
#define XB_TOPGEN   3392
#define XCD_BAR_WORDS 3456
#define XB_SPIN_CAP (1u << 18)
#define LAS __attribute__((address_space(3)))

__device__ __forceinline__ unsigned xb_ld(unsigned* p)              { return __hip_atomic_load(p, __ATOMIC_RELAXED, __HIP_MEMORY_SCOPE_AGENT); }
__device__ __forceinline__ unsigned xb_add(unsigned* p, unsigned v) { return __hip_atomic_fetch_add(p, v, __ATOMIC_RELAXED, __HIP_MEMORY_SCOPE_AGENT); }
__device__ __forceinline__ unsigned xb_xcc_id() { return (unsigned)__builtin_amdgcn_s_getreg((3 << 11) | 20) & 0xFu; }
#define XB_SPIN(cond, bar) do { unsigned _sp = 0; while (cond) { __builtin_amdgcn_s_sleep(1); \
    if ((++_sp & 255u) == 0u) { if (xb_ld(&(bar)[XB_TMO])) break; if (_sp > XB_SPIN_CAP) { atomicAdd(&(bar)[XB_TMO], 1u); break; } } } } while (0)

struct XcdBarrier {
    unsigned* bar; unsigned x;
    volatile LAS unsigned* st;
};

__device__ __forceinline__ XcdBarrier xcd_barrier_post(unsigned* bar, volatile LAS unsigned* st) {
    XcdBarrier b; b.bar = bar; b.x = xb_xcc_id(); b.st = st;
    if (threadIdx.x == 0) (void)xb_add(&bar[XB_XCNT(b.x)], 1u);
    return b;
}
__device__ __forceinline__ void xcd_barrier_complete(unsigned* bar, unsigned x, unsigned& nloc, unsigned& nx) {
    const unsigned G = gridDim.x * gridDim.y * gridDim.z;
    unsigned sum, cnt, mine, sp = 0u;
    for (;;) {
        sum = 0u; cnt = 0u; mine = 0u;
#pragma unroll
        for (unsigned j = 0; j < 16; ++j) { const unsigned c = xb_ld(&bar[XB_XCNT(j)]); sum += c; cnt += (c > 0u) ? 1u : 0u; mine = (j == x) ? c : mine; }
        if (sum == G) break;
        __builtin_amdgcn_s_sleep(1);
        if ((++sp & 255u) == 0u) { if (xb_ld(&bar[XB_TMO])) break; if (sp > XB_SPIN_CAP) { atomicAdd(&bar[XB_TMO], 1u); break; } }
    }
    nloc = mine > 0u ? mine : 1u; nx = cnt > 0u ? cnt : 1u;
}

__device__ __forceinline__ void xcd_barrier(const XcdBarrier& b) {
    asm volatile("s_waitcnt vmcnt(0)" ::: "memory");
    __syncthreads();
    if (threadIdx.x == 0) {
        unsigned* bar = b.bar;
        __builtin_amdgcn_s_waitcnt(0);
        unsigned nloc = b.st[0], nx = b.st[1];
        if (nloc == 0u) { xcd_barrier_complete(bar, b.x, nloc, nx); b.st[0] = nloc; b.st[1] = nx; }
        const unsigned old = xb_add(&bar[XB_XSUB(b.x)], 1u);
        const unsigned gen = old / nloc;
        if (old + 1u == (gen + 1u) * nloc) {
            __builtin_amdgcn_fence(__ATOMIC_RELEASE, "agent");
            asm volatile("s_waitcnt vmcnt(0)" ::: "memory");
            const unsigned og = xb_add(&bar[XB_TOP], 1u);
            const unsigned tg = og / nx;
            if (og + 1u == (tg + 1u) * nx) xb_add(&bar[XB_TOPGEN], 1u);
            else XB_SPIN(xb_ld(&bar[XB_TOPGEN]) == tg, bar);
            __builtin_amdgcn_fence(__ATOMIC_ACQUIRE, "agent");
            xb_add(&bar[XB_XGEN(b.x)], 1u);
            asm volatile("s_waitcnt vmcnt(0)" ::: "memory");
        } else {
            XB_SPIN(xb_ld(&bar[XB_XGEN(b.x)]) == gen, bar);
            __builtin_amdgcn_fence(__ATOMIC_ACQUIRE, "agent");
            asm volatile("s_waitcnt vmcnt(0)" ::: "memory");
        }
    }
    __syncthreads();
}

#define GAS __attribute__((address_space(1)))
typedef unsigned short bf16_t;
typedef short bf16x8 __attribute__((ext_vector_type(8)));
typedef short s16x4 __attribute__((ext_vector_type(4)));
typedef float f32x4 __attribute__((ext_vector_type(4)));
typedef float f32x2 __attribute__((ext_vector_type(2)));
typedef float f32x16 __attribute__((ext_vector_type(16)));
typedef unsigned u32x4 __attribute__((ext_vector_type(4)));
typedef unsigned u32x2 __attribute__((ext_vector_type(2)));
typedef LAS unsigned char lds_u8;

constexpr int MTOK = 32768, DM = 1024, SEQ = 4096, NBATCH = 8, NIN = 3584;
constexpr int OFF_RQ = 0, OFF_RK = 512, OFF_RV = 1024, OFF_RG = 1536, OFF_DQ = 2048, OFF_DK = 2560, OFF_DV = 3072;
constexpr int NEXP = 16384, NQ = 2048;
constexpr float EPSF = 1e-6f, LOG2E = 1.4426950408889634f;
constexpr int NWAVES = 8, NTHR = 512;

constexpr size_t WS_CTL = 0, CTL_BYTES = 65536;
constexpr size_t CTL_Q_ATT = 16384, CTL_Q_P6 = 16384 + 1024;
constexpr size_t WS_R1 = WS_CTL + CTL_BYTES;
constexpr size_t WS_SSQ = WS_R1 + (size_t)MTOK * 4;
constexpr size_t WS_ROPE = WS_SSQ + (size_t)MTOK * 16 * 4;
constexpr size_t WS_DECAY = WS_ROPE + (size_t)SEQ * 32 * 8;
constexpr size_t WS_BTAB = WS_DECAY + 2 * 8 * 128 * 4;
constexpr size_t WS_LAM = WS_BTAB + 4 * 128 * 4;
constexpr size_t WS_WIN = 4u << 20;
constexpr size_t WS_WOUT = WS_WIN + (size_t)NIN * DM * 2;
constexpr size_t WS_WPQ = WS_WOUT + (size_t)DM * DM * 2;
constexpr size_t WS_KEYS = WS_WPQ + (size_t)NQ * DM * 2;
constexpr size_t WS_WD = WS_KEYS + (size_t)8 * 2 * 128 * 128 * 2;
constexpr size_t WS_WU = WS_WD + (size_t)NEXP * DM * 2;
constexpr size_t WS_XB = WS_WU + (size_t)NEXP * DM * 2;
constexpr size_t WS_PROJ = WS_XB + (size_t)MTOK * DM * 2;
constexpr size_t WS_MIX = WS_PROJ + (size_t)MTOK * NIN * 2;
constexpr size_t WS_IDX = WS_MIX, WS_GATE = WS_MIX + (size_t)MTOK * 128 * 4;
constexpr size_t WS_X1B = WS_PROJ + (size_t)MTOK * NQ * 2;
static_assert(WS_X1B + (size_t)MTOK * DM * 2 <= WS_MIX, "ws map");
constexpr size_t WS_END = WS_MIX + (size_t)MTOK * DM * 2;
static_assert(WS_LAM + 256 <= WS_WIN, "ws map");
static_assert(WS_END <= (size_t)512 << 20, "ws map");

constexpr int LDS_SCRATCH = 139264;
constexpr int MISC_OFF = LDS_SCRATCH;
constexpr int LDS_BYTES = 147456;

__device__ __forceinline__ float wave_sum(float v) {
#pragma unroll
    for (int o = 1; o < 64; o <<= 1) v += __shfl_xor(v, o);
    return v;
}
typedef __bf16 bf16v2_t __attribute__((ext_vector_type(2)));
__device__ __forceinline__ unsigned pk2(float lo, float hi) { const bf16v2_t v = {(__bf16)lo, (__bf16)hi}; return __builtin_bit_cast(unsigned, v); }
__device__ __forceinline__ float bf2f(unsigned short b) { return __uint_as_float(((unsigned)b) << 16); }
#define LDS_WAIT() asm volatile("s_waitcnt lgkmcnt(0)" ::: "memory")
#define VM_WAIT() asm volatile("s_waitcnt vmcnt(0)" ::: "memory")

struct Args {
    const float* in[17]; float* out; unsigned char* ws; int ph_lo, ph_hi;
};

template <int MODE>
__device__ __forceinline__ void p0_transpose_item(const float* W, const float* scale, int K, int N, bf16_t* WT, LAS float* scr, int item, int lane) {
    const int nblk = N / 32, kb = item / nblk, nb = item % nblk, k0 = 64 * kb, n0 = 32 * nb;
#pragma unroll 8
    for (int i = 0; i < 32; ++i) { const int kk = 2 * i + (lane >> 5); const float sc = scale ? scale[k0 + kk] : 1.0f; scr[kk * 33 + (lane & 31)] = W[(size_t)(k0 + kk) * N + n0 + (lane & 31)] * sc; }
    LDS_WAIT();
    const int c = lane & 7;
#pragma unroll
    for (int j = 0; j < 4; ++j) { const int n = (lane >> 3) + 8 * j; const LAS float* s = scr + (8 * c) * 33 + n;
        u32x4 o; o.x = pk2(s[0 * 33], s[1 * 33]); o.y = pk2(s[2 * 33], s[3 * 33]); o.z = pk2(s[4 * 33], s[5 * 33]); o.w = pk2(s[6 * 33], s[7 * 33]);
        int nn = n0 + n;
        if (MODE == 1 && nn < 1024) { const int d = nn & 63; nn = (nn & ~63) + ((d < 32) ? 2 * d : 2 * (d - 32) + 1); }
        *(GAS u32x4*)(WT + (size_t)nn * K + k0 + 8 * c) = o; }
    LDS_WAIT();
}

__device__ __forceinline__ int t5_bucket(int n) {
    if (n < 16) return n;
    const float v = logf((float)n / 16.0f) / 2.0794415416798357f * 16.0f;
    int b = 16 + (int)v; return b > 31 ? 31 : b;
}

__device__ __forceinline__ void p0_prologue(const Args& a, lds_u8* lds, int gw, int NGW, int lane, int wave) {
    unsigned char* ws = a.ws;
    const float* x = a.in[0];
    bf16_t* xb = (bf16_t*)(ws + WS_XB); float* r1 = (float*)(ws + WS_R1);
    for (int m0 = gw; m0 < MTOK; m0 += 4 * NGW) {
        f32x4 v[4][4];
#pragma unroll
        for (int r = 0; r < 4; ++r) { const int m = m0 + r * NGW; const GAS f32x4* xr = (const GAS f32x4*)(x + (size_t)(m < MTOK ? m : m0) * DM) + lane;
#pragma unroll
            for (int j = 0; j < 4; ++j) v[r][j] = xr[64 * j]; }
#pragma unroll
        for (int r = 0; r < 4; ++r) { const int m = m0 + r * NGW; if (m >= MTOK) break;
            float s = 0.f;
#pragma unroll
            for (int j = 0; j < 4; ++j) s += (v[r][j].x * v[r][j].x + v[r][j].y * v[r][j].y) + (v[r][j].z * v[r][j].z + v[r][j].w * v[r][j].w);
            s = wave_sum(s);
            GAS u32x2* o8 = (GAS u32x2*)(xb + (size_t)m * DM) + lane;
#pragma unroll
            for (int j = 0; j < 4; ++j) { u32x2 o; o.x = pk2(v[r][j].x, v[r][j].y); o.y = pk2(v[r][j].z, v[r][j].w); o8[64 * j] = o; }
            if (lane == 0) r1[m] = 1.0f / sqrtf(s * (1.0f / DM) + EPSF); }
    }
    {
        LAS float* scr = (LAS float*)(lds + wave * 8704);
        constexpr int I_IN = (DM / 64) * (NIN / 32);
        for (int it = gw; it < I_IN; it += NGW) p0_transpose_item<1>(a.in[2], a.in[1], DM, NIN, (bf16_t*)(ws + WS_WIN), scr, it, lane);
    }
    const int gt = gw * 64 + lane, NGT = NGW * 64;
    {
        f32x2* rope = (f32x2*)(ws + WS_ROPE);
        for (int i = gt; i < SEQ * 32; i += NGT) { const int pos = i >> 5, j = i & 31; const float fr = (float)pow(10000.0, -(double)j / 32.0); const float ang = (float)pos * fr;
            rope[i] = (f32x2){(float)cos((double)ang), (float)sin((double)ang)}; }
        float* dec = (float*)(ws + WS_DECAY);
        for (int i = gt; i < 2 * 8 * 128; i += NGT) { const int l = i & 127, h = (i >> 7) & 7, kk = i >> 10; const double lg = log2(1.0 - exp2(-5.0 - (double)h));
            dec[i] = kk ? (float)(0.125 * exp2(-lg * (double)l)) : (float)exp2(lg * (double)l); }
        float* bt = (float*)(ws + WS_BTAB); const float* rb = a.in[9];
        for (int i = gt; i < 4 * 128; i += NGT) { const int n = i & 127, h = i >> 7; bt[i] = rb[t5_bucket(n) * 4 + h] * LOG2E; }
        if (gt == 0) { float s1 = 0.f, s2 = 0.f; for (int i = 0; i < 64; ++i) { s1 += a.in[4][i] * a.in[5][i]; s2 += a.in[6][i] * a.in[7][i]; }
            ((float*)(ws + WS_LAM))[0] = expf(s1) - expf(s2) + 0.2f; }
    }
}


constexpr int DEF_T0 = 192, DEF_T1 = 64, DEF_T2 = 512, DEF_T3 = 512, DEF_ITEMS = DEF_T0 + DEF_T1 + DEF_T2 + DEF_T3;
__device__ __forceinline__ void p0_deferred(const Args& a, lds_u8* lds, int item) {
    unsigned char* ws = a.ws;
    int tid_ = threadIdx.x; asm volatile("" : "+v"(tid_));
    const int tid = tid_, lane = tid & 63; const int wave = __builtin_amdgcn_readfirstlane(tid >> 6);
    if (item < DEF_T0) {
        LAS float* scr = (LAS float*)(lds + wave * 8704);
        constexpr int I_OUT = (DM / 64) * (DM / 32), I_PQ = (DM / 64) * (NQ / 32);
        static_assert(I_OUT + I_PQ == DEF_T0 * 8, "deferred transposes");
        const int r = item * 8 + wave;
        if (r < I_OUT) p0_transpose_item<0>(a.in[10], nullptr, DM, DM, (bf16_t*)(ws + WS_WOUT), scr, r, lane);
        else p0_transpose_item<0>(a.in[12], a.in[11], DM, NQ, (bf16_t*)(ws + WS_WPQ), scr, r - I_OUT, lane);
        return;
    }
    item -= DEF_T0;
    if (item < DEF_T1) {
        const float* pk = a.in[13]; bf16_t* kb = (bf16_t*)(ws + WS_KEYS);
        const int i = item * 512 + tid;
        const GAS f32x4* s = (const GAS f32x4*)(pk + (size_t)i * 8); const f32x4 p = s[0], q = s[1];
        u32x4 o; o.x = pk2(p.x, p.y); o.y = pk2(p.z, p.w); o.z = pk2(q.x, q.y); o.w = pk2(q.z, q.w); *(GAS u32x4*)(kb + (size_t)i * 8) = o;
        return;
    }
    item -= DEF_T1;
    const float* dn = a.in[14]; const float* up = a.in[15]; const float* gf = a.in[11];
    unsigned char* wd = ws + WS_WD; unsigned char* wu = ws + WS_WU;
    const bool isup = item < DEF_T2; if (!isup) item -= DEF_T2;
    const float* src = (isup ? up : dn) + (size_t)(item * 32 + wave * 4) * DM + lane * 4;
    f32x4 g[4];
#pragma unroll
    for (int k = 0; k < 4; ++k) g[k] = isup ? (f32x4){6.0f, 6.0f, 6.0f, 6.0f} : *(const GAS f32x4*)(gf + k * 256 + lane * 4) * 64.0f;
    f32x4 v[4][4];
#pragma unroll
    for (int r = 0; r < 4; ++r)
#pragma unroll
        for (int k = 0; k < 4; ++k) v[r][k] = *(const GAS f32x4*)(src + (size_t)r * DM + k * 256);
#pragma unroll
    for (int r = 0; r < 4; ++r) {
        const int e = item * 32 + wave * 4 + r;
#pragma unroll
        for (int k = 0; k < 4; ++k) {
            const f32x4 p = v[r][k] * g[k];
            unsigned w = __builtin_amdgcn_cvt_scalef32_pk_fp4_f32(0u, p.x, p.y, 1.0f, 0);
            w = __builtin_amdgcn_cvt_scalef32_pk_fp4_f32(w, p.z, p.w, 1.0f, 1);
            unsigned char* dst = isup ? wu + (size_t)e * 512 + k * 128 + lane * 2 : wd + (size_t)k * ((size_t)NEXP * 128) + (size_t)e * 128 + lane * 2;
            *(GAS unsigned short*)dst = (unsigned short)w;
        }
    }
}

__device__ __forceinline__ f32x4 bf4_lo(u32x4 w) { return (f32x4){__uint_as_float(w.x << 16), __uint_as_float(w.x & 0xffff0000u), __uint_as_float(w.y << 16), __uint_as_float(w.y & 0xffff0000u)}; }
__device__ __forceinline__ f32x4 bf4_hi(u32x4 w) { return (f32x4){__uint_as_float(w.z << 16), __uint_as_float(w.z & 0xffff0000u), __uint_as_float(w.w << 16), __uint_as_float(w.w & 0xffff0000u)}; }
struct EpiProj {
    static constexpr bool PERM = true, AFTER_DRAIN = false;
    bf16_t* P; const float* r1; const f32x4* rope; const float* decay;
    __device__ __forceinline__ void operator()(const f32x4 (&acc)[2][2][4][2], const pg8::Unit& u, int wr, int wc, int fr, int fq) const {
        const int row0 = u.pm * 256 + wr * 64 + fr, seg = u.pn >> 1;
        float rsv[2][4];
#pragma unroll
        for (int ai = 0; ai < 2; ++ai)
#pragma unroll
            for (int m = 0; m < 4; ++m) rsv[ai][m] = *(const GAS float*)(r1 + row0 + ai * 128 + m * 16);
        if (seg <= 1) {
#pragma unroll
            for (int ai = 0; ai < 2; ++ai) {
                f32x4 ra[4][2], rb[4][2]; float ff[4][2];
#pragma unroll
                for (int m = 0; m < 4; ++m)
#pragma unroll
                    for (int bj = 0; bj < 2; ++bj) {
                        const int row = row0 + ai * 128 + m * 16, c0 = u.pn * 256 + bj * 128 + wc * 32 + 8 * fq;
                        const int pos = row & (SEQ - 1), l = row & 127, head = (c0 & 511) >> 6, jb = (c0 & 63) >> 1;
                        const GAS f32x4* rp = (const GAS f32x4*)rope + ((size_t)pos * 32 + jb) / 2; ra[m][bj] = rp[0]; rb[m][bj] = rp[1];
                        ff[m][bj] = *(const GAS float*)(decay + (seg * 8 + head) * 128 + l);
                    }
#pragma unroll
                for (int m = 0; m < 4; ++m)
#pragma unroll
                    for (int bj = 0; bj < 2; ++bj) {
                        const int row = row0 + ai * 128 + m * 16, c0 = u.pn * 256 + bj * 128 + wc * 32 + 8 * fq;
                        const f32x4 v0 = acc[ai][bj][m][0] * rsv[ai][m], v1 = acc[ai][bj][m][1] * rsv[ai][m];
                        const f32x4 a_ = ra[m][bj], b_ = rb[m][bj]; const float f = ff[m][bj];
                        f32x4 w0, w1;
                        w0.x = (v0.x * a_.x - v0.y * a_.y) * f; w0.y = (v0.y * a_.x + v0.x * a_.y) * f;
                        w0.z = (v0.z * a_.z - v0.w * a_.w) * f; w0.w = (v0.w * a_.z + v0.z * a_.w) * f;
                        w1.x = (v1.x * b_.x - v1.y * b_.y) * f; w1.y = (v1.y * b_.x + v1.x * b_.y) * f;
                        w1.z = (v1.z * b_.z - v1.w * b_.w) * f; w1.w = (v1.w * b_.z + v1.z * b_.w) * f;
                        u32x4 w; w.x = pk2(w0.x, w0.y); w.y = pk2(w0.z, w0.w); w.z = pk2(w1.x, w1.y); w.w = pk2(w1.z, w1.w);
                        *(GAS u32x4*)(P + (size_t)row * NIN + c0) = w;
                    }
            }
        } else {
#pragma unroll
            for (int ai = 0; ai < 2; ++ai)
#pragma unroll
                for (int m = 0; m < 4; ++m)
#pragma unroll
                    for (int bj = 0; bj < 2; ++bj) {
                        const int row = row0 + ai * 128 + m * 16, c0 = u.pn * 256 + bj * 128 + wc * 32 + 8 * fq;
                        f32x4 v0 = acc[ai][bj][m][0] * rsv[ai][m], v1 = acc[ai][bj][m][1] * rsv[ai][m];
                        if (seg == 3) {
#pragma unroll
                            for (int j = 0; j < 4; ++j) { v0[j] = v0[j] / (1.0f + __expf(-v0[j])); v1[j] = v1[j] / (1.0f + __expf(-v1[j])); }
                        } else if (seg == 4) { v0 = v0 * (0.125f * LOG2E); v1 = v1 * (0.125f * LOG2E); }
                        u32x4 w; w.x = pk2(v0.x, v0.y); w.y = pk2(v0.z, v0.w); w.z = pk2(v1.x, v1.y); w.w = pk2(v1.z, v1.w);
                        *(GAS u32x4*)(P + (size_t)row * NIN + c0) = w;
                    }
        }
    }
};
struct EpiX1 {
    static constexpr bool PERM = true, AFTER_DRAIN = false;
    const bf16_t* XB; bf16_t* X1B; bf16_t* ssq;
    __device__ __forceinline__ void operator()(const f32x4 (&acc)[2][2][4][2], const pg8::Unit& u, int wr, int wc, int fr, int fq) const {
        const int row0 = u.pm * 256 + wr * 64 + fr, c00 = u.pn * 256 + wc * 32 + 8 * fq;
        u32x4 xin[2][4][2];
#pragma unroll
        for (int ai = 0; ai < 2; ++ai)
#pragma unroll
            for (int m = 0; m < 4; ++m)
#pragma unroll
                for (int bj = 0; bj < 2; ++bj) xin[ai][m][bj] = *(const GAS u32x4*)(XB + (size_t)(row0 + ai * 128 + m * 16) * DM + c00 + bj * 128);
#pragma unroll
        for (int ai = 0; ai < 2; ++ai)
#pragma unroll
            for (int m = 0; m < 4; ++m) {
                const int row = row0 + ai * 128 + m * 16; float ss = 0.f;
#pragma unroll
                for (int bj = 0; bj < 2; ++bj) {
                    const f32x4 o0 = acc[ai][bj][m][0] + bf4_lo(xin[ai][m][bj]), o1 = acc[ai][bj][m][1] + bf4_hi(xin[ai][m][bj]);
                    u32x4 w; w.x = pk2(o0.x, o0.y); w.y = pk2(o0.z, o0.w); w.z = pk2(o1.x, o1.y); w.w = pk2(o1.z, o1.w);
                    *(GAS u32x4*)(X1B + (size_t)row * DM + c00 + bj * 128) = w;
                    ss += ((o0.x * o0.x + o0.y * o0.y) + (o0.z * o0.z + o0.w * o0.w)) + ((o1.x * o1.x + o1.y * o1.y) + (o1.z * o1.z + o1.w * o1.w));
                }
                ss += __shfl_xor(ss, 16); ss += __shfl_xor(ss, 32);
                if (fq == 0) *(GAS bf16_t*)(ssq + (size_t)row * 16 + u.pn * 4 + wc) = (bf16_t)(pk2(ss, 0.f) & 0xffffu);
            }
    }
};
__device__ __forceinline__ float rs2_from(u32x4 a, u32x4 b) {
    const f32x4 p = bf4_lo(a) + bf4_hi(a) + bf4_lo(b) + bf4_hi(b);
    return 1.0f / sqrtf(((p.x + p.y) + (p.z + p.w)) * (1.0f / DM) + EPSF);
}
__device__ __forceinline__ float row_rs2(const bf16_t* ssq, int row) {
    const GAS u32x4* p = (const GAS u32x4*)(ssq + (size_t)row * 16); return rs2_from(p[0], p[1]);
}
struct EpiQ {
    static constexpr bool PERM = true, AFTER_DRAIN = false;
    bf16_t* Q; const bf16_t* ssq;
    __device__ __forceinline__ void operator()(const f32x4 (&acc)[2][2][4][2], const pg8::Unit& u, int wr, int wc, int fr, int fq) const {
        const int row0 = u.pm * 256 + wr * 64 + fr;
        u32x4 sa[2][4], sb[2][4];
#pragma unroll
        for (int ai = 0; ai < 2; ++ai)
#pragma unroll
            for (int m = 0; m < 4; ++m) { const GAS u32x4* p = (const GAS u32x4*)(ssq + (size_t)(row0 + ai * 128 + m * 16) * 16); sa[ai][m] = p[0]; sb[ai][m] = p[1]; }
#pragma unroll
        for (int ai = 0; ai < 2; ++ai)
#pragma unroll
            for (int m = 0; m < 4; ++m) {
                const int row = row0 + ai * 128 + m * 16; const float rs = rs2_from(sa[ai][m], sb[ai][m]);
#pragma unroll
                for (int bj = 0; bj < 2; ++bj) {
                    const int c0 = u.pn * 256 + bj * 128 + wc * 32 + 8 * fq;
                    const f32x4 v0 = acc[ai][bj][m][0] * rs, v1 = acc[ai][bj][m][1] * rs;
                    u32x4 w; w.x = pk2(v0.x, v0.y); w.y = pk2(v0.z, v0.w); w.z = pk2(v1.x, v1.y); w.w = pk2(v1.z, v1.w);
                    *(GAS u32x4*)(Q + (size_t)row * NQ + c0) = w;
                }
            }
    }
};

#define MFMA32(a, b, c) __builtin_amdgcn_mfma_f32_32x32x16_bf16(a, b, c, 0, 0, 0)
typedef short v4i16_t __attribute__((ext_vector_type(4)));
__device__ __forceinline__ s16x4 vtr(const lds_u8* p) { return __builtin_bit_cast(s16x4, __builtin_amdgcn_ds_read_tr16_b64_v4i16((LAS v4i16_t*)p)); }
__device__ __forceinline__ bf16x8 vfrag(const lds_u8* p) { const s16x4 lo = vtr(p), hi = vtr(p + 512); return (bf16x8){lo[0], lo[1], lo[2], lo[3], hi[0], hi[1], hi[2], hi[3]}; }
__device__ __forceinline__ bf16x8 ldsb128(const lds_u8* p) { return *(const LAS bf16x8*)p; }
__device__ __forceinline__ int crow(int r, int hi) { return (r & 3) + 8 * (r >> 2) + 4 * hi; }
__device__ __forceinline__ void glds16(const void* g, lds_u8* l) {
    unsigned sv; const unsigned lb = (unsigned)__builtin_amdgcn_readfirstlane((int)(unsigned)(uintptr_t)l);
    asm volatile("s_mov_b32 %0, m0\n\ts_mov_b32 m0, %2\n\ts_nop 0\n\tglobal_load_lds_dwordx4 %1, off\n\ts_mov_b32 m0, %0" : "=&s"(sv) : "v"(g), "s"(lb) : "memory");
}
__device__ __forceinline__ float swap_sum(float v) { auto rr = __builtin_amdgcn_permlane32_swap(__float_as_uint(v), __float_as_uint(v), false, false); return __uint_as_float(rr[0]) + __uint_as_float(rr[1]); }
__device__ __forceinline__ float swap_max(float v) { auto rr = __builtin_amdgcn_permlane32_swap(__float_as_uint(v), __float_as_uint(v), false, false); return __builtin_fmaxf(__uint_as_float(rr[0]), __uint_as_float(rr[1])); }

constexpr int ATT_SLOT = 32768, ATT_XCH = 65536, ATT_XPITCH = 528, ATT_BTAB = ATT_XCH + 128 * ATT_XPITCH;
static_assert(ATT_BTAB + 512 <= LDS_SCRATCH, "attention LDS");

template <int MODE>
__device__ __forceinline__ void attn_unit(const Args& a, lds_u8* lds, int b, int h, int qb) {
    int tid_ = threadIdx.x; asm volatile("" : "+v"(tid_));
    const int tid = tid_, lane = tid & 63, r32 = lane & 31, hi = lane >> 5; const int wid = __builtin_amdgcn_readfirstlane(tid >> 6);
    const int rgp = wid & 3, map = wid >> 2;
    const bf16_t* proj = (const bf16_t*)(a.ws + WS_PROJ);
    const size_t rowbase = (size_t)b * SEQ; const int q0 = qb * 128, NT = 2 * qb + 2;
    const float lam = ((const float*)(a.ws + WS_LAM))[0];
    if (tid < 128) ((LAS float*)(lds + ATT_BTAB))[tid] = ((const float*)(a.ws + WS_BTAB))[h * 128 + tid];
    bf16x8 qf[4];
    { const bf16_t* qp = proj + (rowbase + q0 + rgp * 32 + r32) * NIN + OFF_DQ + h * 128 + map * 64 + hi * 8;
#pragma unroll
      for (int s = 0; s < 4; ++s) qf[s] = *(const GAS bf16x8*)(qp + s * 16); }
    asm volatile("" : "+v"(qf[0]), "+v"(qf[1]), "+v"(qf[2]), "+v"(qf[3]));
    const int krow = 8 * wid + (lane >> 3);
    const bf16_t* k1src = proj + (rowbase + krow) * NIN + OFF_DK + h * 128 + ((lane & 7) ^ ((krow >> 1) & 7)) * 8;
    const bf16_t* k2src = k1src + 64;
    const bf16_t* vsrc0 = proj + (rowbase + 16 * ((2 * wid) & 3) + (lane >> 2)) * NIN + OFF_DV + h * 128 + 32 * ((2 * wid) >> 2) + (lane & 3) * 8;
    const bf16_t* vsrc1 = proj + (rowbase + 16 * ((2 * wid + 1) & 3) + (lane >> 2)) * NIN + OFF_DV + h * 128 + 32 * ((2 * wid + 1) >> 2) + (lane & 3) * 8;
#define ATT_DMA(t, slot) do { const size_t go = (size_t)(t) * 64 * NIN; lds_u8* sb = lds + (slot) * ATT_SLOT; \
        glds16(k1src + go, sb + wid * 1024); glds16(k2src + go, sb + 8192 + wid * 1024); \
        glds16(vsrc0 + go, sb + 16384 + (2 * wid) * 1024); glds16(vsrc1 + go, sb + 16384 + (2 * wid + 1) * 1024); } while (0)
    const int koff = map * 8192 + r32 * 128, ksw = (r32 >> 1) & 7;
    const int voff = 16384 + ((lane >> 4) & 1) * 32 + (lane & 3) * 8 + (4 * hi + ((lane & 15) >> 2)) * 64;
    f32x16 o[4];
#pragma unroll
    for (int d = 0; d < 4; ++d) o[d] = f32x16{};
    float mrun = -INFINITY, lrun = 0.f;
    const int qpos = q0 + rgp * 32 + r32;
    float b31 = ((const float*)(a.ws + WS_BTAB))[h * 128 + 127]; asm volatile("" : "+v"(b31));
    ATT_DMA(0, 0);
    for (int t = 0; t < NT; ++t) {
        VM_WAIT(); __syncthreads();
        if (t + 1 < NT && (!(MODE & 8) || t + 1 < 2)) ATT_DMA(t + 1, (t + 1) & 1);
        if (64 * t > q0 + rgp * 32 + 31) continue;
        const lds_u8* sb = lds + (t & 1) * ATT_SLOT;
        const bool nearT = (64 * t + 176 > q0);
        const float cb = nearT ? 0.f : b31;
        f32x16 sA, sB;
        { const float c0 = (t == 0) ? 0.f : cb - mrun;
#pragma unroll
          for (int r = 0; r < 16; ++r) { sA[r] = c0; sB[r] = c0; } }
        if (MODE & 1) {
            bf16x8 kf[8];
#pragma unroll
            for (int d0 = 0; d0 < 4; ++d0) { const int kc = koff + (((2 * d0 + hi) ^ ksw) << 4); if (MODE & 16) { kf[2 * d0] = qf[d0]; kf[2 * d0 + 1] = qf[3 - d0]; } else { kf[2 * d0] = ldsb128(sb + kc); kf[2 * d0 + 1] = ldsb128(sb + kc + 4096); } }
            __builtin_amdgcn_sched_group_barrier(0x100, 8, 0);
#pragma unroll
            for (int d0 = 0; d0 < 4; ++d0) { sA = MFMA32(kf[2 * d0], qf[d0], sA); sB = MFMA32(kf[2 * d0 + 1], qf[d0], sB); }
            __builtin_amdgcn_sched_group_barrier(0x8, 8, 0);
        }
        if (MODE & 4) {
        if (nearT) {
            const LAS float* bt = (const LAS float*)(lds + ATT_BTAB);
#pragma unroll
            for (int r = 0; r < 16; ++r) {
                const int kp = 64 * t + crow(r, hi); int d0 = qpos - kp, d1 = d0 - 32;
                const float b0 = bt[d0 < 0 ? 0 : (d0 > 127 ? 127 : d0)], b1 = bt[d1 < 0 ? 0 : (d1 > 127 ? 127 : d1)];
                sA[r] = d0 < 0 ? -INFINITY : sA[r] + b0; sB[r] = d1 < 0 ? -INFINITY : sB[r] + b1;
            }
        }
#define MX3(a_, b_, c_) __builtin_fmaxf(__builtin_fmaxf((a_), (b_)), (c_))
        float mxa = MX3(sA[0], sA[1], sB[0]), mxb = MX3(sA[2], sA[3], sB[1]); mxa = MX3(mxa, sB[2], sB[3]);
#pragma unroll
        for (int r = 4; r < 16; r += 4) { mxa = MX3(mxa, sA[r], sA[r + 1]); mxb = MX3(mxb, sA[r + 2], sA[r + 3]); mxa = MX3(mxa, sB[r], sB[r + 1]); mxb = MX3(mxb, sB[r + 2], sB[r + 3]); }
#undef MX3
        const float mx = swap_max(__builtin_fmaxf(mxa, mxb));
        if (t == 0 || __any(mx > 6.0f)) {
            const float up = (t == 0) ? mx : __builtin_fmaxf(mx, 0.f), alpha = (t == 0) ? 0.f : __builtin_amdgcn_exp2f(-up);
            mrun = (t == 0) ? mx + cb : mrun + up; lrun *= alpha;
#pragma unroll
            for (int d = 0; d < 4; ++d)
#pragma unroll
                for (int r = 0; r < 16; ++r) o[d][r] *= alpha;
            const float sh = (t == 0) ? mx : up;
#pragma unroll
            for (int r = 0; r < 16; ++r) { sA[r] -= sh; sB[r] -= sh; }
        }
        float ps = 0.f;
#pragma unroll
        for (int r = 0; r < 16; ++r) { sA[r] = __builtin_amdgcn_exp2f(sA[r]); sB[r] = __builtin_amdgcn_exp2f(sB[r]); ps += sA[r] + sB[r]; }
        lrun += ps;
        } else { asm volatile("" : "+v"(sA), "+v"(sB)); }
        u32x4 pw[4];
        pw[0] = (u32x4){pk2(sA[0], sA[1]), pk2(sA[2], sA[3]), pk2(sA[4], sA[5]), pk2(sA[6], sA[7])};
        pw[1] = (u32x4){pk2(sA[8], sA[9]), pk2(sA[10], sA[11]), pk2(sA[12], sA[13]), pk2(sA[14], sA[15])};
        pw[2] = (u32x4){pk2(sB[0], sB[1]), pk2(sB[2], sB[3]), pk2(sB[4], sB[5]), pk2(sB[6], sB[7])};
        pw[3] = (u32x4){pk2(sB[8], sB[9]), pk2(sB[10], sB[11]), pk2(sB[12], sB[13]), pk2(sB[14], sB[15])};
        if (!(MODE & 2)) { asm volatile("" :: "v"(pw[0]), "v"(pw[1]), "v"(pw[2]), "v"(pw[3])); continue; }
        {
            bf16x8 vfa[4], vfb[4];
#pragma unroll
            for (int d = 0; d < 4; ++d) vfa[d] = (MODE & 16) ? qf[d] : vfrag(sb + voff + d * 4096);
            __builtin_amdgcn_sched_group_barrier(0x100, 8, 0);
#pragma unroll
            for (int ks = 0; ks < 4; ks += 2) {
#pragma unroll
                for (int d = 0; d < 4; ++d) vfb[d] = (MODE & 16) ? qf[3 - d] : vfrag(sb + voff + d * 4096 + (ks + 1) * 1024);
                __builtin_amdgcn_sched_group_barrier(0x100, 8, 0);
                { const bf16x8 pb = __builtin_bit_cast(bf16x8, pw[ks]);
#pragma unroll
                  for (int d = 0; d < 4; ++d) o[d] = MFMA32(vfa[d], pb, o[d]); }
                __builtin_amdgcn_sched_group_barrier(0x8, 4, 0);
                if (ks + 2 < 4) {
#pragma unroll
                    for (int d = 0; d < 4; ++d) vfa[d] = (MODE & 16) ? qf[d] : vfrag(sb + voff + d * 4096 + (ks + 2) * 1024);
                    __builtin_amdgcn_sched_group_barrier(0x100, 8, 0);
                }
                { const bf16x8 pb = __builtin_bit_cast(bf16x8, pw[ks + 1]);
#pragma unroll
                  for (int d = 0; d < 4; ++d) o[d] = MFMA32(vfb[d], pb, o[d]); }
                __builtin_amdgcn_sched_group_barrier(0x8, 4, 0);
            }
        }
    }
    const float inv = 1.0f / swap_sum(lrun);
    LAS float* xch = (LAS float*)(lds + ATT_XCH + (rgp * 32 + r32) * ATT_XPITCH);
    if (map == 1) {
        const float sc = inv * lam;
#pragma unroll
        for (int d = 0; d < 4; ++d)
#pragma unroll
            for (int g = 0; g < 4; ++g) *(LAS f32x4*)(xch + 32 * d + 8 * g + 4 * hi) = (f32x4){o[d][4 * g] * sc, o[d][4 * g + 1] * sc, o[d][4 * g + 2] * sc, o[d][4 * g + 3] * sc};
    }
    __syncthreads();
    if (map == 0) {
        float ss = 0.f;
#pragma unroll
        for (int d = 0; d < 4; ++d)
#pragma unroll
            for (int g = 0; g < 4; ++g) { const f32x4 o2 = *(const LAS f32x4*)(xch + 32 * d + 8 * g + 4 * hi);
#pragma unroll
                for (int j = 0; j < 4; ++j) { const float v = o[d][4 * g + j] * inv - o2[j]; o[d][4 * g + j] = v; ss += v * v; } }
        ss = swap_sum(ss);
        const float rn = 0.8f / sqrtf(ss * (1.0f / 128.0f) + EPSF);
        const float* sub = a.in[8];
        bf16_t* mixp = (bf16_t*)(a.ws + WS_MIX) + (rowbase + qpos) * DM + 512 + h * 128;
#pragma unroll
        for (int d = 0; d < 4; ++d)
#pragma unroll
            for (int g = 0; g < 4; ++g) { const int dd = 32 * d + 8 * g + 4 * hi; const f32x4 sv = *(const GAS f32x4*)(sub + dd);
                u32x2 w; w.x = pk2(o[d][4 * g] * rn * sv.x, o[d][4 * g + 1] * rn * sv.y); w.y = pk2(o[d][4 * g + 2] * rn * sv.z, o[d][4 * g + 3] * rn * sv.w);
                *(GAS u32x2*)(mixp + dd) = w; }
    }
    __syncthreads();
#undef ATT_DMA
}

constexpr int RET_BUF = 49152, RET_RT = 2 * RET_BUF, RET_GN = RET_RT + 8192;
static_assert(RET_GN + 2048 <= LDS_SCRATCH, "retention LDS");

__device__ __forceinline__ void ret_unit(const Args& a, lds_u8* lds, int b, int h) {
    int tid_ = threadIdx.x; asm volatile("" : "+v"(tid_));
    const int tid = tid_, lane = tid & 63, r32 = lane & 31, hi = lane >> 5; const int wid = __builtin_amdgcn_readfirstlane(tid >> 6);
    const int rgp = wid & 3, eh = wid >> 2;
    const bf16_t* proj = (const bf16_t*)(a.ws + WS_PROJ);
    const size_t rowbase = (size_t)b * SEQ;
    const double lg = log2(1.0 - exp2(-5.0 - (double)h));
    const float gam = (float)exp2(lg), g127 = (float)exp2(lg * 127.0), g128 = (float)exp2(lg * 128.0);
#define RET_DMA(c, buf) do { const size_t ro = (rowbase + (size_t)(c) * 128) * NIN; lds_u8* bb = lds + (buf) * RET_BUF; \
        _Pragma("unroll") for (int i_ = 0; i_ < 2; ++i_) { const int p_ = 2 * wid + i_; \
            { const int ch = p_ >> 1, rh = p_ & 1; glds16(proj + ro + (size_t)(rh * 64 + lane) * NIN + OFF_RK + h * 64 + ch * 8, bb + ch * 2048 + rh * 1024); } \
            { const int db = p_ >> 3, rg_ = p_ & 7; glds16(proj + ro + (size_t)(rg_ * 16 + (lane >> 2)) * NIN + OFF_RK + h * 64 + db * 32 + (lane & 3) * 8, bb + 16384 + db * 8192 + rg_ * 1024); \
              glds16(proj + ro + (size_t)(rg_ * 16 + (lane >> 2)) * NIN + OFF_RV + h * 64 + db * 32 + (lane & 3) * 8, bb + 32768 + db * 8192 + rg_ * 1024); } } } while (0)
    const int koff = hi * 2048 + r32 * 16;
    const int troff = ((lane >> 4) & 1) * 32 + (lane & 3) * 8 + (4 * hi + ((lane & 15) >> 2)) * 64;
    f32x16 R = f32x16{};
    for (int i = tid; i < 8192 / 16; i += NTHR) *(LAS u32x4*)(lds + RET_RT + i * 16) = (u32x4){0u, 0u, 0u, 0u};
    const float* gn = a.in[3];
    f32x4 gv[4];
#pragma unroll
    for (int g = 0; g < 4; ++g) gv[g] = *(const GAS f32x4*)(gn + h * 64 + eh * 32 + 8 * g + 4 * hi);
    bf16x8 qn[4]; u32x2 svn[4];
#define RET_PREF(c) do { const size_t tk_ = rowbase + (size_t)(c) * 128 + rgp * 32 + r32; const bf16_t* qp_ = proj + tk_ * NIN + OFF_RQ + h * 64 + hi * 8; const bf16_t* sg_ = proj + tk_ * NIN + OFF_RG + h * 64 + eh * 32 + 4 * hi; \
        _Pragma("unroll") for (int s = 0; s < 4; ++s) qn[s] = *(const GAS bf16x8*)(qp_ + s * 16); \
        _Pragma("unroll") for (int g = 0; g < 4; ++g) svn[g] = *(const GAS u32x2*)(sg_ + 8 * g); } while (0)
    RET_PREF(0);
    RET_DMA(0, 0);
    for (int c = 0; c < 32; ++c) {
        VM_WAIT(); __syncthreads();
        bf16x8 qf[4]; u32x2 svc[4];
#pragma unroll
        for (int s = 0; s < 4; ++s) { qf[s] = qn[s]; svc[s] = svn[s]; }
        if (c + 1 < 32) { RET_PREF(c + 1); RET_DMA(c + 1, (c + 1) & 1); }
        const lds_u8* bb = lds + (c & 1) * RET_BUF;
        const size_t tok = rowbase + (size_t)c * 128 + rgp * 32 + r32;
        f32x16 O = f32x16{};
#pragma unroll
        for (int s = 0; s < 4; ++s) { const bf16x8 rt = ldsb128(lds + RET_RT + (2 * s + hi) * 1024 + (eh * 32 + r32) * 16); O = MFMA32(rt, qf[s], O); }
        for (int kb = 0; kb <= rgp; ++kb) {
            f32x16 S = f32x16{};
#pragma unroll
            for (int s = 0; s < 4; ++s) { const bf16x8 ka = ldsb128(bb + koff + s * 4096 + (kb * 32) * 16); S = MFMA32(ka, qf[s], S); }
            if (kb == rgp) {
#pragma unroll
                for (int r = 0; r < 16; ++r) S[r] = (crow(r, hi) > r32) ? 0.f : S[r];
            }
            const u32x4 p0 = (u32x4){pk2(S[0], S[1]), pk2(S[2], S[3]), pk2(S[4], S[5]), pk2(S[6], S[7])};
            const u32x4 p1 = (u32x4){pk2(S[8], S[9]), pk2(S[10], S[11]), pk2(S[12], S[13]), pk2(S[14], S[15])};
            const bf16x8 v0 = vfrag(bb + 32768 + eh * 8192 + troff + (2 * kb) * 1024), v1 = vfrag(bb + 32768 + eh * 8192 + troff + (2 * kb + 1) * 1024);
            O = MFMA32(v0, __builtin_bit_cast(bf16x8, p0), O); O = MFMA32(v1, __builtin_bit_cast(bf16x8, p1), O);
        }
        if (rgp < 2) {
            f32x16 T = f32x16{};
#pragma unroll
            for (int ks = 0; ks < 8; ++ks) { const bf16x8 kt = vfrag(bb + 16384 + rgp * 8192 + troff + ks * 1024), vv = vfrag(bb + 32768 + eh * 8192 + troff + ks * 1024); T = MFMA32(kt, vv, T); }
#pragma unroll
            for (int r = 0; r < 16; ++r) R[r] = R[r] * g128 + T[r] * g127;
        }
        float s1 = 0.f, s2 = 0.f;
#pragma unroll
        for (int r = 0; r < 16; ++r) { s1 += O[r]; s2 += O[r] * O[r]; }
        s1 = swap_sum(s1); s2 = swap_sum(s2);
        LAS f32x2* gx = (LAS f32x2*)(lds + RET_GN);
        if (hi == 0) gx[(rgp * 32 + r32) * 2 + eh] = (f32x2){s1, s2};
        __syncthreads();
        if (rgp < 2) {
#pragma unroll
            for (int g = 0; g < 4; ++g) { u32x2 w; w.x = pk2(R[4 * g] * gam, R[4 * g + 1] * gam); w.y = pk2(R[4 * g + 2] * gam, R[4 * g + 3] * gam);
                *(LAS u32x2*)(lds + RET_RT + (rgp * 4 + g) * 1024 + (eh * 32 + r32) * 16 + hi * 8) = w; }
        }
        const f32x2 ga = gx[(rgp * 32 + r32) * 2], gb = gx[(rgp * 32 + r32) * 2 + 1];
        const float mean = (ga.x + gb.x) * (1.0f / 64.0f), var = (ga.y + gb.y) * (1.0f / 64.0f) - mean * mean;
        const float rstd = 1.0f / sqrtf(__builtin_fmaxf(var, 0.f) + EPSF);
        bf16_t* mixp = (bf16_t*)(a.ws + WS_MIX) + tok * DM + h * 64 + eh * 32;
#pragma unroll
        for (int g = 0; g < 4; ++g) { const int e = 8 * g + 4 * hi; const u32x2 sv = svc[g];
            const float y0 = (O[4 * g] - mean) * rstd * gv[g].x * __uint_as_float(sv.x << 16), y1 = (O[4 * g + 1] - mean) * rstd * gv[g].y * __uint_as_float(sv.x & 0xffff0000u);
            const float y2 = (O[4 * g + 2] - mean) * rstd * gv[g].z * __uint_as_float(sv.y << 16), y3 = (O[4 * g + 3] - mean) * rstd * gv[g].w * __uint_as_float(sv.y & 0xffff0000u);
            u32x2 w; w.x = pk2(y0, y1); w.y = pk2(y2, y3); *(GAS u32x2*)(mixp + e) = w; }
    }
    __syncthreads();
#undef RET_DMA
#undef RET_PREF
}


#define CAS_DESC(x, y) do { const float hi_ = __builtin_fmaxf(x, y), lo_ = __builtin_fminf(x, y); x = hi_; y = lo_; } while (0)
#define CAS_ASC(x, y) do { const float hi_ = __builtin_fmaxf(x, y), lo_ = __builtin_fminf(x, y); x = lo_; y = hi_; } while (0)
__device__ __forceinline__ void sort16_desc(float (&v)[16]) {
#pragma unroll
    for (int k = 2; k <= 16; k <<= 1)
#pragma unroll
        for (int j = k >> 1; j > 0; j >>= 1)
#pragma unroll
            for (int i = 0; i < 16; ++i) { const int l = i ^ j; if (l > i) { if ((i & k) == 0) CAS_DESC(v[i], v[l]); else CAS_ASC(v[i], v[l]); } }
}
__device__ __forceinline__ void bitonic_merge16_desc(float (&v)[16]) {
#pragma unroll
    for (int j = 8; j > 0; j >>= 1)
#pragma unroll
        for (int i = 0; i < 16; ++i) { const int l = i ^ j; if (l > i) CAS_DESC(v[i], v[l]); }
}
__device__ __forceinline__ void merge_top16(float (&a)[16], const float (&b)[16]) {
#pragma unroll
    for (int i = 0; i < 16; ++i) a[i] = __builtin_fmaxf(a[i], b[15 - i]);
    bitonic_merge16_desc(a);
}
__device__ __forceinline__ unsigned pack_idx4(const float (&v)[16], int w) {
    return (__float_as_uint(v[4 * w]) & 127u) | ((__float_as_uint(v[4 * w + 1]) & 127u) << 8) | ((__float_as_uint(v[4 * w + 2]) & 127u) << 16) | ((__float_as_uint(v[4 * w + 3]) & 127u) << 24);
}
__device__ __forceinline__ unsigned lookup_idx(const unsigned (&pk)[4], unsigned i) {
    const unsigned w = i >> 2; unsigned s = w == 0 ? pk[0] : (w == 1 ? pk[1] : (w == 2 ? pk[2] : pk[3]));
    return (s >> ((i & 3u) * 8u)) & 127u;
}

constexpr int P5_KEYB = 32768;
__device__ __forceinline__ void p5_topk(const Args& a, lds_u8* lds) {
    const int tid = threadIdx.x, lane = tid & 63, r32 = lane & 31, hi = lane >> 5; const int wid = __builtin_amdgcn_readfirstlane(tid >> 6);
    const int hp = blockIdx.x & 3, wgi = blockIdx.x >> 2, nwg = (gridDim.x + 3 - hp) / 4;
    const bf16_t* keys = (const bf16_t*)(a.ws + WS_KEYS) + (size_t)hp * 4 * 128 * 128;
    for (int i = tid; i < 4 * 128 * 16; i += NTHR) { const int t = i >> 11, key = (i >> 4) & 127, c = i & 15;
        *(LAS u32x4*)(lds + t * P5_KEYB + c * 2048 + key * 16) = *(const GAS u32x4*)(keys + ((size_t)t * 128 + key) * 128 + c * 8); }
    __syncthreads();
    const bf16_t* Q = (const bf16_t*)(a.ws + WS_PROJ);
    int* IDX = (int*)(a.ws + WS_IDX); float* GATE = (float*)(a.ws + WS_GATE);
    const int tg0 = wgi * NWAVES + wid, tgs = nwg * NWAVES;
    const int ntask = (tg0 < MTOK / 32) ? 4 * ((MTOK / 32 - 1 - tg0) / tgs + 1) : 0;
#define P5_QLOAD(QF, k_) do { const int tg_ = tg0 + ((k_) >> 2) * tgs, t_ = (k_) & 3; \
        const bf16_t* qp = Q + (size_t)(tg_ * 32 + r32) * NQ + (2 * hp + (t_ >> 1)) * 256 + (t_ & 1) * 128 + hi * 8; \
        _Pragma("unroll") for (int s = 0; s < 8; ++s) QF[s] = *(const GAS bf16x8*)(qp + s * 16); } while (0)
    float la[16], lb[16];
#pragma unroll
    for (int r = 0; r < 16; ++r) { la[r] = 0.f; lb[r] = 0.f; }
    bf16x8 qf[8], qn[8];
    if (ntask > 0) P5_QLOAD(qf, 0);
#pragma unroll 1
    for (int k = 0; k < ntask; ++k) {
      {
        const int tg = tg0 + (k >> 2) * tgs, t = k & 3;
        if (k + 1 < ntask) P5_QLOAD(qn, k + 1);
        {
            float top[16];
#pragma unroll
            for (int kb = 0; kb < 4; ++kb) {
                f32x16 S = f32x16{};
#pragma unroll
                for (int s = 0; s < 8; ++s) { const bf16x8 kf = ldsb128(lds + t * P5_KEYB + (2 * s + hi) * 2048 + (kb * 32 + r32) * 16); S = MFMA32(kf, qf[s], S); }
                float v[16];
#pragma unroll
                for (int r = 0; r < 16; ++r) v[r] = __uint_as_float((__float_as_uint(S[r]) & ~127u) | (unsigned)(kb * 32 + (r & 3) + 8 * (r >> 2)) | ((unsigned)hi << 2));
                sort16_desc(v);
                if (kb == 0) {
#pragma unroll
                    for (int r = 0; r < 16; ++r) top[r] = v[r];
                } else merge_top16(top, v);
            }
            float oth[16];
#pragma unroll
            for (int r = 0; r < 16; ++r) { auto rr = __builtin_amdgcn_permlane32_swap(__float_as_uint(top[r]), __float_as_uint(top[r]), false, false); top[r] = __uint_as_float(rr[0]); oth[r] = __uint_as_float(rr[1]); }
            merge_top16(top, oth);
            const bool ka = ((t >> 1) == hi) && ((t & 1) == 0), kb2 = ((t >> 1) == hi) && ((t & 1) == 1);
#pragma unroll
            for (int r = 0; r < 16; ++r) { la[r] = ka ? top[r] : la[r]; lb[r] = kb2 ? top[r] : lb[r]; }
        }
#pragma unroll
        for (int s2 = 0; s2 < 8; ++s2) qf[s2] = qn[s2];
        if (t != 3) continue;
        unsigned pa[4], pb[4];
#pragma unroll
        for (int w = 0; w < 4; ++w) { pa[w] = pack_idx4(la, w); pb[w] = pack_idx4(lb, w); }
        float c0[16], c1[16];
#define CAND(i, j) __uint_as_float((__float_as_uint(la[i] + lb[j]) & ~255u) | (unsigned)((i) * 16 + (j)))
        const float NEG = -INFINITY;
        c0[0] = CAND(0, 0); c0[1] = CAND(0, 1); c0[2] = CAND(0, 2); c0[3] = CAND(0, 3); c0[4] = CAND(0, 4); c0[5] = CAND(0, 5); c0[6] = CAND(0, 6); c0[7] = CAND(0, 7);
        c0[8] = CAND(0, 8); c0[9] = CAND(0, 9); c0[10] = CAND(0, 10); c0[11] = CAND(0, 11); c0[12] = CAND(0, 12); c0[13] = CAND(0, 13); c0[14] = CAND(0, 14); c0[15] = CAND(0, 15);
        sort16_desc(c0);
        c1[0] = CAND(1, 0); c1[1] = CAND(1, 1); c1[2] = CAND(1, 2); c1[3] = CAND(1, 3); c1[4] = CAND(1, 4); c1[5] = CAND(1, 5); c1[6] = CAND(1, 6); c1[7] = CAND(1, 7);
        c1[8] = CAND(2, 0); c1[9] = CAND(2, 1); c1[10] = CAND(2, 2); c1[11] = CAND(2, 3); c1[12] = CAND(2, 4); c1[13] = CAND(3, 0); c1[14] = CAND(3, 1); c1[15] = CAND(3, 2);
        sort16_desc(c1); merge_top16(c0, c1);
        asm volatile("" : "+v"(c0[0]), "+v"(c0[15]));
        c1[0] = CAND(3, 3); c1[1] = CAND(4, 0); c1[2] = CAND(4, 1); c1[3] = CAND(4, 2); c1[4] = CAND(5, 0); c1[5] = CAND(5, 1); c1[6] = CAND(6, 0); c1[7] = CAND(6, 1);
        c1[8] = CAND(7, 0); c1[9] = CAND(7, 1); c1[10] = CAND(8, 0); c1[11] = CAND(9, 0); c1[12] = CAND(10, 0); c1[13] = CAND(11, 0); c1[14] = CAND(12, 0); c1[15] = CAND(13, 0);
        sort16_desc(c1); merge_top16(c0, c1);
        asm volatile("" : "+v"(c0[0]), "+v"(c0[15]));
        c1[0] = CAND(14, 0); c1[1] = CAND(15, 0);
#pragma unroll
        for (int r = 2; r < 16; ++r) c1[r] = NEG;
#undef CAND
        sort16_desc(c1); merge_top16(c0, c1);
        float gsum = 0.f, gv[16]; int ex[16];
        const float mx = __uint_as_float(__float_as_uint(c0[0]) & ~255u);
#pragma unroll
        for (int r = 0; r < 16; ++r) { const unsigned bits = __float_as_uint(c0[r]); const float val = __uint_as_float(bits & ~255u);
            gv[r] = __expf(val - mx); gsum += gv[r];
            ex[r] = (int)(lookup_idx(pa, (bits >> 4) & 15u) * 128u + lookup_idx(pb, bits & 15u)); }
        const float ginv = 1.0f / gsum;
        const size_t ob = (size_t)(tg * 32 + r32) * 128 + (2 * hp + hi) * 16;
#pragma unroll
        for (int r = 0; r < 16; r += 4) { *(GAS u32x4*)(IDX + ob + r) = (u32x4){(unsigned)ex[r], (unsigned)ex[r + 1], (unsigned)ex[r + 2], (unsigned)ex[r + 3]};
            *(GAS f32x4*)(GATE + ob + r) = (f32x4){gv[r] * ginv, gv[r + 1] * ginv, gv[r + 2] * ginv, gv[r + 3] * ginv}; }
      }
    }
#undef P5_QLOAD
    __syncthreads();
}

typedef long i64_t;
typedef int v8i_t __attribute__((ext_vector_type(8)));
#define MFMA16F8(a, b, c) __builtin_amdgcn_mfma_f32_16x16x32_fp8_fp8(a, b, c, 0, 0, 0)
constexpr float P6_SD = 64.f, P6_SX = 8.f, P6_SU = 16.f, P6_SA = 64.f, P6_SU4 = 6.f;
constexpr size_t P6_SLICEB = (size_t)NEXP * 128;
__device__ __forceinline__ unsigned pk4_fp8(float a, float b, float c, float d) { int w = __builtin_amdgcn_cvt_pk_fp8_f32(a, b, 0, false); w = __builtin_amdgcn_cvt_pk_fp8_f32(c, d, w, true); return (unsigned)w; }
__device__ __forceinline__ float fp8_byte0(unsigned w) { return __builtin_amdgcn_cvt_f32_fp8((int)w, 0); }
constexpr int P6_WSCR = 3328;
__device__ __forceinline__ void p6_token(const Args& a, lds_u8* wl, int tok, int lane, float* OUTW) {
    const int n = lane & 15, g = lane >> 4;
    const unsigned char* ws = a.ws;
    const unsigned char* WD = ws + WS_WD; const unsigned char* WU = ws + WS_WU;
    const int* IDX = (const int*)(ws + WS_IDX) + (size_t)tok * 128; const float* GATE = (const float*)(ws + WS_GATE) + (size_t)tok * 128;
    const bf16_t* X1 = (const bf16_t*)(ws + WS_X1B) + (size_t)tok * DM;
    {
#pragma unroll
        for (int j = 0; j < 4; ++j) {
            const u32x2 xw_ = *(const GAS u32x2*)(X1 + 256 * j + 4 * lane); const f32x4 v = (f32x4){__uint_as_float(xw_.x << 16), __uint_as_float(xw_.x & 0xffff0000u), __uint_as_float(xw_.y << 16), __uint_as_float(xw_.y & 0xffff0000u)} * P6_SX;
            const unsigned hw = pk4_fp8(v.x, v.y, v.z, v.w);
            const float r0 = v.x - __builtin_amdgcn_cvt_f32_fp8((int)hw, 0), r1 = v.y - __builtin_amdgcn_cvt_f32_fp8((int)hw, 1), r2 = v.z - __builtin_amdgcn_cvt_f32_fp8((int)hw, 2), r3 = v.w - __builtin_amdgcn_cvt_f32_fp8((int)hw, 3);
            const unsigned lw = pk4_fp8(r0 * 16.f, r1 * 16.f, r2 * 16.f, r3 * 16.f);
            *(LAS unsigned*)(wl + 256 * j + 4 * lane) = hw; *(LAS unsigned*)(wl + 1024 + 256 * j + 4 * lane) = lw;
        }
        const u32x2 iv = *(const GAS u32x2*)(IDX + lane * 2); *(LAS u32x2*)(wl + 2048 + lane * 8) = iv;
    }
    const float rs2 = row_rs2((const bf16_t*)(ws + WS_SSQ), tok);
    LDS_WAIT();
    const LAS int* idxl = (const LAS int*)(wl + 2048); LAS unsigned short* actl = (LAS unsigned short*)(wl + 2560);
    const int xoff = (n & 1) * 1024 + 16 * g;
#pragma unroll 1
    for (int eg = 0; eg < 8; ++eg) {
        const int e = idxl[eg * 16 + n];
        const unsigned char* rp = WD + (size_t)e * 128 + 16 * g;
        f32x4 acc = (f32x4){0.f, 0.f, 0.f, 0.f};
        u32x4 bq[16];
#pragma unroll
        for (int sl = 0; sl < 8; ++sl) { bq[2 * sl] = *(const GAS u32x4*)(rp + sl * P6_SLICEB); bq[2 * sl + 1] = *(const GAS u32x4*)(rp + sl * P6_SLICEB + 64); }
#pragma unroll
        for (int sl = 0; sl < 8; ++sl)
#pragma unroll
            for (int hf = 0; hf < 2; ++hf) {
                const u32x4 xa = *(const LAS u32x4*)(wl + xoff + sl * 128 + hf * 64); const u32x4 bb = bq[2 * sl + hf];
                acc = MFMA16F8((i64_t)(((unsigned long long)xa.y << 32) | xa.x), (i64_t)(((unsigned long long)bb.y << 32) | bb.x), acc);
                acc = MFMA16F8((i64_t)(((unsigned long long)xa.w << 32) | xa.z), (i64_t)(((unsigned long long)bb.w << 32) | bb.z), acc);
            }
        const float av = (acc[0] + acc[1] * 0.0625f) * (rs2 * (1.0f / (P6_SD * P6_SX)));
        const float act = 0.5f * av * (1.0f + erff(av * 0.70710678118654752f)) * GATE[eg * 16 + n] * P6_SA;
        const unsigned hb = pk4_fp8(act, 0.f, 0.f, 0.f) & 0xffu;
        const unsigned lb = pk4_fp8((act - fp8_byte0(hb)) * 16.f, 0.f, 0.f, 0.f) & 0xffu;
        if (g == 0) actl[eg * 16 + n] = (unsigned short)(hb | (lb << 8));
    }
    LDS_WAIT();
    const int pos = n & 7, sel = n >> 3;
    float ss = 0.f;
    const bool owner = (n < 8) && (g < 2);
#pragma unroll 1
    for (int sl = 0; sl < 8; ++sl) {
        f32x4 ah[2], al[2];
#pragma unroll
        for (int s = 0; s < 2; ++s) { ah[s] = (f32x4){0.f, 0.f, 0.f, 0.f}; al[s] = (f32x4){0.f, 0.f, 0.f, 0.f}; }
        u32x4 bq[16]; unsigned av[16];
#pragma unroll
        for (int q = 0; q < 16; ++q) { const int ei = 8 * q + 4 * sel + g; const int e = idxl[ei]; av[q] = actl[ei];
            bq[q] = *(const GAS u32x4*)(WU + sl * P6_SLICEB + (size_t)e * 128 + 16 * pos); }
#pragma unroll
        for (int q = 0; q < 16; ++q) {
            const unsigned long long ahv = (unsigned long long)(av[q] & 0xffu) << (8 * pos), alv = (unsigned long long)(av[q] >> 8) << (8 * pos);
            const u32x4 bb = bq[q];
            const i64_t b0 = (i64_t)(((unsigned long long)bb.y << 32) | bb.x), b1 = (i64_t)(((unsigned long long)bb.w << 32) | bb.z);
            ah[0] = MFMA16F8((i64_t)ahv, b0, ah[0]); al[0] = MFMA16F8((i64_t)alv, b0, al[0]);
            ah[1] = MFMA16F8((i64_t)ahv, b1, ah[1]); al[1] = MFMA16F8((i64_t)alv, b1, al[1]);
        }
#pragma unroll
        for (int s = 0; s < 2; ++s) {
            f32x4 t = ah[s] + al[s] * 0.0625f, u;
#pragma unroll
            for (int r = 0; r < 4; ++r) u[r] = __shfl(t[r], (lane + 40) & 63);
            const int col = 128 * sl + 16 * pos + 8 * s + 4 * (g & 1);
            const u32x2 xq_ = *(const GAS u32x2*)(X1 + col); const f32x4 xv = (f32x4){__uint_as_float(xq_.x << 16), __uint_as_float(xq_.x & 0xffff0000u), __uint_as_float(xq_.y << 16), __uint_as_float(xq_.y & 0xffff0000u)};
            const f32x4 x2 = xv + (t + u) * (1.0f / (P6_SA * P6_SU));
            if (owner) { ss += (x2.x * x2.x + x2.y * x2.y) + (x2.z * x2.z + x2.w * x2.w); *(GAS f32x4*)(OUTW + (size_t)tok * DM + col) = x2; }
        }
    }
    ss = wave_sum(ss);
    const float rn = 1.0f / sqrtf(ss * (1.0f / DM) + EPSF);
    const float* nf = a.in[16];
    if (owner) {
#pragma unroll
        for (int sl = 0; sl < 8; ++sl)
#pragma unroll
            for (int s = 0; s < 2; ++s) { const int col = 128 * sl + 16 * pos + 8 * s + 4 * g; const f32x4 gv = *(const GAS f32x4*)(nf + col);
                GAS f32x4* op = (GAS f32x4*)(OUTW + (size_t)tok * DM + col); *op = *op * rn * gv; }
    }
}

constexpr int P6S_WAVE = 16384 + 512 + 128;
static_assert(NWAVES * P6S_WAVE <= LDS_SCRATCH, "P6 LDS");
__device__ __forceinline__ float gelu_as(float v) {
    const float av = __builtin_fabsf(v), t = __builtin_amdgcn_rcpf(av * 0.2316418882f + 1.0f);
    float q = t * 0.5307027145f + (-0.7265760135f); q = q * t + 0.7107068705f; q = q * t + (-0.142248368f); q = q * t + 0.127414796f; q = q * t;
    const float e = __builtin_amdgcn_exp2f((v * v) * (-0.72134752044f));
    const float m = v * (q * e);
    return v < 0.f ? m : v - m;
}
template <int EMASK, int PARTS>
__device__ __forceinline__ void p6_slices(const Args& a, lds_u8* wl, int tok0, int lane) {
    const int n = lane & 15, g = lane >> 4;
    const unsigned char* ws = a.ws;
    const unsigned char* WD = ws + WS_WD; const unsigned char* WU = ws + WS_WU;
    LAS float* aacc = (LAS float*)wl; LAS unsigned short* idl = (LAS unsigned short*)(wl + 8192); LAS unsigned short* actl = (LAS unsigned short*)(wl + 12288);
    lds_u8* xs = wl + 16384; LAS float* ssl = (LAS float*)(wl + 16384 + 512); LAS float* r2l = ssl + 16;
#pragma unroll 1
    for (int t = 0; t < 16; ++t) {
        const u32x2 iv = *(const GAS u32x2*)((const int*)(ws + WS_IDX) + (size_t)(tok0 + t) * 128 + lane * 2);
        *(LAS unsigned*)(wl + 8192 + t * 256 + lane * 4) = (iv.x & 0xffffu) | (iv.y << 16);
        *(LAS f32x2*)(wl + t * 512 + lane * 8) = (f32x2){0.f, 0.f};
    }
    if (lane < 16) { ssl[lane] = 0.f; r2l[lane] = row_rs2((const bf16_t*)(ws + WS_SSQ), tok0 + lane); }
    unsigned char* X4 = (unsigned char*)a.ws + WS_XB;
#pragma unroll 1
    for (int t = 0; t < 16; ++t) {
        const bf16_t* xr = (const bf16_t*)(ws + WS_X1B) + (size_t)(tok0 + t) * DM + 16 * lane;
        const u32x4 xw0 = *(const GAS u32x4*)xr, xw1 = *(const GAS u32x4*)(xr + 8);
        float rr[16];
#pragma unroll
        for (int j = 0; j < 4; ++j) { rr[2 * j] = __uint_as_float(xw0[j] << 16); rr[2 * j + 1] = __uint_as_float(xw0[j] & 0xffff0000u); rr[8 + 2 * j] = __uint_as_float(xw1[j] << 16); rr[9 + 2 * j] = __uint_as_float(xw1[j] & 0xffff0000u); }
#pragma unroll
        for (int st = 0; st < 4; ++st) {
            unsigned w0 = 0u, w1 = 0u;
#define P6_Q4(p_) do { w0 = __builtin_amdgcn_cvt_scalef32_pk_fp4_f32(w0, rr[2 * (p_)], rr[2 * (p_) + 1], 1.0f, p_); w1 = __builtin_amdgcn_cvt_scalef32_pk_fp4_f32(w1, rr[8 + 2 * (p_)], rr[9 + 2 * (p_)], 1.0f, p_); } while (0)
            P6_Q4(0); P6_Q4(1); P6_Q4(2); P6_Q4(3);
#undef P6_Q4
#define P6_D4(p_) do { const f32x2 d0 = __builtin_amdgcn_cvt_scalef32_pk_f32_fp4(w0, 1.0f, p_), d1 = __builtin_amdgcn_cvt_scalef32_pk_f32_fp4(w1, 1.0f, p_); \
                rr[2 * (p_)] = (rr[2 * (p_)] - d0.x) * 4.0f; rr[2 * (p_) + 1] = (rr[2 * (p_) + 1] - d0.y) * 4.0f; rr[8 + 2 * (p_)] = (rr[8 + 2 * (p_)] - d1.x) * 4.0f; rr[9 + 2 * (p_)] = (rr[9 + 2 * (p_)] - d1.y) * 4.0f; } while (0)
            P6_D4(0); P6_D4(1); P6_D4(2); P6_D4(3);
#undef P6_D4
            *(GAS u32x2*)(X4 + (size_t)(tok0 + t) * 2048 + st * 512 + 8 * lane) = (u32x2){w0, w1};
        }
    }
    LDS_WAIT(); VM_WAIT();
    const int xoff = (n & 3) * 128 + 16 * g;
    const int bpa = 4 * (4 * (lane & 15) + (lane >> 4));
#define MFMA4(a_, b_, c_) __builtin_amdgcn_mfma_scale_f32_16x16x128_f8f6f4(a_, b_, c_, 4  , 4  , 0, 0, 0, 0)
#define P6_DLOAD(BQ, XV, it_) do { const int sl_ = (it_) >> 4, t_ = (it_) & 15; \
        _Pragma("unroll") for (int eg = 0; eg < 8; ++eg) { const int e_ = idl[t_ * 128 + eg * 16 + (lane >> 2)] & EMASK; const unsigned char* rp_ = WD + sl_ * P6_SLICEB + (size_t)e_ * 128 + 16 * (lane & 3); \
            BQ[2 * eg] = *(const GAS u32x4*)rp_; BQ[2 * eg + 1] = *(const GAS u32x4*)(rp_ + 64); } \
        XV = *(const GAS u32x2*)(X4 + (size_t)(tok0 + t_) * 2048 + (lane >> 4) * 512 + sl_ * 128 + 8 * (lane & 15)); } while (0)
#define P6_DCOMP(BQ, XV, it_) do { const int t_ = (it_) & 15; \
        *(LAS u32x2*)(xs + (lane >> 4) * 128 + 8 * (lane & 15)) = XV; \
        LDS_WAIT(); \
        const u32x4 xa0 = *(const LAS u32x4*)(xs + xoff), xa1 = *(const LAS u32x4*)(xs + xoff + 64); \
        const v8i_t A0 = (v8i_t){(int)xa0.x, (int)xa0.y, (int)xa0.z, (int)xa0.w, 0, 0, 0, 0}; \
        const v8i_t A1 = (v8i_t){(int)xa1.x, (int)xa1.y, (int)xa1.z, (int)xa1.w, 0, 0, 0, 0}; \
        _Pragma("unroll") for (int eg = 0; eg < 8; ++eg) { f32x4 acc = (f32x4){0.f, 0.f, 0.f, 0.f}; v8i_t b0 = (v8i_t){0, 0, 0, 0, 0, 0, 0, 0}, b1 = (v8i_t){0, 0, 0, 0, 0, 0, 0, 0}; \
            _Pragma("unroll") for (int w_ = 0; w_ < 4; ++w_) { b0[w_] = __builtin_amdgcn_ds_bpermute(bpa, (int)BQ[2 * eg][w_]); b1[w_] = __builtin_amdgcn_ds_bpermute(bpa, (int)BQ[2 * eg + 1][w_]); } \
            acc = MFMA4(A0, b0, acc); acc = MFMA4(A1, b1, acc); \
            float r_ = (acc[0] + acc[1] * 0.25f) + (acc[2] * 0.0625f + acc[3] * 0.015625f); asm volatile("" : "+v"(r_)); \
            if (g == 0) aacc[t_ * 128 + eg * 16 + n] += r_; } \
        LDS_WAIT(); } while (0)
    if (PARTS & 1) {
        u32x4 bqA[16], bqB[16]; u32x2 xvA, xvB;
        P6_DLOAD(bqA, xvA, 0);
#pragma unroll 1
        for (int it = 0; it < 64; it += 2) {
            P6_DLOAD(bqB, xvB, it + 1);
            P6_DCOMP(bqA, xvA, it);
            if (it + 2 < 64) P6_DLOAD(bqA, xvA, it + 2);
            P6_DCOMP(bqB, xvB, it + 1);
        }
    }
#undef MFMA4
#undef P6_DLOAD
#undef P6_DCOMP
    int lane_g = lane; asm volatile("" : "+v"(lane_g));
#pragma unroll 1
    for (int t = 0; t < 16; ++t) {
        const float sc = r2l[t] * (1.0f / P6_SD);
#pragma unroll
        for (int j = 0; j < 2; ++j) { const int ei = lane_g + 64 * j; const float av = aacc[t * 128 + ei] * sc;
            const float act = gelu_as(av) * ((const float*)(ws + WS_GATE))[(size_t)(tok0 + t) * 128 + ei];
            const unsigned ab = __float_as_uint(act), eb = (ab >> 23) & 255u;
            unsigned pk = 0u;
            if (eb > 4u) {
                const float m = __uint_as_float((ab & 0x807fffffu) | (128u << 23));
                const unsigned w0 = __builtin_amdgcn_cvt_scalef32_pk_fp4_f32(0u, m, 0.f, 1.0f, 0);
                const f32x2 d0 = __builtin_amdgcn_cvt_scalef32_pk_f32_fp4(w0, 1.0f, 0);
                const unsigned w1 = __builtin_amdgcn_cvt_scalef32_pk_fp4_f32(0u, (m - d0.x) * 4.0f, 0.f, 1.0f, 0);
                pk = (w0 & 15u) | ((w1 & 15u) << 4) | ((eb - 1u) << 8);
            }
            actl[t * 128 + ei] = (unsigned short)pk; }
    }
    LDS_WAIT();
    int lane_u = lane; asm volatile("" : "+v"(lane_u));
    const float* nf = a.in[16];
    const int ui = lane_u & 31, ug = lane_u >> 5, ush = 4 * (ui & 7);
    const unsigned uk0 = (ui >> 3) == 0 ? 0xffffffffu : 0u, uk1 = (ui >> 3) == 1 ? 0xffffffffu : 0u, uk2 = (ui >> 3) == 2 ? 0xffffffffu : 0u, uk3 = (ui >> 3) == 3 ? 0xffffffffu : 0u;
#define MFMA32S(a_, b_, c_, sa_) __builtin_amdgcn_mfma_scale_f32_32x32x64_f8f6f4(a_, b_, c_, 4, 4, 0, sa_, 0, 127)
#define P6_ULOAD(BQ, sq_) do { const int t_ = (sq_) >> 3, qs_ = (sq_) & 7; \
        _Pragma("unroll") for (int q = 0; q < 8; ++q) { const int e_ = idl[t_ * 128 + 2 * (8 * qs_ + q) + ug] & EMASK; \
            BQ[q] = *(const GAS u32x4*)(WU + (size_t)e_ * 512 + 16 * ui); } } while (0)
#define P6_UMMA(BQ, sq_) do { const int t_ = (sq_) >> 3, qs_ = (sq_) & 7; \
        _Pragma("unroll") for (int q = 0; q < 8; ++q) { \
            const unsigned av_ = actl[t_ * 128 + 2 * (8 * qs_ + q) + ug]; \
            const unsigned w0_ = (av_ & 15u) << ush, w1_ = ((av_ >> 4) & 15u) << ush; const int s0_ = (int)(av_ >> 8), s1_ = s0_ - 2; \
            const u32x4 bb = BQ[q]; const v8i_t B_ = (v8i_t){(int)bb.x, (int)bb.y, (int)bb.z, (int)bb.w, 0, 0, 0, 0}; \
            uacc = MFMA32S(((v8i_t){(int)(w0_ & uk0), (int)(w0_ & uk1), (int)(w0_ & uk2), (int)(w0_ & uk3), 0, 0, 0, 0}), B_, uacc, s0_); \
            uacc = MFMA32S(((v8i_t){(int)(w1_ & uk0), (int)(w1_ & uk1), (int)(w1_ & uk2), (int)(w1_ & uk3), 0, 0, 0, 0}), B_, uacc, s1_); } } while (0)
#define P6_UEPI(sq_) do { const int t_ = (sq_) >> 3; \
        float* orow = a.out + (size_t)(tok0 + t_) * DM + 32 * ui + 4 * ug; const bf16_t* xrow = (const bf16_t*)(ws + WS_X1B) + (size_t)(tok0 + t_) * DM + 32 * ui + 4 * ug; \
        f32x4 x2[4]; float ss = 0.f; \
        _Pragma("unroll") for (int gq = 0; gq < 4; ++gq) { \
            const u32x2 xq_ = *(const GAS u32x2*)(xrow + 8 * gq); \
            x2[gq] = (f32x4){__uint_as_float(xq_.x << 16), __uint_as_float(xq_.x & 0xffff0000u), __uint_as_float(xq_.y << 16), __uint_as_float(xq_.y & 0xffff0000u)} \
                + (f32x4){uacc[4 * gq], uacc[4 * gq + 1], uacc[4 * gq + 2], uacc[4 * gq + 3]} * (1.0f / P6_SU4); \
            ss += (x2[gq].x * x2[gq].x + x2[gq].y * x2[gq].y) + (x2[gq].z * x2[gq].z + x2[gq].w * x2[gq].w); } \
        const float rn = 1.0f / sqrtf(wave_sum(ss) * (1.0f / DM) + EPSF);     \
        _Pragma("unroll") for (int gq = 0; gq < 4; ++gq) { const f32x4 gv = *(const GAS f32x4*)(nf + 32 * ui + 4 * ug + 8 * gq); *(GAS f32x4*)(orow + 8 * gq) = x2[gq] * rn * gv; } \
        uacc = f32x16{}; } while (0)
    if (PARTS & 2) {
        u32x4 bqA[8], bqB[8]; f32x16 uacc = f32x16{};
        P6_ULOAD(bqA, 0);
#pragma unroll 1
        for (int sq = 0; sq < 128; sq += 2) {
            P6_ULOAD(bqB, sq + 1);
            P6_UMMA(bqA, sq);
            if (sq + 2 < 128) P6_ULOAD(bqA, sq + 2);
            P6_UMMA(bqB, sq + 1);
            if (((sq + 1) & 7) == 7) P6_UEPI(sq + 1);
        }
    }
#undef P6_ULOAD
#undef P6_UMMA
#undef P6_UEPI
#undef MFMA32S
}

#ifndef MK_N_LAUNCHES
#define MK_N_LAUNCHES 1
#endif
constexpr int NPHASE = 7;

__device__ __forceinline__ int queue_next(unsigned* ctr, volatile LAS unsigned* slot) {
    __syncthreads();
    if (threadIdx.x == 0) *slot = __hip_atomic_fetch_add(ctr, 1u, __ATOMIC_RELAXED, __HIP_MEMORY_SCOPE_AGENT);
    __syncthreads();
    return (int)*slot;
}

__global__ void __launch_bounds__(NTHR, 2) hymba_fwd(Args a) {
    extern __shared__ __attribute__((aligned(16))) unsigned char lds_raw[];
    lds_u8* lds = (lds_u8*)lds_raw;
    volatile LAS unsigned* MISC = (volatile LAS unsigned*)(lds + MISC_OFF);
    const int tid = threadIdx.x, lane = tid & 63; const int wave = __builtin_amdgcn_readfirstlane(tid >> 6);
    const int G = gridDim.x; const int bx = blockIdx.x;
    const int vcu = (G % 8 == 0) ? (bx % 8) * (G / 8) + bx / 8 : bx;
    const int gw = vcu * NWAVES + wave, NGW = G * NWAVES;
    for (int u = tid; u < (LDS_BYTES - MISC_OFF) / 4; u += NTHR) MISC[u] = 0u;
    __syncthreads();
    const int lo = a.ph_lo, hi = a.ph_hi;
    const bool use_bar = (hi - lo) > 1;
    XcdBarrier bar; bar.bar = (unsigned*)(a.ws + WS_CTL); bar.x = 0; bar.st = MISC + 8;
    if (use_bar) bar = xcd_barrier_post((unsigned*)(a.ws + WS_CTL), MISC + 8);
#ifndef PH_MASK
#define PH_MASK 127
#endif
#define IN(k) (((PH_MASK >> (k)) & 1) && lo <= (k) && (k) < hi)
#ifdef DBL_BAR
#define SEAM(k) do { if (IN(k) && IN((k) + 1)) { xcd_barrier(bar); xcd_barrier(bar); } } while (0)
#else
#define SEAM(k) do { if (IN(k) && IN((k) + 1)) xcd_barrier(bar); } while (0)
#endif
    unsigned char* ws = a.ws;

    if (IN(0)) { p0_prologue(a, lds, gw, NGW, lane, wave);
#ifdef DBL_P0
        __syncthreads(); p0_prologue(a, lds, gw, NGW, lane, wave);
#endif
    }
    SEAM(0);
    if (IN(1)) {
        pg8::Gemm g{(const bf16_t*)(ws + WS_XB), (const bf16_t*)(ws + WS_WIN), MTOK, NIN, DM}; pg8::StaticOrder S; S.init(MTOK, NIN, G, bx);
        EpiProj E{(bf16_t*)(ws + WS_PROJ), (const float*)(ws + WS_R1), (const f32x4*)(ws + WS_ROPE), (const float*)(ws + WS_DECAY)};
        pg8::gemm_phase<EpiProj, pg8::StaticOrder>(lds, g, S, E);
#ifdef DBL_P1
        pg8::gemm_phase<EpiProj, pg8::StaticOrder>(lds, g, S, E);
#endif
    }
    SEAM(1);
    if (IN(2)) {
#ifdef DBL_P2
        for (int rep = 0; rep < 2; ++rep) {
        unsigned* ctr = (unsigned*)(ws + WS_CTL + CTL_Q_ATT + rep * 256);
#else
        {
        unsigned* ctr = (unsigned*)(ws + WS_CTL + CTL_Q_ATT);
#endif
        for (;;) {
            int u = queue_next(ctr, MISC + 16);
            if (u >= 64 + 1024 + DEF_ITEMS) break;
            if (u >= 64) { const int i9 = (u - 64) / 9, r9 = (u - 64) % 9; u = (r9 < 4) ? 64 + i9 * 4 + r9 : 64 + 1024 + i9 * 5 + (r9 - 4); }
#ifdef PROBE_P2
            if (rep == 0 && u >= 64 + 1024) continue;
#endif
            if (u >= 64 + 1024) { p0_deferred(a, lds, u - (64 + 1024)); continue; }
#ifdef PROBE_P2
            if (rep == 0) { if (u < 64) { if (PROBE_P2 & 1) ret_unit(a, lds, u >> 3, u & 7); } else if (PROBE_P2 & 2) { const int v = u - 64; attn_unit<PROBE_ATT>(a, lds, (v & 31) >> 2, v & 3, 31 - (v >> 5)); } continue; }
#endif
            if (u < 64) ret_unit(a, lds, u >> 3, u & 7);
            else { const int v = u - 64; attn_unit<7>(a, lds, (v & 31) >> 2, v & 3, 31 - (v >> 5)); }
        }
        }
    }
    SEAM(2);
    if (IN(3)) {
        pg8::Gemm g{(const bf16_t*)(ws + WS_MIX), (const bf16_t*)(ws + WS_WOUT), MTOK, DM, DM}; pg8::StaticOrder S; S.init(MTOK, DM, G, bx);
        EpiX1 E{(const bf16_t*)(ws + WS_XB), (bf16_t*)(ws + WS_X1B), (bf16_t*)(ws + WS_SSQ)};
        pg8::gemm_phase<EpiX1, pg8::StaticOrder>(lds, g, S, E);
    }
    SEAM(3);
    if (IN(4)) {
        pg8::Gemm g{(const bf16_t*)(ws + WS_X1B), (const bf16_t*)(ws + WS_WPQ), MTOK, NQ, DM}; pg8::StaticOrder S; S.init(MTOK, NQ, G, bx);
        EpiQ E{(bf16_t*)(ws + WS_PROJ), (const bf16_t*)(ws + WS_SSQ)};
        pg8::gemm_phase<EpiQ, pg8::StaticOrder>(lds, g, S, E);
#ifdef DBL_P4
        pg8::gemm_phase<EpiQ, pg8::StaticOrder>(lds, g, S, E);
#endif
    }
    SEAM(4);
    if (IN(5)) { p5_topk(a, lds);
#ifdef DBL_P5
        p5_topk(a, lds);
#endif
    }
    SEAM(5);
    if (IN(6)) {
#ifdef P6_TOKEN_MAJOR
        lds_u8* wl = lds + wave * P6_WSCR;
        for (int tok = gw; tok < MTOK; tok += NGW) p6_token(a, wl, tok, lane, a.out);
#else
#ifdef PROBE_EMASK
        for (int tb = gw; tb < MTOK / 16; tb += NGW) p6_slices<PROBE_EMASK, PROBE_PARTS>(a, lds + wave * P6S_WAVE, tb * 16, lane);
#endif
        for (int tb = gw; tb < MTOK / 16; tb += NGW) p6_slices<0xffff, 3>(a, lds + wave * P6S_WAVE, tb * 16, lane);
#endif
    }
#ifdef DBG_DUMP
    if (hi - lo > 1) xcd_barrier(bar);
    {
        for (int m = gw; m < MTOK; m += NGW) {
            for (int c = lane; c < DM; c += 64) {
                float v = 0.f;
#if DBG_DUMP == 1
                v = bf2f(((const bf16_t*)(ws + WS_PROJ))[(size_t)m * NIN + DBG_COL + c]);
#elif DBG_DUMP == 2
                v = (c >= DBG_C0 && c < DBG_C1) ? bf2f(((const bf16_t*)(ws + WS_MIX))[(size_t)m * DM + c]) : 0.f;
#endif
                a.out[(size_t)m * DM + c] = v;
            }
        }
    }
#endif
#undef IN
#undef SEAM
}

extern "C" void kernel_launch(void* const* d_in, const int* in_sizes, int n_in, void* d_out, int out_size, void* d_ws, size_t ws_size, hipStream_t stream) {
    static int grid = 0;
    if (grid == 0) {
        if (n_in != 17 || in_sizes[0] != MTOK * DM || out_size != MTOK * DM || ws_size < WS_END) {
            fprintf(stderr, "kernel_launch: unexpected shapes (n_in %d, in0 %d, out %d, ws %zu < %zu); nothing launched\n", n_in, n_in > 0 ? in_sizes[0] : -1, out_size, ws_size, (size_t)WS_END); grid = -1; return; }
        int dev = 0, cus = 0, per_cu = 0;
        if (hipGetDevice(&dev) != hipSuccess || hipDeviceGetAttribute(&cus, hipDeviceAttributeMultiprocessorCount, dev) != hipSuccess) { fprintf(stderr, "kernel_launch: device query failed\n"); grid = -1; return; }
        if (hipFuncSetAttribute((const void*)hymba_fwd, hipFuncAttributeMaxDynamicSharedMemorySize, LDS_BYTES) != hipSuccess) { fprintf(stderr, "kernel_launch: hipFuncSetAttribute failed\n"); grid = -1; return; }
        if (hipOccupancyMaxActiveBlocksPerMultiprocessor(&per_cu, (const void*)hymba_fwd, NTHR, LDS_BYTES) != hipSuccess || per_cu < 1)
            fprintf(stderr, "kernel_launch: note: occupancy query reports %d workgroups per CU\n", per_cu);
        (void)hipGetLastError();
        grid = cus;
    }
    if (grid < 0) return;
    if (hipMemsetAsync((char*)d_ws + WS_CTL, 0, CTL_BYTES, stream) != hipSuccess) { fprintf(stderr, "kernel_launch: memset failed\n"); return; }
    Args a{};
    for (int i = 0; i < 17; ++i) a.in[i] = (const float*)d_in[i];
    a.out = (float*)d_out; a.ws = (unsigned char*)d_ws;
#if MK_N_LAUNCHES == 1
#ifdef DBG_STOP
    a.ph_lo = 0; a.ph_hi = DBG_STOP + 1;
#else
    a.ph_lo = 0; a.ph_hi = NPHASE;
#endif
    hipLaunchKernelGGL(hymba_fwd, dim3(grid), dim3(NTHR), LDS_BYTES, stream, a);
#else
    for (int p = 0; p < NPHASE; ++p) { a.ph_lo = p; a.ph_hi = p + 1; hipLaunchKernelGGL(hymba_fwd, dim3(grid), dim3(NTHR), LDS_BYTES, stream, a); }
#endif
    const hipError_t le = hipPeekAtLastError();
    if (le != hipSuccess) fprintf(stderr, "kernel_launch: launch failed: %s\n", hipGetErrorName(le));
}
```

```cpp
#include <hip/hip_runtime.h>
#include <cstdio>
#include <cstdint>

namespace pg8 {
#define PG8_LAS __attribute__((address_space(3)))
typedef unsigned short bf16_t;
typedef short bf16x8 __attribute__((ext_vector_type(8)));
typedef float f32x4 __attribute__((ext_vector_type(4)));
typedef unsigned u32x4 __attribute__((ext_vector_type(4)));
constexpr int BM = 256, BK = 64, HALF = 128, HTB = HALF * BK * 2  , STAGE_BYTES = 8 * HTB, NXCD = 8, WGM = 8;

__host__ __device__ __forceinline__ int lds_byte(int r, int c) { const int st = (r >> 4) * 2 + (c >> 5), rr = r & 15, cc = c & 31, ob = rr * 64 + cc * 2; return st * 1024 + (ob ^ (((ob >> 9) & 1) << 5)); }
__host__ __device__ __forceinline__ void stage_rc(int b, int& R, int& C) { const int st = b / 1024, sb = b % 1024, swz = sb ^ (((sb >> 9) & 1) << 5); R = (st >> 1) * 16 + swz / 64; C = (st & 1) * 32 + (swz % 64) / 2; }
__host__ __device__ __forceinline__ int perm32(int rho) { const int n = rho >> 4, i = rho & 15; return 8 * (i >> 2) + 4 * n + (i & 3); }

struct Unit { int pm, pn; };
struct Gemm { const bf16_t* A; const bf16_t* Bt; int M, N, K; };

struct StaticOrder {
    int nM, nN, nwg, G, c;
    __host__ __device__ void init(int M, int N, int G_, int c_) { nM = M / BM; nN = N / BM; nwg = nM * nN; G = G_; c = c_; }
    __host__ __device__ bool next(int i, Unit& u) const {
        const long L = (long)i * G + c; if (L >= nwg) return false;
        int wgid = (int)L; { const int q = nwg / NXCD, r = nwg % NXCD, xcd = wgid % NXCD, off = wgid / NXCD; wgid = (xcd < r ? xcd * (q + 1) : r * (q + 1) + (xcd - r) * q) + off; }
        const int nig = WGM * nN, gid = wgid / nig, fm = gid * WGM, gsz = (nM - fm) < WGM ? (nM - fm) : WGM;
        u.pm = fm + ((wgid % nig) % gsz); u.pn = (wgid % nig) / gsz; return true;
    }
    __device__ __forceinline__ void a_ready(const Unit&) const {}
    __device__ __forceinline__ void done(const Unit&) const {}
};
__device__ __forceinline__ unsigned cvt_pk_bf16(float lo, float hi) { unsigned r; asm volatile("v_cvt_pk_bf16_f32 %0, %1, %2" : "=v"(r) : "v"(lo), "v"(hi)); return r; }
template <class Epi, class Sched>
__device__ __forceinline__ void gemm_phase(PG8_LAS unsigned char* lds, const Gemm g, const Sched& S, const Epi& E) {
    const int tid = threadIdx.x, wid = __builtin_amdgcn_readfirstlane(tid >> 6), lane = tid & 63, wr = wid >> 2, wc = wid & 3, fr = lane & 15, fq = lane >> 4;
    const int K = g.K, nt = K / BK;
    unsigned voffA[2], voffB[2];
#pragma unroll
    for (int i = 0; i < 2; ++i) { int R, C; stage_rc(tid * 16 + i * 8192, R, C); const int Rb = Epi::PERM ? ((R & ~31) + perm32(R & 31)) : R;
        voffA[i] = (unsigned)(R * K + C) * 2u; voffB[i] = (unsigned)(Rb * K + C) * 2u; }
    const size_t kstep = (size_t)(BK * 2);
    const size_t hstep = (size_t)HALF * K * 2;
    const size_t tstep = 2 * hstep;
    const unsigned ldsw = (unsigned)wid * 1024u;
    const int aoff = lds_byte(wr * 64 + fr, fq * 8), boff = lds_byte(wc * 32 + fr, fq * 8);
#define PG8_SA(b, h) (((b) * 2 + (h)) * HTB)
#define PG8_SB(b, h) ((4 + (b) * 2 + (h)) * HTB)
#define PG8_STAGE(bufoff, gbase, voff) do { _Pragma("unroll") for (int _i = 0; _i < 2; ++_i) \
        __builtin_amdgcn_global_load_lds((const unsigned*)((const char*)(gbase) + (voff)[_i]), (PG8_LAS unsigned*)(lds + (bufoff) + ldsw + _i * 8192), 16, 0, 0); } while (0)
#define PG8_LDA(dst, b, h) do { _Pragma("unroll") for (int m = 0; m < 4; ++m) _Pragma("unroll") for (int k = 0; k < 2; ++k) dst[m][k] = *(const PG8_LAS bf16x8*)(lds + PG8_SA(b, h) + aoff + m * 2048 + k * 1024); } while (0)
#define PG8_LDB(dst, b, h) do { _Pragma("unroll") for (int n = 0; n < 2; ++n) _Pragma("unroll") for (int k = 0; k < 2; ++k) dst[n][k] = *(const PG8_LAS bf16x8*)(lds + PG8_SB(b, h) + boff + n * 2048 + k * 1024); } while (0)
#define PG8_MMA(ai, bj, At, Bt) do { __builtin_amdgcn_s_setprio(1); _Pragma("unroll") for (int m = 0; m < 4; ++m) _Pragma("unroll") for (int n = 0; n < 2; ++n) _Pragma("unroll") for (int k = 0; k < 2; ++k) \
        acc[ai][bj][m][n] = __builtin_amdgcn_mfma_f32_16x16x32_bf16(Bt[n][k], At[m][k], acc[ai][bj][m][n], 0, 0, 0); __builtin_amdgcn_s_setprio(0); } while (0)
#define PG8_WAIT_V(n) asm volatile("s_waitcnt vmcnt(" #n ")" ::: "memory")
#define PG8_WAIT_L(n) asm volatile("s_waitcnt lgkmcnt(" #n ")" ::: "memory")
#define PG8_BAR __builtin_amdgcn_s_barrier()
#define PG8_SCHED __builtin_amdgcn_sched_barrier(0)
    Unit cur, nxt; int ui = 0;
    if (!S.next(0, cur)) return;
    f32x4 acc[2][2][4][2];
#pragma unroll
    for (int a = 0; a < 2; ++a)
#pragma unroll
        for (int b = 0; b < 2; ++b)
#pragma unroll
            for (int m = 0; m < 4; ++m)
#pragma unroll
                for (int n = 0; n < 2; ++n) acc[a][b][m][n] = (f32x4){0.f, 0.f, 0.f, 0.f};
    bf16x8 At[4][2], B0[2][2], B1[2][2];
    const char* cA = (const char*)g.A + (size_t)cur.pm * tstep; const char* cB = (const char*)g.Bt + (size_t)cur.pn * tstep;
    S.a_ready(cur);
    PG8_STAGE(PG8_SB(0, 0), cB, voffB); PG8_STAGE(PG8_SA(0, 0), cA, voffA); PG8_STAGE(PG8_SB(0, 1), cB + hstep, voffB); PG8_STAGE(PG8_SA(0, 1), cA + hstep, voffA);
    if (wr == 1) PG8_BAR;
    PG8_WAIT_V(4); PG8_BAR;
    PG8_STAGE(PG8_SB(1, 0), cB + kstep, voffB); PG8_STAGE(PG8_SA(1, 0), cA + kstep, voffA); PG8_STAGE(PG8_SB(1, 1), cB + hstep + kstep, voffB);
    PG8_WAIT_V(6); PG8_BAR;
    for (;;) {
        const bool has_next = S.next(ui + 1, nxt);
        const char* nA = has_next ? (const char*)g.A + (size_t)nxt.pm * tstep : cA; const char* nB = has_next ? (const char*)g.Bt + (size_t)nxt.pn * tstep : cB;
        for (int t = 0; t < nt; t += 2) {
            const bool last = (t == nt - 2);
            const char* a1 = cA + (size_t)(t + 1) * kstep;
            const char* a2 = last ? nA : cA + (size_t)(t + 2) * kstep; const char* b2 = last ? nB : cB + (size_t)(t + 2) * kstep;
            const char* a3 = a2 + kstep; const char* b3 = b2 + kstep;
            if (last && has_next) S.a_ready(nxt);
            PG8_LDB(B0, 0, 0); PG8_SCHED; PG8_LDA(At, 0, 0); PG8_STAGE(PG8_SA(1, 1), a1 + hstep, voffA);
            PG8_WAIT_L(8); PG8_BAR; PG8_WAIT_L(0); PG8_MMA(0, 0, At, B0); PG8_BAR; PG8_SCHED;
            PG8_LDB(B1, 0, 1); PG8_STAGE(PG8_SB(0, 0), b2, voffB);
            PG8_BAR; PG8_WAIT_L(0); PG8_MMA(0, 1, At, B1); PG8_BAR;
            PG8_LDA(At, 0, 1); PG8_STAGE(PG8_SA(0, 0), a2, voffA);
            PG8_BAR; PG8_WAIT_L(0); PG8_MMA(1, 0, At, B0); PG8_BAR; PG8_SCHED;
            PG8_STAGE(PG8_SB(0, 1), b2 + hstep, voffB);
            PG8_WAIT_V(6); PG8_BAR; PG8_MMA(1, 1, At, B1); PG8_BAR;
            PG8_LDB(B0, 1, 0); PG8_SCHED; PG8_LDA(At, 1, 0); PG8_STAGE(PG8_SA(0, 1), a2 + hstep, voffA);
            PG8_WAIT_L(8); PG8_BAR; PG8_WAIT_L(0); PG8_MMA(0, 0, At, B0); PG8_BAR; PG8_SCHED;
            PG8_LDB(B1, 1, 1); PG8_STAGE(PG8_SB(1, 0), b3, voffB);
            PG8_BAR; PG8_WAIT_L(0); PG8_MMA(0, 1, At, B1); PG8_BAR;
            PG8_LDA(At, 1, 1); PG8_STAGE(PG8_SA(1, 0), a3, voffA);
            PG8_BAR; PG8_WAIT_L(0); PG8_MMA(1, 0, At, B0); PG8_BAR; PG8_SCHED;
            PG8_STAGE(PG8_SB(1, 1), b3 + hstep, voffB);
            PG8_WAIT_V(6); PG8_BAR; PG8_MMA(1, 1, At, B1); PG8_BAR;
        }
        if constexpr (!Epi::AFTER_DRAIN) { E(acc, cur, wr, wc, fr, fq); S.done(cur); }
        if (!has_next) break;
#pragma unroll
        for (int a = 0; a < 2; ++a)
#pragma unroll
            for (int b = 0; b < 2; ++b)
#pragma unroll
                for (int m = 0; m < 4; ++m)
#pragma unroll
                    for (int n = 0; n < 2; ++n) acc[a][b][m][n] = (f32x4){0.f, 0.f, 0.f, 0.f};
        cur = nxt; cA = nA; cB = nB; ++ui;
    }
    PG8_WAIT_V(0);
    if (wr == 0) PG8_BAR;
    PG8_BAR;
    if constexpr (Epi::AFTER_DRAIN) { E.fused(acc, cur, wr, wc, fr, fq, lds, wid, lane); S.done(cur); }
#undef PG8_SA
#undef PG8_SB
#undef PG8_STAGE
#undef PG8_LDA
#undef PG8_LDB
#undef PG8_MMA
#undef PG8_WAIT_V
#undef PG8_WAIT_L
#undef PG8_BAR
#undef PG8_SCHED
}
}

#define XB_TMO      128
#define XB_XCNT(j)  (256  + 64 * (j))
#define XB_XSUB(j)  (1280 + 64 * (j))
#define XB_XGEN(j)  (2304 + 64 * (j))
#define XB_TOP      3328
#define XB_TOPGEN   3392
#define XCD_BAR_WORDS 3456
#define XB_SPIN_CAP (1u << 18)
#define LAS __attribute__((address_space(3)))

__device__ __forceinline__ unsigned xb_ld(unsigned* p)              { return __hip_atomic_load(p, __ATOMIC_RELAXED, __HIP_MEMORY_SCOPE_AGENT); }
__device__ __forceinline__ unsigned xb_add(unsigned* p, unsigned v) { return __hip_atomic_fetch_add(p, v, __ATOMIC_RELAXED, __HIP_MEMORY_SCOPE_AGENT); }
__device__ __forceinline__ unsigned xb_xcc_id() { return (unsigned)__builtin_amdgcn_s_getreg((3 << 11) | 20) & 0xFu; }
#define XB_SPIN(cond, bar) do { unsigned _sp = 0; while (cond) { __builtin_amdgcn_s_sleep(1); \
    if ((++_sp & 255u) == 0u) { if (xb_ld(&(bar)[XB_TMO])) break; if (_sp > XB_SPIN_CAP) { atomicAdd(&(bar)[XB_TMO], 1u); break; } } } } while (0)

struct XcdBarrier {
    unsigned* bar; unsigned x;
    volatile LAS unsigned* st;
};

__device__ __forceinline__ XcdBarrier xcd_barrier_post(unsigned* bar, volatile LAS unsigned* st) {
    XcdBarrier b; b.bar = bar; b.x = xb_xcc_id(); b.st = st;
    if (threadIdx.x == 0) (void)xb_add(&bar[XB_XCNT(b.x)], 1u);
    return b;
}
__device__ __forceinline__ void xcd_barrier_complete(unsigned* bar, unsigned x, unsigned& nloc, unsigned& nx) {
    const unsigned G = gridDim.x * gridDim.y * gridDim.z;
    unsigned sum, cnt, mine, sp = 0u;
    for (;;) {
        sum = 0u; cnt = 0u; mine = 0u;
#pragma unroll
        for (unsigned j = 0; j < 16; ++j) { const unsigned c = xb_ld(&bar[XB_XCNT(j)]); sum += c; cnt += (c > 0u) ? 1u : 0u; mine = (j == x) ? c : mine; }
        if (sum == G) break;
        __builtin_amdgcn_s_sleep(1);
        if ((++sp & 255u) == 0u) { if (xb_ld(&bar[XB_TMO])) break; if (sp > XB_SPIN_CAP) { atomicAdd(&bar[XB_TMO], 1u); break; } }
    }
    nloc = mine > 0u ? mine : 1u; nx = cnt > 0u ? cnt : 1u;
}

__device__ __forceinline__ void xcd_barrier(const XcdBarrier& b) {
    asm volatile("s_waitcnt vmcnt(0)" ::: "memory");
    __syncthreads();
    if (threadIdx.x == 0) {
        unsigned* bar = b.bar;
        __builtin_amdgcn_s_waitcnt(0);
        unsigned nloc = b.st[0], nx = b.st[1];
        if (nloc == 0u) { xcd_barrier_complete(bar, b.x, nloc, nx); b.st[0] = nloc; b.st[1] = nx; }
        const unsigned old = xb_add(&bar[XB_XSUB(b.x)], 1u);
        const unsigned gen = old / nloc;
        if (old + 1u == (gen + 1u) * nloc) {
            __builtin_amdgcn_fence(__ATOMIC_RELEASE, "agent");
            asm volatile("s_waitcnt vmcnt(0)" ::: "memory");
            const unsigned og = xb_add(&bar[XB_TOP], 1u);
            const unsigned tg = og / nx;
            if (og + 1u == (tg + 1u) * nx) xb_add(&bar[XB_TOPGEN], 1u);
            else XB_SPIN(xb_ld(&bar[XB_TOPGEN]) == tg, bar);
            __builtin_amdgcn_fence(__ATOMIC_ACQUIRE, "agent");
            xb_add(&bar[XB_XGEN(b.x)], 1u);
            asm volatile("s_waitcnt vmcnt(0)" ::: "memory");
        } else {
            XB_SPIN(xb_ld(&bar[XB_XGEN(b.x)]) == gen, bar);
            __builtin_amdgcn_fence(__ATOMIC_ACQUIRE, "agent");
            asm volatile("s_waitcnt vmcnt(0)" ::: "memory");
        }
    }
    __syncthreads();
}

#define GAS __attribute__((address_space(1)))
typedef unsigned short bf16_t;
typedef short bf16x8 __attribute__((ext_vector_type(8)));
typedef short s16x4 __attribute__((ext_vector_type(4)));
typedef float f32x4 __attribute__((ext_vector_type(4)));
typedef float f32x2 __attribute__((ext_vector_type(2)));
typedef float f32x16 __attribute__((ext_vector_type(16)));
typedef unsigned u32x4 __attribute__((ext_vector_type(4)));
typedef unsigned u32x2 __attribute__((ext_vector_type(2)));
typedef LAS unsigned char lds_u8;

constexpr int MTOK = 32768, DM = 1024, SEQ = 4096, NBATCH = 8, NIN = 3584;
constexpr int OFF_RQ = 0, OFF_RK = 512, OFF_RV = 1024, OFF_RG = 1536, OFF_DQ = 2048, OFF_DK = 2560, OFF_DV = 3072;
constexpr int NEXP = 16384, NQ = 2048;
constexpr float EPSF = 1e-6f, LOG2E = 1.4426950408889634f;
constexpr int NWAVES = 8, NTHR = 512;

constexpr size_t WS_CTL = 0, CTL_BYTES = 65536;
constexpr size_t CTL_Q_ATT = 16384, CTL_Q_P6 = 16384 + 1024;
constexpr size_t WS_R1 = WS_CTL + CTL_BYTES;
constexpr size_t WS_SSQ = WS_R1 + (size_t)MTOK * 4;
constexpr size_t WS_ROPE = WS_SSQ + (size_t)MTOK * 16 * 4;
constexpr size_t WS_DECAY = WS_ROPE + (size_t)SEQ * 32 * 8;
constexpr size_t WS_BTAB = WS_DECAY + 2 * 8 * 128 * 4;
constexpr size_t WS_LAM = WS_BTAB + 4 * 128 * 4;
constexpr size_t WS_WIN = 4u << 20;
constexpr size_t WS_WOUT = WS_WIN + (size_t)NIN * DM * 2;
constexpr size_t WS_WPQ = WS_WOUT + (size_t)DM * DM * 2;
constexpr size_t WS_KEYS = WS_WPQ + (size_t)NQ * DM * 2;
constexpr size_t WS_WD = WS_KEYS + (size_t)8 * 2 * 128 * 128 * 2;
constexpr size_t WS_WU = WS_WD + (size_t)NEXP * DM * 2;
constexpr size_t WS_XB = WS_WU + (size_t)NEXP * DM * 2;
constexpr size_t WS_PROJ = WS_XB + (size_t)MTOK * DM * 2;
constexpr size_t WS_MIX = WS_PROJ + (size_t)MTOK * NIN * 2;
constexpr size_t WS_IDX = WS_MIX, WS_GATE = WS_MIX + (size_t)MTOK * 128 * 4;
constexpr size_t WS_X1B = WS_PROJ + (size_t)MTOK * NQ * 2;
static_assert(WS_X1B + (size_t)MTOK * DM * 2 <= WS_MIX, "ws map");
constexpr size_t WS_END = WS_MIX + (size_t)MTOK * DM * 2;
static_assert(WS_LAM + 256 <= WS_WIN, "ws map");
static_assert(WS_END <= (size_t)512 << 20, "ws map");

constexpr int LDS_SCRATCH = 139264;
constexpr int MISC_OFF = LDS_SCRATCH;
constexpr int LDS_BYTES = 147456;

__device__ __forceinline__ float wave_sum(float v) {
    v += __uint_as_float(__builtin_amdgcn_update_dpp(0u, __float_as_uint(v), 0xB1, 0xf, 0xf, true));
    v += __uint_as_float(__builtin_amdgcn_update_dpp(0u, __float_as_uint(v), 0x4E, 0xf, 0xf, true));
    v += __uint_as_float(__builtin_amdgcn_update_dpp(0u, __float_as_uint(v), 0x141, 0xf, 0xf, true));
    v += __uint_as_float(__builtin_amdgcn_update_dpp(0u, __float_as_uint(v), 0x140, 0xf, 0xf, true));
    { auto rr = __builtin_amdgcn_permlane16_swap(__float_as_uint(v), __float_as_uint(v), false, false); v = __uint_as_float(rr[0]) + __uint_as_float(rr[1]); }
    { auto rr = __builtin_amdgcn_permlane32_swap(__float_as_uint(v), __float_as_uint(v), false, false); v = __uint_as_float(rr[0]) + __uint_as_float(rr[1]); }
    return v;
}
typedef __bf16 bf16v2_t __attribute__((ext_vector_type(2)));
__device__ __forceinline__ unsigned pk2(float lo, float hi) { const bf16v2_t v = {(__bf16)lo, (__bf16)hi}; return __builtin_bit_cast(unsigned, v); }
__device__ __forceinline__ float bf2f(unsigned short b) { return __uint_as_float(((unsigned)b) << 16); }
#define LDS_WAIT() asm volatile("s_waitcnt lgkmcnt(0)" ::: "memory")
#define VM_WAIT() asm volatile("s_waitcnt vmcnt(0)" ::: "memory")

struct Args {
    const float* in[17]; float* out; unsigned char* ws; int ph_lo, ph_hi;
};

template <int MODE>
__device__ __forceinline__ void p0_transpose_item(const float* W, const float* scale, int K, int N, bf16_t* WT, LAS float* scr, int item, int lane) {
    const int nblk = N / 32, kb = item / nblk, nb = item % nblk, k0 = 64 * kb, n0 = 32 * nb;
#pragma unroll 8
    for (int i = 0; i < 32; ++i) { const int kk = 2 * i + (lane >> 5); const float sc = scale ? scale[k0 + kk] : 1.0f; scr[kk * 33 + (lane & 31)] = W[(size_t)(k0 + kk) * N + n0 + (lane & 31)] * sc; }
    LDS_WAIT();
    const int c = lane & 7;
#pragma unroll
    for (int j = 0; j < 4; ++j) { const int n = (lane >> 3) + 8 * j; const LAS float* s = scr + (8 * c) * 33 + n;
        u32x4 o; o.x = pk2(s[0 * 33], s[1 * 33]); o.y = pk2(s[2 * 33], s[3 * 33]); o.z = pk2(s[4 * 33], s[5 * 33]); o.w = pk2(s[6 * 33], s[7 * 33]);
        int nn = n0 + n;
        if (MODE == 1 && nn < 1024) { const int d = nn & 63; nn = (nn & ~63) + ((d < 32) ? 2 * d : 2 * (d - 32) + 1); }
        *(GAS u32x4*)(WT + (size_t)nn * K + k0 + 8 * c) = o; }
    LDS_WAIT();
}

__device__ __forceinline__ int t5_bucket(int n) {
    if (n < 16) return n;
    const float v = logf((float)n / 16.0f) / 2.0794415416798357f * 16.0f;
    int b = 16 + (int)v; return b > 31 ? 31 : b;
}

__device__ __forceinline__ void p0_prologue(const Args& a, lds_u8* lds, int gw, int NGW, int lane, int wave) {
    unsigned char* ws = a.ws;
    const float* x = a.in[0];
    bf16_t* xb = (bf16_t*)(ws + WS_XB); float* r1 = (float*)(ws + WS_R1);
    for (int m0 = gw; m0 < MTOK; m0 += 4 * NGW) {
        f32x4 v[4][4];
#pragma unroll
        for (int r = 0; r < 4; ++r) { const int m = m0 + r * NGW; const GAS f32x4* xr = (const GAS f32x4*)(x + (size_t)(m < MTOK ? m : m0) * DM) + lane;
#pragma unroll
            for (int j = 0; j < 4; ++j) v[r][j] = xr[64 * j]; }
#pragma unroll
        for (int r = 0; r < 4; ++r) { const int m = m0 + r * NGW; if (m >= MTOK) break;
            float s = 0.f;
#pragma unroll
            for (int j = 0; j < 4; ++j) s += (v[r][j].x * v[r][j].x + v[r][j].y * v[r][j].y) + (v[r][j].z * v[r][j].z + v[r][j].w * v[r][j].w);
            s = wave_sum(s);
            GAS u32x2* o8 = (GAS u32x2*)(xb + (size_t)m * DM) + lane;
#pragma unroll
            for (int j = 0; j < 4; ++j) { u32x2 o; o.x = pk2(v[r][j].x, v[r][j].y); o.y = pk2(v[r][j].z, v[r][j].w); o8[64 * j] = o; }
            if (lane == 0) r1[m] = 1.0f / sqrtf(s * (1.0f / DM) + EPSF); }
    }
    {
        LAS float* scr = (LAS float*)(lds + wave * 8704);
        constexpr int I_IN = (DM / 64) * (NIN / 32);
        for (int it = gw; it < I_IN; it += NGW) p0_transpose_item<1>(a.in[2], a.in[1], DM, NIN, (bf16_t*)(ws + WS_WIN), scr, it, lane);
    }
    const int gt = gw * 64 + lane, NGT = NGW * 64;
    {
        f32x2* rope = (f32x2*)(ws + WS_ROPE);
        for (int i = gt; i < SEQ * 32; i += NGT) { const int pos = i >> 5, j = i & 31; const float fr = (float)pow(10000.0, -(double)j / 32.0); const float ang = (float)pos * fr;
            rope[i] = (f32x2){(float)cos((double)ang), (float)sin((double)ang)}; }
        float* dec = (float*)(ws + WS_DECAY);
        for (int i = gt; i < 2 * 8 * 128; i += NGT) { const int l = i & 127, h = (i >> 7) & 7, kk = i >> 10; const double lg = log2(1.0 - exp2(-5.0 - (double)h));
            dec[i] = kk ? (float)(0.125 * exp2(-lg * (double)l)) : (float)exp2(lg * (double)l); }
        float* bt = (float*)(ws + WS_BTAB); const float* rb = a.in[9];
        for (int i = gt; i < 4 * 128; i += NGT) { const int n = i & 127, h = i >> 7; bt[i] = rb[t5_bucket(n) * 4 + h] * LOG2E; }
        if (gt == 0) { float s1 = 0.f, s2 = 0.f; for (int i = 0; i < 64; ++i) { s1 += a.in[4][i] * a.in[5][i]; s2 += a.in[6][i] * a.in[7][i]; }
            ((float*)(ws + WS_LAM))[0] = expf(s1) - expf(s2) + 0.2f; }
    }
}


constexpr int DEF_T0 = 192, DEF_T1 = 64, DEF_T2 = 512, DEF_T3 = 512, DEF_ITEMS = DEF_T0 + DEF_T1 + DEF_T2 + DEF_T3;
__device__ __forceinline__ void p0_deferred(const Args& a, lds_u8* lds, int item) {
    unsigned char* ws = a.ws;
    int tid_ = threadIdx.x; asm volatile("" : "+v"(tid_));
    const int tid = tid_, lane = tid & 63; const int wave = __builtin_amdgcn_readfirstlane(tid >> 6);
    if (item < DEF_T0) {
        LAS float* scr = (LAS float*)(lds + wave * 8704);
        constexpr int I_OUT = (DM / 64) * (DM / 32), I_PQ = (DM / 64) * (NQ / 32);
        static_assert(I_OUT + I_PQ == DEF_T0 * 8, "deferred transposes");
        const int r = item * 8 + wave;
        if (r < I_OUT) p0_transpose_item<0>(a.in[10], nullptr, DM, DM, (bf16_t*)(ws + WS_WOUT), scr, r, lane);
        else p0_transpose_item<0>(a.in[12], a.in[11], DM, NQ, (bf16_t*)(ws + WS_WPQ), scr, r - I_OUT, lane);
        return;
    }
    item -= DEF_T0;
    if (item < DEF_T1) {
        const float* pk = a.in[13]; bf16_t* kb = (bf16_t*)(ws + WS_KEYS);
        const int i = item * 512 + tid;
        const GAS f32x4* s = (const GAS f32x4*)(pk + (size_t)i * 8); const f32x4 p = s[0], q = s[1];
        u32x4 o; o.x = pk2(p.x, p.y); o.y = pk2(p.z, p.w); o.z = pk2(q.x, q.y); o.w = pk2(q.z, q.w); *(GAS u32x4*)(kb + (size_t)i * 8) = o;
        return;
    }
    item -= DEF_T1;
    const float* dn = a.in[14]; const float* up = a.in[15]; const float* gf = a.in[11];
    unsigned char* wd = ws + WS_WD; unsigned char* wu = ws + WS_WU;
    const bool isup = item < DEF_T2; if (!isup) item -= DEF_T2;
    const float* src = (isup ? up : dn) + (size_t)(item * 32 + wave * 4) * DM + lane * 4;
    f32x4 g[4];
#pragma unroll
    for (int k = 0; k < 4; ++k) g[k] = isup ? (f32x4){6.0f, 6.0f, 6.0f, 6.0f} : *(const GAS f32x4*)(gf + k * 256 + lane * 4) * 64.0f;
    f32x4 v[4][4];
#pragma unroll
    for (int r = 0; r < 4; ++r)
#pragma unroll
        for (int k = 0; k < 4; ++k) v[r][k] = *(const GAS f32x4*)(src + (size_t)r * DM + k * 256);
#pragma unroll
    for (int r = 0; r < 4; ++r) {
        const int e = item * 32 + wave * 4 + r;
#pragma unroll
        for (int k = 0; k < 4; ++k) {
            const f32x4 p = v[r][k] * g[k];
            unsigned w = __builtin_amdgcn_cvt_scalef32_pk_fp4_f32(0u, p.x, p.y, 1.0f, 0);
            w = __builtin_amdgcn_cvt_scalef32_pk_fp4_f32(w, p.z, p.w, 1.0f, 1);
            unsigned char* dst = isup ? wu + (size_t)e * 512 + k * 128 + lane * 2 : wd + (size_t)k * ((size_t)NEXP * 128) + (size_t)e * 128 + lane * 2;
            *(GAS unsigned short*)dst = (unsigned short)w;
        }
    }
}

__device__ __forceinline__ f32x4 bf4_lo(u32x4 w) { return (f32x4){__uint_as_float(w.x << 16), __uint_as_float(w.x & 0xffff0000u), __uint_as_float(w.y << 16), __uint_as_float(w.y & 0xffff0000u)}; }
__device__ __forceinline__ f32x4 bf4_hi(u32x4 w) { return (f32x4){__uint_as_float(w.z << 16), __uint_as_float(w.z & 0xffff0000u), __uint_as_float(w.w << 16), __uint_as_float(w.w & 0xffff0000u)}; }
struct EpiProj {
    static constexpr bool PERM = true, AFTER_DRAIN = false;
    bf16_t* P; const float* r1; const f32x4* rope; const float* decay;
    __device__ __forceinline__ void operator()(const f32x4 (&acc)[2][2][4][2], const pg8::Unit& u, int wr, int wc, int fr, int fq) const {
        const int row0 = u.pm * 256 + wr * 64 + fr, seg = u.pn >> 1;
        float rsv[2][4];
#pragma unroll
        for (int ai = 0; ai < 2; ++ai)
#pragma unroll
            for (int m = 0; m < 4; ++m) rsv[ai][m] = *(const GAS float*)(r1 + row0 + ai * 128 + m * 16);
        if (seg <= 1) {
#pragma unroll
            for (int ai = 0; ai < 2; ++ai) {
                f32x4 ra[4][2], rb[4][2]; float ff[4][2];
#pragma unroll
                for (int m = 0; m < 4; ++m)
#pragma unroll
                    for (int bj = 0; bj < 2; ++bj) {
                        const int row = row0 + ai * 128 + m * 16, c0 = u.pn * 256 + bj * 128 + wc * 32 + 8 * fq;
                        const int pos = row & (SEQ - 1), l = row & 127, head = (c0 & 511) >> 6, jb = (c0 & 63) >> 1;
                        const GAS f32x4* rp = (const GAS f32x4*)rope + ((size_t)pos * 32 + jb) / 2; ra[m][bj] = rp[0]; rb[m][bj] = rp[1];
                        ff[m][bj] = *(const GAS float*)(decay + (seg * 8 + head) * 128 + l);
                    }
#pragma unroll
                for (int m = 0; m < 4; ++m)
#pragma unroll
                    for (int bj = 0; bj < 2; ++bj) {
                        const int row = row0 + ai * 128 + m * 16, c0 = u.pn * 256 + bj * 128 + wc * 32 + 8 * fq;
                        const f32x4 v0 = acc[ai][bj][m][0] * rsv[ai][m], v1 = acc[ai][bj][m][1] * rsv[ai][m];
                        const f32x4 a_ = ra[m][bj], b_ = rb[m][bj]; const float f = ff[m][bj];
                        f32x4 w0, w1;
                        w0.x = (v0.x * a_.x - v0.y * a_.y) * f; w0.y = (v0.y * a_.x + v0.x * a_.y) * f;
                        w0.z = (v0.z * a_.z - v0.w * a_.w) * f; w0.w = (v0.w * a_.z + v0.z * a_.w) * f;
                        w1.x = (v1.x * b_.x - v1.y * b_.y) * f; w1.y = (v1.y * b_.x + v1.x * b_.y) * f;
                        w1.z = (v1.z * b_.z - v1.w * b_.w) * f; w1.w = (v1.w * b_.z + v1.z * b_.w) * f;
                        u32x4 w; w.x = pk2(w0.x, w0.y); w.y = pk2(w0.z, w0.w); w.z = pk2(w1.x, w1.y); w.w = pk2(w1.z, w1.w);
                        *(GAS u32x4*)(P + (size_t)row * NIN + c0) = w;
                    }
            }
        } else {
#pragma unroll
            for (int ai = 0; ai < 2; ++ai)
#pragma unroll
                for (int m = 0; m < 4; ++m)
#pragma unroll
                    for (int bj = 0; bj < 2; ++bj) {
                        const int row = row0 + ai * 128 + m * 16, c0 = u.pn * 256 + bj * 128 + wc * 32 + 8 * fq;
                        f32x4 v0 = acc[ai][bj][m][0] * rsv[ai][m], v1 = acc[ai][bj][m][1] * rsv[ai][m];
                        if (seg == 3) {
#pragma unroll
                            for (int j = 0; j < 4; ++j) { v0[j] = v0[j] / (1.0f + __expf(-v0[j])); v1[j] = v1[j] / (1.0f + __expf(-v1[j])); }
                        } else if (seg == 4) { v0 = v0 * (0.125f * LOG2E); v1 = v1 * (0.125f * LOG2E); }
                        u32x4 w; w.x = pk2(v0.x, v0.y); w.y = pk2(v0.z, v0.w); w.z = pk2(v1.x, v1.y); w.w = pk2(v1.z, v1.w);
                        *(GAS u32x4*)(P + (size_t)row * NIN + c0) = w;
                    }
        }
    }
};
struct EpiX1 {
    static constexpr bool PERM = true, AFTER_DRAIN = false;
    const bf16_t* XB; bf16_t* X1B; bf16_t* ssq;
    __device__ __forceinline__ void operator()(const f32x4 (&acc)[2][2][4][2], const pg8::Unit& u, int wr, int wc, int fr, int fq) const {
        const int row0 = u.pm * 256 + wr * 64 + fr, c00 = u.pn * 256 + wc * 32 + 8 * fq;
        u32x4 xin[2][4][2];
#pragma unroll
        for (int ai = 0; ai < 2; ++ai)
#pragma unroll
            for (int m = 0; m < 4; ++m)
#pragma unroll
                for (int bj = 0; bj < 2; ++bj) xin[ai][m][bj] = *(const GAS u32x4*)(XB + (size_t)(row0 + ai * 128 + m * 16) * DM + c00 + bj * 128);
#pragma unroll
        for (int ai = 0; ai < 2; ++ai)
#pragma unroll
            for (int m = 0; m < 4; ++m) {
                const int row = row0 + ai * 128 + m * 16; float ss = 0.f;
#pragma unroll
                for (int bj = 0; bj < 2; ++bj) {
                    const f32x4 o0 = acc[ai][bj][m][0] + bf4_lo(xin[ai][m][bj]), o1 = acc[ai][bj][m][1] + bf4_hi(xin[ai][m][bj]);
                    u32x4 w; w.x = pk2(o0.x, o0.y); w.y = pk2(o0.z, o0.w); w.z = pk2(o1.x, o1.y); w.w = pk2(o1.z, o1.w);
                    *(GAS u32x4*)(X1B + (size_t)row * DM + c00 + bj * 128) = w;
                    ss += ((o0.x * o0.x + o0.y * o0.y) + (o0.z * o0.z + o0.w * o0.w)) + ((o1.x * o1.x + o1.y * o1.y) + (o1.z * o1.z + o1.w * o1.w));
                }
                ss += __shfl_xor(ss, 16); ss += __shfl_xor(ss, 32);
                if (fq == 0) *(GAS bf16_t*)(ssq + (size_t)row * 16 + u.pn * 4 + wc) = (bf16_t)(pk2(ss, 0.f) & 0xffffu);
            }
    }
};
__device__ __forceinline__ float rs2_from(u32x4 a, u32x4 b) {
    const f32x4 p = bf4_lo(a) + bf4_hi(a) + bf4_lo(b) + bf4_hi(b);
    return 1.0f / sqrtf(((p.x + p.y) + (p.z + p.w)) * (1.0f / DM) + EPSF);
}
__device__ __forceinline__ float row_rs2(const bf16_t* ssq, int row) {
    const GAS u32x4* p = (const GAS u32x4*)(ssq + (size_t)row * 16); return rs2_from(p[0], p[1]);
}
struct EpiQ {
    static constexpr bool PERM = true, AFTER_DRAIN = false;
    bf16_t* Q; const bf16_t* ssq;
    __device__ __forceinline__ void operator()(const f32x4 (&acc)[2][2][4][2], const pg8::Unit& u, int wr, int wc, int fr, int fq) const {
        const int row0 = u.pm * 256 + wr * 64 + fr;
        u32x4 sa[2][4], sb[2][4];
#pragma unroll
        for (int ai = 0; ai < 2; ++ai)
#pragma unroll
            for (int m = 0; m < 4; ++m) { const GAS u32x4* p = (const GAS u32x4*)(ssq + (size_t)(row0 + ai * 128 + m * 16) * 16); sa[ai][m] = p[0]; sb[ai][m] = p[1]; }
#pragma unroll
        for (int ai = 0; ai < 2; ++ai)
#pragma unroll
            for (int m = 0; m < 4; ++m) {
                const int row = row0 + ai * 128 + m * 16; const float rs = rs2_from(sa[ai][m], sb[ai][m]);
#pragma unroll
                for (int bj = 0; bj < 2; ++bj) {
                    const int c0 = u.pn * 256 + bj * 128 + wc * 32 + 8 * fq;
                    const f32x4 v0 = acc[ai][bj][m][0] * rs, v1 = acc[ai][bj][m][1] * rs;
                    u32x4 w; w.x = pk2(v0.x, v0.y); w.y = pk2(v0.z, v0.w); w.z = pk2(v1.x, v1.y); w.w = pk2(v1.z, v1.w);
                    *(GAS u32x4*)(Q + (size_t)row * NQ + c0) = w;
                }
            }
    }
};

#define MFMA32(a, b, c) __builtin_amdgcn_mfma_f32_32x32x16_bf16(a, b, c, 0, 0, 0)
typedef short v4i16_t __attribute__((ext_vector_type(4)));
__device__ __forceinline__ s16x4 vtr(const lds_u8* p) { return __builtin_bit_cast(s16x4, __builtin_amdgcn_ds_read_tr16_b64_v4i16((LAS v4i16_t*)p)); }
__device__ __forceinline__ bf16x8 vfrag(const lds_u8* p) { const s16x4 lo = vtr(p), hi = vtr(p + 512); return (bf16x8){lo[0], lo[1], lo[2], lo[3], hi[0], hi[1], hi[2], hi[3]}; }
__device__ __forceinline__ bf16x8 ldsb128(const lds_u8* p) { return *(const LAS bf16x8*)p; }
__device__ __forceinline__ int crow(int r, int hi) { return (r & 3) + 8 * (r >> 2) + 4 * hi; }
__device__ __forceinline__ void glds16(const void* g, lds_u8* l) {
    unsigned sv; const unsigned lb = (unsigned)__builtin_amdgcn_readfirstlane((int)(unsigned)(uintptr_t)l);
    asm volatile("s_mov_b32 %0, m0\n\ts_mov_b32 m0, %2\n\ts_nop 0\n\tglobal_load_lds_dwordx4 %1, off\n\ts_mov_b32 m0, %0" : "=&s"(sv) : "v"(g), "s"(lb) : "memory");
}
__device__ __forceinline__ float swap_sum(float v) { auto rr = __builtin_amdgcn_permlane32_swap(__float_as_uint(v), __float_as_uint(v), false, false); return __uint_as_float(rr[0]) + __uint_as_float(rr[1]); }
__device__ __forceinline__ float swap_max(float v) { auto rr = __builtin_amdgcn_permlane32_swap(__float_as_uint(v), __float_as_uint(v), false, false); return __builtin_fmaxf(__uint_as_float(rr[0]), __uint_as_float(rr[1])); }

constexpr int ATT_SLOT = 32768, ATT_XCH = 65536, ATT_XPITCH = 528, ATT_BTAB = ATT_XCH + 128 * ATT_XPITCH;
static_assert(ATT_BTAB + 512 <= LDS_SCRATCH, "attention LDS");

template <int MODE>
__device__ __forceinline__ void attn_unit(const Args& a, lds_u8* lds, int b, int h, int qb) {
    int tid_ = threadIdx.x; asm volatile("" : "+v"(tid_));
    const int tid = tid_, lane = tid & 63, r32 = lane & 31, hi = lane >> 5; const int wid = __builtin_amdgcn_readfirstlane(tid >> 6);
    const int rgp = wid & 3, map = wid >> 2;
    const bf16_t* proj = (const bf16_t*)(a.ws + WS_PROJ);
    const size_t rowbase = (size_t)b * SEQ; const int q0 = qb * 128, NT = 2 * qb + 2;
    const float lam = ((const float*)(a.ws + WS_LAM))[0];
    if (tid < 128) ((LAS float*)(lds + ATT_BTAB))[tid] = ((const float*)(a.ws + WS_BTAB))[h * 128 + tid];
    bf16x8 qf[4];
    { const bf16_t* qp = proj + (rowbase + q0 + rgp * 32 + r32) * NIN + OFF_DQ + h * 128 + map * 64 + hi * 8;
#pragma unroll
      for (int s = 0; s < 4; ++s) qf[s] = *(const GAS bf16x8*)(qp + s * 16); }
    asm volatile("" : "+v"(qf[0]), "+v"(qf[1]), "+v"(qf[2]), "+v"(qf[3]));
    const int krow = 8 * wid + (lane >> 3);
    const bf16_t* k1src = proj + (rowbase + krow) * NIN + OFF_DK + h * 128 + ((lane & 7) ^ ((krow >> 1) & 7)) * 8;
    const bf16_t* k2src = k1src + 64;
    const bf16_t* vsrc0 = proj + (rowbase + 16 * ((2 * wid) & 3) + (lane >> 2)) * NIN + OFF_DV + h * 128 + 32 * ((2 * wid) >> 2) + (lane & 3) * 8;
    const bf16_t* vsrc1 = proj + (rowbase + 16 * ((2 * wid + 1) & 3) + (lane >> 2)) * NIN + OFF_DV + h * 128 + 32 * ((2 * wid + 1) >> 2) + (lane & 3) * 8;
#define ATT_DMA(t, slot) do { const size_t go = (size_t)(t) * 64 * NIN; lds_u8* sb = lds + (slot) * ATT_SLOT; \
        glds16(k1src + go, sb + wid * 1024); glds16(k2src + go, sb + 8192 + wid * 1024); \
        glds16(vsrc0 + go, sb + 16384 + (2 * wid) * 1024); glds16(vsrc1 + go, sb + 16384 + (2 * wid + 1) * 1024); } while (0)
    const int koff = map * 8192 + r32 * 128, ksw = (r32 >> 1) & 7;
    const int voff = 16384 + ((lane >> 4) & 1) * 32 + (lane & 3) * 8 + (4 * hi + ((lane & 15) >> 2)) * 64;
    f32x16 o[4];
#pragma unroll
    for (int d = 0; d < 4; ++d) o[d] = f32x16{};
    float mrun = -INFINITY, lrun = 0.f;
    const int qpos = q0 + rgp * 32 + r32;
    float b31 = ((const float*)(a.ws + WS_BTAB))[h * 128 + 127]; asm volatile("" : "+v"(b31));
    ATT_DMA(0, 0);
    for (int t = 0; t < NT; ++t) {
        if (!(MODE & 32) || t < 2) { VM_WAIT(); __syncthreads(); }
        if (t + 1 < NT && (!(MODE & 8) || t + 1 < 2)) ATT_DMA(t + 1, (t + 1) & 1);
        if (64 * t > q0 + rgp * 32 + 31) continue;
        const lds_u8* sb = lds + (t & 1) * ATT_SLOT;
        const bool nearT = (64 * t + 176 > q0);
        const float cb = nearT ? 0.f : b31;
        f32x16 sA, sB;
        { const float c0 = (t == 0) ? 0.f : cb - mrun;
#pragma unroll
          for (int r = 0; r < 16; ++r) { sA[r] = c0; sB[r] = c0; } }
        if (MODE & 1) {
            bf16x8 kf[8];
#pragma unroll
            for (int d0 = 0; d0 < 4; ++d0) { const int kc = koff + (((2 * d0 + hi) ^ ksw) << 4); if (MODE & 16) { kf[2 * d0] = qf[d0]; kf[2 * d0 + 1] = qf[3 - d0]; } else { kf[2 * d0] = ldsb128(sb + kc); kf[2 * d0 + 1] = ldsb128(sb + kc + 4096); } }
            __builtin_amdgcn_sched_group_barrier(0x100, 8, 0);
#pragma unroll
            for (int d0 = 0; d0 < 4; ++d0) { sA = MFMA32(kf[2 * d0], qf[d0], sA); sB = MFMA32(kf[2 * d0 + 1], qf[d0], sB); }
            __builtin_amdgcn_sched_group_barrier(0x8, 8, 0);
        }
        if (!(MODE & 1)) asm volatile("" : "+v"(sA), "+v"(sB));
        if (MODE & 4) {
        if (nearT) {
            const LAS float* bt = (const LAS float*)(lds + ATT_BTAB);
            float bA[16], bB[16];
#pragma unroll
            for (int r = 0; r < 16; ++r) { const int d0 = qpos - (64 * t + crow(r, hi)), d1 = d0 - 32;
                bA[r] = bt[d0 < 0 ? 0 : (d0 > 127 ? 127 : d0)]; bB[r] = bt[d1 < 0 ? 0 : (d1 > 127 ? 127 : d1)]; }
            asm volatile("" : "+v"(bA[0]), "+v"(bA[1]), "+v"(bA[2]), "+v"(bA[3]), "+v"(bA[4]), "+v"(bA[5]), "+v"(bA[6]), "+v"(bA[7]), "+v"(bA[8]), "+v"(bA[9]), "+v"(bA[10]), "+v"(bA[11]), "+v"(bA[12]), "+v"(bA[13]), "+v"(bA[14]), "+v"(bA[15]));
            asm volatile("" : "+v"(bB[0]), "+v"(bB[1]), "+v"(bB[2]), "+v"(bB[3]), "+v"(bB[4]), "+v"(bB[5]), "+v"(bB[6]), "+v"(bB[7]), "+v"(bB[8]), "+v"(bB[9]), "+v"(bB[10]), "+v"(bB[11]), "+v"(bB[12]), "+v"(bB[13]), "+v"(bB[14]), "+v"(bB[15]));
#pragma unroll
            for (int r = 0; r < 16; ++r) { const int d0 = qpos - (64 * t + crow(r, hi)), d1 = d0 - 32;
                sA[r] = d0 < 0 ? -INFINITY : sA[r] + bA[r]; sB[r] = d1 < 0 ? -INFINITY : sB[r] + bB[r]; }
        }
#define MX3(a_, b_, c_) __builtin_fmaxf(__builtin_fmaxf((a_), (b_)), (c_))
        float mxa = MX3(sA[0], sA[1], sB[0]), mxb = MX3(sA[2], sA[3], sB[1]); mxa = MX3(mxa, sB[2], sB[3]);
#pragma unroll
        for (int r = 4; r < 16; r += 4) { mxa = MX3(mxa, sA[r], sA[r + 1]); mxb = MX3(mxb, sA[r + 2], sA[r + 3]); mxa = MX3(mxa, sB[r], sB[r + 1]); mxb = MX3(mxb, sB[r + 2], sB[r + 3]); }
#undef MX3
        const float mx = swap_max(__builtin_fmaxf(mxa, mxb));
        if (t == 0 || __any(mx > 6.0f)) {
            const float up = (t == 0) ? mx : __builtin_fmaxf(mx, 0.f), alpha = (t == 0) ? 0.f : __builtin_amdgcn_exp2f(-up);
            mrun = (t == 0) ? mx + cb : mrun + up; lrun *= alpha;
#pragma unroll
            for (int d = 0; d < 4; ++d)
#pragma unroll
                for (int r = 0; r < 16; ++r) o[d][r] *= alpha;
            const float sh = (t == 0) ? mx : up;
#pragma unroll
            for (int r = 0; r < 16; ++r) { sA[r] -= sh; sB[r] -= sh; }
        }
        float ps = 0.f;
#pragma unroll
        for (int r = 0; r < 16; ++r) { sA[r] = __builtin_amdgcn_exp2f(sA[r]); sB[r] = __builtin_amdgcn_exp2f(sB[r]); ps += sA[r] + sB[r]; }
        lrun += ps;
        } else { asm volatile("" : "+v"(sA), "+v"(sB)); }
        u32x4 pw[4];
        pw[0] = (u32x4){pk2(sA[0], sA[1]), pk2(sA[2], sA[3]), pk2(sA[4], sA[5]), pk2(sA[6], sA[7])};
        pw[1] = (u32x4){pk2(sA[8], sA[9]), pk2(sA[10], sA[11]), pk2(sA[12], sA[13]), pk2(sA[14], sA[15])};
        pw[2] = (u32x4){pk2(sB[0], sB[1]), pk2(sB[2], sB[3]), pk2(sB[4], sB[5]), pk2(sB[6], sB[7])};
        pw[3] = (u32x4){pk2(sB[8], sB[9]), pk2(sB[10], sB[11]), pk2(sB[12], sB[13]), pk2(sB[14], sB[15])};
        if (!(MODE & 2)) { asm volatile("" :: "v"(pw[0]), "v"(pw[1]), "v"(pw[2]), "v"(pw[3])); continue; }
        {
            bf16x8 vfa[4], vfb[4];
#pragma unroll
            for (int d = 0; d < 4; ++d) vfa[d] = (MODE & 16) ? qf[d] : vfrag(sb + voff + d * 4096);
            __builtin_amdgcn_sched_group_barrier(0x100, 8, 0);
#pragma unroll
            for (int ks = 0; ks < 4; ks += 2) {
#pragma unroll
                for (int d = 0; d < 4; ++d) vfb[d] = (MODE & 16) ? qf[3 - d] : vfrag(sb + voff + d * 4096 + (ks + 1) * 1024);
                __builtin_amdgcn_sched_group_barrier(0x100, 8, 0);
                { const bf16x8 pb = __builtin_bit_cast(bf16x8, pw[ks]);
#pragma unroll
                  for (int d = 0; d < 4; ++d) o[d] = MFMA32(vfa[d], pb, o[d]); }
                __builtin_amdgcn_sched_group_barrier(0x8, 4, 0);
                if (ks + 2 < 4) {
#pragma unroll
                    for (int d = 0; d < 4; ++d) vfa[d] = (MODE & 16) ? qf[d] : vfrag(sb + voff + d * 4096 + (ks + 2) * 1024);
                    __builtin_amdgcn_sched_group_barrier(0x100, 8, 0);
                }
                { const bf16x8 pb = __builtin_bit_cast(bf16x8, pw[ks + 1]);
#pragma unroll
                  for (int d = 0; d < 4; ++d) o[d] = MFMA32(vfb[d], pb, o[d]); }
                __builtin_amdgcn_sched_group_barrier(0x8, 4, 0);
            }
        }
    }
    const float inv = 1.0f / swap_sum(lrun);
    LAS float* xch = (LAS float*)(lds + ATT_XCH + (rgp * 32 + r32) * ATT_XPITCH);
    if (map == 1) {
        const float sc = inv * lam;
#pragma unroll
        for (int d = 0; d < 4; ++d)
#pragma unroll
            for (int g = 0; g < 4; ++g) *(LAS f32x4*)(xch + 32 * d + 8 * g + 4 * hi) = (f32x4){o[d][4 * g] * sc, o[d][4 * g + 1] * sc, o[d][4 * g + 2] * sc, o[d][4 * g + 3] * sc};
    }
    __syncthreads();
    if (map == 0) {
        float ss = 0.f;
#pragma unroll
        for (int d = 0; d < 4; ++d)
#pragma unroll
            for (int g = 0; g < 4; ++g) { const f32x4 o2 = *(const LAS f32x4*)(xch + 32 * d + 8 * g + 4 * hi);
#pragma unroll
                for (int j = 0; j < 4; ++j) { const float v = o[d][4 * g + j] * inv - o2[j]; o[d][4 * g + j] = v; ss += v * v; } }
        ss = swap_sum(ss);
        const float rn = 0.8f / sqrtf(ss * (1.0f / 128.0f) + EPSF);
        const float* sub = a.in[8];
        bf16_t* mixp = (bf16_t*)(a.ws + WS_MIX) + (rowbase + qpos) * DM + 512 + h * 128;
#pragma unroll
        for (int d = 0; d < 4; ++d)
#pragma unroll
            for (int g = 0; g < 4; ++g) { const int dd = 32 * d + 8 * g + 4 * hi; const f32x4 sv = *(const GAS f32x4*)(sub + dd);
                u32x2 w; w.x = pk2(o[d][4 * g] * rn * sv.x, o[d][4 * g + 1] * rn * sv.y); w.y = pk2(o[d][4 * g + 2] * rn * sv.z, o[d][4 * g + 3] * rn * sv.w);
                *(GAS u32x2*)(mixp + dd) = w; }
    }
    __syncthreads();
#undef ATT_DMA
}

constexpr int RET_BUF = 49152, RET_RT = 2 * RET_BUF, RET_GN = RET_RT + 8192;
static_assert(RET_GN + 2048 <= LDS_SCRATCH, "retention LDS");

__device__ __forceinline__ void ret_unit(const Args& a, lds_u8* lds, int b, int h) {
    int tid_ = threadIdx.x; asm volatile("" : "+v"(tid_));
    const int tid = tid_, lane = tid & 63, r32 = lane & 31, hi = lane >> 5; const int wid = __builtin_amdgcn_readfirstlane(tid >> 6);
    const int rgp = wid & 3, eh = wid >> 2;
    const bf16_t* proj = (const bf16_t*)(a.ws + WS_PROJ);
    const size_t rowbase = (size_t)b * SEQ;
    const double lg = log2(1.0 - exp2(-5.0 - (double)h));
    const float gam = (float)exp2(lg), g127 = (float)exp2(lg * 127.0), g128 = (float)exp2(lg * 128.0);
#define RET_DMA(c, buf) do { const size_t ro = (rowbase + (size_t)(c) * 128) * NIN; lds_u8* bb = lds + (buf) * RET_BUF; \
        _Pragma("unroll") for (int i_ = 0; i_ < 2; ++i_) { const int p_ = 2 * wid + i_; \
            { const int ch = p_ >> 1, rh = p_ & 1; glds16(proj + ro + (size_t)(rh * 64 + lane) * NIN + OFF_RK + h * 64 + ch * 8, bb + ch * 2048 + rh * 1024); } \
            { const int db = p_ >> 3, rg_ = p_ & 7; glds16(proj + ro + (size_t)(rg_ * 16 + (lane >> 2)) * NIN + OFF_RK + h * 64 + db * 32 + (lane & 3) * 8, bb + 16384 + db * 8192 + rg_ * 1024); \
              glds16(proj + ro + (size_t)(rg_ * 16 + (lane >> 2)) * NIN + OFF_RV + h * 64 + db * 32 + (lane & 3) * 8, bb + 32768 + db * 8192 + rg_ * 1024); } } } while (0)
    const int koff = hi * 2048 + r32 * 16;
    const int troff = ((lane >> 4) & 1) * 32 + (lane & 3) * 8 + (4 * hi + ((lane & 15) >> 2)) * 64;
    f32x16 R = f32x16{};
    for (int i = tid; i < 8192 / 16; i += NTHR) *(LAS u32x4*)(lds + RET_RT + i * 16) = (u32x4){0u, 0u, 0u, 0u};
    const float* gn = a.in[3];
    f32x4 gv[4];
#pragma unroll
    for (int g = 0; g < 4; ++g) gv[g] = *(const GAS f32x4*)(gn + h * 64 + eh * 32 + 8 * g + 4 * hi);
    bf16x8 qn[4]; u32x2 svn[4];
#define RET_PREF(c) do { const size_t tk_ = rowbase + (size_t)(c) * 128 + rgp * 32 + r32; const bf16_t* qp_ = proj + tk_ * NIN + OFF_RQ + h * 64 + hi * 8; const bf16_t* sg_ = proj + tk_ * NIN + OFF_RG + h * 64 + eh * 32 + 4 * hi; \
        _Pragma("unroll") for (int s = 0; s < 4; ++s) qn[s] = *(const GAS bf16x8*)(qp_ + s * 16); \
        _Pragma("unroll") for (int g = 0; g < 4; ++g) svn[g] = *(const GAS u32x2*)(sg_ + 8 * g); } while (0)
    RET_PREF(0);
    RET_DMA(0, 0);
    for (int c = 0; c < 32; ++c) {
        VM_WAIT(); __syncthreads();
        bf16x8 qf[4]; u32x2 svc[4];
#pragma unroll
        for (int s = 0; s < 4; ++s) { qf[s] = qn[s]; svc[s] = svn[s]; }
        if (c + 1 < 32) { RET_PREF(c + 1); RET_DMA(c + 1, (c + 1) & 1); }
        const lds_u8* bb = lds + (c & 1) * RET_BUF;
        const size_t tok = rowbase + (size_t)c * 128 + rgp * 32 + r32;
        f32x16 O = f32x16{};
#pragma unroll
        for (int s = 0; s < 4; ++s) { const bf16x8 rt = ldsb128(lds + RET_RT + (2 * s + hi) * 1024 + (eh * 32 + r32) * 16); O = MFMA32(rt, qf[s], O); }
        for (int kb = 0; kb <= rgp; ++kb) {
            f32x16 S = f32x16{};
#pragma unroll
            for (int s = 0; s < 4; ++s) { const bf16x8 ka = ldsb128(bb + koff + s * 4096 + (kb * 32) * 16); S = MFMA32(ka, qf[s], S); }
            if (kb == rgp) {
#pragma unroll
                for (int r = 0; r < 16; ++r) S[r] = (crow(r, hi) > r32) ? 0.f : S[r];
            }
            const u32x4 p0 = (u32x4){pk2(S[0], S[1]), pk2(S[2], S[3]), pk2(S[4], S[5]), pk2(S[6], S[7])};
            const u32x4 p1 = (u32x4){pk2(S[8], S[9]), pk2(S[10], S[11]), pk2(S[12], S[13]), pk2(S[14], S[15])};
            const bf16x8 v0 = vfrag(bb + 32768 + eh * 8192 + troff + (2 * kb) * 1024), v1 = vfrag(bb + 32768 + eh * 8192 + troff + (2 * kb + 1) * 1024);
            O = MFMA32(v0, __builtin_bit_cast(bf16x8, p0), O); O = MFMA32(v1, __builtin_bit_cast(bf16x8, p1), O);
        }
        if (rgp < 2) {
            f32x16 T = f32x16{};
#pragma unroll
            for (int ks = 0; ks < 8; ++ks) { const bf16x8 kt = vfrag(bb + 16384 + rgp * 8192 + troff + ks * 1024), vv = vfrag(bb + 32768 + eh * 8192 + troff + ks * 1024); T = MFMA32(kt, vv, T); }
#pragma unroll
            for (int r = 0; r < 16; ++r) R[r] = R[r] * g128 + T[r] * g127;
        }
        float s1 = 0.f, s2 = 0.f;
#pragma unroll
        for (int r = 0; r < 16; ++r) { s1 += O[r]; s2 += O[r] * O[r]; }
        s1 = swap_sum(s1); s2 = swap_sum(s2);
        LAS f32x2* gx = (LAS f32x2*)(lds + RET_GN);
        if (hi == 0) gx[(rgp * 32 + r32) * 2 + eh] = (f32x2){s1, s2};
        __syncthreads();
        if (rgp < 2) {
#pragma unroll
            for (int g = 0; g < 4; ++g) { u32x2 w; w.x = pk2(R[4 * g] * gam, R[4 * g + 1] * gam); w.y = pk2(R[4 * g + 2] * gam, R[4 * g + 3] * gam);
                *(LAS u32x2*)(lds + RET_RT + (rgp * 4 + g) * 1024 + (eh * 32 + r32) * 16 + hi * 8) = w; }
        }
        const f32x2 ga = gx[(rgp * 32 + r32) * 2], gb = gx[(rgp * 32 + r32) * 2 + 1];
        const float mean = (ga.x + gb.x) * (1.0f / 64.0f), var = (ga.y + gb.y) * (1.0f / 64.0f) - mean * mean;
        const float rstd = 1.0f / sqrtf(__builtin_fmaxf(var, 0.f) + EPSF);
        bf16_t* mixp = (bf16_t*)(a.ws + WS_MIX) + tok * DM + h * 64 + eh * 32;
#pragma unroll
        for (int g = 0; g < 4; ++g) { const int e = 8 * g + 4 * hi; const u32x2 sv = svc[g];
            const float y0 = (O[4 * g] - mean) * rstd * gv[g].x * __uint_as_float(sv.x << 16), y1 = (O[4 * g + 1] - mean) * rstd * gv[g].y * __uint_as_float(sv.x & 0xffff0000u);
            const float y2 = (O[4 * g + 2] - mean) * rstd * gv[g].z * __uint_as_float(sv.y << 16), y3 = (O[4 * g + 3] - mean) * rstd * gv[g].w * __uint_as_float(sv.y & 0xffff0000u);
            u32x2 w; w.x = pk2(y0, y1); w.y = pk2(y2, y3); *(GAS u32x2*)(mixp + e) = w; }
    }
    __syncthreads();
#undef RET_DMA
#undef RET_PREF
}


#define CAS_DESC(x, y) do { const float hi_ = __builtin_fmaxf(x, y), lo_ = __builtin_fminf(x, y); x = hi_; y = lo_; } while (0)
#define CAS_ASC(x, y) do { const float hi_ = __builtin_fmaxf(x, y), lo_ = __builtin_fminf(x, y); x = lo_; y = hi_; } while (0)
__device__ __forceinline__ void sort16_desc(float (&v)[16]) {
#pragma unroll
    for (int k = 2; k <= 16; k <<= 1)
#pragma unroll
        for (int j = k >> 1; j > 0; j >>= 1)
#pragma unroll
            for (int i = 0; i < 16; ++i) { const int l = i ^ j; if (l > i) { if ((i & k) == 0) CAS_DESC(v[i], v[l]); else CAS_ASC(v[i], v[l]); } }
}
__device__ __forceinline__ void bitonic_merge16_desc(float (&v)[16]) {
#pragma unroll
    for (int j = 8; j > 0; j >>= 1)
#pragma unroll
        for (int i = 0; i < 16; ++i) { const int l = i ^ j; if (l > i) CAS_DESC(v[i], v[l]); }
}
__device__ __forceinline__ void merge_top16(float (&a)[16], const float (&b)[16]) {
#pragma unroll
    for (int i = 0; i < 16; ++i) a[i] = __builtin_fmaxf(a[i], b[15 - i]);
    bitonic_merge16_desc(a);
}
__device__ __forceinline__ unsigned pack_idx4(const float (&v)[16], int w) {
    return (__float_as_uint(v[4 * w]) & 127u) | ((__float_as_uint(v[4 * w + 1]) & 127u) << 8) | ((__float_as_uint(v[4 * w + 2]) & 127u) << 16) | ((__float_as_uint(v[4 * w + 3]) & 127u) << 24);
}
__device__ __forceinline__ unsigned lookup_idx(const unsigned (&pk)[4], unsigned i) {
    const unsigned w = i >> 2; unsigned s = w == 0 ? pk[0] : (w == 1 ? pk[1] : (w == 2 ? pk[2] : pk[3]));
    return (s >> ((i & 3u) * 8u)) & 127u;
}

constexpr int P5_KEYB = 32768;
__device__ __forceinline__ void p5_topk(const Args& a, lds_u8* lds) {
    const int tid = threadIdx.x, lane = tid & 63, r32 = lane & 31, hi = lane >> 5; const int wid = __builtin_amdgcn_readfirstlane(tid >> 6);
    const int hp = blockIdx.x & 3, wgi = blockIdx.x >> 2, nwg = (gridDim.x + 3 - hp) / 4;
    const bf16_t* keys = (const bf16_t*)(a.ws + WS_KEYS) + (size_t)hp * 4 * 128 * 128;
    for (int i = tid; i < 4 * 128 * 16; i += NTHR) { const int t = i >> 11, key = (i >> 4) & 127, c = i & 15;
        *(LAS u32x4*)(lds + t * P5_KEYB + c * 2048 + key * 16) = *(const GAS u32x4*)(keys + ((size_t)t * 128 + key) * 128 + c * 8); }
    __syncthreads();
    const bf16_t* Q = (const bf16_t*)(a.ws + WS_PROJ);
    int* IDX = (int*)(a.ws + WS_IDX); float* GATE = (float*)(a.ws + WS_GATE);
    const int tg0 = wgi * NWAVES + wid, tgs = nwg * NWAVES;
    const int ntask = (tg0 < MTOK / 32) ? 4 * ((MTOK / 32 - 1 - tg0) / tgs + 1) : 0;
#define P5_QLOAD(QF, k_) do { const int tg_ = tg0 + ((k_) >> 2) * tgs, t_ = (k_) & 3; \
        const bf16_t* qp = Q + (size_t)(tg_ * 32 + r32) * NQ + (2 * hp + (t_ >> 1)) * 256 + (t_ & 1) * 128 + hi * 8; \
        _Pragma("unroll") for (int s = 0; s < 8; ++s) QF[s] = *(const GAS bf16x8*)(qp + s * 16); } while (0)
    float la[16], lb[16];
#pragma unroll
    for (int r = 0; r < 16; ++r) { la[r] = 0.f; lb[r] = 0.f; }
    bf16x8 qf[8], qn[8];
    if (ntask > 0) P5_QLOAD(qf, 0);
#pragma unroll 1
    for (int k = 0; k < ntask; ++k) {
      {
        const int tg = tg0 + (k >> 2) * tgs, t = k & 3;
        if (k + 1 < ntask) P5_QLOAD(qn, k + 1);
        {
            float top[16];
#pragma unroll
            for (int kb = 0; kb < 4; ++kb) {
                f32x16 S = f32x16{};
#pragma unroll
                for (int s = 0; s < 8; ++s) { const bf16x8 kf = ldsb128(lds + t * P5_KEYB + (2 * s + hi) * 2048 + (kb * 32 + r32) * 16); S = MFMA32(kf, qf[s], S); }
                float v[16];
#pragma unroll
                for (int r = 0; r < 16; ++r) v[r] = __uint_as_float((__float_as_uint(S[r]) & ~127u) | (unsigned)(kb * 32 + (r & 3) + 8 * (r >> 2)) | ((unsigned)hi << 2));
                sort16_desc(v);
                if (kb == 0) {
#pragma unroll
                    for (int r = 0; r < 16; ++r) top[r] = v[r];
                } else merge_top16(top, v);
            }
            float oth[16];
#pragma unroll
            for (int r = 0; r < 16; ++r) { auto rr = __builtin_amdgcn_permlane32_swap(__float_as_uint(top[r]), __float_as_uint(top[r]), false, false); top[r] = __uint_as_float(rr[0]); oth[r] = __uint_as_float(rr[1]); }
            merge_top16(top, oth);
            const bool ka = ((t >> 1) == hi) && ((t & 1) == 0), kb2 = ((t >> 1) == hi) && ((t & 1) == 1);
#pragma unroll
            for (int r = 0; r < 16; ++r) { la[r] = ka ? top[r] : la[r]; lb[r] = kb2 ? top[r] : lb[r]; }
        }
#pragma unroll
        for (int s2 = 0; s2 < 8; ++s2) qf[s2] = qn[s2];
        if (t != 3) continue;
        unsigned pa[4], pb[4];
#pragma unroll
        for (int w = 0; w < 4; ++w) { pa[w] = pack_idx4(la, w); pb[w] = pack_idx4(lb, w); }
        float c0[16], c1[16];
#define CAND(i, j) __uint_as_float((__float_as_uint(la[i] + lb[j]) & ~255u) | (unsigned)((i) * 16 + (j)))
        const float NEG = -INFINITY;
        c0[0] = CAND(0, 0); c0[1] = CAND(0, 1); c0[2] = CAND(0, 2); c0[3] = CAND(0, 3); c0[4] = CAND(0, 4); c0[5] = CAND(0, 5); c0[6] = CAND(0, 6); c0[7] = CAND(0, 7);
        c0[8] = CAND(0, 8); c0[9] = CAND(0, 9); c0[10] = CAND(0, 10); c0[11] = CAND(0, 11); c0[12] = CAND(0, 12); c0[13] = CAND(0, 13); c0[14] = CAND(0, 14); c0[15] = CAND(0, 15);
        sort16_desc(c0);
        c1[0] = CAND(1, 0); c1[1] = CAND(1, 1); c1[2] = CAND(1, 2); c1[3] = CAND(1, 3); c1[4] = CAND(1, 4); c1[5] = CAND(1, 5); c1[6] = CAND(1, 6); c1[7] = CAND(1, 7);
        c1[8] = CAND(2, 0); c1[9] = CAND(2, 1); c1[10] = CAND(2, 2); c1[11] = CAND(2, 3); c1[12] = CAND(2, 4); c1[13] = CAND(3, 0); c1[14] = CAND(3, 1); c1[15] = CAND(3, 2);
        sort16_desc(c1); merge_top16(c0, c1);
        asm volatile("" : "+v"(c0[0]), "+v"(c0[15]));
        c1[0] = CAND(3, 3); c1[1] = CAND(4, 0); c1[2] = CAND(4, 1); c1[3] = CAND(4, 2); c1[4] = CAND(5, 0); c1[5] = CAND(5, 1); c1[6] = CAND(6, 0); c1[7] = CAND(6, 1);
        c1[8] = CAND(7, 0); c1[9] = CAND(7, 1); c1[10] = CAND(8, 0); c1[11] = CAND(9, 0); c1[12] = CAND(10, 0); c1[13] = CAND(11, 0); c1[14] = CAND(12, 0); c1[15] = CAND(13, 0);
        sort16_desc(c1); merge_top16(c0, c1);
        asm volatile("" : "+v"(c0[0]), "+v"(c0[15]));
        c1[0] = CAND(14, 0); c1[1] = CAND(15, 0);
#pragma unroll
        for (int r = 2; r < 16; ++r) c1[r] = NEG;
#undef CAND
        sort16_desc(c1); merge_top16(c0, c1);
        float gsum = 0.f, gv[16]; int ex[16];
        const float mx = __uint_as_float(__float_as_uint(c0[0]) & ~255u);
#pragma unroll
        for (int r = 0; r < 16; ++r) { const unsigned bits = __float_as_uint(c0[r]); const float val = __uint_as_float(bits & ~255u);
            gv[r] = __expf(val - mx); gsum += gv[r];
            ex[r] = (int)(lookup_idx(pa, (bits >> 4) & 15u) * 128u + lookup_idx(pb, bits & 15u)); }
        const float ginv = 1.0f / gsum;
        const size_t ob = (size_t)(tg * 32 + r32) * 128 + (2 * hp + hi) * 16;
#pragma unroll
        for (int r = 0; r < 16; r += 4) { *(GAS u32x4*)(IDX + ob + r) = (u32x4){(unsigned)ex[r], (unsigned)ex[r + 1], (unsigned)ex[r + 2], (unsigned)ex[r + 3]};
            *(GAS f32x4*)(GATE + ob + r) = (f32x4){gv[r] * ginv, gv[r + 1] * ginv, gv[r + 2] * ginv, gv[r + 3] * ginv}; }
      }
    }
#undef P5_QLOAD
    __syncthreads();
}

typedef long i64_t;
typedef int v8i_t __attribute__((ext_vector_type(8)));
#define MFMA16F8(a, b, c) __builtin_amdgcn_mfma_f32_16x16x32_fp8_fp8(a, b, c, 0, 0, 0)
constexpr float P6_SD = 64.f, P6_SX = 8.f, P6_SU = 16.f, P6_SA = 64.f, P6_SU4 = 6.f;
constexpr size_t P6_SLICEB = (size_t)NEXP * 128;
__device__ __forceinline__ unsigned pk4_fp8(float a, float b, float c, float d) { int w = __builtin_amdgcn_cvt_pk_fp8_f32(a, b, 0, false); w = __builtin_amdgcn_cvt_pk_fp8_f32(c, d, w, true); return (unsigned)w; }
__device__ __forceinline__ float fp8_byte0(unsigned w) { return __builtin_amdgcn_cvt_f32_fp8((int)w, 0); }
constexpr int P6_WSCR = 3328;
__device__ __forceinline__ void p6_token(const Args& a, lds_u8* wl, int tok, int lane, float* OUTW) {
    const int n = lane & 15, g = lane >> 4;
    const unsigned char* ws = a.ws;
    const unsigned char* WD = ws + WS_WD; const unsigned char* WU = ws + WS_WU;
    const int* IDX = (const int*)(ws + WS_IDX) + (size_t)tok * 128; const float* GATE = (const float*)(ws + WS_GATE) + (size_t)tok * 128;
    const bf16_t* X1 = (const bf16_t*)(ws + WS_X1B) + (size_t)tok * DM;
    {
#pragma unroll
        for (int j = 0; j < 4; ++j) {
            const u32x2 xw_ = *(const GAS u32x2*)(X1 + 256 * j + 4 * lane); const f32x4 v = (f32x4){__uint_as_float(xw_.x << 16), __uint_as_float(xw_.x & 0xffff0000u), __uint_as_float(xw_.y << 16), __uint_as_float(xw_.y & 0xffff0000u)} * P6_SX;
            const unsigned hw = pk4_fp8(v.x, v.y, v.z, v.w);
            const float r0 = v.x - __builtin_amdgcn_cvt_f32_fp8((int)hw, 0), r1 = v.y - __builtin_amdgcn_cvt_f32_fp8((int)hw, 1), r2 = v.z - __builtin_amdgcn_cvt_f32_fp8((int)hw, 2), r3 = v.w - __builtin_amdgcn_cvt_f32_fp8((int)hw, 3);
            const unsigned lw = pk4_fp8(r0 * 16.f, r1 * 16.f, r2 * 16.f, r3 * 16.f);
            *(LAS unsigned*)(wl + 256 * j + 4 * lane) = hw; *(LAS unsigned*)(wl + 1024 + 256 * j + 4 * lane) = lw;
        }
        const u32x2 iv = *(const GAS u32x2*)(IDX + lane * 2); *(LAS u32x2*)(wl + 2048 + lane * 8) = iv;
    }
    const float rs2 = row_rs2((const bf16_t*)(ws + WS_SSQ), tok);
    LDS_WAIT();
    const LAS int* idxl = (const LAS int*)(wl + 2048); LAS unsigned short* actl = (LAS unsigned short*)(wl + 2560);
    const int xoff = (n & 1) * 1024 + 16 * g;
#pragma unroll 1
    for (int eg = 0; eg < 8; ++eg) {
        const int e = idxl[eg * 16 + n];
        const unsigned char* rp = WD + (size_t)e * 128 + 16 * g;
        f32x4 acc = (f32x4){0.f, 0.f, 0.f, 0.f};
        u32x4 bq[16];
#pragma unroll
        for (int sl = 0; sl < 8; ++sl) { bq[2 * sl] = *(const GAS u32x4*)(rp + sl * P6_SLICEB); bq[2 * sl + 1] = *(const GAS u32x4*)(rp + sl * P6_SLICEB + 64); }
#pragma unroll
        for (int sl = 0; sl < 8; ++sl)
#pragma unroll
            for (int hf = 0; hf < 2; ++hf) {
                const u32x4 xa = *(const LAS u32x4*)(wl + xoff + sl * 128 + hf * 64); const u32x4 bb = bq[2 * sl + hf];
                acc = MFMA16F8((i64_t)(((unsigned long long)xa.y << 32) | xa.x), (i64_t)(((unsigned long long)bb.y << 32) | bb.x), acc);
                acc = MFMA16F8((i64_t)(((unsigned long long)xa.w << 32) | xa.z), (i64_t)(((unsigned long long)bb.w << 32) | bb.z), acc);
            }
        const float av = (acc[0] + acc[1] * 0.0625f) * (rs2 * (1.0f / (P6_SD * P6_SX)));
        const float act = 0.5f * av * (1.0f + erff(av * 0.70710678118654752f)) * GATE[eg * 16 + n] * P6_SA;
        const unsigned hb = pk4_fp8(act, 0.f, 0.f, 0.f) & 0xffu;
        const unsigned lb = pk4_fp8((act - fp8_byte0(hb)) * 16.f, 0.f, 0.f, 0.f) & 0xffu;
        if (g == 0) actl[eg * 16 + n] = (unsigned short)(hb | (lb << 8));
    }
    LDS_WAIT();
    const int pos = n & 7, sel = n >> 3;
    float ss = 0.f;
    const bool owner = (n < 8) && (g < 2);
#pragma unroll 1
    for (int sl = 0; sl < 8; ++sl) {
        f32x4 ah[2], al[2];
#pragma unroll
        for (int s = 0; s < 2; ++s) { ah[s] = (f32x4){0.f, 0.f, 0.f, 0.f}; al[s] = (f32x4){0.f, 0.f, 0.f, 0.f}; }
        u32x4 bq[16]; unsigned av[16];
#pragma unroll
        for (int q = 0; q < 16; ++q) { const int ei = 8 * q + 4 * sel + g; const int e = idxl[ei]; av[q] = actl[ei];
            bq[q] = *(const GAS u32x4*)(WU + sl * P6_SLICEB + (size_t)e * 128 + 16 * pos); }
#pragma unroll
        for (int q = 0; q < 16; ++q) {
            const unsigned long long ahv = (unsigned long long)(av[q] & 0xffu) << (8 * pos), alv = (unsigned long long)(av[q] >> 8) << (8 * pos);
            const u32x4 bb = bq[q];
            const i64_t b0 = (i64_t)(((unsigned long long)bb.y << 32) | bb.x), b1 = (i64_t)(((unsigned long long)bb.w << 32) | bb.z);
            ah[0] = MFMA16F8((i64_t)ahv, b0, ah[0]); al[0] = MFMA16F8((i64_t)alv, b0, al[0]);
            ah[1] = MFMA16F8((i64_t)ahv, b1, ah[1]); al[1] = MFMA16F8((i64_t)alv, b1, al[1]);
        }
#pragma unroll
        for (int s = 0; s < 2; ++s) {
            f32x4 t = ah[s] + al[s] * 0.0625f, u;
#pragma unroll
            for (int r = 0; r < 4; ++r) u[r] = __shfl(t[r], (lane + 40) & 63);
            const int col = 128 * sl + 16 * pos + 8 * s + 4 * (g & 1);
            const u32x2 xq_ = *(const GAS u32x2*)(X1 + col); const f32x4 xv = (f32x4){__uint_as_float(xq_.x << 16), __uint_as_float(xq_.x & 0xffff0000u), __uint_as_float(xq_.y << 16), __uint_as_float(xq_.y & 0xffff0000u)};
            const f32x4 x2 = xv + (t + u) * (1.0f / (P6_SA * P6_SU));
            if (owner) { ss += (x2.x * x2.x + x2.y * x2.y) + (x2.z * x2.z + x2.w * x2.w); *(GAS f32x4*)(OUTW + (size_t)tok * DM + col) = x2; }
        }
    }
    ss = wave_sum(ss);
    const float rn = 1.0f / sqrtf(ss * (1.0f / DM) + EPSF);
    const float* nf = a.in[16];
    if (owner) {
#pragma unroll
        for (int sl = 0; sl < 8; ++sl)
#pragma unroll
            for (int s = 0; s < 2; ++s) { const int col = 128 * sl + 16 * pos + 8 * s + 4 * g; const f32x4 gv = *(const GAS f32x4*)(nf + col);
                GAS f32x4* op = (GAS f32x4*)(OUTW + (size_t)tok * DM + col); *op = *op * rn * gv; }
    }
}

constexpr int P6S_WAVE = 16384 + 512 + 128;
static_assert(NWAVES * P6S_WAVE <= LDS_SCRATCH, "P6 LDS");
__device__ __forceinline__ float gelu_as(float v) {
    const float av = __builtin_fabsf(v), t = __builtin_amdgcn_rcpf(av * 0.2316418882f + 1.0f);
    float q = t * 0.5307027145f + (-0.7265760135f); q = q * t + 0.7107068705f; q = q * t + (-0.142248368f); q = q * t + 0.127414796f; q = q * t;
    const float e = __builtin_amdgcn_exp2f((v * v) * (-0.72134752044f));
    const float m = v * (q * e);
    return v < 0.f ? m : v - m;
}
template <int EMASK, int PARTS>
__device__ __forceinline__ void p6_slices(const Args& a, lds_u8* wl, int tok0, int lane) {
    const int n = lane & 15, g = lane >> 4;
    const unsigned char* ws = a.ws;
    const unsigned char* WD = ws + WS_WD; const unsigned char* WU = ws + WS_WU;
    LAS float* aacc = (LAS float*)wl; LAS unsigned short* idl = (LAS unsigned short*)(wl + 8192); LAS unsigned short* actl = (LAS unsigned short*)(wl + 12288);
    lds_u8* xs = wl + 16384; LAS float* ssl = (LAS float*)(wl + 16384 + 512); LAS float* r2l = ssl + 16;
    {
        u32x2 iv[16];
#pragma unroll
        for (int t = 0; t < 16; ++t) iv[t] = *(const GAS u32x2*)((const int*)(ws + WS_IDX) + (size_t)(tok0 + t) * 128 + lane * 2);
#pragma unroll
        for (int t = 0; t < 16; ++t) {
            *(LAS unsigned*)(wl + 8192 + t * 256 + lane * 4) = (iv[t].x & 0xffffu) | (iv[t].y << 16);
            *(LAS f32x2*)(wl + t * 512 + lane * 8) = (f32x2){0.f, 0.f};
        }
    }
    if (lane < 16) { ssl[lane] = 0.f; r2l[lane] = row_rs2((const bf16_t*)(ws + WS_SSQ), tok0 + lane); }
    unsigned char* X4 = (unsigned char*)a.ws + WS_XB;
#pragma unroll 1
    for (int t8 = 0; t8 < 16; t8 += 8) {
    u32x4 xwa[8], xwb[8];
#pragma unroll
    for (int tt = 0; tt < 8; ++tt) { const bf16_t* xr = (const bf16_t*)(ws + WS_X1B) + (size_t)(tok0 + t8 + tt) * DM + 16 * lane; xwa[tt] = *(const GAS u32x4*)xr; xwb[tt] = *(const GAS u32x4*)(xr + 8); }
#pragma unroll
    for (int tt = 0; tt < 8; ++tt) {
        const int t = t8 + tt;
        const u32x4 xw0 = xwa[tt], xw1 = xwb[tt];
        float rr[16];
#pragma unroll
        for (int j = 0; j < 4; ++j) { rr[2 * j] = __uint_as_float(xw0[j] << 16); rr[2 * j + 1] = __uint_as_float(xw0[j] & 0xffff0000u); rr[8 + 2 * j] = __uint_as_float(xw1[j] << 16); rr[9 + 2 * j] = __uint_as_float(xw1[j] & 0xffff0000u); }
#pragma unroll
        for (int st = 0; st < 4; ++st) {
            unsigned w0 = 0u, w1 = 0u;
#define P6_Q4(p_) do { w0 = __builtin_amdgcn_cvt_scalef32_pk_fp4_f32(w0, rr[2 * (p_)], rr[2 * (p_) + 1], 1.0f, p_); w1 = __builtin_amdgcn_cvt_scalef32_pk_fp4_f32(w1, rr[8 + 2 * (p_)], rr[9 + 2 * (p_)], 1.0f, p_); } while (0)
            P6_Q4(0); P6_Q4(1); P6_Q4(2); P6_Q4(3);
#undef P6_Q4
#define P6_D4(p_) do { const f32x2 d0 = __builtin_amdgcn_cvt_scalef32_pk_f32_fp4(w0, 1.0f, p_), d1 = __builtin_amdgcn_cvt_scalef32_pk_f32_fp4(w1, 1.0f, p_); \
                rr[2 * (p_)] = (rr[2 * (p_)] - d0.x) * 4.0f; rr[2 * (p_) + 1] = (rr[2 * (p_) + 1] - d0.y) * 4.0f; rr[8 + 2 * (p_)] = (rr[8 + 2 * (p_)] - d1.x) * 4.0f; rr[9 + 2 * (p_)] = (rr[9 + 2 * (p_)] - d1.y) * 4.0f; } while (0)
            P6_D4(0); P6_D4(1); P6_D4(2); P6_D4(3);
#undef P6_D4
            *(GAS u32x2*)(X4 + (size_t)(tok0 + t) * 2048 + st * 512 + 8 * lane) = (u32x2){w0, w1};
        }
    }
    }
    LDS_WAIT(); VM_WAIT();
    const int xoff = (n & 3) * 128 + 16 * g;
    const int bpa = 4 * (4 * (lane & 15) + (lane >> 4));
#define MFMA4(a_, b_, c_) __builtin_amdgcn_mfma_scale_f32_16x16x128_f8f6f4(a_, b_, c_, 4  , 4  , 0, 0, 0, 0)
#define P6_DLOAD(BQ, XV, it_) do { const int sl_ = (it_) >> 4, t_ = (it_) & 15; \
        _Pragma("unroll") for (int eg = 0; eg < 8; ++eg) { const int e_ = idl[t_ * 128 + eg * 16 + (lane >> 2)] & EMASK; const unsigned char* rp_ = WD + sl_ * P6_SLICEB + (size_t)e_ * 128 + 16 * (lane & 3); \
            BQ[2 * eg] = *(const GAS u32x4*)rp_; BQ[2 * eg + 1] = *(const GAS u32x4*)(rp_ + 64); } \
        XV = *(const GAS u32x2*)(X4 + (size_t)(tok0 + t_) * 2048 + (lane >> 4) * 512 + sl_ * 128 + 8 * (lane & 15)); } while (0)
#define P6_DCOMP(BQ, XV, it_) do { const int t_ = (it_) & 15; \
        *(LAS u32x2*)(xs + (lane >> 4) * 128 + 8 * (lane & 15)) = XV; \
        LDS_WAIT(); \
        const u32x4 xa0 = *(const LAS u32x4*)(xs + xoff), xa1 = *(const LAS u32x4*)(xs + xoff + 64); \
        const v8i_t A0 = (v8i_t){(int)xa0.x, (int)xa0.y, (int)xa0.z, (int)xa0.w, 0, 0, 0, 0}; \
        const v8i_t A1 = (v8i_t){(int)xa1.x, (int)xa1.y, (int)xa1.z, (int)xa1.w, 0, 0, 0, 0}; \
        _Pragma("unroll") for (int eg = 0; eg < 8; ++eg) { f32x4 acc = (f32x4){0.f, 0.f, 0.f, 0.f}; v8i_t b0 = (v8i_t){0, 0, 0, 0, 0, 0, 0, 0}, b1 = (v8i_t){0, 0, 0, 0, 0, 0, 0, 0}; \
            _Pragma("unroll") for (int w_ = 0; w_ < 4; ++w_) { b0[w_] = __builtin_amdgcn_ds_bpermute(bpa, (int)BQ[2 * eg][w_]); b1[w_] = __builtin_amdgcn_ds_bpermute(bpa, (int)BQ[2 * eg + 1][w_]); } \
            acc = MFMA4(A0, b0, acc); acc = MFMA4(A1, b1, acc); \
            float r_ = (acc[0] + acc[1] * 0.25f) + (acc[2] * 0.0625f + acc[3] * 0.015625f); asm volatile("" : "+v"(r_)); \
            if (g == 0) aacc[t_ * 128 + eg * 16 + n] += r_; } \
        LDS_WAIT(); } while (0)
    if (PARTS & 1) {
        u32x4 bqA[16], bqB[16]; u32x2 xvA, xvB;
        P6_DLOAD(bqA, xvA, 0);
#pragma unroll 1
        for (int it = 0; it < 64; it += 2) {
            P6_DLOAD(bqB, xvB, it + 1);
            P6_DCOMP(bqA, xvA, it);
            if (it + 2 < 64) P6_DLOAD(bqA, xvA, it + 2);
            P6_DCOMP(bqB, xvB, it + 1);
        }
    }
#undef MFMA4
#undef P6_DLOAD
#undef P6_DCOMP
    int lane_g = lane; asm volatile("" : "+v"(lane_g));
    float gts[16][2];
#pragma unroll
    for (int t = 0; t < 16; ++t) { gts[t][0] = ((const float*)(ws + WS_GATE))[(size_t)(tok0 + t) * 128 + lane_g]; gts[t][1] = ((const float*)(ws + WS_GATE))[(size_t)(tok0 + t) * 128 + lane_g + 64]; }
#pragma unroll
    for (int t = 0; t < 16; ++t) {
        const float sc = r2l[t] * (1.0f / P6_SD);
#pragma unroll
        for (int j = 0; j < 2; ++j) { const int ei = lane_g + 64 * j; const float av = aacc[t * 128 + ei] * sc;
            const float act = gelu_as(av) * gts[t][j];
            const unsigned ab = __float_as_uint(act), eb = (ab >> 23) & 255u;
            unsigned pk = 0u;
            if (eb > 4u) {
                const float m = __uint_as_float((ab & 0x807fffffu) | (128u << 23));
                const unsigned w0 = __builtin_amdgcn_cvt_scalef32_pk_fp4_f32(0u, m, 0.f, 1.0f, 0);
                const f32x2 d0 = __builtin_amdgcn_cvt_scalef32_pk_f32_fp4(w0, 1.0f, 0);
                const unsigned w1 = __builtin_amdgcn_cvt_scalef32_pk_fp4_f32(0u, (m - d0.x) * 4.0f, 0.f, 1.0f, 0);
                pk = (w0 & 15u) | ((w1 & 15u) << 4) | ((eb - 1u) << 8);
            }
            actl[t * 128 + ei] = (unsigned short)pk; }
    }
    LDS_WAIT();
    int lane_u = lane; asm volatile("" : "+v"(lane_u));
    const float* nf = a.in[16];
    const int ui = lane_u & 31, ug = lane_u >> 5, ush = 4 * (ui & 7);
    const unsigned uk0 = (ui >> 3) == 0 ? 0xffffffffu : 0u, uk1 = (ui >> 3) == 1 ? 0xffffffffu : 0u, uk2 = (ui >> 3) == 2 ? 0xffffffffu : 0u, uk3 = (ui >> 3) == 3 ? 0xffffffffu : 0u;
#ifndef P6_DIGITS
#define P6_DIGITS 2
#endif
#define MFMA32S(a_, b_, c_, sa_) __builtin_amdgcn_mfma_scale_f32_32x32x64_f8f6f4(a_, b_, c_, 4, 4, 0, sa_, 0, 127)
#ifndef P6_UPROBE
#define P6_UPROBE 0
#endif
#define P6_ULOAD(BQ, sq_) do { const int t_ = (sq_) >> 3, qs_ = (sq_) & 7; \
        if (!((P6_UPROBE & 1) && PARTS == 2 && EMASK != 0xffff)) \
        _Pragma("unroll") for (int q = 0; q < 8; ++q) { const int e_ = idl[t_ * 128 + 2 * (8 * qs_ + q) + ug] & EMASK; \
            BQ[q] = *(const GAS u32x4*)(WU + (size_t)e_ * 512 + 16 * ui); } } while (0)
#define P6_UMMA(BQ, sq_) do { const int t_ = (sq_) >> 3, qs_ = (sq_) & 7; \
        _Pragma("unroll") for (int q = 0; q < 8; ++q) { \
            const unsigned av_ = actl[t_ * 128 + 2 * (8 * qs_ + q) + ug]; \
            const unsigned w0_ = (av_ & 15u) << ush, w1_ = ((av_ >> 4) & 15u) << ush; const int s0_ = (int)(av_ >> 8), s1_ = s0_ - 2; \
            const u32x4 bb = BQ[q]; const v8i_t B_ = (v8i_t){(int)bb.x, (int)bb.y, (int)bb.z, (int)bb.w, 0, 0, 0, 0}; \
            if ((P6_UPROBE & 2) && PARTS == 2) { asm volatile("" :: "v"(w0_ & uk0), "v"(w0_ & uk1), "v"(w0_ & uk2), "v"(w0_ & uk3), "v"(w1_ & uk0), "v"(w1_ & uk1), "v"(w1_ & uk2), "v"(w1_ & uk3), "v"(bb), "v"(s0_), "v"(s1_)); continue; } \
            uacc = MFMA32S(((v8i_t){(int)(w0_ & uk0), (int)(w0_ & uk1), (int)(w0_ & uk2), (int)(w0_ & uk3), 0, 0, 0, 0}), B_, uacc, s0_); \
            if (P6_DIGITS == 2) uacc = MFMA32S(((v8i_t){(int)(w1_ & uk0), (int)(w1_ & uk1), (int)(w1_ & uk2), (int)(w1_ & uk3), 0, 0, 0, 0}), B_, uacc, s1_); } } while (0)
    f32x4 gvu[4];
#pragma unroll
    for (int gq = 0; gq < 4; ++gq) gvu[gq] = *(const GAS f32x4*)(nf + 32 * ui + 4 * ug + 8 * gq);
    u32x2 xqn[4];
#define P6_UXPREF(t_) do { const bf16_t* xrow_ = (const bf16_t*)(ws + WS_X1B) + (size_t)(tok0 + (t_)) * DM + 32 * ui + 4 * ug; \
        _Pragma("unroll") for (int gq = 0; gq < 4; ++gq) xqn[gq] = *(const GAS u32x2*)(xrow_ + 8 * gq); } while (0)
#define P6_UEPI(sq_) do { const int t_ = (sq_) >> 3; \
        float* orow = a.out + (size_t)(tok0 + t_) * DM + 32 * ui + 4 * ug; \
        f32x4 x2[4]; float ss = 0.f; \
        _Pragma("unroll") for (int gq = 0; gq < 4; ++gq) { \
            const u32x2 xq_ = xqn[gq]; \
            x2[gq] = (f32x4){__uint_as_float(xq_.x << 16), __uint_as_float(xq_.x & 0xffff0000u), __uint_as_float(xq_.y << 16), __uint_as_float(xq_.y & 0xffff0000u)} \
                + (f32x4){uacc[4 * gq], uacc[4 * gq + 1], uacc[4 * gq + 2], uacc[4 * gq + 3]} * (1.0f / P6_SU4); \
            ss += (x2[gq].x * x2[gq].x + x2[gq].y * x2[gq].y) + (x2[gq].z * x2[gq].z + x2[gq].w * x2[gq].w); } \
        const float rn = 1.0f / sqrtf(wave_sum(ss) * (1.0f / DM) + EPSF);     \
        _Pragma("unroll") for (int gq = 0; gq < 4; ++gq) *(GAS f32x4*)(orow + 8 * gq) = x2[gq] * rn * gvu[gq]; \
        uacc = f32x16{}; } while (0)
    if (PARTS & 2) {
        u32x4 bqA[8], bqB[8]; f32x16 uacc = f32x16{};
        if ((P6_UPROBE & 1) && PARTS == 2 && EMASK != 0xffff) {
#pragma unroll
            for (int q = 0; q < 8; ++q) { bqA[q] = (u32x4){(unsigned)lane, 1u, 2u, 3u}; bqB[q] = bqA[q]; } }
        P6_ULOAD(bqA, 0);
#pragma unroll 1
        for (int sq = 0; sq < 128; sq += 2) {
            if ((sq & 7) == 0) P6_UXPREF(sq >> 3);
            P6_ULOAD(bqB, sq + 1);
            P6_UMMA(bqA, sq);
            if (sq + 2 < 128) P6_ULOAD(bqA, sq + 2);
            P6_UMMA(bqB, sq + 1);
            if (((sq + 1) & 7) == 7) { if ((P6_UPROBE & 4) && PARTS == 2) { asm volatile("" : "+v"(uacc)); uacc = f32x16{}; } else P6_UEPI(sq + 1); }
        }
    }
#undef P6_ULOAD
#undef P6_UMMA
#undef P6_UEPI
#undef P6_UXPREF
#undef MFMA32S
}

#ifndef MK_N_LAUNCHES
#define MK_N_LAUNCHES 1
#endif
constexpr int NPHASE = 7;

__device__ __forceinline__ int queue_next(unsigned* ctr, volatile LAS unsigned* slot) {
    __syncthreads();
    if (threadIdx.x == 0) *slot = __hip_atomic_fetch_add(ctr, 1u, __ATOMIC_RELAXED, __HIP_MEMORY_SCOPE_AGENT);
    __syncthreads();
    return (int)*slot;
}

__global__ void __launch_bounds__(NTHR, 2) hymba_fwd(Args a) {
    extern __shared__ __attribute__((aligned(16))) unsigned char lds_raw[];
    lds_u8* lds = (lds_u8*)lds_raw;
    volatile LAS unsigned* MISC = (volatile LAS unsigned*)(lds + MISC_OFF);
    const int tid = threadIdx.x, lane = tid & 63; const int wave = __builtin_amdgcn_readfirstlane(tid >> 6);
    const int G = gridDim.x; const int bx = blockIdx.x;
    const int vcu = (G % 8 == 0) ? (bx % 8) * (G / 8) + bx / 8 : bx;
    const int gw = vcu * NWAVES + wave, NGW = G * NWAVES;
    for (int u = tid; u < (LDS_BYTES - MISC_OFF) / 4; u += NTHR) MISC[u] = 0u;
    __syncthreads();
    const int lo = a.ph_lo, hi = a.ph_hi;
    const bool use_bar = (hi - lo) > 1;
    XcdBarrier bar; bar.bar = (unsigned*)(a.ws + WS_CTL); bar.x = 0; bar.st = MISC + 8;
    if (use_bar) bar = xcd_barrier_post((unsigned*)(a.ws + WS_CTL), MISC + 8);
#ifndef PH_MASK
#define PH_MASK 127
#endif
#define IN(k) (((PH_MASK >> (k)) & 1) && lo <= (k) && (k) < hi)
#ifdef DBL_BAR
#define SEAM(k) do { if (IN(k) && IN((k) + 1)) { xcd_barrier(bar); xcd_barrier(bar); } } while (0)
#else
#define SEAM(k) do { if (IN(k) && IN((k) + 1)) xcd_barrier(bar); } while (0)
#endif
    unsigned char* ws = a.ws;

    if (IN(0)) { p0_prologue(a, lds, gw, NGW, lane, wave);
#ifdef DBL_P0
        __syncthreads(); p0_prologue(a, lds, gw, NGW, lane, wave);
#endif
    }
    SEAM(0);
    if (IN(1)) {
        pg8::Gemm g{(const bf16_t*)(ws + WS_XB), (const bf16_t*)(ws + WS_WIN), MTOK, NIN, DM}; pg8::StaticOrder S; S.init(MTOK, NIN, G, bx);
        EpiProj E{(bf16_t*)(ws + WS_PROJ), (const float*)(ws + WS_R1), (const f32x4*)(ws + WS_ROPE), (const float*)(ws + WS_DECAY)};
        pg8::gemm_phase<EpiProj, pg8::StaticOrder>(lds, g, S, E);
#ifdef DBL_P1
        pg8::gemm_phase<EpiProj, pg8::StaticOrder>(lds, g, S, E);
#endif
    }
    SEAM(1);
    if (IN(2)) {
#ifdef DBL_P2
        for (int rep = 0; rep < 2; ++rep) {
        unsigned* ctr = (unsigned*)(ws + WS_CTL + CTL_Q_ATT + rep * 256);
#else
        {
        unsigned* ctr = (unsigned*)(ws + WS_CTL + CTL_Q_ATT);
#endif
        for (;;) {
            int u = queue_next(ctr, MISC + 16);
            if (u >= 64 + 1024 + DEF_ITEMS) break;
            if (u >= 64) { const int i9 = (u - 64) / 9, r9 = (u - 64) % 9; u = (r9 < 4) ? 64 + i9 * 4 + r9 : 64 + 1024 + i9 * 5 + (r9 - 4); }
#ifdef PROBE_P2
            if (rep == 0 && u >= 64 + 1024) continue;
#endif
            if (u >= 64 + 1024) { p0_deferred(a, lds, u - (64 + 1024)); continue; }
#ifdef PROBE_P2
            if (rep == 0) { if (u < 64) { if (PROBE_P2 & 1) ret_unit(a, lds, u >> 3, u & 7); } else if (PROBE_P2 & 2) { const int v = u - 64;
#ifdef PROBE_ATT2
                if (wave >= 4) attn_unit<PROBE_ATT2>(a, lds, (v & 31) >> 2, v & 3, 31 - (v >> 5)); else
#endif
                attn_unit<PROBE_ATT>(a, lds, (v & 31) >> 2, v & 3, 31 - (v >> 5)); } continue; }
#endif
            if (u < 64) ret_unit(a, lds, u >> 3, u & 7);
            else { const int v = u - 64; attn_unit<7>(a, lds, (v & 31) >> 2, v & 3, 31 - (v >> 5)); }
        }
        }
    }
    SEAM(2);
    if (IN(3)) {
        pg8::Gemm g{(const bf16_t*)(ws + WS_MIX), (const bf16_t*)(ws + WS_WOUT), MTOK, DM, DM}; pg8::StaticOrder S; S.init(MTOK, DM, G, bx);
        EpiX1 E{(const bf16_t*)(ws + WS_XB), (bf16_t*)(ws + WS_X1B), (bf16_t*)(ws + WS_SSQ)};
        pg8::gemm_phase<EpiX1, pg8::StaticOrder>(lds, g, S, E);
#ifdef DBL_P3
        pg8::gemm_phase<EpiX1, pg8::StaticOrder>(lds, g, S, E);
#endif
    }
    SEAM(3);
    if (IN(4)) {
        pg8::Gemm g{(const bf16_t*)(ws + WS_X1B), (const bf16_t*)(ws + WS_WPQ), MTOK, NQ, DM}; pg8::StaticOrder S; S.init(MTOK, NQ, G, bx);
        EpiQ E{(bf16_t*)(ws + WS_PROJ), (const bf16_t*)(ws + WS_SSQ)};
        pg8::gemm_phase<EpiQ, pg8::StaticOrder>(lds, g, S, E);
#ifdef DBL_P4
        pg8::gemm_phase<EpiQ, pg8::StaticOrder>(lds, g, S, E);
#endif
    }
    SEAM(4);
    if (IN(5)) { p5_topk(a, lds);
#ifdef DBL_P5
        p5_topk(a, lds);
#endif
    }
    SEAM(5);
    if (IN(6)) {
#ifdef P6_TOKEN_MAJOR
        lds_u8* wl = lds + wave * P6_WSCR;
        for (int tok = gw; tok < MTOK; tok += NGW) p6_token(a, wl, tok, lane, a.out);
#else
#ifdef PROBE_EMASK
        for (int tb = gw; tb < MTOK / 16; tb += NGW) p6_slices<PROBE_EMASK, PROBE_PARTS>(a, lds + wave * P6S_WAVE, tb * 16, lane);
#endif
        for (int tb = gw; tb < MTOK / 16; tb += NGW) p6_slices<0xffff, 3>(a, lds + wave * P6S_WAVE, tb * 16, lane);
#endif
    }
#ifdef DBG_DUMP
    if (hi - lo > 1) xcd_barrier(bar);
    {
        for (int m = gw; m < MTOK; m += NGW) {
            for (int c = lane; c < DM; c += 64) {
                float v = 0.f;
#if DBG_DUMP == 1
                v = bf2f(((const bf16_t*)(ws + WS_PROJ))[(size_t)m * NIN + DBG_COL + c]);
#elif DBG_DUMP == 2
                v = (c >= DBG_C0 && c < DBG_C1) ? bf2f(((const bf16_t*)(ws + WS_MIX))[(size_t)m * DM + c]) : 0.f;
#endif
                a.out[(size_t)m * DM + c] = v;
            }
        }
    }
#endif
#undef IN
#undef SEAM
}

extern "C" void kernel_launch(void* const* d_in, const int* in_sizes, int n_in, void* d_out, int out_size, void* d_ws, size_t ws_size, hipStream_t stream) {
    static int grid = 0;
    if (grid == 0) {
        if (n_in != 17 || in_sizes[0] != MTOK * DM || out_size != MTOK * DM || ws_size < WS_END) {
            fprintf(stderr, "kernel_launch: unexpected shapes (n_in %d, in0 %d, out %d, ws %zu < %zu); nothing launched\n", n_in, n_in > 0 ? in_sizes[0] : -1, out_size, ws_size, (size_t)WS_END); grid = -1; return; }
        int dev = 0, cus = 0, per_cu = 0;
        if (hipGetDevice(&dev) != hipSuccess || hipDeviceGetAttribute(&cus, hipDeviceAttributeMultiprocessorCount, dev) != hipSuccess) { fprintf(stderr, "kernel_launch: device query failed\n"); grid = -1; return; }
        if (hipFuncSetAttribute((const void*)hymba_fwd, hipFuncAttributeMaxDynamicSharedMemorySize, LDS_BYTES) != hipSuccess) { fprintf(stderr, "kernel_launch: hipFuncSetAttribute failed\n"); grid = -1; return; }
        if (hipOccupancyMaxActiveBlocksPerMultiprocessor(&per_cu, (const void*)hymba_fwd, NTHR, LDS_BYTES) != hipSuccess || per_cu < 1)
            fprintf(stderr, "kernel_launch: note: occupancy query reports %d workgroups per CU\n", per_cu);
        (void)hipGetLastError();
        grid = cus;
    }
    if (grid < 0) return;
    if (hipMemsetAsync((char*)d_ws + WS_CTL, 0, CTL_BYTES, stream) != hipSuccess) { fprintf(stderr, "kernel_launch: memset failed\n"); return; }
    Args a{};
    for (int i = 0; i < 17; ++i) a.in[i] = (const float*)d_in[i];
    a.out = (float*)d_out; a.ws = (unsigned char*)d_ws;
#if MK_N_LAUNCHES == 1
#ifdef DBG_STOP
    a.ph_lo = 0; a.ph_hi = DBG_STOP + 1;
#else
    a.ph_lo = 0; a.ph_hi = NPHASE;
#endif
    hipLaunchKernelGGL(hymba_fwd, dim3(grid), dim3(NTHR), LDS_BYTES, stream, a);
#else
    for (int p = 0; p < NPHASE; ++p) { a.ph_lo = p; a.ph_hi = p + 1; hipLaunchKernelGGL(hymba_fwd, dim3(grid), dim3(NTHR), LDS_BYTES, stream, a); }
#endif
    const hipError_t le = hipPeekAtLastError();
    if (le != hipSuccess) fprintf(stderr, "kernel_launch: launch failed: %s\n", hipGetErrorName(le));
}
```

```cpp
#include <hip/hip_runtime.h>
#include <cstdio>
#include <cstdint>

namespace pg8 {
#define PG8_LAS __attribute__((address_space(3)))
typedef unsigned short bf16_t;
typedef short bf16x8 __attribute__((ext_vector_type(8)));
typedef float f32x4 __attribute__((ext_vector_type(4)));
typedef unsigned u32x4 __attribute__((ext_vector_type(4)));
constexpr int BM = 256, BK = 64, HALF = 128, HTB = HALF * BK * 2  , STAGE_BYTES = 8 * HTB, NXCD = 8, WGM = 8;

__host__ __device__ __forceinline__ int lds_byte(int r, int c) { const int st = (r >> 4) * 2 + (c >> 5), rr = r & 15, cc = c & 31, ob = rr * 64 + cc * 2; return st * 1024 + (ob ^ (((ob >> 9) & 1) << 5)); }
__host__ __device__ __forceinline__ void stage_rc(int b, int& R, int& C) { const int st = b / 1024, sb = b % 1024, swz = sb ^ (((sb >> 9) & 1) << 5); R = (st >> 1) * 16 + swz / 64; C = (st & 1) * 32 + (swz % 64) / 2; }
__host__ __device__ __forceinline__ int perm32(int rho) { const int n = rho >> 4, i = rho & 15; return 8 * (i >> 2) + 4 * n + (i & 3); }

struct Unit { int pm, pn; };
struct Gemm { const bf16_t* A; const bf16_t* Bt; int M, N, K; };

struct StaticOrder {
    int nM, nN, nwg, G, c;
    __host__ __device__ void init(int M, int N, int G_, int c_) { nM = M / BM; nN = N / BM; nwg = nM * nN; G = G_; c = c_; }
    __host__ __device__ bool next(int i, Unit& u) const {
        const long L = (long)i * G + c; if (L >= nwg) return false;
        int wgid = (int)L; { const int q = nwg / NXCD, r = nwg % NXCD, xcd = wgid % NXCD, off = wgid / NXCD; wgid = (xcd < r ? xcd * (q + 1) : r * (q + 1) + (xcd - r) * q) + off; }
        const int nig = WGM * nN, gid = wgid / nig, fm = gid * WGM, gsz = (nM - fm) < WGM ? (nM - fm) : WGM;
        u.pm = fm + ((wgid % nig) % gsz); u.pn = (wgid % nig) / gsz; return true;
    }
    __device__ __forceinline__ void a_ready(const Unit&) const {}
    __device__ __forceinline__ void done(const Unit&) const {}
};
__device__ __forceinline__ unsigned cvt_pk_bf16(float lo, float hi) { unsigned r; asm volatile("v_cvt_pk_bf16_f32 %0, %1, %2" : "=v"(r) : "v"(lo), "v"(hi)); return r; }
template <class Epi, class Sched>
__device__ __forceinline__ void gemm_phase(PG8_LAS unsigned char* lds, const Gemm g, const Sched& S, const Epi& E) {
    const int tid = threadIdx.x, wid = __builtin_amdgcn_readfirstlane(tid >> 6), lane = tid & 63, wr = wid >> 2, wc = wid & 3, fr = lane & 15, fq = lane >> 4;
    const int K = g.K, nt = K / BK;
    unsigned voffA[2], voffB[2];
#pragma unroll
    for (int i = 0; i < 2; ++i) { int R, C; stage_rc(tid * 16 + i * 8192, R, C); const int Rb = Epi::PERM ? ((R & ~31) + perm32(R & 31)) : R;
        voffA[i] = (unsigned)(R * K + C) * 2u; voffB[i] = (unsigned)(Rb * K + C) * 2u; }
    const size_t kstep = (size_t)(BK * 2);
    const size_t hstep = (size_t)HALF * K * 2;
    const size_t tstep = 2 * hstep;
    const unsigned ldsw = (unsigned)wid * 1024u;
    const int aoff = lds_byte(wr * 64 + fr, fq * 8), boff = lds_byte(wc * 32 + fr, fq * 8);
#define PG8_SA(b, h) (((b) * 2 + (h)) * HTB)
#define PG8_SB(b, h) ((4 + (b) * 2 + (h)) * HTB)
#define PG8_STAGE(bufoff, gbase, voff) do { _Pragma("unroll") for (int _i = 0; _i < 2; ++_i) \
        __builtin_amdgcn_global_load_lds((const unsigned*)((const char*)(gbase) + (voff)[_i]), (PG8_LAS unsigned*)(lds + (bufoff) + ldsw + _i * 8192), 16, 0, 0); } while (0)
#define PG8_LDA(dst, b, h) do { _Pragma("unroll") for (int m = 0; m < 4; ++m) _Pragma("unroll") for (int k = 0; k < 2; ++k) dst[m][k] = *(const PG8_LAS bf16x8*)(lds + PG8_SA(b, h) + aoff + m * 2048 + k * 1024); } while (0)
#define PG8_LDB(dst, b, h) do { _Pragma("unroll") for (int n = 0; n < 2; ++n) _Pragma("unroll") for (int k = 0; k < 2; ++k) dst[n][k] = *(const PG8_LAS bf16x8*)(lds + PG8_SB(b, h) + boff + n * 2048 + k * 1024); } while (0)
#define PG8_MMA(ai, bj, At, Bt) do { __builtin_amdgcn_s_setprio(1); _Pragma("unroll") for (int m = 0; m < 4; ++m) _Pragma("unroll") for (int n = 0; n < 2; ++n) _Pragma("unroll") for (int k = 0; k < 2; ++k) \
        acc[ai][bj][m][n] = __builtin_amdgcn_mfma_f32_16x16x32_bf16(Bt[n][k], At[m][k], acc[ai][bj][m][n], 0, 0, 0); __builtin_amdgcn_s_setprio(0); } while (0)
#define PG8_WAIT_V(n) asm volatile("s_waitcnt vmcnt(" #n ")" ::: "memory")
#define PG8_WAIT_L(n) asm volatile("s_waitcnt lgkmcnt(" #n ")" ::: "memory")
#define PG8_BAR __builtin_amdgcn_s_barrier()
#define PG8_SCHED __builtin_amdgcn_sched_barrier(0)
    Unit cur, nxt; int ui = 0;
    if (!S.next(0, cur)) return;
    f32x4 acc[2][2][4][2];
#pragma unroll
    for (int a = 0; a < 2; ++a)
#pragma unroll
        for (int b = 0; b < 2; ++b)
#pragma unroll
            for (int m = 0; m < 4; ++m)
#pragma unroll
                for (int n = 0; n < 2; ++n) acc[a][b][m][n] = (f32x4){0.f, 0.f, 0.f, 0.f};
    bf16x8 At[4][2], B0[2][2], B1[2][2];
    const char* cA = (const char*)g.A + (size_t)cur.pm * tstep; const char* cB = (const char*)g.Bt + (size_t)cur.pn * tstep;
    S.a_ready(cur);
    PG8_STAGE(PG8_SB(0, 0), cB, voffB); PG8_STAGE(PG8_SA(0, 0), cA, voffA); PG8_STAGE(PG8_SB(0, 1), cB + hstep, voffB); PG8_STAGE(PG8_SA(0, 1), cA + hstep, voffA);
    if (wr == 1) PG8_BAR;
    PG8_WAIT_V(4); PG8_BAR;
    PG8_STAGE(PG8_SB(1, 0), cB + kstep, voffB); PG8_STAGE(PG8_SA(1, 0), cA + kstep, voffA); PG8_STAGE(PG8_SB(1, 1), cB + hstep + kstep, voffB);
    PG8_WAIT_V(6); PG8_BAR;
    for (;;) {
        const bool has_next = S.next(ui + 1, nxt);
        const char* nA = has_next ? (const char*)g.A + (size_t)nxt.pm * tstep : cA; const char* nB = has_next ? (const char*)g.Bt + (size_t)nxt.pn * tstep : cB;
        for (int t = 0; t < nt; t += 2) {
            const bool last = (t == nt - 2);
            const char* a1 = cA + (size_t)(t + 1) * kstep;
            const char* a2 = last ? nA : cA + (size_t)(t + 2) * kstep; const char* b2 = last ? nB : cB + (size_t)(t + 2) * kstep;
            const char* a3 = a2 + kstep; const char* b3 = b2 + kstep;
            if (last && has_next) S.a_ready(nxt);
            PG8_LDB(B0, 0, 0); PG8_SCHED; PG8_LDA(At, 0, 0); PG8_STAGE(PG8_SA(1, 1), a1 + hstep, voffA);
            PG8_WAIT_L(8); PG8_BAR; PG8_WAIT_L(0); PG8_MMA(0, 0, At, B0); PG8_BAR; PG8_SCHED;
            PG8_LDB(B1, 0, 1); PG8_STAGE(PG8_SB(0, 0), b2, voffB);
            PG8_BAR; PG8_WAIT_L(0); PG8_MMA(0, 1, At, B1); PG8_BAR;
            PG8_LDA(At, 0, 1); PG8_STAGE(PG8_SA(0, 0), a2, voffA);
            PG8_BAR; PG8_WAIT_L(0); PG8_MMA(1, 0, At, B0); PG8_BAR; PG8_SCHED;
            PG8_STAGE(PG8_SB(0, 1), b2 + hstep, voffB);
            PG8_WAIT_V(6); PG8_BAR; PG8_MMA(1, 1, At, B1); PG8_BAR;
            PG8_LDB(B0, 1, 0); PG8_SCHED; PG8_LDA(At, 1, 0); PG8_STAGE(PG8_SA(0, 1), a2 + hstep, voffA);
            PG8_WAIT_L(8); PG8_BAR; PG8_WAIT_L(0); PG8_MMA(0, 0, At, B0); PG8_BAR; PG8_SCHED;
            PG8_LDB(B1, 1, 1); PG8_STAGE(PG8_SB(1, 0), b3, voffB);
            PG8_BAR; PG8_WAIT_L(0); PG8_MMA(0, 1, At, B1); PG8_BAR;
            PG8_LDA(At, 1, 1); PG8_STAGE(PG8_SA(1, 0), a3, voffA);
            PG8_BAR; PG8_WAIT_L(0); PG8_MMA(1, 0, At, B0); PG8_BAR; PG8_SCHED;
            PG8_STAGE(PG8_SB(1, 1), b3 + hstep, voffB);
            PG8_WAIT_V(6); PG8_BAR; PG8_MMA(1, 1, At, B1); PG8_BAR;
        }
        if constexpr (!Epi::AFTER_DRAIN) { E(acc, cur, wr, wc, fr, fq); S.done(cur); }
        if (!has_next) break;
#pragma unroll
        for (int a = 0; a < 2; ++a)
#pragma unroll
            for (int b = 0; b < 2; ++b)
#pragma unroll
                for (int m = 0; m < 4; ++m)
#pragma unroll
                    for (int n = 0; n < 2; ++n) acc[a][b][m][n] = (f32x4){0.f, 0.f, 0.f, 0.f};
        cur = nxt; cA = nA; cB = nB; ++ui;
    }
    PG8_WAIT_V(0);
    if (wr == 0) PG8_BAR;
    PG8_BAR;
    if constexpr (Epi::AFTER_DRAIN) { E.fused(acc, cur, wr, wc, fr, fq, lds, wid, lane); S.done(cur); }
#undef PG8_SA
#undef PG8_SB
#undef PG8_STAGE
#undef PG8_LDA
#undef PG8_LDB
#undef PG8_MMA
#undef PG8_WAIT_V
#undef PG8_WAIT_L
#undef PG8_BAR
#undef PG8_SCHED
}
}

#define XB_TMO      128
#define XB_XCNT(j)  (256  + 64 * (j))
#define XB_XSUB(j)  (1280 + 64 * (j))
#define XB_XGEN(j)  (2304 + 64 * (j))
#define XB_TOP      3328
#define XB_TOPGEN   3392
#define XCD_BAR_WORDS 3456
#define XB_SPIN_CAP (1u << 18)
#define LAS __attribute__((address_space(3)))

__device__ __forceinline__ unsigned xb_ld(unsigned* p)              { return __hip_atomic_load(p, __ATOMIC_RELAXED, __HIP_MEMORY_SCOPE_AGENT); }
__device__ __forceinline__ unsigned xb_add(unsigned* p, unsigned v) { return __hip_atomic_fetch_add(p, v, __ATOMIC_RELAXED, __HIP_MEMORY_SCOPE_AGENT); }
__device__ __forceinline__ unsigned xb_xcc_id() { return (unsigned)__builtin_amdgcn_s_getreg((3 << 11) | 20) & 0xFu; }
#define XB_SPIN(cond, bar) do { unsigned _sp = 0; while (cond) { __builtin_amdgcn_s_sleep(1); \
    if ((++_sp & 255u) == 0u) { if (xb_ld(&(bar)[XB_TMO])) break; if (_sp > XB_SPIN_CAP) { atomicAdd(&(bar)[XB_TMO], 1u); break; } } } } while (0)

struct XcdBarrier {
    unsigned* bar; unsigned x;
    volatile LAS unsigned* st;
};

__device__ __forceinline__ XcdBarrier xcd_barrier_post(unsigned* bar, volatile LAS unsigned* st) {
    XcdBarrier b; b.bar = bar; b.x = xb_xcc_id(); b.st = st;
    if (threadIdx.x == 0) (void)xb_add(&bar[XB_XCNT(b.x)], 1u);
    return b;
}
__device__ __forceinline__ void xcd_barrier_complete(unsigned* bar, unsigned x, unsigned& nloc, unsigned& nx) {
    const unsigned G = gridDim.x * gridDim.y * gridDim.z;
    unsigned sum, cnt, mine, sp = 0u;
    for (;;) {
        sum = 0u; cnt = 0u; mine = 0u;
#pragma unroll
        for (unsigned j = 0; j < 16; ++j) { const unsigned c = xb_ld(&bar[XB_XCNT(j)]); sum += c; cnt += (c > 0u) ? 1u : 0u; mine = (j == x) ? c : mine; }
        if (sum == G) break;
        __builtin_amdgcn_s_sleep(1);
        if ((++sp & 255u) == 0u) { if (xb_ld(&bar[XB_TMO])) break; if (sp > XB_SPIN_CAP) { atomicAdd(&bar[XB_TMO], 1u); break; } }
    }
    nloc = mine > 0u ? mine : 1u; nx = cnt > 0u ? cnt : 1u;
}

__device__ __forceinline__ void xcd_barrier(const XcdBarrier& b) {
    asm volatile("s_waitcnt vmcnt(0)" ::: "memory");
    __syncthreads();
    if (threadIdx.x == 0) {
        unsigned* bar = b.bar;
        __builtin_amdgcn_s_waitcnt(0);
        unsigned nloc = b.st[0], nx = b.st[1];
        if (nloc == 0u) { xcd_barrier_complete(bar, b.x, nloc, nx); b.st[0] = nloc; b.st[1] = nx; }
        const unsigned old = xb_add(&bar[XB_XSUB(b.x)], 1u);
        const unsigned gen = old / nloc;
        if (old + 1u == (gen + 1u) * nloc) {
            __builtin_amdgcn_fence(__ATOMIC_RELEASE, "agent");
            asm volatile("s_waitcnt vmcnt(0)" ::: "memory");
            const unsigned og = xb_add(&bar[XB_TOP], 1u);
            const unsigned tg = og / nx;
            if (og + 1u == (tg + 1u) * nx) xb_add(&bar[XB_TOPGEN], 1u);
            else XB_SPIN(xb_ld(&bar[XB_TOPGEN]) == tg, bar);
            __builtin_amdgcn_fence(__ATOMIC_ACQUIRE, "agent");
            xb_add(&bar[XB_XGEN(b.x)], 1u);
            asm volatile("s_waitcnt vmcnt(0)" ::: "memory");
        } else {
            XB_SPIN(xb_ld(&bar[XB_XGEN(b.x)]) == gen, bar);
            __builtin_amdgcn_fence(__ATOMIC_ACQUIRE, "agent");
            asm volatile("s_waitcnt vmcnt(0)" ::: "memory");
        }
    }
    __syncthreads();
}

#define GAS __attribute__((address_space(1)))
typedef unsigned short bf16_t;
typedef short bf16x8 __attribute__((ext_vector_type(8)));
typedef short s16x4 __attribute__((ext_vector_type(4)));
typedef float f32x4 __attribute__((ext_vector_type(4)));
typedef float f32x2 __attribute__((ext_vector_type(2)));
typedef float f32x16 __attribute__((ext_vector_type(16)));
typedef unsigned u32x4 __attribute__((ext_vector_type(4)));
typedef unsigned u32x2 __attribute__((ext_vector_type(2)));
typedef LAS unsigned char lds_u8;

constexpr int MTOK = 32768, DM = 1024, SEQ = 4096, NBATCH = 8, NIN = 3584;
constexpr int OFF_RQ = 0, OFF_RK = 512, OFF_RV = 1024, OFF_RG = 1536, OFF_DQ = 2048, OFF_DK = 2560, OFF_DV = 3072;
constexpr int NEXP = 16384, NQ = 2048;
constexpr float EPSF = 1e-6f, LOG2E = 1.4426950408889634f;
constexpr int NWAVES = 8, NTHR = 512;

constexpr size_t WS_CTL = 0, CTL_BYTES = 65536;
constexpr size_t CTL_Q_ATT = 16384, CTL_Q_P6 = 16384 + 1024;
constexpr size_t WS_R1 = WS_CTL + CTL_BYTES;
constexpr size_t WS_SSQ = WS_R1 + (size_t)MTOK * 4;
constexpr size_t WS_ROPE = WS_SSQ + (size_t)MTOK * 16 * 4;
constexpr size_t WS_DECAY = WS_ROPE + (size_t)SEQ * 32 * 8;
constexpr size_t WS_BTAB = WS_DECAY + 2 * 8 * 128 * 4;
constexpr size_t WS_LAM = WS_BTAB + 4 * 128 * 4;
constexpr size_t WS_WIN = 4u << 20;
constexpr size_t WS_WOUT = WS_WIN + (size_t)NIN * DM * 2;
constexpr size_t WS_WPQ = WS_WOUT + (size_t)DM * DM * 2;
constexpr size_t WS_KEYS = WS_WPQ + (size_t)NQ * DM * 2;
constexpr size_t WS_WD = WS_KEYS + (size_t)8 * 2 * 128 * 128 * 2;
constexpr size_t WS_WU = WS_WD + (size_t)NEXP * DM * 2;
constexpr size_t WS_XB = WS_WU + (size_t)NEXP * DM * 2;
constexpr size_t WS_PROJ = WS_XB + (size_t)MTOK * DM * 2;
constexpr size_t WS_MIX = WS_PROJ + (size_t)MTOK * NIN * 2;
constexpr size_t WS_IDX = WS_MIX, WS_GATE = WS_MIX + (size_t)MTOK * 128 * 4;
constexpr size_t WS_X1B = WS_PROJ + (size_t)MTOK * NQ * 2;
static_assert(WS_X1B + (size_t)MTOK * DM * 2 <= WS_MIX, "ws map");
constexpr size_t WS_END = WS_MIX + (size_t)MTOK * DM * 2;
static_assert(WS_LAM + 256 <= WS_WIN, "ws map");
static_assert(WS_END <= (size_t)512 << 20, "ws map");

constexpr int LDS_SCRATCH = 139264;
constexpr int MISC_OFF = LDS_SCRATCH;
constexpr int LDS_BYTES = 147456;

__device__ __forceinline__ float wave_sum(float v) {
    v += __uint_as_float(__builtin_amdgcn_update_dpp(0u, __float_as_uint(v), 0xB1, 0xf, 0xf, true));
    v += __uint_as_float(__builtin_amdgcn_update_dpp(0u, __float_as_uint(v), 0x4E, 0xf, 0xf, true));
    v += __uint_as_float(__builtin_amdgcn_update_dpp(0u, __float_as_uint(v), 0x141, 0xf, 0xf, true));
    v += __uint_as_float(__builtin_amdgcn_update_dpp(0u, __float_as_uint(v), 0x140, 0xf, 0xf, true));
    { auto rr = __builtin_amdgcn_permlane16_swap(__float_as_uint(v), __float_as_uint(v), false, false); v = __uint_as_float(rr[0]) + __uint_as_float(rr[1]); }
    { auto rr = __builtin_amdgcn_permlane32_swap(__float_as_uint(v), __float_as_uint(v), false, false); v = __uint_as_float(rr[0]) + __uint_as_float(rr[1]); }
    return v;
}
typedef __bf16 bf16v2_t __attribute__((ext_vector_type(2)));
__device__ __forceinline__ unsigned pk2(float lo, float hi) { const bf16v2_t v = {(__bf16)lo, (__bf16)hi}; return __builtin_bit_cast(unsigned, v); }
__device__ __forceinline__ float bf2f(unsigned short b) { return __uint_as_float(((unsigned)b) << 16); }
#define LDS_WAIT() asm volatile("s_waitcnt lgkmcnt(0)" ::: "memory")
#define VM_WAIT() asm volatile("s_waitcnt vmcnt(0)" ::: "memory")

struct Args {
    const float* in[17]; float* out; unsigned char* ws; int ph_lo, ph_hi;
};

template <int MODE>
__device__ __forceinline__ void p0_transpose_item(const float* W, const float* scale, int K, int N, bf16_t* WT, LAS float* scr, int item, int lane) {
    const int nblk = N / 32, kb = item / nblk, nb = item % nblk, k0 = 64 * kb, n0 = 32 * nb;
#pragma unroll 8
    for (int i = 0; i < 32; ++i) { const int kk = 2 * i + (lane >> 5); const float sc = scale ? scale[k0 + kk] : 1.0f; scr[kk * 33 + (lane & 31)] = W[(size_t)(k0 + kk) * N + n0 + (lane & 31)] * sc; }
    LDS_WAIT();
    const int c = lane & 7;
#pragma unroll
    for (int j = 0; j < 4; ++j) { const int n = (lane >> 3) + 8 * j; const LAS float* s = scr + (8 * c) * 33 + n;
        u32x4 o; o.x = pk2(s[0 * 33], s[1 * 33]); o.y = pk2(s[2 * 33], s[3 * 33]); o.z = pk2(s[4 * 33], s[5 * 33]); o.w = pk2(s[6 * 33], s[7 * 33]);
        int nn = n0 + n;
        if (MODE == 1 && nn < 1024) { const int d = nn & 63; nn = (nn & ~63) + ((d < 32) ? 2 * d : 2 * (d - 32) + 1); }
        *(GAS u32x4*)(WT + (size_t)nn * K + k0 + 8 * c) = o; }
    LDS_WAIT();
}

__device__ __forceinline__ int t5_bucket(int n) {
    if (n < 16) return n;
    const float v = logf((float)n / 16.0f) / 2.0794415416798357f * 16.0f;
    int b = 16 + (int)v; return b > 31 ? 31 : b;
}

__device__ __forceinline__ void p0_prologue(const Args& a, lds_u8* lds, int gw, int NGW, int lane, int wave) {
    unsigned char* ws = a.ws;
    const float* x = a.in[0];
    bf16_t* xb = (bf16_t*)(ws + WS_XB); float* r1 = (float*)(ws + WS_R1);
    for (int m0 = gw; m0 < MTOK; m0 += 4 * NGW) {
        f32x4 v[4][4];
#pragma unroll
        for (int r = 0; r < 4; ++r) { const int m = m0 + r * NGW; const GAS f32x4* xr = (const GAS f32x4*)(x + (size_t)(m < MTOK ? m : m0) * DM) + lane;
#pragma unroll
            for (int j = 0; j < 4; ++j) v[r][j] = xr[64 * j]; }
#pragma unroll
        for (int r = 0; r < 4; ++r) { const int m = m0 + r * NGW; if (m >= MTOK) break;
            float s = 0.f;
#pragma unroll
            for (int j = 0; j < 4; ++j) s += (v[r][j].x * v[r][j].x + v[r][j].y * v[r][j].y) + (v[r][j].z * v[r][j].z + v[r][j].w * v[r][j].w);
            s = wave_sum(s);
            GAS u32x2* o8 = (GAS u32x2*)(xb + (size_t)m * DM) + lane;
#pragma unroll
            for (int j = 0; j < 4; ++j) { u32x2 o; o.x = pk2(v[r][j].x, v[r][j].y); o.y = pk2(v[r][j].z, v[r][j].w); o8[64 * j] = o; }
            if (lane == 0) r1[m] = 1.0f / sqrtf(s * (1.0f / DM) + EPSF); }
    }
    {
        LAS float* scr = (LAS float*)(lds + wave * 8704);
        constexpr int I_IN = (DM / 64) * (NIN / 32);
        for (int it = gw; it < I_IN; it += NGW) p0_transpose_item<1>(a.in[2], a.in[1], DM, NIN, (bf16_t*)(ws + WS_WIN), scr, it, lane);
    }
    const int gt = gw * 64 + lane, NGT = NGW * 64;
    {
        f32x2* rope = (f32x2*)(ws + WS_ROPE);
        for (int i = gt; i < SEQ * 32; i += NGT) { const int pos = i >> 5, j = i & 31; const float fr = (float)pow(10000.0, -(double)j / 32.0); const float ang = (float)pos * fr;
            rope[i] = (f32x2){(float)cos((double)ang), (float)sin((double)ang)}; }
        float* dec = (float*)(ws + WS_DECAY);
        for (int i = gt; i < 2 * 8 * 128; i += NGT) { const int l = i & 127, h = (i >> 7) & 7, kk = i >> 10; const double lg = log2(1.0 - exp2(-5.0 - (double)h));
            dec[i] = kk ? (float)(0.125 * exp2(-lg * (double)l)) : (float)exp2(lg * (double)l); }
        float* bt = (float*)(ws + WS_BTAB); const float* rb = a.in[9];
        for (int i = gt; i < 4 * 128; i += NGT) { const int n = i & 127, h = i >> 7; bt[i] = rb[t5_bucket(n) * 4 + h] * LOG2E; }
        if (gt == 0) { float s1 = 0.f, s2 = 0.f; for (int i = 0; i < 64; ++i) { s1 += a.in[4][i] * a.in[5][i]; s2 += a.in[6][i] * a.in[7][i]; }
            ((float*)(ws + WS_LAM))[0] = expf(s1) - expf(s2) + 0.2f; }
    }
}


constexpr int DEF_T0 = 192, DEF_T1 = 64, DEF_T2 = 512, DEF_T3 = 512, DEF_ITEMS = DEF_T0 + DEF_T1 + DEF_T2 + DEF_T3;
__device__ __forceinline__ void p0_deferred(const Args& a, lds_u8* lds, int item) {
    unsigned char* ws = a.ws;
    int tid_ = threadIdx.x; asm volatile("" : "+v"(tid_));
    const int tid = tid_, lane = tid & 63; const int wave = __builtin_amdgcn_readfirstlane(tid >> 6);
    if (item < DEF_T0) {
        LAS float* scr = (LAS float*)(lds + wave * 8704);
        constexpr int I_OUT = (DM / 64) * (DM / 32), I_PQ = (DM / 64) * (NQ / 32);
        static_assert(I_OUT + I_PQ == DEF_T0 * 8, "deferred transposes");
        const int r = item * 8 + wave;
        if (r < I_OUT) p0_transpose_item<0>(a.in[10], nullptr, DM, DM, (bf16_t*)(ws + WS_WOUT), scr, r, lane);
        else p0_transpose_item<0>(a.in[12], a.in[11], DM, NQ, (bf16_t*)(ws + WS_WPQ), scr, r - I_OUT, lane);
        return;
    }
    item -= DEF_T0;
    if (item < DEF_T1) {
        const float* pk = a.in[13]; bf16_t* kb = (bf16_t*)(ws + WS_KEYS);
        const int i = item * 512 + tid;
        const GAS f32x4* s = (const GAS f32x4*)(pk + (size_t)i * 8); const f32x4 p = s[0], q = s[1];
        u32x4 o; o.x = pk2(p.x, p.y); o.y = pk2(p.z, p.w); o.z = pk2(q.x, q.y); o.w = pk2(q.z, q.w); *(GAS u32x4*)(kb + (size_t)i * 8) = o;
        return;
    }
    item -= DEF_T1;
    const float* dn = a.in[14]; const float* up = a.in[15]; const float* gf = a.in[11];
    unsigned char* wd = ws + WS_WD; unsigned char* wu = ws + WS_WU;
    const bool isup = item < DEF_T2; if (!isup) item -= DEF_T2;
    const float* src = (isup ? up : dn) + (size_t)(item * 32 + wave * 4) * DM + lane * 4;
    f32x4 g[4];
#pragma unroll
    for (int k = 0; k < 4; ++k) g[k] = isup ? (f32x4){6.0f, 6.0f, 6.0f, 6.0f} : *(const GAS f32x4*)(gf + k * 256 + lane * 4) * 64.0f;
    f32x4 v[4][4];
#pragma unroll
    for (int r = 0; r < 4; ++r)
#pragma unroll
        for (int k = 0; k < 4; ++k) v[r][k] = *(const GAS f32x4*)(src + (size_t)r * DM + k * 256);
#pragma unroll
    for (int r = 0; r < 4; ++r) {
        const int e = item * 32 + wave * 4 + r;
#pragma unroll
        for (int k = 0; k < 4; ++k) {
            const f32x4 p = v[r][k] * g[k];
            unsigned w = __builtin_amdgcn_cvt_scalef32_pk_fp4_f32(0u, p.x, p.y, 1.0f, 0);
            w = __builtin_amdgcn_cvt_scalef32_pk_fp4_f32(w, p.z, p.w, 1.0f, 1);
            unsigned char* dst = isup ? wu + (size_t)e * 512 + k * 128 + lane * 2 : wd + (size_t)k * ((size_t)NEXP * 128) + (size_t)e * 128 + lane * 2;
            *(GAS unsigned short*)dst = (unsigned short)w;
        }
    }
}

__device__ __forceinline__ f32x4 bf4_lo(u32x4 w) { return (f32x4){__uint_as_float(w.x << 16), __uint_as_float(w.x & 0xffff0000u), __uint_as_float(w.y << 16), __uint_as_float(w.y & 0xffff0000u)}; }
__device__ __forceinline__ f32x4 bf4_hi(u32x4 w) { return (f32x4){__uint_as_float(w.z << 16), __uint_as_float(w.z & 0xffff0000u), __uint_as_float(w.w << 16), __uint_as_float(w.w & 0xffff0000u)}; }
struct EpiProj {
    static constexpr bool PERM = true, AFTER_DRAIN = false;
    bf16_t* P; const float* r1; const f32x4* rope; const float* decay;
    __device__ __forceinline__ void operator()(const f32x4 (&acc)[2][2][4][2], const pg8::Unit& u, int wr, int wc, int fr, int fq) const {
        const int row0 = u.pm * 256 + wr * 64 + fr, seg = u.pn >> 1;
        float rsv[2][4];
#pragma unroll
        for (int ai = 0; ai < 2; ++ai)
#pragma unroll
            for (int m = 0; m < 4; ++m) rsv[ai][m] = *(const GAS float*)(r1 + row0 + ai * 128 + m * 16);
        if (seg <= 1) {
#pragma unroll
            for (int ai = 0; ai < 2; ++ai) {
                f32x4 ra[4][2], rb[4][2]; float ff[4][2];
#pragma unroll
                for (int m = 0; m < 4; ++m)
#pragma unroll
                    for (int bj = 0; bj < 2; ++bj) {
                        const int row = row0 + ai * 128 + m * 16, c0 = u.pn * 256 + bj * 128 + wc * 32 + 8 * fq;
                        const int pos = row & (SEQ - 1), l = row & 127, head = (c0 & 511) >> 6, jb = (c0 & 63) >> 1;
                        const GAS f32x4* rp = (const GAS f32x4*)rope + ((size_t)pos * 32 + jb) / 2; ra[m][bj] = rp[0]; rb[m][bj] = rp[1];
                        ff[m][bj] = *(const GAS float*)(decay + (seg * 8 + head) * 128 + l);
                    }
#pragma unroll
                for (int m = 0; m < 4; ++m)
#pragma unroll
                    for (int bj = 0; bj < 2; ++bj) {
                        const int row = row0 + ai * 128 + m * 16, c0 = u.pn * 256 + bj * 128 + wc * 32 + 8 * fq;
                        const f32x4 v0 = acc[ai][bj][m][0] * rsv[ai][m], v1 = acc[ai][bj][m][1] * rsv[ai][m];
                        const f32x4 a_ = ra[m][bj], b_ = rb[m][bj]; const float f = ff[m][bj];
                        f32x4 w0, w1;
                        w0.x = (v0.x * a_.x - v0.y * a_.y) * f; w0.y = (v0.y * a_.x + v0.x * a_.y) * f;
                        w0.z = (v0.z * a_.z - v0.w * a_.w) * f; w0.w = (v0.w * a_.z + v0.z * a_.w) * f;
                        w1.x = (v1.x * b_.x - v1.y * b_.y) * f; w1.y = (v1.y * b_.x + v1.x * b_.y) * f;
                        w1.z = (v1.z * b_.z - v1.w * b_.w) * f; w1.w = (v1.w * b_.z + v1.z * b_.w) * f;
                        u32x4 w; w.x = pk2(w0.x, w0.y); w.y = pk2(w0.z, w0.w); w.z = pk2(w1.x, w1.y); w.w = pk2(w1.z, w1.w);
                        *(GAS u32x4*)(P + (size_t)row * NIN + c0) = w;
                    }
            }
        } else {
#pragma unroll
            for (int ai = 0; ai < 2; ++ai)
#pragma unroll
                for (int m = 0; m < 4; ++m)
#pragma unroll
                    for (int bj = 0; bj < 2; ++bj) {
                        const int row = row0 + ai * 128 + m * 16, c0 = u.pn * 256 + bj * 128 + wc * 32 + 8 * fq;
                        f32x4 v0 = acc[ai][bj][m][0] * rsv[ai][m], v1 = acc[ai][bj][m][1] * rsv[ai][m];
                        if (seg == 3) {
#pragma unroll
                            for (int j = 0; j < 4; ++j) { v0[j] = v0[j] / (1.0f + __expf(-v0[j])); v1[j] = v1[j] / (1.0f + __expf(-v1[j])); }
                        } else if (seg == 4) { v0 = v0 * (0.125f * LOG2E); v1 = v1 * (0.125f * LOG2E); }
                        u32x4 w; w.x = pk2(v0.x, v0.y); w.y = pk2(v0.z, v0.w); w.z = pk2(v1.x, v1.y); w.w = pk2(v1.z, v1.w);
                        *(GAS u32x4*)(P + (size_t)row * NIN + c0) = w;
                    }
        }
    }
};
struct EpiX1 {
    static constexpr bool PERM = true, AFTER_DRAIN = false;
    const bf16_t* XB; bf16_t* X1B; bf16_t* ssq;
    __device__ __forceinline__ void operator()(const f32x4 (&acc)[2][2][4][2], const pg8::Unit& u, int wr, int wc, int fr, int fq) const {
        const int row0 = u.pm * 256 + wr * 64 + fr, c00 = u.pn * 256 + wc * 32 + 8 * fq;
        u32x4 xin[2][4][2];
#pragma unroll
        for (int ai = 0; ai < 2; ++ai)
#pragma unroll
            for (int m = 0; m < 4; ++m)
#pragma unroll
                for (int bj = 0; bj < 2; ++bj) xin[ai][m][bj] = *(const GAS u32x4*)(XB + (size_t)(row0 + ai * 128 + m * 16) * DM + c00 + bj * 128);
#pragma unroll
        for (int ai = 0; ai < 2; ++ai)
#pragma unroll
            for (int m = 0; m < 4; ++m) {
                const int row = row0 + ai * 128 + m * 16; float ss = 0.f;
#pragma unroll
                for (int bj = 0; bj < 2; ++bj) {
                    const f32x4 o0 = acc[ai][bj][m][0] + bf4_lo(xin[ai][m][bj]), o1 = acc[ai][bj][m][1] + bf4_hi(xin[ai][m][bj]);
                    u32x4 w; w.x = pk2(o0.x, o0.y); w.y = pk2(o0.z, o0.w); w.z = pk2(o1.x, o1.y); w.w = pk2(o1.z, o1.w);
                    *(GAS u32x4*)(X1B + (size_t)row * DM + c00 + bj * 128) = w;
                    ss += ((o0.x * o0.x + o0.y * o0.y) + (o0.z * o0.z + o0.w * o0.w)) + ((o1.x * o1.x + o1.y * o1.y) + (o1.z * o1.z + o1.w * o1.w));
                }
                ss += __shfl_xor(ss, 16); ss += __shfl_xor(ss, 32);
                if (fq == 0) *(GAS bf16_t*)(ssq + (size_t)row * 16 + u.pn * 4 + wc) = (bf16_t)(pk2(ss, 0.f) & 0xffffu);
            }
    }
};
__device__ __forceinline__ float rs2_from(u32x4 a, u32x4 b) {
    const f32x4 p = bf4_lo(a) + bf4_hi(a) + bf4_lo(b) + bf4_hi(b);
    return 1.0f / sqrtf(((p.x + p.y) + (p.z + p.w)) * (1.0f / DM) + EPSF);
}
__device__ __forceinline__ float row_rs2(const bf16_t* ssq, int row) {
    const GAS u32x4* p = (const GAS u32x4*)(ssq + (size_t)row * 16); return rs2_from(p[0], p[1]);
}
struct EpiQ {
    static constexpr bool PERM = true, AFTER_DRAIN = false;
    bf16_t* Q; const bf16_t* ssq;
    __device__ __forceinline__ void operator()(const f32x4 (&acc)[2][2][4][2], const pg8::Unit& u, int wr, int wc, int fr, int fq) const {
        const int row0 = u.pm * 256 + wr * 64 + fr;
        u32x4 sa[2][4], sb[2][4];
#pragma unroll
        for (int ai = 0; ai < 2; ++ai)
#pragma unroll
            for (int m = 0; m < 4; ++m) { const GAS u32x4* p = (const GAS u32x4*)(ssq + (size_t)(row0 + ai * 128 + m * 16) * 16); sa[ai][m] = p[0]; sb[ai][m] = p[1]; }
#pragma unroll
        for (int ai = 0; ai < 2; ++ai)
#pragma unroll
            for (int m = 0; m < 4; ++m) {
                const int row = row0 + ai * 128 + m * 16; const float rs = rs2_from(sa[ai][m], sb[ai][m]);
#pragma unroll
                for (int bj = 0; bj < 2; ++bj) {
                    const int c0 = u.pn * 256 + bj * 128 + wc * 32 + 8 * fq;
                    const f32x4 v0 = acc[ai][bj][m][0] * rs, v1 = acc[ai][bj][m][1] * rs;
                    u32x4 w; w.x = pk2(v0.x, v0.y); w.y = pk2(v0.z, v0.w); w.z = pk2(v1.x, v1.y); w.w = pk2(v1.z, v1.w);
                    *(GAS u32x4*)(Q + (size_t)row * NQ + c0) = w;
                }
            }
    }
};

#define MFMA32(a, b, c) __builtin_amdgcn_mfma_f32_32x32x16_bf16(a, b, c, 0, 0, 0)
typedef short v4i16_t __attribute__((ext_vector_type(4)));
__device__ __forceinline__ s16x4 vtr(const lds_u8* p) { return __builtin_bit_cast(s16x4, __builtin_amdgcn_ds_read_tr16_b64_v4i16((LAS v4i16_t*)p)); }
__device__ __forceinline__ bf16x8 vfrag(const lds_u8* p) { const s16x4 lo = vtr(p), hi = vtr(p + 512); return (bf16x8){lo[0], lo[1], lo[2], lo[3], hi[0], hi[1], hi[2], hi[3]}; }
__device__ __forceinline__ bf16x8 ldsb128(const lds_u8* p) { return *(const LAS bf16x8*)p; }
__device__ __forceinline__ int crow(int r, int hi) { return (r & 3) + 8 * (r >> 2) + 4 * hi; }
__device__ __forceinline__ void glds16(const void* g, lds_u8* l) {
    unsigned sv; const unsigned lb = (unsigned)__builtin_amdgcn_readfirstlane((int)(unsigned)(uintptr_t)l);
    asm volatile("s_mov_b32 %0, m0\n\ts_mov_b32 m0, %2\n\ts_nop 0\n\tglobal_load_lds_dwordx4 %1, off\n\ts_mov_b32 m0, %0" : "=&s"(sv) : "v"(g), "s"(lb) : "memory");
}
__device__ __forceinline__ float swap_sum(float v) { auto rr = __builtin_amdgcn_permlane32_swap(__float_as_uint(v), __float_as_uint(v), false, false); return __uint_as_float(rr[0]) + __uint_as_float(rr[1]); }
__device__ __forceinline__ float swap_max(float v) { auto rr = __builtin_amdgcn_permlane32_swap(__float_as_uint(v), __float_as_uint(v), false, false); return __builtin_fmaxf(__uint_as_float(rr[0]), __uint_as_float(rr[1])); }

constexpr int ATT_SLOT = 32768, ATT_XCH = 65536, ATT_XPITCH = 528, ATT_BTAB = ATT_XCH + 128 * ATT_XPITCH;
static_assert(ATT_BTAB + 512 <= LDS_SCRATCH, "attention LDS");

template <int MODE>
__device__ __forceinline__ void attn_unit(const Args& a, lds_u8* lds, int b, int h, int qb) {
    int tid_ = threadIdx.x; asm volatile("" : "+v"(tid_));
    const int tid = tid_, lane = tid & 63, r32 = lane & 31, hi = lane >> 5; const int wid = __builtin_amdgcn_readfirstlane(tid >> 6);
    const int rgp = wid & 3, map = wid >> 2;
    const bf16_t* proj = (const bf16_t*)(a.ws + WS_PROJ);
    const size_t rowbase = (size_t)b * SEQ; const int q0 = qb * 128, NT = 2 * qb + 2;
    const float lam = ((const float*)(a.ws + WS_LAM))[0];
    if (tid < 128) ((LAS float*)(lds + ATT_BTAB))[tid] = ((const float*)(a.ws + WS_BTAB))[h * 128 + tid];
    bf16x8 qf[4];
    { const bf16_t* qp = proj + (rowbase + q0 + rgp * 32 + r32) * NIN + OFF_DQ + h * 128 + map * 64 + hi * 8;
#pragma unroll
      for (int s = 0; s < 4; ++s) qf[s] = *(const GAS bf16x8*)(qp + s * 16); }
    asm volatile("" : "+v"(qf[0]), "+v"(qf[1]), "+v"(qf[2]), "+v"(qf[3]));
    const int krow = 8 * wid + (lane >> 3);
    const bf16_t* k1src = proj + (rowbase + krow) * NIN + OFF_DK + h * 128 + ((lane & 7) ^ ((krow >> 1) & 7)) * 8;
    const bf16_t* k2src = k1src + 64;
    const bf16_t* vsrc0 = proj + (rowbase + 16 * ((2 * wid) & 3) + (lane >> 2)) * NIN + OFF_DV + h * 128 + 32 * ((2 * wid) >> 2) + (lane & 3) * 8;
    const bf16_t* vsrc1 = proj + (rowbase + 16 * ((2 * wid + 1) & 3) + (lane >> 2)) * NIN + OFF_DV + h * 128 + 32 * ((2 * wid + 1) >> 2) + (lane & 3) * 8;
#define ATT_DMA(t, slot) do { const size_t go = (size_t)(t) * 64 * NIN; lds_u8* sb = lds + (slot) * ATT_SLOT; \
        glds16(k1src + go, sb + wid * 1024); glds16(k2src + go, sb + 8192 + wid * 1024); \
        glds16(vsrc0 + go, sb + 16384 + (2 * wid) * 1024); glds16(vsrc1 + go, sb + 16384 + (2 * wid + 1) * 1024); } while (0)
    const int koff = map * 8192 + r32 * 128, ksw = (r32 >> 1) & 7;
    const int voff = 16384 + ((lane >> 4) & 1) * 32 + (lane & 3) * 8 + (4 * hi + ((lane & 15) >> 2)) * 64;
    f32x16 o[4];
#pragma unroll
    for (int d = 0; d < 4; ++d) o[d] = f32x16{};
    float mrun = -INFINITY, lrun = 0.f;
    const int qpos = q0 + rgp * 32 + r32;
    float b31 = ((const float*)(a.ws + WS_BTAB))[h * 128 + 127]; asm volatile("" : "+v"(b31));
    ATT_DMA(0, 0);
    for (int t = 0; t < NT; ++t) {
        if (!(MODE & 32) || t < 2) { VM_WAIT(); __syncthreads(); }
        if (t + 1 < NT && (!(MODE & 8) || t + 1 < 2)) ATT_DMA(t + 1, (t + 1) & 1);
        if (64 * t > q0 + rgp * 32 + 31) continue;
        const lds_u8* sb = lds + (t & 1) * ATT_SLOT;
        const bool nearT = (64 * t + 176 > q0);
        const float cb = nearT ? 0.f : b31;
        f32x16 sA, sB;
        { const float c0 = (t == 0) ? 0.f : cb - mrun;
#pragma unroll
          for (int r = 0; r < 16; ++r) { sA[r] = c0; sB[r] = c0; } }
        if (MODE & 1) {
            bf16x8 kf[8];
#pragma unroll
            for (int d0 = 0; d0 < 4; ++d0) { const int kc = koff + (((2 * d0 + hi) ^ ksw) << 4); if (MODE & 16) { kf[2 * d0] = qf[d0]; kf[2 * d0 + 1] = qf[3 - d0]; } else { kf[2 * d0] = ldsb128(sb + kc); kf[2 * d0 + 1] = ldsb128(sb + kc + 4096); } }
            __builtin_amdgcn_sched_group_barrier(0x100, 8, 0);
#pragma unroll
            for (int d0 = 0; d0 < 4; ++d0) { sA = MFMA32(kf[2 * d0], qf[d0], sA); sB = MFMA32(kf[2 * d0 + 1], qf[d0], sB); }
            __builtin_amdgcn_sched_group_barrier(0x8, 8, 0);
        }
        if (!(MODE & 1)) asm volatile("" : "+v"(sA), "+v"(sB));
        if (MODE & 4) {
        if (nearT) {
            const LAS float* bt = (const LAS float*)(lds + ATT_BTAB);
            float bA[16], bB[16];
#pragma unroll
            for (int r = 0; r < 16; ++r) { const int d0 = qpos - (64 * t + crow(r, hi)), d1 = d0 - 32;
                bA[r] = bt[d0 < 0 ? 0 : (d0 > 127 ? 127 : d0)]; bB[r] = bt[d1 < 0 ? 0 : (d1 > 127 ? 127 : d1)]; }
            asm volatile("" : "+v"(bA[0]), "+v"(bA[1]), "+v"(bA[2]), "+v"(bA[3]), "+v"(bA[4]), "+v"(bA[5]), "+v"(bA[6]), "+v"(bA[7]), "+v"(bA[8]), "+v"(bA[9]), "+v"(bA[10]), "+v"(bA[11]), "+v"(bA[12]), "+v"(bA[13]), "+v"(bA[14]), "+v"(bA[15]));
            asm volatile("" : "+v"(bB[0]), "+v"(bB[1]), "+v"(bB[2]), "+v"(bB[3]), "+v"(bB[4]), "+v"(bB[5]), "+v"(bB[6]), "+v"(bB[7]), "+v"(bB[8]), "+v"(bB[9]), "+v"(bB[10]), "+v"(bB[11]), "+v"(bB[12]), "+v"(bB[13]), "+v"(bB[14]), "+v"(bB[15]));
#pragma unroll
            for (int r = 0; r < 16; ++r) { const int d0 = qpos - (64 * t + crow(r, hi)), d1 = d0 - 32;
                sA[r] = d0 < 0 ? -INFINITY : sA[r] + bA[r]; sB[r] = d1 < 0 ? -INFINITY : sB[r] + bB[r]; }
        }
#define MX3(a_, b_, c_) __builtin_fmaxf(__builtin_fmaxf((a_), (b_)), (c_))
        float mxa = MX3(sA[0], sA[1], sB[0]), mxb = MX3(sA[2], sA[3], sB[1]); mxa = MX3(mxa, sB[2], sB[3]);
#pragma unroll
        for (int r = 4; r < 16; r += 4) { mxa = MX3(mxa, sA[r], sA[r + 1]); mxb = MX3(mxb, sA[r + 2], sA[r + 3]); mxa = MX3(mxa, sB[r], sB[r + 1]); mxb = MX3(mxb, sB[r + 2], sB[r + 3]); }
#undef MX3
        const float mx = swap_max(__builtin_fmaxf(mxa, mxb));
        if (t == 0 || __any(mx > 6.0f)) {
            const float up = (t == 0) ? mx : __builtin_fmaxf(mx, 0.f), alpha = (t == 0) ? 0.f : __builtin_amdgcn_exp2f(-up);
            mrun = (t == 0) ? mx + cb : mrun + up; lrun *= alpha;
#pragma unroll
            for (int d = 0; d < 4; ++d)
#pragma unroll
                for (int r = 0; r < 16; ++r) o[d][r] *= alpha;
            const float sh = (t == 0) ? mx : up;
#pragma unroll
            for (int r = 0; r < 16; ++r) { sA[r] -= sh; sB[r] -= sh; }
        }
#pragma unroll
        for (int r = 0; r < 16; ++r) { sA[r] = __builtin_amdgcn_exp2f(sA[r]); sB[r] = __builtin_amdgcn_exp2f(sB[r]); }
        f32x2 ps2a = (f32x2){0.f, 0.f}, ps2b = (f32x2){0.f, 0.f};
#pragma unroll
        for (int r = 0; r < 16; r += 2) { ps2a += (f32x2){sA[r], sA[r + 1]}; ps2b += (f32x2){sB[r], sB[r + 1]}; }
        lrun += (ps2a.x + ps2a.y) + (ps2b.x + ps2b.y);
        } else { asm volatile("" : "+v"(sA), "+v"(sB)); }
        u32x4 pw[4];
        pw[0] = (u32x4){pk2(sA[0], sA[1]), pk2(sA[2], sA[3]), pk2(sA[4], sA[5]), pk2(sA[6], sA[7])};
        pw[1] = (u32x4){pk2(sA[8], sA[9]), pk2(sA[10], sA[11]), pk2(sA[12], sA[13]), pk2(sA[14], sA[15])};
        pw[2] = (u32x4){pk2(sB[0], sB[1]), pk2(sB[2], sB[3]), pk2(sB[4], sB[5]), pk2(sB[6], sB[7])};
        pw[3] = (u32x4){pk2(sB[8], sB[9]), pk2(sB[10], sB[11]), pk2(sB[12], sB[13]), pk2(sB[14], sB[15])};
        if (!(MODE & 2)) { asm volatile("" :: "v"(pw[0]), "v"(pw[1]), "v"(pw[2]), "v"(pw[3])); continue; }
        {
            bf16x8 vfa[4], vfb[4];
#pragma unroll
            for (int d = 0; d < 4; ++d) vfa[d] = (MODE & 16) ? qf[d] : vfrag(sb + voff + d * 4096);
            __builtin_amdgcn_sched_group_barrier(0x100, 8, 0);
#pragma unroll
            for (int ks = 0; ks < 4; ks += 2) {
#pragma unroll
                for (int d = 0; d < 4; ++d) vfb[d] = (MODE & 16) ? qf[3 - d] : vfrag(sb + voff + d * 4096 + (ks + 1) * 1024);
                __builtin_amdgcn_sched_group_barrier(0x100, 8, 0);
                { const bf16x8 pb = __builtin_bit_cast(bf16x8, pw[ks]);
#pragma unroll
                  for (int d = 0; d < 4; ++d) o[d] = MFMA32(vfa[d], pb, o[d]); }
                __builtin_amdgcn_sched_group_barrier(0x8, 4, 0);
                if (ks + 2 < 4) {
#pragma unroll
                    for (int d = 0; d < 4; ++d) vfa[d] = (MODE & 16) ? qf[d] : vfrag(sb + voff + d * 4096 + (ks + 2) * 1024);
                    __builtin_amdgcn_sched_group_barrier(0x100, 8, 0);
                }
                { const bf16x8 pb = __builtin_bit_cast(bf16x8, pw[ks + 1]);
#pragma unroll
                  for (int d = 0; d < 4; ++d) o[d] = MFMA32(vfb[d], pb, o[d]); }
                __builtin_amdgcn_sched_group_barrier(0x8, 4, 0);
            }
        }
    }
    const float inv = 1.0f / swap_sum(lrun);
    LAS float* xch = (LAS float*)(lds + ATT_XCH + (rgp * 32 + r32) * ATT_XPITCH);
    if (map == 1) {
        const float sc = inv * lam;
#pragma unroll
        for (int d = 0; d < 4; ++d)
#pragma unroll
            for (int g = 0; g < 4; ++g) *(LAS f32x4*)(xch + 32 * d + 8 * g + 4 * hi) = (f32x4){o[d][4 * g] * sc, o[d][4 * g + 1] * sc, o[d][4 * g + 2] * sc, o[d][4 * g + 3] * sc};
    }
    __syncthreads();
    if (map == 0) {
        float ss = 0.f;
#pragma unroll
        for (int d = 0; d < 4; ++d)
#pragma unroll
            for (int g = 0; g < 4; ++g) { const f32x4 o2 = *(const LAS f32x4*)(xch + 32 * d + 8 * g + 4 * hi);
#pragma unroll
                for (int j = 0; j < 4; ++j) { const float v = o[d][4 * g + j] * inv - o2[j]; o[d][4 * g + j] = v; ss += v * v; } }
        ss = swap_sum(ss);
        const float rn = 0.8f / sqrtf(ss * (1.0f / 128.0f) + EPSF);
        const float* sub = a.in[8];
        bf16_t* mixp = (bf16_t*)(a.ws + WS_MIX) + (rowbase + qpos) * DM + 512 + h * 128;
#pragma unroll
        for (int d = 0; d < 4; ++d)
#pragma unroll
            for (int g = 0; g < 4; ++g) { const int dd = 32 * d + 8 * g + 4 * hi; const f32x4 sv = *(const GAS f32x4*)(sub + dd);
                u32x2 w; w.x = pk2(o[d][4 * g] * rn * sv.x, o[d][4 * g + 1] * rn * sv.y); w.y = pk2(o[d][4 * g + 2] * rn * sv.z, o[d][4 * g + 3] * rn * sv.w);
                *(GAS u32x2*)(mixp + dd) = w; }
    }
    __syncthreads();
#undef ATT_DMA
}

constexpr int RET_BUF = 49152, RET_RT = 2 * RET_BUF, RET_GN = RET_RT + 8192;
static_assert(RET_GN + 2048 <= LDS_SCRATCH, "retention LDS");

__device__ __forceinline__ void ret_unit(const Args& a, lds_u8* lds, int b, int h) {
    int tid_ = threadIdx.x; asm volatile("" : "+v"(tid_));
    const int tid = tid_, lane = tid & 63, r32 = lane & 31, hi = lane >> 5; const int wid = __builtin_amdgcn_readfirstlane(tid >> 6);
    const int rgp = wid & 3, eh = wid >> 2;
    const bf16_t* proj = (const bf16_t*)(a.ws + WS_PROJ);
    const size_t rowbase = (size_t)b * SEQ;
    const double lg = log2(1.0 - exp2(-5.0 - (double)h));
    const float gam = (float)exp2(lg), g127 = (float)exp2(lg * 127.0), g128 = (float)exp2(lg * 128.0);
#define RET_DMA(c, buf) do { const size_t ro = (rowbase + (size_t)(c) * 128) * NIN; lds_u8* bb = lds + (buf) * RET_BUF; \
        _Pragma("unroll") for (int i_ = 0; i_ < 2; ++i_) { const int p_ = 2 * wid + i_; \
            { const int ch = p_ >> 1, rh = p_ & 1; glds16(proj + ro + (size_t)(rh * 64 + lane) * NIN + OFF_RK + h * 64 + ch * 8, bb + ch * 2048 + rh * 1024); } \
            { const int db = p_ >> 3, rg_ = p_ & 7; glds16(proj + ro + (size_t)(rg_ * 16 + (lane >> 2)) * NIN + OFF_RK + h * 64 + db * 32 + (lane & 3) * 8, bb + 16384 + db * 8192 + rg_ * 1024); \
              glds16(proj + ro + (size_t)(rg_ * 16 + (lane >> 2)) * NIN + OFF_RV + h * 64 + db * 32 + (lane & 3) * 8, bb + 32768 + db * 8192 + rg_ * 1024); } } } while (0)
    const int koff = hi * 2048 + r32 * 16;
    const int troff = ((lane >> 4) & 1) * 32 + (lane & 3) * 8 + (4 * hi + ((lane & 15) >> 2)) * 64;
    f32x16 R = f32x16{};
    for (int i = tid; i < 8192 / 16; i += NTHR) *(LAS u32x4*)(lds + RET_RT + i * 16) = (u32x4){0u, 0u, 0u, 0u};
    const float* gn = a.in[3];
    f32x4 gv[4];
#pragma unroll
    for (int g = 0; g < 4; ++g) gv[g] = *(const GAS f32x4*)(gn + h * 64 + eh * 32 + 8 * g + 4 * hi);
    bf16x8 qn[4]; u32x2 svn[4];
#define RET_PREF(c) do { const size_t tk_ = rowbase + (size_t)(c) * 128 + rgp * 32 + r32; const bf16_t* qp_ = proj + tk_ * NIN + OFF_RQ + h * 64 + hi * 8; const bf16_t* sg_ = proj + tk_ * NIN + OFF_RG + h * 64 + eh * 32 + 4 * hi; \
        _Pragma("unroll") for (int s = 0; s < 4; ++s) qn[s] = *(const GAS bf16x8*)(qp_ + s * 16); \
        _Pragma("unroll") for (int g = 0; g < 4; ++g) svn[g] = *(const GAS u32x2*)(sg_ + 8 * g); } while (0)
    RET_PREF(0);
    RET_DMA(0, 0);
    for (int c = 0; c < 32; ++c) {
        VM_WAIT(); __syncthreads();
        bf16x8 qf[4]; u32x2 svc[4];
#pragma unroll
        for (int s = 0; s < 4; ++s) { qf[s] = qn[s]; svc[s] = svn[s]; }
        if (c + 1 < 32) { RET_PREF(c + 1); RET_DMA(c + 1, (c + 1) & 1); }
        const lds_u8* bb = lds + (c & 1) * RET_BUF;
        const size_t tok = rowbase + (size_t)c * 128 + rgp * 32 + r32;
        f32x16 O = f32x16{};
#pragma unroll
        for (int s = 0; s < 4; ++s) { const bf16x8 rt = ldsb128(lds + RET_RT + (2 * s + hi) * 1024 + (eh * 32 + r32) * 16); O = MFMA32(rt, qf[s], O); }
        for (int kb = 0; kb <= rgp; ++kb) {
            f32x16 S = f32x16{};
#pragma unroll
            for (int s = 0; s < 4; ++s) { const bf16x8 ka = ldsb128(bb + koff + s * 4096 + (kb * 32) * 16); S = MFMA32(ka, qf[s], S); }
            if (kb == rgp) {
#pragma unroll
                for (int r = 0; r < 16; ++r) S[r] = (crow(r, hi) > r32) ? 0.f : S[r];
            }
            const u32x4 p0 = (u32x4){pk2(S[0], S[1]), pk2(S[2], S[3]), pk2(S[4], S[5]), pk2(S[6], S[7])};
            const u32x4 p1 = (u32x4){pk2(S[8], S[9]), pk2(S[10], S[11]), pk2(S[12], S[13]), pk2(S[14], S[15])};
            const bf16x8 v0 = vfrag(bb + 32768 + eh * 8192 + troff + (2 * kb) * 1024), v1 = vfrag(bb + 32768 + eh * 8192 + troff + (2 * kb + 1) * 1024);
            O = MFMA32(v0, __builtin_bit_cast(bf16x8, p0), O); O = MFMA32(v1, __builtin_bit_cast(bf16x8, p1), O);
        }
        if (rgp < 2) {
            f32x16 T = f32x16{};
#pragma unroll
            for (int ks = 0; ks < 8; ++ks) { const bf16x8 kt = vfrag(bb + 16384 + rgp * 8192 + troff + ks * 1024), vv = vfrag(bb + 32768 + eh * 8192 + troff + ks * 1024); T = MFMA32(kt, vv, T); }
#pragma unroll
            for (int r = 0; r < 16; ++r) R[r] = R[r] * g128 + T[r] * g127;
        }
        float s1 = 0.f, s2 = 0.f;
#pragma unroll
        for (int r = 0; r < 16; ++r) { s1 += O[r]; s2 += O[r] * O[r]; }
        s1 = swap_sum(s1); s2 = swap_sum(s2);
        LAS f32x2* gx = (LAS f32x2*)(lds + RET_GN);
        if (hi == 0) gx[(rgp * 32 + r32) * 2 + eh] = (f32x2){s1, s2};
        __syncthreads();
        if (rgp < 2) {
#pragma unroll
            for (int g = 0; g < 4; ++g) { u32x2 w; w.x = pk2(R[4 * g] * gam, R[4 * g + 1] * gam); w.y = pk2(R[4 * g + 2] * gam, R[4 * g + 3] * gam);
                *(LAS u32x2*)(lds + RET_RT + (rgp * 4 + g) * 1024 + (eh * 32 + r32) * 16 + hi * 8) = w; }
        }
        const f32x2 ga = gx[(rgp * 32 + r32) * 2], gb = gx[(rgp * 32 + r32) * 2 + 1];
        const float mean = (ga.x + gb.x) * (1.0f / 64.0f), var = (ga.y + gb.y) * (1.0f / 64.0f) - mean * mean;
        const float rstd = 1.0f / sqrtf(__builtin_fmaxf(var, 0.f) + EPSF);
        bf16_t* mixp = (bf16_t*)(a.ws + WS_MIX) + tok * DM + h * 64 + eh * 32;
#pragma unroll
        for (int g = 0; g < 4; ++g) { const int e = 8 * g + 4 * hi; const u32x2 sv = svc[g];
            const float y0 = (O[4 * g] - mean) * rstd * gv[g].x * __uint_as_float(sv.x << 16), y1 = (O[4 * g + 1] - mean) * rstd * gv[g].y * __uint_as_float(sv.x & 0xffff0000u);
            const float y2 = (O[4 * g + 2] - mean) * rstd * gv[g].z * __uint_as_float(sv.y << 16), y3 = (O[4 * g + 3] - mean) * rstd * gv[g].w * __uint_as_float(sv.y & 0xffff0000u);
            u32x2 w; w.x = pk2(y0, y1); w.y = pk2(y2, y3); *(GAS u32x2*)(mixp + e) = w; }
    }
    __syncthreads();
#undef RET_DMA
#undef RET_PREF
}


#define CAS_DESC(x, y) do { const float hi_ = __builtin_fmaxf(x, y), lo_ = __builtin_fminf(x, y); x = hi_; y = lo_; } while (0)
#define CAS_ASC(x, y) do { const float hi_ = __builtin_fmaxf(x, y), lo_ = __builtin_fminf(x, y); x = lo_; y = hi_; } while (0)
__device__ __forceinline__ void sort16_desc(float (&v)[16]) {
#pragma unroll
    for (int k = 2; k <= 16; k <<= 1)
#pragma unroll
        for (int j = k >> 1; j > 0; j >>= 1)
#pragma unroll
            for (int i = 0; i < 16; ++i) { const int l = i ^ j; if (l > i) { if ((i & k) == 0) CAS_DESC(v[i], v[l]); else CAS_ASC(v[i], v[l]); } }
}
__device__ __forceinline__ void bitonic_merge16_desc(float (&v)[16]) {
#pragma unroll
    for (int j = 8; j > 0; j >>= 1)
#pragma unroll
        for (int i = 0; i < 16; ++i) { const int l = i ^ j; if (l > i) CAS_DESC(v[i], v[l]); }
}
__device__ __forceinline__ void merge_top16(float (&a)[16], const float (&b)[16]) {
#pragma unroll
    for (int i = 0; i < 16; ++i) a[i] = __builtin_fmaxf(a[i], b[15 - i]);
    bitonic_merge16_desc(a);
}
__device__ __forceinline__ unsigned pack_idx4(const float (&v)[16], int w) {
    return (__float_as_uint(v[4 * w]) & 127u) | ((__float_as_uint(v[4 * w + 1]) & 127u) << 8) | ((__float_as_uint(v[4 * w + 2]) & 127u) << 16) | ((__float_as_uint(v[4 * w + 3]) & 127u) << 24);
}
__device__ __forceinline__ unsigned lookup_idx(const unsigned (&pk)[4], unsigned i) {
    const unsigned w = i >> 2; unsigned s = w == 0 ? pk[0] : (w == 1 ? pk[1] : (w == 2 ? pk[2] : pk[3]));
    return (s >> ((i & 3u) * 8u)) & 127u;
}

constexpr int P5_KEYB = 32768;
__device__ __forceinline__ void p5_topk(const Args& a, lds_u8* lds) {
    const int tid = threadIdx.x, lane = tid & 63, r32 = lane & 31, hi = lane >> 5; const int wid = __builtin_amdgcn_readfirstlane(tid >> 6);
    const int hp = blockIdx.x & 3, wgi = blockIdx.x >> 2, nwg = (gridDim.x + 3 - hp) / 4;
    const bf16_t* keys = (const bf16_t*)(a.ws + WS_KEYS) + (size_t)hp * 4 * 128 * 128;
    for (int i = tid; i < 4 * 128 * 16; i += NTHR) { const int t = i >> 11, key = (i >> 4) & 127, c = i & 15;
        *(LAS u32x4*)(lds + t * P5_KEYB + c * 2048 + key * 16) = *(const GAS u32x4*)(keys + ((size_t)t * 128 + key) * 128 + c * 8); }
    __syncthreads();
    const bf16_t* Q = (const bf16_t*)(a.ws + WS_PROJ);
    int* IDX = (int*)(a.ws + WS_IDX); float* GATE = (float*)(a.ws + WS_GATE);
    const int tg0 = wgi * NWAVES + wid, tgs = nwg * NWAVES;
    const int ntask = (tg0 < MTOK / 32) ? 4 * ((MTOK / 32 - 1 - tg0) / tgs + 1) : 0;
#define P5_QLOAD(QF, k_) do { const int tg_ = tg0 + ((k_) >> 2) * tgs, t_ = (k_) & 3; \
        const bf16_t* qp = Q + (size_t)(tg_ * 32 + r32) * NQ + (2 * hp + (t_ >> 1)) * 256 + (t_ & 1) * 128 + hi * 8; \
        _Pragma("unroll") for (int s = 0; s < 8; ++s) QF[s] = *(const GAS bf16x8*)(qp + s * 16); } while (0)
    float la[16], lb[16];
#pragma unroll
    for (int r = 0; r < 16; ++r) { la[r] = 0.f; lb[r] = 0.f; }
    bf16x8 qf[8], qn[8];
    if (ntask > 0) P5_QLOAD(qf, 0);
#pragma unroll 1
    for (int k = 0; k < ntask; ++k) {
      {
        const int tg = tg0 + (k >> 2) * tgs, t = k & 3;
        P5_QLOAD(qn, (k + 1 < ntask ? k + 1 : k));
        {
            float top[16];
#pragma unroll
            for (int kb = 0; kb < 4; ++kb) {
                f32x16 S = f32x16{};
#pragma unroll
                for (int s = 0; s < 8; ++s) { const bf16x8 kf = ldsb128(lds + t * P5_KEYB + (2 * s + hi) * 2048 + (kb * 32 + r32) * 16); S = MFMA32(kf, qf[s], S); }
                float v[16];
#pragma unroll
                for (int r = 0; r < 16; ++r) v[r] = __uint_as_float((__float_as_uint(S[r]) & ~127u) | (unsigned)(kb * 32 + (r & 3) + 8 * (r >> 2)) | ((unsigned)hi << 2));
                sort16_desc(v);
                if (kb == 0) {
#pragma unroll
                    for (int r = 0; r < 16; ++r) top[r] = v[r];
                } else merge_top16(top, v);
            }
            float oth[16];
#pragma unroll
            for (int r = 0; r < 16; ++r) { auto rr = __builtin_amdgcn_permlane32_swap(__float_as_uint(top[r]), __float_as_uint(top[r]), false, false); top[r] = __uint_as_float(rr[0]); oth[r] = __uint_as_float(rr[1]); }
            merge_top16(top, oth);
            const bool ka = ((t >> 1) == hi) && ((t & 1) == 0), kb2 = ((t >> 1) == hi) && ((t & 1) == 1);
#pragma unroll
            for (int r = 0; r < 16; ++r) { la[r] = ka ? top[r] : la[r]; lb[r] = kb2 ? top[r] : lb[r]; }
        }
#pragma unroll
        for (int s2 = 0; s2 < 8; ++s2) qf[s2] = qn[s2];
        if (t != 3) continue;
        unsigned pa[4], pb[4];
#pragma unroll
        for (int w = 0; w < 4; ++w) { pa[w] = pack_idx4(la, w); pb[w] = pack_idx4(lb, w); }
        float c0[16], c1[16];
#define CAND(i, j) __uint_as_float((__float_as_uint(la[i] + lb[j]) & ~255u) | (unsigned)((i) * 16 + (j)))
        const float NEG = -INFINITY;
        c0[0] = CAND(0, 0); c0[1] = CAND(0, 1); c0[2] = CAND(0, 2); c0[3] = CAND(0, 3); c0[4] = CAND(0, 4); c0[5] = CAND(0, 5); c0[6] = CAND(0, 6); c0[7] = CAND(0, 7);
        c0[8] = CAND(0, 8); c0[9] = CAND(0, 9); c0[10] = CAND(0, 10); c0[11] = CAND(0, 11); c0[12] = CAND(0, 12); c0[13] = CAND(0, 13); c0[14] = CAND(0, 14); c0[15] = CAND(0, 15);
        sort16_desc(c0);
        c1[0] = CAND(1, 0); c1[1] = CAND(1, 1); c1[2] = CAND(1, 2); c1[3] = CAND(1, 3); c1[4] = CAND(1, 4); c1[5] = CAND(1, 5); c1[6] = CAND(1, 6); c1[7] = CAND(1, 7);
        c1[8] = CAND(2, 0); c1[9] = CAND(2, 1); c1[10] = CAND(2, 2); c1[11] = CAND(2, 3); c1[12] = CAND(2, 4); c1[13] = CAND(3, 0); c1[14] = CAND(3, 1); c1[15] = CAND(3, 2);
        sort16_desc(c1); merge_top16(c0, c1);
        asm volatile("" : "+v"(c0[0]), "+v"(c0[15]));
        c1[0] = CAND(3, 3); c1[1] = CAND(4, 0); c1[2] = CAND(4, 1); c1[3] = CAND(4, 2); c1[4] = CAND(5, 0); c1[5] = CAND(5, 1); c1[6] = CAND(6, 0); c1[7] = CAND(6, 1);
        c1[8] = CAND(7, 0); c1[9] = CAND(7, 1); c1[10] = CAND(8, 0); c1[11] = CAND(9, 0); c1[12] = CAND(10, 0); c1[13] = CAND(11, 0); c1[14] = CAND(12, 0); c1[15] = CAND(13, 0);
        sort16_desc(c1); merge_top16(c0, c1);
        asm volatile("" : "+v"(c0[0]), "+v"(c0[15]));
        c1[0] = CAND(14, 0); c1[1] = CAND(15, 0);
#pragma unroll
        for (int r = 2; r < 16; ++r) c1[r] = NEG;
#undef CAND
        sort16_desc(c1); merge_top16(c0, c1);
        float gsum = 0.f, gv[16]; int ex[16];
        const float mx = __uint_as_float(__float_as_uint(c0[0]) & ~255u);
#pragma unroll
        for (int r = 0; r < 16; ++r) { const unsigned bits = __float_as_uint(c0[r]); const float val = __uint_as_float(bits & ~255u);
            gv[r] = __expf(val - mx); gsum += gv[r];
            ex[r] = (int)(lookup_idx(pa, (bits >> 4) & 15u) * 128u + lookup_idx(pb, bits & 15u)); }
        const float ginv = 1.0f / gsum;
        const size_t ob = (size_t)(tg * 32 + r32) * 128 + (2 * hp + hi) * 16;
#pragma unroll
        for (int r = 0; r < 16; r += 4) { *(GAS u32x4*)(IDX + ob + r) = (u32x4){(unsigned)ex[r], (unsigned)ex[r + 1], (unsigned)ex[r + 2], (unsigned)ex[r + 3]};
            *(GAS f32x4*)(GATE + ob + r) = (f32x4){gv[r] * ginv, gv[r + 1] * ginv, gv[r + 2] * ginv, gv[r + 3] * ginv}; }
      }
    }
#undef P5_QLOAD
    __syncthreads();
}

typedef long i64_t;
typedef int v8i_t __attribute__((ext_vector_type(8)));
#define MFMA16F8(a, b, c) __builtin_amdgcn_mfma_f32_16x16x32_fp8_fp8(a, b, c, 0, 0, 0)
constexpr float P6_SD = 64.f, P6_SX = 8.f, P6_SU = 16.f, P6_SA = 64.f, P6_SU4 = 6.f;
constexpr size_t P6_SLICEB = (size_t)NEXP * 128;
__device__ __forceinline__ unsigned pk4_fp8(float a, float b, float c, float d) { int w = __builtin_amdgcn_cvt_pk_fp8_f32(a, b, 0, false); w = __builtin_amdgcn_cvt_pk_fp8_f32(c, d, w, true); return (unsigned)w; }
__device__ __forceinline__ float fp8_byte0(unsigned w) { return __builtin_amdgcn_cvt_f32_fp8((int)w, 0); }
constexpr int P6_WSCR = 3328;
__device__ __forceinline__ void p6_token(const Args& a, lds_u8* wl, int tok, int lane, float* OUTW) {
    const int n = lane & 15, g = lane >> 4;
    const unsigned char* ws = a.ws;
    const unsigned char* WD = ws + WS_WD; const unsigned char* WU = ws + WS_WU;
    const int* IDX = (const int*)(ws + WS_IDX) + (size_t)tok * 128; const float* GATE = (const float*)(ws + WS_GATE) + (size_t)tok * 128;
    const bf16_t* X1 = (const bf16_t*)(ws + WS_X1B) + (size_t)tok * DM;
    {
#pragma unroll
        for (int j = 0; j < 4; ++j) {
            const u32x2 xw_ = *(const GAS u32x2*)(X1 + 256 * j + 4 * lane); const f32x4 v = (f32x4){__uint_as_float(xw_.x << 16), __uint_as_float(xw_.x & 0xffff0000u), __uint_as_float(xw_.y << 16), __uint_as_float(xw_.y & 0xffff0000u)} * P6_SX;
            const unsigned hw = pk4_fp8(v.x, v.y, v.z, v.w);
            const float r0 = v.x - __builtin_amdgcn_cvt_f32_fp8((int)hw, 0), r1 = v.y - __builtin_amdgcn_cvt_f32_fp8((int)hw, 1), r2 = v.z - __builtin_amdgcn_cvt_f32_fp8((int)hw, 2), r3 = v.w - __builtin_amdgcn_cvt_f32_fp8((int)hw, 3);
            const unsigned lw = pk4_fp8(r0 * 16.f, r1 * 16.f, r2 * 16.f, r3 * 16.f);
            *(LAS unsigned*)(wl + 256 * j + 4 * lane) = hw; *(LAS unsigned*)(wl + 1024 + 256 * j + 4 * lane) = lw;
        }
        const u32x2 iv = *(const GAS u32x2*)(IDX + lane * 2); *(LAS u32x2*)(wl + 2048 + lane * 8) = iv;
    }
    const float rs2 = row_rs2((const bf16_t*)(ws + WS_SSQ), tok);
    LDS_WAIT();
    const LAS int* idxl = (const LAS int*)(wl + 2048); LAS unsigned short* actl = (LAS unsigned short*)(wl + 2560);
    const int xoff = (n & 1) * 1024 + 16 * g;
#pragma unroll 1
    for (int eg = 0; eg < 8; ++eg) {
        const int e = idxl[eg * 16 + n];
        const unsigned char* rp = WD + (size_t)e * 128 + 16 * g;
        f32x4 acc = (f32x4){0.f, 0.f, 0.f, 0.f};
        u32x4 bq[16];
#pragma unroll
        for (int sl = 0; sl < 8; ++sl) { bq[2 * sl] = *(const GAS u32x4*)(rp + sl * P6_SLICEB); bq[2 * sl + 1] = *(const GAS u32x4*)(rp + sl * P6_SLICEB + 64); }
#pragma unroll
        for (int sl = 0; sl < 8; ++sl)
#pragma unroll
            for (int hf = 0; hf < 2; ++hf) {
                const u32x4 xa = *(const LAS u32x4*)(wl + xoff + sl * 128 + hf * 64); const u32x4 bb = bq[2 * sl + hf];
                acc = MFMA16F8((i64_t)(((unsigned long long)xa.y << 32) | xa.x), (i64_t)(((unsigned long long)bb.y << 32) | bb.x), acc);
                acc = MFMA16F8((i64_t)(((unsigned long long)xa.w << 32) | xa.z), (i64_t)(((unsigned long long)bb.w << 32) | bb.z), acc);
            }
        const float av = (acc[0] + acc[1] * 0.0625f) * (rs2 * (1.0f / (P6_SD * P6_SX)));
        const float act = 0.5f * av * (1.0f + erff(av * 0.70710678118654752f)) * GATE[eg * 16 + n] * P6_SA;
        const unsigned hb = pk4_fp8(act, 0.f, 0.f, 0.f) & 0xffu;
        const unsigned lb = pk4_fp8((act - fp8_byte0(hb)) * 16.f, 0.f, 0.f, 0.f) & 0xffu;
        if (g == 0) actl[eg * 16 + n] = (unsigned short)(hb | (lb << 8));
    }
    LDS_WAIT();
    const int pos = n & 7, sel = n >> 3;
    float ss = 0.f;
    const bool owner = (n < 8) && (g < 2);
#pragma unroll 1
    for (int sl = 0; sl < 8; ++sl) {
        f32x4 ah[2], al[2];
#pragma unroll
        for (int s = 0; s < 2; ++s) { ah[s] = (f32x4){0.f, 0.f, 0.f, 0.f}; al[s] = (f32x4){0.f, 0.f, 0.f, 0.f}; }
        u32x4 bq[16]; unsigned av[16];
#pragma unroll
        for (int q = 0; q < 16; ++q) { const int ei = 8 * q + 4 * sel + g; const int e = idxl[ei]; av[q] = actl[ei];
            bq[q] = *(const GAS u32x4*)(WU + sl * P6_SLICEB + (size_t)e * 128 + 16 * pos); }
#pragma unroll
        for (int q = 0; q < 16; ++q) {
            const unsigned long long ahv = (unsigned long long)(av[q] & 0xffu) << (8 * pos), alv = (unsigned long long)(av[q] >> 8) << (8 * pos);
            const u32x4 bb = bq[q];
            const i64_t b0 = (i64_t)(((unsigned long long)bb.y << 32) | bb.x), b1 = (i64_t)(((unsigned long long)bb.w << 32) | bb.z);
            ah[0] = MFMA16F8((i64_t)ahv, b0, ah[0]); al[0] = MFMA16F8((i64_t)alv, b0, al[0]);
            ah[1] = MFMA16F8((i64_t)ahv, b1, ah[1]); al[1] = MFMA16F8((i64_t)alv, b1, al[1]);
        }
#pragma unroll
        for (int s = 0; s < 2; ++s) {
            f32x4 t = ah[s] + al[s] * 0.0625f, u;
#pragma unroll
            for (int r = 0; r < 4; ++r) u[r] = __shfl(t[r], (lane + 40) & 63);
            const int col = 128 * sl + 16 * pos + 8 * s + 4 * (g & 1);
            const u32x2 xq_ = *(const GAS u32x2*)(X1 + col); const f32x4 xv = (f32x4){__uint_as_float(xq_.x << 16), __uint_as_float(xq_.x & 0xffff0000u), __uint_as_float(xq_.y << 16), __uint_as_float(xq_.y & 0xffff0000u)};
            const f32x4 x2 = xv + (t + u) * (1.0f / (P6_SA * P6_SU));
            if (owner) { ss += (x2.x * x2.x + x2.y * x2.y) + (x2.z * x2.z + x2.w * x2.w); *(GAS f32x4*)(OUTW + (size_t)tok * DM + col) = x2; }
        }
    }
    ss = wave_sum(ss);
    const float rn = 1.0f / sqrtf(ss * (1.0f / DM) + EPSF);
    const float* nf = a.in[16];
    if (owner) {
#pragma unroll
        for (int sl = 0; sl < 8; ++sl)
#pragma unroll
            for (int s = 0; s < 2; ++s) { const int col = 128 * sl + 16 * pos + 8 * s + 4 * g; const f32x4 gv = *(const GAS f32x4*)(nf + col);
                GAS f32x4* op = (GAS f32x4*)(OUTW + (size_t)tok * DM + col); *op = *op * rn * gv; }
    }
}

constexpr int P6S_WAVE = 16384 + 512 + 128;
static_assert(NWAVES * P6S_WAVE <= LDS_SCRATCH, "P6 LDS");
__device__ __forceinline__ float gelu_as(float v) {
    const float av = __builtin_fabsf(v), t = __builtin_amdgcn_rcpf(av * 0.2316418882f + 1.0f);
    float q = t * 0.5307027145f + (-0.7265760135f); q = q * t + 0.7107068705f; q = q * t + (-0.142248368f); q = q * t + 0.127414796f; q = q * t;
    const float e = __builtin_amdgcn_exp2f((v * v) * (-0.72134752044f));
    const float m = v * (q * e);
    return v < 0.f ? m : v - m;
}
template <int EMASK, int PARTS>
__device__ __forceinline__ void p6_slices(const Args& a, lds_u8* wl, int tok0, int lane) {
    const int n = lane & 15, g = lane >> 4;
    const unsigned char* ws = a.ws;
    const unsigned char* WD = ws + WS_WD; const unsigned char* WU = ws + WS_WU;
    LAS float* aacc = (LAS float*)wl; LAS unsigned short* idl = (LAS unsigned short*)(wl + 8192); LAS unsigned short* actl = (LAS unsigned short*)(wl + 12288);
    lds_u8* xs = wl + 16384; LAS float* ssl = (LAS float*)(wl + 16384 + 512); LAS float* r2l = ssl + 16;
    {
        u32x2 iv[16];
#pragma unroll
        for (int t = 0; t < 16; ++t) iv[t] = *(const GAS u32x2*)((const int*)(ws + WS_IDX) + (size_t)(tok0 + t) * 128 + lane * 2);
#pragma unroll
        for (int t = 0; t < 16; ++t) {
            *(LAS unsigned*)(wl + 8192 + t * 256 + lane * 4) = (iv[t].x & 0xffffu) | (iv[t].y << 16);
            *(LAS f32x2*)(wl + t * 512 + lane * 8) = (f32x2){0.f, 0.f};
        }
    }
    if (lane < 16) { ssl[lane] = 0.f; r2l[lane] = row_rs2((const bf16_t*)(ws + WS_SSQ), tok0 + lane); }
    unsigned char* X4 = (unsigned char*)a.ws + WS_XB;
#pragma unroll 1
    for (int t8 = 0; t8 < 16; t8 += 8) {
    u32x4 xwa[8], xwb[8];
#pragma unroll
    for (int tt = 0; tt < 8; ++tt) { const bf16_t* xr = (const bf16_t*)(ws + WS_X1B) + (size_t)(tok0 + t8 + tt) * DM + 16 * lane; xwa[tt] = *(const GAS u32x4*)xr; xwb[tt] = *(const GAS u32x4*)(xr + 8); }
#pragma unroll
    for (int tt = 0; tt < 8; ++tt) {
        const int t = t8 + tt;
        const u32x4 xw0 = xwa[tt], xw1 = xwb[tt];
        float rr[16];
#pragma unroll
        for (int j = 0; j < 4; ++j) { rr[2 * j] = __uint_as_float(xw0[j] << 16); rr[2 * j + 1] = __uint_as_float(xw0[j] & 0xffff0000u); rr[8 + 2 * j] = __uint_as_float(xw1[j] << 16); rr[9 + 2 * j] = __uint_as_float(xw1[j] & 0xffff0000u); }
#pragma unroll
        for (int st = 0; st < 4; ++st) {
            unsigned w0 = 0u, w1 = 0u;
#define P6_Q4(p_) do { w0 = __builtin_amdgcn_cvt_scalef32_pk_fp4_f32(w0, rr[2 * (p_)], rr[2 * (p_) + 1], 1.0f, p_); w1 = __builtin_amdgcn_cvt_scalef32_pk_fp4_f32(w1, rr[8 + 2 * (p_)], rr[9 + 2 * (p_)], 1.0f, p_); } while (0)
            P6_Q4(0); P6_Q4(1); P6_Q4(2); P6_Q4(3);
#undef P6_Q4
#define P6_D4(p_) do { const f32x2 d0 = __builtin_amdgcn_cvt_scalef32_pk_f32_fp4(w0, 1.0f, p_), d1 = __builtin_amdgcn_cvt_scalef32_pk_f32_fp4(w1, 1.0f, p_); \
                rr[2 * (p_)] = (rr[2 * (p_)] - d0.x) * 4.0f; rr[2 * (p_) + 1] = (rr[2 * (p_) + 1] - d0.y) * 4.0f; rr[8 + 2 * (p_)] = (rr[8 + 2 * (p_)] - d1.x) * 4.0f; rr[9 + 2 * (p_)] = (rr[9 + 2 * (p_)] - d1.y) * 4.0f; } while (0)
            P6_D4(0); P6_D4(1); P6_D4(2); P6_D4(3);
#undef P6_D4
            *(GAS u32x2*)(X4 + (size_t)(tok0 + t) * 2048 + st * 512 + 8 * lane) = (u32x2){w0, w1};
        }
    }
    }
    LDS_WAIT(); VM_WAIT();
    const int xoff = (n & 3) * 128 + 16 * g;
    const int bpa = 4 * (4 * (lane & 15) + (lane >> 4));
#define MFMA4(a_, b_, c_) __builtin_amdgcn_mfma_scale_f32_16x16x128_f8f6f4(a_, b_, c_, 4  , 4  , 0, 0, 0, 0)
#define P6_DLOAD(BQ, XV, it_) do { const int sl_ = (it_) >> 4, t_ = (it_) & 15; \
        _Pragma("unroll") for (int eg = 0; eg < 8; ++eg) { const int e_ = idl[t_ * 128 + eg * 16 + (lane >> 2)] & EMASK; const unsigned char* rp_ = WD + sl_ * P6_SLICEB + (size_t)e_ * 128 + 16 * (lane & 3); \
            BQ[2 * eg] = *(const GAS u32x4*)rp_; BQ[2 * eg + 1] = *(const GAS u32x4*)(rp_ + 64); } \
        XV = *(const GAS u32x2*)(X4 + (size_t)(tok0 + t_) * 2048 + (lane >> 4) * 512 + sl_ * 128 + 8 * (lane & 15)); } while (0)
#define P6_DCOMP(BQ, XV, it_) do { const int t_ = (it_) & 15; \
        *(LAS u32x2*)(xs + (lane >> 4) * 128 + 8 * (lane & 15)) = XV; \
        LDS_WAIT(); \
        const u32x4 xa0 = *(const LAS u32x4*)(xs + xoff), xa1 = *(const LAS u32x4*)(xs + xoff + 64); \
        const v8i_t A0 = (v8i_t){(int)xa0.x, (int)xa0.y, (int)xa0.z, (int)xa0.w, 0, 0, 0, 0}; \
        const v8i_t A1 = (v8i_t){(int)xa1.x, (int)xa1.y, (int)xa1.z, (int)xa1.w, 0, 0, 0, 0}; \
        _Pragma("unroll") for (int eg = 0; eg < 8; ++eg) { f32x4 acc = (f32x4){0.f, 0.f, 0.f, 0.f}; v8i_t b0 = (v8i_t){0, 0, 0, 0, 0, 0, 0, 0}, b1 = (v8i_t){0, 0, 0, 0, 0, 0, 0, 0}; \
            _Pragma("unroll") for (int w_ = 0; w_ < 4; ++w_) { b0[w_] = __builtin_amdgcn_ds_bpermute(bpa, (int)BQ[2 * eg][w_]); b1[w_] = __builtin_amdgcn_ds_bpermute(bpa, (int)BQ[2 * eg + 1][w_]); } \
            acc = MFMA4(A0, b0, acc); acc = MFMA4(A1, b1, acc); \
            float r_ = (acc[0] + acc[1] * 0.25f) + (acc[2] * 0.0625f + acc[3] * 0.015625f); asm volatile("" : "+v"(r_)); \
            if (g == 0) aacc[t_ * 128 + eg * 16 + n] += r_; } \
        LDS_WAIT(); } while (0)
    if (PARTS & 1) {
        u32x4 bqA[16], bqB[16]; u32x2 xvA, xvB;
        P6_DLOAD(bqA, xvA, 0);
#pragma unroll 1
        for (int it = 0; it < 64; it += 2) {
            P6_DLOAD(bqB, xvB, it + 1);
            P6_DCOMP(bqA, xvA, it);
            P6_DLOAD(bqA, xvA, (it + 2 < 64 ? it + 2 : it));
            P6_DCOMP(bqB, xvB, it + 1);
        }
    }
#undef MFMA4
#undef P6_DLOAD
#undef P6_DCOMP
    int lane_g = lane; asm volatile("" : "+v"(lane_g));
    float gts[16][2];
#pragma unroll
    for (int t = 0; t < 16; ++t) { gts[t][0] = ((const float*)(ws + WS_GATE))[(size_t)(tok0 + t) * 128 + lane_g]; gts[t][1] = ((const float*)(ws + WS_GATE))[(size_t)(tok0 + t) * 128 + lane_g + 64]; }
#pragma unroll
    for (int t = 0; t < 16; ++t) {
        const float sc = r2l[t] * (1.0f / P6_SD);
#pragma unroll
        for (int j = 0; j < 2; ++j) { const int ei = lane_g + 64 * j; const float av = aacc[t * 128 + ei] * sc;
            const float act = gelu_as(av) * gts[t][j];
            const unsigned ab = __float_as_uint(act), eb = (ab >> 23) & 255u;
            unsigned pk = 0u;
            if (eb > 4u) {
                const float m = __uint_as_float((ab & 0x807fffffu) | (128u << 23));
                const unsigned w0 = __builtin_amdgcn_cvt_scalef32_pk_fp4_f32(0u, m, 0.f, 1.0f, 0);
                const f32x2 d0 = __builtin_amdgcn_cvt_scalef32_pk_f32_fp4(w0, 1.0f, 0);
                const unsigned w1 = __builtin_amdgcn_cvt_scalef32_pk_fp4_f32(0u, (m - d0.x) * 4.0f, 0.f, 1.0f, 0);
                pk = (w0 & 15u) | ((w1 & 15u) << 4) | ((eb - 1u) << 8);
            }
            actl[t * 128 + ei] = (unsigned short)pk; }
    }
    LDS_WAIT();
    int lane_u = lane; asm volatile("" : "+v"(lane_u));
    const float* nf = a.in[16];
    const int ui = lane_u & 31, ug = lane_u >> 5, ush = 4 * (ui & 7);
    const unsigned uk0 = (ui >> 3) == 0 ? 0xffffffffu : 0u, uk1 = (ui >> 3) == 1 ? 0xffffffffu : 0u, uk2 = (ui >> 3) == 2 ? 0xffffffffu : 0u, uk3 = (ui >> 3) == 3 ? 0xffffffffu : 0u;
#ifndef P6_DIGITS
#define P6_DIGITS 2
#endif
#define MFMA32S(a_, b_, c_, sa_) __builtin_amdgcn_mfma_scale_f32_32x32x64_f8f6f4(a_, b_, c_, 4, 4, 0, sa_, 0, 127)
#ifndef P6_UPROBE
#define P6_UPROBE 0
#endif
#define P6_ULOAD(BQ, sq_) do { const int t_ = (sq_) >> 3, qs_ = (sq_) & 7; \
        if (!((P6_UPROBE & 1) && PARTS == 2 && EMASK != 0xffff)) \
        _Pragma("unroll") for (int q = 0; q < 8; ++q) { const int e_ = idl[t_ * 128 + 2 * (8 * qs_ + q) + ug] & EMASK; \
            BQ[q] = *(const GAS u32x4*)(WU + (size_t)e_ * 512 + 16 * ui); } } while (0)
#define P6_UMMA(BQ, sq_) do { const int t_ = (sq_) >> 3, qs_ = (sq_) & 7; \
        _Pragma("unroll") for (int q = 0; q < 8; ++q) { \
            const unsigned av_ = actl[t_ * 128 + 2 * (8 * qs_ + q) + ug]; \
            const unsigned w0_ = (av_ & 15u) << ush, w1_ = ((av_ >> 4) & 15u) << ush; const int s0_ = (int)(av_ >> 8), s1_ = s0_ - 2; \
            const u32x4 bb = BQ[q]; const v8i_t B_ = (v8i_t){(int)bb.x, (int)bb.y, (int)bb.z, (int)bb.w, 0, 0, 0, 0}; \
            if ((P6_UPROBE & 2) && PARTS == 2) { asm volatile("" :: "v"(w0_ & uk0), "v"(w0_ & uk1), "v"(w0_ & uk2), "v"(w0_ & uk3), "v"(w1_ & uk0), "v"(w1_ & uk1), "v"(w1_ & uk2), "v"(w1_ & uk3), "v"(bb), "v"(s0_), "v"(s1_)); continue; } \
            uacc = MFMA32S(((v8i_t){(int)(w0_ & uk0), (int)(w0_ & uk1), (int)(w0_ & uk2), (int)(w0_ & uk3), 0, 0, 0, 0}), B_, uacc, s0_); \
            if (P6_DIGITS == 2) uacc = MFMA32S(((v8i_t){(int)(w1_ & uk0), (int)(w1_ & uk1), (int)(w1_ & uk2), (int)(w1_ & uk3), 0, 0, 0, 0}), B_, uacc, s1_); } } while (0)
    f32x4 gvu[4];
#pragma unroll
    for (int gq = 0; gq < 4; ++gq) gvu[gq] = *(const GAS f32x4*)(nf + 32 * ui + 4 * ug + 8 * gq);
    u32x2 xqn[4];
#define P6_UXPREF(t_) do { const bf16_t* xrow_ = (const bf16_t*)(ws + WS_X1B) + (size_t)(tok0 + (t_)) * DM + 32 * ui + 4 * ug; \
        _Pragma("unroll") for (int gq = 0; gq < 4; ++gq) xqn[gq] = *(const GAS u32x2*)(xrow_ + 8 * gq); } while (0)
#define P6_UEPI(sq_) do { const int t_ = (sq_) >> 3; \
        f32x4 x2[4]; float ss = 0.f; \
        _Pragma("unroll") for (int gq = 0; gq < 4; ++gq) { \
            const u32x2 xq_ = xqn[gq]; \
            x2[gq] = (f32x4){__uint_as_float(xq_.x << 16), __uint_as_float(xq_.x & 0xffff0000u), __uint_as_float(xq_.y << 16), __uint_as_float(xq_.y & 0xffff0000u)} \
                + (f32x4){uacc[4 * gq], uacc[4 * gq + 1], uacc[4 * gq + 2], uacc[4 * gq + 3]} * (1.0f / P6_SU4); \
            ss += (x2[gq].x * x2[gq].x + x2[gq].y * x2[gq].y) + (x2[gq].z * x2[gq].z + x2[gq].w * x2[gq].w); } \
        const float rn = 1.0f / sqrtf(wave_sum(ss) * (1.0f / DM) + EPSF);     \
          \
        _Pragma("unroll") for (int gq = 0; gq < 4; ++gq) *(LAS f32x4*)(wl + ui * 144 + 32 * gq + 16 * ug) = x2[gq] * rn * gvu[gq]; \
        _Pragma("unroll") for (int k = 0; k < 4; ++k) { const int d_ = 4 * lane_u + 256 * k; const f32x4 ov_ = *(const LAS f32x4*)(wl + (d_ >> 5) * 144 + (d_ & 31) * 4); \
            if ((P6_UPROBE & 8) && PARTS == 2) asm volatile("" :: "v"(ov_)); else *(GAS f32x4*)(a.out + (size_t)(tok0 + t_) * DM + d_) = ov_; } \
        uacc = f32x16{}; } while (0)
    if (PARTS & 2) {
        u32x4 bqA[8], bqB[8]; f32x16 uacc = f32x16{};
        if ((P6_UPROBE & 1) && PARTS == 2 && EMASK != 0xffff) {
#pragma unroll
            for (int q = 0; q < 8; ++q) { bqA[q] = (u32x4){(unsigned)lane, 1u, 2u, 3u}; bqB[q] = bqA[q]; } }
        P6_ULOAD(bqA, 0);
#pragma unroll 1
        for (int sq = 0; sq < 128; sq += 2) {
            if ((sq & 7) == 0) P6_UXPREF(sq >> 3);
            P6_ULOAD(bqB, sq + 1);
            P6_UMMA(bqA, sq);
            P6_ULOAD(bqA, (sq + 2 < 128 ? sq + 2 : sq));
            P6_UMMA(bqB, sq + 1);
            if (((sq + 1) & 7) == 7) { if ((P6_UPROBE & 4) && PARTS == 2) { asm volatile("" : "+v"(uacc)); uacc = f32x16{}; } else P6_UEPI(sq + 1); }
        }
    }
#undef P6_ULOAD
#undef P6_UMMA
#undef P6_UEPI
#undef P6_UXPREF
#undef MFMA32S
}

#ifndef MK_N_LAUNCHES
#define MK_N_LAUNCHES 1
#endif
constexpr int NPHASE = 7;

__device__ __forceinline__ int queue_next(unsigned* ctr, volatile LAS unsigned* slot) {
    __syncthreads();
    if (threadIdx.x == 0) *slot = __hip_atomic_fetch_add(ctr, 1u, __ATOMIC_RELAXED, __HIP_MEMORY_SCOPE_AGENT);
    __syncthreads();
    return (int)*slot;
}

__global__ void __launch_bounds__(NTHR, 2) hymba_fwd(Args a) {
    extern __shared__ __attribute__((aligned(16))) unsigned char lds_raw[];
    lds_u8* lds = (lds_u8*)lds_raw;
    volatile LAS unsigned* MISC = (volatile LAS unsigned*)(lds + MISC_OFF);
    const int tid = threadIdx.x, lane = tid & 63; const int wave = __builtin_amdgcn_readfirstlane(tid >> 6);
    const int G = gridDim.x; const int bx = blockIdx.x;
    const int vcu = (G % 8 == 0) ? (bx % 8) * (G / 8) + bx / 8 : bx;
    const int gw = vcu * NWAVES + wave, NGW = G * NWAVES;
    for (int u = tid; u < (LDS_BYTES - MISC_OFF) / 4; u += NTHR) MISC[u] = 0u;
    __syncthreads();
    const int lo = a.ph_lo, hi = a.ph_hi;
    const bool use_bar = (hi - lo) > 1;
    XcdBarrier bar; bar.bar = (unsigned*)(a.ws + WS_CTL); bar.x = 0; bar.st = MISC + 8;
    if (use_bar) bar = xcd_barrier_post((unsigned*)(a.ws + WS_CTL), MISC + 8);
#ifndef PH_MASK
#define PH_MASK 127
#endif
#define IN(k) (((PH_MASK >> (k)) & 1) && lo <= (k) && (k) < hi)
#ifdef DBL_BAR
#define SEAM(k) do { if (IN(k) && IN((k) + 1)) { xcd_barrier(bar); xcd_barrier(bar); } } while (0)
#else
#define SEAM(k) do { if (IN(k) && IN((k) + 1)) xcd_barrier(bar); } while (0)
#endif
    unsigned char* ws = a.ws;

    if (IN(0)) { p0_prologue(a, lds, gw, NGW, lane, wave);
#ifdef DBL_P0
        __syncthreads(); p0_prologue(a, lds, gw, NGW, lane, wave);
#endif
    }
    SEAM(0);
    if (IN(1)) {
        pg8::Gemm g{(const bf16_t*)(ws + WS_XB), (const bf16_t*)(ws + WS_WIN), MTOK, NIN, DM}; pg8::StaticOrder S; S.init(MTOK, NIN, G, bx);
        EpiProj E{(bf16_t*)(ws + WS_PROJ), (const float*)(ws + WS_R1), (const f32x4*)(ws + WS_ROPE), (const float*)(ws + WS_DECAY)};
        pg8::gemm_phase<EpiProj, pg8::StaticOrder>(lds, g, S, E);
#ifdef DBL_P1
        pg8::gemm_phase<EpiProj, pg8::StaticOrder>(lds, g, S, E);
#endif
    }
    SEAM(1);
    if (IN(2)) {
#ifdef DBL_P2
        for (int rep = 0; rep < 2; ++rep) {
        unsigned* ctr = (unsigned*)(ws + WS_CTL + CTL_Q_ATT + rep * 256);
#else
        {
        unsigned* ctr = (unsigned*)(ws + WS_CTL + CTL_Q_ATT);
#endif
        for (;;) {
            int u = queue_next(ctr, MISC + 16);
            if (u >= 64 + 1024 + DEF_ITEMS / 5) break;
            static_assert(DEF_ITEMS % 5 == 0 && DEF_ITEMS / 5 == 1024 / 4, "P2 ticket pattern");
            if (u >= 64) { const int i5 = (u - 64) / 5, r5 = (u - 64) % 5;
                if (r5 == 4) {
#ifdef PROBE_P2
                    if (rep == 0 && !(PROBE_P2 & 4)) continue;
#endif
                    for (int k = 0; k < 5; ++k) p0_deferred(a, lds, i5 * 5 + k);
                    continue; }
                u = 64 + i5 * 4 + r5; }
#ifdef PROBE_P2
            if (rep == 0) { if (u < 64) { if (PROBE_P2 & 1) ret_unit(a, lds, u >> 3, u & 7); } else if (PROBE_P2 & 2) { const int v = u - 64;
#ifdef PROBE_ATT2
                if (wave >= 4) attn_unit<PROBE_ATT2>(a, lds, (v & 31) >> 2, v & 3, 31 - (v >> 5)); else
#endif
                attn_unit<PROBE_ATT>(a, lds, (v & 31) >> 2, v & 3, 31 - (v >> 5)); } continue; }
#endif
            if (u < 64) ret_unit(a, lds, u >> 3, u & 7);
            else { const int v = u - 64; attn_unit<7>(a, lds, (v & 31) >> 2, v & 3, 31 - (v >> 5)); }
        }
        }
    }
    SEAM(2);
    if (IN(3)) {
        pg8::Gemm g{(const bf16_t*)(ws + WS_MIX), (const bf16_t*)(ws + WS_WOUT), MTOK, DM, DM}; pg8::StaticOrder S; S.init(MTOK, DM, G, bx);
        EpiX1 E{(const bf16_t*)(ws + WS_XB), (bf16_t*)(ws + WS_X1B), (bf16_t*)(ws + WS_SSQ)};
        pg8::gemm_phase<EpiX1, pg8::StaticOrder>(lds, g, S, E);
#ifdef DBL_P3
        pg8::gemm_phase<EpiX1, pg8::StaticOrder>(lds, g, S, E);
#endif
    }
    SEAM(3);
    if (IN(4)) {
        pg8::Gemm g{(const bf16_t*)(ws + WS_X1B), (const bf16_t*)(ws + WS_WPQ), MTOK, NQ, DM}; pg8::StaticOrder S; S.init(MTOK, NQ, G, bx);
        EpiQ E{(bf16_t*)(ws + WS_PROJ), (const bf16_t*)(ws + WS_SSQ)};
        pg8::gemm_phase<EpiQ, pg8::StaticOrder>(lds, g, S, E);
#ifdef DBL_P4
        pg8::gemm_phase<EpiQ, pg8::StaticOrder>(lds, g, S, E);
#endif
    }
    SEAM(4);
    if (IN(5)) { p5_topk(a, lds);
#ifdef DBL_P5
        p5_topk(a, lds);
#endif
    }
    SEAM(5);
    if (IN(6)) {
#ifdef P6_TOKEN_MAJOR
        lds_u8* wl = lds + wave * P6_WSCR;
        for (int tok = gw; tok < MTOK; tok += NGW) p6_token(a, wl, tok, lane, a.out);
#else
#ifdef PROBE_EMASK
        for (int tb = gw; tb < MTOK / 16; tb += NGW) p6_slices<PROBE_EMASK, PROBE_PARTS>(a, lds + wave * P6S_WAVE, tb * 16, lane);
#endif
        for (int tb = gw; tb < MTOK / 16; tb += NGW) p6_slices<0xffff, 3>(a, lds + wave * P6S_WAVE, tb * 16, lane);
#endif
    }
#ifdef DBG_DUMP
    if (hi - lo > 1) xcd_barrier(bar);
    {
        for (int m = gw; m < MTOK; m += NGW) {
            for (int c = lane; c < DM; c += 64) {
                float v = 0.f;
#if DBG_DUMP == 1
                v = bf2f(((const bf16_t*)(ws + WS_PROJ))[(size_t)m * NIN + DBG_COL + c]);
#elif DBG_DUMP == 2
                v = (c >= DBG_C0 && c < DBG_C1) ? bf2f(((const bf16_t*)(ws + WS_MIX))[(size_t)m * DM + c]) : 0.f;
#endif
                a.out[(size_t)m * DM + c] = v;
            }
        }
    }
#endif
#undef IN
#undef SEAM
}

extern "C" void kernel_launch(void* const* d_in, const int* in_sizes, int n_in, void* d_out, int out_size, void* d_ws, size_t ws_size, hipStream_t stream) {
    static int grid = 0;
    if (grid == 0) {
        if (n_in != 17 || in_sizes[0] != MTOK * DM || out_size != MTOK * DM || ws_size < WS_END) {
            fprintf(stderr, "kernel_launch: unexpected shapes (n_in %d, in0 %d, out %d, ws %zu < %zu); nothing launched\n", n_in, n_in > 0 ? in_sizes[0] : -1, out_size, ws_size, (size_t)WS_END); grid = -1; return; }
        int dev = 0, cus = 0, per_cu = 0;
        if (hipGetDevice(&dev) != hipSuccess || hipDeviceGetAttribute(&cus, hipDeviceAttributeMultiprocessorCount, dev) != hipSuccess) { fprintf(stderr, "kernel_launch: device query failed\n"); grid = -1; return; }
        if (hipFuncSetAttribute((const void*)hymba_fwd, hipFuncAttributeMaxDynamicSharedMemorySize, LDS_BYTES) != hipSuccess) { fprintf(stderr, "kernel_launch: hipFuncSetAttribute failed\n"); grid = -1; return; }
        if (hipOccupancyMaxActiveBlocksPerMultiprocessor(&per_cu, (const void*)hymba_fwd, NTHR, LDS_BYTES) != hipSuccess || per_cu < 1)
            fprintf(stderr, "kernel_launch: note: occupancy query reports %d workgroups per CU\n", per_cu);
        (void)hipGetLastError();
        grid = cus;
    }
    if (grid < 0) return;
    if (hipMemsetAsync((char*)d_ws + WS_CTL, 0, CTL_BYTES, stream) != hipSuccess) { fprintf(stderr, "kernel_launch: memset failed\n"); return; }
    Args a{};
    for (int i = 0; i < 17; ++i) a.in[i] = (const float*)d_in[i];
    a.out = (float*)d_out; a.ws = (unsigned char*)d_ws;
#if MK_N_LAUNCHES == 1
#ifdef DBG_STOP
    a.ph_lo = 0; a.ph_hi = DBG_STOP + 1;
#else
    a.ph_lo = 0; a.ph_hi = NPHASE;
#endif
    hipLaunchKernelGGL(hymba_fwd, dim3(grid), dim3(NTHR), LDS_BYTES, stream, a);
#else
    for (int p = 0; p < NPHASE; ++p) { a.ph_lo = p; a.ph_hi = p + 1; hipLaunchKernelGGL(hymba_fwd, dim3(grid), dim3(NTHR), LDS_BYTES, stream, a); }
#endif
    const hipError_t le = hipPeekAtLastError();
    if (le != hipSuccess) fprintf(stderr, "kernel_launch: launch failed: %s\n", hipGetErrorName(le));
}
```

```cpp
#include <hip/hip_runtime.h>
#include <cstdio>
#include <cstdint>

namespace pg8 {
#define PG8_LAS __attribute__((address_space(3)))
typedef unsigned short bf16_t;
typedef short bf16x8 __attribute__((ext_vector_type(8)));
typedef float f32x4 __attribute__((ext_vector_type(4)));
typedef unsigned u32x4 __attribute__((ext_vector_type(4)));
constexpr int BM = 256, BK = 64, HALF = 128, HTB = HALF * BK * 2  , STAGE_BYTES = 8 * HTB, NXCD = 8, WGM = 8;

__host__ __device__ __forceinline__ int lds_byte(int r, int c) { const int st = (r >> 4) * 2 + (c >> 5), rr = r & 15, cc = c & 31, ob = rr * 64 + cc * 2; return st * 1024 + (ob ^ (((ob >> 9) & 1) << 5)); }
__host__ __device__ __forceinline__ void stage_rc(int b, int& R, int& C) { const int st = b / 1024, sb = b % 1024, swz = sb ^ (((sb >> 9) & 1) << 5); R = (st >> 1) * 16 + swz / 64; C = (st & 1) * 32 + (swz % 64) / 2; }
__host__ __device__ __forceinline__ int perm32(int rho) { const int n = rho >> 4, i = rho & 15; return 8 * (i >> 2) + 4 * n + (i & 3); }

struct Unit { int pm, pn; };
struct Gemm { const bf16_t* A; const bf16_t* Bt; int M, N, K; };

struct StaticOrder {
    int nM, nN, nwg, G, c;
    __host__ __device__ void init(int M, int N, int G_, int c_) { nM = M / BM; nN = N / BM; nwg = nM * nN; G = G_; c = c_; }
    __host__ __device__ bool next(int i, Unit& u) const {
        const long L = (long)i * G + c; if (L >= nwg) return false;
        int wgid = (int)L; { const int q = nwg / NXCD, r = nwg % NXCD, xcd = wgid % NXCD, off = wgid / NXCD; wgid = (xcd < r ? xcd * (q + 1) : r * (q + 1) + (xcd - r) * q) + off; }
        const int nig = WGM * nN, gid = wgid / nig, fm = gid * WGM, gsz = (nM - fm) < WGM ? (nM - fm) : WGM;
        u.pm = fm + ((wgid % nig) % gsz); u.pn = (wgid % nig) / gsz; return true;
    }
    __device__ __forceinline__ void a_ready(const Unit&) const {}
    __device__ __forceinline__ void done(const Unit&) const {}
};
__device__ __forceinline__ unsigned cvt_pk_bf16(float lo, float hi) { unsigned r; asm volatile("v_cvt_pk_bf16_f32 %0, %1, %2" : "=v"(r) : "v"(lo), "v"(hi)); return r; }
template <class Epi, class Sched>
__device__ __forceinline__ void gemm_phase(PG8_LAS unsigned char* lds, const Gemm g, const Sched& S, const Epi& E) {
    const int tid = threadIdx.x, wid = __builtin_amdgcn_readfirstlane(tid >> 6), lane = tid & 63, wr = wid >> 2, wc = wid & 3, fr = lane & 15, fq = lane >> 4;
    const int K = g.K, nt = K / BK;
    unsigned voffA[2], voffB[2];
#pragma unroll
    for (int i = 0; i < 2; ++i) { int R, C; stage_rc(tid * 16 + i * 8192, R, C); const int Rb = Epi::PERM ? ((R & ~31) + perm32(R & 31)) : R;
        voffA[i] = (unsigned)(R * K + C) * 2u; voffB[i] = (unsigned)(Rb * K + C) * 2u; }
    const size_t kstep = (size_t)(BK * 2);
    const size_t hstep = (size_t)HALF * K * 2;
    const size_t tstep = 2 * hstep;
    const unsigned ldsw = (unsigned)wid * 1024u;
    const int aoff = lds_byte(wr * 64 + fr, fq * 8), boff = lds_byte(wc * 32 + fr, fq * 8);
#define PG8_SA(b, h) (((b) * 2 + (h)) * HTB)
#define PG8_SB(b, h) ((4 + (b) * 2 + (h)) * HTB)
#define PG8_STAGE(bufoff, gbase, voff) do { _Pragma("unroll") for (int _i = 0; _i < 2; ++_i) \
        __builtin_amdgcn_global_load_lds((const unsigned*)((const char*)(gbase) + (voff)[_i]), (PG8_LAS unsigned*)(lds + (bufoff) + ldsw + _i * 8192), 16, 0, 0); } while (0)
#define PG8_LDA(dst, b, h) do { _Pragma("unroll") for (int m = 0; m < 4; ++m) _Pragma("unroll") for (int k = 0; k < 2; ++k) dst[m][k] = *(const PG8_LAS bf16x8*)(lds + PG8_SA(b, h) + aoff + m * 2048 + k * 1024); } while (0)
#define PG8_LDB(dst, b, h) do { _Pragma("unroll") for (int n = 0; n < 2; ++n) _Pragma("unroll") for (int k = 0; k < 2; ++k) dst[n][k] = *(const PG8_LAS bf16x8*)(lds + PG8_SB(b, h) + boff + n * 2048 + k * 1024); } while (0)
#define PG8_MMA(ai, bj, At, Bt) do { __builtin_amdgcn_s_setprio(1); _Pragma("unroll") for (int m = 0; m < 4; ++m) _Pragma("unroll") for (int n = 0; n < 2; ++n) _Pragma("unroll") for (int k = 0; k < 2; ++k) \
        acc[ai][bj][m][n] = __builtin_amdgcn_mfma_f32_16x16x32_bf16(Bt[n][k], At[m][k], acc[ai][bj][m][n], 0, 0, 0); __builtin_amdgcn_s_setprio(0); } while (0)
#define PG8_WAIT_V(n) asm volatile("s_waitcnt vmcnt(" #n ")" ::: "memory")
#define PG8_WAIT_L(n) asm volatile("s_waitcnt lgkmcnt(" #n ")" ::: "memory")
#define PG8_BAR __builtin_amdgcn_s_barrier()
#define PG8_SCHED __builtin_amdgcn_sched_barrier(0)
    Unit cur, nxt; int ui = 0;
    if (!S.next(0, cur)) return;
    f32x4 acc[2][2][4][2];
#pragma unroll
    for (int a = 0; a < 2; ++a)
#pragma unroll
        for (int b = 0; b < 2; ++b)
#pragma unroll
            for (int m = 0; m < 4; ++m)
#pragma unroll
                for (int n = 0; n < 2; ++n) acc[a][b][m][n] = (f32x4){0.f, 0.f, 0.f, 0.f};
    bf16x8 At[4][2], B0[2][2], B1[2][2];
    const char* cA = (const char*)g.A + (size_t)cur.pm * tstep; const char* cB = (const char*)g.Bt + (size_t)cur.pn * tstep;
    S.a_ready(cur);
    PG8_STAGE(PG8_SB(0, 0), cB, voffB); PG8_STAGE(PG8_SA(0, 0), cA, voffA); PG8_STAGE(PG8_SB(0, 1), cB + hstep, voffB); PG8_STAGE(PG8_SA(0, 1), cA + hstep, voffA);
    if (wr == 1) PG8_BAR;
    PG8_WAIT_V(4); PG8_BAR;
    PG8_STAGE(PG8_SB(1, 0), cB + kstep, voffB); PG8_STAGE(PG8_SA(1, 0), cA + kstep, voffA); PG8_STAGE(PG8_SB(1, 1), cB + hstep + kstep, voffB);
    PG8_WAIT_V(6); PG8_BAR;
    for (;;) {
        const bool has_next = S.next(ui + 1, nxt);
        const char* nA = has_next ? (const char*)g.A + (size_t)nxt.pm * tstep : cA; const char* nB = has_next ? (const char*)g.Bt + (size_t)nxt.pn * tstep : cB;
        for (int t = 0; t < nt; t += 2) {
            const bool last = (t == nt - 2);
            const char* a1 = cA + (size_t)(t + 1) * kstep;
            const char* a2 = last ? nA : cA + (size_t)(t + 2) * kstep; const char* b2 = last ? nB : cB + (size_t)(t + 2) * kstep;
            const char* a3 = a2 + kstep; const char* b3 = b2 + kstep;
            if (last && has_next) S.a_ready(nxt);
            PG8_LDB(B0, 0, 0); PG8_SCHED; PG8_LDA(At, 0, 0); PG8_STAGE(PG8_SA(1, 1), a1 + hstep, voffA);
            PG8_WAIT_L(8); PG8_BAR; PG8_WAIT_L(0); PG8_MMA(0, 0, At, B0); PG8_BAR; PG8_SCHED;
            PG8_LDB(B1, 0, 1); PG8_STAGE(PG8_SB(0, 0), b2, voffB);
            PG8_BAR; PG8_WAIT_L(0); PG8_MMA(0, 1, At, B1); PG8_BAR;
            PG8_LDA(At, 0, 1); PG8_STAGE(PG8_SA(0, 0), a2, voffA);
            PG8_BAR; PG8_WAIT_L(0); PG8_MMA(1, 0, At, B0); PG8_BAR; PG8_SCHED;
            PG8_STAGE(PG8_SB(0, 1), b2 + hstep, voffB);
            PG8_WAIT_V(6); PG8_BAR; PG8_MMA(1, 1, At, B1); PG8_BAR;
            PG8_LDB(B0, 1, 0); PG8_SCHED; PG8_LDA(At, 1, 0); PG8_STAGE(PG8_SA(0, 1), a2 + hstep, voffA);
            PG8_WAIT_L(8); PG8_BAR; PG8_WAIT_L(0); PG8_MMA(0, 0, At, B0); PG8_BAR; PG8_SCHED;
            PG8_LDB(B1, 1, 1); PG8_STAGE(PG8_SB(1, 0), b3, voffB);
            PG8_BAR; PG8_WAIT_L(0); PG8_MMA(0, 1, At, B1); PG8_BAR;
            PG8_LDA(At, 1, 1); PG8_STAGE(PG8_SA(1, 0), a3, voffA);
            PG8_BAR; PG8_WAIT_L(0); PG8_MMA(1, 0, At, B0); PG8_BAR; PG8_SCHED;
            PG8_STAGE(PG8_SB(1, 1), b3 + hstep, voffB);
            PG8_WAIT_V(6); PG8_BAR; PG8_MMA(1, 1, At, B1); PG8_BAR;
        }
        if constexpr (!Epi::AFTER_DRAIN) { E(acc, cur, wr, wc, fr, fq); S.done(cur); }
        if (!has_next) break;
#pragma unroll
        for (int a = 0; a < 2; ++a)
#pragma unroll
            for (int b = 0; b < 2; ++b)
#pragma unroll
                for (int m = 0; m < 4; ++m)
#pragma unroll
                    for (int n = 0; n < 2; ++n) acc[a][b][m][n] = (f32x4){0.f, 0.f, 0.f, 0.f};
        cur = nxt; cA = nA; cB = nB; ++ui;
    }
    PG8_WAIT_V(0);
    if (wr == 0) PG8_BAR;
    PG8_BAR;
    if constexpr (Epi::AFTER_DRAIN) { E.fused(acc, cur, wr, wc, fr, fq, lds, wid, lane); S.done(cur); }
#undef PG8_SA
#undef PG8_SB
#undef PG8_STAGE
#undef PG8_LDA
#undef PG8_LDB
#undef PG8_MMA
#undef PG8_WAIT_V
#undef PG8_WAIT_L
#undef PG8_BAR
#undef PG8_SCHED
}
}

#define XB_TMO      128
#define XB_XCNT(j)  (256  + 64 * (j))
#define XB_XSUB(j)  (1280 + 64 * (j))
#define XB_XGEN(j)  (2304 + 64 * (j))
#define XB_TOP      3328
#define XB_TOPGEN   3392
#define XCD_BAR_WORDS 3456
#define XB_SPIN_CAP (1u << 18)
#define LAS __attribute__((address_space(3)))

__device__ __forceinline__ unsigned xb_ld(unsigned* p)              { return __hip_atomic_load(p, __ATOMIC_RELAXED, __HIP_MEMORY_SCOPE_AGENT); }
__device__ __forceinline__ unsigned xb_add(unsigned* p, unsigned v) { return __hip_atomic_fetch_add(p, v, __ATOMIC_RELAXED, __HIP_MEMORY_SCOPE_AGENT); }
__device__ __forceinline__ unsigned xb_xcc_id() { return (unsigned)__builtin_amdgcn_s_getreg((3 << 11) | 20) & 0xFu; }
#define XB_SPIN(cond, bar) do { unsigned _sp = 0; while (cond) { __builtin_amdgcn_s_sleep(1); \
    if ((++_sp & 255u) == 0u) { if (xb_ld(&(bar)[XB_TMO])) break; if (_sp > XB_SPIN_CAP) { atomicAdd(&(bar)[XB_TMO], 1u); break; } } } } while (0)

struct XcdBarrier {
    unsigned* bar; unsigned x;
    volatile LAS unsigned* st;
};

__device__ __forceinline__ XcdBarrier xcd_barrier_post(unsigned* bar, volatile LAS unsigned* st) {
    XcdBarrier b; b.bar = bar; b.x = xb_xcc_id(); b.st = st;
    if (threadIdx.x == 0) (void)xb_add(&bar[XB_XCNT(b.x)], 1u);
    return b;
}
__device__ __forceinline__ void xcd_barrier_complete(unsigned* bar, unsigned x, unsigned& nloc, unsigned& nx) {
    const unsigned G = gridDim.x * gridDim.y * gridDim.z;
    unsigned sum, cnt, mine, sp = 0u;
    for (;;) {
        sum = 0u; cnt = 0u; mine = 0u;
#pragma unroll
        for (unsigned j = 0; j < 16; ++j) { const unsigned c = xb_ld(&bar[XB_XCNT(j)]); sum += c; cnt += (c > 0u) ? 1u : 0u; mine = (j == x) ? c : mine; }
        if (sum == G) break;
        __builtin_amdgcn_s_sleep(1);
        if ((++sp & 255u) == 0u) { if (xb_ld(&bar[XB_TMO])) break; if (sp > XB_SPIN_CAP) { atomicAdd(&bar[XB_TMO], 1u); break; } }
    }
    nloc = mine > 0u ? mine : 1u; nx = cnt > 0u ? cnt : 1u;
}

__device__ __forceinline__ void xcd_barrier(const XcdBarrier& b) {
    asm volatile("s_waitcnt vmcnt(0)" ::: "memory");
    __syncthreads();
    if (threadIdx.x == 0) {
        unsigned* bar = b.bar;
        __builtin_amdgcn_s_waitcnt(0);
        unsigned nloc = b.st[0], nx = b.st[1];
        if (nloc == 0u) { xcd_barrier_complete(bar, b.x, nloc, nx); b.st[0] = nloc; b.st[1] = nx; }
        const unsigned old = xb_add(&bar[XB_XSUB(b.x)], 1u);
        const unsigned gen = old / nloc;
        if (old + 1u == (gen + 1u) * nloc) {
            __builtin_amdgcn_fence(__ATOMIC_RELEASE, "agent");
            asm volatile("s_waitcnt vmcnt(0)" ::: "memory");
            const unsigned og = xb_add(&bar[XB_TOP], 1u);
            const unsigned tg = og / nx;
            if (og + 1u == (tg + 1u) * nx) xb_add(&bar[XB_TOPGEN], 1u);
            else XB_SPIN(xb_ld(&bar[XB_TOPGEN]) == tg, bar);
            __builtin_amdgcn_fence(__ATOMIC_ACQUIRE, "agent");
            xb_add(&bar[XB_XGEN(b.x)], 1u);
            asm volatile("s_waitcnt vmcnt(0)" ::: "memory");
        } else {
            XB_SPIN(xb_ld(&bar[XB_XGEN(b.x)]) == gen, bar);
            __builtin_amdgcn_fence(__ATOMIC_ACQUIRE, "agent");
            asm volatile("s_waitcnt vmcnt(0)" ::: "memory");
        }
    }
    __syncthreads();
}

#define GAS __attribute__((address_space(1)))
typedef unsigned short bf16_t;
typedef short bf16x8 __attribute__((ext_vector_type(8)));
typedef short s16x4 __attribute__((ext_vector_type(4)));
typedef float f32x4 __attribute__((ext_vector_type(4)));
typedef float f32x2 __attribute__((ext_vector_type(2)));
typedef float f32x16 __attribute__((ext_vector_type(16)));
typedef unsigned u32x4 __attribute__((ext_vector_type(4)));
typedef unsigned u32x2 __attribute__((ext_vector_type(2)));
typedef LAS unsigned char lds_u8;

constexpr int MTOK = 32768, DM = 1024, SEQ = 4096, NBATCH = 8, NIN = 3584;
constexpr int OFF_RQ = 0, OFF_RK = 512, OFF_RV = 1024, OFF_RG = 1536, OFF_DQ = 2048, OFF_DK = 2560, OFF_DV = 3072;
constexpr int NEXP = 16384, NQ = 2048;
constexpr float EPSF = 1e-6f, LOG2E = 1.4426950408889634f;
constexpr int NWAVES = 8, NTHR = 512;

constexpr size_t WS_CTL = 0, CTL_BYTES = 65536;
constexpr size_t CTL_Q_ATT = 16384, CTL_Q_P6 = 16384 + 1024;
constexpr size_t WS_R1 = WS_CTL + CTL_BYTES;
constexpr size_t WS_SSQ = WS_R1 + (size_t)MTOK * 4;
constexpr size_t WS_ROPE = WS_SSQ + (size_t)MTOK * 16 * 4;
constexpr size_t WS_DECAY = WS_ROPE + (size_t)SEQ * 32 * 8;
constexpr size_t WS_BTAB = WS_DECAY + 2 * 8 * 128 * 4;
constexpr size_t WS_LAM = WS_BTAB + 4 * 128 * 4;
constexpr size_t WS_WIN = 4u << 20;
constexpr size_t WS_WOUT = WS_WIN + (size_t)NIN * DM * 2;
constexpr size_t WS_WPQ = WS_WOUT + (size_t)DM * DM * 2;
constexpr size_t WS_KEYS = WS_WPQ + (size_t)NQ * DM * 2;
constexpr size_t WS_WD = WS_KEYS + (size_t)8 * 2 * 128 * 128 * 2;
constexpr size_t WS_WU = WS_WD + (size_t)NEXP * DM * 2;
constexpr size_t WS_XB = WS_WU + (size_t)NEXP * DM * 2;
constexpr size_t WS_PROJ = WS_XB + (size_t)MTOK * DM * 2;
constexpr size_t WS_MIX = WS_PROJ + (size_t)MTOK * NIN * 2;
constexpr size_t WS_IDX = WS_MIX, WS_GATE = WS_MIX + (size_t)MTOK * 128 * 4;
constexpr size_t WS_X1B = WS_PROJ + (size_t)MTOK * NQ * 2;
static_assert(WS_X1B + (size_t)MTOK * DM * 2 <= WS_MIX, "ws map");
constexpr size_t WS_END = WS_MIX + (size_t)MTOK * DM * 2;
static_assert(WS_LAM + 256 <= WS_WIN, "ws map");
static_assert(WS_END <= (size_t)512 << 20, "ws map");

constexpr int LDS_SCRATCH = 139264;
constexpr int MISC_OFF = LDS_SCRATCH;
constexpr int LDS_BYTES = 147456;

__device__ __forceinline__ float wave_sum(float v) {
    v += __uint_as_float(__builtin_amdgcn_update_dpp(0u, __float_as_uint(v), 0xB1, 0xf, 0xf, true));
    v += __uint_as_float(__builtin_amdgcn_update_dpp(0u, __float_as_uint(v), 0x4E, 0xf, 0xf, true));
    v += __uint_as_float(__builtin_amdgcn_update_dpp(0u, __float_as_uint(v), 0x141, 0xf, 0xf, true));
    v += __uint_as_float(__builtin_amdgcn_update_dpp(0u, __float_as_uint(v), 0x140, 0xf, 0xf, true));
    { auto rr = __builtin_amdgcn_permlane16_swap(__float_as_uint(v), __float_as_uint(v), false, false); v = __uint_as_float(rr[0]) + __uint_as_float(rr[1]); }
    { auto rr = __builtin_amdgcn_permlane32_swap(__float_as_uint(v), __float_as_uint(v), false, false); v = __uint_as_float(rr[0]) + __uint_as_float(rr[1]); }
    return v;
}
typedef __bf16 bf16v2_t __attribute__((ext_vector_type(2)));
__device__ __forceinline__ unsigned pk2(float lo, float hi) { const bf16v2_t v = {(__bf16)lo, (__bf16)hi}; return __builtin_bit_cast(unsigned, v); }
__device__ __forceinline__ float bf2f(unsigned short b) { return __uint_as_float(((unsigned)b) << 16); }
#define LDS_WAIT() asm volatile("s_waitcnt lgkmcnt(0)" ::: "memory")
#define VM_WAIT() asm volatile("s_waitcnt vmcnt(0)" ::: "memory")

struct Args {
    const float* in[17]; float* out; unsigned char* ws; int ph_lo, ph_hi;
};

template <int MODE>
__device__ __forceinline__ void p0_transpose_item(const float* W, const float* scale, int K, int N, bf16_t* WT, LAS float* scr, int item, int lane) {
    const int nblk = N / 32, kb = item / nblk, nb = item % nblk, k0 = 64 * kb, n0 = 32 * nb;
#pragma unroll 8
    for (int i = 0; i < 32; ++i) { const int kk = 2 * i + (lane >> 5); const float sc = scale ? scale[k0 + kk] : 1.0f; scr[kk * 33 + (lane & 31)] = W[(size_t)(k0 + kk) * N + n0 + (lane & 31)] * sc; }
    LDS_WAIT();
    const int c = lane & 7;
#pragma unroll
    for (int j = 0; j < 4; ++j) { const int n = (lane >> 3) + 8 * j; const LAS float* s = scr + (8 * c) * 33 + n;
        u32x4 o; o.x = pk2(s[0 * 33], s[1 * 33]); o.y = pk2(s[2 * 33], s[3 * 33]); o.z = pk2(s[4 * 33], s[5 * 33]); o.w = pk2(s[6 * 33], s[7 * 33]);
        int nn = n0 + n;
        if (MODE == 1 && nn < 1024) { const int d = nn & 63; nn = (nn & ~63) + ((d < 32) ? 2 * d : 2 * (d - 32) + 1); }
        *(GAS u32x4*)(WT + (size_t)nn * K + k0 + 8 * c) = o; }
    LDS_WAIT();
}

__device__ __forceinline__ int t5_bucket(int n) {
    if (n < 16) return n;
    const float v = logf((float)n / 16.0f) / 2.0794415416798357f * 16.0f;
    int b = 16 + (int)v; return b > 31 ? 31 : b;
}

__device__ __forceinline__ void p0_prologue(const Args& a, lds_u8* lds, int gw, int NGW, int lane, int wave) {
    unsigned char* ws = a.ws;
    const float* x = a.in[0];
    bf16_t* xb = (bf16_t*)(ws + WS_XB); float* r1 = (float*)(ws + WS_R1);
    for (int m0 = gw; m0 < MTOK; m0 += 4 * NGW) {
        f32x4 v[4][4];
#pragma unroll
        for (int r = 0; r < 4; ++r) { const int m = m0 + r * NGW; const GAS f32x4* xr = (const GAS f32x4*)(x + (size_t)(m < MTOK ? m : m0) * DM) + lane;
#pragma unroll
            for (int j = 0; j < 4; ++j) v[r][j] = xr[64 * j]; }
#pragma unroll
        for (int r = 0; r < 4; ++r) { const int m = m0 + r * NGW; if (m >= MTOK) break;
            float s = 0.f;
#pragma unroll
            for (int j = 0; j < 4; ++j) s += (v[r][j].x * v[r][j].x + v[r][j].y * v[r][j].y) + (v[r][j].z * v[r][j].z + v[r][j].w * v[r][j].w);
            s = wave_sum(s);
            GAS u32x2* o8 = (GAS u32x2*)(xb + (size_t)m * DM) + lane;
#pragma unroll
            for (int j = 0; j < 4; ++j) { u32x2 o; o.x = pk2(v[r][j].x, v[r][j].y); o.y = pk2(v[r][j].z, v[r][j].w); o8[64 * j] = o; }
            if (lane == 0) r1[m] = 1.0f / sqrtf(s * (1.0f / DM) + EPSF); }
    }
    {
        LAS float* scr = (LAS float*)(lds + wave * 8704);
        constexpr int I_IN = (DM / 64) * (NIN / 32);
        for (int it = gw; it < I_IN; it += NGW) p0_transpose_item<1>(a.in[2], a.in[1], DM, NIN, (bf16_t*)(ws + WS_WIN), scr, it, lane);
    }
    const int gt = gw * 64 + lane, NGT = NGW * 64;
    {
        f32x2* rope = (f32x2*)(ws + WS_ROPE);
        for (int i = gt; i < SEQ * 32; i += NGT) { const int pos = i >> 5, j = i & 31; const float fr = (float)pow(10000.0, -(double)j / 32.0); const float ang = (float)pos * fr;
            rope[i] = (f32x2){(float)cos((double)ang), (float)sin((double)ang)}; }
        float* dec = (float*)(ws + WS_DECAY);
        for (int i = gt; i < 2 * 8 * 128; i += NGT) { const int l = i & 127, h = (i >> 7) & 7, kk = i >> 10; const double lg = log2(1.0 - exp2(-5.0 - (double)h));
            dec[i] = kk ? (float)(0.125 * exp2(-lg * (double)l)) : (float)exp2(lg * (double)l); }
        float* bt = (float*)(ws + WS_BTAB); const float* rb = a.in[9];
        for (int i = gt; i < 4 * 128; i += NGT) { const int n = i & 127, h = i >> 7; bt[i] = rb[t5_bucket(n) * 4 + h] * LOG2E; }
        if (gt == 0) { float s1 = 0.f, s2 = 0.f; for (int i = 0; i < 64; ++i) { s1 += a.in[4][i] * a.in[5][i]; s2 += a.in[6][i] * a.in[7][i]; }
            ((float*)(ws + WS_LAM))[0] = expf(s1) - expf(s2) + 0.2f; }
    }
}


constexpr int DEF_T0 = 192, DEF_T1 = 64, DEF_T2 = 512, DEF_T3 = 512, DEF_ITEMS = DEF_T0 + DEF_T1 + DEF_T2 + DEF_T3;
__device__ __forceinline__ void p0_deferred(const Args& a, lds_u8* lds, int item) {
    unsigned char* ws = a.ws;
    int tid_ = threadIdx.x; asm volatile("" : "+v"(tid_));
    const int tid = tid_, lane = tid & 63; const int wave = __builtin_amdgcn_readfirstlane(tid >> 6);
    if (item < DEF_T0) {
        LAS float* scr = (LAS float*)(lds + wave * 8704);
        constexpr int I_OUT = (DM / 64) * (DM / 32), I_PQ = (DM / 64) * (NQ / 32);
        static_assert(I_OUT + I_PQ == DEF_T0 * 8, "deferred transposes");
        const int r = item * 8 + wave;
        if (r < I_OUT) p0_transpose_item<0>(a.in[10], nullptr, DM, DM, (bf16_t*)(ws + WS_WOUT), scr, r, lane);
        else p0_transpose_item<0>(a.in[12], a.in[11], DM, NQ, (bf16_t*)(ws + WS_WPQ), scr, r - I_OUT, lane);
        return;
    }
    item -= DEF_T0;
    if (item < DEF_T1) {
        const float* pk = a.in[13]; bf16_t* kb = (bf16_t*)(ws + WS_KEYS);
        const int i = item * 512 + tid;
        const GAS f32x4* s = (const GAS f32x4*)(pk + (size_t)i * 8); const f32x4 p = s[0], q = s[1];
        u32x4 o; o.x = pk2(p.x, p.y); o.y = pk2(p.z, p.w); o.z = pk2(q.x, q.y); o.w = pk2(q.z, q.w); *(GAS u32x4*)(kb + (size_t)i * 8) = o;
        return;
    }
    item -= DEF_T1;
    const float* dn = a.in[14]; const float* up = a.in[15]; const float* gf = a.in[11];
    unsigned char* wd = ws + WS_WD; unsigned char* wu = ws + WS_WU;
    const bool isup = item < DEF_T2; if (!isup) item -= DEF_T2;
    const float* src = (isup ? up : dn) + (size_t)(item * 32 + wave * 4) * DM + lane * 4;
    f32x4 g[4];
#pragma unroll
    for (int k = 0; k < 4; ++k) g[k] = isup ? (f32x4){6.0f, 6.0f, 6.0f, 6.0f} : *(const GAS f32x4*)(gf + k * 256 + lane * 4) * 64.0f;
    f32x4 v[4][4];
#pragma unroll
    for (int r = 0; r < 4; ++r)
#pragma unroll
        for (int k = 0; k < 4; ++k) v[r][k] = *(const GAS f32x4*)(src + (size_t)r * DM + k * 256);
#pragma unroll
    for (int r = 0; r < 4; ++r) {
        const int e = item * 32 + wave * 4 + r;
#pragma unroll
        for (int k = 0; k < 4; ++k) {
            const f32x4 p = v[r][k] * g[k];
            unsigned w = __builtin_amdgcn_cvt_scalef32_pk_fp4_f32(0u, p.x, p.y, 1.0f, 0);
            w = __builtin_amdgcn_cvt_scalef32_pk_fp4_f32(w, p.z, p.w, 1.0f, 1);
            unsigned char* dst = isup ? wu + (size_t)e * 512 + k * 128 + lane * 2 : wd + (size_t)k * ((size_t)NEXP * 128) + (size_t)e * 128 + lane * 2;
            *(GAS unsigned short*)dst = (unsigned short)w;
        }
    }
}

__device__ __forceinline__ f32x4 bf4_lo(u32x4 w) { return (f32x4){__uint_as_float(w.x << 16), __uint_as_float(w.x & 0xffff0000u), __uint_as_float(w.y << 16), __uint_as_float(w.y & 0xffff0000u)}; }
__device__ __forceinline__ f32x4 bf4_hi(u32x4 w) { return (f32x4){__uint_as_float(w.z << 16), __uint_as_float(w.z & 0xffff0000u), __uint_as_float(w.w << 16), __uint_as_float(w.w & 0xffff0000u)}; }
struct EpiProj {
    static constexpr bool PERM = true, AFTER_DRAIN = false;
    bf16_t* P; const float* r1; const f32x4* rope; const float* decay;
    __device__ __forceinline__ void operator()(const f32x4 (&acc)[2][2][4][2], const pg8::Unit& u, int wr, int wc, int fr, int fq) const {
        const int row0 = u.pm * 256 + wr * 64 + fr, seg = u.pn >> 1;
        float rsv[2][4];
#pragma unroll
        for (int ai = 0; ai < 2; ++ai)
#pragma unroll
            for (int m = 0; m < 4; ++m) rsv[ai][m] = *(const GAS float*)(r1 + row0 + ai * 128 + m * 16);
        if (seg <= 1) {
#pragma unroll
            for (int ai = 0; ai < 2; ++ai) {
                f32x4 ra[4][2], rb[4][2]; float ff[4][2];
#pragma unroll
                for (int m = 0; m < 4; ++m)
#pragma unroll
                    for (int bj = 0; bj < 2; ++bj) {
                        const int row = row0 + ai * 128 + m * 16, c0 = u.pn * 256 + bj * 128 + wc * 32 + 8 * fq;
                        const int pos = row & (SEQ - 1), l = row & 127, head = (c0 & 511) >> 6, jb = (c0 & 63) >> 1;
                        const GAS f32x4* rp = (const GAS f32x4*)rope + ((size_t)pos * 32 + jb) / 2; ra[m][bj] = rp[0]; rb[m][bj] = rp[1];
                        ff[m][bj] = *(const GAS float*)(decay + (seg * 8 + head) * 128 + l);
                    }
#pragma unroll
                for (int m = 0; m < 4; ++m)
#pragma unroll
                    for (int bj = 0; bj < 2; ++bj) {
                        const int row = row0 + ai * 128 + m * 16, c0 = u.pn * 256 + bj * 128 + wc * 32 + 8 * fq;
                        const f32x4 v0 = acc[ai][bj][m][0] * rsv[ai][m], v1 = acc[ai][bj][m][1] * rsv[ai][m];
                        const f32x4 a_ = ra[m][bj], b_ = rb[m][bj]; const float f = ff[m][bj];
                        f32x4 w0, w1;
                        w0.x = (v0.x * a_.x - v0.y * a_.y) * f; w0.y = (v0.y * a_.x + v0.x * a_.y) * f;
                        w0.z = (v0.z * a_.z - v0.w * a_.w) * f; w0.w = (v0.w * a_.z + v0.z * a_.w) * f;
                        w1.x = (v1.x * b_.x - v1.y * b_.y) * f; w1.y = (v1.y * b_.x + v1.x * b_.y) * f;
                        w1.z = (v1.z * b_.z - v1.w * b_.w) * f; w1.w = (v1.w * b_.z + v1.z * b_.w) * f;
                        u32x4 w; w.x = pk2(w0.x, w0.y); w.y = pk2(w0.z, w0.w); w.z = pk2(w1.x, w1.y); w.w = pk2(w1.z, w1.w);
                        *(GAS u32x4*)(P + (size_t)row * NIN + c0) = w;
                    }
            }
        } else {
#pragma unroll
            for (int ai = 0; ai < 2; ++ai)
#pragma unroll
                for (int m = 0; m < 4; ++m)
#pragma unroll
                    for (int bj = 0; bj < 2; ++bj) {
                        const int row = row0 + ai * 128 + m * 16, c0 = u.pn * 256 + bj * 128 + wc * 32 + 8 * fq;
                        f32x4 v0 = acc[ai][bj][m][0] * rsv[ai][m], v1 = acc[ai][bj][m][1] * rsv[ai][m];
                        if (seg == 3) {
#pragma unroll
                            for (int j = 0; j < 4; ++j) { v0[j] = v0[j] / (1.0f + __expf(-v0[j])); v1[j] = v1[j] / (1.0f + __expf(-v1[j])); }
                        } else if (seg == 4) { v0 = v0 * (0.125f * LOG2E); v1 = v1 * (0.125f * LOG2E); }
                        u32x4 w; w.x = pk2(v0.x, v0.y); w.y = pk2(v0.z, v0.w); w.z = pk2(v1.x, v1.y); w.w = pk2(v1.z, v1.w);
                        *(GAS u32x4*)(P + (size_t)row * NIN + c0) = w;
                    }
        }
    }
};
struct EpiX1 {
    static constexpr bool PERM = true, AFTER_DRAIN = false;
    const bf16_t* XB; bf16_t* X1B; bf16_t* ssq;
    __device__ __forceinline__ void operator()(const f32x4 (&acc)[2][2][4][2], const pg8::Unit& u, int wr, int wc, int fr, int fq) const {
        const int row0 = u.pm * 256 + wr * 64 + fr, c00 = u.pn * 256 + wc * 32 + 8 * fq;
        u32x4 xin[2][4][2];
#pragma unroll
        for (int ai = 0; ai < 2; ++ai)
#pragma unroll
            for (int m = 0; m < 4; ++m)
#pragma unroll
                for (int bj = 0; bj < 2; ++bj) xin[ai][m][bj] = *(const GAS u32x4*)(XB + (size_t)(row0 + ai * 128 + m * 16) * DM + c00 + bj * 128);
#pragma unroll
        for (int ai = 0; ai < 2; ++ai)
#pragma unroll
            for (int m = 0; m < 4; ++m) {
                const int row = row0 + ai * 128 + m * 16; float ss = 0.f;
#pragma unroll
                for (int bj = 0; bj < 2; ++bj) {
                    const f32x4 o0 = acc[ai][bj][m][0] + bf4_lo(xin[ai][m][bj]), o1 = acc[ai][bj][m][1] + bf4_hi(xin[ai][m][bj]);
                    u32x4 w; w.x = pk2(o0.x, o0.y); w.y = pk2(o0.z, o0.w); w.z = pk2(o1.x, o1.y); w.w = pk2(o1.z, o1.w);
                    *(GAS u32x4*)(X1B + (size_t)row * DM + c00 + bj * 128) = w;
                    ss += ((o0.x * o0.x + o0.y * o0.y) + (o0.z * o0.z + o0.w * o0.w)) + ((o1.x * o1.x + o1.y * o1.y) + (o1.z * o1.z + o1.w * o1.w));
                }
                ss += __shfl_xor(ss, 16); ss += __shfl_xor(ss, 32);
                if (fq == 0) *(GAS bf16_t*)(ssq + (size_t)row * 16 + u.pn * 4 + wc) = (bf16_t)(pk2(ss, 0.f) & 0xffffu);
            }
    }
};
__device__ __forceinline__ float rs2_from(u32x4 a, u32x4 b) {
    const f32x4 p = bf4_lo(a) + bf4_hi(a) + bf4_lo(b) + bf4_hi(b);
    return 1.0f / sqrtf(((p.x + p.y) + (p.z + p.w)) * (1.0f / DM) + EPSF);
}
__device__ __forceinline__ float row_rs2(const bf16_t* ssq, int row) {
    const GAS u32x4* p = (const GAS u32x4*)(ssq + (size_t)row * 16); return rs2_from(p[0], p[1]);
}
struct EpiQ {
    static constexpr bool PERM = true, AFTER_DRAIN = false;
    bf16_t* Q; const bf16_t* ssq;
    __device__ __forceinline__ void operator()(const f32x4 (&acc)[2][2][4][2], const pg8::Unit& u, int wr, int wc, int fr, int fq) const {
        const int row0 = u.pm * 256 + wr * 64 + fr;
        u32x4 sa[2][4], sb[2][4];
#pragma unroll
        for (int ai = 0; ai < 2; ++ai)
#pragma unroll
            for (int m = 0; m < 4; ++m) { const GAS u32x4* p = (const GAS u32x4*)(ssq + (size_t)(row0 + ai * 128 + m * 16) * 16); sa[ai][m] = p[0]; sb[ai][m] = p[1]; }
#pragma unroll
        for (int ai = 0; ai < 2; ++ai)
#pragma unroll
            for (int m = 0; m < 4; ++m) {
                const int row = row0 + ai * 128 + m * 16; const float rs = rs2_from(sa[ai][m], sb[ai][m]);
#pragma unroll
                for (int bj = 0; bj < 2; ++bj) {
                    const int c0 = u.pn * 256 + bj * 128 + wc * 32 + 8 * fq;
                    const f32x4 v0 = acc[ai][bj][m][0] * rs, v1 = acc[ai][bj][m][1] * rs;
                    u32x4 w; w.x = pk2(v0.x, v0.y); w.y = pk2(v0.z, v0.w); w.z = pk2(v1.x, v1.y); w.w = pk2(v1.z, v1.w);
                    *(GAS u32x4*)(Q + (size_t)row * NQ + c0) = w;
                }
            }
    }
};

#define MFMA32(a, b, c) __builtin_amdgcn_mfma_f32_32x32x16_bf16(a, b, c, 0, 0, 0)
typedef short v4i16_t __attribute__((ext_vector_type(4)));
__device__ __forceinline__ s16x4 vtr(const lds_u8* p) { return __builtin_bit_cast(s16x4, __builtin_amdgcn_ds_read_tr16_b64_v4i16((LAS v4i16_t*)p)); }
__device__ __forceinline__ bf16x8 vfrag(const lds_u8* p) { const s16x4 lo = vtr(p), hi = vtr(p + 512); return (bf16x8){lo[0], lo[1], lo[2], lo[3], hi[0], hi[1], hi[2], hi[3]}; }
__device__ __forceinline__ bf16x8 ldsb128(const lds_u8* p) { return *(const LAS bf16x8*)p; }
__device__ __forceinline__ int crow(int r, int hi) { return (r & 3) + 8 * (r >> 2) + 4 * hi; }
__device__ __forceinline__ void glds16(const void* g, lds_u8* l) {
    unsigned sv; const unsigned lb = (unsigned)__builtin_amdgcn_readfirstlane((int)(unsigned)(uintptr_t)l);
    asm volatile("s_mov_b32 %0, m0\n\ts_mov_b32 m0, %2\n\ts_nop 0\n\tglobal_load_lds_dwordx4 %1, off\n\ts_mov_b32 m0, %0" : "=&s"(sv) : "v"(g), "s"(lb) : "memory");
}
__device__ __forceinline__ float swap_sum(float v) { auto rr = __builtin_amdgcn_permlane32_swap(__float_as_uint(v), __float_as_uint(v), false, false); return __uint_as_float(rr[0]) + __uint_as_float(rr[1]); }
__device__ __forceinline__ float swap_max(float v) { auto rr = __builtin_amdgcn_permlane32_swap(__float_as_uint(v), __float_as_uint(v), false, false); return __builtin_fmaxf(__uint_as_float(rr[0]), __uint_as_float(rr[1])); }

constexpr int ATT_SLOT = 32768, ATT_XCH = 65536, ATT_XPITCH = 528, ATT_BTAB = ATT_XCH + 128 * ATT_XPITCH;
static_assert(ATT_BTAB + 512 <= LDS_SCRATCH, "attention LDS");

template <int MODE>
__device__ __forceinline__ void attn_unit(const Args& a, lds_u8* lds, int b, int h, int qb) {
    int tid_ = threadIdx.x; asm volatile("" : "+v"(tid_));
    const int tid = tid_, lane = tid & 63, r32 = lane & 31, hi = lane >> 5; const int wid = __builtin_amdgcn_readfirstlane(tid >> 6);
    const int rgp = wid & 3, map = wid >> 2;
    const bf16_t* proj = (const bf16_t*)(a.ws + WS_PROJ);
    const size_t rowbase = (size_t)b * SEQ; const int q0 = qb * 128, NT = 2 * qb + 2;
    const float lam = ((const float*)(a.ws + WS_LAM))[0];
    if (tid < 128) ((LAS float*)(lds + ATT_BTAB))[tid] = ((const float*)(a.ws + WS_BTAB))[h * 128 + tid];
    bf16x8 qf[4];
    { const bf16_t* qp = proj + (rowbase + q0 + rgp * 32 + r32) * NIN + OFF_DQ + h * 128 + map * 64 + hi * 8;
#pragma unroll
      for (int s = 0; s < 4; ++s) qf[s] = *(const GAS bf16x8*)(qp + s * 16); }
    asm volatile("" : "+v"(qf[0]), "+v"(qf[1]), "+v"(qf[2]), "+v"(qf[3]));
    const int krow = 8 * wid + (lane >> 3);
    const bf16_t* k1src = proj + (rowbase + krow) * NIN + OFF_DK + h * 128 + ((lane & 7) ^ ((krow >> 1) & 7)) * 8;
    const bf16_t* k2src = k1src + 64;
    const bf16_t* vsrc0 = proj + (rowbase + 16 * ((2 * wid) & 3) + (lane >> 2)) * NIN + OFF_DV + h * 128 + 32 * ((2 * wid) >> 2) + (lane & 3) * 8;
    const bf16_t* vsrc1 = proj + (rowbase + 16 * ((2 * wid + 1) & 3) + (lane >> 2)) * NIN + OFF_DV + h * 128 + 32 * ((2 * wid + 1) >> 2) + (lane & 3) * 8;
#define ATT_DMA(t, slot) do { const size_t go = (size_t)(t) * 64 * NIN; lds_u8* sb = lds + (slot) * ATT_SLOT; \
        glds16(k1src + go, sb + wid * 1024); glds16(k2src + go, sb + 8192 + wid * 1024); \
        glds16(vsrc0 + go, sb + 16384 + (2 * wid) * 1024); glds16(vsrc1 + go, sb + 16384 + (2 * wid + 1) * 1024); } while (0)
    const int koff = map * 8192 + r32 * 128, ksw = (r32 >> 1) & 7;
    const int voff = 16384 + ((lane >> 4) & 1) * 32 + (lane & 3) * 8 + (4 * hi + ((lane & 15) >> 2)) * 64;
    f32x16 o[4];
#pragma unroll
    for (int d = 0; d < 4; ++d) o[d] = f32x16{};
    float mrun = -INFINITY, lrun = 0.f;
    const int qpos = q0 + rgp * 32 + r32;
    float b31 = ((const float*)(a.ws + WS_BTAB))[h * 128 + 127]; asm volatile("" : "+v"(b31));
    ATT_DMA(0, 0);
    for (int t = 0; t < NT; ++t) {
        if (!(MODE & 32) || t < 2) { VM_WAIT(); __syncthreads(); }
        if (t + 1 < NT && (!(MODE & 8) || t + 1 < 2)) ATT_DMA(t + 1, (t + 1) & 1);
        if (64 * t > q0 + rgp * 32 + 31) continue;
        const lds_u8* sb = lds + (t & 1) * ATT_SLOT;
        const bool nearT = (64 * t + 176 > q0);
        const float cb = nearT ? 0.f : b31;
        f32x16 sA, sB;
        { const float c0 = (t == 0) ? 0.f : cb - mrun;
#pragma unroll
          for (int r = 0; r < 16; ++r) { sA[r] = c0; sB[r] = c0; } }
        if (MODE & 1) {
            bf16x8 kf[8];
#pragma unroll
            for (int d0 = 0; d0 < 4; ++d0) { const int kc = koff + (((2 * d0 + hi) ^ ksw) << 4); if (MODE & 16) { kf[2 * d0] = qf[d0]; kf[2 * d0 + 1] = qf[3 - d0]; } else { kf[2 * d0] = ldsb128(sb + kc); kf[2 * d0 + 1] = ldsb128(sb + kc + 4096); } }
            __builtin_amdgcn_sched_group_barrier(0x100, 8, 0);
#pragma unroll
            for (int d0 = 0; d0 < 4; ++d0) { sA = MFMA32(kf[2 * d0], qf[d0], sA); sB = MFMA32(kf[2 * d0 + 1], qf[d0], sB); }
            __builtin_amdgcn_sched_group_barrier(0x8, 8, 0);
        }
        if (!(MODE & 1)) asm volatile("" : "+v"(sA), "+v"(sB));
        if (MODE & 4) {
        if (nearT) {
            const LAS float* bt = (const LAS float*)(lds + ATT_BTAB);
            float bA[16], bB[16];
#pragma unroll
            for (int r = 0; r < 16; ++r) { const int d0 = qpos - (64 * t + crow(r, hi)), d1 = d0 - 32;
                bA[r] = bt[d0 < 0 ? 0 : (d0 > 127 ? 127 : d0)]; bB[r] = bt[d1 < 0 ? 0 : (d1 > 127 ? 127 : d1)]; }
            asm volatile("" : "+v"(bA[0]), "+v"(bA[1]), "+v"(bA[2]), "+v"(bA[3]), "+v"(bA[4]), "+v"(bA[5]), "+v"(bA[6]), "+v"(bA[7]), "+v"(bA[8]), "+v"(bA[9]), "+v"(bA[10]), "+v"(bA[11]), "+v"(bA[12]), "+v"(bA[13]), "+v"(bA[14]), "+v"(bA[15]));
            asm volatile("" : "+v"(bB[0]), "+v"(bB[1]), "+v"(bB[2]), "+v"(bB[3]), "+v"(bB[4]), "+v"(bB[5]), "+v"(bB[6]), "+v"(bB[7]), "+v"(bB[8]), "+v"(bB[9]), "+v"(bB[10]), "+v"(bB[11]), "+v"(bB[12]), "+v"(bB[13]), "+v"(bB[14]), "+v"(bB[15]));
#pragma unroll
            for (int r = 0; r < 16; ++r) { const int d0 = qpos - (64 * t + crow(r, hi)), d1 = d0 - 32;
                sA[r] = d0 < 0 ? -INFINITY : sA[r] + bA[r]; sB[r] = d1 < 0 ? -INFINITY : sB[r] + bB[r]; }
        }
#define MX3(a_, b_, c_) __builtin_fmaxf(__builtin_fmaxf((a_), (b_)), (c_))
        float mxa = MX3(sA[0], sA[1], sB[0]), mxb = MX3(sA[2], sA[3], sB[1]); mxa = MX3(mxa, sB[2], sB[3]);
#pragma unroll
        for (int r = 4; r < 16; r += 4) { mxa = MX3(mxa, sA[r], sA[r + 1]); mxb = MX3(mxb, sA[r + 2], sA[r + 3]); mxa = MX3(mxa, sB[r], sB[r + 1]); mxb = MX3(mxb, sB[r + 2], sB[r + 3]); }
#undef MX3
        const float mx = swap_max(__builtin_fmaxf(mxa, mxb));
        if (t == 0 || __any(mx > 6.0f)) {
            const float up = (t == 0) ? mx : __builtin_fmaxf(mx, 0.f), alpha = (t == 0) ? 0.f : __builtin_amdgcn_exp2f(-up);
            mrun = (t == 0) ? mx + cb : mrun + up; lrun *= alpha;
#pragma unroll
            for (int d = 0; d < 4; ++d)
#pragma unroll
                for (int r = 0; r < 16; ++r) o[d][r] *= alpha;
            const float sh = (t == 0) ? mx : up;
#pragma unroll
            for (int r = 0; r < 16; ++r) { sA[r] -= sh; sB[r] -= sh; }
        }
#pragma unroll
        for (int r = 0; r < 16; ++r) { sA[r] = __builtin_amdgcn_exp2f(sA[r]); sB[r] = __builtin_amdgcn_exp2f(sB[r]); }
        f32x2 ps2a = (f32x2){0.f, 0.f}, ps2b = (f32x2){0.f, 0.f};
#pragma unroll
        for (int r = 0; r < 16; r += 2) { ps2a += (f32x2){sA[r], sA[r + 1]}; ps2b += (f32x2){sB[r], sB[r + 1]}; }
        lrun += (ps2a.x + ps2a.y) + (ps2b.x + ps2b.y);
        } else { asm volatile("" : "+v"(sA), "+v"(sB)); }
        u32x4 pw[4];
        pw[0] = (u32x4){pk2(sA[0], sA[1]), pk2(sA[2], sA[3]), pk2(sA[4], sA[5]), pk2(sA[6], sA[7])};
        pw[1] = (u32x4){pk2(sA[8], sA[9]), pk2(sA[10], sA[11]), pk2(sA[12], sA[13]), pk2(sA[14], sA[15])};
        pw[2] = (u32x4){pk2(sB[0], sB[1]), pk2(sB[2], sB[3]), pk2(sB[4], sB[5]), pk2(sB[6], sB[7])};
        pw[3] = (u32x4){pk2(sB[8], sB[9]), pk2(sB[10], sB[11]), pk2(sB[12], sB[13]), pk2(sB[14], sB[15])};
        if (!(MODE & 2)) { asm volatile("" :: "v"(pw[0]), "v"(pw[1]), "v"(pw[2]), "v"(pw[3])); continue; }
        {
            bf16x8 vfa[4], vfb[4];
#pragma unroll
            for (int d = 0; d < 4; ++d) vfa[d] = (MODE & 16) ? qf[d] : vfrag(sb + voff + d * 4096);
            __builtin_amdgcn_sched_group_barrier(0x100, 8, 0);
#pragma unroll
            for (int ks = 0; ks < 4; ks += 2) {
#pragma unroll
                for (int d = 0; d < 4; ++d) vfb[d] = (MODE & 16) ? qf[3 - d] : vfrag(sb + voff + d * 4096 + (ks + 1) * 1024);
                __builtin_amdgcn_sched_group_barrier(0x100, 8, 0);
                { const bf16x8 pb = __builtin_bit_cast(bf16x8, pw[ks]);
#pragma unroll
                  for (int d = 0; d < 4; ++d) o[d] = MFMA32(vfa[d], pb, o[d]); }
                __builtin_amdgcn_sched_group_barrier(0x8, 4, 0);
                if (ks + 2 < 4) {
#pragma unroll
                    for (int d = 0; d < 4; ++d) vfa[d] = (MODE & 16) ? qf[d] : vfrag(sb + voff + d * 4096 + (ks + 2) * 1024);
                    __builtin_amdgcn_sched_group_barrier(0x100, 8, 0);
                }
                { const bf16x8 pb = __builtin_bit_cast(bf16x8, pw[ks + 1]);
#pragma unroll
                  for (int d = 0; d < 4; ++d) o[d] = MFMA32(vfb[d], pb, o[d]); }
                __builtin_amdgcn_sched_group_barrier(0x8, 4, 0);
            }
        }
    }
    const float inv = 1.0f / swap_sum(lrun);
    LAS float* xch = (LAS float*)(lds + ATT_XCH + (rgp * 32 + r32) * ATT_XPITCH);
    if (map == 1) {
        const float sc = inv * lam;
#pragma unroll
        for (int d = 0; d < 4; ++d)
#pragma unroll
            for (int g = 0; g < 4; ++g) *(LAS f32x4*)(xch + 32 * d + 8 * g + 4 * hi) = (f32x4){o[d][4 * g] * sc, o[d][4 * g + 1] * sc, o[d][4 * g + 2] * sc, o[d][4 * g + 3] * sc};
    }
    __syncthreads();
    if (map == 0) {
        float ss = 0.f;
#pragma unroll
        for (int d = 0; d < 4; ++d)
#pragma unroll
            for (int g = 0; g < 4; ++g) { const f32x4 o2 = *(const LAS f32x4*)(xch + 32 * d + 8 * g + 4 * hi);
#pragma unroll
                for (int j = 0; j < 4; ++j) { const float v = o[d][4 * g + j] * inv - o2[j]; o[d][4 * g + j] = v; ss += v * v; } }
        ss = swap_sum(ss);
        const float rn = 0.8f / sqrtf(ss * (1.0f / 128.0f) + EPSF);
        const float* sub = a.in[8];
        bf16_t* mixp = (bf16_t*)(a.ws + WS_MIX) + (rowbase + qpos) * DM + 512 + h * 128;
#pragma unroll
        for (int d = 0; d < 4; ++d)
#pragma unroll
            for (int g = 0; g < 4; ++g) { const int dd = 32 * d + 8 * g + 4 * hi; const f32x4 sv = *(const GAS f32x4*)(sub + dd);
                u32x2 w; w.x = pk2(o[d][4 * g] * rn * sv.x, o[d][4 * g + 1] * rn * sv.y); w.y = pk2(o[d][4 * g + 2] * rn * sv.z, o[d][4 * g + 3] * rn * sv.w);
                *(GAS u32x2*)(mixp + dd) = w; }
    }
    __syncthreads();
#undef ATT_DMA
}

constexpr int RET_BUF = 49152, RET_RT = 2 * RET_BUF, RET_GN = RET_RT + 8192;
static_assert(RET_GN + 2048 <= LDS_SCRATCH, "retention LDS");

__device__ __forceinline__ void ret_unit(const Args& a, lds_u8* lds, int b, int h) {
    int tid_ = threadIdx.x; asm volatile("" : "+v"(tid_));
    const int tid = tid_, lane = tid & 63, r32 = lane & 31, hi = lane >> 5; const int wid = __builtin_amdgcn_readfirstlane(tid >> 6);
    const int rgp = wid & 3, eh = wid >> 2;
    const bf16_t* proj = (const bf16_t*)(a.ws + WS_PROJ);
    const size_t rowbase = (size_t)b * SEQ;
    const double lg = log2(1.0 - exp2(-5.0 - (double)h));
    const float gam = (float)exp2(lg), g127 = (float)exp2(lg * 127.0), g128 = (float)exp2(lg * 128.0);
#define RET_DMA(c, buf) do { const size_t ro = (rowbase + (size_t)(c) * 128) * NIN; lds_u8* bb = lds + (buf) * RET_BUF; \
        _Pragma("unroll") for (int i_ = 0; i_ < 2; ++i_) { const int p_ = 2 * wid + i_; \
            { const int ch = p_ >> 1, rh = p_ & 1; glds16(proj + ro + (size_t)(rh * 64 + lane) * NIN + OFF_RK + h * 64 + ch * 8, bb + ch * 2048 + rh * 1024); } \
            { const int db = p_ >> 3, rg_ = p_ & 7; glds16(proj + ro + (size_t)(rg_ * 16 + (lane >> 2)) * NIN + OFF_RK + h * 64 + db * 32 + (lane & 3) * 8, bb + 16384 + db * 8192 + rg_ * 1024); \
              glds16(proj + ro + (size_t)(rg_ * 16 + (lane >> 2)) * NIN + OFF_RV + h * 64 + db * 32 + (lane & 3) * 8, bb + 32768 + db * 8192 + rg_ * 1024); } } } while (0)
    const int koff = hi * 2048 + r32 * 16;
    const int troff = ((lane >> 4) & 1) * 32 + (lane & 3) * 8 + (4 * hi + ((lane & 15) >> 2)) * 64;
    f32x16 R = f32x16{};
    for (int i = tid; i < 8192 / 16; i += NTHR) *(LAS u32x4*)(lds + RET_RT + i * 16) = (u32x4){0u, 0u, 0u, 0u};
    const float* gn = a.in[3];
    f32x4 gv[4];
#pragma unroll
    for (int g = 0; g < 4; ++g) gv[g] = *(const GAS f32x4*)(gn + h * 64 + eh * 32 + 8 * g + 4 * hi);
    bf16x8 qn[4]; u32x2 svn[4];
#define RET_PREF(c) do { const size_t tk_ = rowbase + (size_t)(c) * 128 + rgp * 32 + r32; const bf16_t* qp_ = proj + tk_ * NIN + OFF_RQ + h * 64 + hi * 8; const bf16_t* sg_ = proj + tk_ * NIN + OFF_RG + h * 64 + eh * 32 + 4 * hi; \
        _Pragma("unroll") for (int s = 0; s < 4; ++s) qn[s] = *(const GAS bf16x8*)(qp_ + s * 16); \
        _Pragma("unroll") for (int g = 0; g < 4; ++g) svn[g] = *(const GAS u32x2*)(sg_ + 8 * g); } while (0)
    RET_PREF(0);
    RET_DMA(0, 0);
    u32x2 wst[4]; bf16_t* wptr = nullptr;
#pragma unroll
    for (int g = 0; g < 4; ++g) wst[g] = (u32x2){0u, 0u};
    for (int c = 0; c < 32; ++c) {
        VM_WAIT(); __syncthreads();
        if (c > 0) {
#pragma unroll
            for (int g = 0; g < 4; ++g) *(GAS u32x2*)(wptr + 8 * g + 4 * hi) = wst[g];
        }
        bf16x8 qf[4]; u32x2 svc[4];
#pragma unroll
        for (int s = 0; s < 4; ++s) { qf[s] = qn[s]; svc[s] = svn[s]; }
        if (c + 1 < 32) { RET_PREF(c + 1); RET_DMA(c + 1, (c + 1) & 1); }
        const lds_u8* bb = lds + (c & 1) * RET_BUF;
        const size_t tok = rowbase + (size_t)c * 128 + rgp * 32 + r32;
        f32x16 O = f32x16{};
#pragma unroll
        for (int s = 0; s < 4; ++s) { const bf16x8 rt = ldsb128(lds + RET_RT + (2 * s + hi) * 1024 + (eh * 32 + r32) * 16); O = MFMA32(rt, qf[s], O); }
        for (int kb = 0; kb <= rgp; ++kb) {
            f32x16 S = f32x16{};
#pragma unroll
            for (int s = 0; s < 4; ++s) { const bf16x8 ka = ldsb128(bb + koff + s * 4096 + (kb * 32) * 16); S = MFMA32(ka, qf[s], S); }
            if (kb == rgp) {
#pragma unroll
                for (int r = 0; r < 16; ++r) S[r] = (crow(r, hi) > r32) ? 0.f : S[r];
            }
            const u32x4 p0 = (u32x4){pk2(S[0], S[1]), pk2(S[2], S[3]), pk2(S[4], S[5]), pk2(S[6], S[7])};
            const u32x4 p1 = (u32x4){pk2(S[8], S[9]), pk2(S[10], S[11]), pk2(S[12], S[13]), pk2(S[14], S[15])};
            const bf16x8 v0 = vfrag(bb + 32768 + eh * 8192 + troff + (2 * kb) * 1024), v1 = vfrag(bb + 32768 + eh * 8192 + troff + (2 * kb + 1) * 1024);
            O = MFMA32(v0, __builtin_bit_cast(bf16x8, p0), O); O = MFMA32(v1, __builtin_bit_cast(bf16x8, p1), O);
        }
        if (rgp < 2) {
            f32x16 T = f32x16{};
#pragma unroll
            for (int ks = 0; ks < 8; ++ks) { const bf16x8 kt = vfrag(bb + 16384 + rgp * 8192 + troff + ks * 1024), vv = vfrag(bb + 32768 + eh * 8192 + troff + ks * 1024); T = MFMA32(kt, vv, T); }
#pragma unroll
            for (int r = 0; r < 16; ++r) R[r] = R[r] * g128 + T[r] * g127;
        }
        float s1 = 0.f, s2 = 0.f;
#pragma unroll
        for (int r = 0; r < 16; ++r) { s1 += O[r]; s2 += O[r] * O[r]; }
        s1 = swap_sum(s1); s2 = swap_sum(s2);
        LAS f32x2* gx = (LAS f32x2*)(lds + RET_GN);
        if (hi == 0) gx[(rgp * 32 + r32) * 2 + eh] = (f32x2){s1, s2};
        __syncthreads();
        if (rgp < 2) {
#pragma unroll
            for (int g = 0; g < 4; ++g) { u32x2 w; w.x = pk2(R[4 * g] * gam, R[4 * g + 1] * gam); w.y = pk2(R[4 * g + 2] * gam, R[4 * g + 3] * gam);
                *(LAS u32x2*)(lds + RET_RT + (rgp * 4 + g) * 1024 + (eh * 32 + r32) * 16 + hi * 8) = w; }
        }
        const f32x2 ga = gx[(rgp * 32 + r32) * 2], gb = gx[(rgp * 32 + r32) * 2 + 1];
        const float mean = (ga.x + gb.x) * (1.0f / 64.0f), var = (ga.y + gb.y) * (1.0f / 64.0f) - mean * mean;
        const float rstd = 1.0f / sqrtf(__builtin_fmaxf(var, 0.f) + EPSF);
        bf16_t* mixp = (bf16_t*)(a.ws + WS_MIX) + tok * DM + h * 64 + eh * 32;
#pragma unroll
        for (int g = 0; g < 4; ++g) { const int e = 8 * g + 4 * hi; const u32x2 sv = svc[g];
            const float y0 = (O[4 * g] - mean) * rstd * gv[g].x * __uint_as_float(sv.x << 16), y1 = (O[4 * g + 1] - mean) * rstd * gv[g].y * __uint_as_float(sv.x & 0xffff0000u);
            const float y2 = (O[4 * g + 2] - mean) * rstd * gv[g].z * __uint_as_float(sv.y << 16), y3 = (O[4 * g + 3] - mean) * rstd * gv[g].w * __uint_as_float(sv.y & 0xffff0000u);
            wst[g].x = pk2(y0, y1); wst[g].y = pk2(y2, y3); }
        wptr = mixp;
    }
#pragma unroll
    for (int g = 0; g < 4; ++g) *(GAS u32x2*)(wptr + 8 * g + 4 * hi) = wst[g];
    __syncthreads();
#undef RET_DMA
#undef RET_PREF
}


#define CAS_DESC(x, y) do { const float hi_ = __builtin_fmaxf(x, y), lo_ = __builtin_fminf(x, y); x = hi_; y = lo_; } while (0)
#define CAS_ASC(x, y) do { const float hi_ = __builtin_fmaxf(x, y), lo_ = __builtin_fminf(x, y); x = lo_; y = hi_; } while (0)
__device__ __forceinline__ void sort16_desc(float (&v)[16]) {
#pragma unroll
    for (int k = 2; k <= 16; k <<= 1)
#pragma unroll
        for (int j = k >> 1; j > 0; j >>= 1)
#pragma unroll
            for (int i = 0; i < 16; ++i) { const int l = i ^ j; if (l > i) { if ((i & k) == 0) CAS_DESC(v[i], v[l]); else CAS_ASC(v[i], v[l]); } }
}
__device__ __forceinline__ void bitonic_merge16_desc(float (&v)[16]) {
#pragma unroll
    for (int j = 8; j > 0; j >>= 1)
#pragma unroll
        for (int i = 0; i < 16; ++i) { const int l = i ^ j; if (l > i) CAS_DESC(v[i], v[l]); }
}
__device__ __forceinline__ void merge_top16(float (&a)[16], const float (&b)[16]) {
#pragma unroll
    for (int i = 0; i < 16; ++i) a[i] = __builtin_fmaxf(a[i], b[15 - i]);
    bitonic_merge16_desc(a);
}
__device__ __forceinline__ unsigned pack_idx4(const float (&v)[16], int w) {
    return (__float_as_uint(v[4 * w]) & 127u) | ((__float_as_uint(v[4 * w + 1]) & 127u) << 8) | ((__float_as_uint(v[4 * w + 2]) & 127u) << 16) | ((__float_as_uint(v[4 * w + 3]) & 127u) << 24);
}
__device__ __forceinline__ unsigned lookup_idx(const unsigned (&pk)[4], unsigned i) {
    const unsigned w = i >> 2; unsigned s = w == 0 ? pk[0] : (w == 1 ? pk[1] : (w == 2 ? pk[2] : pk[3]));
    return (s >> ((i & 3u) * 8u)) & 127u;
}

constexpr int P5_KEYB = 32768;
__device__ __forceinline__ void p5_topk(const Args& a, lds_u8* lds) {
    const int tid = threadIdx.x, lane = tid & 63, r32 = lane & 31, hi = lane >> 5; const int wid = __builtin_amdgcn_readfirstlane(tid >> 6);
    const int hp = blockIdx.x & 3, wgi = blockIdx.x >> 2, nwg = (gridDim.x + 3 - hp) / 4;
    const bf16_t* keys = (const bf16_t*)(a.ws + WS_KEYS) + (size_t)hp * 4 * 128 * 128;
    for (int i = tid; i < 4 * 128 * 16; i += NTHR) { const int t = i >> 11, key = (i >> 4) & 127, c = i & 15;
        *(LAS u32x4*)(lds + t * P5_KEYB + c * 2048 + key * 16) = *(const GAS u32x4*)(keys + ((size_t)t * 128 + key) * 128 + c * 8); }
    __syncthreads();
    const bf16_t* Q = (const bf16_t*)(a.ws + WS_PROJ);
    int* IDX = (int*)(a.ws + WS_IDX); float* GATE = (float*)(a.ws + WS_GATE);
    const int tg0 = wgi * NWAVES + wid, tgs = nwg * NWAVES;
    const int ntask = (tg0 < MTOK / 32) ? 4 * ((MTOK / 32 - 1 - tg0) / tgs + 1) : 0;
#define P5_QLOAD(QF, k_) do { const int tg_ = tg0 + ((k_) >> 2) * tgs, t_ = (k_) & 3; \
        const bf16_t* qp = Q + (size_t)(tg_ * 32 + r32) * NQ + (2 * hp + (t_ >> 1)) * 256 + (t_ & 1) * 128 + hi * 8; \
        _Pragma("unroll") for (int s = 0; s < 8; ++s) QF[s] = *(const GAS bf16x8*)(qp + s * 16); } while (0)
    float la[16], lb[16];
#pragma unroll
    for (int r = 0; r < 16; ++r) { la[r] = 0.f; lb[r] = 0.f; }
    bf16x8 qf[8], qn[8];
    if (ntask > 0) P5_QLOAD(qf, 0);
#pragma unroll 1
    for (int k = 0; k < ntask; ++k) {
      {
        const int tg = tg0 + (k >> 2) * tgs, t = k & 3;
        P5_QLOAD(qn, (k + 1 < ntask ? k + 1 : k));
        {
            float top[16];
#pragma unroll
            for (int kb = 0; kb < 4; ++kb) {
                f32x16 S = f32x16{};
#pragma unroll
                for (int s = 0; s < 8; ++s) { const bf16x8 kf = ldsb128(lds + t * P5_KEYB + (2 * s + hi) * 2048 + (kb * 32 + r32) * 16); S = MFMA32(kf, qf[s], S); }
                float v[16];
#pragma unroll
                for (int r = 0; r < 16; ++r) v[r] = __uint_as_float((__float_as_uint(S[r]) & ~127u) | (unsigned)(kb * 32 + (r & 3) + 8 * (r >> 2)) | ((unsigned)hi << 2));
                sort16_desc(v);
                if (kb == 0) {
#pragma unroll
                    for (int r = 0; r < 16; ++r) top[r] = v[r];
                } else merge_top16(top, v);
            }
            float oth[16];
#pragma unroll
            for (int r = 0; r < 16; ++r) { auto rr = __builtin_amdgcn_permlane32_swap(__float_as_uint(top[r]), __float_as_uint(top[r]), false, false); top[r] = __uint_as_float(rr[0]); oth[r] = __uint_as_float(rr[1]); }
            merge_top16(top, oth);
            const bool ka = ((t >> 1) == hi) && ((t & 1) == 0), kb2 = ((t >> 1) == hi) && ((t & 1) == 1);
#pragma unroll
            for (int r = 0; r < 16; ++r) { la[r] = ka ? top[r] : la[r]; lb[r] = kb2 ? top[r] : lb[r]; }
        }
#pragma unroll
        for (int s2 = 0; s2 < 8; ++s2) qf[s2] = qn[s2];
        if (t != 3) continue;
        unsigned pa[4], pb[4];
#pragma unroll
        for (int w = 0; w < 4; ++w) { pa[w] = pack_idx4(la, w); pb[w] = pack_idx4(lb, w); }
        float c0[16], c1[16];
#define CAND(i, j) __uint_as_float((__float_as_uint(la[i] + lb[j]) & ~255u) | (unsigned)((i) * 16 + (j)))
        const float NEG = -INFINITY;
        c0[0] = CAND(0, 0); c0[1] = CAND(0, 1); c0[2] = CAND(0, 2); c0[3] = CAND(0, 3); c0[4] = CAND(0, 4); c0[5] = CAND(0, 5); c0[6] = CAND(0, 6); c0[7] = CAND(0, 7);
        c0[8] = CAND(0, 8); c0[9] = CAND(0, 9); c0[10] = CAND(0, 10); c0[11] = CAND(0, 11); c0[12] = CAND(0, 12); c0[13] = CAND(0, 13); c0[14] = CAND(0, 14); c0[15] = CAND(0, 15);
        sort16_desc(c0);
        c1[0] = CAND(1, 0); c1[1] = CAND(1, 1); c1[2] = CAND(1, 2); c1[3] = CAND(1, 3); c1[4] = CAND(1, 4); c1[5] = CAND(1, 5); c1[6] = CAND(1, 6); c1[7] = CAND(1, 7);
        c1[8] = CAND(2, 0); c1[9] = CAND(2, 1); c1[10] = CAND(2, 2); c1[11] = CAND(2, 3); c1[12] = CAND(2, 4); c1[13] = CAND(3, 0); c1[14] = CAND(3, 1); c1[15] = CAND(3, 2);
        sort16_desc(c1); merge_top16(c0, c1);
        asm volatile("" : "+v"(c0[0]), "+v"(c0[15]));
        c1[0] = CAND(3, 3); c1[1] = CAND(4, 0); c1[2] = CAND(4, 1); c1[3] = CAND(4, 2); c1[4] = CAND(5, 0); c1[5] = CAND(5, 1); c1[6] = CAND(6, 0); c1[7] = CAND(6, 1);
        c1[8] = CAND(7, 0); c1[9] = CAND(7, 1); c1[10] = CAND(8, 0); c1[11] = CAND(9, 0); c1[12] = CAND(10, 0); c1[13] = CAND(11, 0); c1[14] = CAND(12, 0); c1[15] = CAND(13, 0);
        sort16_desc(c1); merge_top16(c0, c1);
        asm volatile("" : "+v"(c0[0]), "+v"(c0[15]));
        c1[0] = CAND(14, 0); c1[1] = CAND(15, 0);
#pragma unroll
        for (int r = 2; r < 16; ++r) c1[r] = NEG;
#undef CAND
        sort16_desc(c1); merge_top16(c0, c1);
        float gsum = 0.f, gv[16]; int ex[16];
        const float mx = __uint_as_float(__float_as_uint(c0[0]) & ~255u);
#pragma unroll
        for (int r = 0; r < 16; ++r) { const unsigned bits = __float_as_uint(c0[r]); const float val = __uint_as_float(bits & ~255u);
            gv[r] = __expf(val - mx); gsum += gv[r];
            ex[r] = (int)(lookup_idx(pa, (bits >> 4) & 15u) * 128u + lookup_idx(pb, bits & 15u)); }
        const float ginv = 1.0f / gsum;
        const size_t ob = (size_t)(tg * 32 + r32) * 128 + (2 * hp + hi) * 16;
#pragma unroll
        for (int r = 0; r < 16; r += 4) { *(GAS u32x4*)(IDX + ob + r) = (u32x4){(unsigned)ex[r], (unsigned)ex[r + 1], (unsigned)ex[r + 2], (unsigned)ex[r + 3]};
            *(GAS f32x4*)(GATE + ob + r) = (f32x4){gv[r] * ginv, gv[r + 1] * ginv, gv[r + 2] * ginv, gv[r + 3] * ginv}; }
      }
    }
#undef P5_QLOAD
    __syncthreads();
}

typedef long i64_t;
typedef int v8i_t __attribute__((ext_vector_type(8)));
#define MFMA16F8(a, b, c) __builtin_amdgcn_mfma_f32_16x16x32_fp8_fp8(a, b, c, 0, 0, 0)
constexpr float P6_SD = 64.f, P6_SX = 8.f, P6_SU = 16.f, P6_SA = 64.f, P6_SU4 = 6.f;
constexpr size_t P6_SLICEB = (size_t)NEXP * 128;
__device__ __forceinline__ unsigned pk4_fp8(float a, float b, float c, float d) { int w = __builtin_amdgcn_cvt_pk_fp8_f32(a, b, 0, false); w = __builtin_amdgcn_cvt_pk_fp8_f32(c, d, w, true); return (unsigned)w; }
__device__ __forceinline__ float fp8_byte0(unsigned w) { return __builtin_amdgcn_cvt_f32_fp8((int)w, 0); }
constexpr int P6_WSCR = 3328;
__device__ __forceinline__ void p6_token(const Args& a, lds_u8* wl, int tok, int lane, float* OUTW) {
    const int n = lane & 15, g = lane >> 4;
    const unsigned char* ws = a.ws;
    const unsigned char* WD = ws + WS_WD; const unsigned char* WU = ws + WS_WU;
    const int* IDX = (const int*)(ws + WS_IDX) + (size_t)tok * 128; const float* GATE = (const float*)(ws + WS_GATE) + (size_t)tok * 128;
    const bf16_t* X1 = (const bf16_t*)(ws + WS_X1B) + (size_t)tok * DM;
    {
#pragma unroll
        for (int j = 0; j < 4; ++j) {
            const u32x2 xw_ = *(const GAS u32x2*)(X1 + 256 * j + 4 * lane); const f32x4 v = (f32x4){__uint_as_float(xw_.x << 16), __uint_as_float(xw_.x & 0xffff0000u), __uint_as_float(xw_.y << 16), __uint_as_float(xw_.y & 0xffff0000u)} * P6_SX;
            const unsigned hw = pk4_fp8(v.x, v.y, v.z, v.w);
            const float r0 = v.x - __builtin_amdgcn_cvt_f32_fp8((int)hw, 0), r1 = v.y - __builtin_amdgcn_cvt_f32_fp8((int)hw, 1), r2 = v.z - __builtin_amdgcn_cvt_f32_fp8((int)hw, 2), r3 = v.w - __builtin_amdgcn_cvt_f32_fp8((int)hw, 3);
            const unsigned lw = pk4_fp8(r0 * 16.f, r1 * 16.f, r2 * 16.f, r3 * 16.f);
            *(LAS unsigned*)(wl + 256 * j + 4 * lane) = hw; *(LAS unsigned*)(wl + 1024 + 256 * j + 4 * lane) = lw;
        }
        const u32x2 iv = *(const GAS u32x2*)(IDX + lane * 2); *(LAS u32x2*)(wl + 2048 + lane * 8) = iv;
    }
    const float rs2 = row_rs2((const bf16_t*)(ws + WS_SSQ), tok);
    LDS_WAIT();
    const LAS int* idxl = (const LAS int*)(wl + 2048); LAS unsigned short* actl = (LAS unsigned short*)(wl + 2560);
    const int xoff = (n & 1) * 1024 + 16 * g;
#pragma unroll 1
    for (int eg = 0; eg < 8; ++eg) {
        const int e = idxl[eg * 16 + n];
        const unsigned char* rp = WD + (size_t)e * 128 + 16 * g;
        f32x4 acc = (f32x4){0.f, 0.f, 0.f, 0.f};
        u32x4 bq[16];
#pragma unroll
        for (int sl = 0; sl < 8; ++sl) { bq[2 * sl] = *(const GAS u32x4*)(rp + sl * P6_SLICEB); bq[2 * sl + 1] = *(const GAS u32x4*)(rp + sl * P6_SLICEB + 64); }
#pragma unroll
        for (int sl = 0; sl < 8; ++sl)
#pragma unroll
            for (int hf = 0; hf < 2; ++hf) {
                const u32x4 xa = *(const LAS u32x4*)(wl + xoff + sl * 128 + hf * 64); const u32x4 bb = bq[2 * sl + hf];
                acc = MFMA16F8((i64_t)(((unsigned long long)xa.y << 32) | xa.x), (i64_t)(((unsigned long long)bb.y << 32) | bb.x), acc);
                acc = MFMA16F8((i64_t)(((unsigned long long)xa.w << 32) | xa.z), (i64_t)(((unsigned long long)bb.w << 32) | bb.z), acc);
            }
        const float av = (acc[0] + acc[1] * 0.0625f) * (rs2 * (1.0f / (P6_SD * P6_SX)));
        const float act = 0.5f * av * (1.0f + erff(av * 0.70710678118654752f)) * GATE[eg * 16 + n] * P6_SA;
        const unsigned hb = pk4_fp8(act, 0.f, 0.f, 0.f) & 0xffu;
        const unsigned lb = pk4_fp8((act - fp8_byte0(hb)) * 16.f, 0.f, 0.f, 0.f) & 0xffu;
        if (g == 0) actl[eg * 16 + n] = (unsigned short)(hb | (lb << 8));
    }
    LDS_WAIT();
    const int pos = n & 7, sel = n >> 3;
    float ss = 0.f;
    const bool owner = (n < 8) && (g < 2);
#pragma unroll 1
    for (int sl = 0; sl < 8; ++sl) {
        f32x4 ah[2], al[2];
#pragma unroll
        for (int s = 0; s < 2; ++s) { ah[s] = (f32x4){0.f, 0.f, 0.f, 0.f}; al[s] = (f32x4){0.f, 0.f, 0.f, 0.f}; }
        u32x4 bq[16]; unsigned av[16];
#pragma unroll
        for (int q = 0; q < 16; ++q) { const int ei = 8 * q + 4 * sel + g; const int e = idxl[ei]; av[q] = actl[ei];
            bq[q] = *(const GAS u32x4*)(WU + sl * P6_SLICEB + (size_t)e * 128 + 16 * pos); }
#pragma unroll
        for (int q = 0; q < 16; ++q) {
            const unsigned long long ahv = (unsigned long long)(av[q] & 0xffu) << (8 * pos), alv = (unsigned long long)(av[q] >> 8) << (8 * pos);
            const u32x4 bb = bq[q];
            const i64_t b0 = (i64_t)(((unsigned long long)bb.y << 32) | bb.x), b1 = (i64_t)(((unsigned long long)bb.w << 32) | bb.z);
            ah[0] = MFMA16F8((i64_t)ahv, b0, ah[0]); al[0] = MFMA16F8((i64_t)alv, b0, al[0]);
            ah[1] = MFMA16F8((i64_t)ahv, b1, ah[1]); al[1] = MFMA16F8((i64_t)alv, b1, al[1]);
        }
#pragma unroll
        for (int s = 0; s < 2; ++s) {
            f32x4 t = ah[s] + al[s] * 0.0625f, u;
#pragma unroll
            for (int r = 0; r < 4; ++r) u[r] = __shfl(t[r], (lane + 40) & 63);
            const int col = 128 * sl + 16 * pos + 8 * s + 4 * (g & 1);
            const u32x2 xq_ = *(const GAS u32x2*)(X1 + col); const f32x4 xv = (f32x4){__uint_as_float(xq_.x << 16), __uint_as_float(xq_.x & 0xffff0000u), __uint_as_float(xq_.y << 16), __uint_as_float(xq_.y & 0xffff0000u)};
            const f32x4 x2 = xv + (t + u) * (1.0f / (P6_SA * P6_SU));
            if (owner) { ss += (x2.x * x2.x + x2.y * x2.y) + (x2.z * x2.z + x2.w * x2.w); *(GAS f32x4*)(OUTW + (size_t)tok * DM + col) = x2; }
        }
    }
    ss = wave_sum(ss);
    const float rn = 1.0f / sqrtf(ss * (1.0f / DM) + EPSF);
    const float* nf = a.in[16];
    if (owner) {
#pragma unroll
        for (int sl = 0; sl < 8; ++sl)
#pragma unroll
            for (int s = 0; s < 2; ++s) { const int col = 128 * sl + 16 * pos + 8 * s + 4 * g; const f32x4 gv = *(const GAS f32x4*)(nf + col);
                GAS f32x4* op = (GAS f32x4*)(OUTW + (size_t)tok * DM + col); *op = *op * rn * gv; }
    }
}

constexpr int P6S_WAVE = 16384 + 512 + 128;
static_assert(NWAVES * P6S_WAVE <= LDS_SCRATCH, "P6 LDS");
__device__ __forceinline__ float gelu_as(float v) {
    const float av = __builtin_fabsf(v), t = __builtin_amdgcn_rcpf(av * 0.2316418882f + 1.0f);
    float q = t * 0.5307027145f + (-0.7265760135f); q = q * t + 0.7107068705f; q = q * t + (-0.142248368f); q = q * t + 0.127414796f; q = q * t;
    const float e = __builtin_amdgcn_exp2f((v * v) * (-0.72134752044f));
    const float m = v * (q * e);
    return v < 0.f ? m : v - m;
}
template <int EMASK, int PARTS>
__device__ __forceinline__ void p6_slices(const Args& a, lds_u8* wl, int tok0, int lane) {
    const int n = lane & 15, g = lane >> 4;
    const unsigned char* ws = a.ws;
    const unsigned char* WD = ws + WS_WD; const unsigned char* WU = ws + WS_WU;
    LAS float* aacc = (LAS float*)wl; LAS unsigned short* idl = (LAS unsigned short*)(wl + 8192); LAS unsigned short* actl = (LAS unsigned short*)(wl + 12288);
    lds_u8* xs = wl + 16384; LAS float* ssl = (LAS float*)(wl + 16384 + 512); LAS float* r2l = ssl + 16;
    {
        u32x2 iv[16];
#pragma unroll
        for (int t = 0; t < 16; ++t) iv[t] = *(const GAS u32x2*)((const int*)(ws + WS_IDX) + (size_t)(tok0 + t) * 128 + lane * 2);
#pragma unroll
        for (int t = 0; t < 16; ++t) {
            *(LAS unsigned*)(wl + 8192 + t * 256 + lane * 4) = (iv[t].x & 0xffffu) | (iv[t].y << 16);
            *(LAS f32x2*)(wl + t * 512 + lane * 8) = (f32x2){0.f, 0.f};
        }
    }
    if (lane < 16) { ssl[lane] = 0.f; r2l[lane] = row_rs2((const bf16_t*)(ws + WS_SSQ), tok0 + lane); }
    unsigned char* X4 = (unsigned char*)a.ws + WS_XB;
#pragma unroll 1
    for (int t8 = 0; t8 < 16; t8 += 8) {
    u32x4 xwa[8], xwb[8];
#pragma unroll
    for (int tt = 0; tt < 8; ++tt) { const bf16_t* xr = (const bf16_t*)(ws + WS_X1B) + (size_t)(tok0 + t8 + tt) * DM + 16 * lane; xwa[tt] = *(const GAS u32x4*)xr; xwb[tt] = *(const GAS u32x4*)(xr + 8); }
#pragma unroll
    for (int tt = 0; tt < 8; ++tt) {
        const int t = t8 + tt;
        const u32x4 xw0 = xwa[tt], xw1 = xwb[tt];
        float rr[16];
#pragma unroll
        for (int j = 0; j < 4; ++j) { rr[2 * j] = __uint_as_float(xw0[j] << 16); rr[2 * j + 1] = __uint_as_float(xw0[j] & 0xffff0000u); rr[8 + 2 * j] = __uint_as_float(xw1[j] << 16); rr[9 + 2 * j] = __uint_as_float(xw1[j] & 0xffff0000u); }
#pragma unroll
        for (int st = 0; st < 4; ++st) {
            unsigned w0 = 0u, w1 = 0u;
#define P6_Q4(p_) do { w0 = __builtin_amdgcn_cvt_scalef32_pk_fp4_f32(w0, rr[2 * (p_)], rr[2 * (p_) + 1], 1.0f, p_); w1 = __builtin_amdgcn_cvt_scalef32_pk_fp4_f32(w1, rr[8 + 2 * (p_)], rr[9 + 2 * (p_)], 1.0f, p_); } while (0)
            P6_Q4(0); P6_Q4(1); P6_Q4(2); P6_Q4(3);
#undef P6_Q4
#define P6_D4(p_) do { const f32x2 d0 = __builtin_amdgcn_cvt_scalef32_pk_f32_fp4(w0, 1.0f, p_), d1 = __builtin_amdgcn_cvt_scalef32_pk_f32_fp4(w1, 1.0f, p_); \
                rr[2 * (p_)] = (rr[2 * (p_)] - d0.x) * 4.0f; rr[2 * (p_) + 1] = (rr[2 * (p_) + 1] - d0.y) * 4.0f; rr[8 + 2 * (p_)] = (rr[8 + 2 * (p_)] - d1.x) * 4.0f; rr[9 + 2 * (p_)] = (rr[9 + 2 * (p_)] - d1.y) * 4.0f; } while (0)
            P6_D4(0); P6_D4(1); P6_D4(2); P6_D4(3);
#undef P6_D4
            *(GAS u32x2*)(X4 + (size_t)(tok0 + t) * 2048 + st * 512 + 8 * lane) = (u32x2){w0, w1};
        }
    }
    }
    LDS_WAIT(); VM_WAIT();
    const int xoff = (n & 3) * 128 + 16 * g;
    const int bpa = 4 * (4 * (lane & 15) + (lane >> 4));
#define MFMA4(a_, b_, c_) __builtin_amdgcn_mfma_scale_f32_16x16x128_f8f6f4(a_, b_, c_, 4  , 4  , 0, 0, 0, 0)
#define P6_DLOAD(BQ, XV, it_) do { const int sl_ = (it_) >> 4, t_ = (it_) & 15; \
        _Pragma("unroll") for (int eg = 0; eg < 8; ++eg) { const int e_ = idl[t_ * 128 + eg * 16 + (lane >> 2)] & EMASK; const unsigned char* rp_ = WD + sl_ * P6_SLICEB + (size_t)e_ * 128 + 16 * (lane & 3); \
            BQ[2 * eg] = *(const GAS u32x4*)rp_; BQ[2 * eg + 1] = *(const GAS u32x4*)(rp_ + 64); } \
        XV = *(const GAS u32x2*)(X4 + (size_t)(tok0 + t_) * 2048 + (lane >> 4) * 512 + sl_ * 128 + 8 * (lane & 15)); } while (0)
#define P6_DCOMP(BQ, XV, it_) do { const int t_ = (it_) & 15; \
        *(LAS u32x2*)(xs + (lane >> 4) * 128 + 8 * (lane & 15)) = XV; \
        LDS_WAIT(); \
        const u32x4 xa0 = *(const LAS u32x4*)(xs + xoff), xa1 = *(const LAS u32x4*)(xs + xoff + 64); \
        const v8i_t A0 = (v8i_t){(int)xa0.x, (int)xa0.y, (int)xa0.z, (int)xa0.w, 0, 0, 0, 0}; \
        const v8i_t A1 = (v8i_t){(int)xa1.x, (int)xa1.y, (int)xa1.z, (int)xa1.w, 0, 0, 0, 0}; \
        _Pragma("unroll") for (int eg = 0; eg < 8; ++eg) { f32x4 acc = (f32x4){0.f, 0.f, 0.f, 0.f}; v8i_t b0 = (v8i_t){0, 0, 0, 0, 0, 0, 0, 0}, b1 = (v8i_t){0, 0, 0, 0, 0, 0, 0, 0}; \
            _Pragma("unroll") for (int w_ = 0; w_ < 4; ++w_) { b0[w_] = __builtin_amdgcn_ds_bpermute(bpa, (int)BQ[2 * eg][w_]); b1[w_] = __builtin_amdgcn_ds_bpermute(bpa, (int)BQ[2 * eg + 1][w_]); } \
            acc = MFMA4(A0, b0, acc); acc = MFMA4(A1, b1, acc); \
            float r_ = (acc[0] + acc[1] * 0.25f) + (acc[2] * 0.0625f + acc[3] * 0.015625f); asm volatile("" : "+v"(r_)); \
            if (g == 0) aacc[t_ * 128 + eg * 16 + n] += r_; } \
        LDS_WAIT(); } while (0)
    if (PARTS & 1) {
        u32x4 bqA[16], bqB[16]; u32x2 xvA, xvB;
        P6_DLOAD(bqA, xvA, 0);
#pragma unroll 1
        for (int it = 0; it < 64; it += 2) {
            P6_DLOAD(bqB, xvB, it + 1);
            P6_DCOMP(bqA, xvA, it);
            P6_DLOAD(bqA, xvA, (it + 2 < 64 ? it + 2 : it));
            P6_DCOMP(bqB, xvB, it + 1);
        }
    }
#undef MFMA4
#undef P6_DLOAD
#undef P6_DCOMP
    int lane_g = lane; asm volatile("" : "+v"(lane_g));
    float gts[16][2];
#pragma unroll
    for (int t = 0; t < 16; ++t) { gts[t][0] = ((const float*)(ws + WS_GATE))[(size_t)(tok0 + t) * 128 + lane_g]; gts[t][1] = ((const float*)(ws + WS_GATE))[(size_t)(tok0 + t) * 128 + lane_g + 64]; }
#pragma unroll
    for (int t = 0; t < 16; ++t) {
        const float sc = r2l[t] * (1.0f / P6_SD);
#pragma unroll
        for (int j = 0; j < 2; ++j) { const int ei = lane_g + 64 * j; const float av = aacc[t * 128 + ei] * sc;
            const float act = gelu_as(av) * gts[t][j];
            const unsigned ab = __float_as_uint(act), eb = (ab >> 23) & 255u;
            unsigned pk = 0u;
            if (eb > 4u) {
                const float m = __uint_as_float((ab & 0x807fffffu) | (128u << 23));
                const unsigned w0 = __builtin_amdgcn_cvt_scalef32_pk_fp4_f32(0u, m, 0.f, 1.0f, 0);
                const f32x2 d0 = __builtin_amdgcn_cvt_scalef32_pk_f32_fp4(w0, 1.0f, 0);
                const unsigned w1 = __builtin_amdgcn_cvt_scalef32_pk_fp4_f32(0u, (m - d0.x) * 4.0f, 0.f, 1.0f, 0);
                pk = (w0 & 15u) | ((w1 & 15u) << 4) | ((eb - 1u) << 8);
            }
            actl[t * 128 + ei] = (unsigned short)pk; }
    }
    LDS_WAIT();
    int lane_u = lane; asm volatile("" : "+v"(lane_u));
    const float* nf = a.in[16];
    const int ui = lane_u & 31, ug = lane_u >> 5, ush = 4 * (ui & 7);
    const unsigned uk0 = (ui >> 3) == 0 ? 0xffffffffu : 0u, uk1 = (ui >> 3) == 1 ? 0xffffffffu : 0u, uk2 = (ui >> 3) == 2 ? 0xffffffffu : 0u, uk3 = (ui >> 3) == 3 ? 0xffffffffu : 0u;
#ifndef P6_DIGITS
#define P6_DIGITS 2
#endif
#define MFMA32S(a_, b_, c_, sa_) __builtin_amdgcn_mfma_scale_f32_32x32x64_f8f6f4(a_, b_, c_, 4, 4, 0, sa_, 0, 127)
#ifndef P6_UPROBE
#define P6_UPROBE 0
#endif
#define P6_ULOAD(BQ, sq_) do { const int t_ = (sq_) >> 3, qs_ = (sq_) & 7; \
        if (!((P6_UPROBE & 1) && PARTS == 2 && EMASK != 0xffff)) \
        _Pragma("unroll") for (int q = 0; q < 8; ++q) { const int e_ = idl[t_ * 128 + 2 * (8 * qs_ + q) + ug] & EMASK; \
            BQ[q] = *(const GAS u32x4*)(WU + (size_t)e_ * 512 + 16 * ui); } } while (0)
#define P6_UMMA(BQ, sq_) do { const int t_ = (sq_) >> 3, qs_ = (sq_) & 7; \
        _Pragma("unroll") for (int q = 0; q < 8; ++q) { \
            const unsigned av_ = actl[t_ * 128 + 2 * (8 * qs_ + q) + ug]; \
            const unsigned w0_ = (av_ & 15u) << ush, w1_ = ((av_ >> 4) & 15u) << ush; const int s0_ = (int)(av_ >> 8), s1_ = s0_ - 2; \
            const u32x4 bb = BQ[q]; const v8i_t B_ = (v8i_t){(int)bb.x, (int)bb.y, (int)bb.z, (int)bb.w, 0, 0, 0, 0}; \
            if ((P6_UPROBE & 2) && PARTS == 2) { asm volatile("" :: "v"(w0_ & uk0), "v"(w0_ & uk1), "v"(w0_ & uk2), "v"(w0_ & uk3), "v"(w1_ & uk0), "v"(w1_ & uk1), "v"(w1_ & uk2), "v"(w1_ & uk3), "v"(bb), "v"(s0_), "v"(s1_)); continue; } \
            uacc = MFMA32S(((v8i_t){(int)(w0_ & uk0), (int)(w0_ & uk1), (int)(w0_ & uk2), (int)(w0_ & uk3), 0, 0, 0, 0}), B_, uacc, s0_); \
            if (P6_DIGITS == 2) uacc = MFMA32S(((v8i_t){(int)(w1_ & uk0), (int)(w1_ & uk1), (int)(w1_ & uk2), (int)(w1_ & uk3), 0, 0, 0, 0}), B_, uacc, s1_); } } while (0)
    f32x4 gvu[4];
#pragma unroll
    for (int gq = 0; gq < 4; ++gq) gvu[gq] = *(const GAS f32x4*)(nf + 32 * ui + 4 * ug + 8 * gq);
    u32x2 xqn[4];
#define P6_UXPREF(t_) do { const bf16_t* xrow_ = (const bf16_t*)(ws + WS_X1B) + (size_t)(tok0 + (t_)) * DM + 32 * ui + 4 * ug; \
        _Pragma("unroll") for (int gq = 0; gq < 4; ++gq) xqn[gq] = *(const GAS u32x2*)(xrow_ + 8 * gq); } while (0)
#define P6_UEPI(sq_) do { const int t_ = (sq_) >> 3; \
        f32x4 x2[4]; float ss = 0.f; \
        _Pragma("unroll") for (int gq = 0; gq < 4; ++gq) { \
            const u32x2 xq_ = xqn[gq]; \
            x2[gq] = (f32x4){__uint_as_float(xq_.x << 16), __uint_as_float(xq_.x & 0xffff0000u), __uint_as_float(xq_.y << 16), __uint_as_float(xq_.y & 0xffff0000u)} \
                + (f32x4){uacc[4 * gq], uacc[4 * gq + 1], uacc[4 * gq + 2], uacc[4 * gq + 3]} * (1.0f / P6_SU4); \
            ss += (x2[gq].x * x2[gq].x + x2[gq].y * x2[gq].y) + (x2[gq].z * x2[gq].z + x2[gq].w * x2[gq].w); } \
        const float rn = 1.0f / sqrtf(wave_sum(ss) * (1.0f / DM) + EPSF);     \
          \
        _Pragma("unroll") for (int gq = 0; gq < 4; ++gq) *(LAS f32x4*)(wl + ui * 144 + 32 * gq + 16 * ug) = x2[gq] * rn * gvu[gq]; \
        _Pragma("unroll") for (int k = 0; k < 4; ++k) { const int d_ = 4 * lane_u + 256 * k; const f32x4 ov_ = *(const LAS f32x4*)(wl + (d_ >> 5) * 144 + (d_ & 31) * 4); \
            if ((P6_UPROBE & 8) && PARTS == 2) asm volatile("" :: "v"(ov_)); else *(GAS f32x4*)(a.out + (size_t)(tok0 + t_) * DM + d_) = ov_; } \
        uacc = f32x16{}; } while (0)
    if (PARTS & 2) {
        u32x4 bqA[8], bqB[8]; f32x16 uacc = f32x16{};
        if ((P6_UPROBE & 1) && PARTS == 2 && EMASK != 0xffff) {
#pragma unroll
            for (int q = 0; q < 8; ++q) { bqA[q] = (u32x4){(unsigned)lane, 1u, 2u, 3u}; bqB[q] = bqA[q]; } }
        P6_ULOAD(bqA, 0);
#pragma unroll 1
        for (int sq = 0; sq < 128; sq += 2) {
            if ((sq & 7) == 0) P6_UXPREF(sq >> 3);
            P6_ULOAD(bqB, sq + 1);
            P6_UMMA(bqA, sq);
            P6_ULOAD(bqA, (sq + 2 < 128 ? sq + 2 : sq));
            P6_UMMA(bqB, sq + 1);
            if (((sq + 1) & 7) == 7) { if ((P6_UPROBE & 4) && PARTS == 2) { asm volatile("" : "+v"(uacc)); uacc = f32x16{}; } else P6_UEPI(sq + 1); }
        }
    }
#undef P6_ULOAD
#undef P6_UMMA
#undef P6_UEPI
#undef P6_UXPREF
#undef MFMA32S
}

#ifndef MK_N_LAUNCHES
#define MK_N_LAUNCHES 1
#endif
constexpr int NPHASE = 7;

__device__ __forceinline__ int queue_next(unsigned* ctr, volatile LAS unsigned* slot) {
    __syncthreads();
    if (threadIdx.x == 0) *slot = __hip_atomic_fetch_add(ctr, 1u, __ATOMIC_RELAXED, __HIP_MEMORY_SCOPE_AGENT);
    __syncthreads();
    return (int)*slot;
}

__global__ void __launch_bounds__(NTHR, 2) hymba_fwd(Args a) {
    extern __shared__ __attribute__((aligned(16))) unsigned char lds_raw[];
    lds_u8* lds = (lds_u8*)lds_raw;
    volatile LAS unsigned* MISC = (volatile LAS unsigned*)(lds + MISC_OFF);
    const int tid = threadIdx.x, lane = tid & 63; const int wave = __builtin_amdgcn_readfirstlane(tid >> 6);
    const int G = gridDim.x; const int bx = blockIdx.x;
    const int vcu = (G % 8 == 0) ? (bx % 8) * (G / 8) + bx / 8 : bx;
    const int gw = vcu * NWAVES + wave, NGW = G * NWAVES;
    for (int u = tid; u < (LDS_BYTES - MISC_OFF) / 4; u += NTHR) MISC[u] = 0u;
    __syncthreads();
    const int lo = a.ph_lo, hi = a.ph_hi;
    const bool use_bar = (hi - lo) > 1;
    XcdBarrier bar; bar.bar = (unsigned*)(a.ws + WS_CTL); bar.x = 0; bar.st = MISC + 8;
    if (use_bar) bar = xcd_barrier_post((unsigned*)(a.ws + WS_CTL), MISC + 8);
#ifndef PH_MASK
#define PH_MASK 127
#endif
#define IN(k) (((PH_MASK >> (k)) & 1) && lo <= (k) && (k) < hi)
#ifdef DBL_BAR
#define SEAM(k) do { if (IN(k) && IN((k) + 1)) { xcd_barrier(bar); xcd_barrier(bar); } } while (0)
#else
#define SEAM(k) do { if (IN(k) && IN((k) + 1)) xcd_barrier(bar); } while (0)
#endif
    unsigned char* ws = a.ws;

    if (IN(0)) { p0_prologue(a, lds, gw, NGW, lane, wave);
#ifdef DBL_P0
        __syncthreads(); p0_prologue(a, lds, gw, NGW, lane, wave);
#endif
    }
    SEAM(0);
    if (IN(1)) {
        pg8::Gemm g{(const bf16_t*)(ws + WS_XB), (const bf16_t*)(ws + WS_WIN), MTOK, NIN, DM}; pg8::StaticOrder S; S.init(MTOK, NIN, G, bx);
        EpiProj E{(bf16_t*)(ws + WS_PROJ), (const float*)(ws + WS_R1), (const f32x4*)(ws + WS_ROPE), (const float*)(ws + WS_DECAY)};
        pg8::gemm_phase<EpiProj, pg8::StaticOrder>(lds, g, S, E);
#ifdef DBL_P1
        pg8::gemm_phase<EpiProj, pg8::StaticOrder>(lds, g, S, E);
#endif
    }
    SEAM(1);
    if (IN(2)) {
#ifdef DBL_P2
        for (int rep = 0; rep < 2; ++rep) {
        unsigned* ctr = (unsigned*)(ws + WS_CTL + CTL_Q_ATT + rep * 256);
#else
        {
        unsigned* ctr = (unsigned*)(ws + WS_CTL + CTL_Q_ATT);
#endif
        int tkt = queue_next(ctr, MISC + 16);
        for (;;) {
            int u = tkt;
            if (u >= 64 + 1024 + DEF_ITEMS / 5) break;
            static_assert(DEF_ITEMS % 5 == 0 && DEF_ITEMS / 5 == 1024 / 4, "P2 ticket pattern");
            if (u >= 64) { const int i5 = (u - 64) / 5, r5 = (u - 64) % 5;
                if (r5 == 4) {
#ifdef PROBE_P2
                    if (rep == 0 && !(PROBE_P2 & 4)) { tkt = queue_next(ctr, MISC + 16); continue; }
#endif
                    for (int k = 0; k < 5; ++k) p0_deferred(a, lds, i5 * 5 + k);
                    tkt = queue_next(ctr, MISC + 16); continue; }
                u = 64 + i5 * 4 + r5; }
#ifdef PROBE_P2
            if (rep == 0) { if (u >= 64 && (PROBE_P2 & 2)) { const int v = u - 64; attn_unit<PROBE_ATT>(a, lds, (v & 31) >> 2, v & 3, 31 - (v >> 5)); tkt = queue_next(ctr, MISC + 16); continue; }
                if (u < 64 && (PROBE_P2 & 1)) ret_unit(a, lds, u >> 3, u & 7);
                tkt = queue_next(ctr, MISC + 16); continue; }
#endif
            if (u < 64) { ret_unit(a, lds, u >> 3, u & 7); tkt = queue_next(ctr, MISC + 16); }
            else { const int v = u - 64; attn_unit<7>(a, lds, (v & 31) >> 2, v & 3, 31 - (v >> 5)); tkt = queue_next(ctr, MISC + 16); }
        }
        }
    }
    SEAM(2);
    if (IN(3)) {
        pg8::Gemm g{(const bf16_t*)(ws + WS_MIX), (const bf16_t*)(ws + WS_WOUT), MTOK, DM, DM}; pg8::StaticOrder S; S.init(MTOK, DM, G, bx);
        EpiX1 E{(const bf16_t*)(ws + WS_XB), (bf16_t*)(ws + WS_X1B), (bf16_t*)(ws + WS_SSQ)};
        pg8::gemm_phase<EpiX1, pg8::StaticOrder>(lds, g, S, E);
#ifdef DBL_P3
        pg8::gemm_phase<EpiX1, pg8::StaticOrder>(lds, g, S, E);
#endif
    }
    SEAM(3);
    if (IN(4)) {
        pg8::Gemm g{(const bf16_t*)(ws + WS_X1B), (const bf16_t*)(ws + WS_WPQ), MTOK, NQ, DM}; pg8::StaticOrder S; S.init(MTOK, NQ, G, bx);
        EpiQ E{(bf16_t*)(ws + WS_PROJ), (const bf16_t*)(ws + WS_SSQ)};
        pg8::gemm_phase<EpiQ, pg8::StaticOrder>(lds, g, S, E);
#ifdef DBL_P4
        pg8::gemm_phase<EpiQ, pg8::StaticOrder>(lds, g, S, E);
#endif
    }
    SEAM(4);
    if (IN(5)) { p5_topk(a, lds);
#ifdef DBL_P5
        p5_topk(a, lds);
#endif
    }
    SEAM(5);
    if (IN(6)) {
#ifdef P6_TOKEN_MAJOR
        lds_u8* wl = lds + wave * P6_WSCR;
        for (int tok = gw; tok < MTOK; tok += NGW) p6_token(a, wl, tok, lane, a.out);
#else
#ifdef PROBE_EMASK
        for (int tb = gw; tb < MTOK / 16; tb += NGW) p6_slices<PROBE_EMASK, PROBE_PARTS>(a, lds + wave * P6S_WAVE, tb * 16, lane);
#endif
        for (int tb = gw; tb < MTOK / 16; tb += NGW) p6_slices<0xffff, 3>(a, lds + wave * P6S_WAVE, tb * 16, lane);
#endif
    }
#ifdef DBG_DUMP
    if (hi - lo > 1) xcd_barrier(bar);
    {
        for (int m = gw; m < MTOK; m += NGW) {
            for (int c = lane; c < DM; c += 64) {
                float v = 0.f;
#if DBG_DUMP == 1
                v = bf2f(((const bf16_t*)(ws + WS_PROJ))[(size_t)m * NIN + DBG_COL + c]);
#elif DBG_DUMP == 2
                v = (c >= DBG_C0 && c < DBG_C1) ? bf2f(((const bf16_t*)(ws + WS_MIX))[(size_t)m * DM + c]) : 0.f;
#endif
                a.out[(size_t)m * DM + c] = v;
            }
        }
    }
#endif
#undef IN
#undef SEAM
}

extern "C" void kernel_launch(void* const* d_in, const int* in_sizes, int n_in, void* d_out, int out_size, void* d_ws, size_t ws_size, hipStream_t stream) {
    static int grid = 0;
    if (grid == 0) {
        if (n_in != 17 || in_sizes[0] != MTOK * DM || out_size != MTOK * DM || ws_size < WS_END) {
            fprintf(stderr, "kernel_launch: unexpected shapes (n_in %d, in0 %d, out %d, ws %zu < %zu); nothing launched\n", n_in, n_in > 0 ? in_sizes[0] : -1, out_size, ws_size, (size_t)WS_END); grid = -1; return; }
        int dev = 0, cus = 0, per_cu = 0;
        if (hipGetDevice(&dev) != hipSuccess || hipDeviceGetAttribute(&cus, hipDeviceAttributeMultiprocessorCount, dev) != hipSuccess) { fprintf(stderr, "kernel_launch: device query failed\n"); grid = -1; return; }
        if (hipFuncSetAttribute((const void*)hymba_fwd, hipFuncAttributeMaxDynamicSharedMemorySize, LDS_BYTES) != hipSuccess) { fprintf(stderr, "kernel_launch: hipFuncSetAttribute failed\n"); grid = -1; return; }
        if (hipOccupancyMaxActiveBlocksPerMultiprocessor(&per_cu, (const void*)hymba_fwd, NTHR, LDS_BYTES) != hipSuccess || per_cu < 1)
            fprintf(stderr, "kernel_launch: note: occupancy query reports %d workgroups per CU\n", per_cu);
        (void)hipGetLastError();
        grid = cus;
    }
    if (grid < 0) return;
    if (hipMemsetAsync((char*)d_ws + WS_CTL, 0, CTL_BYTES, stream) != hipSuccess) { fprintf(stderr, "kernel_launch: memset failed\n"); return; }
    Args a{};
    for (int i = 0; i < 17; ++i) a.in[i] = (const float*)d_in[i];
    a.out = (float*)d_out; a.ws = (unsigned char*)d_ws;
#if MK_N_LAUNCHES == 1
#ifdef DBG_STOP
    a.ph_lo = 0; a.ph_hi = DBG_STOP + 1;
#else
    a.ph_lo = 0; a.ph_hi = NPHASE;
#endif
    hipLaunchKernelGGL(hymba_fwd, dim3(grid), dim3(NTHR), LDS_BYTES, stream, a);
#else
    for (int p = 0; p < NPHASE; ++p) { a.ph_lo = p; a.ph_hi = p + 1; hipLaunchKernelGGL(hymba_fwd, dim3(grid), dim3(NTHR), LDS_BYTES, stream, a); }
#endif
    const hipError_t le = hipPeekAtLastError();
    if (le != hipSuccess) fprintf(stderr, "kernel_launch: launch failed: %s\n", hipGetErrorName(le));
}
```

```cpp
#include <hip/hip_runtime.h>
#include <cstdio>
#include <cstdint>

namespace pg8 {
#define PG8_LAS __attribute__((address_space(3)))
typedef unsigned short bf16_t;
typedef short bf16x8 __attribute__((ext_vector_type(8)));
typedef float f32x4 __attribute__((ext_vector_type(4)));
typedef unsigned u32x4 __attribute__((ext_vector_type(4)));
constexpr int BM = 256, BK = 64, HALF = 128, HTB = HALF * BK * 2  , STAGE_BYTES = 8 * HTB, NXCD = 8, WGM = 8;

__host__ __device__ __forceinline__ int lds_byte(int r, int c) { const int st = (r >> 4) * 2 + (c >> 5), rr = r & 15, cc = c & 31, ob = rr * 64 + cc * 2; return st * 1024 + (ob ^ (((ob >> 9) & 1) << 5)); }
__host__ __device__ __forceinline__ void stage_rc(int b, int& R, int& C) { const int st = b / 1024, sb = b % 1024, swz = sb ^ (((sb >> 9) & 1) << 5); R = (st >> 1) * 16 + swz / 64; C = (st & 1) * 32 + (swz % 64) / 2; }
__host__ __device__ __forceinline__ int perm32(int rho) { const int n = rho >> 4, i = rho & 15; return 8 * (i >> 2) + 4 * n + (i & 3); }

struct Unit { int pm, pn; };
struct Gemm { const bf16_t* A; const bf16_t* Bt; int M, N, K; };

struct StaticOrder {
    int nM, nN, nwg, G, c;
    __host__ __device__ void init(int M, int N, int G_, int c_) { nM = M / BM; nN = N / BM; nwg = nM * nN; G = G_; c = c_; }
    __host__ __device__ bool next(int i, Unit& u) const {
        const long L = (long)i * G + c; if (L >= nwg) return false;
        int wgid = (int)L; { const int q = nwg / NXCD, r = nwg % NXCD, xcd = wgid % NXCD, off = wgid / NXCD; wgid = (xcd < r ? xcd * (q + 1) : r * (q + 1) + (xcd - r) * q) + off; }
        const int nig = WGM * nN, gid = wgid / nig, fm = gid * WGM, gsz = (nM - fm) < WGM ? (nM - fm) : WGM;
        u.pm = fm + ((wgid % nig) % gsz); u.pn = (wgid % nig) / gsz; return true;
    }
    __device__ __forceinline__ void a_ready(const Unit&) const {}
    __device__ __forceinline__ void done(const Unit&) const {}
};
__device__ __forceinline__ unsigned cvt_pk_bf16(float lo, float hi) { unsigned r; asm volatile("v_cvt_pk_bf16_f32 %0, %1, %2" : "=v"(r) : "v"(lo), "v"(hi)); return r; }
template <class Epi, class Sched>
__device__ __forceinline__ void gemm_phase(PG8_LAS unsigned char* lds, const Gemm g, const Sched& S, const Epi& E) {
    const int tid = threadIdx.x, wid = __builtin_amdgcn_readfirstlane(tid >> 6), lane = tid & 63, wr = wid >> 2, wc = wid & 3, fr = lane & 15, fq = lane >> 4;
    const int K = g.K, nt = K / BK;
    unsigned voffA[2], voffB[2];
#pragma unroll
    for (int i = 0; i < 2; ++i) { int R, C; stage_rc(tid * 16 + i * 8192, R, C); const int Rb = Epi::PERM ? ((R & ~31) + perm32(R & 31)) : R;
        voffA[i] = (unsigned)(R * K + C) * 2u; voffB[i] = (unsigned)(Rb * K + C) * 2u; }
    const size_t kstep = (size_t)(BK * 2);
    const size_t hstep = (size_t)HALF * K * 2;
    const size_t tstep = 2 * hstep;
    const unsigned ldsw = (unsigned)wid * 1024u;
    const int aoff = lds_byte(wr * 64 + fr, fq * 8), boff = lds_byte(wc * 32 + fr, fq * 8);
#define PG8_SA(b, h) (((b) * 2 + (h)) * HTB)
#define PG8_SB(b, h) ((4 + (b) * 2 + (h)) * HTB)
#define PG8_STAGE(bufoff, gbase, voff) do { _Pragma("unroll") for (int _i = 0; _i < 2; ++_i) \
        __builtin_amdgcn_global_load_lds((const unsigned*)((const char*)(gbase) + (voff)[_i]), (PG8_LAS unsigned*)(lds + (bufoff) + ldsw + _i * 8192), 16, 0, 0); } while (0)
#define PG8_LDA(dst, b, h) do { _Pragma("unroll") for (int m = 0; m < 4; ++m) _Pragma("unroll") for (int k = 0; k < 2; ++k) dst[m][k] = *(const PG8_LAS bf16x8*)(lds + PG8_SA(b, h) + aoff + m * 2048 + k * 1024); } while (0)
#define PG8_LDB(dst, b, h) do { _Pragma("unroll") for (int n = 0; n < 2; ++n) _Pragma("unroll") for (int k = 0; k < 2; ++k) dst[n][k] = *(const PG8_LAS bf16x8*)(lds + PG8_SB(b, h) + boff + n * 2048 + k * 1024); } while (0)
#define PG8_MMA(ai, bj, At, Bt) do { __builtin_amdgcn_s_setprio(1); _Pragma("unroll") for (int m = 0; m < 4; ++m) _Pragma("unroll") for (int n = 0; n < 2; ++n) _Pragma("unroll") for (int k = 0; k < 2; ++k) \
        acc[ai][bj][m][n] = __builtin_amdgcn_mfma_f32_16x16x32_bf16(Bt[n][k], At[m][k], acc[ai][bj][m][n], 0, 0, 0); __builtin_amdgcn_s_setprio(0); } while (0)
#define PG8_WAIT_V(n) asm volatile("s_waitcnt vmcnt(" #n ")" ::: "memory")
#define PG8_WAIT_L(n) asm volatile("s_waitcnt lgkmcnt(" #n ")" ::: "memory")
#define PG8_BAR __builtin_amdgcn_s_barrier()
#define PG8_SCHED __builtin_amdgcn_sched_barrier(0)
    Unit cur, nxt; int ui = 0;
    if (!S.next(0, cur)) return;
    f32x4 acc[2][2][4][2];
#pragma unroll
    for (int a = 0; a < 2; ++a)
#pragma unroll
        for (int b = 0; b < 2; ++b)
#pragma unroll
            for (int m = 0; m < 4; ++m)
#pragma unroll
                for (int n = 0; n < 2; ++n) acc[a][b][m][n] = (f32x4){0.f, 0.f, 0.f, 0.f};
    bf16x8 At[4][2], B0[2][2], B1[2][2];
    const char* cA = (const char*)g.A + (size_t)cur.pm * tstep; const char* cB = (const char*)g.Bt + (size_t)cur.pn * tstep;
    S.a_ready(cur);
    PG8_STAGE(PG8_SB(0, 0), cB, voffB); PG8_STAGE(PG8_SA(0, 0), cA, voffA); PG8_STAGE(PG8_SB(0, 1), cB + hstep, voffB); PG8_STAGE(PG8_SA(0, 1), cA + hstep, voffA);
    if (wr == 1) PG8_BAR;
    PG8_WAIT_V(4); PG8_BAR;
    PG8_STAGE(PG8_SB(1, 0), cB + kstep, voffB); PG8_STAGE(PG8_SA(1, 0), cA + kstep, voffA); PG8_STAGE(PG8_SB(1, 1), cB + hstep + kstep, voffB);
    PG8_WAIT_V(6); PG8_BAR;
    for (;;) {
        const bool has_next = S.next(ui + 1, nxt);
        const char* nA = has_next ? (const char*)g.A + (size_t)nxt.pm * tstep : cA; const char* nB = has_next ? (const char*)g.Bt + (size_t)nxt.pn * tstep : cB;
        for (int t = 0; t < nt; t += 2) {
            const bool last = (t == nt - 2);
            const char* a1 = cA + (size_t)(t + 1) * kstep;
            const char* a2 = last ? nA : cA + (size_t)(t + 2) * kstep; const char* b2 = last ? nB : cB + (size_t)(t + 2) * kstep;
            const char* a3 = a2 + kstep; const char* b3 = b2 + kstep;
            if (last && has_next) S.a_ready(nxt);
            PG8_LDB(B0, 0, 0); PG8_SCHED; PG8_LDA(At, 0, 0); PG8_STAGE(PG8_SA(1, 1), a1 + hstep, voffA);
            PG8_WAIT_L(8); PG8_BAR; PG8_WAIT_L(0); PG8_MMA(0, 0, At, B0); PG8_BAR; PG8_SCHED;
            PG8_LDB(B1, 0, 1); PG8_STAGE(PG8_SB(0, 0), b2, voffB);
            PG8_BAR; PG8_WAIT_L(0); PG8_MMA(0, 1, At, B1); PG8_BAR;
            PG8_LDA(At, 0, 1); PG8_STAGE(PG8_SA(0, 0), a2, voffA);
            PG8_BAR; PG8_WAIT_L(0); PG8_MMA(1, 0, At, B0); PG8_BAR; PG8_SCHED;
            PG8_STAGE(PG8_SB(0, 1), b2 + hstep, voffB);
            PG8_WAIT_V(6); PG8_BAR; PG8_MMA(1, 1, At, B1); PG8_BAR;
            PG8_LDB(B0, 1, 0); PG8_SCHED; PG8_LDA(At, 1, 0); PG8_STAGE(PG8_SA(0, 1), a2 + hstep, voffA);
            PG8_WAIT_L(8); PG8_BAR; PG8_WAIT_L(0); PG8_MMA(0, 0, At, B0); PG8_BAR; PG8_SCHED;
            PG8_LDB(B1, 1, 1); PG8_STAGE(PG8_SB(1, 0), b3, voffB);
            PG8_BAR; PG8_WAIT_L(0); PG8_MMA(0, 1, At, B1); PG8_BAR;
            PG8_LDA(At, 1, 1); PG8_STAGE(PG8_SA(1, 0), a3, voffA);
            PG8_BAR; PG8_WAIT_L(0); PG8_MMA(1, 0, At, B0); PG8_BAR; PG8_SCHED;
            PG8_STAGE(PG8_SB(1, 1), b3 + hstep, voffB);
            PG8_WAIT_V(6); PG8_BAR; PG8_MMA(1, 1, At, B1); PG8_BAR;
        }
        if constexpr (!Epi::AFTER_DRAIN) { E(acc, cur, wr, wc, fr, fq); S.done(cur); }
        if (!has_next) break;
#pragma unroll
        for (int a = 0; a < 2; ++a)
#pragma unroll
            for (int b = 0; b < 2; ++b)
#pragma unroll
                for (int m = 0; m < 4; ++m)
#pragma unroll
                    for (int n = 0; n < 2; ++n) acc[a][b][m][n] = (f32x4){0.f, 0.f, 0.f, 0.f};
        cur = nxt; cA = nA; cB = nB; ++ui;
    }
    PG8_WAIT_V(0);
    if (wr == 0) PG8_BAR;
    PG8_BAR;
    if constexpr (Epi::AFTER_DRAIN) { E.fused(acc, cur, wr, wc, fr, fq, lds, wid, lane); S.done(cur); }
#undef PG8_SA
#undef PG8_SB
#undef PG8_STAGE
#undef PG8_LDA
#undef PG8_LDB
#undef PG8_MMA
#undef PG8_WAIT_V
#undef PG8_WAIT_L
#undef PG8_BAR
#undef PG8_SCHED
}
}

#define XB_TMO      128
#define XB_XCNT(j)  (256  + 64 * (j))
#define XB_XSUB(j)  (1280 + 64 * (j))
#define XB_XGEN(j)  (2304 + 64 * (j))
#define XB_TOP      3328
#define XB_TOPGEN   3392
#define XCD_BAR_WORDS 3456
#define XB_SPIN_CAP (1u << 18)
#define LAS __attribute__((address_space(3)))

__device__ __forceinline__ unsigned xb_ld(unsigned* p)              { return __hip_atomic_load(p, __ATOMIC_RELAXED, __HIP_MEMORY_SCOPE_AGENT); }
__device__ __forceinline__ unsigned xb_add(unsigned* p, unsigned v) { return __hip_atomic_fetch_add(p, v, __ATOMIC_RELAXED, __HIP_MEMORY_SCOPE_AGENT); }
__device__ __forceinline__ unsigned xb_xcc_id() { return (unsigned)__builtin_amdgcn_s_getreg((3 << 11) | 20) & 0xFu; }
#define XB_SPIN(cond, bar) do { unsigned _sp = 0; while (cond) { __builtin_amdgcn_s_sleep(1); \
    if ((++_sp & 255u) == 0u) { if (xb_ld(&(bar)[XB_TMO])) break; if (_sp > XB_SPIN_CAP) { atomicAdd(&(bar)[XB_TMO], 1u); break; } } } } while (0)

struct XcdBarrier {
    unsigned* bar; unsigned x;
    volatile LAS unsigned* st;
};

__device__ __forceinline__ XcdBarrier xcd_barrier_post(unsigned* bar, volatile LAS unsigned* st) {
    XcdBarrier b; b.bar = bar; b.x = xb_xcc_id(); b.st = st;
    if (threadIdx.x == 0) (void)xb_add(&bar[XB_XCNT(b.x)], 1u);
    return b;
}
__device__ __forceinline__ void xcd_barrier_complete(unsigned* bar, unsigned x, unsigned& nloc, unsigned& nx) {
    const unsigned G = gridDim.x * gridDim.y * gridDim.z;
    unsigned sum, cnt, mine, sp = 0u;
    for (;;) {
        sum = 0u; cnt = 0u; mine = 0u;
#pragma unroll
        for (unsigned j = 0; j < 16; ++j) { const unsigned c = xb_ld(&bar[XB_XCNT(j)]); sum += c; cnt += (c > 0u) ? 1u : 0u; mine = (j == x) ? c : mine; }
        if (sum == G) break;
        __builtin_amdgcn_s_sleep(1);
        if ((++sp & 255u) == 0u) { if (xb_ld(&bar[XB_TMO])) break; if (sp > XB_SPIN_CAP) { atomicAdd(&bar[XB_TMO], 1u); break; } }
    }
    nloc = mine > 0u ? mine : 1u; nx = cnt > 0u ? cnt : 1u;
}

__device__ __forceinline__ void xcd_barrier(const XcdBarrier& b) {
    asm volatile("s_waitcnt vmcnt(0)" ::: "memory");
    __syncthreads();
    if (threadIdx.x == 0) {
        unsigned* bar = b.bar;
        __builtin_amdgcn_s_waitcnt(0);
        unsigned nloc = b.st[0], nx = b.st[1];
        if (nloc == 0u) { xcd_barrier_complete(bar, b.x, nloc, nx); b.st[0] = nloc; b.st[1] = nx; }
        const unsigned old = xb_add(&bar[XB_XSUB(b.x)], 1u);
        const unsigned gen = old / nloc;
        if (old + 1u == (gen + 1u) * nloc) {
            __builtin_amdgcn_fence(__ATOMIC_RELEASE, "agent");
            asm volatile("s_waitcnt vmcnt(0)" ::: "memory");
            const unsigned og = xb_add(&bar[XB_TOP], 1u);
            const unsigned tg = og / nx;
            if (og + 1u == (tg + 1u) * nx) xb_add(&bar[XB_TOPGEN], 1u);
            else XB_SPIN(xb_ld(&bar[XB_TOPGEN]) == tg, bar);
            __builtin_amdgcn_fence(__ATOMIC_ACQUIRE, "agent");
            xb_add(&bar[XB_XGEN(b.x)], 1u);
            asm volatile("s_waitcnt vmcnt(0)" ::: "memory");
        } else {
            XB_SPIN(xb_ld(&bar[XB_XGEN(b.x)]) == gen, bar);
            __builtin_amdgcn_fence(__ATOMIC_ACQUIRE, "agent");
            asm volatile("s_waitcnt vmcnt(0)" ::: "memory");
        }
    }
    __syncthreads();
}

#define GAS __attribute__((address_space(1)))
typedef unsigned short bf16_t;
typedef short bf16x8 __attribute__((ext_vector_type(8)));
typedef short s16x4 __attribute__((ext_vector_type(4)));
typedef float f32x4 __attribute__((ext_vector_type(4)));
typedef float f32x2 __attribute__((ext_vector_type(2)));
typedef float f32x16 __attribute__((ext_vector_type(16)));
typedef unsigned u32x4 __attribute__((ext_vector_type(4)));
typedef unsigned u32x2 __attribute__((ext_vector_type(2)));
typedef LAS unsigned char lds_u8;

constexpr int MTOK = 32768, DM = 1024, SEQ = 4096, NBATCH = 8, NIN = 3584;
constexpr int OFF_RQ = 0, OFF_RK = 512, OFF_RV = 1024, OFF_RG = 1536, OFF_DQ = 2048, OFF_DK = 2560, OFF_DV = 3072;
constexpr int NEXP = 16384, NQ = 2048;
constexpr float EPSF = 1e-6f, LOG2E = 1.4426950408889634f;
constexpr int NWAVES = 8, NTHR = 512;

constexpr size_t WS_CTL = 0, CTL_BYTES = 65536;
constexpr size_t CTL_Q_ATT = 16384, CTL_Q_P6 = 16384 + 1024;
constexpr size_t WS_R1 = WS_CTL + CTL_BYTES;
constexpr size_t WS_SSQ = WS_R1 + (size_t)MTOK * 4;
constexpr size_t WS_ROPE = WS_SSQ + (size_t)MTOK * 16 * 4;
constexpr size_t WS_DECAY = WS_ROPE + (size_t)SEQ * 32 * 8;
constexpr size_t WS_BTAB = WS_DECAY + 2 * 8 * 128 * 4;
constexpr size_t WS_LAM = WS_BTAB + 4 * 128 * 4;
constexpr size_t WS_WIN = 4u << 20;
constexpr size_t WS_WOUT = WS_WIN + (size_t)NIN * DM * 2;
constexpr size_t WS_WPQ = WS_WOUT + (size_t)DM * DM * 2;
constexpr size_t WS_KEYS = WS_WPQ + (size_t)NQ * DM * 2;
constexpr size_t WS_WD = WS_KEYS + (size_t)8 * 2 * 128 * 128 * 2;
constexpr size_t WS_WU = WS_WD + (size_t)NEXP * DM * 2;
constexpr size_t WS_XB = WS_WU + (size_t)NEXP * DM * 2;
constexpr size_t WS_PROJ = WS_XB + (size_t)MTOK * DM * 2;
constexpr size_t WS_MIX = WS_PROJ + (size_t)MTOK * NIN * 2;
constexpr size_t WS_IDX = WS_MIX, WS_GATE = WS_MIX + (size_t)MTOK * 128 * 4;
constexpr size_t WS_X1B = WS_PROJ + (size_t)MTOK * NQ * 2;
static_assert(WS_X1B + (size_t)MTOK * DM * 2 <= WS_MIX, "ws map");
constexpr size_t WS_END = WS_MIX + (size_t)MTOK * DM * 2;
static_assert(WS_LAM + 256 <= WS_WIN, "ws map");
static_assert(WS_END <= (size_t)512 << 20, "ws map");

constexpr int LDS_SCRATCH = 139264;
constexpr int MISC_OFF = LDS_SCRATCH;
constexpr int LDS_BYTES = 147456;

__device__ __forceinline__ float wave_sum(float v) {
    v += __uint_as_float(__builtin_amdgcn_update_dpp(0u, __float_as_uint(v), 0xB1, 0xf, 0xf, true));
    v += __uint_as_float(__builtin_amdgcn_update_dpp(0u, __float_as_uint(v), 0x4E, 0xf, 0xf, true));
    v += __uint_as_float(__builtin_amdgcn_update_dpp(0u, __float_as_uint(v), 0x141, 0xf, 0xf, true));
    v += __uint_as_float(__builtin_amdgcn_update_dpp(0u, __float_as_uint(v), 0x140, 0xf, 0xf, true));
    { auto rr = __builtin_amdgcn_permlane16_swap(__float_as_uint(v), __float_as_uint(v), false, false); v = __uint_as_float(rr[0]) + __uint_as_float(rr[1]); }
    { auto rr = __builtin_amdgcn_permlane32_swap(__float_as_uint(v), __float_as_uint(v), false, false); v = __uint_as_float(rr[0]) + __uint_as_float(rr[1]); }
    return v;
}
typedef __bf16 bf16v2_t __attribute__((ext_vector_type(2)));
__device__ __forceinline__ unsigned pk2(float lo, float hi) { const bf16v2_t v = {(__bf16)lo, (__bf16)hi}; return __builtin_bit_cast(unsigned, v); }
__device__ __forceinline__ float bf2f(unsigned short b) { return __uint_as_float(((unsigned)b) << 16); }
#define LDS_WAIT() asm volatile("s_waitcnt lgkmcnt(0)" ::: "memory")
#define VM_WAIT() asm volatile("s_waitcnt vmcnt(0)" ::: "memory")

struct Args {
    const float* in[17]; float* out; unsigned char* ws; int ph_lo, ph_hi;
};

template <int MODE>
__device__ __forceinline__ void p0_transpose_item(const float* W, const float* scale, int K, int N, bf16_t* WT, LAS float* scr, int item, int lane) {
    const int nblk = N / 32, kb = item / nblk, nb = item % nblk, k0 = 64 * kb, n0 = 32 * nb;
#pragma unroll 8
    for (int i = 0; i < 32; ++i) { const int kk = 2 * i + (lane >> 5); const float sc = scale ? scale[k0 + kk] : 1.0f; scr[kk * 33 + (lane & 31)] = __builtin_nontemporal_load((const GAS float*)(W + (size_t)(k0 + kk) * N + n0 + (lane & 31))) * sc; }
    LDS_WAIT();
    const int c = lane & 7;
#pragma unroll
    for (int j = 0; j < 4; ++j) { const int n = (lane >> 3) + 8 * j; const LAS float* s = scr + (8 * c) * 33 + n;
        u32x4 o; o.x = pk2(s[0 * 33], s[1 * 33]); o.y = pk2(s[2 * 33], s[3 * 33]); o.z = pk2(s[4 * 33], s[5 * 33]); o.w = pk2(s[6 * 33], s[7 * 33]);
        int nn = n0 + n;
        if (MODE == 1 && nn < 1024) { const int d = nn & 63; nn = (nn & ~63) + ((d < 32) ? 2 * d : 2 * (d - 32) + 1); }
        *(GAS u32x4*)(WT + (size_t)nn * K + k0 + 8 * c) = o; }
    LDS_WAIT();
}

__device__ __forceinline__ int t5_bucket(int n) {
    if (n < 16) return n;
    const float v = logf((float)n / 16.0f) / 2.0794415416798357f * 16.0f;
    int b = 16 + (int)v; return b > 31 ? 31 : b;
}

__device__ __forceinline__ void p0_prologue(const Args& a, lds_u8* lds, int gw, int NGW, int lane, int wave) {
    unsigned char* ws = a.ws;
    const float* x = a.in[0];
    bf16_t* xb = (bf16_t*)(ws + WS_XB); float* r1 = (float*)(ws + WS_R1);
    for (int m0 = gw; m0 < MTOK; m0 += 4 * NGW) {
        f32x4 v[4][4];
#pragma unroll
        for (int r = 0; r < 4; ++r) { const int m = m0 + r * NGW; const GAS f32x4* xr = (const GAS f32x4*)(x + (size_t)(m < MTOK ? m : m0) * DM) + lane;
#pragma unroll
            for (int j = 0; j < 4; ++j) v[r][j] = __builtin_nontemporal_load(xr + 64 * j); }
#pragma unroll
        for (int r = 0; r < 4; ++r) { const int m = m0 + r * NGW; if (m >= MTOK) break;
            float s = 0.f;
#pragma unroll
            for (int j = 0; j < 4; ++j) s += (v[r][j].x * v[r][j].x + v[r][j].y * v[r][j].y) + (v[r][j].z * v[r][j].z + v[r][j].w * v[r][j].w);
            s = wave_sum(s);
            GAS u32x2* o8 = (GAS u32x2*)(xb + (size_t)m * DM) + lane;
#pragma unroll
            for (int j = 0; j < 4; ++j) { u32x2 o; o.x = pk2(v[r][j].x, v[r][j].y); o.y = pk2(v[r][j].z, v[r][j].w); o8[64 * j] = o; }
            if (lane == 0) r1[m] = 1.0f / sqrtf(s * (1.0f / DM) + EPSF); }
    }
    {
        LAS float* scr = (LAS float*)(lds + wave * 8704);
        constexpr int I_IN = (DM / 64) * (NIN / 32);
        for (int it = gw; it < I_IN; it += NGW) p0_transpose_item<1>(a.in[2], a.in[1], DM, NIN, (bf16_t*)(ws + WS_WIN), scr, it, lane);
    }
    const int gt = gw * 64 + lane, NGT = NGW * 64;
    {
        f32x2* rope = (f32x2*)(ws + WS_ROPE);
        for (int i = gt; i < SEQ * 32; i += NGT) { const int pos = i >> 5, j = i & 31; const float fr = (float)pow(10000.0, -(double)j / 32.0); const float ang = (float)pos * fr;
            rope[i] = (f32x2){(float)cos((double)ang), (float)sin((double)ang)}; }
        float* dec = (float*)(ws + WS_DECAY);
        for (int i = gt; i < 2 * 8 * 128; i += NGT) { const int l = i & 127, h = (i >> 7) & 7, kk = i >> 10; const double lg = log2(1.0 - exp2(-5.0 - (double)h));
            dec[i] = kk ? (float)(0.125 * exp2(-lg * (double)l)) : (float)exp2(lg * (double)l); }
        float* bt = (float*)(ws + WS_BTAB); const float* rb = a.in[9];
        for (int i = gt; i < 4 * 128; i += NGT) { const int n = i & 127, h = i >> 7; bt[i] = rb[t5_bucket(n) * 4 + h] * LOG2E; }
        if (gt == 0) { float s1 = 0.f, s2 = 0.f; for (int i = 0; i < 64; ++i) { s1 += a.in[4][i] * a.in[5][i]; s2 += a.in[6][i] * a.in[7][i]; }
            ((float*)(ws + WS_LAM))[0] = expf(s1) - expf(s2) + 0.2f; }
    }
}


constexpr int DEF_T0 = 192, DEF_T1 = 64, DEF_T2 = 512, DEF_T3 = 512, DEF_ITEMS = DEF_T0 + DEF_T1 + DEF_T2 + DEF_T3;
__device__ __forceinline__ void p0_deferred(const Args& a, lds_u8* lds, int item) {
    unsigned char* ws = a.ws;
    int tid_ = threadIdx.x; asm volatile("" : "+v"(tid_));
    const int tid = tid_, lane = tid & 63; const int wave = __builtin_amdgcn_readfirstlane(tid >> 6);
    if (item < DEF_T0) {
        LAS float* scr = (LAS float*)(lds + wave * 8704);
        constexpr int I_OUT = (DM / 64) * (DM / 32), I_PQ = (DM / 64) * (NQ / 32);
        static_assert(I_OUT + I_PQ == DEF_T0 * 8, "deferred transposes");
        const int r = item * 8 + wave;
        if (r < I_OUT) p0_transpose_item<0>(a.in[10], nullptr, DM, DM, (bf16_t*)(ws + WS_WOUT), scr, r, lane);
        else p0_transpose_item<0>(a.in[12], a.in[11], DM, NQ, (bf16_t*)(ws + WS_WPQ), scr, r - I_OUT, lane);
        return;
    }
    item -= DEF_T0;
    if (item < DEF_T1) {
        const float* pk = a.in[13]; bf16_t* kb = (bf16_t*)(ws + WS_KEYS);
        const int i = item * 512 + tid;
        const GAS f32x4* s = (const GAS f32x4*)(pk + (size_t)i * 8); const f32x4 p = __builtin_nontemporal_load(s), q = __builtin_nontemporal_load(s + 1);
        u32x4 o; o.x = pk2(p.x, p.y); o.y = pk2(p.z, p.w); o.z = pk2(q.x, q.y); o.w = pk2(q.z, q.w); *(GAS u32x4*)(kb + (size_t)i * 8) = o;
        return;
    }
    item -= DEF_T1;
    const float* dn = a.in[14]; const float* up = a.in[15]; const float* gf = a.in[11];
    unsigned char* wd = ws + WS_WD; unsigned char* wu = ws + WS_WU;
    const bool isup = item < DEF_T2; if (!isup) item -= DEF_T2;
    const float* src = (isup ? up : dn) + (size_t)(item * 32 + wave * 4) * DM + lane * 4;
    f32x4 g[4];
#pragma unroll
    for (int k = 0; k < 4; ++k) g[k] = isup ? (f32x4){6.0f, 6.0f, 6.0f, 6.0f} : *(const GAS f32x4*)(gf + k * 256 + lane * 4) * 64.0f;
    f32x4 v[4][4];
#pragma unroll
    for (int r = 0; r < 4; ++r)
#pragma unroll
        for (int k = 0; k < 4; ++k) v[r][k] = __builtin_nontemporal_load((const GAS f32x4*)(src + (size_t)r * DM + k * 256));
#pragma unroll
    for (int r = 0; r < 4; ++r) {
        const int e = item * 32 + wave * 4 + r;
#pragma unroll
        for (int k = 0; k < 4; ++k) {
            const f32x4 p = v[r][k] * g[k];
            unsigned w = __builtin_amdgcn_cvt_scalef32_pk_fp4_f32(0u, p.x, p.y, 1.0f, 0);
            w = __builtin_amdgcn_cvt_scalef32_pk_fp4_f32(w, p.z, p.w, 1.0f, 1);
            unsigned char* dst = isup ? wu + (size_t)e * 512 + k * 128 + lane * 2 : wd + (size_t)k * ((size_t)NEXP * 128) + (size_t)e * 128 + lane * 2;
            *(GAS unsigned short*)dst = (unsigned short)w;
        }
    }
}

__device__ __forceinline__ f32x4 bf4_lo(u32x4 w) { return (f32x4){__uint_as_float(w.x << 16), __uint_as_float(w.x & 0xffff0000u), __uint_as_float(w.y << 16), __uint_as_float(w.y & 0xffff0000u)}; }
__device__ __forceinline__ f32x4 bf4_hi(u32x4 w) { return (f32x4){__uint_as_float(w.z << 16), __uint_as_float(w.z & 0xffff0000u), __uint_as_float(w.w << 16), __uint_as_float(w.w & 0xffff0000u)}; }
struct EpiProj {
    static constexpr bool PERM = true, AFTER_DRAIN = false;
    bf16_t* P; const float* r1; const f32x4* rope; const float* decay;
    __device__ __forceinline__ void operator()(const f32x4 (&acc)[2][2][4][2], const pg8::Unit& u, int wr, int wc, int fr, int fq) const {
        const int row0 = u.pm * 256 + wr * 64 + fr, seg = u.pn >> 1;
        float rsv[2][4];
#pragma unroll
        for (int ai = 0; ai < 2; ++ai)
#pragma unroll
            for (int m = 0; m < 4; ++m) rsv[ai][m] = *(const GAS float*)(r1 + row0 + ai * 128 + m * 16);
        if (seg <= 1) {
#pragma unroll
            for (int ai = 0; ai < 2; ++ai) {
                f32x4 ra[4][2], rb[4][2]; float ff[4][2];
#pragma unroll
                for (int m = 0; m < 4; ++m)
#pragma unroll
                    for (int bj = 0; bj < 2; ++bj) {
                        const int row = row0 + ai * 128 + m * 16, c0 = u.pn * 256 + bj * 128 + wc * 32 + 8 * fq;
                        const int pos = row & (SEQ - 1), l = row & 127, head = (c0 & 511) >> 6, jb = (c0 & 63) >> 1;
                        const GAS f32x4* rp = (const GAS f32x4*)rope + ((size_t)pos * 32 + jb) / 2; ra[m][bj] = rp[0]; rb[m][bj] = rp[1];
                        ff[m][bj] = *(const GAS float*)(decay + (seg * 8 + head) * 128 + l);
                    }
#pragma unroll
                for (int m = 0; m < 4; ++m)
#pragma unroll
                    for (int bj = 0; bj < 2; ++bj) {
                        const int row = row0 + ai * 128 + m * 16, c0 = u.pn * 256 + bj * 128 + wc * 32 + 8 * fq;
                        const f32x4 v0 = acc[ai][bj][m][0] * rsv[ai][m], v1 = acc[ai][bj][m][1] * rsv[ai][m];
                        const f32x4 a_ = ra[m][bj], b_ = rb[m][bj]; const float f = ff[m][bj];
                        f32x4 w0, w1;
                        w0.x = (v0.x * a_.x - v0.y * a_.y) * f; w0.y = (v0.y * a_.x + v0.x * a_.y) * f;
                        w0.z = (v0.z * a_.z - v0.w * a_.w) * f; w0.w = (v0.w * a_.z + v0.z * a_.w) * f;
                        w1.x = (v1.x * b_.x - v1.y * b_.y) * f; w1.y = (v1.y * b_.x + v1.x * b_.y) * f;
                        w1.z = (v1.z * b_.z - v1.w * b_.w) * f; w1.w = (v1.w * b_.z + v1.z * b_.w) * f;
                        u32x4 w; w.x = pk2(w0.x, w0.y); w.y = pk2(w0.z, w0.w); w.z = pk2(w1.x, w1.y); w.w = pk2(w1.z, w1.w);
                        *(GAS u32x4*)(P + (size_t)row * NIN + c0) = w;
                    }
            }
        } else {
#pragma unroll
            for (int ai = 0; ai < 2; ++ai)
#pragma unroll
                for (int m = 0; m < 4; ++m)
#pragma unroll
                    for (int bj = 0; bj < 2; ++bj) {
                        const int row = row0 + ai * 128 + m * 16, c0 = u.pn * 256 + bj * 128 + wc * 32 + 8 * fq;
                        f32x4 v0 = acc[ai][bj][m][0] * rsv[ai][m], v1 = acc[ai][bj][m][1] * rsv[ai][m];
                        if (seg == 3) {
#pragma unroll
                            for (int j = 0; j < 4; ++j) { v0[j] = v0[j] / (1.0f + __expf(-v0[j])); v1[j] = v1[j] / (1.0f + __expf(-v1[j])); }
                        } else if (seg == 4) { v0 = v0 * (0.125f * LOG2E); v1 = v1 * (0.125f * LOG2E); }
                        u32x4 w; w.x = pk2(v0.x, v0.y); w.y = pk2(v0.z, v0.w); w.z = pk2(v1.x, v1.y); w.w = pk2(v1.z, v1.w);
                        *(GAS u32x4*)(P + (size_t)row * NIN + c0) = w;
                    }
        }
    }
};
struct EpiX1 {
    static constexpr bool PERM = true, AFTER_DRAIN = false;
    const bf16_t* XB; bf16_t* X1B; bf16_t* ssq;
    __device__ __forceinline__ void operator()(const f32x4 (&acc)[2][2][4][2], const pg8::Unit& u, int wr, int wc, int fr, int fq) const {
        const int row0 = u.pm * 256 + wr * 64 + fr, c00 = u.pn * 256 + wc * 32 + 8 * fq;
        u32x4 xin[2][4][2];
#pragma unroll
        for (int ai = 0; ai < 2; ++ai)
#pragma unroll
            for (int m = 0; m < 4; ++m)
#pragma unroll
                for (int bj = 0; bj < 2; ++bj) xin[ai][m][bj] = *(const GAS u32x4*)(XB + (size_t)(row0 + ai * 128 + m * 16) * DM + c00 + bj * 128);
#pragma unroll
        for (int ai = 0; ai < 2; ++ai)
#pragma unroll
            for (int m = 0; m < 4; ++m) {
                const int row = row0 + ai * 128 + m * 16; float ss = 0.f;
#pragma unroll
                for (int bj = 0; bj < 2; ++bj) {
                    const f32x4 o0 = acc[ai][bj][m][0] + bf4_lo(xin[ai][m][bj]), o1 = acc[ai][bj][m][1] + bf4_hi(xin[ai][m][bj]);
                    u32x4 w; w.x = pk2(o0.x, o0.y); w.y = pk2(o0.z, o0.w); w.z = pk2(o1.x, o1.y); w.w = pk2(o1.z, o1.w);
                    *(GAS u32x4*)(X1B + (size_t)row * DM + c00 + bj * 128) = w;
                    ss += ((o0.x * o0.x + o0.y * o0.y) + (o0.z * o0.z + o0.w * o0.w)) + ((o1.x * o1.x + o1.y * o1.y) + (o1.z * o1.z + o1.w * o1.w));
                }
                ss += __shfl_xor(ss, 16); ss += __shfl_xor(ss, 32);
                if (fq == 0) *(GAS bf16_t*)(ssq + (size_t)row * 16 + u.pn * 4 + wc) = (bf16_t)(pk2(ss, 0.f) & 0xffffu);
            }
    }
};
__device__ __forceinline__ float rs2_from(u32x4 a, u32x4 b) {
    const f32x4 p = bf4_lo(a) + bf4_hi(a) + bf4_lo(b) + bf4_hi(b);
    return 1.0f / sqrtf(((p.x + p.y) + (p.z + p.w)) * (1.0f / DM) + EPSF);
}
__device__ __forceinline__ float row_rs2(const bf16_t* ssq, int row) {
    const GAS u32x4* p = (const GAS u32x4*)(ssq + (size_t)row * 16); return rs2_from(p[0], p[1]);
}
struct EpiQ {
    static constexpr bool PERM = true, AFTER_DRAIN = false;
    bf16_t* Q; const bf16_t* ssq;
    __device__ __forceinline__ void operator()(const f32x4 (&acc)[2][2][4][2], const pg8::Unit& u, int wr, int wc, int fr, int fq) const {
        const int row0 = u.pm * 256 + wr * 64 + fr;
        u32x4 sa[2][4], sb[2][4];
#pragma unroll
        for (int ai = 0; ai < 2; ++ai)
#pragma unroll
            for (int m = 0; m < 4; ++m) { const GAS u32x4* p = (const GAS u32x4*)(ssq + (size_t)(row0 + ai * 128 + m * 16) * 16); sa[ai][m] = p[0]; sb[ai][m] = p[1]; }
#pragma unroll
        for (int ai = 0; ai < 2; ++ai)
#pragma unroll
            for (int m = 0; m < 4; ++m) {
                const int row = row0 + ai * 128 + m * 16; const float rs = rs2_from(sa[ai][m], sb[ai][m]);
#pragma unroll
                for (int bj = 0; bj < 2; ++bj) {
                    const int c0 = u.pn * 256 + bj * 128 + wc * 32 + 8 * fq;
                    const f32x4 v0 = acc[ai][bj][m][0] * rs, v1 = acc[ai][bj][m][1] * rs;
                    u32x4 w; w.x = pk2(v0.x, v0.y); w.y = pk2(v0.z, v0.w); w.z = pk2(v1.x, v1.y); w.w = pk2(v1.z, v1.w);
                    *(GAS u32x4*)(Q + (size_t)row * NQ + c0) = w;
                }
            }
    }
};

#define MFMA32(a, b, c) __builtin_amdgcn_mfma_f32_32x32x16_bf16(a, b, c, 0, 0, 0)
typedef short v4i16_t __attribute__((ext_vector_type(4)));
__device__ __forceinline__ s16x4 vtr(const lds_u8* p) { return __builtin_bit_cast(s16x4, __builtin_amdgcn_ds_read_tr16_b64_v4i16((LAS v4i16_t*)p)); }
__device__ __forceinline__ bf16x8 vfrag(const lds_u8* p) { const s16x4 lo = vtr(p), hi = vtr(p + 512); return (bf16x8){lo[0], lo[1], lo[2], lo[3], hi[0], hi[1], hi[2], hi[3]}; }
__device__ __forceinline__ bf16x8 ldsb128(const lds_u8* p) { return *(const LAS bf16x8*)p; }
__device__ __forceinline__ int crow(int r, int hi) { return (r & 3) + 8 * (r >> 2) + 4 * hi; }
__device__ __forceinline__ void glds16(const void* g, lds_u8* l) {
    unsigned sv; const unsigned lb = (unsigned)__builtin_amdgcn_readfirstlane((int)(unsigned)(uintptr_t)l);
    asm volatile("s_mov_b32 %0, m0\n\ts_mov_b32 m0, %2\n\ts_nop 0\n\tglobal_load_lds_dwordx4 %1, off\n\ts_mov_b32 m0, %0" : "=&s"(sv) : "v"(g), "s"(lb) : "memory");
}
__device__ __forceinline__ float swap_sum(float v) { auto rr = __builtin_amdgcn_permlane32_swap(__float_as_uint(v), __float_as_uint(v), false, false); return __uint_as_float(rr[0]) + __uint_as_float(rr[1]); }
__device__ __forceinline__ float swap_max(float v) { auto rr = __builtin_amdgcn_permlane32_swap(__float_as_uint(v), __float_as_uint(v), false, false); return __builtin_fmaxf(__uint_as_float(rr[0]), __uint_as_float(rr[1])); }

constexpr int ATT_SLOT = 32768, ATT_XCH = 65536, ATT_XPITCH = 528, ATT_BTAB = ATT_XCH + 128 * ATT_XPITCH;
static_assert(ATT_BTAB + 512 <= LDS_SCRATCH, "attention LDS");

template <int MODE>
__device__ __forceinline__ void attn_unit(const Args& a, lds_u8* lds, int b, int h, int qb) {
    int tid_ = threadIdx.x; asm volatile("" : "+v"(tid_));
    const int tid = tid_, lane = tid & 63, r32 = lane & 31, hi = lane >> 5; const int wid = __builtin_amdgcn_readfirstlane(tid >> 6);
    const int rgp = wid & 3, map = wid >> 2;
    const bf16_t* proj = (const bf16_t*)(a.ws + WS_PROJ);
    const size_t rowbase = (size_t)b * SEQ; const int q0 = qb * 128, NT = 2 * qb + 2;
    const float lam = ((const float*)(a.ws + WS_LAM))[0];
    if (tid < 128) ((LAS float*)(lds + ATT_BTAB))[tid] = ((const float*)(a.ws + WS_BTAB))[h * 128 + tid];
    bf16x8 qf[4];
    { const bf16_t* qp = proj + (rowbase + q0 + rgp * 32 + r32) * NIN + OFF_DQ + h * 128 + map * 64 + hi * 8;
#pragma unroll
      for (int s = 0; s < 4; ++s) qf[s] = *(const GAS bf16x8*)(qp + s * 16); }
    asm volatile("" : "+v"(qf[0]), "+v"(qf[1]), "+v"(qf[2]), "+v"(qf[3]));
    const int krow = 8 * wid + (lane >> 3);
    const bf16_t* k1src = proj + (rowbase + krow) * NIN + OFF_DK + h * 128 + ((lane & 7) ^ ((krow >> 1) & 7)) * 8;
    const bf16_t* k2src = k1src + 64;
    const bf16_t* vsrc0 = proj + (rowbase + 16 * ((2 * wid) & 3) + (lane >> 2)) * NIN + OFF_DV + h * 128 + 32 * ((2 * wid) >> 2) + (lane & 3) * 8;
    const bf16_t* vsrc1 = proj + (rowbase + 16 * ((2 * wid + 1) & 3) + (lane >> 2)) * NIN + OFF_DV + h * 128 + 32 * ((2 * wid + 1) >> 2) + (lane & 3) * 8;
#define ATT_DMA(t, slot) do { const size_t go = (size_t)(t) * 64 * NIN; lds_u8* sb = lds + (slot) * ATT_SLOT; \
        glds16(k1src + go, sb + wid * 1024); glds16(k2src + go, sb + 8192 + wid * 1024); \
        glds16(vsrc0 + go, sb + 16384 + (2 * wid) * 1024); glds16(vsrc1 + go, sb + 16384 + (2 * wid + 1) * 1024); } while (0)
    const int koff = map * 8192 + r32 * 128, ksw = (r32 >> 1) & 7;
    const int voff = 16384 + ((lane >> 4) & 1) * 32 + (lane & 3) * 8 + (4 * hi + ((lane & 15) >> 2)) * 64;
    f32x16 o[4];
#pragma unroll
    for (int d = 0; d < 4; ++d) o[d] = f32x16{};
    float mrun = -INFINITY, lrun = 0.f;
    const int qpos = q0 + rgp * 32 + r32;
    float b31 = ((const float*)(a.ws + WS_BTAB))[h * 128 + 127]; asm volatile("" : "+v"(b31));
    ATT_DMA(0, 0);
    for (int t = 0; t < NT; ++t) {
        if (!(MODE & 32) || t < 2) { VM_WAIT(); __syncthreads(); }
        if (t + 1 < NT && (!(MODE & 8) || t + 1 < 2)) ATT_DMA(t + 1, (t + 1) & 1);
        if (64 * t > q0 + rgp * 32 + 31) continue;
        const lds_u8* sb = lds + (t & 1) * ATT_SLOT;
        const bool nearT = (64 * t + 176 > q0);
        const float cb = nearT ? 0.f : b31;
        f32x16 sA, sB;
        { const float c0 = (t == 0) ? 0.f : cb - mrun;
#pragma unroll
          for (int r = 0; r < 16; ++r) { sA[r] = c0; sB[r] = c0; } }
        if (MODE & 1) {
            bf16x8 kf[8];
#pragma unroll
            for (int d0 = 0; d0 < 4; ++d0) { const int kc = koff + (((2 * d0 + hi) ^ ksw) << 4); if (MODE & 16) { kf[2 * d0] = qf[d0]; kf[2 * d0 + 1] = qf[3 - d0]; } else { kf[2 * d0] = ldsb128(sb + kc); kf[2 * d0 + 1] = ldsb128(sb + kc + 4096); } }
            __builtin_amdgcn_sched_group_barrier(0x100, 8, 0);
#pragma unroll
            for (int d0 = 0; d0 < 4; ++d0) { sA = MFMA32(kf[2 * d0], qf[d0], sA); sB = MFMA32(kf[2 * d0 + 1], qf[d0], sB); }
            __builtin_amdgcn_sched_group_barrier(0x8, 8, 0);
        }
        if (!(MODE & 1)) asm volatile("" : "+v"(sA), "+v"(sB));
        if (MODE & 4) {
        if (nearT) {
            const LAS float* bt = (const LAS float*)(lds + ATT_BTAB);
            float bA[16], bB[16];
#pragma unroll
            for (int r = 0; r < 16; ++r) { const int d0 = qpos - (64 * t + crow(r, hi)), d1 = d0 - 32;
                bA[r] = bt[d0 < 0 ? 0 : (d0 > 127 ? 127 : d0)]; bB[r] = bt[d1 < 0 ? 0 : (d1 > 127 ? 127 : d1)]; }
            asm volatile("" : "+v"(bA[0]), "+v"(bA[1]), "+v"(bA[2]), "+v"(bA[3]), "+v"(bA[4]), "+v"(bA[5]), "+v"(bA[6]), "+v"(bA[7]), "+v"(bA[8]), "+v"(bA[9]), "+v"(bA[10]), "+v"(bA[11]), "+v"(bA[12]), "+v"(bA[13]), "+v"(bA[14]), "+v"(bA[15]));
            asm volatile("" : "+v"(bB[0]), "+v"(bB[1]), "+v"(bB[2]), "+v"(bB[3]), "+v"(bB[4]), "+v"(bB[5]), "+v"(bB[6]), "+v"(bB[7]), "+v"(bB[8]), "+v"(bB[9]), "+v"(bB[10]), "+v"(bB[11]), "+v"(bB[12]), "+v"(bB[13]), "+v"(bB[14]), "+v"(bB[15]));
#pragma unroll
            for (int r = 0; r < 16; ++r) { const int d0 = qpos - (64 * t + crow(r, hi)), d1 = d0 - 32;
                sA[r] = d0 < 0 ? -INFINITY : sA[r] + bA[r]; sB[r] = d1 < 0 ? -INFINITY : sB[r] + bB[r]; }
        }
#define MX3(a_, b_, c_) __builtin_fmaxf(__builtin_fmaxf((a_), (b_)), (c_))
        float mxa = MX3(sA[0], sA[1], sB[0]), mxb = MX3(sA[2], sA[3], sB[1]); mxa = MX3(mxa, sB[2], sB[3]);
#pragma unroll
        for (int r = 4; r < 16; r += 4) { mxa = MX3(mxa, sA[r], sA[r + 1]); mxb = MX3(mxb, sA[r + 2], sA[r + 3]); mxa = MX3(mxa, sB[r], sB[r + 1]); mxb = MX3(mxb, sB[r + 2], sB[r + 3]); }
#undef MX3
        const float mx = swap_max(__builtin_fmaxf(mxa, mxb));
        if (t == 0 || __any(mx > 6.0f)) {
            const float up = (t == 0) ? mx : __builtin_fmaxf(mx, 0.f), alpha = (t == 0) ? 0.f : __builtin_amdgcn_exp2f(-up);
            mrun = (t == 0) ? mx + cb : mrun + up; lrun *= alpha;
#pragma unroll
            for (int d = 0; d < 4; ++d)
#pragma unroll
                for (int r = 0; r < 16; ++r) o[d][r] *= alpha;
            const float sh = (t == 0) ? mx : up;
#pragma unroll
            for (int r = 0; r < 16; ++r) { sA[r] -= sh; sB[r] -= sh; }
        }
#pragma unroll
        for (int r = 0; r < 16; ++r) { sA[r] = __builtin_amdgcn_exp2f(sA[r]); sB[r] = __builtin_amdgcn_exp2f(sB[r]); }
        f32x2 ps2a = (f32x2){0.f, 0.f}, ps2b = (f32x2){0.f, 0.f};
#pragma unroll
        for (int r = 0; r < 16; r += 2) { ps2a += (f32x2){sA[r], sA[r + 1]}; ps2b += (f32x2){sB[r], sB[r + 1]}; }
        lrun += (ps2a.x + ps2a.y) + (ps2b.x + ps2b.y);
        } else { asm volatile("" : "+v"(sA), "+v"(sB)); }
        u32x4 pw[4];
        pw[0] = (u32x4){pk2(sA[0], sA[1]), pk2(sA[2], sA[3]), pk2(sA[4], sA[5]), pk2(sA[6], sA[7])};
        pw[1] = (u32x4){pk2(sA[8], sA[9]), pk2(sA[10], sA[11]), pk2(sA[12], sA[13]), pk2(sA[14], sA[15])};
        pw[2] = (u32x4){pk2(sB[0], sB[1]), pk2(sB[2], sB[3]), pk2(sB[4], sB[5]), pk2(sB[6], sB[7])};
        pw[3] = (u32x4){pk2(sB[8], sB[9]), pk2(sB[10], sB[11]), pk2(sB[12], sB[13]), pk2(sB[14], sB[15])};
        if (!(MODE & 2)) { asm volatile("" :: "v"(pw[0]), "v"(pw[1]), "v"(pw[2]), "v"(pw[3])); continue; }
        {
            bf16x8 vfa[4], vfb[4];
#pragma unroll
            for (int d = 0; d < 4; ++d) vfa[d] = (MODE & 16) ? qf[d] : vfrag(sb + voff + d * 4096);
            __builtin_amdgcn_sched_group_barrier(0x100, 8, 0);
#pragma unroll
            for (int ks = 0; ks < 4; ks += 2) {
#pragma unroll
                for (int d = 0; d < 4; ++d) vfb[d] = (MODE & 16) ? qf[3 - d] : vfrag(sb + voff + d * 4096 + (ks + 1) * 1024);
                __builtin_amdgcn_sched_group_barrier(0x100, 8, 0);
                { const bf16x8 pb = __builtin_bit_cast(bf16x8, pw[ks]);
#pragma unroll
                  for (int d = 0; d < 4; ++d) o[d] = MFMA32(vfa[d], pb, o[d]); }
                __builtin_amdgcn_sched_group_barrier(0x8, 4, 0);
                if (ks + 2 < 4) {
#pragma unroll
                    for (int d = 0; d < 4; ++d) vfa[d] = (MODE & 16) ? qf[d] : vfrag(sb + voff + d * 4096 + (ks + 2) * 1024);
                    __builtin_amdgcn_sched_group_barrier(0x100, 8, 0);
                }
                { const bf16x8 pb = __builtin_bit_cast(bf16x8, pw[ks + 1]);
#pragma unroll
                  for (int d = 0; d < 4; ++d) o[d] = MFMA32(vfb[d], pb, o[d]); }
                __builtin_amdgcn_sched_group_barrier(0x8, 4, 0);
            }
        }
    }
    const float inv = 1.0f / swap_sum(lrun);
    LAS float* xch = (LAS float*)(lds + ATT_XCH + (rgp * 32 + r32) * ATT_XPITCH);
    if (map == 1) {
        const float sc = inv * lam;
#pragma unroll
        for (int d = 0; d < 4; ++d)
#pragma unroll
            for (int g = 0; g < 4; ++g) *(LAS f32x4*)(xch + 32 * d + 8 * g + 4 * hi) = (f32x4){o[d][4 * g] * sc, o[d][4 * g + 1] * sc, o[d][4 * g + 2] * sc, o[d][4 * g + 3] * sc};
    }
    __syncthreads();
    if (map == 0) {
        float ss = 0.f;
#pragma unroll
        for (int d = 0; d < 4; ++d)
#pragma unroll
            for (int g = 0; g < 4; ++g) { const f32x4 o2 = *(const LAS f32x4*)(xch + 32 * d + 8 * g + 4 * hi);
#pragma unroll
                for (int j = 0; j < 4; ++j) { const float v = o[d][4 * g + j] * inv - o2[j]; o[d][4 * g + j] = v; ss += v * v; } }
        ss = swap_sum(ss);
        const float rn = 0.8f / sqrtf(ss * (1.0f / 128.0f) + EPSF);
        const float* sub = a.in[8];
        bf16_t* mixp = (bf16_t*)(a.ws + WS_MIX) + (rowbase + qpos) * DM + 512 + h * 128;
#pragma unroll
        for (int d = 0; d < 4; ++d)
#pragma unroll
            for (int g = 0; g < 4; ++g) { const int dd = 32 * d + 8 * g + 4 * hi; const f32x4 sv = *(const GAS f32x4*)(sub + dd);
                u32x2 w; w.x = pk2(o[d][4 * g] * rn * sv.x, o[d][4 * g + 1] * rn * sv.y); w.y = pk2(o[d][4 * g + 2] * rn * sv.z, o[d][4 * g + 3] * rn * sv.w);
                *(GAS u32x2*)(mixp + dd) = w; }
    }
    __syncthreads();
#undef ATT_DMA
}

constexpr int RET_BUF = 49152, RET_RT = 2 * RET_BUF, RET_GN = RET_RT + 8192;
static_assert(RET_GN + 2048 <= LDS_SCRATCH, "retention LDS");

__device__ __forceinline__ void ret_unit(const Args& a, lds_u8* lds, int b, int h) {
    int tid_ = threadIdx.x; asm volatile("" : "+v"(tid_));
    const int tid = tid_, lane = tid & 63, r32 = lane & 31, hi = lane >> 5; const int wid = __builtin_amdgcn_readfirstlane(tid >> 6);
    const int rgp = wid & 3, eh = wid >> 2;
    const bf16_t* proj = (const bf16_t*)(a.ws + WS_PROJ);
    const size_t rowbase = (size_t)b * SEQ;
    const double lg = log2(1.0 - exp2(-5.0 - (double)h));
    const float gam = (float)exp2(lg), g127 = (float)exp2(lg * 127.0), g128 = (float)exp2(lg * 128.0);
#define RET_DMA(c, buf) do { const size_t ro = (rowbase + (size_t)(c) * 128) * NIN; lds_u8* bb = lds + (buf) * RET_BUF; \
        _Pragma("unroll") for (int i_ = 0; i_ < 2; ++i_) { const int p_ = 2 * wid + i_; \
            { const int ch = p_ >> 1, rh = p_ & 1; glds16(proj + ro + (size_t)(rh * 64 + lane) * NIN + OFF_RK + h * 64 + ch * 8, bb + ch * 2048 + rh * 1024); } \
            { const int db = p_ >> 3, rg_ = p_ & 7; glds16(proj + ro + (size_t)(rg_ * 16 + (lane >> 2)) * NIN + OFF_RK + h * 64 + db * 32 + (lane & 3) * 8, bb + 16384 + db * 8192 + rg_ * 1024); \
              glds16(proj + ro + (size_t)(rg_ * 16 + (lane >> 2)) * NIN + OFF_RV + h * 64 + db * 32 + (lane & 3) * 8, bb + 32768 + db * 8192 + rg_ * 1024); } } } while (0)
    const int koff = hi * 2048 + r32 * 16;
    const int troff = ((lane >> 4) & 1) * 32 + (lane & 3) * 8 + (4 * hi + ((lane & 15) >> 2)) * 64;
    f32x16 R = f32x16{};
    for (int i = tid; i < 8192 / 16; i += NTHR) *(LAS u32x4*)(lds + RET_RT + i * 16) = (u32x4){0u, 0u, 0u, 0u};
    const float* gn = a.in[3];
    f32x4 gv[4];
#pragma unroll
    for (int g = 0; g < 4; ++g) gv[g] = *(const GAS f32x4*)(gn + h * 64 + eh * 32 + 8 * g + 4 * hi);
    bf16x8 qn[4]; u32x2 svn[4];
#define RET_PREF(c) do { const size_t tk_ = rowbase + (size_t)(c) * 128 + rgp * 32 + r32; const bf16_t* qp_ = proj + tk_ * NIN + OFF_RQ + h * 64 + hi * 8; const bf16_t* sg_ = proj + tk_ * NIN + OFF_RG + h * 64 + eh * 32 + 4 * hi; \
        _Pragma("unroll") for (int s = 0; s < 4; ++s) qn[s] = *(const GAS bf16x8*)(qp_ + s * 16); \
        _Pragma("unroll") for (int g = 0; g < 4; ++g) svn[g] = *(const GAS u32x2*)(sg_ + 8 * g); } while (0)
    RET_PREF(0);
    RET_DMA(0, 0);
    u32x2 wst[4]; bf16_t* wptr = nullptr;
#pragma unroll
    for (int g = 0; g < 4; ++g) wst[g] = (u32x2){0u, 0u};
    for (int c = 0; c < 32; ++c) {
        VM_WAIT(); __syncthreads();
        if (c > 0) {
#pragma unroll
            for (int g = 0; g < 4; ++g) *(GAS u32x2*)(wptr + 8 * g + 4 * hi) = wst[g];
        }
        bf16x8 qf[4]; u32x2 svc[4];
#pragma unroll
        for (int s = 0; s < 4; ++s) { qf[s] = qn[s]; svc[s] = svn[s]; }
        if (c + 1 < 32) { RET_PREF(c + 1); RET_DMA(c + 1, (c + 1) & 1); }
        const lds_u8* bb = lds + (c & 1) * RET_BUF;
        const size_t tok = rowbase + (size_t)c * 128 + rgp * 32 + r32;
        f32x16 O = f32x16{};
#pragma unroll
        for (int s = 0; s < 4; ++s) { const bf16x8 rt = ldsb128(lds + RET_RT + (2 * s + hi) * 1024 + (eh * 32 + r32) * 16); O = MFMA32(rt, qf[s], O); }
        for (int kb = 0; kb <= rgp; ++kb) {
            f32x16 S = f32x16{};
#pragma unroll
            for (int s = 0; s < 4; ++s) { const bf16x8 ka = ldsb128(bb + koff + s * 4096 + (kb * 32) * 16); S = MFMA32(ka, qf[s], S); }
            if (kb == rgp) {
#pragma unroll
                for (int r = 0; r < 16; ++r) S[r] = (crow(r, hi) > r32) ? 0.f : S[r];
            }
            const u32x4 p0 = (u32x4){pk2(S[0], S[1]), pk2(S[2], S[3]), pk2(S[4], S[5]), pk2(S[6], S[7])};
            const u32x4 p1 = (u32x4){pk2(S[8], S[9]), pk2(S[10], S[11]), pk2(S[12], S[13]), pk2(S[14], S[15])};
            const bf16x8 v0 = vfrag(bb + 32768 + eh * 8192 + troff + (2 * kb) * 1024), v1 = vfrag(bb + 32768 + eh * 8192 + troff + (2 * kb + 1) * 1024);
            O = MFMA32(v0, __builtin_bit_cast(bf16x8, p0), O); O = MFMA32(v1, __builtin_bit_cast(bf16x8, p1), O);
        }
        if (rgp < 2) {
            f32x16 T = f32x16{};
#pragma unroll
            for (int ks = 0; ks < 8; ++ks) { const bf16x8 kt = vfrag(bb + 16384 + rgp * 8192 + troff + ks * 1024), vv = vfrag(bb + 32768 + eh * 8192 + troff + ks * 1024); T = MFMA32(kt, vv, T); }
#pragma unroll
            for (int r = 0; r < 16; ++r) R[r] = R[r] * g128 + T[r] * g127;
        }
        float s1 = 0.f, s2 = 0.f;
#pragma unroll
        for (int r = 0; r < 16; ++r) { s1 += O[r]; s2 += O[r] * O[r]; }
        s1 = swap_sum(s1); s2 = swap_sum(s2);
        LAS f32x2* gx = (LAS f32x2*)(lds + RET_GN);
        if (hi == 0) gx[(rgp * 32 + r32) * 2 + eh] = (f32x2){s1, s2};
        __syncthreads();
        if (rgp < 2) {
#pragma unroll
            for (int g = 0; g < 4; ++g) { u32x2 w; w.x = pk2(R[4 * g] * gam, R[4 * g + 1] * gam); w.y = pk2(R[4 * g + 2] * gam, R[4 * g + 3] * gam);
                *(LAS u32x2*)(lds + RET_RT + (rgp * 4 + g) * 1024 + (eh * 32 + r32) * 16 + hi * 8) = w; }
        }
        const f32x2 ga = gx[(rgp * 32 + r32) * 2], gb = gx[(rgp * 32 + r32) * 2 + 1];
        const float mean = (ga.x + gb.x) * (1.0f / 64.0f), var = (ga.y + gb.y) * (1.0f / 64.0f) - mean * mean;
        const float rstd = 1.0f / sqrtf(__builtin_fmaxf(var, 0.f) + EPSF);
        bf16_t* mixp = (bf16_t*)(a.ws + WS_MIX) + tok * DM + h * 64 + eh * 32;
#pragma unroll
        for (int g = 0; g < 4; ++g) { const int e = 8 * g + 4 * hi; const u32x2 sv = svc[g];
            const float y0 = (O[4 * g] - mean) * rstd * gv[g].x * __uint_as_float(sv.x << 16), y1 = (O[4 * g + 1] - mean) * rstd * gv[g].y * __uint_as_float(sv.x & 0xffff0000u);
            const float y2 = (O[4 * g + 2] - mean) * rstd * gv[g].z * __uint_as_float(sv.y << 16), y3 = (O[4 * g + 3] - mean) * rstd * gv[g].w * __uint_as_float(sv.y & 0xffff0000u);
            wst[g].x = pk2(y0, y1); wst[g].y = pk2(y2, y3); }
        wptr = mixp;
    }
#pragma unroll
    for (int g = 0; g < 4; ++g) *(GAS u32x2*)(wptr + 8 * g + 4 * hi) = wst[g];
    __syncthreads();
#undef RET_DMA
#undef RET_PREF
}


#define CAS_DESC(x, y) do { const float hi_ = __builtin_fmaxf(x, y), lo_ = __builtin_fminf(x, y); x = hi_; y = lo_; } while (0)
#define CAS_ASC(x, y) do { const float hi_ = __builtin_fmaxf(x, y), lo_ = __builtin_fminf(x, y); x = lo_; y = hi_; } while (0)
__device__ __forceinline__ void sort16_desc(float (&v)[16]) {
#pragma unroll
    for (int k = 2; k <= 16; k <<= 1)
#pragma unroll
        for (int j = k >> 1; j > 0; j >>= 1)
#pragma unroll
            for (int i = 0; i < 16; ++i) { const int l = i ^ j; if (l > i) { if ((i & k) == 0) CAS_DESC(v[i], v[l]); else CAS_ASC(v[i], v[l]); } }
}
__device__ __forceinline__ void bitonic_merge16_desc(float (&v)[16]) {
#pragma unroll
    for (int j = 8; j > 0; j >>= 1)
#pragma unroll
        for (int i = 0; i < 16; ++i) { const int l = i ^ j; if (l > i) CAS_DESC(v[i], v[l]); }
}
__device__ __forceinline__ void merge_top16(float (&a)[16], const float (&b)[16]) {
#pragma unroll
    for (int i = 0; i < 16; ++i) a[i] = __builtin_fmaxf(a[i], b[15 - i]);
    bitonic_merge16_desc(a);
}
__device__ __forceinline__ unsigned pack_idx4(const float (&v)[16], int w) {
    return (__float_as_uint(v[4 * w]) & 127u) | ((__float_as_uint(v[4 * w + 1]) & 127u) << 8) | ((__float_as_uint(v[4 * w + 2]) & 127u) << 16) | ((__float_as_uint(v[4 * w + 3]) & 127u) << 24);
}
__device__ __forceinline__ unsigned lookup_idx(const unsigned (&pk)[4], unsigned i) {
    const unsigned w = i >> 2; unsigned s = w == 0 ? pk[0] : (w == 1 ? pk[1] : (w == 2 ? pk[2] : pk[3]));
    return (s >> ((i & 3u) * 8u)) & 127u;
}

constexpr int P5_KEYB = 32768;
__device__ __forceinline__ void p5_topk(const Args& a, lds_u8* lds) {
    const int tid = threadIdx.x, lane = tid & 63, r32 = lane & 31, hi = lane >> 5; const int wid = __builtin_amdgcn_readfirstlane(tid >> 6);
    const int hp = blockIdx.x & 3, wgi = blockIdx.x >> 2, nwg = (gridDim.x + 3 - hp) / 4;
    const bf16_t* keys = (const bf16_t*)(a.ws + WS_KEYS) + (size_t)hp * 4 * 128 * 128;
    {
        static_assert(4 * 128 * 16 == 16 * NTHR, "key image copy");
        u32x4 kv[16];
#pragma unroll
        for (int j = 0; j < 16; ++j) { const int i = tid + j * NTHR, t = i >> 11, key = (i >> 4) & 127, c = i & 15; kv[j] = *(const GAS u32x4*)(keys + ((size_t)t * 128 + key) * 128 + c * 8); }
#pragma unroll
        for (int j = 0; j < 16; ++j) { const int i = tid + j * NTHR, t = i >> 11, key = (i >> 4) & 127, c = i & 15; *(LAS u32x4*)(lds + t * P5_KEYB + c * 2048 + key * 16) = kv[j]; }
    }
    __syncthreads();
    const bf16_t* Q = (const bf16_t*)(a.ws + WS_PROJ);
    int* IDX = (int*)(a.ws + WS_IDX); float* GATE = (float*)(a.ws + WS_GATE);
    const int tg0 = wgi * NWAVES + wid, tgs = nwg * NWAVES;
    const int ntask = (tg0 < MTOK / 32) ? 4 * ((MTOK / 32 - 1 - tg0) / tgs + 1) : 0;
#define P5_QLOAD(QF, k_) do { const int tg_ = tg0 + ((k_) >> 2) * tgs, t_ = (k_) & 3; \
        const bf16_t* qp = Q + (size_t)(tg_ * 32 + r32) * NQ + (2 * hp + (t_ >> 1)) * 256 + (t_ & 1) * 128 + hi * 8; \
        _Pragma("unroll") for (int s = 0; s < 8; ++s) QF[s] = *(const GAS bf16x8*)(qp + s * 16); } while (0)
    float la[16], lb[16];
#pragma unroll
    for (int r = 0; r < 16; ++r) { la[r] = 0.f; lb[r] = 0.f; }
    bf16x8 qf[8], qn[8];
    if (ntask > 0) P5_QLOAD(qf, 0);
#pragma unroll 1
    for (int k = 0; k < ntask; ++k) {
      {
        const int tg = tg0 + (k >> 2) * tgs, t = k & 3;
        P5_QLOAD(qn, (k + 1 < ntask ? k + 1 : k));
        {
            float top[16];
#pragma unroll
            for (int kb = 0; kb < 4; ++kb) {
                f32x16 S = f32x16{};
#pragma unroll
                for (int s = 0; s < 8; ++s) { const bf16x8 kf = ldsb128(lds + t * P5_KEYB + (2 * s + hi) * 2048 + (kb * 32 + r32) * 16); S = MFMA32(kf, qf[s], S); }
                float v[16];
#pragma unroll
                for (int r = 0; r < 16; ++r) v[r] = __uint_as_float((__float_as_uint(S[r]) & ~127u) | (unsigned)(kb * 32 + (r & 3) + 8 * (r >> 2)) | ((unsigned)hi << 2));
                sort16_desc(v);
                if (kb == 0) {
#pragma unroll
                    for (int r = 0; r < 16; ++r) top[r] = v[r];
                } else merge_top16(top, v);
            }
            float oth[16];
#pragma unroll
            for (int r = 0; r < 16; ++r) { auto rr = __builtin_amdgcn_permlane32_swap(__float_as_uint(top[r]), __float_as_uint(top[r]), false, false); top[r] = __uint_as_float(rr[0]); oth[r] = __uint_as_float(rr[1]); }
            merge_top16(top, oth);
            const bool ka = ((t >> 1) == hi) && ((t & 1) == 0), kb2 = ((t >> 1) == hi) && ((t & 1) == 1);
#pragma unroll
            for (int r = 0; r < 16; ++r) { la[r] = ka ? top[r] : la[r]; lb[r] = kb2 ? top[r] : lb[r]; }
        }
#pragma unroll
        for (int s2 = 0; s2 < 8; ++s2) qf[s2] = qn[s2];
        if (t != 3) continue;
        unsigned pa[4], pb[4];
#pragma unroll
        for (int w = 0; w < 4; ++w) { pa[w] = pack_idx4(la, w); pb[w] = pack_idx4(lb, w); }
        float c0[16], c1[16];
#define CAND(i, j) __uint_as_float((__float_as_uint(la[i] + lb[j]) & ~255u) | (unsigned)((i) * 16 + (j)))
        const float NEG = -INFINITY;
        c0[0] = CAND(0, 0); c0[1] = CAND(0, 1); c0[2] = CAND(0, 2); c0[3] = CAND(0, 3); c0[4] = CAND(0, 4); c0[5] = CAND(0, 5); c0[6] = CAND(0, 6); c0[7] = CAND(0, 7);
        c0[8] = CAND(0, 8); c0[9] = CAND(0, 9); c0[10] = CAND(0, 10); c0[11] = CAND(0, 11); c0[12] = CAND(0, 12); c0[13] = CAND(0, 13); c0[14] = CAND(0, 14); c0[15] = CAND(0, 15);
        sort16_desc(c0);
        c1[0] = CAND(1, 0); c1[1] = CAND(1, 1); c1[2] = CAND(1, 2); c1[3] = CAND(1, 3); c1[4] = CAND(1, 4); c1[5] = CAND(1, 5); c1[6] = CAND(1, 6); c1[7] = CAND(1, 7);
        c1[8] = CAND(2, 0); c1[9] = CAND(2, 1); c1[10] = CAND(2, 2); c1[11] = CAND(2, 3); c1[12] = CAND(2, 4); c1[13] = CAND(3, 0); c1[14] = CAND(3, 1); c1[15] = CAND(3, 2);
        sort16_desc(c1); merge_top16(c0, c1);
        asm volatile("" : "+v"(c0[0]), "+v"(c0[15]));
        c1[0] = CAND(3, 3); c1[1] = CAND(4, 0); c1[2] = CAND(4, 1); c1[3] = CAND(4, 2); c1[4] = CAND(5, 0); c1[5] = CAND(5, 1); c1[6] = CAND(6, 0); c1[7] = CAND(6, 1);
        c1[8] = CAND(7, 0); c1[9] = CAND(7, 1); c1[10] = CAND(8, 0); c1[11] = CAND(9, 0); c1[12] = CAND(10, 0); c1[13] = CAND(11, 0); c1[14] = CAND(12, 0); c1[15] = CAND(13, 0);
        sort16_desc(c1); merge_top16(c0, c1);
        asm volatile("" : "+v"(c0[0]), "+v"(c0[15]));
        c1[0] = CAND(14, 0); c1[1] = CAND(15, 0);
#pragma unroll
        for (int r = 2; r < 16; ++r) c1[r] = NEG;
#undef CAND
        sort16_desc(c1); merge_top16(c0, c1);
        float gsum = 0.f, gv[16]; int ex[16];
        const float mx = __uint_as_float(__float_as_uint(c0[0]) & ~255u);
#pragma unroll
        for (int r = 0; r < 16; ++r) { const unsigned bits = __float_as_uint(c0[r]); const float val = __uint_as_float(bits & ~255u);
            gv[r] = __expf(val - mx); gsum += gv[r];
            ex[r] = (int)(lookup_idx(pa, (bits >> 4) & 15u) * 128u + lookup_idx(pb, bits & 15u)); }
        const float ginv = 1.0f / gsum;
        const size_t ob = (size_t)(tg * 32 + r32) * 128 + (2 * hp + hi) * 16;
#pragma unroll
        for (int r = 0; r < 16; r += 4) { *(GAS u32x4*)(IDX + ob + r) = (u32x4){(unsigned)ex[r], (unsigned)ex[r + 1], (unsigned)ex[r + 2], (unsigned)ex[r + 3]};
            *(GAS f32x4*)(GATE + ob + r) = (f32x4){gv[r] * ginv, gv[r + 1] * ginv, gv[r + 2] * ginv, gv[r + 3] * ginv}; }
      }
    }
#undef P5_QLOAD
    __syncthreads();
}

typedef long i64_t;
typedef int v8i_t __attribute__((ext_vector_type(8)));
#define MFMA16F8(a, b, c) __builtin_amdgcn_mfma_f32_16x16x32_fp8_fp8(a, b, c, 0, 0, 0)
constexpr float P6_SD = 64.f, P6_SX = 8.f, P6_SU = 16.f, P6_SA = 64.f, P6_SU4 = 6.f;
constexpr size_t P6_SLICEB = (size_t)NEXP * 128;
__device__ __forceinline__ unsigned pk4_fp8(float a, float b, float c, float d) { int w = __builtin_amdgcn_cvt_pk_fp8_f32(a, b, 0, false); w = __builtin_amdgcn_cvt_pk_fp8_f32(c, d, w, true); return (unsigned)w; }
__device__ __forceinline__ float fp8_byte0(unsigned w) { return __builtin_amdgcn_cvt_f32_fp8((int)w, 0); }
constexpr int P6_WSCR = 3328;
__device__ __forceinline__ void p6_token(const Args& a, lds_u8* wl, int tok, int lane, float* OUTW) {
    const int n = lane & 15, g = lane >> 4;
    const unsigned char* ws = a.ws;
    const unsigned char* WD = ws + WS_WD; const unsigned char* WU = ws + WS_WU;
    const int* IDX = (const int*)(ws + WS_IDX) + (size_t)tok * 128; const float* GATE = (const float*)(ws + WS_GATE) + (size_t)tok * 128;
    const bf16_t* X1 = (const bf16_t*)(ws + WS_X1B) + (size_t)tok * DM;
    {
#pragma unroll
        for (int j = 0; j < 4; ++j) {
            const u32x2 xw_ = *(const GAS u32x2*)(X1 + 256 * j + 4 * lane); const f32x4 v = (f32x4){__uint_as_float(xw_.x << 16), __uint_as_float(xw_.x & 0xffff0000u), __uint_as_float(xw_.y << 16), __uint_as_float(xw_.y & 0xffff0000u)} * P6_SX;
            const unsigned hw = pk4_fp8(v.x, v.y, v.z, v.w);
            const float r0 = v.x - __builtin_amdgcn_cvt_f32_fp8((int)hw, 0), r1 = v.y - __builtin_amdgcn_cvt_f32_fp8((int)hw, 1), r2 = v.z - __builtin_amdgcn_cvt_f32_fp8((int)hw, 2), r3 = v.w - __builtin_amdgcn_cvt_f32_fp8((int)hw, 3);
            const unsigned lw = pk4_fp8(r0 * 16.f, r1 * 16.f, r2 * 16.f, r3 * 16.f);
            *(LAS unsigned*)(wl + 256 * j + 4 * lane) = hw; *(LAS unsigned*)(wl + 1024 + 256 * j + 4 * lane) = lw;
        }
        const u32x2 iv = *(const GAS u32x2*)(IDX + lane * 2); *(LAS u32x2*)(wl + 2048 + lane * 8) = iv;
    }
    const float rs2 = row_rs2((const bf16_t*)(ws + WS_SSQ), tok);
    LDS_WAIT();
    const LAS int* idxl = (const LAS int*)(wl + 2048); LAS unsigned short* actl = (LAS unsigned short*)(wl + 2560);
    const int xoff = (n & 1) * 1024 + 16 * g;
#pragma unroll 1
    for (int eg = 0; eg < 8; ++eg) {
        const int e = idxl[eg * 16 + n];
        const unsigned char* rp = WD + (size_t)e * 128 + 16 * g;
        f32x4 acc = (f32x4){0.f, 0.f, 0.f, 0.f};
        u32x4 bq[16];
#pragma unroll
        for (int sl = 0; sl < 8; ++sl) { bq[2 * sl] = *(const GAS u32x4*)(rp + sl * P6_SLICEB); bq[2 * sl + 1] = *(const GAS u32x4*)(rp + sl * P6_SLICEB + 64); }
#pragma unroll
        for (int sl = 0; sl < 8; ++sl)
#pragma unroll
            for (int hf = 0; hf < 2; ++hf) {
                const u32x4 xa = *(const LAS u32x4*)(wl + xoff + sl * 128 + hf * 64); const u32x4 bb = bq[2 * sl + hf];
                acc = MFMA16F8((i64_t)(((unsigned long long)xa.y << 32) | xa.x), (i64_t)(((unsigned long long)bb.y << 32) | bb.x), acc);
                acc = MFMA16F8((i64_t)(((unsigned long long)xa.w << 32) | xa.z), (i64_t)(((unsigned long long)bb.w << 32) | bb.z), acc);
            }
        const float av = (acc[0] + acc[1] * 0.0625f) * (rs2 * (1.0f / (P6_SD * P6_SX)));
        const float act = 0.5f * av * (1.0f + erff(av * 0.70710678118654752f)) * GATE[eg * 16 + n] * P6_SA;
        const unsigned hb = pk4_fp8(act, 0.f, 0.f, 0.f) & 0xffu;
        const unsigned lb = pk4_fp8((act - fp8_byte0(hb)) * 16.f, 0.f, 0.f, 0.f) & 0xffu;
        if (g == 0) actl[eg * 16 + n] = (unsigned short)(hb | (lb << 8));
    }
    LDS_WAIT();
    const int pos = n & 7, sel = n >> 3;
    float ss = 0.f;
    const bool owner = (n < 8) && (g < 2);
#pragma unroll 1
    for (int sl = 0; sl < 8; ++sl) {
        f32x4 ah[2], al[2];
#pragma unroll
        for (int s = 0; s < 2; ++s) { ah[s] = (f32x4){0.f, 0.f, 0.f, 0.f}; al[s] = (f32x4){0.f, 0.f, 0.f, 0.f}; }
        u32x4 bq[16]; unsigned av[16];
#pragma unroll
        for (int q = 0; q < 16; ++q) { const int ei = 8 * q + 4 * sel + g; const int e = idxl[ei]; av[q] = actl[ei];
            bq[q] = *(const GAS u32x4*)(WU + sl * P6_SLICEB + (size_t)e * 128 + 16 * pos); }
#pragma unroll
        for (int q = 0; q < 16; ++q) {
            const unsigned long long ahv = (unsigned long long)(av[q] & 0xffu) << (8 * pos), alv = (unsigned long long)(av[q] >> 8) << (8 * pos);
            const u32x4 bb = bq[q];
            const i64_t b0 = (i64_t)(((unsigned long long)bb.y << 32) | bb.x), b1 = (i64_t)(((unsigned long long)bb.w << 32) | bb.z);
            ah[0] = MFMA16F8((i64_t)ahv, b0, ah[0]); al[0] = MFMA16F8((i64_t)alv, b0, al[0]);
            ah[1] = MFMA16F8((i64_t)ahv, b1, ah[1]); al[1] = MFMA16F8((i64_t)alv, b1, al[1]);
        }
#pragma unroll
        for (int s = 0; s < 2; ++s) {
            f32x4 t = ah[s] + al[s] * 0.0625f, u;
#pragma unroll
            for (int r = 0; r < 4; ++r) u[r] = __shfl(t[r], (lane + 40) & 63);
            const int col = 128 * sl + 16 * pos + 8 * s + 4 * (g & 1);
            const u32x2 xq_ = *(const GAS u32x2*)(X1 + col); const f32x4 xv = (f32x4){__uint_as_float(xq_.x << 16), __uint_as_float(xq_.x & 0xffff0000u), __uint_as_float(xq_.y << 16), __uint_as_float(xq_.y & 0xffff0000u)};
            const f32x4 x2 = xv + (t + u) * (1.0f / (P6_SA * P6_SU));
            if (owner) { ss += (x2.x * x2.x + x2.y * x2.y) + (x2.z * x2.z + x2.w * x2.w); *(GAS f32x4*)(OUTW + (size_t)tok * DM + col) = x2; }
        }
    }
    ss = wave_sum(ss);
    const float rn = 1.0f / sqrtf(ss * (1.0f / DM) + EPSF);
    const float* nf = a.in[16];
    if (owner) {
#pragma unroll
        for (int sl = 0; sl < 8; ++sl)
#pragma unroll
            for (int s = 0; s < 2; ++s) { const int col = 128 * sl + 16 * pos + 8 * s + 4 * g; const f32x4 gv = *(const GAS f32x4*)(nf + col);
                GAS f32x4* op = (GAS f32x4*)(OUTW + (size_t)tok * DM + col); *op = *op * rn * gv; }
    }
}

constexpr int P6S_WAVE = 16384 + 512 + 128;
static_assert(NWAVES * P6S_WAVE <= LDS_SCRATCH, "P6 LDS");
__device__ __forceinline__ float gelu_as(float v) {
    const float av = __builtin_fabsf(v), t = __builtin_amdgcn_rcpf(av * 0.2316418882f + 1.0f);
    float q = t * 0.5307027145f + (-0.7265760135f); q = q * t + 0.7107068705f; q = q * t + (-0.142248368f); q = q * t + 0.127414796f; q = q * t;
    const float e = __builtin_amdgcn_exp2f((v * v) * (-0.72134752044f));
    const float m = v * (q * e);
    return v < 0.f ? m : v - m;
}
template <int EMASK, int PARTS>
__device__ __forceinline__ void p6_slices(const Args& a, lds_u8* wl, int tok0, int lane) {
    const int n = lane & 15, g = lane >> 4;
    const unsigned char* ws = a.ws;
    const unsigned char* WD = ws + WS_WD; const unsigned char* WU = ws + WS_WU;
    LAS float* aacc = (LAS float*)wl; LAS unsigned short* idl = (LAS unsigned short*)(wl + 8192); LAS unsigned short* actl = (LAS unsigned short*)(wl + 12288);
    lds_u8* xs = wl + 16384; LAS float* ssl = (LAS float*)(wl + 16384 + 512); LAS float* r2l = ssl + 16;
    {
        u32x2 iv[16];
#pragma unroll
        for (int t = 0; t < 16; ++t) iv[t] = *(const GAS u32x2*)((const int*)(ws + WS_IDX) + (size_t)(tok0 + t) * 128 + lane * 2);
#pragma unroll
        for (int t = 0; t < 16; ++t) {
            *(LAS unsigned*)(wl + 8192 + t * 256 + lane * 4) = (iv[t].x & 0xffffu) | (iv[t].y << 16);
            *(LAS f32x2*)(wl + t * 512 + lane * 8) = (f32x2){0.f, 0.f};
        }
    }
    if (lane < 16) { ssl[lane] = 0.f; r2l[lane] = row_rs2((const bf16_t*)(ws + WS_SSQ), tok0 + lane); }
    unsigned char* X4 = (unsigned char*)a.ws + WS_XB;
#pragma unroll 1
    for (int t8 = 0; t8 < 16; t8 += 8) {
    u32x4 xwa[8], xwb[8];
#pragma unroll
    for (int tt = 0; tt < 8; ++tt) { const bf16_t* xr = (const bf16_t*)(ws + WS_X1B) + (size_t)(tok0 + t8 + tt) * DM + 16 * lane; xwa[tt] = *(const GAS u32x4*)xr; xwb[tt] = *(const GAS u32x4*)(xr + 8); }
#pragma unroll
    for (int tt = 0; tt < 8; ++tt) {
        const int t = t8 + tt;
        const u32x4 xw0 = xwa[tt], xw1 = xwb[tt];
        float rr[16];
#pragma unroll
        for (int j = 0; j < 4; ++j) { rr[2 * j] = __uint_as_float(xw0[j] << 16); rr[2 * j + 1] = __uint_as_float(xw0[j] & 0xffff0000u); rr[8 + 2 * j] = __uint_as_float(xw1[j] << 16); rr[9 + 2 * j] = __uint_as_float(xw1[j] & 0xffff0000u); }
#pragma unroll
        for (int st = 0; st < 4; ++st) {
            unsigned w0 = 0u, w1 = 0u;
#define P6_Q4(p_) do { w0 = __builtin_amdgcn_cvt_scalef32_pk_fp4_f32(w0, rr[2 * (p_)], rr[2 * (p_) + 1], 1.0f, p_); w1 = __builtin_amdgcn_cvt_scalef32_pk_fp4_f32(w1, rr[8 + 2 * (p_)], rr[9 + 2 * (p_)], 1.0f, p_); } while (0)
            P6_Q4(0); P6_Q4(1); P6_Q4(2); P6_Q4(3);
#undef P6_Q4
#define P6_D4(p_) do { const f32x2 d0 = __builtin_amdgcn_cvt_scalef32_pk_f32_fp4(w0, 1.0f, p_), d1 = __builtin_amdgcn_cvt_scalef32_pk_f32_fp4(w1, 1.0f, p_); \
                rr[2 * (p_)] = (rr[2 * (p_)] - d0.x) * 4.0f; rr[2 * (p_) + 1] = (rr[2 * (p_) + 1] - d0.y) * 4.0f; rr[8 + 2 * (p_)] = (rr[8 + 2 * (p_)] - d1.x) * 4.0f; rr[9 + 2 * (p_)] = (rr[9 + 2 * (p_)] - d1.y) * 4.0f; } while (0)
            P6_D4(0); P6_D4(1); P6_D4(2); P6_D4(3);
#undef P6_D4
            *(GAS u32x2*)(X4 + (size_t)(tok0 + t) * 2048 + st * 512 + 8 * lane) = (u32x2){w0, w1};
        }
    }
    }
    LDS_WAIT(); VM_WAIT();
    const int xoff = (n & 3) * 128 + 16 * g;
    const int bpa = 4 * (4 * (lane & 15) + (lane >> 4));
#define MFMA4(a_, b_, c_) __builtin_amdgcn_mfma_scale_f32_16x16x128_f8f6f4(a_, b_, c_, 4  , 4  , 0, 0, 0, 0)
#define P6_DLOAD(BQ, XV, it_) do { const int sl_ = (it_) >> 4, t_ = (it_) & 15; \
        _Pragma("unroll") for (int eg = 0; eg < 8; ++eg) { const int e_ = idl[t_ * 128 + eg * 16 + (lane >> 2)] & EMASK; const unsigned char* rp_ = WD + sl_ * P6_SLICEB + (size_t)e_ * 128 + 16 * (lane & 3); \
            BQ[2 * eg] = *(const GAS u32x4*)rp_; BQ[2 * eg + 1] = *(const GAS u32x4*)(rp_ + 64); } \
        XV = *(const GAS u32x2*)(X4 + (size_t)(tok0 + t_) * 2048 + (lane >> 4) * 512 + sl_ * 128 + 8 * (lane & 15)); } while (0)
#define P6_DCOMP(BQ, XV, it_) do { const int t_ = (it_) & 15; \
        *(LAS u32x2*)(xs + (lane >> 4) * 128 + 8 * (lane & 15)) = XV; \
        LDS_WAIT(); \
        const u32x4 xa0 = *(const LAS u32x4*)(xs + xoff), xa1 = *(const LAS u32x4*)(xs + xoff + 64); \
        const v8i_t A0 = (v8i_t){(int)xa0.x, (int)xa0.y, (int)xa0.z, (int)xa0.w, 0, 0, 0, 0}; \
        const v8i_t A1 = (v8i_t){(int)xa1.x, (int)xa1.y, (int)xa1.z, (int)xa1.w, 0, 0, 0, 0}; \
        _Pragma("unroll") for (int eg = 0; eg < 8; ++eg) { f32x4 acc = (f32x4){0.f, 0.f, 0.f, 0.f}; v8i_t b0 = (v8i_t){0, 0, 0, 0, 0, 0, 0, 0}, b1 = (v8i_t){0, 0, 0, 0, 0, 0, 0, 0}; \
            _Pragma("unroll") for (int w_ = 0; w_ < 4; ++w_) { b0[w_] = __builtin_amdgcn_ds_bpermute(bpa, (int)BQ[2 * eg][w_]); b1[w_] = __builtin_amdgcn_ds_bpermute(bpa, (int)BQ[2 * eg + 1][w_]); } \
            acc = MFMA4(A0, b0, acc); acc = MFMA4(A1, b1, acc); \
            float r_ = (acc[0] + acc[1] * 0.25f) + (acc[2] * 0.0625f + acc[3] * 0.015625f); asm volatile("" : "+v"(r_)); \
            if (g == 0) aacc[t_ * 128 + eg * 16 + n] += r_; } \
        LDS_WAIT(); } while (0)
    if (PARTS & 1) {
        u32x4 bqA[16], bqB[16]; u32x2 xvA, xvB;
        P6_DLOAD(bqA, xvA, 0);
#pragma unroll 1
        for (int it = 0; it < 64; it += 2) {
            P6_DLOAD(bqB, xvB, it + 1);
            P6_DCOMP(bqA, xvA, it);
            P6_DLOAD(bqA, xvA, (it + 2 < 64 ? it + 2 : it));
            P6_DCOMP(bqB, xvB, it + 1);
        }
    }
#undef MFMA4
#undef P6_DLOAD
#undef P6_DCOMP
    int lane_g = lane; asm volatile("" : "+v"(lane_g));
    float gts[16][2];
#pragma unroll
    for (int t = 0; t < 16; ++t) { gts[t][0] = ((const float*)(ws + WS_GATE))[(size_t)(tok0 + t) * 128 + lane_g]; gts[t][1] = ((const float*)(ws + WS_GATE))[(size_t)(tok0 + t) * 128 + lane_g + 64]; }
#pragma unroll
    for (int t = 0; t < 16; ++t) {
        const float sc = r2l[t] * (1.0f / P6_SD);
#pragma unroll
        for (int j = 0; j < 2; ++j) { const int ei = lane_g + 64 * j; const float av = aacc[t * 128 + ei] * sc;
            const float act = gelu_as(av) * gts[t][j];
            const unsigned ab = __float_as_uint(act), eb = (ab >> 23) & 255u;
            unsigned pk = 0u;
            if (eb > 4u) {
                const float m = __uint_as_float((ab & 0x807fffffu) | (128u << 23));
                const unsigned w0 = __builtin_amdgcn_cvt_scalef32_pk_fp4_f32(0u, m, 0.f, 1.0f, 0);
                const f32x2 d0 = __builtin_amdgcn_cvt_scalef32_pk_f32_fp4(w0, 1.0f, 0);
                const unsigned w1 = __builtin_amdgcn_cvt_scalef32_pk_fp4_f32(0u, (m - d0.x) * 4.0f, 0.f, 1.0f, 0);
                pk = (w0 & 15u) | ((w1 & 15u) << 4) | ((eb - 1u) << 8);
            }
            actl[t * 128 + ei] = (unsigned short)pk; }
    }
    LDS_WAIT();
    int lane_u = lane; asm volatile("" : "+v"(lane_u));
    const float* nf = a.in[16];
    const int ui = lane_u & 31, ug = lane_u >> 5, ush = 4 * (ui & 7);
    const unsigned uk0 = (ui >> 3) == 0 ? 0xffffffffu : 0u, uk1 = (ui >> 3) == 1 ? 0xffffffffu : 0u, uk2 = (ui >> 3) == 2 ? 0xffffffffu : 0u, uk3 = (ui >> 3) == 3 ? 0xffffffffu : 0u;
#ifndef P6_DIGITS
#define P6_DIGITS 2
#endif
#define MFMA32S(a_, b_, c_, sa_) __builtin_amdgcn_mfma_scale_f32_32x32x64_f8f6f4(a_, b_, c_, 4, 4, 0, sa_, 0, 127)
#ifndef P6_UPROBE
#define P6_UPROBE 0
#endif
#define P6_ULOAD(BQ, sq_) do { const int t_ = (sq_) >> 3, qs_ = (sq_) & 7; \
        if (!((P6_UPROBE & 1) && PARTS == 2 && EMASK != 0xffff)) \
        _Pragma("unroll") for (int q = 0; q < 8; ++q) { const int e_ = idl[t_ * 128 + 2 * (8 * qs_ + q) + ug] & EMASK; \
            BQ[q] = *(const GAS u32x4*)(WU + (size_t)e_ * 512 + 16 * ui); } } while (0)
#define P6_UMMA(BQ, sq_) do { const int t_ = (sq_) >> 3, qs_ = (sq_) & 7; \
        _Pragma("unroll") for (int q = 0; q < 8; ++q) { \
            const unsigned av_ = actl[t_ * 128 + 2 * (8 * qs_ + q) + ug]; \
            const unsigned w0_ = (av_ & 15u) << ush, w1_ = ((av_ >> 4) & 15u) << ush; const int s0_ = (int)(av_ >> 8), s1_ = s0_ - 2; \
            const u32x4 bb = BQ[q]; const v8i_t B_ = (v8i_t){(int)bb.x, (int)bb.y, (int)bb.z, (int)bb.w, 0, 0, 0, 0}; \
            if ((P6_UPROBE & 2) && PARTS == 2) { asm volatile("" :: "v"(w0_ & uk0), "v"(w0_ & uk1), "v"(w0_ & uk2), "v"(w0_ & uk3), "v"(w1_ & uk0), "v"(w1_ & uk1), "v"(w1_ & uk2), "v"(w1_ & uk3), "v"(bb), "v"(s0_), "v"(s1_)); continue; } \
            uacc = MFMA32S(((v8i_t){(int)(w0_ & uk0), (int)(w0_ & uk1), (int)(w0_ & uk2), (int)(w0_ & uk3), 0, 0, 0, 0}), B_, uacc, s0_); \
            if (P6_DIGITS == 2) uacc = MFMA32S(((v8i_t){(int)(w1_ & uk0), (int)(w1_ & uk1), (int)(w1_ & uk2), (int)(w1_ & uk3), 0, 0, 0, 0}), B_, uacc, s1_); } } while (0)
    f32x4 gvu[4];
#pragma unroll
    for (int gq = 0; gq < 4; ++gq) gvu[gq] = *(const GAS f32x4*)(nf + 32 * ui + 4 * ug + 8 * gq);
    u32x2 xqn[4];
#define P6_UXPREF(t_) do { const bf16_t* xrow_ = (const bf16_t*)(ws + WS_X1B) + (size_t)(tok0 + (t_)) * DM + 32 * ui + 4 * ug; \
        _Pragma("unroll") for (int gq = 0; gq < 4; ++gq) xqn[gq] = *(const GAS u32x2*)(xrow_ + 8 * gq); } while (0)
#define P6_UEPI(sq_) do { const int t_ = (sq_) >> 3; \
        f32x4 x2[4]; float ss = 0.f; \
        _Pragma("unroll") for (int gq = 0; gq < 4; ++gq) { \
            const u32x2 xq_ = xqn[gq]; \
            x2[gq] = (f32x4){__uint_as_float(xq_.x << 16), __uint_as_float(xq_.x & 0xffff0000u), __uint_as_float(xq_.y << 16), __uint_as_float(xq_.y & 0xffff0000u)} \
                + (f32x4){uacc[4 * gq], uacc[4 * gq + 1], uacc[4 * gq + 2], uacc[4 * gq + 3]} * (1.0f / P6_SU4); \
            ss += (x2[gq].x * x2[gq].x + x2[gq].y * x2[gq].y) + (x2[gq].z * x2[gq].z + x2[gq].w * x2[gq].w); } \
        const float rn = 1.0f / sqrtf(wave_sum(ss) * (1.0f / DM) + EPSF);     \
          \
        _Pragma("unroll") for (int gq = 0; gq < 4; ++gq) *(LAS f32x4*)(wl + ui * 144 + 32 * gq + 16 * ug) = x2[gq] * rn * gvu[gq]; \
        _Pragma("unroll") for (int k = 0; k < 4; ++k) { const int d_ = 4 * lane_u + 256 * k; const f32x4 ov_ = *(const LAS f32x4*)(wl + (d_ >> 5) * 144 + (d_ & 31) * 4); \
            if ((P6_UPROBE & 8) && PARTS == 2) asm volatile("" :: "v"(ov_)); else __builtin_nontemporal_store(ov_, (GAS f32x4*)(a.out + (size_t)(tok0 + t_) * DM + d_)); } \
        uacc = f32x16{}; } while (0)
    if (PARTS & 2) {
        u32x4 bqA[8], bqB[8]; f32x16 uacc = f32x16{};
        if ((P6_UPROBE & 1) && PARTS == 2 && EMASK != 0xffff) {
#pragma unroll
            for (int q = 0; q < 8; ++q) { bqA[q] = (u32x4){(unsigned)lane, 1u, 2u, 3u}; bqB[q] = bqA[q]; } }
        P6_ULOAD(bqA, 0);
#pragma unroll 1
        for (int sq = 0; sq < 128; sq += 2) {
            if ((sq & 7) == 0) P6_UXPREF(sq >> 3);
            P6_ULOAD(bqB, sq + 1);
            P6_UMMA(bqA, sq);
            P6_ULOAD(bqA, (sq + 2 < 128 ? sq + 2 : sq));
            P6_UMMA(bqB, sq + 1);
            if (((sq + 1) & 7) == 7) { if ((P6_UPROBE & 4) && PARTS == 2) { asm volatile("" : "+v"(uacc)); uacc = f32x16{}; } else P6_UEPI(sq + 1); }
        }
    }
#undef P6_ULOAD
#undef P6_UMMA
#undef P6_UEPI
#undef P6_UXPREF
#undef MFMA32S
}

#ifndef MK_N_LAUNCHES
#define MK_N_LAUNCHES 1
#endif
constexpr int NPHASE = 7;

__device__ __forceinline__ int queue_next(unsigned* ctr, volatile LAS unsigned* slot) {
    __syncthreads();
    if (threadIdx.x == 0) *slot = __hip_atomic_fetch_add(ctr, 1u, __ATOMIC_RELAXED, __HIP_MEMORY_SCOPE_AGENT);
    __syncthreads();
    return (int)*slot;
}

__global__ void __launch_bounds__(NTHR, 2) hymba_fwd(Args a) {
    extern __shared__ __attribute__((aligned(16))) unsigned char lds_raw[];
    lds_u8* lds = (lds_u8*)lds_raw;
    volatile LAS unsigned* MISC = (volatile LAS unsigned*)(lds + MISC_OFF);
    const int tid = threadIdx.x, lane = tid & 63; const int wave = __builtin_amdgcn_readfirstlane(tid >> 6);
    const int G = gridDim.x; const int bx = blockIdx.x;
    const int vcu = (G % 8 == 0) ? (bx % 8) * (G / 8) + bx / 8 : bx;
    const int gw = vcu * NWAVES + wave, NGW = G * NWAVES;
    for (int u = tid; u < (LDS_BYTES - MISC_OFF) / 4; u += NTHR) MISC[u] = 0u;
    __syncthreads();
    const int lo = a.ph_lo, hi = a.ph_hi;
    const bool use_bar = (hi - lo) > 1;
    XcdBarrier bar; bar.bar = (unsigned*)(a.ws + WS_CTL); bar.x = 0; bar.st = MISC + 8;
    if (use_bar) bar = xcd_barrier_post((unsigned*)(a.ws + WS_CTL), MISC + 8);
#ifndef PH_MASK
#define PH_MASK 127
#endif
#define IN(k) (((PH_MASK >> (k)) & 1) && lo <= (k) && (k) < hi)
#ifdef DBL_BAR
#define SEAM(k) do { if (IN(k) && IN((k) + 1)) { xcd_barrier(bar); xcd_barrier(bar); } } while (0)
#else
#define SEAM(k) do { if (IN(k) && IN((k) + 1)) xcd_barrier(bar); } while (0)
#endif
    unsigned char* ws = a.ws;

    if (IN(0)) { p0_prologue(a, lds, gw, NGW, lane, wave);
#ifdef DBL_P0
        __syncthreads(); p0_prologue(a, lds, gw, NGW, lane, wave);
#endif
    }
    SEAM(0);
    if (IN(1)) {
        pg8::Gemm g{(const bf16_t*)(ws + WS_XB), (const bf16_t*)(ws + WS_WIN), MTOK, NIN, DM}; pg8::StaticOrder S; S.init(MTOK, NIN, G, bx);
        EpiProj E{(bf16_t*)(ws + WS_PROJ), (const float*)(ws + WS_R1), (const f32x4*)(ws + WS_ROPE), (const float*)(ws + WS_DECAY)};
        pg8::gemm_phase<EpiProj, pg8::StaticOrder>(lds, g, S, E);
#ifdef DBL_P1
        pg8::gemm_phase<EpiProj, pg8::StaticOrder>(lds, g, S, E);
#endif
    }
    SEAM(1);
    if (IN(2)) {
#ifdef DBL_P2
        for (int rep = 0; rep < 2; ++rep) {
        unsigned* ctr = (unsigned*)(ws + WS_CTL + CTL_Q_ATT + rep * 256);
#else
        {
        unsigned* ctr = (unsigned*)(ws + WS_CTL + CTL_Q_ATT);
#endif
        int tkt = queue_next(ctr, MISC + 16);
        for (;;) {
            int u = tkt;
            if (u >= 64 + 1024 + DEF_ITEMS / 5) break;
            static_assert(DEF_ITEMS % 5 == 0 && DEF_ITEMS / 5 == 1024 / 4, "P2 ticket pattern");
            if (u >= 64) { const int i5 = (u - 64) / 5, r5 = (u - 64) % 5;
                if (r5 == 4) {
#ifdef PROBE_P2
                    if (rep == 0 && !(PROBE_P2 & 4)) { tkt = queue_next(ctr, MISC + 16); continue; }
#endif
                    for (int k = 0; k < 5; ++k) p0_deferred(a, lds, i5 * 5 + k);
                    tkt = queue_next(ctr, MISC + 16); continue; }
                u = 64 + i5 * 4 + r5; }
#ifdef PROBE_P2
            if (rep == 0) { if (u >= 64 && (PROBE_P2 & 2)) { const int v = u - 64; attn_unit<PROBE_ATT>(a, lds, (v & 31) >> 2, v & 3, 31 - (v >> 5)); tkt = queue_next(ctr, MISC + 16); continue; }
                if (u < 64 && (PROBE_P2 & 1)) ret_unit(a, lds, u >> 3, u & 7);
                tkt = queue_next(ctr, MISC + 16); continue; }
#endif
            if (u < 64) { ret_unit(a, lds, u >> 3, u & 7); tkt = queue_next(ctr, MISC + 16); }
            else { const int v = u - 64; attn_unit<7>(a, lds, (v & 31) >> 2, v & 3, 31 - (v >> 5)); tkt = queue_next(ctr, MISC + 16); }
        }
        }
    }
    SEAM(2);
    if (IN(3)) {
        pg8::Gemm g{(const bf16_t*)(ws + WS_MIX), (const bf16_t*)(ws + WS_WOUT), MTOK, DM, DM}; pg8::StaticOrder S; S.init(MTOK, DM, G, bx);
        EpiX1 E{(const bf16_t*)(ws + WS_XB), (bf16_t*)(ws + WS_X1B), (bf16_t*)(ws + WS_SSQ)};
        pg8::gemm_phase<EpiX1, pg8::StaticOrder>(lds, g, S, E);

    }
    SEAM(3);
    if (IN(4)) {
        pg8::Gemm g{(const bf16_t*)(ws + WS_X1B), (const bf16_t*)(ws + WS_WPQ), MTOK, NQ, DM}; pg8::StaticOrder S; S.init(MTOK, NQ, G, bx);
        EpiQ E{(bf16_t*)(ws + WS_PROJ), (const bf16_t*)(ws + WS_SSQ)};
        pg8::gemm_phase<EpiQ, pg8::StaticOrder>(lds, g, S, E);
#ifdef DBL_P4
        pg8::gemm_phase<EpiQ, pg8::StaticOrder>(lds, g, S, E);
#endif
    }
    SEAM(4);
    if (IN(3)) {
#ifdef DBL_P3
        { unsigned long long w2 = (unsigned long long)ws; asm volatile("" : "+s"(w2)); unsigned char* ws2 = (unsigned char*)w2; int bx2 = bx; asm volatile("" : "+s"(bx2));
          pg8::Gemm g2{(const bf16_t*)(ws2 + WS_MIX), (const bf16_t*)(ws2 + WS_WOUT), MTOK, DM, DM}; pg8::StaticOrder S2; S2.init(MTOK, DM, G, bx2);
          EpiX1 E2{(const bf16_t*)(ws2 + WS_XB), (bf16_t*)(ws2 + WS_X1B), (bf16_t*)(ws2 + WS_SSQ)};
          pg8::gemm_phase<EpiX1, pg8::StaticOrder>(lds, g2, S2, E2); }
#endif
    }
    if (IN(5)) p5_topk(a, lds);
    SEAM(5);
#ifdef DBL_P5
    if (IN(5)) { Args a2 = a; asm volatile("" : "+s"(a2.ws)); p5_topk(a2, lds); }
#endif
    if (IN(6)) {
#ifdef P6_TOKEN_MAJOR
        lds_u8* wl = lds + wave * P6_WSCR;
        for (int tok = gw; tok < MTOK; tok += NGW) p6_token(a, wl, tok, lane, a.out);
#else
#ifdef PROBE_EMASK
        for (int tb = gw; tb < MTOK / 16; tb += NGW) p6_slices<PROBE_EMASK, PROBE_PARTS>(a, lds + wave * P6S_WAVE, tb * 16, lane);
#endif
#ifdef DBL_P6
#pragma unroll 1
        for (int rep6 = 0; rep6 < 2; ++rep6)
#endif
        for (int tb = gw; tb < MTOK / 16; tb += NGW) p6_slices<0xffff, 3>(a, lds + wave * P6S_WAVE, tb * 16, lane);
#endif
    }
#ifdef DBG_DUMP
    if (hi - lo > 1) xcd_barrier(bar);
    {
        for (int m = gw; m < MTOK; m += NGW) {
            for (int c = lane; c < DM; c += 64) {
                float v = 0.f;
#if DBG_DUMP == 1
                v = bf2f(((const bf16_t*)(ws + WS_PROJ))[(size_t)m * NIN + DBG_COL + c]);
#elif DBG_DUMP == 2
                v = (c >= DBG_C0 && c < DBG_C1) ? bf2f(((const bf16_t*)(ws + WS_MIX))[(size_t)m * DM + c]) : 0.f;
#endif
                a.out[(size_t)m * DM + c] = v;
            }
        }
    }
#endif
#undef IN
#undef SEAM
}

extern "C" void kernel_launch(void* const* d_in, const int* in_sizes, int n_in, void* d_out, int out_size, void* d_ws, size_t ws_size, hipStream_t stream) {
    static int grid = 0;
    if (grid == 0) {
        if (n_in != 17 || in_sizes[0] != MTOK * DM || out_size != MTOK * DM || ws_size < WS_END) {
            fprintf(stderr, "kernel_launch: unexpected shapes (n_in %d, in0 %d, out %d, ws %zu < %zu); nothing launched\n", n_in, n_in > 0 ? in_sizes[0] : -1, out_size, ws_size, (size_t)WS_END); grid = -1; return; }
        int dev = 0, cus = 0, per_cu = 0;
        if (hipGetDevice(&dev) != hipSuccess || hipDeviceGetAttribute(&cus, hipDeviceAttributeMultiprocessorCount, dev) != hipSuccess) { fprintf(stderr, "kernel_launch: device query failed\n"); grid = -1; return; }
        if (hipFuncSetAttribute((const void*)hymba_fwd, hipFuncAttributeMaxDynamicSharedMemorySize, LDS_BYTES) != hipSuccess) { fprintf(stderr, "kernel_launch: hipFuncSetAttribute failed\n"); grid = -1; return; }
        if (hipOccupancyMaxActiveBlocksPerMultiprocessor(&per_cu, (const void*)hymba_fwd, NTHR, LDS_BYTES) != hipSuccess || per_cu < 1)
            fprintf(stderr, "kernel_launch: note: occupancy query reports %d workgroups per CU\n", per_cu);
        (void)hipGetLastError();
        grid = cus;
    }
    if (grid < 0) return;
    if (hipMemsetAsync((char*)d_ws + WS_CTL, 0, CTL_BYTES, stream) != hipSuccess) { fprintf(stderr, "kernel_launch: memset failed\n"); return; }
    Args a{};
    for (int i = 0; i < 17; ++i) a.in[i] = (const float*)d_in[i];
    a.out = (float*)d_out; a.ws = (unsigned char*)d_ws;
#if MK_N_LAUNCHES == 1
#ifdef DBG_STOP
    a.ph_lo = 0; a.ph_hi = DBG_STOP + 1;
#else
    a.ph_lo = 0; a.ph_hi = NPHASE;
#endif
    hipLaunchKernelGGL(hymba_fwd, dim3(grid), dim3(NTHR), LDS_BYTES, stream, a);
#else
    for (int p = 0; p < NPHASE; ++p) { a.ph_lo = p; a.ph_hi = p + 1; hipLaunchKernelGGL(hymba_fwd, dim3(grid), dim3(NTHR), LDS_BYTES, stream, a); }
#endif
    const hipError_t le = hipPeekAtLastError();
    if (le != hipSuccess) fprintf(stderr, "kernel_launch: launch failed: %s\n", hipGetErrorName(le));
}
```

```cpp
#include <hip/hip_runtime.h>
#include <cstdio>
#include <cstdint>

namespace pg8 {
#define PG8_LAS __attribute__((address_space(3)))
typedef unsigned short bf16_t;
typedef short bf16x8 __attribute__((ext_vector_type(8)));
typedef float f32x4 __attribute__((ext_vector_type(4)));
typedef unsigned u32x4 __attribute__((ext_vector_type(4)));
constexpr int BM = 256, BK = 64, HALF = 128, HTB = HALF * BK * 2  , STAGE_BYTES = 8 * HTB, NXCD = 8, WGM = 8;

__host__ __device__ __forceinline__ int lds_byte(int r, int c) { const int st = (r >> 4) * 2 + (c >> 5), rr = r & 15, cc = c & 31, ob = rr * 64 + cc * 2; return st * 1024 + (ob ^ (((ob >> 9) & 1) << 5)); }
__host__ __device__ __forceinline__ void stage_rc(int b, int& R, int& C) { const int st = b / 1024, sb = b % 1024, swz = sb ^ (((sb >> 9) & 1) << 5); R = (st >> 1) * 16 + swz / 64; C = (st & 1) * 32 + (swz % 64) / 2; }
__host__ __device__ __forceinline__ int perm32(int rho) { const int n = rho >> 4, i = rho & 15; return 8 * (i >> 2) + 4 * n + (i & 3); }

struct Unit { int pm, pn; };
struct Gemm { const bf16_t* A; const bf16_t* Bt; int M, N, K; };

struct StaticOrder {
    int nM, nN, nwg, G, c;
    __host__ __device__ void init(int M, int N, int G_, int c_) { nM = M / BM; nN = N / BM; nwg = nM * nN; G = G_; c = c_; }
    __host__ __device__ bool next(int i, Unit& u) const {
        const long L = (long)i * G + c; if (L >= nwg) return false;
        int wgid = (int)L; { const int q = nwg / NXCD, r = nwg % NXCD, xcd = wgid % NXCD, off = wgid / NXCD; wgid = (xcd < r ? xcd * (q + 1) : r * (q + 1) + (xcd - r) * q) + off; }
        const int nig = WGM * nN, gid = wgid / nig, fm = gid * WGM, gsz = (nM - fm) < WGM ? (nM - fm) : WGM;
        u.pm = fm + ((wgid % nig) % gsz); u.pn = (wgid % nig) / gsz; return true;
    }
    __device__ __forceinline__ void a_ready(const Unit&) const {}
    __device__ __forceinline__ void done(const Unit&) const {}
};
__device__ __forceinline__ unsigned cvt_pk_bf16(float lo, float hi) { unsigned r; asm volatile("v_cvt_pk_bf16_f32 %0, %1, %2" : "=v"(r) : "v"(lo), "v"(hi)); return r; }
template <class Epi, class Sched>
__device__ __forceinline__ void gemm_phase(PG8_LAS unsigned char* lds, const Gemm g, const Sched& S, const Epi& E) {
    const int tid = threadIdx.x, wid = __builtin_amdgcn_readfirstlane(tid >> 6), lane = tid & 63, wr = wid >> 2, wc = wid & 3, fr = lane & 15, fq = lane >> 4;
    const int K = g.K, nt = K / BK;
    unsigned voffA[2], voffB[2];
#pragma unroll
    for (int i = 0; i < 2; ++i) { int R, C; stage_rc(tid * 16 + i * 8192, R, C); const int Rb = Epi::PERM ? ((R & ~31) + perm32(R & 31)) : R;
        voffA[i] = (unsigned)(R * K + C) * 2u; voffB[i] = (unsigned)(Rb * K + C) * 2u; }
    const size_t kstep = (size_t)(BK * 2);
    const size_t hstep = (size_t)HALF * K * 2;
    const size_t tstep = 2 * hstep;
    const unsigned ldsw = (unsigned)wid * 1024u;
    const int aoff = lds_byte(wr * 64 + fr, fq * 8), boff = lds_byte(wc * 32 + fr, fq * 8);
#define PG8_SA(b, h) (((b) * 2 + (h)) * HTB)
#define PG8_SB(b, h) ((4 + (b) * 2 + (h)) * HTB)
#define PG8_STAGE(bufoff, gbase, voff) do { _Pragma("unroll") for (int _i = 0; _i < 2; ++_i) \
        __builtin_amdgcn_global_load_lds((const unsigned*)((const char*)(gbase) + (voff)[_i]), (PG8_LAS unsigned*)(lds + (bufoff) + ldsw + _i * 8192), 16, 0, 0); } while (0)
#define PG8_LDA(dst, b, h) do { _Pragma("unroll") for (int m = 0; m < 4; ++m) _Pragma("unroll") for (int k = 0; k < 2; ++k) dst[m][k] = *(const PG8_LAS bf16x8*)(lds + PG8_SA(b, h) + aoff + m * 2048 + k * 1024); } while (0)
#define PG8_LDB(dst, b, h) do { _Pragma("unroll") for (int n = 0; n < 2; ++n) _Pragma("unroll") for (int k = 0; k < 2; ++k) dst[n][k] = *(const PG8_LAS bf16x8*)(lds + PG8_SB(b, h) + boff + n * 2048 + k * 1024); } while (0)
#define PG8_MMA(ai, bj, At, Bt) do { __builtin_amdgcn_s_setprio(1); _Pragma("unroll") for (int m = 0; m < 4; ++m) _Pragma("unroll") for (int n = 0; n < 2; ++n) _Pragma("unroll") for (int k = 0; k < 2; ++k) \
        acc[ai][bj][m][n] = __builtin_amdgcn_mfma_f32_16x16x32_bf16(Bt[n][k], At[m][k], acc[ai][bj][m][n], 0, 0, 0); __builtin_amdgcn_s_setprio(0); } while (0)
#define PG8_WAIT_V(n) asm volatile("s_waitcnt vmcnt(" #n ")" ::: "memory")
#define PG8_WAIT_L(n) asm volatile("s_waitcnt lgkmcnt(" #n ")" ::: "memory")
#define PG8_BAR __builtin_amdgcn_s_barrier()
#define PG8_SCHED __builtin_amdgcn_sched_barrier(0)
    Unit cur, nxt; int ui = 0;
    if (!S.next(0, cur)) return;
    f32x4 acc[2][2][4][2];
#pragma unroll
    for (int a = 0; a < 2; ++a)
#pragma unroll
        for (int b = 0; b < 2; ++b)
#pragma unroll
            for (int m = 0; m < 4; ++m)
#pragma unroll
                for (int n = 0; n < 2; ++n) acc[a][b][m][n] = (f32x4){0.f, 0.f, 0.f, 0.f};
    bf16x8 At[4][2], B0[2][2], B1[2][2];
    const char* cA = (const char*)g.A + (size_t)cur.pm * tstep; const char* cB = (const char*)g.Bt + (size_t)cur.pn * tstep;
    S.a_ready(cur);
    PG8_STAGE(PG8_SB(0, 0), cB, voffB); PG8_STAGE(PG8_SA(0, 0), cA, voffA); PG8_STAGE(PG8_SB(0, 1), cB + hstep, voffB); PG8_STAGE(PG8_SA(0, 1), cA + hstep, voffA);
    if (wr == 1) PG8_BAR;
    PG8_WAIT_V(4); PG8_BAR;
    PG8_STAGE(PG8_SB(1, 0), cB + kstep, voffB); PG8_STAGE(PG8_SA(1, 0), cA + kstep, voffA); PG8_STAGE(PG8_SB(1, 1), cB + hstep + kstep, voffB);
    PG8_WAIT_V(6); PG8_BAR;
    for (;;) {
        const bool has_next = S.next(ui + 1, nxt);
        const char* nA = has_next ? (const char*)g.A + (size_t)nxt.pm * tstep : cA; const char* nB = has_next ? (const char*)g.Bt + (size_t)nxt.pn * tstep : cB;
        for (int t = 0; t < nt; t += 2) {
            const bool last = (t == nt - 2);
            const char* a1 = cA + (size_t)(t + 1) * kstep;
            const char* a2 = last ? nA : cA + (size_t)(t + 2) * kstep; const char* b2 = last ? nB : cB + (size_t)(t + 2) * kstep;
            const char* a3 = a2 + kstep; const char* b3 = b2 + kstep;
            if (last && has_next) S.a_ready(nxt);
            PG8_LDB(B0, 0, 0); PG8_SCHED; PG8_LDA(At, 0, 0); PG8_STAGE(PG8_SA(1, 1), a1 + hstep, voffA);
            PG8_WAIT_L(8); PG8_BAR; PG8_WAIT_L(0); PG8_MMA(0, 0, At, B0); PG8_BAR; PG8_SCHED;
            PG8_LDB(B1, 0, 1); PG8_STAGE(PG8_SB(0, 0), b2, voffB);
            PG8_BAR; PG8_WAIT_L(0); PG8_MMA(0, 1, At, B1); PG8_BAR;
            PG8_LDA(At, 0, 1); PG8_STAGE(PG8_SA(0, 0), a2, voffA);
            PG8_BAR; PG8_WAIT_L(0); PG8_MMA(1, 0, At, B0); PG8_BAR; PG8_SCHED;
            PG8_STAGE(PG8_SB(0, 1), b2 + hstep, voffB);
            PG8_WAIT_V(6); PG8_BAR; PG8_MMA(1, 1, At, B1); PG8_BAR;
            PG8_LDB(B0, 1, 0); PG8_SCHED; PG8_LDA(At, 1, 0); PG8_STAGE(PG8_SA(0, 1), a2 + hstep, voffA);
            PG8_WAIT_L(8); PG8_BAR; PG8_WAIT_L(0); PG8_MMA(0, 0, At, B0); PG8_BAR; PG8_SCHED;
            PG8_LDB(B1, 1, 1); PG8_STAGE(PG8_SB(1, 0), b3, voffB);
            PG8_BAR; PG8_WAIT_L(0); PG8_MMA(0, 1, At, B1); PG8_BAR;
            PG8_LDA(At, 1, 1); PG8_STAGE(PG8_SA(1, 0), a3, voffA);
            PG8_BAR; PG8_WAIT_L(0); PG8_MMA(1, 0, At, B0); PG8_BAR; PG8_SCHED;
            PG8_STAGE(PG8_SB(1, 1), b3 + hstep, voffB);
            PG8_WAIT_V(6); PG8_BAR; PG8_MMA(1, 1, At, B1); PG8_BAR;
        }
        if constexpr (!Epi::AFTER_DRAIN) { E(acc, cur, wr, wc, fr, fq); S.done(cur); }
        if (!has_next) break;
#pragma unroll
        for (int a = 0; a < 2; ++a)
#pragma unroll
            for (int b = 0; b < 2; ++b)
#pragma unroll
                for (int m = 0; m < 4; ++m)
#pragma unroll
                    for (int n = 0; n < 2; ++n) acc[a][b][m][n] = (f32x4){0.f, 0.f, 0.f, 0.f};
        cur = nxt; cA = nA; cB = nB; ++ui;
    }
    PG8_WAIT_V(0);
    if (wr == 0) PG8_BAR;
    PG8_BAR;
    if constexpr (Epi::AFTER_DRAIN) { E.fused(acc, cur, wr, wc, fr, fq, lds, wid, lane); S.done(cur); }
#undef PG8_SA
#undef PG8_SB
#undef PG8_STAGE
#undef PG8_LDA
#undef PG8_LDB
#undef PG8_MMA
#undef PG8_WAIT_V
#undef PG8_WAIT_L
#undef PG8_BAR
#undef PG8_SCHED
}
}

#define XB_TMO      128
#define XB_XCNT(j)  (256  + 64 * (j))
#define XB_XSUB(j)  (1280 + 64 * (j))
#define XB_XGEN(j)  (2304 + 64 * (j))
#define XB_TOP      3328
#define XB_TOPGEN   3392
#define XCD_BAR_WORDS 3456
#define XB_SPIN_CAP (1u << 18)
#define LAS __attribute__((address_space(3)))

__device__ __forceinline__ unsigned xb_ld(unsigned* p)              { return __hip_atomic_load(p, __ATOMIC_RELAXED, __HIP_MEMORY_SCOPE_AGENT); }
__device__ __forceinline__ unsigned xb_add(unsigned* p, unsigned v) { return __hip_atomic_fetch_add(p, v, __ATOMIC_RELAXED, __HIP_MEMORY_SCOPE_AGENT); }
__device__ __forceinline__ unsigned xb_xcc_id() { return (unsigned)__builtin_amdgcn_s_getreg((3 << 11) | 20) & 0xFu; }
#define XB_SPIN(cond, bar) do { unsigned _sp = 0; while (cond) { __builtin_amdgcn_s_sleep(1); \
    if ((++_sp & 255u) == 0u) { if (xb_ld(&(bar)[XB_TMO])) break; if (_sp > XB_SPIN_CAP) { atomicAdd(&(bar)[XB_TMO], 1u); break; } } } } while (0)

struct XcdBarrier {
    unsigned* bar; unsigned x;
    volatile LAS unsigned* st;
};

__device__ __forceinline__ XcdBarrier xcd_barrier_post(unsigned* bar, volatile LAS unsigned* st) {
    XcdBarrier b; b.bar = bar; b.x = xb_xcc_id(); b.st = st;
    if (threadIdx.x == 0) (void)xb_add(&bar[XB_XCNT(b.x)], 1u);
    return b;
}
__device__ __forceinline__ void xcd_barrier_complete(unsigned* bar, unsigned x, unsigned& nloc, unsigned& nx) {
    const unsigned G = gridDim.x * gridDim.y * gridDim.z;
    unsigned sum, cnt, mine, sp = 0u;
    for (;;) {
        sum = 0u; cnt = 0u; mine = 0u;
#pragma unroll
        for (unsigned j = 0; j < 16; ++j) { const unsigned c = xb_ld(&bar[XB_XCNT(j)]); sum += c; cnt += (c > 0u) ? 1u : 0u; mine = (j == x) ? c : mine; }
        if (sum == G) break;
        __builtin_amdgcn_s_sleep(1);
        if ((++sp & 255u) == 0u) { if (xb_ld(&bar[XB_TMO])) break; if (sp > XB_SPIN_CAP) { atomicAdd(&bar[XB_TMO], 1u); break; } }
    }
    nloc = mine > 0u ? mine : 1u; nx = cnt > 0u ? cnt : 1u;
}

__device__ __forceinline__ void xcd_barrier(const XcdBarrier& b) {
    asm volatile("s_waitcnt vmcnt(0)" ::: "memory");
    __syncthreads();
    if (threadIdx.x == 0) {
        unsigned* bar = b.bar;
        __builtin_amdgcn_s_waitcnt(0);
        unsigned nloc = b.st[0], nx = b.st[1];
        if (nloc == 0u) { xcd_barrier_complete(bar, b.x, nloc, nx); b.st[0] = nloc; b.st[1] = nx; }
        const unsigned old = xb_add(&bar[XB_XSUB(b.x)], 1u);
        const unsigned gen = old / nloc;
        if (old + 1u == (gen + 1u) * nloc) {
            __builtin_amdgcn_fence(__ATOMIC_RELEASE, "agent");
            asm volatile("s_waitcnt vmcnt(0)" ::: "memory");
            const unsigned og = xb_add(&bar[XB_TOP], 1u);
            const unsigned tg = og / nx;
            if (og + 1u == (tg + 1u) * nx) xb_add(&bar[XB_TOPGEN], 1u);
            else XB_SPIN(xb_ld(&bar[XB_TOPGEN]) == tg, bar);
            __builtin_amdgcn_fence(__ATOMIC_ACQUIRE, "agent");
            xb_add(&bar[XB_XGEN(b.x)], 1u);
            asm volatile("s_waitcnt vmcnt(0)" ::: "memory");
        } else {
            XB_SPIN(xb_ld(&bar[XB_XGEN(b.x)]) == gen, bar);
            __builtin_amdgcn_fence(__ATOMIC_ACQUIRE, "agent");
            asm volatile("s_waitcnt vmcnt(0)" ::: "memory");
        }
    }
    __syncthreads();
}

#define GAS __attribute__((address_space(1)))
typedef unsigned short bf16_t;
typedef short bf16x8 __attribute__((ext_vector_type(8)));
typedef short s16x4 __attribute__((ext_vector_type(4)));
typedef float f32x4 __attribute__((ext_vector_type(4)));
typedef float f32x2 __attribute__((ext_vector_type(2)));
typedef float f32x16 __attribute__((ext_vector_type(16)));
typedef unsigned u32x4 __attribute__((ext_vector_type(4)));
typedef unsigned u32x2 __attribute__((ext_vector_type(2)));
typedef LAS unsigned char lds_u8;

constexpr int MTOK = 32768, DM = 1024, SEQ = 4096, NBATCH = 8, NIN = 3584;
constexpr int OFF_RQ = 0, OFF_RK = 512, OFF_RV = 1024, OFF_RG = 1536, OFF_DQ = 2048, OFF_DK = 2560, OFF_DV = 3072;
constexpr int NEXP = 16384, NQ = 2048;
constexpr float EPSF = 1e-6f, LOG2E = 1.4426950408889634f;
constexpr int NWAVES = 8, NTHR = 512;

constexpr size_t WS_CTL = 0, CTL_BYTES = 65536;
constexpr size_t CTL_Q_ATT = 16384, CTL_Q_P6 = 16384 + 1024;
constexpr size_t WS_R1 = WS_CTL + CTL_BYTES;
constexpr size_t WS_SSQ = WS_R1 + (size_t)MTOK * 4;
constexpr size_t WS_ROPE = WS_SSQ + (size_t)MTOK * 16 * 4;
constexpr size_t WS_DECAY = WS_ROPE + (size_t)SEQ * 32 * 8;
constexpr size_t WS_BTAB = WS_DECAY + 2 * 8 * 128 * 4;
constexpr size_t WS_LAM = WS_BTAB + 4 * 128 * 4;
constexpr size_t WS_WIN = 4u << 20;
constexpr size_t WS_WOUT = WS_WIN + (size_t)NIN * DM * 2;
constexpr size_t WS_WPQ = WS_WOUT + (size_t)DM * DM * 2;
constexpr size_t WS_KEYS = WS_WPQ + (size_t)NQ * DM * 2;
constexpr size_t WS_WD = WS_KEYS + (size_t)8 * 2 * 128 * 128 * 2;
constexpr size_t WS_WU = WS_WD + (size_t)NEXP * DM * 2;
constexpr size_t WS_XB = WS_WU + (size_t)NEXP * DM * 2;
constexpr size_t WS_PROJ = WS_XB + (size_t)MTOK * DM * 2;
constexpr size_t WS_MIX = WS_PROJ + (size_t)MTOK * NIN * 2;
constexpr size_t WS_IDX = WS_MIX, WS_GATE = WS_MIX + (size_t)MTOK * 128 * 4;
constexpr size_t WS_X1B = WS_PROJ + (size_t)MTOK * NQ * 2;
static_assert(WS_X1B + (size_t)MTOK * DM * 2 <= WS_MIX, "ws map");
constexpr size_t WS_END = WS_MIX + (size_t)MTOK * DM * 2;
static_assert(WS_LAM + 256 <= WS_WIN, "ws map");
static_assert(WS_END <= (size_t)512 << 20, "ws map");

constexpr int LDS_SCRATCH = 139264;
constexpr int MISC_OFF = LDS_SCRATCH;
constexpr int LDS_BYTES = 147456;

__device__ __forceinline__ float wave_sum(float v) {
    v += __uint_as_float(__builtin_amdgcn_update_dpp(0u, __float_as_uint(v), 0xB1, 0xf, 0xf, true));
    v += __uint_as_float(__builtin_amdgcn_update_dpp(0u, __float_as_uint(v), 0x4E, 0xf, 0xf, true));
    v += __uint_as_float(__builtin_amdgcn_update_dpp(0u, __float_as_uint(v), 0x141, 0xf, 0xf, true));
    v += __uint_as_float(__builtin_amdgcn_update_dpp(0u, __float_as_uint(v), 0x140, 0xf, 0xf, true));
    { auto rr = __builtin_amdgcn_permlane16_swap(__float_as_uint(v), __float_as_uint(v), false, false); v = __uint_as_float(rr[0]) + __uint_as_float(rr[1]); }
    { auto rr = __builtin_amdgcn_permlane32_swap(__float_as_uint(v), __float_as_uint(v), false, false); v = __uint_as_float(rr[0]) + __uint_as_float(rr[1]); }
    return v;
}
typedef __bf16 bf16v2_t __attribute__((ext_vector_type(2)));
__device__ __forceinline__ unsigned pk2(float lo, float hi) { const bf16v2_t v = {(__bf16)lo, (__bf16)hi}; return __builtin_bit_cast(unsigned, v); }
__device__ __forceinline__ float bf2f(unsigned short b) { return __uint_as_float(((unsigned)b) << 16); }
#define LDS_WAIT() asm volatile("s_waitcnt lgkmcnt(0)" ::: "memory")
#define VM_WAIT() asm volatile("s_waitcnt vmcnt(0)" ::: "memory")

struct Args {
    const float* in[17]; float* out; unsigned char* ws; int ph_lo, ph_hi;
};

template <int MODE>
__device__ __forceinline__ void p0_transpose_item(const float* W, const float* scale, int K, int N, bf16_t* WT, LAS float* scr, int item, int lane) {
    const int nblk = N / 32, kb = item / nblk, nb = item % nblk, k0 = 64 * kb, n0 = 32 * nb;
#pragma unroll 8
    for (int i = 0; i < 32; ++i) { const int kk = 2 * i + (lane >> 5); const float sc = scale ? scale[k0 + kk] : 1.0f; scr[kk * 33 + (lane & 31)] = __builtin_nontemporal_load((const GAS float*)(W + (size_t)(k0 + kk) * N + n0 + (lane & 31))) * sc; }
    LDS_WAIT();
    const int c = lane & 7;
#pragma unroll
    for (int j = 0; j < 4; ++j) { const int n = (lane >> 3) + 8 * j; const LAS float* s = scr + (8 * c) * 33 + n;
        u32x4 o; o.x = pk2(s[0 * 33], s[1 * 33]); o.y = pk2(s[2 * 33], s[3 * 33]); o.z = pk2(s[4 * 33], s[5 * 33]); o.w = pk2(s[6 * 33], s[7 * 33]);
        int nn = n0 + n;
        if (MODE == 1 && nn < 1024) { const int d = nn & 63; nn = (nn & ~63) + ((d < 32) ? 2 * d : 2 * (d - 32) + 1); }
        *(GAS u32x4*)(WT + (size_t)nn * K + k0 + 8 * c) = o; }
    LDS_WAIT();
}

__device__ __forceinline__ int t5_bucket(int n) {
    if (n < 16) return n;
    const float v = logf((float)n / 16.0f) / 2.0794415416798357f * 16.0f;
    int b = 16 + (int)v; return b > 31 ? 31 : b;
}

__device__ __forceinline__ void p0_prologue(const Args& a, lds_u8* lds, int gw, int NGW, int lane, int wave) {
    unsigned char* ws = a.ws;
    const float* x = a.in[0];
    bf16_t* xb = (bf16_t*)(ws + WS_XB); float* r1 = (float*)(ws + WS_R1);
    for (int m0 = gw; m0 < MTOK; m0 += 4 * NGW) {
        f32x4 v[4][4];
#pragma unroll
        for (int r = 0; r < 4; ++r) { const int m = m0 + r * NGW; const GAS f32x4* xr = (const GAS f32x4*)(x + (size_t)(m < MTOK ? m : m0) * DM) + lane;
#pragma unroll
            for (int j = 0; j < 4; ++j) v[r][j] = __builtin_nontemporal_load(xr + 64 * j); }
#pragma unroll
        for (int r = 0; r < 4; ++r) { const int m = m0 + r * NGW; if (m >= MTOK) break;
            float s = 0.f;
#pragma unroll
            for (int j = 0; j < 4; ++j) s += (v[r][j].x * v[r][j].x + v[r][j].y * v[r][j].y) + (v[r][j].z * v[r][j].z + v[r][j].w * v[r][j].w);
            s = wave_sum(s);
            GAS u32x2* o8 = (GAS u32x2*)(xb + (size_t)m * DM) + lane;
#pragma unroll
            for (int j = 0; j < 4; ++j) { u32x2 o; o.x = pk2(v[r][j].x, v[r][j].y); o.y = pk2(v[r][j].z, v[r][j].w); o8[64 * j] = o; }
            if (lane == 0) r1[m] = 1.0f / sqrtf(s * (1.0f / DM) + EPSF); }
    }
    {
        LAS float* scr = (LAS float*)(lds + wave * 8704);
        constexpr int I_IN = (DM / 64) * (NIN / 32);
        for (int it = gw; it < I_IN; it += NGW) p0_transpose_item<1>(a.in[2], a.in[1], DM, NIN, (bf16_t*)(ws + WS_WIN), scr, it, lane);
    }
    const int gt = gw * 64 + lane, NGT = NGW * 64;
    {
        f32x2* rope = (f32x2*)(ws + WS_ROPE);
        for (int i = gt; i < SEQ * 32; i += NGT) { const int pos = i >> 5, j = i & 31; const float fr = (float)pow(10000.0, -(double)j / 32.0); const float ang = (float)pos * fr;
            rope[i] = (f32x2){(float)cos((double)ang), (float)sin((double)ang)}; }
        float* dec = (float*)(ws + WS_DECAY);
        for (int i = gt; i < 2 * 8 * 128; i += NGT) { const int l = i & 127, h = (i >> 7) & 7, kk = i >> 10; const double lg = log2(1.0 - exp2(-5.0 - (double)h));
            dec[i] = kk ? (float)(0.125 * exp2(-lg * (double)l)) : (float)exp2(lg * (double)l); }
        float* bt = (float*)(ws + WS_BTAB); const float* rb = a.in[9];
        for (int i = gt; i < 4 * 128; i += NGT) { const int n = i & 127, h = i >> 7; bt[i] = rb[t5_bucket(n) * 4 + h] * LOG2E; }
        if (gt == 0) { float s1 = 0.f, s2 = 0.f; for (int i = 0; i < 64; ++i) { s1 += a.in[4][i] * a.in[5][i]; s2 += a.in[6][i] * a.in[7][i]; }
            ((float*)(ws + WS_LAM))[0] = expf(s1) - expf(s2) + 0.2f; }
    }
}


constexpr int DEF_T0 = 192, DEF_T1 = 64, DEF_T2 = 512, DEF_T3 = 512, DEF_ITEMS = DEF_T0 + DEF_T1 + DEF_T2 + DEF_T3;
__device__ __forceinline__ void p0_deferred(const Args& a, lds_u8* lds, int item) {
    unsigned char* ws = a.ws;
    int tid_ = threadIdx.x; asm volatile("" : "+v"(tid_));
    const int tid = tid_, lane = tid & 63; const int wave = __builtin_amdgcn_readfirstlane(tid >> 6);
    if (item < DEF_T0) {
        LAS float* scr = (LAS float*)(lds + wave * 8704);
        constexpr int I_OUT = (DM / 64) * (DM / 32), I_PQ = (DM / 64) * (NQ / 32);
        static_assert(I_OUT + I_PQ == DEF_T0 * 8, "deferred transposes");
        const int r = item * 8 + wave;
        if (r < I_OUT) p0_transpose_item<0>(a.in[10], nullptr, DM, DM, (bf16_t*)(ws + WS_WOUT), scr, r, lane);
        else p0_transpose_item<0>(a.in[12], a.in[11], DM, NQ, (bf16_t*)(ws + WS_WPQ), scr, r - I_OUT, lane);
        return;
    }
    item -= DEF_T0;
    if (item < DEF_T1) {
        const float* pk = a.in[13]; bf16_t* kb = (bf16_t*)(ws + WS_KEYS);
        const int i = item * 512 + tid;
        const GAS f32x4* s = (const GAS f32x4*)(pk + (size_t)i * 8); const f32x4 p = __builtin_nontemporal_load(s), q = __builtin_nontemporal_load(s + 1);
        u32x4 o; o.x = pk2(p.x, p.y); o.y = pk2(p.z, p.w); o.z = pk2(q.x, q.y); o.w = pk2(q.z, q.w); *(GAS u32x4*)(kb + (size_t)i * 8) = o;
        return;
    }
    item -= DEF_T1;
    const float* dn = a.in[14]; const float* up = a.in[15]; const float* gf = a.in[11];
    unsigned char* wd = ws + WS_WD; unsigned char* wu = ws + WS_WU;
    const bool isup = item < DEF_T2; if (!isup) item -= DEF_T2;
    const float* src = (isup ? up : dn) + (size_t)(item * 32 + wave * 4) * DM + lane * 4;
    f32x4 g[4];
#pragma unroll
    for (int k = 0; k < 4; ++k) g[k] = isup ? (f32x4){6.0f, 6.0f, 6.0f, 6.0f} : *(const GAS f32x4*)(gf + k * 256 + lane * 4) * 64.0f;
    f32x4 v[4][4];
#pragma unroll
    for (int r = 0; r < 4; ++r)
#pragma unroll
        for (int k = 0; k < 4; ++k) v[r][k] = __builtin_nontemporal_load((const GAS f32x4*)(src + (size_t)r * DM + k * 256));
#pragma unroll
    for (int r = 0; r < 4; ++r) {
        const int e = item * 32 + wave * 4 + r;
#pragma unroll
        for (int k = 0; k < 4; ++k) {
            const f32x4 p = v[r][k] * g[k];
            unsigned w = __builtin_amdgcn_cvt_scalef32_pk_fp4_f32(0u, p.x, p.y, 1.0f, 0);
            w = __builtin_amdgcn_cvt_scalef32_pk_fp4_f32(w, p.z, p.w, 1.0f, 1);
            unsigned char* dst = isup ? wu + (size_t)e * 512 + k * 128 + lane * 2 : wd + (size_t)k * ((size_t)NEXP * 128) + (size_t)e * 128 + lane * 2;
            *(GAS unsigned short*)dst = (unsigned short)w;
        }
    }
}

__device__ __forceinline__ f32x4 bf4_lo(u32x4 w) { return (f32x4){__uint_as_float(w.x << 16), __uint_as_float(w.x & 0xffff0000u), __uint_as_float(w.y << 16), __uint_as_float(w.y & 0xffff0000u)}; }
__device__ __forceinline__ f32x4 bf4_hi(u32x4 w) { return (f32x4){__uint_as_float(w.z << 16), __uint_as_float(w.z & 0xffff0000u), __uint_as_float(w.w << 16), __uint_as_float(w.w & 0xffff0000u)}; }
struct EpiProj {
    static constexpr bool PERM = true, AFTER_DRAIN = false;
    bf16_t* P; const float* r1; const f32x4* rope; const float* decay;
    __device__ __forceinline__ void operator()(const f32x4 (&acc)[2][2][4][2], const pg8::Unit& u, int wr, int wc, int fr, int fq) const {
        const int row0 = u.pm * 256 + wr * 64 + fr, seg = u.pn >> 1;
        float rsv[2][4];
#pragma unroll
        for (int ai = 0; ai < 2; ++ai)
#pragma unroll
            for (int m = 0; m < 4; ++m) rsv[ai][m] = *(const GAS float*)(r1 + row0 + ai * 128 + m * 16);
        if (seg <= 1) {
#pragma unroll
            for (int ai = 0; ai < 2; ++ai) {
                f32x4 ra[4][2], rb[4][2]; float ff[4][2];
#pragma unroll
                for (int m = 0; m < 4; ++m)
#pragma unroll
                    for (int bj = 0; bj < 2; ++bj) {
                        const int row = row0 + ai * 128 + m * 16, c0 = u.pn * 256 + bj * 128 + wc * 32 + 8 * fq;
                        const int pos = row & (SEQ - 1), l = row & 127, head = (c0 & 511) >> 6, jb = (c0 & 63) >> 1;
                        const GAS f32x4* rp = (const GAS f32x4*)rope + ((size_t)pos * 32 + jb) / 2; ra[m][bj] = rp[0]; rb[m][bj] = rp[1];
                        ff[m][bj] = *(const GAS float*)(decay + (seg * 8 + head) * 128 + l);
                    }
#pragma unroll
                for (int m = 0; m < 4; ++m)
#pragma unroll
                    for (int bj = 0; bj < 2; ++bj) {
                        const int row = row0 + ai * 128 + m * 16, c0 = u.pn * 256 + bj * 128 + wc * 32 + 8 * fq;
                        const f32x4 v0 = acc[ai][bj][m][0] * rsv[ai][m], v1 = acc[ai][bj][m][1] * rsv[ai][m];
                        const f32x4 a_ = ra[m][bj], b_ = rb[m][bj]; const float f = ff[m][bj];
                        f32x4 w0, w1;
                        w0.x = (v0.x * a_.x - v0.y * a_.y) * f; w0.y = (v0.y * a_.x + v0.x * a_.y) * f;
                        w0.z = (v0.z * a_.z - v0.w * a_.w) * f; w0.w = (v0.w * a_.z + v0.z * a_.w) * f;
                        w1.x = (v1.x * b_.x - v1.y * b_.y) * f; w1.y = (v1.y * b_.x + v1.x * b_.y) * f;
                        w1.z = (v1.z * b_.z - v1.w * b_.w) * f; w1.w = (v1.w * b_.z + v1.z * b_.w) * f;
                        u32x4 w; w.x = pk2(w0.x, w0.y); w.y = pk2(w0.z, w0.w); w.z = pk2(w1.x, w1.y); w.w = pk2(w1.z, w1.w);
                        *(GAS u32x4*)(P + (size_t)row * NIN + c0) = w;
                    }
            }
        } else {
#pragma unroll
            for (int ai = 0; ai < 2; ++ai)
#pragma unroll
                for (int m = 0; m < 4; ++m)
#pragma unroll
                    for (int bj = 0; bj < 2; ++bj) {
                        const int row = row0 + ai * 128 + m * 16, c0 = u.pn * 256 + bj * 128 + wc * 32 + 8 * fq;
                        f32x4 v0 = acc[ai][bj][m][0] * rsv[ai][m], v1 = acc[ai][bj][m][1] * rsv[ai][m];
                        if (seg == 3) {
#pragma unroll
                            for (int j = 0; j < 4; ++j) { v0[j] = v0[j] / (1.0f + __expf(-v0[j])); v1[j] = v1[j] / (1.0f + __expf(-v1[j])); }
                        } else if (seg == 4) { v0 = v0 * (0.125f * LOG2E); v1 = v1 * (0.125f * LOG2E); }
                        u32x4 w; w.x = pk2(v0.x, v0.y); w.y = pk2(v0.z, v0.w); w.z = pk2(v1.x, v1.y); w.w = pk2(v1.z, v1.w);
                        *(GAS u32x4*)(P + (size_t)row * NIN + c0) = w;
                    }
        }
    }
};
struct EpiX1 {
    static constexpr bool PERM = true, AFTER_DRAIN = false;
    const bf16_t* XB; bf16_t* X1B; bf16_t* ssq;
    __device__ __forceinline__ void operator()(const f32x4 (&acc)[2][2][4][2], const pg8::Unit& u, int wr, int wc, int fr, int fq) const {
        const int row0 = u.pm * 256 + wr * 64 + fr, c00 = u.pn * 256 + wc * 32 + 8 * fq;
        u32x4 xin[2][4][2];
#pragma unroll
        for (int ai = 0; ai < 2; ++ai)
#pragma unroll
            for (int m = 0; m < 4; ++m)
#pragma unroll
                for (int bj = 0; bj < 2; ++bj) xin[ai][m][bj] = *(const GAS u32x4*)(XB + (size_t)(row0 + ai * 128 + m * 16) * DM + c00 + bj * 128);
#pragma unroll
        for (int ai = 0; ai < 2; ++ai)
#pragma unroll
            for (int m = 0; m < 4; ++m) {
                const int row = row0 + ai * 128 + m * 16; float ss = 0.f;
#pragma unroll
                for (int bj = 0; bj < 2; ++bj) {
                    const f32x4 o0 = acc[ai][bj][m][0] + bf4_lo(xin[ai][m][bj]), o1 = acc[ai][bj][m][1] + bf4_hi(xin[ai][m][bj]);
                    u32x4 w; w.x = pk2(o0.x, o0.y); w.y = pk2(o0.z, o0.w); w.z = pk2(o1.x, o1.y); w.w = pk2(o1.z, o1.w);
                    *(GAS u32x4*)(X1B + (size_t)row * DM + c00 + bj * 128) = w;
                    ss += ((o0.x * o0.x + o0.y * o0.y) + (o0.z * o0.z + o0.w * o0.w)) + ((o1.x * o1.x + o1.y * o1.y) + (o1.z * o1.z + o1.w * o1.w));
                }
                ss += __shfl_xor(ss, 16); ss += __shfl_xor(ss, 32);
                if (fq == 0) *(GAS bf16_t*)(ssq + (size_t)row * 16 + u.pn * 4 + wc) = (bf16_t)(pk2(ss, 0.f) & 0xffffu);
            }
    }
};
__device__ __forceinline__ float rs2_from(u32x4 a, u32x4 b) {
    const f32x4 p = bf4_lo(a) + bf4_hi(a) + bf4_lo(b) + bf4_hi(b);
    return 1.0f / sqrtf(((p.x + p.y) + (p.z + p.w)) * (1.0f / DM) + EPSF);
}
__device__ __forceinline__ float row_rs2(const bf16_t* ssq, int row) {
    const GAS u32x4* p = (const GAS u32x4*)(ssq + (size_t)row * 16); return rs2_from(p[0], p[1]);
}
struct EpiQ {
    static constexpr bool PERM = true, AFTER_DRAIN = false;
    bf16_t* Q; const bf16_t* ssq;
    __device__ __forceinline__ void operator()(const f32x4 (&acc)[2][2][4][2], const pg8::Unit& u, int wr, int wc, int fr, int fq) const {
        const int row0 = u.pm * 256 + wr * 64 + fr;
        u32x4 sa[2][4], sb[2][4];
#pragma unroll
        for (int ai = 0; ai < 2; ++ai)
#pragma unroll
            for (int m = 0; m < 4; ++m) { const GAS u32x4* p = (const GAS u32x4*)(ssq + (size_t)(row0 + ai * 128 + m * 16) * 16); sa[ai][m] = p[0]; sb[ai][m] = p[1]; }
#pragma unroll
        for (int ai = 0; ai < 2; ++ai)
#pragma unroll
            for (int m = 0; m < 4; ++m) {
                const int row = row0 + ai * 128 + m * 16; const float rs = rs2_from(sa[ai][m], sb[ai][m]);
#pragma unroll
                for (int bj = 0; bj < 2; ++bj) {
                    const int c0 = u.pn * 256 + bj * 128 + wc * 32 + 8 * fq;
                    const f32x4 v0 = acc[ai][bj][m][0] * rs, v1 = acc[ai][bj][m][1] * rs;
                    u32x4 w; w.x = pk2(v0.x, v0.y); w.y = pk2(v0.z, v0.w); w.z = pk2(v1.x, v1.y); w.w = pk2(v1.z, v1.w);
                    *(GAS u32x4*)(Q + (size_t)row * NQ + c0) = w;
                }
            }
    }
};

#define MFMA32(a, b, c) __builtin_amdgcn_mfma_f32_32x32x16_bf16(a, b, c, 0, 0, 0)
typedef short v4i16_t __attribute__((ext_vector_type(4)));
__device__ __forceinline__ s16x4 vtr(const lds_u8* p) { return __builtin_bit_cast(s16x4, __builtin_amdgcn_ds_read_tr16_b64_v4i16((LAS v4i16_t*)p)); }
__device__ __forceinline__ bf16x8 vfrag(const lds_u8* p) { const s16x4 lo = vtr(p), hi = vtr(p + 512); return (bf16x8){lo[0], lo[1], lo[2], lo[3], hi[0], hi[1], hi[2], hi[3]}; }
__device__ __forceinline__ bf16x8 ldsb128(const lds_u8* p) { return *(const LAS bf16x8*)p; }
__device__ __forceinline__ int crow(int r, int hi) { return (r & 3) + 8 * (r >> 2) + 4 * hi; }
__device__ __forceinline__ void glds16(const void* g, lds_u8* l) {
    unsigned sv; const unsigned lb = (unsigned)__builtin_amdgcn_readfirstlane((int)(unsigned)(uintptr_t)l);
    asm volatile("s_mov_b32 %0, m0\n\ts_mov_b32 m0, %2\n\ts_nop 0\n\tglobal_load_lds_dwordx4 %1, off\n\ts_mov_b32 m0, %0" : "=&s"(sv) : "v"(g), "s"(lb) : "memory");
}
__device__ __forceinline__ float swap_sum(float v) { auto rr = __builtin_amdgcn_permlane32_swap(__float_as_uint(v), __float_as_uint(v), false, false); return __uint_as_float(rr[0]) + __uint_as_float(rr[1]); }
__device__ __forceinline__ float swap_max(float v) { auto rr = __builtin_amdgcn_permlane32_swap(__float_as_uint(v), __float_as_uint(v), false, false); return __builtin_fmaxf(__uint_as_float(rr[0]), __uint_as_float(rr[1])); }

constexpr int ATT_SLOT = 32768, ATT_XCH = 65536, ATT_XPITCH = 528, ATT_BTAB = ATT_XCH + 128 * ATT_XPITCH;
static_assert(ATT_BTAB + 512 <= LDS_SCRATCH, "attention LDS");

template <int MODE>
__device__ __forceinline__ void attn_unit(const Args& a, lds_u8* lds, int b, int h, int qb) {
    int tid_ = threadIdx.x; asm volatile("" : "+v"(tid_));
    const int tid = tid_, lane = tid & 63, r32 = lane & 31, hi = lane >> 5; const int wid = __builtin_amdgcn_readfirstlane(tid >> 6);
    const int rgp = wid & 3, map = wid >> 2;
    const bf16_t* proj = (const bf16_t*)(a.ws + WS_PROJ);
    const size_t rowbase = (size_t)b * SEQ; const int q0 = qb * 128, NT = 2 * qb + 2;
    const float lam = ((const float*)(a.ws + WS_LAM))[0];
    if (tid < 128) ((LAS float*)(lds + ATT_BTAB))[tid] = ((const float*)(a.ws + WS_BTAB))[h * 128 + tid];
    bf16x8 qf[4];
    { const bf16_t* qp = proj + (rowbase + q0 + rgp * 32 + r32) * NIN + OFF_DQ + h * 128 + map * 64 + hi * 8;
#pragma unroll
      for (int s = 0; s < 4; ++s) qf[s] = *(const GAS bf16x8*)(qp + s * 16); }
    asm volatile("" : "+v"(qf[0]), "+v"(qf[1]), "+v"(qf[2]), "+v"(qf[3]));
    const int krow = 8 * wid + (lane >> 3);
    const bf16_t* k1src = proj + (rowbase + krow) * NIN + OFF_DK + h * 128 + ((lane & 7) ^ ((krow >> 1) & 7)) * 8;
    const bf16_t* k2src = k1src + 64;
    const bf16_t* vsrc0 = proj + (rowbase + 16 * ((2 * wid) & 3) + (lane >> 2)) * NIN + OFF_DV + h * 128 + 32 * ((2 * wid) >> 2) + (lane & 3) * 8;
    const bf16_t* vsrc1 = proj + (rowbase + 16 * ((2 * wid + 1) & 3) + (lane >> 2)) * NIN + OFF_DV + h * 128 + 32 * ((2 * wid + 1) >> 2) + (lane & 3) * 8;
#define ATT_DMA(t, slot) do { const size_t go = (size_t)(t) * 64 * NIN; lds_u8* sb = lds + (slot) * ATT_SLOT; \
        glds16(k1src + go, sb + wid * 1024); glds16(k2src + go, sb + 8192 + wid * 1024); \
        glds16(vsrc0 + go, sb + 16384 + (2 * wid) * 1024); glds16(vsrc1 + go, sb + 16384 + (2 * wid + 1) * 1024); } while (0)
    const int koff = map * 8192 + r32 * 128, ksw = (r32 >> 1) & 7;
    const int voff = 16384 + ((lane >> 4) & 1) * 32 + (lane & 3) * 8 + (4 * hi + ((lane & 15) >> 2)) * 64;
    f32x16 o[4];
#pragma unroll
    for (int d = 0; d < 4; ++d) o[d] = f32x16{};
    float mrun = -INFINITY, lrun = 0.f;
    const int qpos = q0 + rgp * 32 + r32;
    float b31 = ((const float*)(a.ws + WS_BTAB))[h * 128 + 127]; asm volatile("" : "+v"(b31));
    ATT_DMA(0, 0);
    for (int t = 0; t < NT; ++t) {
        if (!(MODE & 32) || t < 2) { VM_WAIT(); __syncthreads(); }
        if (t + 1 < NT && (!(MODE & 8) || t + 1 < 2)) ATT_DMA(t + 1, (t + 1) & 1);
        if (64 * t > q0 + rgp * 32 + 31) continue;
        const lds_u8* sb = lds + (t & 1) * ATT_SLOT;
        const bool nearT = (64 * t + 176 > q0);
        const float cb = nearT ? 0.f : b31;
        f32x16 sA, sB;
        { const float c0 = (t == 0) ? 0.f : cb - mrun;
#pragma unroll
          for (int r = 0; r < 16; ++r) { sA[r] = c0; sB[r] = c0; } }
        if (MODE & 1) {
            bf16x8 kf[8];
#pragma unroll
            for (int d0 = 0; d0 < 4; ++d0) { const int kc = koff + (((2 * d0 + hi) ^ ksw) << 4); if (MODE & 16) { kf[2 * d0] = qf[d0]; kf[2 * d0 + 1] = qf[3 - d0]; } else { kf[2 * d0] = ldsb128(sb + kc); kf[2 * d0 + 1] = ldsb128(sb + kc + 4096); } }
            __builtin_amdgcn_sched_group_barrier(0x100, 8, 0);
#pragma unroll
            for (int d0 = 0; d0 < 4; ++d0) { sA = MFMA32(kf[2 * d0], qf[d0], sA); sB = MFMA32(kf[2 * d0 + 1], qf[d0], sB); }
            __builtin_amdgcn_sched_group_barrier(0x8, 8, 0);
        }
        if (!(MODE & 1)) asm volatile("" : "+v"(sA), "+v"(sB));
        if (MODE & 4) {
        if (nearT) {
            const LAS float* bt = (const LAS float*)(lds + ATT_BTAB);
            float bA[16], bB[16];
#pragma unroll
            for (int r = 0; r < 16; ++r) { const int d0 = qpos - (64 * t + crow(r, hi)), d1 = d0 - 32;
                bA[r] = bt[d0 < 0 ? 0 : (d0 > 127 ? 127 : d0)]; bB[r] = bt[d1 < 0 ? 0 : (d1 > 127 ? 127 : d1)]; }
            asm volatile("" : "+v"(bA[0]), "+v"(bA[1]), "+v"(bA[2]), "+v"(bA[3]), "+v"(bA[4]), "+v"(bA[5]), "+v"(bA[6]), "+v"(bA[7]), "+v"(bA[8]), "+v"(bA[9]), "+v"(bA[10]), "+v"(bA[11]), "+v"(bA[12]), "+v"(bA[13]), "+v"(bA[14]), "+v"(bA[15]));
            asm volatile("" : "+v"(bB[0]), "+v"(bB[1]), "+v"(bB[2]), "+v"(bB[3]), "+v"(bB[4]), "+v"(bB[5]), "+v"(bB[6]), "+v"(bB[7]), "+v"(bB[8]), "+v"(bB[9]), "+v"(bB[10]), "+v"(bB[11]), "+v"(bB[12]), "+v"(bB[13]), "+v"(bB[14]), "+v"(bB[15]));
#pragma unroll
            for (int r = 0; r < 16; ++r) { const int d0 = qpos - (64 * t + crow(r, hi)), d1 = d0 - 32;
                sA[r] = d0 < 0 ? -INFINITY : sA[r] + bA[r]; sB[r] = d1 < 0 ? -INFINITY : sB[r] + bB[r]; }
        }
#define MX3(a_, b_, c_) __builtin_fmaxf(__builtin_fmaxf((a_), (b_)), (c_))
        float mxa = MX3(sA[0], sA[1], sB[0]), mxb = MX3(sA[2], sA[3], sB[1]); mxa = MX3(mxa, sB[2], sB[3]);
#pragma unroll
        for (int r = 4; r < 16; r += 4) { mxa = MX3(mxa, sA[r], sA[r + 1]); mxb = MX3(mxb, sA[r + 2], sA[r + 3]); mxa = MX3(mxa, sB[r], sB[r + 1]); mxb = MX3(mxb, sB[r + 2], sB[r + 3]); }
#undef MX3
        const float mx = swap_max(__builtin_fmaxf(mxa, mxb));
        if (t == 0 || __any(mx > 6.0f)) {
            const float up = (t == 0) ? mx : __builtin_fmaxf(mx, 0.f), alpha = (t == 0) ? 0.f : __builtin_amdgcn_exp2f(-up);
            mrun = (t == 0) ? mx + cb : mrun + up; lrun *= alpha;
#pragma unroll
            for (int d = 0; d < 4; ++d)
#pragma unroll
                for (int r = 0; r < 16; ++r) o[d][r] *= alpha;
            const float sh = (t == 0) ? mx : up;
#pragma unroll
            for (int r = 0; r < 16; ++r) { sA[r] -= sh; sB[r] -= sh; }
        }
#pragma unroll
        for (int r = 0; r < 16; ++r) { if (MODE & 64) { sA[r] = sA[r] * 1.0009765625f; sB[r] = sB[r] * 1.0009765625f; } else { sA[r] = __builtin_amdgcn_exp2f(sA[r]); sB[r] = __builtin_amdgcn_exp2f(sB[r]); } }
#pragma unroll
        for (int r = 0; r < 16; ++r) { lrun += sA[r]; lrun += sB[r]; }
        } else { asm volatile("" : "+v"(sA), "+v"(sB)); }
        u32x4 pw[4];
        pw[0] = (u32x4){pk2(sA[0], sA[1]), pk2(sA[2], sA[3]), pk2(sA[4], sA[5]), pk2(sA[6], sA[7])};
        pw[1] = (u32x4){pk2(sA[8], sA[9]), pk2(sA[10], sA[11]), pk2(sA[12], sA[13]), pk2(sA[14], sA[15])};
        pw[2] = (u32x4){pk2(sB[0], sB[1]), pk2(sB[2], sB[3]), pk2(sB[4], sB[5]), pk2(sB[6], sB[7])};
        pw[3] = (u32x4){pk2(sB[8], sB[9]), pk2(sB[10], sB[11]), pk2(sB[12], sB[13]), pk2(sB[14], sB[15])};
        if (!(MODE & 2)) { asm volatile("" :: "v"(pw[0]), "v"(pw[1]), "v"(pw[2]), "v"(pw[3])); continue; }
        {
            bf16x8 vfa[4], vfb[4];
#pragma unroll
            for (int d = 0; d < 4; ++d) vfa[d] = (MODE & 16) ? qf[d] : vfrag(sb + voff + d * 4096);
            __builtin_amdgcn_sched_group_barrier(0x100, 8, 0);
#pragma unroll
            for (int ks = 0; ks < 4; ks += 2) {
#pragma unroll
                for (int d = 0; d < 4; ++d) vfb[d] = (MODE & 16) ? qf[3 - d] : vfrag(sb + voff + d * 4096 + (ks + 1) * 1024);
                __builtin_amdgcn_sched_group_barrier(0x100, 8, 0);
                { const bf16x8 pb = __builtin_bit_cast(bf16x8, pw[ks]);
#pragma unroll
                  for (int d = 0; d < 4; ++d) o[d] = MFMA32(vfa[d], pb, o[d]); }
                __builtin_amdgcn_sched_group_barrier(0x8, 4, 0);
                if (ks + 2 < 4) {
#pragma unroll
                    for (int d = 0; d < 4; ++d) vfa[d] = (MODE & 16) ? qf[d] : vfrag(sb + voff + d * 4096 + (ks + 2) * 1024);
                    __builtin_amdgcn_sched_group_barrier(0x100, 8, 0);
                }
                { const bf16x8 pb = __builtin_bit_cast(bf16x8, pw[ks + 1]);
#pragma unroll
                  for (int d = 0; d < 4; ++d) o[d] = MFMA32(vfb[d], pb, o[d]); }
                __builtin_amdgcn_sched_group_barrier(0x8, 4, 0);
            }
        }
    }
    const float inv = 1.0f / swap_sum(lrun);
    LAS float* xch = (LAS float*)(lds + ATT_XCH + (rgp * 32 + r32) * ATT_XPITCH);
    if (map == 1) {
        const float sc = inv * lam;
#pragma unroll
        for (int d = 0; d < 4; ++d)
#pragma unroll
            for (int g = 0; g < 4; ++g) *(LAS f32x4*)(xch + 32 * d + 8 * g + 4 * hi) = (f32x4){o[d][4 * g] * sc, o[d][4 * g + 1] * sc, o[d][4 * g + 2] * sc, o[d][4 * g + 3] * sc};
    }
    __syncthreads();
    if (map == 0) {
        float ss = 0.f;
#pragma unroll
        for (int d = 0; d < 4; ++d)
#pragma unroll
            for (int g = 0; g < 4; ++g) { const f32x4 o2 = *(const LAS f32x4*)(xch + 32 * d + 8 * g + 4 * hi);
#pragma unroll
                for (int j = 0; j < 4; ++j) { const float v = o[d][4 * g + j] * inv - o2[j]; o[d][4 * g + j] = v; ss += v * v; } }
        ss = swap_sum(ss);
        const float rn = 0.8f / sqrtf(ss * (1.0f / 128.0f) + EPSF);
        const float* sub = a.in[8];
        bf16_t* mixp = (bf16_t*)(a.ws + WS_MIX) + (rowbase + qpos) * DM + 512 + h * 128;
#pragma unroll
        for (int d = 0; d < 4; ++d)
#pragma unroll
            for (int g = 0; g < 4; ++g) { const int dd = 32 * d + 8 * g + 4 * hi; const f32x4 sv = *(const GAS f32x4*)(sub + dd);
                u32x2 w; w.x = pk2(o[d][4 * g] * rn * sv.x, o[d][4 * g + 1] * rn * sv.y); w.y = pk2(o[d][4 * g + 2] * rn * sv.z, o[d][4 * g + 3] * rn * sv.w);
                *(GAS u32x2*)(mixp + dd) = w; }
    }
    __syncthreads();
#undef ATT_DMA
}

constexpr int RET_BUF = 49152, RET_RT = 2 * RET_BUF, RET_GN = RET_RT + 8192;
static_assert(RET_GN + 2048 <= LDS_SCRATCH, "retention LDS");

__device__ __forceinline__ void ret_unit(const Args& a, lds_u8* lds, int b, int h) {
    int tid_ = threadIdx.x; asm volatile("" : "+v"(tid_));
    const int tid = tid_, lane = tid & 63, r32 = lane & 31, hi = lane >> 5; const int wid = __builtin_amdgcn_readfirstlane(tid >> 6);
    const int rgp = wid & 3, eh = wid >> 2;
    const bf16_t* proj = (const bf16_t*)(a.ws + WS_PROJ);
    const size_t rowbase = (size_t)b * SEQ;
    const double lg = log2(1.0 - exp2(-5.0 - (double)h));
    const float gam = (float)exp2(lg), g127 = (float)exp2(lg * 127.0), g128 = (float)exp2(lg * 128.0);
#define RET_DMA(c, buf) do { const size_t ro = (rowbase + (size_t)(c) * 128) * NIN; lds_u8* bb = lds + (buf) * RET_BUF; \
        _Pragma("unroll") for (int i_ = 0; i_ < 2; ++i_) { const int p_ = 2 * wid + i_; \
            { const int ch = p_ >> 1, rh = p_ & 1; glds16(proj + ro + (size_t)(rh * 64 + lane) * NIN + OFF_RK + h * 64 + ch * 8, bb + ch * 2048 + rh * 1024); } \
            { const int db = p_ >> 3, rg_ = p_ & 7; glds16(proj + ro + (size_t)(rg_ * 16 + (lane >> 2)) * NIN + OFF_RK + h * 64 + db * 32 + (lane & 3) * 8, bb + 16384 + db * 8192 + rg_ * 1024); \
              glds16(proj + ro + (size_t)(rg_ * 16 + (lane >> 2)) * NIN + OFF_RV + h * 64 + db * 32 + (lane & 3) * 8, bb + 32768 + db * 8192 + rg_ * 1024); } } } while (0)
    const int koff = hi * 2048 + r32 * 16;
    const int troff = ((lane >> 4) & 1) * 32 + (lane & 3) * 8 + (4 * hi + ((lane & 15) >> 2)) * 64;
    f32x16 R = f32x16{};
    for (int i = tid; i < 8192 / 16; i += NTHR) *(LAS u32x4*)(lds + RET_RT + i * 16) = (u32x4){0u, 0u, 0u, 0u};
    const float* gn = a.in[3];
    f32x4 gv[4];
#pragma unroll
    for (int g = 0; g < 4; ++g) gv[g] = *(const GAS f32x4*)(gn + h * 64 + eh * 32 + 8 * g + 4 * hi);
    bf16x8 qn[4]; u32x2 svn[4];
#define RET_PREF(c) do { const size_t tk_ = rowbase + (size_t)(c) * 128 + rgp * 32 + r32; const bf16_t* qp_ = proj + tk_ * NIN + OFF_RQ + h * 64 + hi * 8; const bf16_t* sg_ = proj + tk_ * NIN + OFF_RG + h * 64 + eh * 32 + 4 * hi; \
        _Pragma("unroll") for (int s = 0; s < 4; ++s) qn[s] = *(const GAS bf16x8*)(qp_ + s * 16); \
        _Pragma("unroll") for (int g = 0; g < 4; ++g) svn[g] = *(const GAS u32x2*)(sg_ + 8 * g); } while (0)
    RET_PREF(0);
    RET_DMA(0, 0);
    u32x2 wst[4]; bf16_t* wptr = nullptr;
#pragma unroll
    for (int g = 0; g < 4; ++g) wst[g] = (u32x2){0u, 0u};
    for (int c = 0; c < 32; ++c) {
        VM_WAIT(); __syncthreads();
        if (c > 0) {
#pragma unroll
            for (int g = 0; g < 4; ++g) *(GAS u32x2*)(wptr + 8 * g + 4 * hi) = wst[g];
        }
        bf16x8 qf[4]; u32x2 svc[4];
#pragma unroll
        for (int s = 0; s < 4; ++s) { qf[s] = qn[s]; svc[s] = svn[s]; }
        if (c + 1 < 32) { RET_PREF(c + 1); RET_DMA(c + 1, (c + 1) & 1); }
        const lds_u8* bb = lds + (c & 1) * RET_BUF;
        const size_t tok = rowbase + (size_t)c * 128 + rgp * 32 + r32;
        f32x16 O = f32x16{};
#pragma unroll
        for (int s = 0; s < 4; ++s) { const bf16x8 rt = ldsb128(lds + RET_RT + (2 * s + hi) * 1024 + (eh * 32 + r32) * 16); O = MFMA32(rt, qf[s], O); }
        for (int kb = 0; kb <= rgp; ++kb) {
            f32x16 S = f32x16{};
#pragma unroll
            for (int s = 0; s < 4; ++s) { const bf16x8 ka = ldsb128(bb + koff + s * 4096 + (kb * 32) * 16); S = MFMA32(ka, qf[s], S); }
            if (kb == rgp) {
#pragma unroll
                for (int r = 0; r < 16; ++r) S[r] = (crow(r, hi) > r32) ? 0.f : S[r];
            }
            const u32x4 p0 = (u32x4){pk2(S[0], S[1]), pk2(S[2], S[3]), pk2(S[4], S[5]), pk2(S[6], S[7])};
            const u32x4 p1 = (u32x4){pk2(S[8], S[9]), pk2(S[10], S[11]), pk2(S[12], S[13]), pk2(S[14], S[15])};
            const bf16x8 v0 = vfrag(bb + 32768 + eh * 8192 + troff + (2 * kb) * 1024), v1 = vfrag(bb + 32768 + eh * 8192 + troff + (2 * kb + 1) * 1024);
            O = MFMA32(v0, __builtin_bit_cast(bf16x8, p0), O); O = MFMA32(v1, __builtin_bit_cast(bf16x8, p1), O);
        }
        if (rgp < 2) {
            f32x16 T = f32x16{};
#pragma unroll
            for (int ks = 0; ks < 8; ++ks) { const bf16x8 kt = vfrag(bb + 16384 + rgp * 8192 + troff + ks * 1024), vv = vfrag(bb + 32768 + eh * 8192 + troff + ks * 1024); T = MFMA32(kt, vv, T); }
#pragma unroll
            for (int r = 0; r < 16; ++r) R[r] = R[r] * g128 + T[r] * g127;
        }
        float s1 = 0.f, s2 = 0.f;
#pragma unroll
        for (int r = 0; r < 16; ++r) { s1 += O[r]; s2 += O[r] * O[r]; }
        s1 = swap_sum(s1); s2 = swap_sum(s2);
        LAS f32x2* gx = (LAS f32x2*)(lds + RET_GN);
        if (hi == 0) gx[(rgp * 32 + r32) * 2 + eh] = (f32x2){s1, s2};
        __syncthreads();
        if (rgp < 2) {
#pragma unroll
            for (int g = 0; g < 4; ++g) { u32x2 w; w.x = pk2(R[4 * g] * gam, R[4 * g + 1] * gam); w.y = pk2(R[4 * g + 2] * gam, R[4 * g + 3] * gam);
                *(LAS u32x2*)(lds + RET_RT + (rgp * 4 + g) * 1024 + (eh * 32 + r32) * 16 + hi * 8) = w; }
        }
        const f32x2 ga = gx[(rgp * 32 + r32) * 2], gb = gx[(rgp * 32 + r32) * 2 + 1];
        const float mean = (ga.x + gb.x) * (1.0f / 64.0f), var = (ga.y + gb.y) * (1.0f / 64.0f) - mean * mean;
        const float rstd = 1.0f / sqrtf(__builtin_fmaxf(var, 0.f) + EPSF);
        bf16_t* mixp = (bf16_t*)(a.ws + WS_MIX) + tok * DM + h * 64 + eh * 32;
#pragma unroll
        for (int g = 0; g < 4; ++g) { const int e = 8 * g + 4 * hi; const u32x2 sv = svc[g];
            const float y0 = (O[4 * g] - mean) * rstd * gv[g].x * __uint_as_float(sv.x << 16), y1 = (O[4 * g + 1] - mean) * rstd * gv[g].y * __uint_as_float(sv.x & 0xffff0000u);
            const float y2 = (O[4 * g + 2] - mean) * rstd * gv[g].z * __uint_as_float(sv.y << 16), y3 = (O[4 * g + 3] - mean) * rstd * gv[g].w * __uint_as_float(sv.y & 0xffff0000u);
            wst[g].x = pk2(y0, y1); wst[g].y = pk2(y2, y3); }
        wptr = mixp;
    }
#pragma unroll
    for (int g = 0; g < 4; ++g) *(GAS u32x2*)(wptr + 8 * g + 4 * hi) = wst[g];
    __syncthreads();
#undef RET_DMA
#undef RET_PREF
}


#define CAS_DESC(x, y) do { const float hi_ = __builtin_fmaxf(x, y), lo_ = __builtin_fminf(x, y); x = hi_; y = lo_; } while (0)
#define CAS_ASC(x, y) do { const float hi_ = __builtin_fmaxf(x, y), lo_ = __builtin_fminf(x, y); x = lo_; y = hi_; } while (0)
__device__ __forceinline__ void sort16_desc(float (&v)[16]) {
#pragma unroll
    for (int k = 2; k <= 16; k <<= 1)
#pragma unroll
        for (int j = k >> 1; j > 0; j >>= 1)
#pragma unroll
            for (int i = 0; i < 16; ++i) { const int l = i ^ j; if (l > i) { if ((i & k) == 0) CAS_DESC(v[i], v[l]); else CAS_ASC(v[i], v[l]); } }
}
__device__ __forceinline__ void bitonic_merge16_desc(float (&v)[16]) {
#pragma unroll
    for (int j = 8; j > 0; j >>= 1)
#pragma unroll
        for (int i = 0; i < 16; ++i) { const int l = i ^ j; if (l > i) CAS_DESC(v[i], v[l]); }
}
__device__ __forceinline__ void merge_top16(float (&a)[16], const float (&b)[16]) {
#pragma unroll
    for (int i = 0; i < 16; ++i) a[i] = __builtin_fmaxf(a[i], b[15 - i]);
    bitonic_merge16_desc(a);
}
__device__ __forceinline__ unsigned pack_idx4(const float (&v)[16], int w) {
    return (__float_as_uint(v[4 * w]) & 127u) | ((__float_as_uint(v[4 * w + 1]) & 127u) << 8) | ((__float_as_uint(v[4 * w + 2]) & 127u) << 16) | ((__float_as_uint(v[4 * w + 3]) & 127u) << 24);
}
__device__ __forceinline__ unsigned lookup_idx(const unsigned (&pk)[4], unsigned i) {
    const unsigned w = i >> 2; unsigned s = w == 0 ? pk[0] : (w == 1 ? pk[1] : (w == 2 ? pk[2] : pk[3]));
    return (s >> ((i & 3u) * 8u)) & 127u;
}

constexpr int P5_KEYB = 32768;
__device__ __forceinline__ void p5_topk(const Args& a, lds_u8* lds) {
    const int tid = threadIdx.x, lane = tid & 63, r32 = lane & 31, hi = lane >> 5; const int wid = __builtin_amdgcn_readfirstlane(tid >> 6);
    const int hp = blockIdx.x & 3, wgi = blockIdx.x >> 2, nwg = (gridDim.x + 3 - hp) / 4;
    const bf16_t* keys = (const bf16_t*)(a.ws + WS_KEYS) + (size_t)hp * 4 * 128 * 128;
    {
        static_assert(4 * 128 * 16 == 16 * NTHR, "key image copy");
        u32x4 kv[16];
#pragma unroll
        for (int j = 0; j < 16; ++j) { const int i = tid + j * NTHR, t = i >> 11, key = (i >> 4) & 127, c = i & 15; kv[j] = *(const GAS u32x4*)(keys + ((size_t)t * 128 + key) * 128 + c * 8); }
#pragma unroll
        for (int j = 0; j < 16; ++j) { const int i = tid + j * NTHR, t = i >> 11, key = (i >> 4) & 127, c = i & 15; *(LAS u32x4*)(lds + t * P5_KEYB + c * 2048 + key * 16) = kv[j]; }
    }
    __syncthreads();
    const bf16_t* Q = (const bf16_t*)(a.ws + WS_PROJ);
    int* IDX = (int*)(a.ws + WS_IDX); float* GATE = (float*)(a.ws + WS_GATE);
    const int tg0 = wgi * NWAVES + wid, tgs = nwg * NWAVES;
    const int ntask = (tg0 < MTOK / 32) ? 4 * ((MTOK / 32 - 1 - tg0) / tgs + 1) : 0;
#define P5_QLOAD(QF, k_) do { const int tg_ = tg0 + ((k_) >> 2) * tgs, t_ = (k_) & 3; \
        const bf16_t* qp = Q + (size_t)(tg_ * 32 + r32) * NQ + (2 * hp + (t_ >> 1)) * 256 + (t_ & 1) * 128 + hi * 8; \
        _Pragma("unroll") for (int s = 0; s < 8; ++s) QF[s] = *(const GAS bf16x8*)(qp + s * 16); } while (0)
    float la[16], lb[16];
#pragma unroll
    for (int r = 0; r < 16; ++r) { la[r] = 0.f; lb[r] = 0.f; }
    bf16x8 qf[8], qn[8];
    if (ntask > 0) P5_QLOAD(qf, 0);
#pragma unroll 1
    for (int k = 0; k < ntask; ++k) {
      {
        const int tg = tg0 + (k >> 2) * tgs, t = k & 3;
        P5_QLOAD(qn, (k + 1 < ntask ? k + 1 : k));
        {
            float top[16];
#pragma unroll
            for (int kb = 0; kb < 4; ++kb) {
                f32x16 S = f32x16{};
#pragma unroll
                for (int s = 0; s < 8; ++s) { const bf16x8 kf = ldsb128(lds + t * P5_KEYB + (2 * s + hi) * 2048 + (kb * 32 + r32) * 16); S = MFMA32(kf, qf[s], S); }
                float v[16];
#pragma unroll
                for (int r = 0; r < 16; ++r) v[r] = __uint_as_float((__float_as_uint(S[r]) & ~127u) | (unsigned)(kb * 32 + (r & 3) + 8 * (r >> 2)) | ((unsigned)hi << 2));
                sort16_desc(v);
                if (kb == 0) {
#pragma unroll
                    for (int r = 0; r < 16; ++r) top[r] = v[r];
                } else merge_top16(top, v);
            }
            float oth[16];
#pragma unroll
            for (int r = 0; r < 16; ++r) { auto rr = __builtin_amdgcn_permlane32_swap(__float_as_uint(top[r]), __float_as_uint(top[r]), false, false); top[r] = __uint_as_float(rr[0]); oth[r] = __uint_as_float(rr[1]); }
            merge_top16(top, oth);
            const bool ka = ((t >> 1) == hi) && ((t & 1) == 0), kb2 = ((t >> 1) == hi) && ((t & 1) == 1);
#pragma unroll
            for (int r = 0; r < 16; ++r) { la[r] = ka ? top[r] : la[r]; lb[r] = kb2 ? top[r] : lb[r]; }
        }
#pragma unroll
        for (int s2 = 0; s2 < 8; ++s2) qf[s2] = qn[s2];
        if (t != 3) continue;
        unsigned pa[4], pb[4];
#pragma unroll
        for (int w = 0; w < 4; ++w) { pa[w] = pack_idx4(la, w); pb[w] = pack_idx4(lb, w); }
        float c0[16], c1[16];
#define CAND(i, j) __uint_as_float((__float_as_uint(la[i] + lb[j]) & ~255u) | (unsigned)((i) * 16 + (j)))
        const float NEG = -INFINITY;
        c0[0] = CAND(0, 0); c0[1] = CAND(0, 1); c0[2] = CAND(0, 2); c0[3] = CAND(0, 3); c0[4] = CAND(0, 4); c0[5] = CAND(0, 5); c0[6] = CAND(0, 6); c0[7] = CAND(0, 7);
        c0[8] = CAND(0, 8); c0[9] = CAND(0, 9); c0[10] = CAND(0, 10); c0[11] = CAND(0, 11); c0[12] = CAND(0, 12); c0[13] = CAND(0, 13); c0[14] = CAND(0, 14); c0[15] = CAND(0, 15);
        sort16_desc(c0);
        c1[0] = CAND(1, 0); c1[1] = CAND(1, 1); c1[2] = CAND(1, 2); c1[3] = CAND(1, 3); c1[4] = CAND(1, 4); c1[5] = CAND(1, 5); c1[6] = CAND(1, 6); c1[7] = CAND(1, 7);
        c1[8] = CAND(2, 0); c1[9] = CAND(2, 1); c1[10] = CAND(2, 2); c1[11] = CAND(2, 3); c1[12] = CAND(2, 4); c1[13] = CAND(3, 0); c1[14] = CAND(3, 1); c1[15] = CAND(3, 2);
        sort16_desc(c1); merge_top16(c0, c1);
        asm volatile("" : "+v"(c0[0]), "+v"(c0[15]));
        c1[0] = CAND(3, 3); c1[1] = CAND(4, 0); c1[2] = CAND(4, 1); c1[3] = CAND(4, 2); c1[4] = CAND(5, 0); c1[5] = CAND(5, 1); c1[6] = CAND(6, 0); c1[7] = CAND(6, 1);
        c1[8] = CAND(7, 0); c1[9] = CAND(7, 1); c1[10] = CAND(8, 0); c1[11] = CAND(9, 0); c1[12] = CAND(10, 0); c1[13] = CAND(11, 0); c1[14] = CAND(12, 0); c1[15] = CAND(13, 0);
        sort16_desc(c1); merge_top16(c0, c1);
        asm volatile("" : "+v"(c0[0]), "+v"(c0[15]));
        c1[0] = CAND(14, 0); c1[1] = CAND(15, 0);
#pragma unroll
        for (int r = 2; r < 16; ++r) c1[r] = NEG;
#undef CAND
        sort16_desc(c1); merge_top16(c0, c1);
        float gsum = 0.f, gv[16]; int ex[16];
        const float mx = __uint_as_float(__float_as_uint(c0[0]) & ~255u);
#pragma unroll
        for (int r = 0; r < 16; ++r) { const unsigned bits = __float_as_uint(c0[r]); const float val = __uint_as_float(bits & ~255u);
            gv[r] = __expf(val - mx); gsum += gv[r];
            ex[r] = (int)(lookup_idx(pa, (bits >> 4) & 15u) * 128u + lookup_idx(pb, bits & 15u)); }
        const float ginv = 1.0f / gsum;
        const size_t ob = (size_t)(tg * 32 + r32) * 128 + (2 * hp + hi) * 16;
#pragma unroll
        for (int r = 0; r < 16; r += 4) { *(GAS u32x4*)(IDX + ob + r) = (u32x4){(unsigned)ex[r], (unsigned)ex[r + 1], (unsigned)ex[r + 2], (unsigned)ex[r + 3]};
            *(GAS f32x4*)(GATE + ob + r) = (f32x4){gv[r] * ginv, gv[r + 1] * ginv, gv[r + 2] * ginv, gv[r + 3] * ginv}; }
      }
    }
#undef P5_QLOAD
    __syncthreads();
}

typedef long i64_t;
typedef int v8i_t __attribute__((ext_vector_type(8)));
#define MFMA16F8(a, b, c) __builtin_amdgcn_mfma_f32_16x16x32_fp8_fp8(a, b, c, 0, 0, 0)
constexpr float P6_SD = 64.f, P6_SX = 8.f, P6_SU = 16.f, P6_SA = 64.f, P6_SU4 = 6.f;
constexpr size_t P6_SLICEB = (size_t)NEXP * 128;
__device__ __forceinline__ unsigned pk4_fp8(float a, float b, float c, float d) { int w = __builtin_amdgcn_cvt_pk_fp8_f32(a, b, 0, false); w = __builtin_amdgcn_cvt_pk_fp8_f32(c, d, w, true); return (unsigned)w; }
__device__ __forceinline__ float fp8_byte0(unsigned w) { return __builtin_amdgcn_cvt_f32_fp8((int)w, 0); }
constexpr int P6_WSCR = 3328;
__device__ __forceinline__ void p6_token(const Args& a, lds_u8* wl, int tok, int lane, float* OUTW) {
    const int n = lane & 15, g = lane >> 4;
    const unsigned char* ws = a.ws;
    const unsigned char* WD = ws + WS_WD; const unsigned char* WU = ws + WS_WU;
    const int* IDX = (const int*)(ws + WS_IDX) + (size_t)tok * 128; const float* GATE = (const float*)(ws + WS_GATE) + (size_t)tok * 128;
    const bf16_t* X1 = (const bf16_t*)(ws + WS_X1B) + (size_t)tok * DM;
    {
#pragma unroll
        for (int j = 0; j < 4; ++j) {
            const u32x2 xw_ = *(const GAS u32x2*)(X1 + 256 * j + 4 * lane); const f32x4 v = (f32x4){__uint_as_float(xw_.x << 16), __uint_as_float(xw_.x & 0xffff0000u), __uint_as_float(xw_.y << 16), __uint_as_float(xw_.y & 0xffff0000u)} * P6_SX;
            const unsigned hw = pk4_fp8(v.x, v.y, v.z, v.w);
            const float r0 = v.x - __builtin_amdgcn_cvt_f32_fp8((int)hw, 0), r1 = v.y - __builtin_amdgcn_cvt_f32_fp8((int)hw, 1), r2 = v.z - __builtin_amdgcn_cvt_f32_fp8((int)hw, 2), r3 = v.w - __builtin_amdgcn_cvt_f32_fp8((int)hw, 3);
            const unsigned lw = pk4_fp8(r0 * 16.f, r1 * 16.f, r2 * 16.f, r3 * 16.f);
            *(LAS unsigned*)(wl + 256 * j + 4 * lane) = hw; *(LAS unsigned*)(wl + 1024 + 256 * j + 4 * lane) = lw;
        }
        const u32x2 iv = *(const GAS u32x2*)(IDX + lane * 2); *(LAS u32x2*)(wl + 2048 + lane * 8) = iv;
    }
    const float rs2 = row_rs2((const bf16_t*)(ws + WS_SSQ), tok);
    LDS_WAIT();
    const LAS int* idxl = (const LAS int*)(wl + 2048); LAS unsigned short* actl = (LAS unsigned short*)(wl + 2560);
    const int xoff = (n & 1) * 1024 + 16 * g;
#pragma unroll 1
    for (int eg = 0; eg < 8; ++eg) {
        const int e = idxl[eg * 16 + n];
        const unsigned char* rp = WD + (size_t)e * 128 + 16 * g;
        f32x4 acc = (f32x4){0.f, 0.f, 0.f, 0.f};
        u32x4 bq[16];
#pragma unroll
        for (int sl = 0; sl < 8; ++sl) { bq[2 * sl] = *(const GAS u32x4*)(rp + sl * P6_SLICEB); bq[2 * sl + 1] = *(const GAS u32x4*)(rp + sl * P6_SLICEB + 64); }
#pragma unroll
        for (int sl = 0; sl < 8; ++sl)
#pragma unroll
            for (int hf = 0; hf < 2; ++hf) {
                const u32x4 xa = *(const LAS u32x4*)(wl + xoff + sl * 128 + hf * 64); const u32x4 bb = bq[2 * sl + hf];
                acc = MFMA16F8((i64_t)(((unsigned long long)xa.y << 32) | xa.x), (i64_t)(((unsigned long long)bb.y << 32) | bb.x), acc);
                acc = MFMA16F8((i64_t)(((unsigned long long)xa.w << 32) | xa.z), (i64_t)(((unsigned long long)bb.w << 32) | bb.z), acc);
            }
        const float av = (acc[0] + acc[1] * 0.0625f) * (rs2 * (1.0f / (P6_SD * P6_SX)));
        const float act = 0.5f * av * (1.0f + erff(av * 0.70710678118654752f)) * GATE[eg * 16 + n] * P6_SA;
        const unsigned hb = pk4_fp8(act, 0.f, 0.f, 0.f) & 0xffu;
        const unsigned lb = pk4_fp8((act - fp8_byte0(hb)) * 16.f, 0.f, 0.f, 0.f) & 0xffu;
        if (g == 0) actl[eg * 16 + n] = (unsigned short)(hb | (lb << 8));
    }
    LDS_WAIT();
    const int pos = n & 7, sel = n >> 3;
    float ss = 0.f;
    const bool owner = (n < 8) && (g < 2);
#pragma unroll 1
    for (int sl = 0; sl < 8; ++sl) {
        f32x4 ah[2], al[2];
#pragma unroll
        for (int s = 0; s < 2; ++s) { ah[s] = (f32x4){0.f, 0.f, 0.f, 0.f}; al[s] = (f32x4){0.f, 0.f, 0.f, 0.f}; }
        u32x4 bq[16]; unsigned av[16];
#pragma unroll
        for (int q = 0; q < 16; ++q) { const int ei = 8 * q + 4 * sel + g; const int e = idxl[ei]; av[q] = actl[ei];
            bq[q] = *(const GAS u32x4*)(WU + sl * P6_SLICEB + (size_t)e * 128 + 16 * pos); }
#pragma unroll
        for (int q = 0; q < 16; ++q) {
            const unsigned long long ahv = (unsigned long long)(av[q] & 0xffu) << (8 * pos), alv = (unsigned long long)(av[q] >> 8) << (8 * pos);
            const u32x4 bb = bq[q];
            const i64_t b0 = (i64_t)(((unsigned long long)bb.y << 32) | bb.x), b1 = (i64_t)(((unsigned long long)bb.w << 32) | bb.z);
            ah[0] = MFMA16F8((i64_t)ahv, b0, ah[0]); al[0] = MFMA16F8((i64_t)alv, b0, al[0]);
            ah[1] = MFMA16F8((i64_t)ahv, b1, ah[1]); al[1] = MFMA16F8((i64_t)alv, b1, al[1]);
        }
#pragma unroll
        for (int s = 0; s < 2; ++s) {
            f32x4 t = ah[s] + al[s] * 0.0625f, u;
#pragma unroll
            for (int r = 0; r < 4; ++r) u[r] = __shfl(t[r], (lane + 40) & 63);
            const int col = 128 * sl + 16 * pos + 8 * s + 4 * (g & 1);
            const u32x2 xq_ = *(const GAS u32x2*)(X1 + col); const f32x4 xv = (f32x4){__uint_as_float(xq_.x << 16), __uint_as_float(xq_.x & 0xffff0000u), __uint_as_float(xq_.y << 16), __uint_as_float(xq_.y & 0xffff0000u)};
            const f32x4 x2 = xv + (t + u) * (1.0f / (P6_SA * P6_SU));
            if (owner) { ss += (x2.x * x2.x + x2.y * x2.y) + (x2.z * x2.z + x2.w * x2.w); *(GAS f32x4*)(OUTW + (size_t)tok * DM + col) = x2; }
        }
    }
    ss = wave_sum(ss);
    const float rn = 1.0f / sqrtf(ss * (1.0f / DM) + EPSF);
    const float* nf = a.in[16];
    if (owner) {
#pragma unroll
        for (int sl = 0; sl < 8; ++sl)
#pragma unroll
            for (int s = 0; s < 2; ++s) { const int col = 128 * sl + 16 * pos + 8 * s + 4 * g; const f32x4 gv = *(const GAS f32x4*)(nf + col);
                GAS f32x4* op = (GAS f32x4*)(OUTW + (size_t)tok * DM + col); *op = *op * rn * gv; }
    }
}

constexpr int P6S_WAVE = 16384 + 512 + 128;
static_assert(NWAVES * P6S_WAVE <= LDS_SCRATCH, "P6 LDS");
__device__ __forceinline__ float gelu_as(float v) {
    const float av = __builtin_fabsf(v), t = __builtin_amdgcn_rcpf(av * 0.2316418882f + 1.0f);
    float q = t * 0.5307027145f + (-0.7265760135f); q = q * t + 0.7107068705f; q = q * t + (-0.142248368f); q = q * t + 0.127414796f; q = q * t;
    const float e = __builtin_amdgcn_exp2f((v * v) * (-0.72134752044f));
    const float m = v * (q * e);
    return v < 0.f ? m : v - m;
}
template <int EMASK, int PARTS>
__device__ __forceinline__ void p6_slices(const Args& a, lds_u8* wl, int tok0, int lane) {
    const int n = lane & 15, g = lane >> 4;
    const unsigned char* ws = a.ws;
    const unsigned char* WD = ws + WS_WD; const unsigned char* WU = ws + WS_WU;
    LAS float* aacc = (LAS float*)wl; LAS unsigned short* idl = (LAS unsigned short*)(wl + 8192); LAS unsigned short* actl = (LAS unsigned short*)(wl + 12288);
    lds_u8* xs = wl + 16384; LAS float* ssl = (LAS float*)(wl + 16384 + 512); LAS float* r2l = ssl + 16;
    {
        u32x2 iv[16];
#pragma unroll
        for (int t = 0; t < 16; ++t) iv[t] = *(const GAS u32x2*)((const int*)(ws + WS_IDX) + (size_t)(tok0 + t) * 128 + lane * 2);
#pragma unroll
        for (int t = 0; t < 16; ++t) {
            *(LAS unsigned*)(wl + 8192 + t * 256 + lane * 4) = (iv[t].x & 0xffffu) | (iv[t].y << 16);
            *(LAS f32x2*)(wl + t * 512 + lane * 8) = (f32x2){0.f, 0.f};
        }
    }
    if (lane < 16) { ssl[lane] = 0.f; r2l[lane] = row_rs2((const bf16_t*)(ws + WS_SSQ), tok0 + lane); }
    unsigned char* X4 = (unsigned char*)a.ws + WS_XB;
#pragma unroll 1
    for (int t8 = 0; t8 < 16; t8 += 8) {
    u32x4 xwa[8], xwb[8];
#pragma unroll
    for (int tt = 0; tt < 8; ++tt) { const bf16_t* xr = (const bf16_t*)(ws + WS_X1B) + (size_t)(tok0 + t8 + tt) * DM + 16 * lane; xwa[tt] = *(const GAS u32x4*)xr; xwb[tt] = *(const GAS u32x4*)(xr + 8); }
#pragma unroll
    for (int tt = 0; tt < 8; ++tt) {
        const int t = t8 + tt;
        const u32x4 xw0 = xwa[tt], xw1 = xwb[tt];
        float rr[16];
#pragma unroll
        for (int j = 0; j < 4; ++j) { rr[2 * j] = __uint_as_float(xw0[j] << 16); rr[2 * j + 1] = __uint_as_float(xw0[j] & 0xffff0000u); rr[8 + 2 * j] = __uint_as_float(xw1[j] << 16); rr[9 + 2 * j] = __uint_as_float(xw1[j] & 0xffff0000u); }
#pragma unroll
        for (int st = 0; st < 4; ++st) {
            unsigned w0 = 0u, w1 = 0u;
#define P6_Q4(p_) do { w0 = __builtin_amdgcn_cvt_scalef32_pk_fp4_f32(w0, rr[2 * (p_)], rr[2 * (p_) + 1], 1.0f, p_); w1 = __builtin_amdgcn_cvt_scalef32_pk_fp4_f32(w1, rr[8 + 2 * (p_)], rr[9 + 2 * (p_)], 1.0f, p_); } while (0)
            P6_Q4(0); P6_Q4(1); P6_Q4(2); P6_Q4(3);
#undef P6_Q4
#define P6_D4(p_) do { const f32x2 d0 = __builtin_amdgcn_cvt_scalef32_pk_f32_fp4(w0, 1.0f, p_), d1 = __builtin_amdgcn_cvt_scalef32_pk_f32_fp4(w1, 1.0f, p_); \
                rr[2 * (p_)] = (rr[2 * (p_)] - d0.x) * 4.0f; rr[2 * (p_) + 1] = (rr[2 * (p_) + 1] - d0.y) * 4.0f; rr[8 + 2 * (p_)] = (rr[8 + 2 * (p_)] - d1.x) * 4.0f; rr[9 + 2 * (p_)] = (rr[9 + 2 * (p_)] - d1.y) * 4.0f; } while (0)
            P6_D4(0); P6_D4(1); P6_D4(2); P6_D4(3);
#undef P6_D4
            *(GAS u32x2*)(X4 + (size_t)(tok0 + t) * 2048 + st * 512 + 8 * lane) = (u32x2){w0, w1};
        }
    }
    }
    LDS_WAIT(); VM_WAIT();
    const int xoff = (n & 3) * 128 + 16 * g;
    const int bpa = 4 * (4 * (lane & 15) + (lane >> 4));
#define MFMA4(a_, b_, c_) __builtin_amdgcn_mfma_scale_f32_16x16x128_f8f6f4(a_, b_, c_, 4  , 4  , 0, 0, 0, 0)
#define P6_DLOAD(BQ, XV, it_) do { const int sl_ = (it_) >> 4, t_ = (it_) & 15; \
        _Pragma("unroll") for (int eg = 0; eg < 8; ++eg) { const int e_ = idl[t_ * 128 + eg * 16 + (lane >> 2)] & EMASK; const unsigned char* rp_ = WD + sl_ * P6_SLICEB + (size_t)e_ * 128 + 16 * (lane & 3); \
            BQ[2 * eg] = *(const GAS u32x4*)rp_; BQ[2 * eg + 1] = *(const GAS u32x4*)(rp_ + 64); } \
        XV = *(const GAS u32x2*)(X4 + (size_t)(tok0 + t_) * 2048 + (lane >> 4) * 512 + sl_ * 128 + 8 * (lane & 15)); } while (0)
#define P6_DCOMP(BQ, XV, it_) do { const int t_ = (it_) & 15; \
        *(LAS u32x2*)(xs + (lane >> 4) * 128 + 8 * (lane & 15)) = XV; \
        LDS_WAIT(); \
        const u32x4 xa0 = *(const LAS u32x4*)(xs + xoff), xa1 = *(const LAS u32x4*)(xs + xoff + 64); \
        const v8i_t A0 = (v8i_t){(int)xa0.x, (int)xa0.y, (int)xa0.z, (int)xa0.w, 0, 0, 0, 0}; \
        const v8i_t A1 = (v8i_t){(int)xa1.x, (int)xa1.y, (int)xa1.z, (int)xa1.w, 0, 0, 0, 0}; \
        _Pragma("unroll") for (int eg = 0; eg < 8; ++eg) { f32x4 acc = (f32x4){0.f, 0.f, 0.f, 0.f}; v8i_t b0 = (v8i_t){0, 0, 0, 0, 0, 0, 0, 0}, b1 = (v8i_t){0, 0, 0, 0, 0, 0, 0, 0}; \
            _Pragma("unroll") for (int w_ = 0; w_ < 4; ++w_) { b0[w_] = __builtin_amdgcn_ds_bpermute(bpa, (int)BQ[2 * eg][w_]); b1[w_] = __builtin_amdgcn_ds_bpermute(bpa, (int)BQ[2 * eg + 1][w_]); } \
            acc = MFMA4(A0, b0, acc); acc = MFMA4(A1, b1, acc); \
            float r_ = (acc[0] + acc[1] * 0.25f) + (acc[2] * 0.0625f + acc[3] * 0.015625f); asm volatile("" : "+v"(r_)); \
            if (g == 0) aacc[t_ * 128 + eg * 16 + n] += r_; } \
        LDS_WAIT(); } while (0)
    if (PARTS & 1) {
        u32x4 bqA[16], bqB[16]; u32x2 xvA, xvB;
        P6_DLOAD(bqA, xvA, 0);
#pragma unroll 1
        for (int it = 0; it < 64; it += 2) {
            P6_DLOAD(bqB, xvB, it + 1);
            P6_DCOMP(bqA, xvA, it);
            P6_DLOAD(bqA, xvA, (it + 2 < 64 ? it + 2 : it));
            P6_DCOMP(bqB, xvB, it + 1);
        }
    }
#undef MFMA4
#undef P6_DLOAD
#undef P6_DCOMP
    int lane_g = lane; asm volatile("" : "+v"(lane_g));
    float gts[16][2];
#pragma unroll
    for (int t = 0; t < 16; ++t) { gts[t][0] = ((const float*)(ws + WS_GATE))[(size_t)(tok0 + t) * 128 + lane_g]; gts[t][1] = ((const float*)(ws + WS_GATE))[(size_t)(tok0 + t) * 128 + lane_g + 64]; }
#pragma unroll
    for (int t = 0; t < 16; ++t) {
        const float sc = r2l[t] * (1.0f / P6_SD);
#pragma unroll
        for (int j = 0; j < 2; ++j) { const int ei = lane_g + 64 * j; const float av = aacc[t * 128 + ei] * sc;
            const float act = gelu_as(av) * gts[t][j];
            const unsigned ab = __float_as_uint(act), eb = (ab >> 23) & 255u;
            unsigned pk = 0u;
            if (eb > 4u) {
                const float m = __uint_as_float((ab & 0x807fffffu) | (128u << 23));
                const unsigned w0 = __builtin_amdgcn_cvt_scalef32_pk_fp4_f32(0u, m, 0.f, 1.0f, 0);
                const f32x2 d0 = __builtin_amdgcn_cvt_scalef32_pk_f32_fp4(w0, 1.0f, 0);
                const unsigned w1 = __builtin_amdgcn_cvt_scalef32_pk_fp4_f32(0u, (m - d0.x) * 4.0f, 0.f, 1.0f, 0);
                pk = (w0 & 15u) | ((w1 & 15u) << 4) | ((eb - 1u) << 8);
            }
            actl[t * 128 + ei] = (unsigned short)pk; }
    }
    LDS_WAIT();
    int lane_u = lane; asm volatile("" : "+v"(lane_u));
    const float* nf = a.in[16];
    const int ui = lane_u & 31, ug = lane_u >> 5, ush = 4 * (ui & 7);
    const unsigned uk0 = (ui >> 3) == 0 ? 0xffffffffu : 0u, uk1 = (ui >> 3) == 1 ? 0xffffffffu : 0u, uk2 = (ui >> 3) == 2 ? 0xffffffffu : 0u, uk3 = (ui >> 3) == 3 ? 0xffffffffu : 0u;
#ifndef P6_DIGITS
#define P6_DIGITS 2
#endif
#define MFMA32S(a_, b_, c_, sa_) __builtin_amdgcn_mfma_scale_f32_32x32x64_f8f6f4(a_, b_, c_, 4, 4, 0, sa_, 0, 127)
#ifndef P6_UPROBE
#define P6_UPROBE 0
#endif
#define P6_ULOAD(BQ, sq_) do { const int t_ = (sq_) >> 3, qs_ = (sq_) & 7; \
        if (!((P6_UPROBE & 1) && PARTS == 2 && EMASK != 0xffff)) \
        _Pragma("unroll") for (int q = 0; q < 8; ++q) { const int e_ = idl[t_ * 128 + 2 * (8 * qs_ + q) + ug] & EMASK; \
            BQ[q] = *(const GAS u32x4*)(WU + (size_t)e_ * 512 + 16 * ui); } } while (0)
#define P6_UMMA(BQ, sq_) do { const int t_ = (sq_) >> 3, qs_ = (sq_) & 7; \
        _Pragma("unroll") for (int q = 0; q < 8; ++q) { \
            const unsigned av_ = actl[t_ * 128 + 2 * (8 * qs_ + q) + ug]; \
            const unsigned w0_ = (av_ & 15u) << ush, w1_ = ((av_ >> 4) & 15u) << ush; const int s0_ = (int)(av_ >> 8), s1_ = s0_ - 2; \
            const u32x4 bb = BQ[q]; const v8i_t B_ = (v8i_t){(int)bb.x, (int)bb.y, (int)bb.z, (int)bb.w, 0, 0, 0, 0}; \
            if ((P6_UPROBE & 2) && PARTS == 2) { asm volatile("" :: "v"(w0_ & uk0), "v"(w0_ & uk1), "v"(w0_ & uk2), "v"(w0_ & uk3), "v"(w1_ & uk0), "v"(w1_ & uk1), "v"(w1_ & uk2), "v"(w1_ & uk3), "v"(bb), "v"(s0_), "v"(s1_)); continue; } \
            uacc = MFMA32S(((v8i_t){(int)(w0_ & uk0), (int)(w0_ & uk1), (int)(w0_ & uk2), (int)(w0_ & uk3), 0, 0, 0, 0}), B_, uacc, s0_); \
            if (P6_DIGITS == 2) uacc = MFMA32S(((v8i_t){(int)(w1_ & uk0), (int)(w1_ & uk1), (int)(w1_ & uk2), (int)(w1_ & uk3), 0, 0, 0, 0}), B_, uacc, s1_); } } while (0)
    f32x4 gvu[4];
#pragma unroll
    for (int gq = 0; gq < 4; ++gq) gvu[gq] = *(const GAS f32x4*)(nf + 32 * ui + 4 * ug + 8 * gq);
    u32x2 xqn[4];
#define P6_UXPREF(t_) do { const bf16_t* xrow_ = (const bf16_t*)(ws + WS_X1B) + (size_t)(tok0 + (t_)) * DM + 32 * ui + 4 * ug; \
        _Pragma("unroll") for (int gq = 0; gq < 4; ++gq) xqn[gq] = *(const GAS u32x2*)(xrow_ + 8 * gq); } while (0)
#define P6_UEPI(sq_) do { const int t_ = (sq_) >> 3; \
        f32x4 x2[4]; float ss = 0.f; \
        _Pragma("unroll") for (int gq = 0; gq < 4; ++gq) { \
            const u32x2 xq_ = xqn[gq]; \
            x2[gq] = (f32x4){__uint_as_float(xq_.x << 16), __uint_as_float(xq_.x & 0xffff0000u), __uint_as_float(xq_.y << 16), __uint_as_float(xq_.y & 0xffff0000u)} \
                + (f32x4){uacc[4 * gq], uacc[4 * gq + 1], uacc[4 * gq + 2], uacc[4 * gq + 3]} * (1.0f / P6_SU4); \
            ss += (x2[gq].x * x2[gq].x + x2[gq].y * x2[gq].y) + (x2[gq].z * x2[gq].z + x2[gq].w * x2[gq].w); } \
        const float rn = 1.0f / sqrtf(wave_sum(ss) * (1.0f / DM) + EPSF);     \
          \
        _Pragma("unroll") for (int gq = 0; gq < 4; ++gq) *(LAS f32x4*)(wl + ui * 144 + 32 * gq + 16 * ug) = x2[gq] * rn * gvu[gq]; \
        _Pragma("unroll") for (int k = 0; k < 4; ++k) { const int d_ = 4 * lane_u + 256 * k; const f32x4 ov_ = *(const LAS f32x4*)(wl + (d_ >> 5) * 144 + (d_ & 31) * 4); \
            if ((P6_UPROBE & 8) && PARTS == 2) asm volatile("" :: "v"(ov_)); else __builtin_nontemporal_store(ov_, (GAS f32x4*)(a.out + (size_t)(tok0 + t_) * DM + d_)); } \
        uacc = f32x16{}; } while (0)
    if (PARTS & 2) {
        u32x4 bqA[8], bqB[8]; f32x16 uacc = f32x16{};
        if ((P6_UPROBE & 1) && PARTS == 2 && EMASK != 0xffff) {
#pragma unroll
            for (int q = 0; q < 8; ++q) { bqA[q] = (u32x4){(unsigned)lane, 1u, 2u, 3u}; bqB[q] = bqA[q]; } }
        P6_ULOAD(bqA, 0);
#pragma unroll 1
        for (int sq = 0; sq < 128; sq += 2) {
            if ((sq & 7) == 0) P6_UXPREF(sq >> 3);
            P6_ULOAD(bqB, sq + 1);
            P6_UMMA(bqA, sq);
            P6_ULOAD(bqA, (sq + 2 < 128 ? sq + 2 : sq));
            P6_UMMA(bqB, sq + 1);
            if (((sq + 1) & 7) == 7) { if ((P6_UPROBE & 4) && PARTS == 2) { asm volatile("" : "+v"(uacc)); uacc = f32x16{}; } else P6_UEPI(sq + 1); }
        }
    }
#undef P6_ULOAD
#undef P6_UMMA
#undef P6_UEPI
#undef P6_UXPREF
#undef MFMA32S
}

#ifndef MK_N_LAUNCHES
#define MK_N_LAUNCHES 1
#endif
constexpr int NPHASE = 7;

__device__ __forceinline__ int queue_next(unsigned* ctr, volatile LAS unsigned* slot) {
    __syncthreads();
    if (threadIdx.x == 0) *slot = __hip_atomic_fetch_add(ctr, 1u, __ATOMIC_RELAXED, __HIP_MEMORY_SCOPE_AGENT);
    __syncthreads();
    return (int)*slot;
}

__global__ void __launch_bounds__(NTHR, 2) hymba_fwd(Args a) {
    extern __shared__ __attribute__((aligned(16))) unsigned char lds_raw[];
    lds_u8* lds = (lds_u8*)lds_raw;
    volatile LAS unsigned* MISC = (volatile LAS unsigned*)(lds + MISC_OFF);
    const int tid = threadIdx.x, lane = tid & 63; const int wave = __builtin_amdgcn_readfirstlane(tid >> 6);
    const int G = gridDim.x; const int bx = blockIdx.x;
    const int vcu = (G % 8 == 0) ? (bx % 8) * (G / 8) + bx / 8 : bx;
    const int gw = vcu * NWAVES + wave, NGW = G * NWAVES;
    for (int u = tid; u < (LDS_BYTES - MISC_OFF) / 4; u += NTHR) MISC[u] = 0u;
    __syncthreads();
    const int lo = a.ph_lo, hi = a.ph_hi;
    const bool use_bar = (hi - lo) > 1;
    XcdBarrier bar; bar.bar = (unsigned*)(a.ws + WS_CTL); bar.x = 0; bar.st = MISC + 8;
    if (use_bar) bar = xcd_barrier_post((unsigned*)(a.ws + WS_CTL), MISC + 8);
#ifndef PH_MASK
#define PH_MASK 127
#endif
#define IN(k) (((PH_MASK >> (k)) & 1) && lo <= (k) && (k) < hi)
#ifdef DBL_BAR
#define SEAM(k) do { if (IN(k) && IN((k) + 1)) { xcd_barrier(bar); xcd_barrier(bar); } } while (0)
#else
#define SEAM(k) do { if (IN(k) && IN((k) + 1)) xcd_barrier(bar); } while (0)
#endif
    unsigned char* ws = a.ws;

    if (IN(0)) { p0_prologue(a, lds, gw, NGW, lane, wave);
#ifdef DBL_P0
        __syncthreads(); p0_prologue(a, lds, gw, NGW, lane, wave);
#endif
    }
    SEAM(0);
    if (IN(1)) {
        pg8::Gemm g{(const bf16_t*)(ws + WS_XB), (const bf16_t*)(ws + WS_WIN), MTOK, NIN, DM}; pg8::StaticOrder S; S.init(MTOK, NIN, G, bx);
        EpiProj E{(bf16_t*)(ws + WS_PROJ), (const float*)(ws + WS_R1), (const f32x4*)(ws + WS_ROPE), (const float*)(ws + WS_DECAY)};
        pg8::gemm_phase<EpiProj, pg8::StaticOrder>(lds, g, S, E);
#ifdef DBL_P1
        pg8::gemm_phase<EpiProj, pg8::StaticOrder>(lds, g, S, E);
#endif
    }
    SEAM(1);
    if (IN(2)) {
#ifdef DBL_P2
        for (int rep = 0; rep < 2; ++rep) {
        unsigned* ctr = (unsigned*)(ws + WS_CTL + CTL_Q_ATT + rep * 256);
#else
        {
        unsigned* ctr = (unsigned*)(ws + WS_CTL + CTL_Q_ATT);
#endif
        int tkt = queue_next(ctr, MISC + 16);
        for (;;) {
            int u = tkt;
            if (u >= 64 + 1024 + DEF_ITEMS / 5) break;
            static_assert(DEF_ITEMS % 5 == 0 && DEF_ITEMS / 5 == 1024 / 4, "P2 ticket pattern");
            if (u >= 64) { const int i5 = (u - 64) / 5, r5 = (u - 64) % 5;
                if (r5 == 4) {
#ifdef PROBE_P2
                    if (rep == 0 && !(PROBE_P2 & 4)) { tkt = queue_next(ctr, MISC + 16); continue; }
#endif
                    for (int k = 0; k < 5; ++k) p0_deferred(a, lds, i5 * 5 + k);
                    tkt = queue_next(ctr, MISC + 16); continue; }
                u = 64 + i5 * 4 + r5; }
#ifdef PROBE_P2
            if (rep == 0) { if (u >= 64 && (PROBE_P2 & 2)) { const int v = u - 64;
#ifdef PROBE_ATT2
                    if (wave >= 4) attn_unit<PROBE_ATT2>(a, lds, (v & 31) >> 2, v & 3, 31 - (v >> 5)); else
#endif
                    attn_unit<PROBE_ATT>(a, lds, (v & 31) >> 2, v & 3, 31 - (v >> 5)); tkt = queue_next(ctr, MISC + 16); continue; }
                if (u < 64 && (PROBE_P2 & 1)) ret_unit(a, lds, u >> 3, u & 7);
                tkt = queue_next(ctr, MISC + 16); continue; }
#endif
            if (u < 64) { ret_unit(a, lds, u >> 3, u & 7); tkt = queue_next(ctr, MISC + 16); }
            else { const int v = u - 64; attn_unit<7>(a, lds, (v & 31) >> 2, v & 3, 31 - (v >> 5)); tkt = queue_next(ctr, MISC + 16); }
        }
        }
    }
    SEAM(2);
    if (IN(3)) {
        pg8::Gemm g{(const bf16_t*)(ws + WS_MIX), (const bf16_t*)(ws + WS_WOUT), MTOK, DM, DM}; pg8::StaticOrder S; S.init(MTOK, DM, G, bx);
        EpiX1 E{(const bf16_t*)(ws + WS_XB), (bf16_t*)(ws + WS_X1B), (bf16_t*)(ws + WS_SSQ)};
        pg8::gemm_phase<EpiX1, pg8::StaticOrder>(lds, g, S, E);

    }
    SEAM(3);
    if (IN(4)) {
        pg8::Gemm g{(const bf16_t*)(ws + WS_X1B), (const bf16_t*)(ws + WS_WPQ), MTOK, NQ, DM}; pg8::StaticOrder S; S.init(MTOK, NQ, G, bx);
        EpiQ E{(bf16_t*)(ws + WS_PROJ), (const bf16_t*)(ws + WS_SSQ)};
        pg8::gemm_phase<EpiQ, pg8::StaticOrder>(lds, g, S, E);
#ifdef DBL_P4
        pg8::gemm_phase<EpiQ, pg8::StaticOrder>(lds, g, S, E);
#endif
    }
    SEAM(4);
    if (IN(3)) {
#ifdef DBL_P3
        { unsigned long long w2 = (unsigned long long)ws; asm volatile("" : "+s"(w2)); unsigned char* ws2 = (unsigned char*)w2; int bx2 = bx; asm volatile("" : "+s"(bx2));
          pg8::Gemm g2{(const bf16_t*)(ws2 + WS_MIX), (const bf16_t*)(ws2 + WS_WOUT), MTOK, DM, DM}; pg8::StaticOrder S2; S2.init(MTOK, DM, G, bx2);
          EpiX1 E2{(const bf16_t*)(ws2 + WS_XB), (bf16_t*)(ws2 + WS_X1B), (bf16_t*)(ws2 + WS_SSQ)};
          pg8::gemm_phase<EpiX1, pg8::StaticOrder>(lds, g2, S2, E2); }
#endif
    }
    if (IN(5)) p5_topk(a, lds);
    SEAM(5);
#ifdef DBL_P5
    if (IN(5)) { Args a2 = a; asm volatile("" : "+s"(a2.ws)); p5_topk(a2, lds); }
#endif
    if (IN(6)) {
#ifdef P6_TOKEN_MAJOR
        lds_u8* wl = lds + wave * P6_WSCR;
        for (int tok = gw; tok < MTOK; tok += NGW) p6_token(a, wl, tok, lane, a.out);
#else
#ifdef PROBE_EMASK
        for (int tb = gw; tb < MTOK / 16; tb += NGW) p6_slices<PROBE_EMASK, PROBE_PARTS>(a, lds + wave * P6S_WAVE, tb * 16, lane);
#endif
#ifdef DBL_P6
#pragma unroll 1
        for (int rep6 = 0; rep6 < 2; ++rep6)
#endif
        for (int tb = gw; tb < MTOK / 16; tb += NGW) p6_slices<0xffff, 3>(a, lds + wave * P6S_WAVE, tb * 16, lane);
#endif
    }
#ifdef DBG_DUMP
    if (hi - lo > 1) xcd_barrier(bar);
    {
        for (int m = gw; m < MTOK; m += NGW) {
            for (int c = lane; c < DM; c += 64) {
                float v = 0.f;
#if DBG_DUMP == 1
                v = bf2f(((const bf16_t*)(ws + WS_PROJ))[(size_t)m * NIN + DBG_COL + c]);
#elif DBG_DUMP == 2
                v = (c >= DBG_C0 && c < DBG_C1) ? bf2f(((const bf16_t*)(ws + WS_MIX))[(size_t)m * DM + c]) : 0.f;
#endif
                a.out[(size_t)m * DM + c] = v;
            }
        }
    }
#endif
#undef IN
#undef SEAM
}

extern "C" void kernel_launch(void* const* d_in, const int* in_sizes, int n_in, void* d_out, int out_size, void* d_ws, size_t ws_size, hipStream_t stream) {
    static int grid = 0;
    if (grid == 0) {
        if (n_in != 17 || in_sizes[0] != MTOK * DM || out_size != MTOK * DM || ws_size < WS_END) {
            fprintf(stderr, "kernel_launch: unexpected shapes (n_in %d, in0 %d, out %d, ws %zu < %zu); nothing launched\n", n_in, n_in > 0 ? in_sizes[0] : -1, out_size, ws_size, (size_t)WS_END); grid = -1; return; }
        int dev = 0, cus = 0, per_cu = 0;
        if (hipGetDevice(&dev) != hipSuccess || hipDeviceGetAttribute(&cus, hipDeviceAttributeMultiprocessorCount, dev) != hipSuccess) { fprintf(stderr, "kernel_launch: device query failed\n"); grid = -1; return; }
        if (hipFuncSetAttribute((const void*)hymba_fwd, hipFuncAttributeMaxDynamicSharedMemorySize, LDS_BYTES) != hipSuccess) { fprintf(stderr, "kernel_launch: hipFuncSetAttribute failed\n"); grid = -1; return; }
        if (hipOccupancyMaxActiveBlocksPerMultiprocessor(&per_cu, (const void*)hymba_fwd, NTHR, LDS_BYTES) != hipSuccess || per_cu < 1)
            fprintf(stderr, "kernel_launch: note: occupancy query reports %d workgroups per CU\n", per_cu);
        (void)hipGetLastError();
        grid = cus;
    }
    if (grid < 0) return;
    if (hipMemsetAsync((char*)d_ws + WS_CTL, 0, CTL_BYTES, stream) != hipSuccess) { fprintf(stderr, "kernel_launch: memset failed\n"); return; }
    Args a{};
    for (int i = 0; i < 17; ++i) a.in[i] = (const float*)d_in[i];
    a.out = (float*)d_out; a.ws = (unsigned char*)d_ws;
#if MK_N_LAUNCHES == 1
#ifdef DBG_STOP
    a.ph_lo = 0; a.ph_hi = DBG_STOP + 1;
#else
    a.ph_lo = 0; a.ph_hi = NPHASE;
#endif
    hipLaunchKernelGGL(hymba_fwd, dim3(grid), dim3(NTHR), LDS_BYTES, stream, a);
#else
    for (int p = 0; p < NPHASE; ++p) { a.ph_lo = p; a.ph_hi = p + 1; hipLaunchKernelGGL(hymba_fwd, dim3(grid), dim3(NTHR), LDS_BYTES, stream, a); }
#endif
    const hipError_t le = hipPeekAtLastError();
    if (le != hipSuccess) fprintf(stderr, "kernel_launch: launch failed: %s\n", hipGetErrorName(le));
}
```

```cpp
#include <hip/hip_runtime.h>
#include <cstdio>
#include <cstdint>

namespace pg8 {
#define PG8_LAS __attribute__((address_space(3)))
typedef unsigned short bf16_t;
typedef short bf16x8 __attribute__((ext_vector_type(8)));
typedef float f32x4 __attribute__((ext_vector_type(4)));
typedef unsigned u32x4 __attribute__((ext_vector_type(4)));
constexpr int BM = 256, BK = 64, HALF = 128, HTB = HALF * BK * 2  , STAGE_BYTES = 8 * HTB, NXCD = 8, WGM = 8;

__host__ __device__ __forceinline__ int lds_byte(int r, int c) { const int st = (r >> 4) * 2 + (c >> 5), rr = r & 15, cc = c & 31, ob = rr * 64 + cc * 2; return st * 1024 + (ob ^ (((ob >> 9) & 1) << 5)); }
__host__ __device__ __forceinline__ void stage_rc(int b, int& R, int& C) { const int st = b / 1024, sb = b % 1024, swz = sb ^ (((sb >> 9) & 1) << 5); R = (st >> 1) * 16 + swz / 64; C = (st & 1) * 32 + (swz % 64) / 2; }
__host__ __device__ __forceinline__ int perm32(int rho) { const int n = rho >> 4, i = rho & 15; return 8 * (i >> 2) + 4 * n + (i & 3); }

struct Unit { int pm, pn; };
struct Gemm { const bf16_t* A; const bf16_t* Bt; int M, N, K; };

struct StaticOrder {
    int nM, nN, nwg, G, c;
    __host__ __device__ void init(int M, int N, int G_, int c_) { nM = M / BM; nN = N / BM; nwg = nM * nN; G = G_; c = c_; }
    __host__ __device__ bool next(int i, Unit& u) const {
        const long L = (long)i * G + c; if (L >= nwg) return false;
        int wgid = (int)L; { const int q = nwg / NXCD, r = nwg % NXCD, xcd = wgid % NXCD, off = wgid / NXCD; wgid = (xcd < r ? xcd * (q + 1) : r * (q + 1) + (xcd - r) * q) + off; }
        const int nig = WGM * nN, gid = wgid / nig, fm = gid * WGM, gsz = (nM - fm) < WGM ? (nM - fm) : WGM;
        u.pm = fm + ((wgid % nig) % gsz); u.pn = (wgid % nig) / gsz; return true;
    }
    __device__ __forceinline__ void a_ready(const Unit&) const {}
    __device__ __forceinline__ void done(const Unit&) const {}
};
__device__ __forceinline__ unsigned cvt_pk_bf16(float lo, float hi) { unsigned r; asm volatile("v_cvt_pk_bf16_f32 %0, %1, %2" : "=v"(r) : "v"(lo), "v"(hi)); return r; }
template <class Epi, class Sched>
__device__ __forceinline__ void gemm_phase(PG8_LAS unsigned char* lds, const Gemm g, const Sched& S, const Epi& E) {
    const int tid = threadIdx.x, wid = __builtin_amdgcn_readfirstlane(tid >> 6), lane = tid & 63, wr = wid >> 2, wc = wid & 3, fr = lane & 15, fq = lane >> 4;
    const int K = g.K, nt = K / BK;
    unsigned voffA[2], voffB[2];
#pragma unroll
    for (int i = 0; i < 2; ++i) { int R, C; stage_rc(tid * 16 + i * 8192, R, C); const int Rb = Epi::PERM ? ((R & ~31) + perm32(R & 31)) : R;
        voffA[i] = (unsigned)(R * K + C) * 2u; voffB[i] = (unsigned)(Rb * K + C) * 2u; }
    const size_t kstep = (size_t)(BK * 2);
    const size_t hstep = (size_t)HALF * K * 2;
    const size_t tstep = 2 * hstep;
    const unsigned ldsw = (unsigned)wid * 1024u;
    const int aoff = lds_byte(wr * 64 + fr, fq * 8), boff = lds_byte(wc * 32 + fr, fq * 8);
#define PG8_SA(b, h) (((b) * 2 + (h)) * HTB)
#define PG8_SB(b, h) ((4 + (b) * 2 + (h)) * HTB)
#define PG8_STAGE(bufoff, gbase, voff) do { _Pragma("unroll") for (int _i = 0; _i < 2; ++_i) \
        __builtin_amdgcn_global_load_lds((const unsigned*)((const char*)(gbase) + (voff)[_i]), (PG8_LAS unsigned*)(lds + (bufoff) + ldsw + _i * 8192), 16, 0, 0); } while (0)
#define PG8_LDA(dst, b, h) do { _Pragma("unroll") for (int m = 0; m < 4; ++m) _Pragma("unroll") for (int k = 0; k < 2; ++k) dst[m][k] = *(const PG8_LAS bf16x8*)(lds + PG8_SA(b, h) + aoff + m * 2048 + k * 1024); } while (0)
#define PG8_LDB(dst, b, h) do { _Pragma("unroll") for (int n = 0; n < 2; ++n) _Pragma("unroll") for (int k = 0; k < 2; ++k) dst[n][k] = *(const PG8_LAS bf16x8*)(lds + PG8_SB(b, h) + boff + n * 2048 + k * 1024); } while (0)
#define PG8_MMA(ai, bj, At, Bt) do { __builtin_amdgcn_s_setprio(1); _Pragma("unroll") for (int m = 0; m < 4; ++m) _Pragma("unroll") for (int n = 0; n < 2; ++n) _Pragma("unroll") for (int k = 0; k < 2; ++k) \
        acc[ai][bj][m][n] = __builtin_amdgcn_mfma_f32_16x16x32_bf16(Bt[n][k], At[m][k], acc[ai][bj][m][n], 0, 0, 0); __builtin_amdgcn_s_setprio(0); } while (0)
#define PG8_WAIT_V(n) asm volatile("s_waitcnt vmcnt(" #n ")" ::: "memory")
#define PG8_WAIT_L(n) asm volatile("s_waitcnt lgkmcnt(" #n ")" ::: "memory")
#define PG8_BAR __builtin_amdgcn_s_barrier()
#define PG8_SCHED __builtin_amdgcn_sched_barrier(0)
    Unit cur, nxt; int ui = 0;
    if (!S.next(0, cur)) return;
    f32x4 acc[2][2][4][2];
#pragma unroll
    for (int a = 0; a < 2; ++a)
#pragma unroll
        for (int b = 0; b < 2; ++b)
#pragma unroll
            for (int m = 0; m < 4; ++m)
#pragma unroll
                for (int n = 0; n < 2; ++n) acc[a][b][m][n] = (f32x4){0.f, 0.f, 0.f, 0.f};
    bf16x8 At[4][2], B0[2][2], B1[2][2];
    const char* cA = (const char*)g.A + (size_t)cur.pm * tstep; const char* cB = (const char*)g.Bt + (size_t)cur.pn * tstep;
    S.a_ready(cur);
    PG8_STAGE(PG8_SB(0, 0), cB, voffB); PG8_STAGE(PG8_SA(0, 0), cA, voffA); PG8_STAGE(PG8_SB(0, 1), cB + hstep, voffB); PG8_STAGE(PG8_SA(0, 1), cA + hstep, voffA);
    if (wr == 1) PG8_BAR;
    PG8_WAIT_V(4); PG8_BAR;
    PG8_STAGE(PG8_SB(1, 0), cB + kstep, voffB); PG8_STAGE(PG8_SA(1, 0), cA + kstep, voffA); PG8_STAGE(PG8_SB(1, 1), cB + hstep + kstep, voffB);
    PG8_WAIT_V(6); PG8_BAR;
    for (;;) {
        const bool has_next = S.next(ui + 1, nxt);
        const char* nA = has_next ? (const char*)g.A + (size_t)nxt.pm * tstep : cA; const char* nB = has_next ? (const char*)g.Bt + (size_t)nxt.pn * tstep : cB;
        for (int t = 0; t < nt; t += 2) {
            const bool last = (t == nt - 2);
            const char* a1 = cA + (size_t)(t + 1) * kstep;
            const char* a2 = last ? nA : cA + (size_t)(t + 2) * kstep; const char* b2 = last ? nB : cB + (size_t)(t + 2) * kstep;
            const char* a3 = a2 + kstep; const char* b3 = b2 + kstep;
            if (last && has_next) S.a_ready(nxt);
            PG8_LDB(B0, 0, 0); PG8_SCHED; PG8_LDA(At, 0, 0); PG8_STAGE(PG8_SA(1, 1), a1 + hstep, voffA);
            PG8_WAIT_L(8); PG8_BAR; PG8_WAIT_L(0); PG8_MMA(0, 0, At, B0); PG8_BAR; PG8_SCHED;
            PG8_LDB(B1, 0, 1); PG8_STAGE(PG8_SB(0, 0), b2, voffB);
            PG8_BAR; PG8_WAIT_L(0); PG8_MMA(0, 1, At, B1); PG8_BAR;
            PG8_LDA(At, 0, 1); PG8_STAGE(PG8_SA(0, 0), a2, voffA);
            PG8_BAR; PG8_WAIT_L(0); PG8_MMA(1, 0, At, B0); PG8_BAR; PG8_SCHED;
            PG8_STAGE(PG8_SB(0, 1), b2 + hstep, voffB);
            PG8_WAIT_V(6); PG8_BAR; PG8_MMA(1, 1, At, B1); PG8_BAR;
            PG8_LDB(B0, 1, 0); PG8_SCHED; PG8_LDA(At, 1, 0); PG8_STAGE(PG8_SA(0, 1), a2 + hstep, voffA);
            PG8_WAIT_L(8); PG8_BAR; PG8_WAIT_L(0); PG8_MMA(0, 0, At, B0); PG8_BAR; PG8_SCHED;
            PG8_LDB(B1, 1, 1); PG8_STAGE(PG8_SB(1, 0), b3, voffB);
            PG8_BAR; PG8_WAIT_L(0); PG8_MMA(0, 1, At, B1); PG8_BAR;
            PG8_LDA(At, 1, 1); PG8_STAGE(PG8_SA(1, 0), a3, voffA);
            PG8_BAR; PG8_WAIT_L(0); PG8_MMA(1, 0, At, B0); PG8_BAR; PG8_SCHED;
            PG8_STAGE(PG8_SB(1, 1), b3 + hstep, voffB);
            PG8_WAIT_V(6); PG8_BAR; PG8_MMA(1, 1, At, B1); PG8_BAR;
        }
        if constexpr (!Epi::AFTER_DRAIN) { E(acc, cur, wr, wc, fr, fq); S.done(cur); }
        if (!has_next) break;
#pragma unroll
        for (int a = 0; a < 2; ++a)
#pragma unroll
            for (int b = 0; b < 2; ++b)
#pragma unroll
                for (int m = 0; m < 4; ++m)
#pragma unroll
                    for (int n = 0; n < 2; ++n) acc[a][b][m][n] = (f32x4){0.f, 0.f, 0.f, 0.f};
        cur = nxt; cA = nA; cB = nB; ++ui;
    }
    PG8_WAIT_V(0);
    if (wr == 0) PG8_BAR;
    PG8_BAR;
    if constexpr (Epi::AFTER_DRAIN) { E.fused(acc, cur, wr, wc, fr, fq, lds, wid, lane); S.done(cur); }
#undef PG8_SA
#undef PG8_SB
#undef PG8_STAGE
#undef PG8_LDA
#undef PG8_LDB
#undef PG8_MMA
#undef PG8_WAIT_V
#undef PG8_WAIT_L
#undef PG8_BAR
#undef PG8_SCHED
}
}

#define XB_TMO      128
#define XB_XCNT(j)  (256  + 64 * (j))
#define XB_XSUB(j)  (1280 + 64 * (j))
#define XB_XGEN(j)  (2304 + 64 * (j))
#define XB_TOP      3328
#define XB_TOPGEN   3392
#define XCD_BAR_WORDS 3456
#define XB_SPIN_CAP (1u << 18)
#define LAS __attribute__((address_space(3)))

__device__ __forceinline__ unsigned xb_ld(unsigned* p)              { return __hip_atomic_load(p, __ATOMIC_RELAXED, __HIP_MEMORY_SCOPE_AGENT); }
__device__ __forceinline__ unsigned xb_add(unsigned* p, unsigned v) { return __hip_atomic_fetch_add(p, v, __ATOMIC_RELAXED, __HIP_MEMORY_SCOPE_AGENT); }
__device__ __forceinline__ unsigned xb_xcc_id() { return (unsigned)__builtin_amdgcn_s_getreg((3 << 11) | 20) & 0xFu; }
#define XB_SPIN(cond, bar) do { unsigned _sp = 0; while (cond) { __builtin_amdgcn_s_sleep(1); \
    if ((++_sp & 255u) == 0u) { if (xb_ld(&(bar)[XB_TMO])) break; if (_sp > XB_SPIN_CAP) { atomicAdd(&(bar)[XB_TMO], 1u); break; } } } } while (0)

struct XcdBarrier {
    unsigned* bar; unsigned x;
    volatile LAS unsigned* st;
};

__device__ __forceinline__ XcdBarrier xcd_barrier_post(unsigned* bar, volatile LAS unsigned* st) {
    XcdBarrier b; b.bar = bar; b.x = xb_xcc_id(); b.st = st;
    if (threadIdx.x == 0) (void)xb_add(&bar[XB_XCNT(b.x)], 1u);
    return b;
}
__device__ __forceinline__ void xcd_barrier_complete(unsigned* bar, unsigned x, unsigned& nloc, unsigned& nx) {
    const unsigned G = gridDim.x * gridDim.y * gridDim.z;
    unsigned sum, cnt, mine, sp = 0u;
    for (;;) {
        sum = 0u; cnt = 0u; mine = 0u;
#pragma unroll
        for (unsigned j = 0; j < 16; ++j) { const unsigned c = xb_ld(&bar[XB_XCNT(j)]); sum += c; cnt += (c > 0u) ? 1u : 0u; mine = (j == x) ? c : mine; }
        if (sum == G) break;
        __builtin_amdgcn_s_sleep(1);
        if ((++sp & 255u) == 0u) { if (xb_ld(&bar[XB_TMO])) break; if (sp > XB_SPIN_CAP) { atomicAdd(&bar[XB_TMO], 1u); break; } }
    }
    nloc = mine > 0u ? mine : 1u; nx = cnt > 0u ? cnt : 1u;
}

__device__ __forceinline__ void xcd_barrier(const XcdBarrier& b) {
    asm volatile("s_waitcnt vmcnt(0)" ::: "memory");
    __syncthreads();
    if (threadIdx.x == 0) {
        unsigned* bar = b.bar;
        __builtin_amdgcn_s_waitcnt(0);
        unsigned nloc = b.st[0], nx = b.st[1];
        if (nloc == 0u) { xcd_barrier_complete(bar, b.x, nloc, nx); b.st[0] = nloc; b.st[1] = nx; }
        const unsigned old = xb_add(&bar[XB_XSUB(b.x)], 1u);
        const unsigned gen = old / nloc;
        if (old + 1u == (gen + 1u) * nloc) {
            __builtin_amdgcn_fence(__ATOMIC_RELEASE, "agent");
            asm volatile("s_waitcnt vmcnt(0)" ::: "memory");
            const unsigned og = xb_add(&bar[XB_TOP], 1u);
            const unsigned tg = og / nx;
            if (og + 1u == (tg + 1u) * nx) xb_add(&bar[XB_TOPGEN], 1u);
            else XB_SPIN(xb_ld(&bar[XB_TOPGEN]) == tg, bar);
            __builtin_amdgcn_fence(__ATOMIC_ACQUIRE, "agent");
            xb_add(&bar[XB_XGEN(b.x)], 1u);
            asm volatile("s_waitcnt vmcnt(0)" ::: "memory");
        } else {
            XB_SPIN(xb_ld(&bar[XB_XGEN(b.x)]) == gen, bar);
            __builtin_amdgcn_fence(__ATOMIC_ACQUIRE, "agent");
            asm volatile("s_waitcnt vmcnt(0)" ::: "memory");
        }
    }
    __syncthreads();
}

#define GAS __attribute__((address_space(1)))
typedef unsigned short bf16_t;
typedef short bf16x8 __attribute__((ext_vector_type(8)));
typedef short s16x4 __attribute__((ext_vector_type(4)));
typedef float f32x4 __attribute__((ext_vector_type(4)));
typedef float f32x2 __attribute__((ext_vector_type(2)));
typedef float f32x16 __attribute__((ext_vector_type(16)));
typedef unsigned u32x4 __attribute__((ext_vector_type(4)));
typedef unsigned u32x2 __attribute__((ext_vector_type(2)));
typedef LAS unsigned char lds_u8;

constexpr int MTOK = 32768, DM = 1024, SEQ = 4096, NBATCH = 8, NIN = 3584;
constexpr int OFF_RQ = 0, OFF_RK = 512, OFF_RV = 1024, OFF_RG = 1536, OFF_DQ = 2048, OFF_DK = 2560, OFF_DV = 3072;
constexpr int NEXP = 16384, NQ = 2048;
constexpr float EPSF = 1e-6f, LOG2E = 1.4426950408889634f;
constexpr int NWAVES = 8, NTHR = 512;

constexpr size_t WS_CTL = 0, CTL_BYTES = 65536;
constexpr size_t CTL_Q_ATT = 16384, CTL_Q_P6 = 16384 + 1024;
constexpr size_t WS_R1 = WS_CTL + CTL_BYTES;
constexpr size_t WS_SSQ = WS_R1 + (size_t)MTOK * 4;
constexpr size_t WS_ROPE = WS_SSQ + (size_t)MTOK * 16 * 4;
constexpr size_t WS_DECAY = WS_ROPE + (size_t)SEQ * 32 * 8;
constexpr size_t WS_BTAB = WS_DECAY + 2 * 8 * 128 * 4;
constexpr size_t WS_LAM = WS_BTAB + 4 * 128 * 4;
constexpr size_t WS_WIN = 4u << 20;
constexpr size_t WS_WOUT = WS_WIN + (size_t)NIN * DM * 2;
constexpr size_t WS_WPQ = WS_WOUT + (size_t)DM * DM * 2;
constexpr size_t WS_KEYS = WS_WPQ + (size_t)NQ * DM * 2;
constexpr size_t WS_WD = WS_KEYS + (size_t)8 * 2 * 128 * 128 * 2;
constexpr size_t WS_WU = WS_WD + (size_t)NEXP * DM * 2;
constexpr size_t WS_XB = WS_WU + (size_t)NEXP * DM * 2;
constexpr size_t WS_PROJ = WS_XB + (size_t)MTOK * DM * 2;
constexpr size_t WS_MIX = WS_PROJ + (size_t)MTOK * NIN * 2;
constexpr size_t WS_IDX = WS_MIX, WS_GATE = WS_MIX + (size_t)MTOK * 128 * 4;
constexpr size_t WS_X1B = WS_PROJ + (size_t)MTOK * NQ * 2;
static_assert(WS_X1B + (size_t)MTOK * DM * 2 <= WS_MIX, "ws map");
constexpr size_t WS_END = WS_MIX + (size_t)MTOK * DM * 2;
static_assert(WS_LAM + 256 <= WS_WIN, "ws map");
static_assert(WS_END <= (size_t)512 << 20, "ws map");

constexpr int LDS_SCRATCH = 139264;
constexpr int MISC_OFF = LDS_SCRATCH;
constexpr int LDS_BYTES = 147456;

__device__ __forceinline__ float wave_sum(float v) {
    v += __uint_as_float(__builtin_amdgcn_update_dpp(0u, __float_as_uint(v), 0xB1, 0xf, 0xf, true));
    v += __uint_as_float(__builtin_amdgcn_update_dpp(0u, __float_as_uint(v), 0x4E, 0xf, 0xf, true));
    v += __uint_as_float(__builtin_amdgcn_update_dpp(0u, __float_as_uint(v), 0x141, 0xf, 0xf, true));
    v += __uint_as_float(__builtin_amdgcn_update_dpp(0u, __float_as_uint(v), 0x140, 0xf, 0xf, true));
    { auto rr = __builtin_amdgcn_permlane16_swap(__float_as_uint(v), __float_as_uint(v), false, false); v = __uint_as_float(rr[0]) + __uint_as_float(rr[1]); }
    { auto rr = __builtin_amdgcn_permlane32_swap(__float_as_uint(v), __float_as_uint(v), false, false); v = __uint_as_float(rr[0]) + __uint_as_float(rr[1]); }
    return v;
}
typedef __bf16 bf16v2_t __attribute__((ext_vector_type(2)));
__device__ __forceinline__ unsigned pk2(float lo, float hi) { const bf16v2_t v = {(__bf16)lo, (__bf16)hi}; return __builtin_bit_cast(unsigned, v); }
__device__ __forceinline__ float bf2f(unsigned short b) { return __uint_as_float(((unsigned)b) << 16); }
#define LDS_WAIT() asm volatile("s_waitcnt lgkmcnt(0)" ::: "memory")
#define VM_WAIT() asm volatile("s_waitcnt vmcnt(0)" ::: "memory")

struct Args {
    const float* in[17]; float* out; unsigned char* ws; int ph_lo, ph_hi;
};

template <int MODE>
__device__ __forceinline__ void p0_transpose_item(const float* W, const float* scale, int K, int N, bf16_t* WT, LAS float* scr, int item, int lane) {
    const int nblk = N / 32, kb = item / nblk, nb = item % nblk, k0 = 64 * kb, n0 = 32 * nb;
#pragma unroll 8
    for (int i = 0; i < 32; ++i) { const int kk = 2 * i + (lane >> 5); const float sc = scale ? scale[k0 + kk] : 1.0f; scr[kk * 33 + (lane & 31)] = __builtin_nontemporal_load((const GAS float*)(W + (size_t)(k0 + kk) * N + n0 + (lane & 31))) * sc; }
    LDS_WAIT();
    const int c = lane & 7;
#pragma unroll
    for (int j = 0; j < 4; ++j) { const int n = (lane >> 3) + 8 * j; const LAS float* s = scr + (8 * c) * 33 + n;
        u32x4 o; o.x = pk2(s[0 * 33], s[1 * 33]); o.y = pk2(s[2 * 33], s[3 * 33]); o.z = pk2(s[4 * 33], s[5 * 33]); o.w = pk2(s[6 * 33], s[7 * 33]);
        int nn = n0 + n;
        if (MODE == 1 && nn < 1024) { const int d = nn & 63; nn = (nn & ~63) + ((d < 32) ? 2 * d : 2 * (d - 32) + 1); }
        *(GAS u32x4*)(WT + (size_t)nn * K + k0 + 8 * c) = o; }
    LDS_WAIT();
}

__device__ __forceinline__ int t5_bucket(int n) {
    if (n < 16) return n;
    const float v = logf((float)n / 16.0f) / 2.0794415416798357f * 16.0f;
    int b = 16 + (int)v; return b > 31 ? 31 : b;
}

__device__ __forceinline__ void p0_prologue(const Args& a, lds_u8* lds, int gw, int NGW, int lane, int wave) {
    unsigned char* ws = a.ws;
    const float* x = a.in[0];
    bf16_t* xb = (bf16_t*)(ws + WS_XB); float* r1 = (float*)(ws + WS_R1);
    for (int m0 = gw; m0 < MTOK; m0 += 4 * NGW) {
        f32x4 v[4][4];
#pragma unroll
        for (int r = 0; r < 4; ++r) { const int m = m0 + r * NGW; const GAS f32x4* xr = (const GAS f32x4*)(x + (size_t)(m < MTOK ? m : m0) * DM) + lane;
#pragma unroll
            for (int j = 0; j < 4; ++j) v[r][j] = __builtin_nontemporal_load(xr + 64 * j); }
#pragma unroll
        for (int r = 0; r < 4; ++r) { const int m = m0 + r * NGW; if (m >= MTOK) break;
            float s = 0.f;
#pragma unroll
            for (int j = 0; j < 4; ++j) s += (v[r][j].x * v[r][j].x + v[r][j].y * v[r][j].y) + (v[r][j].z * v[r][j].z + v[r][j].w * v[r][j].w);
            s = wave_sum(s);
            GAS u32x2* o8 = (GAS u32x2*)(xb + (size_t)m * DM) + lane;
#pragma unroll
            for (int j = 0; j < 4; ++j) { u32x2 o; o.x = pk2(v[r][j].x, v[r][j].y); o.y = pk2(v[r][j].z, v[r][j].w); o8[64 * j] = o; }
            if (lane == 0) r1[m] = 1.0f / sqrtf(s * (1.0f / DM) + EPSF); }
    }
    {
        LAS float* scr = (LAS float*)(lds + wave * 8704);
        constexpr int I_IN = (DM / 64) * (NIN / 32);
        for (int it = gw; it < I_IN; it += NGW) p0_transpose_item<1>(a.in[2], a.in[1], DM, NIN, (bf16_t*)(ws + WS_WIN), scr, it, lane);
    }
    const int gt = gw * 64 + lane, NGT = NGW * 64;
    {
        f32x2* rope = (f32x2*)(ws + WS_ROPE);
        for (int i = gt; i < SEQ * 32; i += NGT) { const int pos = i >> 5, j = i & 31; const float fr = (float)pow(10000.0, -(double)j / 32.0); const float ang = (float)pos * fr;
            rope[i] = (f32x2){(float)cos((double)ang), (float)sin((double)ang)}; }
        float* dec = (float*)(ws + WS_DECAY);
        for (int i = gt; i < 2 * 8 * 128; i += NGT) { const int l = i & 127, h = (i >> 7) & 7, kk = i >> 10; const double lg = log2(1.0 - exp2(-5.0 - (double)h));
            dec[i] = kk ? (float)(0.125 * exp2(-lg * (double)l)) : (float)exp2(lg * (double)l); }
        float* bt = (float*)(ws + WS_BTAB); const float* rb = a.in[9];
        for (int i = gt; i < 4 * 128; i += NGT) { const int n = i & 127, h = i >> 7; bt[i] = rb[t5_bucket(n) * 4 + h] * LOG2E; }
        if (gt == 0) { float s1 = 0.f, s2 = 0.f; for (int i = 0; i < 64; ++i) { s1 += a.in[4][i] * a.in[5][i]; s2 += a.in[6][i] * a.in[7][i]; }
            ((float*)(ws + WS_LAM))[0] = expf(s1) - expf(s2) + 0.2f; }
    }
}


constexpr int DEF_T0 = 192, DEF_T1 = 64, DEF_T2 = 512, DEF_T3 = 512, DEF_ITEMS = DEF_T0 + DEF_T1 + DEF_T2 + DEF_T3;
__device__ __forceinline__ void p0_deferred(const Args& a, lds_u8* lds, int item) {
    unsigned char* ws = a.ws;
    int tid_ = threadIdx.x; asm volatile("" : "+v"(tid_));
    const int tid = tid_, lane = tid & 63; const int wave = __builtin_amdgcn_readfirstlane(tid >> 6);
    if (item < DEF_T0) {
        LAS float* scr = (LAS float*)(lds + wave * 8704);
        constexpr int I_OUT = (DM / 64) * (DM / 32), I_PQ = (DM / 64) * (NQ / 32);
        static_assert(I_OUT + I_PQ == DEF_T0 * 8, "deferred transposes");
        const int r = item * 8 + wave;
        if (r < I_OUT) p0_transpose_item<0>(a.in[10], nullptr, DM, DM, (bf16_t*)(ws + WS_WOUT), scr, r, lane);
        else p0_transpose_item<0>(a.in[12], a.in[11], DM, NQ, (bf16_t*)(ws + WS_WPQ), scr, r - I_OUT, lane);
        return;
    }
    item -= DEF_T0;
    if (item < DEF_T1) {
        const float* pk = a.in[13]; bf16_t* kb = (bf16_t*)(ws + WS_KEYS);
        const int i = item * 512 + tid;
        const GAS f32x4* s = (const GAS f32x4*)(pk + (size_t)i * 8); const f32x4 p = __builtin_nontemporal_load(s), q = __builtin_nontemporal_load(s + 1);
        u32x4 o; o.x = pk2(p.x, p.y); o.y = pk2(p.z, p.w); o.z = pk2(q.x, q.y); o.w = pk2(q.z, q.w); *(GAS u32x4*)(kb + (size_t)i * 8) = o;
        return;
    }
    item -= DEF_T1;
    const float* dn = a.in[14]; const float* up = a.in[15]; const float* gf = a.in[11];
    unsigned char* wd = ws + WS_WD; unsigned char* wu = ws + WS_WU;
    const bool isup = item < DEF_T2; if (!isup) item -= DEF_T2;
    const float* src = (isup ? up : dn) + (size_t)(item * 32 + wave * 4) * DM + lane * 4;
    f32x4 g[4];
#pragma unroll
    for (int k = 0; k < 4; ++k) g[k] = isup ? (f32x4){6.0f, 6.0f, 6.0f, 6.0f} : *(const GAS f32x4*)(gf + k * 256 + lane * 4) * 64.0f;
    f32x4 v[4][4];
#pragma unroll
    for (int r = 0; r < 4; ++r)
#pragma unroll
        for (int k = 0; k < 4; ++k) v[r][k] = __builtin_nontemporal_load((const GAS f32x4*)(src + (size_t)r * DM + k * 256));
#pragma unroll
    for (int r = 0; r < 4; ++r) {
        const int e = item * 32 + wave * 4 + r;
#pragma unroll
        for (int k = 0; k < 4; ++k) {
            const f32x4 p = v[r][k] * g[k];
            unsigned w = __builtin_amdgcn_cvt_scalef32_pk_fp4_f32(0u, p.x, p.y, 1.0f, 0);
            w = __builtin_amdgcn_cvt_scalef32_pk_fp4_f32(w, p.z, p.w, 1.0f, 1);
            unsigned char* dst = isup ? wu + (size_t)e * 512 + k * 128 + lane * 2 : wd + (size_t)k * ((size_t)NEXP * 128) + (size_t)e * 128 + lane * 2;
            *(GAS unsigned short*)dst = (unsigned short)w;
        }
    }
}

__device__ __forceinline__ f32x4 bf4_lo(u32x4 w) { return (f32x4){__uint_as_float(w.x << 16), __uint_as_float(w.x & 0xffff0000u), __uint_as_float(w.y << 16), __uint_as_float(w.y & 0xffff0000u)}; }
__device__ __forceinline__ f32x4 bf4_hi(u32x4 w) { return (f32x4){__uint_as_float(w.z << 16), __uint_as_float(w.z & 0xffff0000u), __uint_as_float(w.w << 16), __uint_as_float(w.w & 0xffff0000u)}; }
struct EpiProj {
    static constexpr bool PERM = true, AFTER_DRAIN = false;
    bf16_t* P; const float* r1; const f32x4* rope; const float* decay;
    __device__ __forceinline__ void operator()(const f32x4 (&acc)[2][2][4][2], const pg8::Unit& u, int wr, int wc, int fr, int fq) const {
        const int row0 = u.pm * 256 + wr * 64 + fr, seg = u.pn >> 1;
        float rsv[2][4];
#pragma unroll
        for (int ai = 0; ai < 2; ++ai)
#pragma unroll
            for (int m = 0; m < 4; ++m) rsv[ai][m] = *(const GAS float*)(r1 + row0 + ai * 128 + m * 16);
        if (seg <= 1) {
#pragma unroll
            for (int ai = 0; ai < 2; ++ai) {
                f32x4 ra[4][2], rb[4][2]; float ff[4][2];
#pragma unroll
                for (int m = 0; m < 4; ++m)
#pragma unroll
                    for (int bj = 0; bj < 2; ++bj) {
                        const int row = row0 + ai * 128 + m * 16, c0 = u.pn * 256 + bj * 128 + wc * 32 + 8 * fq;
                        const int pos = row & (SEQ - 1), l = row & 127, head = (c0 & 511) >> 6, jb = (c0 & 63) >> 1;
                        const GAS f32x4* rp = (const GAS f32x4*)rope + ((size_t)pos * 32 + jb) / 2; ra[m][bj] = rp[0]; rb[m][bj] = rp[1];
                        ff[m][bj] = *(const GAS float*)(decay + (seg * 8 + head) * 128 + l);
                    }
#pragma unroll
                for (int m = 0; m < 4; ++m)
#pragma unroll
                    for (int bj = 0; bj < 2; ++bj) {
                        const int row = row0 + ai * 128 + m * 16, c0 = u.pn * 256 + bj * 128 + wc * 32 + 8 * fq;
                        const f32x4 v0 = acc[ai][bj][m][0] * rsv[ai][m], v1 = acc[ai][bj][m][1] * rsv[ai][m];
                        const f32x4 a_ = ra[m][bj], b_ = rb[m][bj]; const float f = ff[m][bj];
                        f32x4 w0, w1;
                        w0.x = (v0.x * a_.x - v0.y * a_.y) * f; w0.y = (v0.y * a_.x + v0.x * a_.y) * f;
                        w0.z = (v0.z * a_.z - v0.w * a_.w) * f; w0.w = (v0.w * a_.z + v0.z * a_.w) * f;
                        w1.x = (v1.x * b_.x - v1.y * b_.y) * f; w1.y = (v1.y * b_.x + v1.x * b_.y) * f;
                        w1.z = (v1.z * b_.z - v1.w * b_.w) * f; w1.w = (v1.w * b_.z + v1.z * b_.w) * f;
                        u32x4 w; w.x = pk2(w0.x, w0.y); w.y = pk2(w0.z, w0.w); w.z = pk2(w1.x, w1.y); w.w = pk2(w1.z, w1.w);
                        *(GAS u32x4*)(P + (size_t)row * NIN + c0) = w;
                    }
            }
        } else {
#pragma unroll
            for (int ai = 0; ai < 2; ++ai)
#pragma unroll
                for (int m = 0; m < 4; ++m)
#pragma unroll
                    for (int bj = 0; bj < 2; ++bj) {
                        const int row = row0 + ai * 128 + m * 16, c0 = u.pn * 256 + bj * 128 + wc * 32 + 8 * fq;
                        f32x4 v0 = acc[ai][bj][m][0] * rsv[ai][m], v1 = acc[ai][bj][m][1] * rsv[ai][m];
                        if (seg == 3) {
#pragma unroll
                            for (int j = 0; j < 4; ++j) { v0[j] = v0[j] / (1.0f + __expf(-v0[j])); v1[j] = v1[j] / (1.0f + __expf(-v1[j])); }
                        } else if (seg == 4) { v0 = v0 * (0.125f * LOG2E); v1 = v1 * (0.125f * LOG2E); }
                        u32x4 w; w.x = pk2(v0.x, v0.y); w.y = pk2(v0.z, v0.w); w.z = pk2(v1.x, v1.y); w.w = pk2(v1.z, v1.w);
                        *(GAS u32x4*)(P + (size_t)row * NIN + c0) = w;
                    }
        }
    }
};
struct EpiX1 {
    static constexpr bool PERM = true, AFTER_DRAIN = false;
    const bf16_t* XB; bf16_t* X1B; bf16_t* ssq;
    __device__ __forceinline__ void operator()(const f32x4 (&acc)[2][2][4][2], const pg8::Unit& u, int wr, int wc, int fr, int fq) const {
        const int row0 = u.pm * 256 + wr * 64 + fr, c00 = u.pn * 256 + wc * 32 + 8 * fq;
        u32x4 xin[2][4][2];
#pragma unroll
        for (int ai = 0; ai < 2; ++ai)
#pragma unroll
            for (int m = 0; m < 4; ++m)
#pragma unroll
                for (int bj = 0; bj < 2; ++bj) xin[ai][m][bj] = *(const GAS u32x4*)(XB + (size_t)(row0 + ai * 128 + m * 16) * DM + c00 + bj * 128);
#pragma unroll
        for (int ai = 0; ai < 2; ++ai)
#pragma unroll
            for (int m = 0; m < 4; ++m) {
                const int row = row0 + ai * 128 + m * 16; float ss = 0.f;
#pragma unroll
                for (int bj = 0; bj < 2; ++bj) {
                    const f32x4 o0 = acc[ai][bj][m][0] + bf4_lo(xin[ai][m][bj]), o1 = acc[ai][bj][m][1] + bf4_hi(xin[ai][m][bj]);
                    u32x4 w; w.x = pk2(o0.x, o0.y); w.y = pk2(o0.z, o0.w); w.z = pk2(o1.x, o1.y); w.w = pk2(o1.z, o1.w);
                    *(GAS u32x4*)(X1B + (size_t)row * DM + c00 + bj * 128) = w;
                    ss += ((o0.x * o0.x + o0.y * o0.y) + (o0.z * o0.z + o0.w * o0.w)) + ((o1.x * o1.x + o1.y * o1.y) + (o1.z * o1.z + o1.w * o1.w));
                }
                ss += __shfl_xor(ss, 16); ss += __shfl_xor(ss, 32);
                if (fq == 0) *(GAS bf16_t*)(ssq + (size_t)row * 16 + u.pn * 4 + wc) = (bf16_t)(pk2(ss, 0.f) & 0xffffu);
            }
    }
};
__device__ __forceinline__ float rs2_from(u32x4 a, u32x4 b) {
    const f32x4 p = bf4_lo(a) + bf4_hi(a) + bf4_lo(b) + bf4_hi(b);
    return 1.0f / sqrtf(((p.x + p.y) + (p.z + p.w)) * (1.0f / DM) + EPSF);
}
__device__ __forceinline__ float row_rs2(const bf16_t* ssq, int row) {
    const GAS u32x4* p = (const GAS u32x4*)(ssq + (size_t)row * 16); return rs2_from(p[0], p[1]);
}
struct EpiQ {
    static constexpr bool PERM = true, AFTER_DRAIN = false;
    bf16_t* Q; const bf16_t* ssq;
    __device__ __forceinline__ void operator()(const f32x4 (&acc)[2][2][4][2], const pg8::Unit& u, int wr, int wc, int fr, int fq) const {
        const int row0 = u.pm * 256 + wr * 64 + fr;
        u32x4 sa[2][4], sb[2][4];
#pragma unroll
        for (int ai = 0; ai < 2; ++ai)
#pragma unroll
            for (int m = 0; m < 4; ++m) { const GAS u32x4* p = (const GAS u32x4*)(ssq + (size_t)(row0 + ai * 128 + m * 16) * 16); sa[ai][m] = p[0]; sb[ai][m] = p[1]; }
#pragma unroll
        for (int ai = 0; ai < 2; ++ai)
#pragma unroll
            for (int m = 0; m < 4; ++m) {
                const int row = row0 + ai * 128 + m * 16; const float rs = rs2_from(sa[ai][m], sb[ai][m]);
#pragma unroll
                for (int bj = 0; bj < 2; ++bj) {
                    const int c0 = u.pn * 256 + bj * 128 + wc * 32 + 8 * fq;
                    const f32x4 v0 = acc[ai][bj][m][0] * rs, v1 = acc[ai][bj][m][1] * rs;
                    u32x4 w; w.x = pk2(v0.x, v0.y); w.y = pk2(v0.z, v0.w); w.z = pk2(v1.x, v1.y); w.w = pk2(v1.z, v1.w);
                    *(GAS u32x4*)(Q + (size_t)row * NQ + c0) = w;
                }
            }
    }
};

#define MFMA32(a, b, c) __builtin_amdgcn_mfma_f32_32x32x16_bf16(a, b, c, 0, 0, 0)
typedef short v4i16_t __attribute__((ext_vector_type(4)));
__device__ __forceinline__ s16x4 vtr(const lds_u8* p) { return __builtin_bit_cast(s16x4, __builtin_amdgcn_ds_read_tr16_b64_v4i16((LAS v4i16_t*)p)); }
__device__ __forceinline__ bf16x8 vfrag(const lds_u8* p) { const s16x4 lo = vtr(p), hi = vtr(p + 512); return (bf16x8){lo[0], lo[1], lo[2], lo[3], hi[0], hi[1], hi[2], hi[3]}; }
__device__ __forceinline__ bf16x8 ldsb128(const lds_u8* p) { return *(const LAS bf16x8*)p; }
__device__ __forceinline__ int crow(int r, int hi) { return (r & 3) + 8 * (r >> 2) + 4 * hi; }
__device__ __forceinline__ void glds16(const void* g, lds_u8* l) {
    unsigned sv; const unsigned lb = (unsigned)__builtin_amdgcn_readfirstlane((int)(unsigned)(uintptr_t)l);
    asm volatile("s_mov_b32 %0, m0\n\ts_mov_b32 m0, %2\n\ts_nop 0\n\tglobal_load_lds_dwordx4 %1, off\n\ts_mov_b32 m0, %0" : "=&s"(sv) : "v"(g), "s"(lb) : "memory");
}
__device__ __forceinline__ float swap_sum(float v) { auto rr = __builtin_amdgcn_permlane32_swap(__float_as_uint(v), __float_as_uint(v), false, false); return __uint_as_float(rr[0]) + __uint_as_float(rr[1]); }
__device__ __forceinline__ float swap_max(float v) { auto rr = __builtin_amdgcn_permlane32_swap(__float_as_uint(v), __float_as_uint(v), false, false); return __builtin_fmaxf(__uint_as_float(rr[0]), __uint_as_float(rr[1])); }

constexpr int ATT_SLOT = 32768, ATT_XCH = 65536, ATT_XPITCH = 528, ATT_BTAB = ATT_XCH + 128 * ATT_XPITCH;
static_assert(ATT_BTAB + 512 <= LDS_SCRATCH, "attention LDS");

template <int MODE>
__device__ __forceinline__ void attn_unit(const Args& a, lds_u8* lds, int b, int h, int qb) {
    int tid_ = threadIdx.x; asm volatile("" : "+v"(tid_));
    const int tid = tid_, lane = tid & 63, r32 = lane & 31, hi = lane >> 5; const int wid = __builtin_amdgcn_readfirstlane(tid >> 6);
    const int rgp = wid & 3, map = wid >> 2;
    const bf16_t* proj = (const bf16_t*)(a.ws + WS_PROJ);
    const size_t rowbase = (size_t)b * SEQ; const int q0 = qb * 128, NT = 2 * qb + 2;
    const float lam = ((const float*)(a.ws + WS_LAM))[0];
    if (tid < 128) ((LAS float*)(lds + ATT_BTAB))[tid] = ((const float*)(a.ws + WS_BTAB))[h * 128 + tid];
    bf16x8 qf[4];
    { const bf16_t* qp = proj + (rowbase + q0 + rgp * 32 + r32) * NIN + OFF_DQ + h * 128 + map * 64 + hi * 8;
#pragma unroll
      for (int s = 0; s < 4; ++s) qf[s] = *(const GAS bf16x8*)(qp + s * 16); }
    asm volatile("" : "+v"(qf[0]), "+v"(qf[1]), "+v"(qf[2]), "+v"(qf[3]));
    const int krow = 8 * wid + (lane >> 3);
    const bf16_t* k1src = proj + (rowbase + krow) * NIN + OFF_DK + h * 128 + ((lane & 7) ^ ((krow >> 1) & 7)) * 8;
    const bf16_t* k2src = k1src + 64;
    const bf16_t* vsrc0 = proj + (rowbase + 16 * ((2 * wid) & 3) + (lane >> 2)) * NIN + OFF_DV + h * 128 + 32 * ((2 * wid) >> 2) + (lane & 3) * 8;
    const bf16_t* vsrc1 = proj + (rowbase + 16 * ((2 * wid + 1) & 3) + (lane >> 2)) * NIN + OFF_DV + h * 128 + 32 * ((2 * wid + 1) >> 2) + (lane & 3) * 8;
#define ATT_DMA(t, slot) do { const size_t go = (size_t)(t) * 64 * NIN; lds_u8* sb = lds + (slot) * ATT_SLOT; \
        glds16(k1src + go, sb + wid * 1024); glds16(k2src + go, sb + 8192 + wid * 1024); \
        glds16(vsrc0 + go, sb + 16384 + (2 * wid) * 1024); glds16(vsrc1 + go, sb + 16384 + (2 * wid + 1) * 1024); } while (0)
    const int koff = map * 8192 + r32 * 128, ksw = (r32 >> 1) & 7;
    const int voff = 16384 + ((lane >> 4) & 1) * 32 + (lane & 3) * 8 + (4 * hi + ((lane & 15) >> 2)) * 64;
    f32x16 o[4];
#pragma unroll
    for (int d = 0; d < 4; ++d) o[d] = f32x16{};
    float mrun = 0.f, lrun = 0.f; bool shifted = false, farpend = !(176 > q0);
    const int qpos = q0 + rgp * 32 + r32;
    float b31 = ((const float*)(a.ws + WS_BTAB))[h * 128 + 127]; asm volatile("" : "+v"(b31));
    ATT_DMA(0, 0);
    for (int t = 0; t < NT; ++t) {
        if (!(MODE & 32) || t < 2) { VM_WAIT(); __syncthreads(); }
        if (t + 1 < NT && (!(MODE & 8) || t + 1 < 2)) ATT_DMA(t + 1, (t + 1) & 1);
        if (64 * t > q0 + rgp * 32 + 31) continue;
        const lds_u8* sb = lds + (t & 1) * ATT_SLOT;
        const bool nearT = (64 * t + 176 > q0);
        f32x16 sA = f32x16{}, sB = f32x16{};
        if (MODE & 1) {
            bf16x8 kf[8];
#pragma unroll
            for (int d0 = 0; d0 < 4; ++d0) { const int kc = koff + (((2 * d0 + hi) ^ ksw) << 4); if (MODE & 16) { kf[2 * d0] = qf[d0]; kf[2 * d0 + 1] = qf[3 - d0]; } else { kf[2 * d0] = ldsb128(sb + kc); kf[2 * d0 + 1] = ldsb128(sb + kc + 4096); } }
            __builtin_amdgcn_sched_group_barrier(0x100, 8, 0);
#pragma unroll
            for (int d0 = 0; d0 < 4; ++d0) { sA = MFMA32(kf[2 * d0], qf[d0], sA); sB = MFMA32(kf[2 * d0 + 1], qf[d0], sB); }
            __builtin_amdgcn_sched_group_barrier(0x8, 8, 0);
        }
        if (!(MODE & 1)) asm volatile("" : "+v"(sA), "+v"(sB));
        if (MODE & 4) {
        if (nearT) {
            if (farpend) { farpend = false; const float fb = __builtin_amdgcn_exp2f(b31); lrun *= fb;
#pragma unroll
                for (int d = 0; d < 4; ++d)
#pragma unroll
                    for (int r = 0; r < 16; ++r) o[d][r] *= fb; }
            const LAS float* bt = (const LAS float*)(lds + ATT_BTAB);
            float bA[16], bB[16];
#pragma unroll
            for (int r = 0; r < 16; ++r) { const int d0 = qpos - (64 * t + crow(r, hi)), d1 = d0 - 32;
                bA[r] = bt[d0 < 0 ? 0 : (d0 > 127 ? 127 : d0)]; bB[r] = bt[d1 < 0 ? 0 : (d1 > 127 ? 127 : d1)]; }
            asm volatile("" : "+v"(bA[0]), "+v"(bA[1]), "+v"(bA[2]), "+v"(bA[3]), "+v"(bA[4]), "+v"(bA[5]), "+v"(bA[6]), "+v"(bA[7]), "+v"(bA[8]), "+v"(bA[9]), "+v"(bA[10]), "+v"(bA[11]), "+v"(bA[12]), "+v"(bA[13]), "+v"(bA[14]), "+v"(bA[15]));
            asm volatile("" : "+v"(bB[0]), "+v"(bB[1]), "+v"(bB[2]), "+v"(bB[3]), "+v"(bB[4]), "+v"(bB[5]), "+v"(bB[6]), "+v"(bB[7]), "+v"(bB[8]), "+v"(bB[9]), "+v"(bB[10]), "+v"(bB[11]), "+v"(bB[12]), "+v"(bB[13]), "+v"(bB[14]), "+v"(bB[15]));
#pragma unroll
            for (int r = 0; r < 16; ++r) { const int d0 = qpos - (64 * t + crow(r, hi)), d1 = d0 - 32;
                sA[r] = d0 < 0 ? -INFINITY : sA[r] + bA[r]; sB[r] = d1 < 0 ? -INFINITY : sB[r] + bB[r]; }
        }
#define MX3(a_, b_, c_) __builtin_fmaxf(__builtin_fmaxf((a_), (b_)), (c_))
        float mxa = MX3(sA[0], sA[1], sB[0]), mxb = MX3(sA[2], sA[3], sB[1]); mxa = MX3(mxa, sB[2], sB[3]);
#pragma unroll
        for (int r = 4; r < 16; r += 4) { mxa = MX3(mxa, sA[r], sA[r + 1]); mxb = MX3(mxb, sA[r + 2], sA[r + 3]); mxa = MX3(mxa, sB[r], sB[r + 1]); mxb = MX3(mxb, sB[r + 2], sB[r + 3]); }
#undef MX3
        const float mx = swap_max(__builtin_fmaxf(mxa, mxb));
        if (shifted) {
#pragma unroll
            for (int r = 0; r < 16; ++r) { asm volatile("v_sub_f32 %0, %0, %1" : "+v"(sA[r]) : "v"(mrun)); asm volatile("v_sub_f32 %0, %0, %1" : "+v"(sB[r]) : "v"(mrun)); }
        }
        const float dmx = mx - mrun;
        if (__any(dmx > 64.0f) || (t == 0 && __any(dmx < -64.0f))) {
            const float up = (t == 0) ? ((dmx > 64.0f || dmx < -64.0f) ? dmx : 0.f) : __builtin_fmaxf(dmx - 32.0f, 0.f) * (dmx > 64.0f ? 1.0f : 0.f);
            const float alpha = (t == 0) ? 0.f : __builtin_amdgcn_exp2f(-up);
            mrun += up; lrun = (up != 0.f) ? lrun * alpha : lrun;
#pragma unroll
            for (int d = 0; d < 4; ++d)
#pragma unroll
                for (int r = 0; r < 16; ++r) o[d][r] = (up != 0.f) ? o[d][r] * alpha : o[d][r];
#pragma unroll
            for (int r = 0; r < 16; ++r) { asm volatile("v_sub_f32 %0, %0, %1" : "+v"(sA[r]) : "v"(up)); asm volatile("v_sub_f32 %0, %0, %1" : "+v"(sB[r]) : "v"(up)); }
            shifted = __any(mrun != 0.f);
        }
#pragma unroll
        for (int r = 0; r < 16; ++r) { if (MODE & 64) { sA[r] = sA[r] * 1.0009765625f; sB[r] = sB[r] * 1.0009765625f; } else { sA[r] = __builtin_amdgcn_exp2f(sA[r]); sB[r] = __builtin_amdgcn_exp2f(sB[r]); } }
#pragma unroll
        for (int r = 0; r < 16; ++r) { lrun += sA[r]; lrun += sB[r]; }
        } else { asm volatile("" : "+v"(sA), "+v"(sB)); }
        u32x4 pw[4];
        pw[0] = (u32x4){pk2(sA[0], sA[1]), pk2(sA[2], sA[3]), pk2(sA[4], sA[5]), pk2(sA[6], sA[7])};
        pw[1] = (u32x4){pk2(sA[8], sA[9]), pk2(sA[10], sA[11]), pk2(sA[12], sA[13]), pk2(sA[14], sA[15])};
        pw[2] = (u32x4){pk2(sB[0], sB[1]), pk2(sB[2], sB[3]), pk2(sB[4], sB[5]), pk2(sB[6], sB[7])};
        pw[3] = (u32x4){pk2(sB[8], sB[9]), pk2(sB[10], sB[11]), pk2(sB[12], sB[13]), pk2(sB[14], sB[15])};
        if (!(MODE & 2)) { asm volatile("" :: "v"(pw[0]), "v"(pw[1]), "v"(pw[2]), "v"(pw[3])); continue; }
        {
            bf16x8 vfa[4], vfb[4];
#pragma unroll
            for (int d = 0; d < 4; ++d) vfa[d] = (MODE & 16) ? qf[d] : vfrag(sb + voff + d * 4096);
            __builtin_amdgcn_sched_group_barrier(0x100, 8, 0);
#pragma unroll
            for (int ks = 0; ks < 4; ks += 2) {
#pragma unroll
                for (int d = 0; d < 4; ++d) vfb[d] = (MODE & 16) ? qf[3 - d] : vfrag(sb + voff + d * 4096 + (ks + 1) * 1024);
                __builtin_amdgcn_sched_group_barrier(0x100, 8, 0);
                { const bf16x8 pb = __builtin_bit_cast(bf16x8, pw[ks]);
#pragma unroll
                  for (int d = 0; d < 4; ++d) o[d] = MFMA32(vfa[d], pb, o[d]); }
                __builtin_amdgcn_sched_group_barrier(0x8, 4, 0);
                if (ks + 2 < 4) {
#pragma unroll
                    for (int d = 0; d < 4; ++d) vfa[d] = (MODE & 16) ? qf[d] : vfrag(sb + voff + d * 4096 + (ks + 2) * 1024);
                    __builtin_amdgcn_sched_group_barrier(0x100, 8, 0);
                }
                { const bf16x8 pb = __builtin_bit_cast(bf16x8, pw[ks + 1]);
#pragma unroll
                  for (int d = 0; d < 4; ++d) o[d] = MFMA32(vfb[d], pb, o[d]); }
                __builtin_amdgcn_sched_group_barrier(0x8, 4, 0);
            }
        }
    }
    const float inv = 1.0f / swap_sum(lrun);
    LAS float* xch = (LAS float*)(lds + ATT_XCH + (rgp * 32 + r32) * ATT_XPITCH);
    if (map == 1) {
        const float sc = inv * lam;
#pragma unroll
        for (int d = 0; d < 4; ++d)
#pragma unroll
            for (int g = 0; g < 4; ++g) *(LAS f32x4*)(xch + 32 * d + 8 * g + 4 * hi) = (f32x4){o[d][4 * g] * sc, o[d][4 * g + 1] * sc, o[d][4 * g + 2] * sc, o[d][4 * g + 3] * sc};
    }
    __syncthreads();
    if (map == 0) {
        float ss = 0.f;
#pragma unroll
        for (int d = 0; d < 4; ++d)
#pragma unroll
            for (int g = 0; g < 4; ++g) { const f32x4 o2 = *(const LAS f32x4*)(xch + 32 * d + 8 * g + 4 * hi);
#pragma unroll
                for (int j = 0; j < 4; ++j) { const float v = o[d][4 * g + j] * inv - o2[j]; o[d][4 * g + j] = v; ss += v * v; } }
        ss = swap_sum(ss);
        const float rn = 0.8f / sqrtf(ss * (1.0f / 128.0f) + EPSF);
        const float* sub = a.in[8];
        bf16_t* mixp = (bf16_t*)(a.ws + WS_MIX) + (rowbase + qpos) * DM + 512 + h * 128;
#pragma unroll
        for (int d = 0; d < 4; ++d)
#pragma unroll
            for (int g = 0; g < 4; ++g) { const int dd = 32 * d + 8 * g + 4 * hi; const f32x4 sv = *(const GAS f32x4*)(sub + dd);
                u32x2 w; w.x = pk2(o[d][4 * g] * rn * sv.x, o[d][4 * g + 1] * rn * sv.y); w.y = pk2(o[d][4 * g + 2] * rn * sv.z, o[d][4 * g + 3] * rn * sv.w);
                *(GAS u32x2*)(mixp + dd) = w; }
    }
    __syncthreads();
#undef ATT_DMA
}

constexpr int RET_BUF = 49152, RET_RT = 2 * RET_BUF, RET_GN = RET_RT + 8192;
static_assert(RET_GN + 2048 <= LDS_SCRATCH, "retention LDS");

__device__ __forceinline__ void ret_unit(const Args& a, lds_u8* lds, int b, int h) {
    int tid_ = threadIdx.x; asm volatile("" : "+v"(tid_));
    const int tid = tid_, lane = tid & 63, r32 = lane & 31, hi = lane >> 5; const int wid = __builtin_amdgcn_readfirstlane(tid >> 6);
    const int rgp = wid & 3, eh = wid >> 2;
    const bf16_t* proj = (const bf16_t*)(a.ws + WS_PROJ);
    const size_t rowbase = (size_t)b * SEQ;
    const double lg = log2(1.0 - exp2(-5.0 - (double)h));
    const float gam = (float)exp2(lg), g127 = (float)exp2(lg * 127.0), g128 = (float)exp2(lg * 128.0);
#define RET_DMA(c, buf) do { const size_t ro = (rowbase + (size_t)(c) * 128) * NIN; lds_u8* bb = lds + (buf) * RET_BUF; \
        _Pragma("unroll") for (int i_ = 0; i_ < 2; ++i_) { const int p_ = 2 * wid + i_; \
            { const int ch = p_ >> 1, rh = p_ & 1; glds16(proj + ro + (size_t)(rh * 64 + lane) * NIN + OFF_RK + h * 64 + ch * 8, bb + ch * 2048 + rh * 1024); } \
            { const int db = p_ >> 3, rg_ = p_ & 7; glds16(proj + ro + (size_t)(rg_ * 16 + (lane >> 2)) * NIN + OFF_RK + h * 64 + db * 32 + (lane & 3) * 8, bb + 16384 + db * 8192 + rg_ * 1024); \
              glds16(proj + ro + (size_t)(rg_ * 16 + (lane >> 2)) * NIN + OFF_RV + h * 64 + db * 32 + (lane & 3) * 8, bb + 32768 + db * 8192 + rg_ * 1024); } } } while (0)
    const int koff = hi * 2048 + r32 * 16;
    const int troff = ((lane >> 4) & 1) * 32 + (lane & 3) * 8 + (4 * hi + ((lane & 15) >> 2)) * 64;
    f32x16 R = f32x16{};
    for (int i = tid; i < 8192 / 16; i += NTHR) *(LAS u32x4*)(lds + RET_RT + i * 16) = (u32x4){0u, 0u, 0u, 0u};
    const float* gn = a.in[3];
    f32x4 gv[4];
#pragma unroll
    for (int g = 0; g < 4; ++g) gv[g] = *(const GAS f32x4*)(gn + h * 64 + eh * 32 + 8 * g + 4 * hi);
    bf16x8 qn[4]; u32x2 svn[4];
#define RET_PREF(c) do { const size_t tk_ = rowbase + (size_t)(c) * 128 + rgp * 32 + r32; const bf16_t* qp_ = proj + tk_ * NIN + OFF_RQ + h * 64 + hi * 8; const bf16_t* sg_ = proj + tk_ * NIN + OFF_RG + h * 64 + eh * 32 + 4 * hi; \
        _Pragma("unroll") for (int s = 0; s < 4; ++s) qn[s] = *(const GAS bf16x8*)(qp_ + s * 16); \
        _Pragma("unroll") for (int g = 0; g < 4; ++g) svn[g] = *(const GAS u32x2*)(sg_ + 8 * g); } while (0)
    RET_PREF(0);
    RET_DMA(0, 0);
    u32x2 wst[4]; bf16_t* wptr = nullptr;
#pragma unroll
    for (int g = 0; g < 4; ++g) wst[g] = (u32x2){0u, 0u};
    for (int c = 0; c < 32; ++c) {
        VM_WAIT(); __syncthreads();
        if (c > 0) {
#pragma unroll
            for (int g = 0; g < 4; ++g) *(GAS u32x2*)(wptr + 8 * g + 4 * hi) = wst[g];
        }
        bf16x8 qf[4]; u32x2 svc[4];
#pragma unroll
        for (int s = 0; s < 4; ++s) { qf[s] = qn[s]; svc[s] = svn[s]; }
        if (c + 1 < 32) { RET_PREF(c + 1); RET_DMA(c + 1, (c + 1) & 1); }
        const lds_u8* bb = lds + (c & 1) * RET_BUF;
        const size_t tok = rowbase + (size_t)c * 128 + rgp * 32 + r32;
        f32x16 O = f32x16{};
#pragma unroll
        for (int s = 0; s < 4; ++s) { const bf16x8 rt = ldsb128(lds + RET_RT + (2 * s + hi) * 1024 + (eh * 32 + r32) * 16); O = MFMA32(rt, qf[s], O); }
        for (int kb = 0; kb <= rgp; ++kb) {
            f32x16 S = f32x16{};
#pragma unroll
            for (int s = 0; s < 4; ++s) { const bf16x8 ka = ldsb128(bb + koff + s * 4096 + (kb * 32) * 16); S = MFMA32(ka, qf[s], S); }
            if (kb == rgp) {
#pragma unroll
                for (int r = 0; r < 16; ++r) S[r] = (crow(r, hi) > r32) ? 0.f : S[r];
            }
            const u32x4 p0 = (u32x4){pk2(S[0], S[1]), pk2(S[2], S[3]), pk2(S[4], S[5]), pk2(S[6], S[7])};
            const u32x4 p1 = (u32x4){pk2(S[8], S[9]), pk2(S[10], S[11]), pk2(S[12], S[13]), pk2(S[14], S[15])};
            const bf16x8 v0 = vfrag(bb + 32768 + eh * 8192 + troff + (2 * kb) * 1024), v1 = vfrag(bb + 32768 + eh * 8192 + troff + (2 * kb + 1) * 1024);
            O = MFMA32(v0, __builtin_bit_cast(bf16x8, p0), O); O = MFMA32(v1, __builtin_bit_cast(bf16x8, p1), O);
        }
        if (rgp < 2) {
            f32x16 T = f32x16{};
#pragma unroll
            for (int ks = 0; ks < 8; ++ks) { const bf16x8 kt = vfrag(bb + 16384 + rgp * 8192 + troff + ks * 1024), vv = vfrag(bb + 32768 + eh * 8192 + troff + ks * 1024); T = MFMA32(kt, vv, T); }
#pragma unroll
            for (int r = 0; r < 16; ++r) R[r] = R[r] * g128 + T[r] * g127;
        }
        float s1 = 0.f, s2 = 0.f;
#pragma unroll
        for (int r = 0; r < 16; ++r) { s1 += O[r]; s2 += O[r] * O[r]; }
        s1 = swap_sum(s1); s2 = swap_sum(s2);
        LAS f32x2* gx = (LAS f32x2*)(lds + RET_GN);
        if (hi == 0) gx[(rgp * 32 + r32) * 2 + eh] = (f32x2){s1, s2};
        __syncthreads();
        if (rgp < 2) {
#pragma unroll
            for (int g = 0; g < 4; ++g) { u32x2 w; w.x = pk2(R[4 * g] * gam, R[4 * g + 1] * gam); w.y = pk2(R[4 * g + 2] * gam, R[4 * g + 3] * gam);
                *(LAS u32x2*)(lds + RET_RT + (rgp * 4 + g) * 1024 + (eh * 32 + r32) * 16 + hi * 8) = w; }
        }
        const f32x2 ga = gx[(rgp * 32 + r32) * 2], gb = gx[(rgp * 32 + r32) * 2 + 1];
        const float mean = (ga.x + gb.x) * (1.0f / 64.0f), var = (ga.y + gb.y) * (1.0f / 64.0f) - mean * mean;
        const float rstd = 1.0f / sqrtf(__builtin_fmaxf(var, 0.f) + EPSF);
        bf16_t* mixp = (bf16_t*)(a.ws + WS_MIX) + tok * DM + h * 64 + eh * 32;
#pragma unroll
        for (int g = 0; g < 4; ++g) { const int e = 8 * g + 4 * hi; const u32x2 sv = svc[g];
            const float y0 = (O[4 * g] - mean) * rstd * gv[g].x * __uint_as_float(sv.x << 16), y1 = (O[4 * g + 1] - mean) * rstd * gv[g].y * __uint_as_float(sv.x & 0xffff0000u);
            const float y2 = (O[4 * g + 2] - mean) * rstd * gv[g].z * __uint_as_float(sv.y << 16), y3 = (O[4 * g + 3] - mean) * rstd * gv[g].w * __uint_as_float(sv.y & 0xffff0000u);
            wst[g].x = pk2(y0, y1); wst[g].y = pk2(y2, y3); }
        wptr = mixp;
    }
#pragma unroll
    for (int g = 0; g < 4; ++g) *(GAS u32x2*)(wptr + 8 * g + 4 * hi) = wst[g];
    __syncthreads();
#undef RET_DMA
#undef RET_PREF
}


#define CAS_DESC(x, y) do { const float hi_ = __builtin_fmaxf(x, y), lo_ = __builtin_fminf(x, y); x = hi_; y = lo_; } while (0)
#define CAS_ASC(x, y) do { const float hi_ = __builtin_fmaxf(x, y), lo_ = __builtin_fminf(x, y); x = lo_; y = hi_; } while (0)
__device__ __forceinline__ void sort16_desc(float (&v)[16]) {
#pragma unroll
    for (int k = 2; k <= 16; k <<= 1)
#pragma unroll
        for (int j = k >> 1; j > 0; j >>= 1)
#pragma unroll
            for (int i = 0; i < 16; ++i) { const int l = i ^ j; if (l > i) { if ((i & k) == 0) CAS_DESC(v[i], v[l]); else CAS_ASC(v[i], v[l]); } }
}
__device__ __forceinline__ void bitonic_merge16_desc(float (&v)[16]) {
#pragma unroll
    for (int j = 8; j > 0; j >>= 1)
#pragma unroll
        for (int i = 0; i < 16; ++i) { const int l = i ^ j; if (l > i) CAS_DESC(v[i], v[l]); }
}
__device__ __forceinline__ void merge_top16(float (&a)[16], const float (&b)[16]) {
#pragma unroll
    for (int i = 0; i < 16; ++i) a[i] = __builtin_fmaxf(a[i], b[15 - i]);
    bitonic_merge16_desc(a);
}
__device__ __forceinline__ unsigned pack_idx4(const float (&v)[16], int w) {
    return (__float_as_uint(v[4 * w]) & 127u) | ((__float_as_uint(v[4 * w + 1]) & 127u) << 8) | ((__float_as_uint(v[4 * w + 2]) & 127u) << 16) | ((__float_as_uint(v[4 * w + 3]) & 127u) << 24);
}
__device__ __forceinline__ unsigned lookup_idx(const unsigned (&pk)[4], unsigned i) {
    const unsigned w = i >> 2; unsigned s = w == 0 ? pk[0] : (w == 1 ? pk[1] : (w == 2 ? pk[2] : pk[3]));
    return (s >> ((i & 3u) * 8u)) & 127u;
}

constexpr int P5_KEYB = 32768;
__device__ __forceinline__ void p5_topk(const Args& a, lds_u8* lds) {
    const int tid = threadIdx.x, lane = tid & 63, r32 = lane & 31, hi = lane >> 5; const int wid = __builtin_amdgcn_readfirstlane(tid >> 6);
    const int hp = blockIdx.x & 3, wgi = blockIdx.x >> 2, nwg = (gridDim.x + 3 - hp) / 4;
    const bf16_t* keys = (const bf16_t*)(a.ws + WS_KEYS) + (size_t)hp * 4 * 128 * 128;
    {
        static_assert(4 * 128 * 16 == 16 * NTHR, "key image copy");
        u32x4 kv[16];
#pragma unroll
        for (int j = 0; j < 16; ++j) { const int i = tid + j * NTHR, t = i >> 11, key = (i >> 4) & 127, c = i & 15; kv[j] = *(const GAS u32x4*)(keys + ((size_t)t * 128 + key) * 128 + c * 8); }
#pragma unroll
        for (int j = 0; j < 16; ++j) { const int i = tid + j * NTHR, t = i >> 11, key = (i >> 4) & 127, c = i & 15; *(LAS u32x4*)(lds + t * P5_KEYB + c * 2048 + key * 16) = kv[j]; }
    }
    __syncthreads();
    const bf16_t* Q = (const bf16_t*)(a.ws + WS_PROJ);
    int* IDX = (int*)(a.ws + WS_IDX); float* GATE = (float*)(a.ws + WS_GATE);
    const int tg0 = wgi * NWAVES + wid, tgs = nwg * NWAVES;
    const int ntask = (tg0 < MTOK / 32) ? 4 * ((MTOK / 32 - 1 - tg0) / tgs + 1) : 0;
#define P5_QLOAD(QF, k_) do { const int tg_ = tg0 + ((k_) >> 2) * tgs, t_ = (k_) & 3; \
        const bf16_t* qp = Q + (size_t)(tg_ * 32 + r32) * NQ + (2 * hp + (t_ >> 1)) * 256 + (t_ & 1) * 128 + hi * 8; \
        _Pragma("unroll") for (int s = 0; s < 8; ++s) QF[s] = *(const GAS bf16x8*)(qp + s * 16); } while (0)
    float la[16], lb[16];
#pragma unroll
    for (int r = 0; r < 16; ++r) { la[r] = 0.f; lb[r] = 0.f; }
    bf16x8 qf[8], qn[8];
    if (ntask > 0) P5_QLOAD(qf, 0);
#pragma unroll 1
    for (int k = 0; k < ntask; ++k) {
      {
        const int tg = tg0 + (k >> 2) * tgs, t = k & 3;
        P5_QLOAD(qn, (k + 1 < ntask ? k + 1 : k));
        {
            float top[16];
#pragma unroll
            for (int kb = 0; kb < 4; ++kb) {
                f32x16 S = f32x16{};
#pragma unroll
                for (int s = 0; s < 8; ++s) { const bf16x8 kf = ldsb128(lds + t * P5_KEYB + (2 * s + hi) * 2048 + (kb * 32 + r32) * 16); S = MFMA32(kf, qf[s], S); }
                float v[16];
#pragma unroll
                for (int r = 0; r < 16; ++r) v[r] = __uint_as_float((__float_as_uint(S[r]) & ~127u) | (unsigned)(kb * 32 + (r & 3) + 8 * (r >> 2)) | ((unsigned)hi << 2));
                sort16_desc(v);
                if (kb == 0) {
#pragma unroll
                    for (int r = 0; r < 16; ++r) top[r] = v[r];
                } else merge_top16(top, v);
            }
            float oth[16];
#pragma unroll
            for (int r = 0; r < 16; ++r) { auto rr = __builtin_amdgcn_permlane32_swap(__float_as_uint(top[r]), __float_as_uint(top[r]), false, false); top[r] = __uint_as_float(rr[0]); oth[r] = __uint_as_float(rr[1]); }
            merge_top16(top, oth);
            const bool ka = ((t >> 1) == hi) && ((t & 1) == 0), kb2 = ((t >> 1) == hi) && ((t & 1) == 1);
#pragma unroll
            for (int r = 0; r < 16; ++r) { la[r] = ka ? top[r] : la[r]; lb[r] = kb2 ? top[r] : lb[r]; }
        }
#pragma unroll
        for (int s2 = 0; s2 < 8; ++s2) qf[s2] = qn[s2];
        if (t != 3) continue;
        unsigned pa[4], pb[4];
#pragma unroll
        for (int w = 0; w < 4; ++w) { pa[w] = pack_idx4(la, w); pb[w] = pack_idx4(lb, w); }
        float c0[16], c1[16];
#define CAND(i, j) __uint_as_float((__float_as_uint(la[i] + lb[j]) & ~255u) | (unsigned)((i) * 16 + (j)))
        const float NEG = -INFINITY;
        c0[0] = CAND(0, 0); c0[1] = CAND(0, 1); c0[2] = CAND(0, 2); c0[3] = CAND(0, 3); c0[4] = CAND(0, 4); c0[5] = CAND(0, 5); c0[6] = CAND(0, 6); c0[7] = CAND(0, 7);
        c0[8] = CAND(0, 8); c0[9] = CAND(0, 9); c0[10] = CAND(0, 10); c0[11] = CAND(0, 11); c0[12] = CAND(0, 12); c0[13] = CAND(0, 13); c0[14] = CAND(0, 14); c0[15] = CAND(0, 15);
        sort16_desc(c0);
        c1[0] = CAND(1, 0); c1[1] = CAND(1, 1); c1[2] = CAND(1, 2); c1[3] = CAND(1, 3); c1[4] = CAND(1, 4); c1[5] = CAND(1, 5); c1[6] = CAND(1, 6); c1[7] = CAND(1, 7);
        c1[8] = CAND(2, 0); c1[9] = CAND(2, 1); c1[10] = CAND(2, 2); c1[11] = CAND(2, 3); c1[12] = CAND(2, 4); c1[13] = CAND(3, 0); c1[14] = CAND(3, 1); c1[15] = CAND(3, 2);
        sort16_desc(c1); merge_top16(c0, c1);
        asm volatile("" : "+v"(c0[0]), "+v"(c0[15]));
        c1[0] = CAND(3, 3); c1[1] = CAND(4, 0); c1[2] = CAND(4, 1); c1[3] = CAND(4, 2); c1[4] = CAND(5, 0); c1[5] = CAND(5, 1); c1[6] = CAND(6, 0); c1[7] = CAND(6, 1);
        c1[8] = CAND(7, 0); c1[9] = CAND(7, 1); c1[10] = CAND(8, 0); c1[11] = CAND(9, 0); c1[12] = CAND(10, 0); c1[13] = CAND(11, 0); c1[14] = CAND(12, 0); c1[15] = CAND(13, 0);
        sort16_desc(c1); merge_top16(c0, c1);
        asm volatile("" : "+v"(c0[0]), "+v"(c0[15]));
        c1[0] = CAND(14, 0); c1[1] = CAND(15, 0);
#pragma unroll
        for (int r = 2; r < 16; ++r) c1[r] = NEG;
#undef CAND
        sort16_desc(c1); merge_top16(c0, c1);
        float gsum = 0.f, gv[16]; int ex[16];
        const float mx = __uint_as_float(__float_as_uint(c0[0]) & ~255u);
#pragma unroll
        for (int r = 0; r < 16; ++r) { const unsigned bits = __float_as_uint(c0[r]); const float val = __uint_as_float(bits & ~255u);
            gv[r] = __expf(val - mx); gsum += gv[r];
            ex[r] = (int)(lookup_idx(pa, (bits >> 4) & 15u) * 128u + lookup_idx(pb, bits & 15u)); }
        const float ginv = 1.0f / gsum;
        const size_t ob = (size_t)(tg * 32 + r32) * 128 + (2 * hp + hi) * 16;
#pragma unroll
        for (int r = 0; r < 16; r += 4) { *(GAS u32x4*)(IDX + ob + r) = (u32x4){(unsigned)ex[r], (unsigned)ex[r + 1], (unsigned)ex[r + 2], (unsigned)ex[r + 3]};
            *(GAS f32x4*)(GATE + ob + r) = (f32x4){gv[r] * ginv, gv[r + 1] * ginv, gv[r + 2] * ginv, gv[r + 3] * ginv}; }
      }
    }
#undef P5_QLOAD
    __syncthreads();
}

typedef long i64_t;
typedef int v8i_t __attribute__((ext_vector_type(8)));
#define MFMA16F8(a, b, c) __builtin_amdgcn_mfma_f32_16x16x32_fp8_fp8(a, b, c, 0, 0, 0)
constexpr float P6_SD = 64.f, P6_SX = 8.f, P6_SU = 16.f, P6_SA = 64.f, P6_SU4 = 6.f;
constexpr size_t P6_SLICEB = (size_t)NEXP * 128;
__device__ __forceinline__ unsigned pk4_fp8(float a, float b, float c, float d) { int w = __builtin_amdgcn_cvt_pk_fp8_f32(a, b, 0, false); w = __builtin_amdgcn_cvt_pk_fp8_f32(c, d, w, true); return (unsigned)w; }
__device__ __forceinline__ float fp8_byte0(unsigned w) { return __builtin_amdgcn_cvt_f32_fp8((int)w, 0); }
constexpr int P6_WSCR = 3328;
__device__ __forceinline__ void p6_token(const Args& a, lds_u8* wl, int tok, int lane, float* OUTW) {
    const int n = lane & 15, g = lane >> 4;
    const unsigned char* ws = a.ws;
    const unsigned char* WD = ws + WS_WD; const unsigned char* WU = ws + WS_WU;
    const int* IDX = (const int*)(ws + WS_IDX) + (size_t)tok * 128; const float* GATE = (const float*)(ws + WS_GATE) + (size_t)tok * 128;
    const bf16_t* X1 = (const bf16_t*)(ws + WS_X1B) + (size_t)tok * DM;
    {
#pragma unroll
        for (int j = 0; j < 4; ++j) {
            const u32x2 xw_ = *(const GAS u32x2*)(X1 + 256 * j + 4 * lane); const f32x4 v = (f32x4){__uint_as_float(xw_.x << 16), __uint_as_float(xw_.x & 0xffff0000u), __uint_as_float(xw_.y << 16), __uint_as_float(xw_.y & 0xffff0000u)} * P6_SX;
            const unsigned hw = pk4_fp8(v.x, v.y, v.z, v.w);
            const float r0 = v.x - __builtin_amdgcn_cvt_f32_fp8((int)hw, 0), r1 = v.y - __builtin_amdgcn_cvt_f32_fp8((int)hw, 1), r2 = v.z - __builtin_amdgcn_cvt_f32_fp8((int)hw, 2), r3 = v.w - __builtin_amdgcn_cvt_f32_fp8((int)hw, 3);
            const unsigned lw = pk4_fp8(r0 * 16.f, r1 * 16.f, r2 * 16.f, r3 * 16.f);
            *(LAS unsigned*)(wl + 256 * j + 4 * lane) = hw; *(LAS unsigned*)(wl + 1024 + 256 * j + 4 * lane) = lw;
        }
        const u32x2 iv = *(const GAS u32x2*)(IDX + lane * 2); *(LAS u32x2*)(wl + 2048 + lane * 8) = iv;
    }
    const float rs2 = row_rs2((const bf16_t*)(ws + WS_SSQ), tok);
    LDS_WAIT();
    const LAS int* idxl = (const LAS int*)(wl + 2048); LAS unsigned short* actl = (LAS unsigned short*)(wl + 2560);
    const int xoff = (n & 1) * 1024 + 16 * g;
#pragma unroll 1
    for (int eg = 0; eg < 8; ++eg) {
        const int e = idxl[eg * 16 + n];
        const unsigned char* rp = WD + (size_t)e * 128 + 16 * g;
        f32x4 acc = (f32x4){0.f, 0.f, 0.f, 0.f};
        u32x4 bq[16];
#pragma unroll
        for (int sl = 0; sl < 8; ++sl) { bq[2 * sl] = *(const GAS u32x4*)(rp + sl * P6_SLICEB); bq[2 * sl + 1] = *(const GAS u32x4*)(rp + sl * P6_SLICEB + 64); }
#pragma unroll
        for (int sl = 0; sl < 8; ++sl)
#pragma unroll
            for (int hf = 0; hf < 2; ++hf) {
                const u32x4 xa = *(const LAS u32x4*)(wl + xoff + sl * 128 + hf * 64); const u32x4 bb = bq[2 * sl + hf];
                acc = MFMA16F8((i64_t)(((unsigned long long)xa.y << 32) | xa.x), (i64_t)(((unsigned long long)bb.y << 32) | bb.x), acc);
                acc = MFMA16F8((i64_t)(((unsigned long long)xa.w << 32) | xa.z), (i64_t)(((unsigned long long)bb.w << 32) | bb.z), acc);
            }
        const float av = (acc[0] + acc[1] * 0.0625f) * (rs2 * (1.0f / (P6_SD * P6_SX)));
        const float act = 0.5f * av * (1.0f + erff(av * 0.70710678118654752f)) * GATE[eg * 16 + n] * P6_SA;
        const unsigned hb = pk4_fp8(act, 0.f, 0.f, 0.f) & 0xffu;
        const unsigned lb = pk4_fp8((act - fp8_byte0(hb)) * 16.f, 0.f, 0.f, 0.f) & 0xffu;
        if (g == 0) actl[eg * 16 + n] = (unsigned short)(hb | (lb << 8));
    }
    LDS_WAIT();
    const int pos = n & 7, sel = n >> 3;
    float ss = 0.f;
    const bool owner = (n < 8) && (g < 2);
#pragma unroll 1
    for (int sl = 0; sl < 8; ++sl) {
        f32x4 ah[2], al[2];
#pragma unroll
        for (int s = 0; s < 2; ++s) { ah[s] = (f32x4){0.f, 0.f, 0.f, 0.f}; al[s] = (f32x4){0.f, 0.f, 0.f, 0.f}; }
        u32x4 bq[16]; unsigned av[16];
#pragma unroll
        for (int q = 0; q < 16; ++q) { const int ei = 8 * q + 4 * sel + g; const int e = idxl[ei]; av[q] = actl[ei];
            bq[q] = *(const GAS u32x4*)(WU + sl * P6_SLICEB + (size_t)e * 128 + 16 * pos); }
#pragma unroll
        for (int q = 0; q < 16; ++q) {
            const unsigned long long ahv = (unsigned long long)(av[q] & 0xffu) << (8 * pos), alv = (unsigned long long)(av[q] >> 8) << (8 * pos);
            const u32x4 bb = bq[q];
            const i64_t b0 = (i64_t)(((unsigned long long)bb.y << 32) | bb.x), b1 = (i64_t)(((unsigned long long)bb.w << 32) | bb.z);
            ah[0] = MFMA16F8((i64_t)ahv, b0, ah[0]); al[0] = MFMA16F8((i64_t)alv, b0, al[0]);
            ah[1] = MFMA16F8((i64_t)ahv, b1, ah[1]); al[1] = MFMA16F8((i64_t)alv, b1, al[1]);
        }
#pragma unroll
        for (int s = 0; s < 2; ++s) {
            f32x4 t = ah[s] + al[s] * 0.0625f, u;
#pragma unroll
            for (int r = 0; r < 4; ++r) u[r] = __shfl(t[r], (lane + 40) & 63);
            const int col = 128 * sl + 16 * pos + 8 * s + 4 * (g & 1);
            const u32x2 xq_ = *(const GAS u32x2*)(X1 + col); const f32x4 xv = (f32x4){__uint_as_float(xq_.x << 16), __uint_as_float(xq_.x & 0xffff0000u), __uint_as_float(xq_.y << 16), __uint_as_float(xq_.y & 0xffff0000u)};
            const f32x4 x2 = xv + (t + u) * (1.0f / (P6_SA * P6_SU));
            if (owner) { ss += (x2.x * x2.x + x2.y * x2.y) + (x2.z * x2.z + x2.w * x2.w); *(GAS f32x4*)(OUTW + (size_t)tok * DM + col) = x2; }
        }
    }
    ss = wave_sum(ss);
    const float rn = 1.0f / sqrtf(ss * (1.0f / DM) + EPSF);
    const float* nf = a.in[16];
    if (owner) {
#pragma unroll
        for (int sl = 0; sl < 8; ++sl)
#pragma unroll
            for (int s = 0; s < 2; ++s) { const int col = 128 * sl + 16 * pos + 8 * s + 4 * g; const f32x4 gv = *(const GAS f32x4*)(nf + col);
                GAS f32x4* op = (GAS f32x4*)(OUTW + (size_t)tok * DM + col); *op = *op * rn * gv; }
    }
}

constexpr int P6S_WAVE = 16384 + 512 + 128;
static_assert(NWAVES * P6S_WAVE <= LDS_SCRATCH, "P6 LDS");
__device__ __forceinline__ float gelu_as(float v) {
    const float av = __builtin_fabsf(v), t = __builtin_amdgcn_rcpf(av * 0.2316418882f + 1.0f);
    float q = t * 0.5307027145f + (-0.7265760135f); q = q * t + 0.7107068705f; q = q * t + (-0.142248368f); q = q * t + 0.127414796f; q = q * t;
    const float e = __builtin_amdgcn_exp2f((v * v) * (-0.72134752044f));
    const float m = v * (q * e);
    return v < 0.f ? m : v - m;
}
template <int EMASK, int PARTS>
__device__ __forceinline__ void p6_slices(const Args& a, lds_u8* wl, int tok0, int lane) {
    const int n = lane & 15, g = lane >> 4;
    const unsigned char* ws = a.ws;
    const unsigned char* WD = ws + WS_WD; const unsigned char* WU = ws + WS_WU;
    LAS float* aacc = (LAS float*)wl; LAS unsigned short* idl = (LAS unsigned short*)(wl + 8192); LAS unsigned short* actl = (LAS unsigned short*)(wl + 12288);
    lds_u8* xs = wl + 16384; LAS float* ssl = (LAS float*)(wl + 16384 + 512); LAS float* r2l = ssl + 16;
    {
        u32x2 iv[16];
#pragma unroll
        for (int t = 0; t < 16; ++t) iv[t] = *(const GAS u32x2*)((const int*)(ws + WS_IDX) + (size_t)(tok0 + t) * 128 + lane * 2);
#pragma unroll
        for (int t = 0; t < 16; ++t) {
            *(LAS unsigned*)(wl + 8192 + t * 256 + lane * 4) = (iv[t].x & 0xffffu) | (iv[t].y << 16);
            *(LAS f32x2*)(wl + t * 512 + lane * 8) = (f32x2){0.f, 0.f};
        }
    }
    if (lane < 16) { ssl[lane] = 0.f; r2l[lane] = row_rs2((const bf16_t*)(ws + WS_SSQ), tok0 + lane); }
    unsigned char* X4 = (unsigned char*)a.ws + WS_XB;
#pragma unroll 1
    for (int t8 = 0; t8 < 16; t8 += 8) {
    u32x4 xwa[8], xwb[8];
#pragma unroll
    for (int tt = 0; tt < 8; ++tt) { const bf16_t* xr = (const bf16_t*)(ws + WS_X1B) + (size_t)(tok0 + t8 + tt) * DM + 16 * lane; xwa[tt] = *(const GAS u32x4*)xr; xwb[tt] = *(const GAS u32x4*)(xr + 8); }
#pragma unroll
    for (int tt = 0; tt < 8; ++tt) {
        const int t = t8 + tt;
        const u32x4 xw0 = xwa[tt], xw1 = xwb[tt];
        float rr[16];
#pragma unroll
        for (int j = 0; j < 4; ++j) { rr[2 * j] = __uint_as_float(xw0[j] << 16); rr[2 * j + 1] = __uint_as_float(xw0[j] & 0xffff0000u); rr[8 + 2 * j] = __uint_as_float(xw1[j] << 16); rr[9 + 2 * j] = __uint_as_float(xw1[j] & 0xffff0000u); }
#pragma unroll
        for (int st = 0; st < 4; ++st) {
            unsigned w0 = 0u, w1 = 0u;
#define P6_Q4(p_) do { w0 = __builtin_amdgcn_cvt_scalef32_pk_fp4_f32(w0, rr[2 * (p_)], rr[2 * (p_) + 1], 1.0f, p_); w1 = __builtin_amdgcn_cvt_scalef32_pk_fp4_f32(w1, rr[8 + 2 * (p_)], rr[9 + 2 * (p_)], 1.0f, p_); } while (0)
            P6_Q4(0); P6_Q4(1); P6_Q4(2); P6_Q4(3);
#undef P6_Q4
#define P6_D4(p_) do { const f32x2 d0 = __builtin_amdgcn_cvt_scalef32_pk_f32_fp4(w0, 1.0f, p_), d1 = __builtin_amdgcn_cvt_scalef32_pk_f32_fp4(w1, 1.0f, p_); \
                rr[2 * (p_)] = (rr[2 * (p_)] - d0.x) * 4.0f; rr[2 * (p_) + 1] = (rr[2 * (p_) + 1] - d0.y) * 4.0f; rr[8 + 2 * (p_)] = (rr[8 + 2 * (p_)] - d1.x) * 4.0f; rr[9 + 2 * (p_)] = (rr[9 + 2 * (p_)] - d1.y) * 4.0f; } while (0)
            P6_D4(0); P6_D4(1); P6_D4(2); P6_D4(3);
#undef P6_D4
            *(GAS u32x2*)(X4 + (size_t)(tok0 + t) * 2048 + st * 512 + 8 * lane) = (u32x2){w0, w1};
        }
    }
    }
    LDS_WAIT(); VM_WAIT();
    const int xoff = (n & 3) * 128 + 16 * g;
    const int bpa = 4 * (4 * (lane & 15) + (lane >> 4));
#define MFMA4(a_, b_, c_) __builtin_amdgcn_mfma_scale_f32_16x16x128_f8f6f4(a_, b_, c_, 4  , 4  , 0, 0, 0, 0)
#define P6_DLOAD(BQ, XV, it_) do { const int sl_ = (it_) >> 4, t_ = (it_) & 15; \
        _Pragma("unroll") for (int eg = 0; eg < 8; ++eg) { const int e_ = idl[t_ * 128 + eg * 16 + (lane >> 2)] & EMASK; const unsigned char* rp_ = WD + sl_ * P6_SLICEB + (size_t)e_ * 128 + 16 * (lane & 3); \
            BQ[2 * eg] = *(const GAS u32x4*)rp_; BQ[2 * eg + 1] = *(const GAS u32x4*)(rp_ + 64); } \
        XV = *(const GAS u32x2*)(X4 + (size_t)(tok0 + t_) * 2048 + (lane >> 4) * 512 + sl_ * 128 + 8 * (lane & 15)); } while (0)
#define P6_DCOMP(BQ, XV, it_) do { const int t_ = (it_) & 15; \
        *(LAS u32x2*)(xs + (lane >> 4) * 128 + 8 * (lane & 15)) = XV; \
        LDS_WAIT(); \
        const u32x4 xa0 = *(const LAS u32x4*)(xs + xoff), xa1 = *(const LAS u32x4*)(xs + xoff + 64); \
        const v8i_t A0 = (v8i_t){(int)xa0.x, (int)xa0.y, (int)xa0.z, (int)xa0.w, 0, 0, 0, 0}; \
        const v8i_t A1 = (v8i_t){(int)xa1.x, (int)xa1.y, (int)xa1.z, (int)xa1.w, 0, 0, 0, 0}; \
        _Pragma("unroll") for (int eg = 0; eg < 8; ++eg) { f32x4 acc = (f32x4){0.f, 0.f, 0.f, 0.f}; v8i_t b0 = (v8i_t){0, 0, 0, 0, 0, 0, 0, 0}, b1 = (v8i_t){0, 0, 0, 0, 0, 0, 0, 0}; \
            _Pragma("unroll") for (int w_ = 0; w_ < 4; ++w_) { b0[w_] = __builtin_amdgcn_ds_bpermute(bpa, (int)BQ[2 * eg][w_]); b1[w_] = __builtin_amdgcn_ds_bpermute(bpa, (int)BQ[2 * eg + 1][w_]); } \
            acc = MFMA4(A0, b0, acc); acc = MFMA4(A1, b1, acc); \
            float r_ = (acc[0] + acc[1] * 0.25f) + (acc[2] * 0.0625f + acc[3] * 0.015625f); asm volatile("" : "+v"(r_)); \
            if (g == 0) aacc[t_ * 128 + eg * 16 + n] += r_; } \
        LDS_WAIT(); } while (0)
    if (PARTS & 1) {
        u32x4 bqA[16], bqB[16]; u32x2 xvA, xvB;
        P6_DLOAD(bqA, xvA, 0);
#pragma unroll 1
        for (int it = 0; it < 64; it += 2) {
            P6_DLOAD(bqB, xvB, it + 1);
            P6_DCOMP(bqA, xvA, it);
            P6_DLOAD(bqA, xvA, (it + 2 < 64 ? it + 2 : it));
            P6_DCOMP(bqB, xvB, it + 1);
        }
    }
#undef MFMA4
#undef P6_DLOAD
#undef P6_DCOMP
    int lane_g = lane; asm volatile("" : "+v"(lane_g));
    float gts[16][2];
#pragma unroll
    for (int t = 0; t < 16; ++t) { gts[t][0] = ((const float*)(ws + WS_GATE))[(size_t)(tok0 + t) * 128 + lane_g]; gts[t][1] = ((const float*)(ws + WS_GATE))[(size_t)(tok0 + t) * 128 + lane_g + 64]; }
#pragma unroll
    for (int t = 0; t < 16; ++t) {
        const float sc = r2l[t] * (1.0f / P6_SD);
#pragma unroll
        for (int j = 0; j < 2; ++j) { const int ei = lane_g + 64 * j; const float av = aacc[t * 128 + ei] * sc;
            const float act = gelu_as(av) * gts[t][j];
            const unsigned ab = __float_as_uint(act), eb = (ab >> 23) & 255u;
            unsigned pk = 0u;
            if (eb > 4u) {
                const float m = __uint_as_float((ab & 0x807fffffu) | (128u << 23));
                const unsigned w0 = __builtin_amdgcn_cvt_scalef32_pk_fp4_f32(0u, m, 0.f, 1.0f, 0);
                const f32x2 d0 = __builtin_amdgcn_cvt_scalef32_pk_f32_fp4(w0, 1.0f, 0);
                const unsigned w1 = __builtin_amdgcn_cvt_scalef32_pk_fp4_f32(0u, (m - d0.x) * 4.0f, 0.f, 1.0f, 0);
                pk = (w0 & 15u) | ((w1 & 15u) << 4) | ((eb - 1u) << 8);
            }
            actl[t * 128 + ei] = (unsigned short)pk; }
    }
    LDS_WAIT();
    int lane_u = lane; asm volatile("" : "+v"(lane_u));
    const float* nf = a.in[16];
    const int ui = lane_u & 31, ug = lane_u >> 5, ush = 4 * (ui & 7);
    const unsigned uk0 = (ui >> 3) == 0 ? 0xffffffffu : 0u, uk1 = (ui >> 3) == 1 ? 0xffffffffu : 0u, uk2 = (ui >> 3) == 2 ? 0xffffffffu : 0u, uk3 = (ui >> 3) == 3 ? 0xffffffffu : 0u;
#ifndef P6_DIGITS
#define P6_DIGITS 2
#endif
#define MFMA32S(a_, b_, c_, sa_) __builtin_amdgcn_mfma_scale_f32_32x32x64_f8f6f4(a_, b_, c_, 4, 4, 0, sa_, 0, 127)
#ifndef P6_UPROBE
#define P6_UPROBE 0
#endif
#define P6_ULOAD(BQ, sq_) do { const int t_ = (sq_) >> 3, qs_ = (sq_) & 7; \
        if (!((P6_UPROBE & 1) && PARTS == 2 && EMASK != 0xffff)) \
        _Pragma("unroll") for (int q = 0; q < 8; ++q) { const int e_ = idl[t_ * 128 + 2 * (8 * qs_ + q) + ug] & EMASK; \
            BQ[q] = *(const GAS u32x4*)(WU + (size_t)e_ * 512 + 16 * ui); } } while (0)
#define P6_UMMA(BQ, sq_) do { const int t_ = (sq_) >> 3, qs_ = (sq_) & 7; \
        _Pragma("unroll") for (int q = 0; q < 8; ++q) { \
            const unsigned av_ = actl[t_ * 128 + 2 * (8 * qs_ + q) + ug]; \
            const unsigned w0_ = (av_ & 15u) << ush, w1_ = ((av_ >> 4) & 15u) << ush; const int s0_ = (int)(av_ >> 8), s1_ = s0_ - 2; \
            const u32x4 bb = BQ[q]; const v8i_t B_ = (v8i_t){(int)bb.x, (int)bb.y, (int)bb.z, (int)bb.w, 0, 0, 0, 0}; \
            if ((P6_UPROBE & 2) && PARTS == 2) { asm volatile("" :: "v"(w0_ & uk0), "v"(w0_ & uk1), "v"(w0_ & uk2), "v"(w0_ & uk3), "v"(w1_ & uk0), "v"(w1_ & uk1), "v"(w1_ & uk2), "v"(w1_ & uk3), "v"(bb), "v"(s0_), "v"(s1_)); continue; } \
            uacc = MFMA32S(((v8i_t){(int)(w0_ & uk0), (int)(w0_ & uk1), (int)(w0_ & uk2), (int)(w0_ & uk3), 0, 0, 0, 0}), B_, uacc, s0_); \
            if (P6_DIGITS == 2) uacc = MFMA32S(((v8i_t){(int)(w1_ & uk0), (int)(w1_ & uk1), (int)(w1_ & uk2), (int)(w1_ & uk3), 0, 0, 0, 0}), B_, uacc, s1_); } } while (0)
    f32x4 gvu[4];
#pragma unroll
    for (int gq = 0; gq < 4; ++gq) gvu[gq] = *(const GAS f32x4*)(nf + 32 * ui + 4 * ug + 8 * gq);
    u32x2 xqn[4];
#define P6_UXPREF(t_) do { const bf16_t* xrow_ = (const bf16_t*)(ws + WS_X1B) + (size_t)(tok0 + (t_)) * DM + 32 * ui + 4 * ug; \
        _Pragma("unroll") for (int gq = 0; gq < 4; ++gq) xqn[gq] = *(const GAS u32x2*)(xrow_ + 8 * gq); } while (0)
#define P6_UEPI(sq_) do { const int t_ = (sq_) >> 3; \
        f32x4 x2[4]; float ss = 0.f; \
        _Pragma("unroll") for (int gq = 0; gq < 4; ++gq) { \
            const u32x2 xq_ = xqn[gq]; \
            x2[gq] = (f32x4){__uint_as_float(xq_.x << 16), __uint_as_float(xq_.x & 0xffff0000u), __uint_as_float(xq_.y << 16), __uint_as_float(xq_.y & 0xffff0000u)} \
                + (f32x4){uacc[4 * gq], uacc[4 * gq + 1], uacc[4 * gq + 2], uacc[4 * gq + 3]} * (1.0f / P6_SU4); \
            ss += (x2[gq].x * x2[gq].x + x2[gq].y * x2[gq].y) + (x2[gq].z * x2[gq].z + x2[gq].w * x2[gq].w); } \
        const float rn = 1.0f / sqrtf(wave_sum(ss) * (1.0f / DM) + EPSF);     \
          \
        _Pragma("unroll") for (int gq = 0; gq < 4; ++gq) *(LAS f32x4*)(wl + ui * 144 + 32 * gq + 16 * ug) = x2[gq] * rn * gvu[gq]; \
        _Pragma("unroll") for (int k = 0; k < 4; ++k) { const int d_ = 4 * lane_u + 256 * k; const f32x4 ov_ = *(const LAS f32x4*)(wl + (d_ >> 5) * 144 + (d_ & 31) * 4); \
            if ((P6_UPROBE & 8) && PARTS == 2) asm volatile("" :: "v"(ov_)); else __builtin_nontemporal_store(ov_, (GAS f32x4*)(a.out + (size_t)(tok0 + t_) * DM + d_)); } \
        uacc = f32x16{}; } while (0)
    if (PARTS & 2) {
        u32x4 bqA[8], bqB[8]; f32x16 uacc = f32x16{};
        if ((P6_UPROBE & 1) && PARTS == 2 && EMASK != 0xffff) {
#pragma unroll
            for (int q = 0; q < 8; ++q) { bqA[q] = (u32x4){(unsigned)lane, 1u, 2u, 3u}; bqB[q] = bqA[q]; } }
        P6_ULOAD(bqA, 0);
#pragma unroll 1
        for (int sq = 0; sq < 128; sq += 2) {
            if ((sq & 7) == 0) P6_UXPREF(sq >> 3);
            P6_ULOAD(bqB, sq + 1);
            P6_UMMA(bqA, sq);
            P6_ULOAD(bqA, (sq + 2 < 128 ? sq + 2 : sq));
            P6_UMMA(bqB, sq + 1);
            if (((sq + 1) & 7) == 7) { if ((P6_UPROBE & 4) && PARTS == 2) { asm volatile("" : "+v"(uacc)); uacc = f32x16{}; } else P6_UEPI(sq + 1); }
        }
    }
#undef P6_ULOAD
#undef P6_UMMA
#undef P6_UEPI
#undef P6_UXPREF
#undef MFMA32S
}

#ifndef MK_N_LAUNCHES
#define MK_N_LAUNCHES 1
#endif
constexpr int NPHASE = 7;

__device__ __forceinline__ int queue_next(unsigned* ctr, volatile LAS unsigned* slot) {
    __syncthreads();
    if (threadIdx.x == 0) *slot = __hip_atomic_fetch_add(ctr, 1u, __ATOMIC_RELAXED, __HIP_MEMORY_SCOPE_AGENT);
    __syncthreads();
    return (int)*slot;
}

__global__ void __launch_bounds__(NTHR, 2) hymba_fwd(Args a) {
    extern __shared__ __attribute__((aligned(16))) unsigned char lds_raw[];
    lds_u8* lds = (lds_u8*)lds_raw;
    volatile LAS unsigned* MISC = (volatile LAS unsigned*)(lds + MISC_OFF);
    const int tid = threadIdx.x, lane = tid & 63; const int wave = __builtin_amdgcn_readfirstlane(tid >> 6);
    const int G = gridDim.x; const int bx = blockIdx.x;
    const int vcu = (G % 8 == 0) ? (bx % 8) * (G / 8) + bx / 8 : bx;
    const int gw = vcu * NWAVES + wave, NGW = G * NWAVES;
    for (int u = tid; u < (LDS_BYTES - MISC_OFF) / 4; u += NTHR) MISC[u] = 0u;
    __syncthreads();
    const int lo = a.ph_lo, hi = a.ph_hi;
    const bool use_bar = (hi - lo) > 1;
    XcdBarrier bar; bar.bar = (unsigned*)(a.ws + WS_CTL); bar.x = 0; bar.st = MISC + 8;
    if (use_bar) bar = xcd_barrier_post((unsigned*)(a.ws + WS_CTL), MISC + 8);
#ifndef PH_MASK
#define PH_MASK 127
#endif
#define IN(k) (((PH_MASK >> (k)) & 1) && lo <= (k) && (k) < hi)
#ifdef DBL_BAR
#define SEAM(k) do { if (IN(k) && IN((k) + 1)) { xcd_barrier(bar); xcd_barrier(bar); } } while (0)
#else
#define SEAM(k) do { if (IN(k) && IN((k) + 1)) xcd_barrier(bar); } while (0)
#endif
    unsigned char* ws = a.ws;

    if (IN(0)) { p0_prologue(a, lds, gw, NGW, lane, wave);
#ifdef DBL_P0
        __syncthreads(); p0_prologue(a, lds, gw, NGW, lane, wave);
#endif
    }
    SEAM(0);
    if (IN(1)) {
        pg8::Gemm g{(const bf16_t*)(ws + WS_XB), (const bf16_t*)(ws + WS_WIN), MTOK, NIN, DM}; pg8::StaticOrder S; S.init(MTOK, NIN, G, bx);
        EpiProj E{(bf16_t*)(ws + WS_PROJ), (const float*)(ws + WS_R1), (const f32x4*)(ws + WS_ROPE), (const float*)(ws + WS_DECAY)};
        pg8::gemm_phase<EpiProj, pg8::StaticOrder>(lds, g, S, E);
#ifdef DBL_P1
        pg8::gemm_phase<EpiProj, pg8::StaticOrder>(lds, g, S, E);
#endif
    }
    SEAM(1);
    if (IN(2)) {
#ifdef DBL_P2
        for (int rep = 0; rep < 2; ++rep) {
        unsigned* ctr = (unsigned*)(ws + WS_CTL + CTL_Q_ATT + rep * 256);
#else
        {
        unsigned* ctr = (unsigned*)(ws + WS_CTL + CTL_Q_ATT);
#endif
        int tkt = queue_next(ctr, MISC + 16);
        for (;;) {
            int u = tkt;
            if (u >= 64 + 1024 + DEF_ITEMS / 5) break;
            static_assert(DEF_ITEMS % 5 == 0 && DEF_ITEMS / 5 == 1024 / 4, "P2 ticket pattern");
            if (u >= 64) { const int i5 = (u - 64) / 5, r5 = (u - 64) % 5;
                if (r5 == 4) {
#ifdef PROBE_P2
                    if (rep == 0 && !(PROBE_P2 & 4)) { tkt = queue_next(ctr, MISC + 16); continue; }
#endif
                    for (int k = 0; k < 5; ++k) p0_deferred(a, lds, i5 * 5 + k);
                    tkt = queue_next(ctr, MISC + 16); continue; }
                u = 64 + i5 * 4 + r5; }
#ifdef PROBE_P2
            if (rep == 0) { if (u >= 64 && (PROBE_P2 & 2)) { const int v = u - 64;
#ifdef PROBE_ATT2
                    if (wave >= 4) attn_unit<PROBE_ATT2>(a, lds, (v & 31) >> 2, v & 3, 31 - (v >> 5)); else
#endif
                    attn_unit<PROBE_ATT>(a, lds, (v & 31) >> 2, v & 3, 31 - (v >> 5)); tkt = queue_next(ctr, MISC + 16); continue; }
                if (u < 64 && (PROBE_P2 & 1)) ret_unit(a, lds, u >> 3, u & 7);
                tkt = queue_next(ctr, MISC + 16); continue; }
#endif
            if (u < 64) { ret_unit(a, lds, u >> 3, u & 7); tkt = queue_next(ctr, MISC + 16); }
            else { const int v = u - 64; attn_unit<7>(a, lds, (v & 31) >> 2, v & 3, 31 - (v >> 5)); tkt = queue_next(ctr, MISC + 16); }
        }
        }
    }
    SEAM(2);
    if (IN(3)) {
        pg8::Gemm g{(const bf16_t*)(ws + WS_MIX), (const bf16_t*)(ws + WS_WOUT), MTOK, DM, DM}; pg8::StaticOrder S; S.init(MTOK, DM, G, bx);
        EpiX1 E{(const bf16_t*)(ws + WS_XB), (bf16_t*)(ws + WS_X1B), (bf16_t*)(ws + WS_SSQ)};
        pg8::gemm_phase<EpiX1, pg8::StaticOrder>(lds, g, S, E);

    }
    SEAM(3);
    if (IN(4)) {
        pg8::Gemm g{(const bf16_t*)(ws + WS_X1B), (const bf16_t*)(ws + WS_WPQ), MTOK, NQ, DM}; pg8::StaticOrder S; S.init(MTOK, NQ, G, bx);
        EpiQ E{(bf16_t*)(ws + WS_PROJ), (const bf16_t*)(ws + WS_SSQ)};
        pg8::gemm_phase<EpiQ, pg8::StaticOrder>(lds, g, S, E);
#ifdef DBL_P4
        pg8::gemm_phase<EpiQ, pg8::StaticOrder>(lds, g, S, E);
#endif
    }
    SEAM(4);
    if (IN(3)) {
#ifdef DBL_P3
        { unsigned long long w2 = (unsigned long long)ws; asm volatile("" : "+s"(w2)); unsigned char* ws2 = (unsigned char*)w2; int bx2 = bx; asm volatile("" : "+s"(bx2));
          pg8::Gemm g2{(const bf16_t*)(ws2 + WS_MIX), (const bf16_t*)(ws2 + WS_WOUT), MTOK, DM, DM}; pg8::StaticOrder S2; S2.init(MTOK, DM, G, bx2);
          EpiX1 E2{(const bf16_t*)(ws2 + WS_XB), (bf16_t*)(ws2 + WS_X1B), (bf16_t*)(ws2 + WS_SSQ)};
          pg8::gemm_phase<EpiX1, pg8::StaticOrder>(lds, g2, S2, E2); }
#endif
    }
    if (IN(5)) p5_topk(a, lds);
    SEAM(5);
#ifdef DBL_P5
    if (IN(5)) { Args a2 = a; asm volatile("" : "+s"(a2.ws)); p5_topk(a2, lds); }
#endif
    if (IN(6)) {
#ifdef P6_TOKEN_MAJOR
        lds_u8* wl = lds + wave * P6_WSCR;
        for (int tok = gw; tok < MTOK; tok += NGW) p6_token(a, wl, tok, lane, a.out);
#else
#ifdef PROBE_EMASK
        for (int tb = gw; tb < MTOK / 16; tb += NGW) p6_slices<PROBE_EMASK, PROBE_PARTS>(a, lds + wave * P6S_WAVE, tb * 16, lane);
#endif
#ifdef DBL_P6
#pragma unroll 1
        for (int rep6 = 0; rep6 < 2; ++rep6)
#endif
        for (int tb = gw; tb < MTOK / 16; tb += NGW) p6_slices<0xffff, 3>(a, lds + wave * P6S_WAVE, tb * 16, lane);
#endif
    }
#ifdef DBG_DUMP
    if (hi - lo > 1) xcd_barrier(bar);
    {
        for (int m = gw; m < MTOK; m += NGW) {
            for (int c = lane; c < DM; c += 64) {
                float v = 0.f;
#if DBG_DUMP == 1
                v = bf2f(((const bf16_t*)(ws + WS_PROJ))[(size_t)m * NIN + DBG_COL + c]);
#elif DBG_DUMP == 2
                v = (c >= DBG_C0 && c < DBG_C1) ? bf2f(((const bf16_t*)(ws + WS_MIX))[(size_t)m * DM + c]) : 0.f;
#endif
                a.out[(size_t)m * DM + c] = v;
            }
        }
    }
#endif
#undef IN
#undef SEAM
}

extern "C" void kernel_launch(void* const* d_in, const int* in_sizes, int n_in, void* d_out, int out_size, void* d_ws, size_t ws_size, hipStream_t stream) {
    static int grid = 0;
    if (grid == 0) {
        if (n_in != 17 || in_sizes[0] != MTOK * DM || out_size != MTOK * DM || ws_size < WS_END) {
            fprintf(stderr, "kernel_launch: unexpected shapes (n_in %d, in0 %d, out %d, ws %zu < %zu); nothing launched\n", n_in, n_in > 0 ? in_sizes[0] : -1, out_size, ws_size, (size_t)WS_END); grid = -1; return; }
        int dev = 0, cus = 0, per_cu = 0;
        if (hipGetDevice(&dev) != hipSuccess || hipDeviceGetAttribute(&cus, hipDeviceAttributeMultiprocessorCount, dev) != hipSuccess) { fprintf(stderr, "kernel_launch: device query failed\n"); grid = -1; return; }
        if (hipFuncSetAttribute((const void*)hymba_fwd, hipFuncAttributeMaxDynamicSharedMemorySize, LDS_BYTES) != hipSuccess) { fprintf(stderr, "kernel_launch: hipFuncSetAttribute failed\n"); grid = -1; return; }
        if (hipOccupancyMaxActiveBlocksPerMultiprocessor(&per_cu, (const void*)hymba_fwd, NTHR, LDS_BYTES) != hipSuccess || per_cu < 1)
            fprintf(stderr, "kernel_launch: note: occupancy query reports %d workgroups per CU\n", per_cu);
        (void)hipGetLastError();
        grid = cus;
    }
    if (grid < 0) return;
    if (hipMemsetAsync((char*)d_ws + WS_CTL, 0, CTL_BYTES, stream) != hipSuccess) { fprintf(stderr, "kernel_launch: memset failed\n"); return; }
    Args a{};
    for (int i = 0; i < 17; ++i) a.in[i] = (const float*)d_in[i];
    a.out = (float*)d_out; a.ws = (unsigned char*)d_ws;
#if MK_N_LAUNCHES == 1
#ifdef DBG_STOP
    a.ph_lo = 0; a.ph_hi = DBG_STOP + 1;
#else
    a.ph_lo = 0; a.ph_hi = NPHASE;
#endif
    hipLaunchKernelGGL(hymba_fwd, dim3(grid), dim3(NTHR), LDS_BYTES, stream, a);
#else
    for (int p = 0; p < NPHASE; ++p) { a.ph_lo = p; a.ph_hi = p + 1; hipLaunchKernelGGL(hymba_fwd, dim3(grid), dim3(NTHR), LDS_BYTES, stream, a); }
#endif
    const hipError_t le = hipPeekAtLastError();
    if (le != hipSuccess) fprintf(stderr, "kernel_launch: launch failed: %s\n", hipGetErrorName(le));
}
```

```cpp
#include <hip/hip_runtime.h>
#include <cstdio>
#include <cstdint>

namespace pg8 {
#define PG8_LAS __attribute__((address_space(3)))
typedef unsigned short bf16_t;
typedef short bf16x8 __attribute__((ext_vector_type(8)));
typedef float f32x4 __attribute__((ext_vector_type(4)));
typedef unsigned u32x4 __attribute__((ext_vector_type(4)));
constexpr int BM = 256, BK = 64, HALF = 128, HTB = HALF * BK * 2  , STAGE_BYTES = 8 * HTB, NXCD = 8, WGM = 8;

__host__ __device__ __forceinline__ int lds_byte(int r, int c) { const int st = (r >> 4) * 2 + (c >> 5), rr = r & 15, cc = c & 31, ob = rr * 64 + cc * 2; return st * 1024 + (ob ^ (((ob >> 9) & 1) << 5)); }
__host__ __device__ __forceinline__ void stage_rc(int b, int& R, int& C) { const int st = b / 1024, sb = b % 1024, swz = sb ^ (((sb >> 9) & 1) << 5); R = (st >> 1) * 16 + swz / 64; C = (st & 1) * 32 + (swz % 64) / 2; }
__host__ __device__ __forceinline__ int perm32(int rho) { const int n = rho >> 4, i = rho & 15; return 8 * (i >> 2) + 4 * n + (i & 3); }

struct Unit { int pm, pn; };
struct Gemm { const bf16_t* A; const bf16_t* Bt; int M, N, K; };

struct StaticOrder {
    int nM, nN, nwg, G, c;
    __host__ __device__ void init(int M, int N, int G_, int c_) { nM = M / BM; nN = N / BM; nwg = nM * nN; G = G_; c = c_; }
    __host__ __device__ bool next(int i, Unit& u) const {
        const long L = (long)i * G + c; if (L >= nwg) return false;
        int wgid = (int)L; { const int q = nwg / NXCD, r = nwg % NXCD, xcd = wgid % NXCD, off = wgid / NXCD; wgid = (xcd < r ? xcd * (q + 1) : r * (q + 1) + (xcd - r) * q) + off; }
        const int nig = WGM * nN, gid = wgid / nig, fm = gid * WGM, gsz = (nM - fm) < WGM ? (nM - fm) : WGM;
        u.pm = fm + ((wgid % nig) % gsz); u.pn = (wgid % nig) / gsz; return true;
    }
    __device__ __forceinline__ void a_ready(const Unit&) const {}
    __device__ __forceinline__ void done(const Unit&) const {}
};
__device__ __forceinline__ unsigned cvt_pk_bf16(float lo, float hi) { unsigned r; asm volatile("v_cvt_pk_bf16_f32 %0, %1, %2" : "=v"(r) : "v"(lo), "v"(hi)); return r; }
template <class Epi, class Sched>
__device__ __forceinline__ void gemm_phase(PG8_LAS unsigned char* lds, const Gemm g, const Sched& S, const Epi& E) {
    const int tid = threadIdx.x, wid = __builtin_amdgcn_readfirstlane(tid >> 6), lane = tid & 63, wr = wid >> 2, wc = wid & 3, fr = lane & 15, fq = lane >> 4;
    const int K = g.K, nt = K / BK;
    unsigned voffA[2], voffB[2];
#pragma unroll
    for (int i = 0; i < 2; ++i) { int R, C; stage_rc(tid * 16 + i * 8192, R, C); const int Rb = Epi::PERM ? ((R & ~31) + perm32(R & 31)) : R;
        voffA[i] = (unsigned)(R * K + C) * 2u; voffB[i] = (unsigned)(Rb * K + C) * 2u; }
    const size_t kstep = (size_t)(BK * 2);
    const size_t hstep = (size_t)HALF * K * 2;
    const size_t tstep = 2 * hstep;
    const unsigned ldsw = (unsigned)wid * 1024u;
    const int aoff = lds_byte(wr * 64 + fr, fq * 8), boff = lds_byte(wc * 32 + fr, fq * 8);
#define PG8_SA(b, h) (((b) * 2 + (h)) * HTB)
#define PG8_SB(b, h) ((4 + (b) * 2 + (h)) * HTB)
#define PG8_STAGE(bufoff, gbase, voff) do { _Pragma("unroll") for (int _i = 0; _i < 2; ++_i) \
        __builtin_amdgcn_global_load_lds((const unsigned*)((const char*)(gbase) + (voff)[_i]), (PG8_LAS unsigned*)(lds + (bufoff) + ldsw + _i * 8192), 16, 0, 0); } while (0)
#define PG8_LDA(dst, b, h) do { _Pragma("unroll") for (int m = 0; m < 4; ++m) _Pragma("unroll") for (int k = 0; k < 2; ++k) dst[m][k] = *(const PG8_LAS bf16x8*)(lds + PG8_SA(b, h) + aoff + m * 2048 + k * 1024); } while (0)
#define PG8_LDB(dst, b, h) do { _Pragma("unroll") for (int n = 0; n < 2; ++n) _Pragma("unroll") for (int k = 0; k < 2; ++k) dst[n][k] = *(const PG8_LAS bf16x8*)(lds + PG8_SB(b, h) + boff + n * 2048 + k * 1024); } while (0)
#define PG8_MMA(ai, bj, At, Bt) do { __builtin_amdgcn_s_setprio(1); _Pragma("unroll") for (int m = 0; m < 4; ++m) _Pragma("unroll") for (int n = 0; n < 2; ++n) _Pragma("unroll") for (int k = 0; k < 2; ++k) \
        acc[ai][bj][m][n] = __builtin_amdgcn_mfma_f32_16x16x32_bf16(Bt[n][k], At[m][k], acc[ai][bj][m][n], 0, 0, 0); __builtin_amdgcn_s_setprio(0); } while (0)
#define PG8_WAIT_V(n) asm volatile("s_waitcnt vmcnt(" #n ")" ::: "memory")
#define PG8_WAIT_L(n) asm volatile("s_waitcnt lgkmcnt(" #n ")" ::: "memory")
#define PG8_BAR __builtin_amdgcn_s_barrier()
#define PG8_SCHED __builtin_amdgcn_sched_barrier(0)
    Unit cur, nxt; int ui = 0;
    if (!S.next(0, cur)) return;
    f32x4 acc[2][2][4][2];
#pragma unroll
    for (int a = 0; a < 2; ++a)
#pragma unroll
        for (int b = 0; b < 2; ++b)
#pragma unroll
            for (int m = 0; m < 4; ++m)
#pragma unroll
                for (int n = 0; n < 2; ++n) acc[a][b][m][n] = (f32x4){0.f, 0.f, 0.f, 0.f};
    bf16x8 At[4][2], B0[2][2], B1[2][2];
    const char* cA = (const char*)g.A + (size_t)cur.pm * tstep; const char* cB = (const char*)g.Bt + (size_t)cur.pn * tstep;
    S.a_ready(cur);
    PG8_STAGE(PG8_SB(0, 0), cB, voffB); PG8_STAGE(PG8_SA(0, 0), cA, voffA); PG8_STAGE(PG8_SB(0, 1), cB + hstep, voffB); PG8_STAGE(PG8_SA(0, 1), cA + hstep, voffA);
    if (wr == 1) PG8_BAR;
    PG8_WAIT_V(4); PG8_BAR;
    PG8_STAGE(PG8_SB(1, 0), cB + kstep, voffB); PG8_STAGE(PG8_SA(1, 0), cA + kstep, voffA); PG8_STAGE(PG8_SB(1, 1), cB + hstep + kstep, voffB);
    PG8_WAIT_V(6); PG8_BAR;
    for (;;) {
        const bool has_next = S.next(ui + 1, nxt);
        const char* nA = has_next ? (const char*)g.A + (size_t)nxt.pm * tstep : cA; const char* nB = has_next ? (const char*)g.Bt + (size_t)nxt.pn * tstep : cB;
        for (int t = 0; t < nt; t += 2) {
            const bool last = (t == nt - 2);
            const char* a1 = cA + (size_t)(t + 1) * kstep;
            const char* a2 = last ? nA : cA + (size_t)(t + 2) * kstep; const char* b2 = last ? nB : cB + (size_t)(t + 2) * kstep;
            const char* a3 = a2 + kstep; const char* b3 = b2 + kstep;
            if (last && has_next) S.a_ready(nxt);
            PG8_LDB(B0, 0, 0); PG8_SCHED; PG8_LDA(At, 0, 0); PG8_STAGE(PG8_SA(1, 1), a1 + hstep, voffA);
            PG8_WAIT_L(8); PG8_BAR; PG8_WAIT_L(0); PG8_MMA(0, 0, At, B0); PG8_BAR; PG8_SCHED;
            PG8_LDB(B1, 0, 1); PG8_STAGE(PG8_SB(0, 0), b2, voffB);
            PG8_BAR; PG8_WAIT_L(0); PG8_MMA(0, 1, At, B1); PG8_BAR;
            PG8_LDA(At, 0, 1); PG8_STAGE(PG8_SA(0, 0), a2, voffA);
            PG8_BAR; PG8_WAIT_L(0); PG8_MMA(1, 0, At, B0); PG8_BAR; PG8_SCHED;
            PG8_STAGE(PG8_SB(0, 1), b2 + hstep, voffB);
            PG8_WAIT_V(6); PG8_BAR; PG8_MMA(1, 1, At, B1); PG8_BAR;
            PG8_LDB(B0, 1, 0); PG8_SCHED; PG8_LDA(At, 1, 0); PG8_STAGE(PG8_SA(0, 1), a2 + hstep, voffA);
            PG8_WAIT_L(8); PG8_BAR; PG8_WAIT_L(0); PG8_MMA(0, 0, At, B0); PG8_BAR; PG8_SCHED;
            PG8_LDB(B1, 1, 1); PG8_STAGE(PG8_SB(1, 0), b3, voffB);
            PG8_BAR; PG8_WAIT_L(0); PG8_MMA(0, 1, At, B1); PG8_BAR;
            PG8_LDA(At, 1, 1); PG8_STAGE(PG8_SA(1, 0), a3, voffA);
            PG8_BAR; PG8_WAIT_L(0); PG8_MMA(1, 0, At, B0); PG8_BAR; PG8_SCHED;
            PG8_STAGE(PG8_SB(1, 1), b3 + hstep, voffB);
            PG8_WAIT_V(6); PG8_BAR; PG8_MMA(1, 1, At, B1); PG8_BAR;
        }
        if constexpr (!Epi::AFTER_DRAIN) { E(acc, cur, wr, wc, fr, fq); S.done(cur); }
        if (!has_next) break;
#pragma unroll
        for (int a = 0; a < 2; ++a)
#pragma unroll
            for (int b = 0; b < 2; ++b)
#pragma unroll
                for (int m = 0; m < 4; ++m)
#pragma unroll
                    for (int n = 0; n < 2; ++n) acc[a][b][m][n] = (f32x4){0.f, 0.f, 0.f, 0.f};
        cur = nxt; cA = nA; cB = nB; ++ui;
    }
    PG8_WAIT_V(0);
    if (wr == 0) PG8_BAR;
    PG8_BAR;
    if constexpr (Epi::AFTER_DRAIN) { E.fused(acc, cur, wr, wc, fr, fq, lds, wid, lane); S.done(cur); }
#undef PG8_SA
#undef PG8_SB
#undef PG8_STAGE
#undef PG8_LDA
#undef PG8_LDB
#undef PG8_MMA
#undef PG8_WAIT_V
#undef PG8_WAIT_L
#undef PG8_BAR
#undef PG8_SCHED
}
}

#define XB_TMO      128
#define XB_XCNT(j)  (256  + 64 * (j))
#define XB_XSUB(j)  (1280 + 64 * (j))
#define XB_XGEN(j)  (2304 + 64 * (j))
#define XB_TOP      3328
#define XB_TOPGEN   3392
#define XCD_BAR_WORDS 3456
#define XB_SPIN_CAP (1u << 18)
#define LAS __attribute__((address_space(3)))

__device__ __forceinline__ unsigned xb_ld(unsigned* p)              { return __hip_atomic_load(p, __ATOMIC_RELAXED, __HIP_MEMORY_SCOPE_AGENT); }
__device__ __forceinline__ unsigned xb_add(unsigned* p, unsigned v) { return __hip_atomic_fetch_add(p, v, __ATOMIC_RELAXED, __HIP_MEMORY_SCOPE_AGENT); }
__device__ __forceinline__ unsigned xb_xcc_id() { return (unsigned)__builtin_amdgcn_s_getreg((3 << 11) | 20) & 0xFu; }
#define XB_SPIN(cond, bar) do { unsigned _sp = 0; while (cond) { __builtin_amdgcn_s_sleep(1); \
    if ((++_sp & 255u) == 0u) { if (xb_ld(&(bar)[XB_TMO])) break; if (_sp > XB_SPIN_CAP) { atomicAdd(&(bar)[XB_TMO], 1u); break; } } } } while (0)

struct XcdBarrier {
    unsigned* bar; unsigned x;
    volatile LAS unsigned* st;
};

__device__ __forceinline__ XcdBarrier xcd_barrier_post(unsigned* bar, volatile LAS unsigned* st) {
    XcdBarrier b; b.bar = bar; b.x = xb_xcc_id(); b.st = st;
    if (threadIdx.x == 0) (void)xb_add(&bar[XB_XCNT(b.x)], 1u);
    return b;
}
__device__ __forceinline__ void xcd_barrier_complete(unsigned* bar, unsigned x, unsigned& nloc, unsigned& nx) {
    const unsigned G = gridDim.x * gridDim.y * gridDim.z;
    unsigned sum, cnt, mine, sp = 0u;
    for (;;) {
        sum = 0u; cnt = 0u; mine = 0u;
#pragma unroll
        for (unsigned j = 0; j < 16; ++j) { const unsigned c = xb_ld(&bar[XB_XCNT(j)]); sum += c; cnt += (c > 0u) ? 1u : 0u; mine = (j == x) ? c : mine; }
        if (sum == G) break;
        __builtin_amdgcn_s_sleep(1);
        if ((++sp & 255u) == 0u) { if (xb_ld(&bar[XB_TMO])) break; if (sp > XB_SPIN_CAP) { atomicAdd(&bar[XB_TMO], 1u); break; } }
    }
    nloc = mine > 0u ? mine : 1u; nx = cnt > 0u ? cnt : 1u;
}

__device__ __forceinline__ void xcd_barrier(const XcdBarrier& b) {
    asm volatile("s_waitcnt vmcnt(0)" ::: "memory");
    __syncthreads();
    if (threadIdx.x == 0) {
        unsigned* bar = b.bar;
        __builtin_amdgcn_s_waitcnt(0);
        unsigned nloc = b.st[0], nx = b.st[1];
        if (nloc == 0u) { xcd_barrier_complete(bar, b.x, nloc, nx); b.st[0] = nloc; b.st[1] = nx; }
        const unsigned old = xb_add(&bar[XB_XSUB(b.x)], 1u);
        const unsigned gen = old / nloc;
        if (old + 1u == (gen + 1u) * nloc) {
            __builtin_amdgcn_fence(__ATOMIC_RELEASE, "agent");
            asm volatile("s_waitcnt vmcnt(0)" ::: "memory");
            const unsigned og = xb_add(&bar[XB_TOP], 1u);
            const unsigned tg = og / nx;
            if (og + 1u == (tg + 1u) * nx) xb_add(&bar[XB_TOPGEN], 1u);
            else XB_SPIN(xb_ld(&bar[XB_TOPGEN]) == tg, bar);
            __builtin_amdgcn_fence(__ATOMIC_ACQUIRE, "agent");
            xb_add(&bar[XB_XGEN(b.x)], 1u);
            asm volatile("s_waitcnt vmcnt(0)" ::: "memory");
        } else {
            XB_SPIN(xb_ld(&bar[XB_XGEN(b.x)]) == gen, bar);
            __builtin_amdgcn_fence(__ATOMIC_ACQUIRE, "agent");
            asm volatile("s_waitcnt vmcnt(0)" ::: "memory");
        }
    }
    __syncthreads();
}

#define GAS __attribute__((address_space(1)))
typedef unsigned short bf16_t;
typedef short bf16x8 __attribute__((ext_vector_type(8)));
typedef short s16x4 __attribute__((ext_vector_type(4)));
typedef float f32x4 __attribute__((ext_vector_type(4)));
typedef float f32x2 __attribute__((ext_vector_type(2)));
typedef float f32x16 __attribute__((ext_vector_type(16)));
typedef unsigned u32x4 __attribute__((ext_vector_type(4)));
typedef unsigned u32x2 __attribute__((ext_vector_type(2)));
typedef LAS unsigned char lds_u8;

constexpr int MTOK = 32768, DM = 1024, SEQ = 4096, NBATCH = 8, NIN = 3584;
constexpr int OFF_RQ = 0, OFF_RK = 512, OFF_RV = 1024, OFF_RG = 1536, OFF_DQ = 2048, OFF_DK = 2560, OFF_DV = 3072;
constexpr int NEXP = 16384, NQ = 2048;
constexpr float EPSF = 1e-6f, LOG2E = 1.4426950408889634f;
constexpr int NWAVES = 8, NTHR = 512;

constexpr size_t WS_CTL = 0, CTL_BYTES = 65536;
constexpr size_t CTL_Q_ATT = 16384, CTL_Q_P6 = 16384 + 1024;
constexpr size_t WS_R1 = WS_CTL + CTL_BYTES;
constexpr size_t WS_SSQ = WS_R1 + (size_t)MTOK * 4;
constexpr size_t WS_ROPE = WS_SSQ + (size_t)MTOK * 16 * 4;
constexpr size_t WS_DECAY = WS_ROPE + (size_t)SEQ * 32 * 8;
constexpr size_t WS_BTAB = WS_DECAY + 2 * 8 * 128 * 4;
constexpr size_t WS_LAM = WS_BTAB + 4 * 128 * 4;
constexpr size_t WS_WIN = 4u << 20;
constexpr size_t WS_WOUT = WS_WIN + (size_t)NIN * DM * 2;
constexpr size_t WS_WPQ = WS_WOUT + (size_t)DM * DM * 2;
constexpr size_t WS_KEYS = WS_WPQ + (size_t)NQ * DM * 2;
constexpr size_t WS_WD = WS_KEYS + (size_t)8 * 2 * 128 * 128 * 2;
constexpr size_t WS_WU = WS_WD + (size_t)NEXP * DM * 2;
constexpr size_t WS_XB = WS_WU + (size_t)NEXP * DM * 2;
constexpr size_t WS_PROJ = WS_XB + (size_t)MTOK * DM * 2;
constexpr size_t WS_MIX = WS_PROJ + (size_t)MTOK * NIN * 2;
constexpr size_t WS_IDX = WS_MIX, WS_GATE = WS_MIX + (size_t)MTOK * 128 * 4;
constexpr size_t WS_X1B = WS_PROJ + (size_t)MTOK * NQ * 2;
static_assert(WS_X1B + (size_t)MTOK * DM * 2 <= WS_MIX, "ws map");
constexpr size_t WS_END = WS_MIX + (size_t)MTOK * DM * 2;
static_assert(WS_LAM + 256 <= WS_WIN, "ws map");
static_assert(WS_END <= (size_t)512 << 20, "ws map");

constexpr int LDS_SCRATCH = 139264;
constexpr int MISC_OFF = LDS_SCRATCH;
constexpr int LDS_BYTES = 147456;

__device__ __forceinline__ float wave_sum(float v) {
    v += __uint_as_float(__builtin_amdgcn_update_dpp(0u, __float_as_uint(v), 0xB1, 0xf, 0xf, true));
    v += __uint_as_float(__builtin_amdgcn_update_dpp(0u, __float_as_uint(v), 0x4E, 0xf, 0xf, true));
    v += __uint_as_float(__builtin_amdgcn_update_dpp(0u, __float_as_uint(v), 0x141, 0xf, 0xf, true));
    v += __uint_as_float(__builtin_amdgcn_update_dpp(0u, __float_as_uint(v), 0x140, 0xf, 0xf, true));
    { auto rr = __builtin_amdgcn_permlane16_swap(__float_as_uint(v), __float_as_uint(v), false, false); v = __uint_as_float(rr[0]) + __uint_as_float(rr[1]); }
    { auto rr = __builtin_amdgcn_permlane32_swap(__float_as_uint(v), __float_as_uint(v), false, false); v = __uint_as_float(rr[0]) + __uint_as_float(rr[1]); }
    return v;
}
typedef __bf16 bf16v2_t __attribute__((ext_vector_type(2)));
__device__ __forceinline__ unsigned pk2(float lo, float hi) { const bf16v2_t v = {(__bf16)lo, (__bf16)hi}; return __builtin_bit_cast(unsigned, v); }
__device__ __forceinline__ float bf2f(unsigned short b) { return __uint_as_float(((unsigned)b) << 16); }
#define LDS_WAIT() asm volatile("s_waitcnt lgkmcnt(0)" ::: "memory")
#define VM_WAIT() asm volatile("s_waitcnt vmcnt(0)" ::: "memory")

struct Args {
    const float* in[17]; float* out; unsigned char* ws; int ph_lo, ph_hi;
};

template <int MODE>
__device__ __forceinline__ void p0_transpose_item(const float* W, const float* scale, int K, int N, bf16_t* WT, LAS float* scr, int item, int lane) {
    const int nblk = N / 32, kb = item / nblk, nb = item % nblk, k0 = 64 * kb, n0 = 32 * nb;
#pragma unroll 8
    for (int i = 0; i < 32; ++i) { const int kk = 2 * i + (lane >> 5); const float sc = scale ? scale[k0 + kk] : 1.0f; scr[kk * 33 + (lane & 31)] = __builtin_nontemporal_load((const GAS float*)(W + (size_t)(k0 + kk) * N + n0 + (lane & 31))) * sc; }
    LDS_WAIT();
    const int c = lane & 7;
#pragma unroll
    for (int j = 0; j < 4; ++j) { const int n = (lane >> 3) + 8 * j; const LAS float* s = scr + (8 * c) * 33 + n;
        u32x4 o; o.x = pk2(s[0 * 33], s[1 * 33]); o.y = pk2(s[2 * 33], s[3 * 33]); o.z = pk2(s[4 * 33], s[5 * 33]); o.w = pk2(s[6 * 33], s[7 * 33]);
        int nn = n0 + n;
        if (MODE == 1 && nn < 1024) { const int d = nn & 63; nn = (nn & ~63) + ((d < 32) ? 2 * d : 2 * (d - 32) + 1); }
        *(GAS u32x4*)(WT + (size_t)nn * K + k0 + 8 * c) = o; }
    LDS_WAIT();
}

__device__ __forceinline__ int t5_bucket(int n) {
    if (n < 16) return n;
    const float v = logf((float)n / 16.0f) / 2.0794415416798357f * 16.0f;
    int b = 16 + (int)v; return b > 31 ? 31 : b;
}

__device__ __forceinline__ void p0_prologue(const Args& a, lds_u8* lds, int gw, int NGW, int lane, int wave) {
    unsigned char* ws = a.ws;
    const float* x = a.in[0];
    bf16_t* xb = (bf16_t*)(ws + WS_XB); float* r1 = (float*)(ws + WS_R1);
    for (int m0 = gw; m0 < MTOK; m0 += 4 * NGW) {
        f32x4 v[4][4];
#pragma unroll
        for (int r = 0; r < 4; ++r) { const int m = m0 + r * NGW; const GAS f32x4* xr = (const GAS f32x4*)(x + (size_t)(m < MTOK ? m : m0) * DM) + lane;
#pragma unroll
            for (int j = 0; j < 4; ++j) v[r][j] = __builtin_nontemporal_load(xr + 64 * j); }
#pragma unroll
        for (int r = 0; r < 4; ++r) { const int m = m0 + r * NGW; if (m >= MTOK) break;
            float s = 0.f;
#pragma unroll
            for (int j = 0; j < 4; ++j) s += (v[r][j].x * v[r][j].x + v[r][j].y * v[r][j].y) + (v[r][j].z * v[r][j].z + v[r][j].w * v[r][j].w);
            s = wave_sum(s);
            GAS u32x2* o8 = (GAS u32x2*)(xb + (size_t)m * DM) + lane;
#pragma unroll
            for (int j = 0; j < 4; ++j) { u32x2 o; o.x = pk2(v[r][j].x, v[r][j].y); o.y = pk2(v[r][j].z, v[r][j].w); o8[64 * j] = o; }
            if (lane == 0) r1[m] = 1.0f / sqrtf(s * (1.0f / DM) + EPSF); }
    }
    {
        LAS float* scr = (LAS float*)(lds + wave * 8704);
        constexpr int I_IN = (DM / 64) * (NIN / 32);
        for (int it = gw; it < I_IN; it += NGW) p0_transpose_item<1>(a.in[2], a.in[1], DM, NIN, (bf16_t*)(ws + WS_WIN), scr, it, lane);
    }
    const int gt = gw * 64 + lane, NGT = NGW * 64;
    {
        f32x2* rope = (f32x2*)(ws + WS_ROPE);
        for (int i = gt; i < SEQ * 32; i += NGT) { const int pos = i >> 5, j = i & 31; const float fr = (float)pow(10000.0, -(double)j / 32.0); const float ang = (float)pos * fr;
            rope[i] = (f32x2){(float)cos((double)ang), (float)sin((double)ang)}; }
        float* dec = (float*)(ws + WS_DECAY);
        for (int i = gt; i < 2 * 8 * 128; i += NGT) { const int l = i & 127, h = (i >> 7) & 7, kk = i >> 10; const double lg = log2(1.0 - exp2(-5.0 - (double)h));
            dec[i] = kk ? (float)(0.125 * exp2(-lg * (double)l)) : (float)exp2(lg * (double)l); }
        float* bt = (float*)(ws + WS_BTAB); const float* rb = a.in[9];
        for (int i = gt; i < 4 * 128; i += NGT) { const int n = i & 127, h = i >> 7; bt[i] = rb[t5_bucket(n) * 4 + h] * LOG2E; }
        if (gt == 0) { float s1 = 0.f, s2 = 0.f; for (int i = 0; i < 64; ++i) { s1 += a.in[4][i] * a.in[5][i]; s2 += a.in[6][i] * a.in[7][i]; }
            ((float*)(ws + WS_LAM))[0] = expf(s1) - expf(s2) + 0.2f; }
    }
}


constexpr int DEF_T0 = 192, DEF_T1 = 64, DEF_T2 = 512, DEF_T3 = 512, DEF_ITEMS = DEF_T0 + DEF_T1 + DEF_T2 + DEF_T3;
__device__ __forceinline__ void p0_deferred(const Args& a, lds_u8* lds, int item) {
    unsigned char* ws = a.ws;
    int tid_ = threadIdx.x; asm volatile("" : "+v"(tid_));
    const int tid = tid_, lane = tid & 63; const int wave = __builtin_amdgcn_readfirstlane(tid >> 6);
    if (item < DEF_T0) {
        LAS float* scr = (LAS float*)(lds + wave * 8704);
        constexpr int I_OUT = (DM / 64) * (DM / 32), I_PQ = (DM / 64) * (NQ / 32);
        static_assert(I_OUT + I_PQ == DEF_T0 * 8, "deferred transposes");
        const int r = item * 8 + wave;
        if (r < I_OUT) p0_transpose_item<0>(a.in[10], nullptr, DM, DM, (bf16_t*)(ws + WS_WOUT), scr, r, lane);
        else p0_transpose_item<0>(a.in[12], a.in[11], DM, NQ, (bf16_t*)(ws + WS_WPQ), scr, r - I_OUT, lane);
        return;
    }
    item -= DEF_T0;
    if (item < DEF_T1) {
        const float* pk = a.in[13]; bf16_t* kb = (bf16_t*)(ws + WS_KEYS);
        const int i = item * 512 + tid;
        const GAS f32x4* s = (const GAS f32x4*)(pk + (size_t)i * 8); const f32x4 p = __builtin_nontemporal_load(s), q = __builtin_nontemporal_load(s + 1);
        u32x4 o; o.x = pk2(p.x, p.y); o.y = pk2(p.z, p.w); o.z = pk2(q.x, q.y); o.w = pk2(q.z, q.w); *(GAS u32x4*)(kb + (size_t)i * 8) = o;
        return;
    }
    item -= DEF_T1;
    const float* dn = a.in[14]; const float* up = a.in[15]; const float* gf = a.in[11];
    unsigned char* wd = ws + WS_WD; unsigned char* wu = ws + WS_WU;
    const bool isup = item < DEF_T2; if (!isup) item -= DEF_T2;
    const float* src = (isup ? up : dn) + (size_t)(item * 32 + wave * 4) * DM + lane * 4;
    f32x4 g[4];
#pragma unroll
    for (int k = 0; k < 4; ++k) g[k] = isup ? (f32x4){6.0f, 6.0f, 6.0f, 6.0f} : *(const GAS f32x4*)(gf + k * 256 + lane * 4) * 64.0f;
    f32x4 v[4][4];
#pragma unroll
    for (int r = 0; r < 4; ++r)
#pragma unroll
        for (int k = 0; k < 4; ++k) v[r][k] = __builtin_nontemporal_load((const GAS f32x4*)(src + (size_t)r * DM + k * 256));
#pragma unroll
    for (int r = 0; r < 4; ++r) {
        const int e = item * 32 + wave * 4 + r;
#pragma unroll
        for (int k = 0; k < 4; ++k) {
            const f32x4 p = v[r][k] * g[k];
            unsigned w = __builtin_amdgcn_cvt_scalef32_pk_fp4_f32(0u, p.x, p.y, 1.0f, 0);
            w = __builtin_amdgcn_cvt_scalef32_pk_fp4_f32(w, p.z, p.w, 1.0f, 1);
            unsigned char* dst = isup ? wu + (size_t)e * 512 + k * 128 + lane * 2 : wd + (size_t)k * ((size_t)NEXP * 128) + (size_t)e * 128 + lane * 2;
            *(GAS unsigned short*)dst = (unsigned short)w;
        }
    }
}

__device__ __forceinline__ f32x4 bf4_lo(u32x4 w) { return (f32x4){__uint_as_float(w.x << 16), __uint_as_float(w.x & 0xffff0000u), __uint_as_float(w.y << 16), __uint_as_float(w.y & 0xffff0000u)}; }
__device__ __forceinline__ f32x4 bf4_hi(u32x4 w) { return (f32x4){__uint_as_float(w.z << 16), __uint_as_float(w.z & 0xffff0000u), __uint_as_float(w.w << 16), __uint_as_float(w.w & 0xffff0000u)}; }
struct EpiProj {
    static constexpr bool PERM = true, AFTER_DRAIN = false;
    bf16_t* P; const float* r1; const f32x4* rope; const float* decay;
    __device__ __forceinline__ void operator()(const f32x4 (&acc)[2][2][4][2], const pg8::Unit& u, int wr, int wc, int fr, int fq) const {
        const int row0 = u.pm * 256 + wr * 64 + fr, seg = u.pn >> 1;
        float rsv[2][4];
#pragma unroll
        for (int ai = 0; ai < 2; ++ai)
#pragma unroll
            for (int m = 0; m < 4; ++m) rsv[ai][m] = *(const GAS float*)(r1 + row0 + ai * 128 + m * 16);
        if (seg <= 1) {
#pragma unroll
            for (int ai = 0; ai < 2; ++ai) {
                f32x4 ra[4][2], rb[4][2]; float ff[4][2];
#pragma unroll
                for (int m = 0; m < 4; ++m)
#pragma unroll
                    for (int bj = 0; bj < 2; ++bj) {
                        const int row = row0 + ai * 128 + m * 16, c0 = u.pn * 256 + bj * 128 + wc * 32 + 8 * fq;
                        const int pos = row & (SEQ - 1), l = row & 127, head = (c0 & 511) >> 6, jb = (c0 & 63) >> 1;
                        const GAS f32x4* rp = (const GAS f32x4*)rope + ((size_t)pos * 32 + jb) / 2; ra[m][bj] = rp[0]; rb[m][bj] = rp[1];
                        ff[m][bj] = *(const GAS float*)(decay + (seg * 8 + head) * 128 + l);
                    }
#pragma unroll
                for (int m = 0; m < 4; ++m)
#pragma unroll
                    for (int bj = 0; bj < 2; ++bj) {
                        const int row = row0 + ai * 128 + m * 16, c0 = u.pn * 256 + bj * 128 + wc * 32 + 8 * fq;
                        const f32x4 v0 = acc[ai][bj][m][0] * rsv[ai][m], v1 = acc[ai][bj][m][1] * rsv[ai][m];
                        const f32x4 a_ = ra[m][bj], b_ = rb[m][bj]; const float f = ff[m][bj];
                        f32x4 w0, w1;
                        w0.x = (v0.x * a_.x - v0.y * a_.y) * f; w0.y = (v0.y * a_.x + v0.x * a_.y) * f;
                        w0.z = (v0.z * a_.z - v0.w * a_.w) * f; w0.w = (v0.w * a_.z + v0.z * a_.w) * f;
                        w1.x = (v1.x * b_.x - v1.y * b_.y) * f; w1.y = (v1.y * b_.x + v1.x * b_.y) * f;
                        w1.z = (v1.z * b_.z - v1.w * b_.w) * f; w1.w = (v1.w * b_.z + v1.z * b_.w) * f;
                        u32x4 w; w.x = pk2(w0.x, w0.y); w.y = pk2(w0.z, w0.w); w.z = pk2(w1.x, w1.y); w.w = pk2(w1.z, w1.w);
                        *(GAS u32x4*)(P + (size_t)row * NIN + c0) = w;
                    }
            }
        } else {
#pragma unroll
            for (int ai = 0; ai < 2; ++ai)
#pragma unroll
                for (int m = 0; m < 4; ++m)
#pragma unroll
                    for (int bj = 0; bj < 2; ++bj) {
                        const int row = row0 + ai * 128 + m * 16, c0 = u.pn * 256 + bj * 128 + wc * 32 + 8 * fq;
                        f32x4 v0 = acc[ai][bj][m][0] * rsv[ai][m], v1 = acc[ai][bj][m][1] * rsv[ai][m];
                        if (seg == 3) {
#pragma unroll
                            for (int j = 0; j < 4; ++j) { v0[j] = v0[j] / (1.0f + __expf(-v0[j])); v1[j] = v1[j] / (1.0f + __expf(-v1[j])); }
                        } else if (seg == 4) { v0 = v0 * (0.125f * LOG2E); v1 = v1 * (0.125f * LOG2E); }
                        u32x4 w; w.x = pk2(v0.x, v0.y); w.y = pk2(v0.z, v0.w); w.z = pk2(v1.x, v1.y); w.w = pk2(v1.z, v1.w);
                        *(GAS u32x4*)(P + (size_t)row * NIN + c0) = w;
                    }
        }
    }
};
struct EpiX1 {
    static constexpr bool PERM = true, AFTER_DRAIN = false;
    const bf16_t* XB; bf16_t* X1B; bf16_t* ssq;
    __device__ __forceinline__ void operator()(const f32x4 (&acc)[2][2][4][2], const pg8::Unit& u, int wr, int wc, int fr, int fq) const {
        const int row0 = u.pm * 256 + wr * 64 + fr, c00 = u.pn * 256 + wc * 32 + 8 * fq;
        u32x4 xin[2][4][2];
#pragma unroll
        for (int ai = 0; ai < 2; ++ai)
#pragma unroll
            for (int m = 0; m < 4; ++m)
#pragma unroll
                for (int bj = 0; bj < 2; ++bj) xin[ai][m][bj] = *(const GAS u32x4*)(XB + (size_t)(row0 + ai * 128 + m * 16) * DM + c00 + bj * 128);
#pragma unroll
        for (int ai = 0; ai < 2; ++ai)
#pragma unroll
            for (int m = 0; m < 4; ++m) {
                const int row = row0 + ai * 128 + m * 16; float ss = 0.f;
#pragma unroll
                for (int bj = 0; bj < 2; ++bj) {
                    const f32x4 o0 = acc[ai][bj][m][0] + bf4_lo(xin[ai][m][bj]), o1 = acc[ai][bj][m][1] + bf4_hi(xin[ai][m][bj]);
                    u32x4 w; w.x = pk2(o0.x, o0.y); w.y = pk2(o0.z, o0.w); w.z = pk2(o1.x, o1.y); w.w = pk2(o1.z, o1.w);
                    *(GAS u32x4*)(X1B + (size_t)row * DM + c00 + bj * 128) = w;
                    ss += ((o0.x * o0.x + o0.y * o0.y) + (o0.z * o0.z + o0.w * o0.w)) + ((o1.x * o1.x + o1.y * o1.y) + (o1.z * o1.z + o1.w * o1.w));
                }
                ss += __shfl_xor(ss, 16); ss += __shfl_xor(ss, 32);
                if (fq == 0) *(GAS bf16_t*)(ssq + (size_t)row * 16 + u.pn * 4 + wc) = (bf16_t)(pk2(ss, 0.f) & 0xffffu);
            }
    }
};
__device__ __forceinline__ float rs2_from(u32x4 a, u32x4 b) {
    const f32x4 p = bf4_lo(a) + bf4_hi(a) + bf4_lo(b) + bf4_hi(b);
    return 1.0f / sqrtf(((p.x + p.y) + (p.z + p.w)) * (1.0f / DM) + EPSF);
}
__device__ __forceinline__ float row_rs2(const bf16_t* ssq, int row) {
    const GAS u32x4* p = (const GAS u32x4*)(ssq + (size_t)row * 16); return rs2_from(p[0], p[1]);
}
struct EpiQ {
    static constexpr bool PERM = true, AFTER_DRAIN = false;
    bf16_t* Q; const bf16_t* ssq;
    __device__ __forceinline__ void operator()(const f32x4 (&acc)[2][2][4][2], const pg8::Unit& u, int wr, int wc, int fr, int fq) const {
        const int row0 = u.pm * 256 + wr * 64 + fr;
        u32x4 sa[2][4], sb[2][4];
#pragma unroll
        for (int ai = 0; ai < 2; ++ai)
#pragma unroll
            for (int m = 0; m < 4; ++m) { const GAS u32x4* p = (const GAS u32x4*)(ssq + (size_t)(row0 + ai * 128 + m * 16) * 16); sa[ai][m] = p[0]; sb[ai][m] = p[1]; }
#pragma unroll
        for (int ai = 0; ai < 2; ++ai)
#pragma unroll
            for (int m = 0; m < 4; ++m) {
                const int row = row0 + ai * 128 + m * 16; const float rs = rs2_from(sa[ai][m], sb[ai][m]);
#pragma unroll
                for (int bj = 0; bj < 2; ++bj) {
                    const int c0 = u.pn * 256 + bj * 128 + wc * 32 + 8 * fq;
                    const f32x4 v0 = acc[ai][bj][m][0] * rs, v1 = acc[ai][bj][m][1] * rs;
                    u32x4 w; w.x = pk2(v0.x, v0.y); w.y = pk2(v0.z, v0.w); w.z = pk2(v1.x, v1.y); w.w = pk2(v1.z, v1.w);
                    *(GAS u32x4*)(Q + (size_t)row * NQ + c0) = w;
                }
            }
    }
};

#define MFMA32(a, b, c) __builtin_amdgcn_mfma_f32_32x32x16_bf16(a, b, c, 0, 0, 0)
typedef short v4i16_t __attribute__((ext_vector_type(4)));
__device__ __forceinline__ s16x4 vtr(const lds_u8* p) { return __builtin_bit_cast(s16x4, __builtin_amdgcn_ds_read_tr16_b64_v4i16((LAS v4i16_t*)p)); }
__device__ __forceinline__ bf16x8 vfrag(const lds_u8* p) { const s16x4 lo = vtr(p), hi = vtr(p + 512); return (bf16x8){lo[0], lo[1], lo[2], lo[3], hi[0], hi[1], hi[2], hi[3]}; }
__device__ __forceinline__ bf16x8 ldsb128(const lds_u8* p) { return *(const LAS bf16x8*)p; }
__device__ __forceinline__ int crow(int r, int hi) { return (r & 3) + 8 * (r >> 2) + 4 * hi; }
__device__ __forceinline__ void glds16(const void* g, lds_u8* l) {
    unsigned sv; const unsigned lb = (unsigned)__builtin_amdgcn_readfirstlane((int)(unsigned)(uintptr_t)l);
    asm volatile("s_mov_b32 %0, m0\n\ts_mov_b32 m0, %2\n\ts_nop 0\n\tglobal_load_lds_dwordx4 %1, off\n\ts_mov_b32 m0, %0" : "=&s"(sv) : "v"(g), "s"(lb) : "memory");
}
__device__ __forceinline__ float swap_sum(float v) { auto rr = __builtin_amdgcn_permlane32_swap(__float_as_uint(v), __float_as_uint(v), false, false); return __uint_as_float(rr[0]) + __uint_as_float(rr[1]); }
__device__ __forceinline__ float swap_max(float v) { auto rr = __builtin_amdgcn_permlane32_swap(__float_as_uint(v), __float_as_uint(v), false, false); return __builtin_fmaxf(__uint_as_float(rr[0]), __uint_as_float(rr[1])); }

constexpr int ATT_SLOT = 32768, ATT_XCH = 65536, ATT_XPITCH = 528, ATT_BTAB = ATT_XCH + 128 * ATT_XPITCH;
constexpr int ATT_SUBG = ATT_BTAB + 512, ATT_OPITCH = 272;
static_assert(ATT_SUBG + 512 <= LDS_SCRATCH && 128 * ATT_OPITCH <= 2 * ATT_SLOT, "attention LDS");

template <int MODE>
__device__ __forceinline__ void attn_unit(const Args& a, lds_u8* lds, int b, int h, int qb) {
    int tid_ = threadIdx.x; asm volatile("" : "+v"(tid_));
    const int tid = tid_, lane = tid & 63, r32 = lane & 31, hi = lane >> 5; const int wid = __builtin_amdgcn_readfirstlane(tid >> 6);
    const int rgp = wid & 3, map = wid >> 2;
    const bf16_t* proj = (const bf16_t*)(a.ws + WS_PROJ);
    const size_t rowbase = (size_t)b * SEQ; const int q0 = qb * 128, NT = 2 * qb + 2;
    const float lam = ((const float*)(a.ws + WS_LAM))[0];
    if (tid < 128) { ((LAS float*)(lds + ATT_BTAB))[tid] = ((const float*)(a.ws + WS_BTAB))[h * 128 + tid]; ((LAS float*)(lds + ATT_SUBG))[tid] = a.in[8][tid]; }
    bf16x8 qf[4];
    { const bf16_t* qp = proj + (rowbase + q0 + rgp * 32 + r32) * NIN + OFF_DQ + h * 128 + map * 64 + hi * 8;
#pragma unroll
      for (int s = 0; s < 4; ++s) qf[s] = *(const GAS bf16x8*)(qp + s * 16); }
    asm volatile("" : "+v"(qf[0]), "+v"(qf[1]), "+v"(qf[2]), "+v"(qf[3]));
    const int krow = 8 * wid + (lane >> 3);
    const bf16_t* k1src = proj + (rowbase + krow) * NIN + OFF_DK + h * 128 + ((lane & 7) ^ ((krow >> 1) & 7)) * 8;
    const bf16_t* k2src = k1src + 64;
    const bf16_t* vsrc0 = proj + (rowbase + 16 * ((2 * wid) & 3) + (lane >> 2)) * NIN + OFF_DV + h * 128 + 32 * ((2 * wid) >> 2) + (lane & 3) * 8;
    const bf16_t* vsrc1 = proj + (rowbase + 16 * ((2 * wid + 1) & 3) + (lane >> 2)) * NIN + OFF_DV + h * 128 + 32 * ((2 * wid + 1) >> 2) + (lane & 3) * 8;
#define ATT_DMA(t, slot) do { const size_t go = (size_t)(t) * 64 * NIN; lds_u8* sb = lds + (slot) * ATT_SLOT; \
        glds16(k1src + go, sb + wid * 1024); glds16(k2src + go, sb + 8192 + wid * 1024); \
        glds16(vsrc0 + go, sb + 16384 + (2 * wid) * 1024); glds16(vsrc1 + go, sb + 16384 + (2 * wid + 1) * 1024); } while (0)
    const int koff = map * 8192 + r32 * 128, ksw = (r32 >> 1) & 7;
    const int voff = 16384 + ((lane >> 4) & 1) * 32 + (lane & 3) * 8 + (4 * hi + ((lane & 15) >> 2)) * 64;
    f32x16 o[4];
#pragma unroll
    for (int d = 0; d < 4; ++d) o[d] = f32x16{};
    float mrun = 0.f, lrun = 0.f; bool shifted = false, farpend = !(176 > q0);
    const int qpos = q0 + rgp * 32 + r32;
    float b31 = ((const float*)(a.ws + WS_BTAB))[h * 128 + 127]; asm volatile("" : "+v"(b31));
    ATT_DMA(0, 0);
    for (int t = 0; t < NT; ++t) {
        if (!(MODE & 32) || t < 2) { VM_WAIT(); __syncthreads(); }
        if (t + 1 < NT && (!(MODE & 8) || t + 1 < 2)) ATT_DMA(t + 1, (t + 1) & 1);
        if (64 * t > q0 + rgp * 32 + 31) continue;
        const lds_u8* sb = lds + (t & 1) * ATT_SLOT;
        const bool nearT = (64 * t + 176 > q0);
        f32x16 sA = f32x16{}, sB = f32x16{};
        if (MODE & 1) {
            bf16x8 kf[8];
#pragma unroll
            for (int d0 = 0; d0 < 4; ++d0) { const int kc = koff + (((2 * d0 + hi) ^ ksw) << 4); if (MODE & 16) { kf[2 * d0] = qf[d0]; kf[2 * d0 + 1] = qf[3 - d0]; } else { kf[2 * d0] = ldsb128(sb + kc); kf[2 * d0 + 1] = ldsb128(sb + kc + 4096); } }
            __builtin_amdgcn_sched_group_barrier(0x100, 8, 0);
#pragma unroll
            for (int d0 = 0; d0 < 4; ++d0) { sA = MFMA32(kf[2 * d0], qf[d0], sA); sB = MFMA32(kf[2 * d0 + 1], qf[d0], sB); }
            __builtin_amdgcn_sched_group_barrier(0x8, 8, 0);
        }
        if (!(MODE & 1)) asm volatile("" : "+v"(sA), "+v"(sB));
        if (MODE & 4) {
        if (nearT) {
            if (farpend) { farpend = false; const float fb = __builtin_amdgcn_exp2f(b31); lrun *= fb;
#pragma unroll
                for (int d = 0; d < 4; ++d)
#pragma unroll
                    for (int r = 0; r < 16; ++r) o[d][r] *= fb; }
            const LAS float* bt = (const LAS float*)(lds + ATT_BTAB);
            float bA[16], bB[16];
#pragma unroll
            for (int r = 0; r < 16; ++r) { const int d0 = qpos - (64 * t + crow(r, hi)), d1 = d0 - 32;
                bA[r] = bt[d0 < 0 ? 0 : (d0 > 127 ? 127 : d0)]; bB[r] = bt[d1 < 0 ? 0 : (d1 > 127 ? 127 : d1)]; }
            asm volatile("" : "+v"(bA[0]), "+v"(bA[1]), "+v"(bA[2]), "+v"(bA[3]), "+v"(bA[4]), "+v"(bA[5]), "+v"(bA[6]), "+v"(bA[7]), "+v"(bA[8]), "+v"(bA[9]), "+v"(bA[10]), "+v"(bA[11]), "+v"(bA[12]), "+v"(bA[13]), "+v"(bA[14]), "+v"(bA[15]));
            asm volatile("" : "+v"(bB[0]), "+v"(bB[1]), "+v"(bB[2]), "+v"(bB[3]), "+v"(bB[4]), "+v"(bB[5]), "+v"(bB[6]), "+v"(bB[7]), "+v"(bB[8]), "+v"(bB[9]), "+v"(bB[10]), "+v"(bB[11]), "+v"(bB[12]), "+v"(bB[13]), "+v"(bB[14]), "+v"(bB[15]));
#pragma unroll
            for (int r = 0; r < 16; ++r) { const int d0 = qpos - (64 * t + crow(r, hi)), d1 = d0 - 32;
                sA[r] = d0 < 0 ? -INFINITY : sA[r] + bA[r]; sB[r] = d1 < 0 ? -INFINITY : sB[r] + bB[r]; }
        }
#define MX3(a_, b_, c_) __builtin_fmaxf(__builtin_fmaxf((a_), (b_)), (c_))
        float mxa = MX3(sA[0], sA[1], sB[0]), mxb = MX3(sA[2], sA[3], sB[1]); mxa = MX3(mxa, sB[2], sB[3]);
#pragma unroll
        for (int r = 4; r < 16; r += 4) { mxa = MX3(mxa, sA[r], sA[r + 1]); mxb = MX3(mxb, sA[r + 2], sA[r + 3]); mxa = MX3(mxa, sB[r], sB[r + 1]); mxb = MX3(mxb, sB[r + 2], sB[r + 3]); }
#undef MX3
        const float mx = swap_max(__builtin_fmaxf(mxa, mxb));
        if (shifted) {
#pragma unroll
            for (int r = 0; r < 16; ++r) { asm volatile("v_sub_f32 %0, %0, %1" : "+v"(sA[r]) : "v"(mrun)); asm volatile("v_sub_f32 %0, %0, %1" : "+v"(sB[r]) : "v"(mrun)); }
        }
        const float dmx = mx - mrun;
        if (__any(dmx > 64.0f) || (t == 0 && __any(dmx < -64.0f))) {
            const float up = (t == 0) ? ((dmx > 64.0f || dmx < -64.0f) ? dmx : 0.f) : __builtin_fmaxf(dmx - 32.0f, 0.f) * (dmx > 64.0f ? 1.0f : 0.f);
            const float alpha = (t == 0) ? 0.f : __builtin_amdgcn_exp2f(-up);
            mrun += up; lrun = (up != 0.f) ? lrun * alpha : lrun;
#pragma unroll
            for (int d = 0; d < 4; ++d)
#pragma unroll
                for (int r = 0; r < 16; ++r) o[d][r] = (up != 0.f) ? o[d][r] * alpha : o[d][r];
#pragma unroll
            for (int r = 0; r < 16; ++r) { asm volatile("v_sub_f32 %0, %0, %1" : "+v"(sA[r]) : "v"(up)); asm volatile("v_sub_f32 %0, %0, %1" : "+v"(sB[r]) : "v"(up)); }
            shifted = __any(mrun != 0.f);
        }
#pragma unroll
        for (int r = 0; r < 16; ++r) { if (MODE & 64) { sA[r] = sA[r] * 1.0009765625f; sB[r] = sB[r] * 1.0009765625f; } else { sA[r] = __builtin_amdgcn_exp2f(sA[r]); sB[r] = __builtin_amdgcn_exp2f(sB[r]); } }
#pragma unroll
        for (int r = 0; r < 16; ++r) { lrun += sA[r]; lrun += sB[r]; }
        } else { asm volatile("" : "+v"(sA), "+v"(sB)); }
        u32x4 pw[4];
        pw[0] = (u32x4){pk2(sA[0], sA[1]), pk2(sA[2], sA[3]), pk2(sA[4], sA[5]), pk2(sA[6], sA[7])};
        pw[1] = (u32x4){pk2(sA[8], sA[9]), pk2(sA[10], sA[11]), pk2(sA[12], sA[13]), pk2(sA[14], sA[15])};
        pw[2] = (u32x4){pk2(sB[0], sB[1]), pk2(sB[2], sB[3]), pk2(sB[4], sB[5]), pk2(sB[6], sB[7])};
        pw[3] = (u32x4){pk2(sB[8], sB[9]), pk2(sB[10], sB[11]), pk2(sB[12], sB[13]), pk2(sB[14], sB[15])};
        if (!(MODE & 2)) { asm volatile("" :: "v"(pw[0]), "v"(pw[1]), "v"(pw[2]), "v"(pw[3])); continue; }
        {
            bf16x8 vfa[4], vfb[4];
#pragma unroll
            for (int d = 0; d < 4; ++d) vfa[d] = (MODE & 16) ? qf[d] : vfrag(sb + voff + d * 4096);
            __builtin_amdgcn_sched_group_barrier(0x100, 8, 0);
#pragma unroll
            for (int ks = 0; ks < 4; ks += 2) {
#pragma unroll
                for (int d = 0; d < 4; ++d) vfb[d] = (MODE & 16) ? qf[3 - d] : vfrag(sb + voff + d * 4096 + (ks + 1) * 1024);
                __builtin_amdgcn_sched_group_barrier(0x100, 8, 0);
                { const bf16x8 pb = __builtin_bit_cast(bf16x8, pw[ks]);
#pragma unroll
                  for (int d = 0; d < 4; ++d) o[d] = MFMA32(vfa[d], pb, o[d]); }
                __builtin_amdgcn_sched_group_barrier(0x8, 4, 0);
                if (ks + 2 < 4) {
#pragma unroll
                    for (int d = 0; d < 4; ++d) vfa[d] = (MODE & 16) ? qf[d] : vfrag(sb + voff + d * 4096 + (ks + 2) * 1024);
                    __builtin_amdgcn_sched_group_barrier(0x100, 8, 0);
                }
                { const bf16x8 pb = __builtin_bit_cast(bf16x8, pw[ks + 1]);
#pragma unroll
                  for (int d = 0; d < 4; ++d) o[d] = MFMA32(vfb[d], pb, o[d]); }
                __builtin_amdgcn_sched_group_barrier(0x8, 4, 0);
            }
        }
    }
    const float inv = 1.0f / swap_sum(lrun);
    LAS float* xch = (LAS float*)(lds + ATT_XCH + (rgp * 32 + r32) * ATT_XPITCH);
    if (map == 1) {
        const float sc = inv * lam;
#pragma unroll
        for (int d = 0; d < 4; ++d)
#pragma unroll
            for (int g = 0; g < 4; ++g) *(LAS f32x4*)(xch + 32 * d + 8 * g + 4 * hi) = (f32x4){o[d][4 * g] * sc, o[d][4 * g + 1] * sc, o[d][4 * g + 2] * sc, o[d][4 * g + 3] * sc};
    }
    __syncthreads();
    if (map == 0) {
        float ss = 0.f;
#pragma unroll
        for (int d = 0; d < 4; ++d)
#pragma unroll
            for (int g = 0; g < 4; ++g) { const f32x4 o2 = *(const LAS f32x4*)(xch + 32 * d + 8 * g + 4 * hi);
#pragma unroll
                for (int j = 0; j < 4; ++j) { const float v = o[d][4 * g + j] * inv - o2[j]; o[d][4 * g + j] = v; ss += v * v; } }
        ss = swap_sum(ss);
        const float rn = 0.8f / sqrtf(ss * (1.0f / 128.0f) + EPSF);
        const LAS float* sub = (const LAS float*)(lds + ATT_SUBG);
        lds_u8* stg = lds + (rgp * 32 + r32) * ATT_OPITCH;
#pragma unroll
        for (int d = 0; d < 4; ++d)
#pragma unroll
            for (int g = 0; g < 4; ++g) { const int dd = 32 * d + 8 * g + 4 * hi; const f32x4 sv = *(const LAS f32x4*)(sub + dd);
                u32x2 w; w.x = pk2(o[d][4 * g] * rn * sv.x, o[d][4 * g + 1] * rn * sv.y); w.y = pk2(o[d][4 * g + 2] * rn * sv.z, o[d][4 * g + 3] * rn * sv.w);
                *(LAS u32x2*)(stg + dd * 2) = w; }
    }
    __syncthreads();
    { bf16_t* mixb = (bf16_t*)(a.ws + WS_MIX) + (rowbase + q0) * DM + 512 + h * 128;
#pragma unroll
      for (int k = 0; k < 4; ++k) { const int idx = tid + k * NTHR, row = idx >> 4, c16 = idx & 15;
          *(GAS u32x4*)(mixb + (size_t)row * DM + c16 * 8) = *(const LAS u32x4*)(lds + row * ATT_OPITCH + c16 * 16); } }
    __syncthreads();
#undef ATT_DMA
}

constexpr int RET_BUF = 49152, RET_RT = 2 * RET_BUF, RET_GN = RET_RT + 8192;
static_assert(RET_GN + 2048 <= LDS_SCRATCH, "retention LDS");

__device__ __forceinline__ void ret_unit(const Args& a, lds_u8* lds, int b, int h) {
    int tid_ = threadIdx.x; asm volatile("" : "+v"(tid_));
    const int tid = tid_, lane = tid & 63, r32 = lane & 31, hi = lane >> 5; const int wid = __builtin_amdgcn_readfirstlane(tid >> 6);
    const int rgp = wid & 3, eh = wid >> 2;
    const bf16_t* proj = (const bf16_t*)(a.ws + WS_PROJ);
    const size_t rowbase = (size_t)b * SEQ;
    const double lg = log2(1.0 - exp2(-5.0 - (double)h));
    const float gam = (float)exp2(lg), g127 = (float)exp2(lg * 127.0), g128 = (float)exp2(lg * 128.0);
#define RET_DMA(c, buf) do { const size_t ro = (rowbase + (size_t)(c) * 128) * NIN; lds_u8* bb = lds + (buf) * RET_BUF; \
        _Pragma("unroll") for (int i_ = 0; i_ < 2; ++i_) { const int p_ = 2 * wid + i_; \
            { const int ch = p_ >> 1, rh = p_ & 1; glds16(proj + ro + (size_t)(rh * 64 + lane) * NIN + OFF_RK + h * 64 + ch * 8, bb + ch * 2048 + rh * 1024); } \
            { const int db = p_ >> 3, rg_ = p_ & 7; glds16(proj + ro + (size_t)(rg_ * 16 + (lane >> 2)) * NIN + OFF_RK + h * 64 + db * 32 + (lane & 3) * 8, bb + 16384 + db * 8192 + rg_ * 1024); \
              glds16(proj + ro + (size_t)(rg_ * 16 + (lane >> 2)) * NIN + OFF_RV + h * 64 + db * 32 + (lane & 3) * 8, bb + 32768 + db * 8192 + rg_ * 1024); } } } while (0)
    const int koff = hi * 2048 + r32 * 16;
    const int troff = ((lane >> 4) & 1) * 32 + (lane & 3) * 8 + (4 * hi + ((lane & 15) >> 2)) * 64;
    f32x16 R = f32x16{};
    for (int i = tid; i < 8192 / 16; i += NTHR) *(LAS u32x4*)(lds + RET_RT + i * 16) = (u32x4){0u, 0u, 0u, 0u};
    const float* gn = a.in[3];
    f32x4 gv[4];
#pragma unroll
    for (int g = 0; g < 4; ++g) gv[g] = *(const GAS f32x4*)(gn + h * 64 + eh * 32 + 8 * g + 4 * hi);
    bf16x8 qn[4]; u32x2 svn[4];
#define RET_PREF(c) do { const size_t tk_ = rowbase + (size_t)(c) * 128 + rgp * 32 + r32; const bf16_t* qp_ = proj + tk_ * NIN + OFF_RQ + h * 64 + hi * 8; const bf16_t* sg_ = proj + tk_ * NIN + OFF_RG + h * 64 + eh * 32 + 4 * hi; \
        _Pragma("unroll") for (int s = 0; s < 4; ++s) qn[s] = *(const GAS bf16x8*)(qp_ + s * 16); \
        _Pragma("unroll") for (int g = 0; g < 4; ++g) svn[g] = *(const GAS u32x2*)(sg_ + 8 * g); } while (0)
    RET_PREF(0);
    RET_DMA(0, 0);
    u32x2 wst[4]; bf16_t* wptr = nullptr;
#pragma unroll
    for (int g = 0; g < 4; ++g) wst[g] = (u32x2){0u, 0u};
    for (int c = 0; c < 32; ++c) {
        VM_WAIT(); __syncthreads();
        if (c > 0) {
#pragma unroll
            for (int g = 0; g < 4; ++g) *(GAS u32x2*)(wptr + 8 * g + 4 * hi) = wst[g];
        }
        bf16x8 qf[4]; u32x2 svc[4];
#pragma unroll
        for (int s = 0; s < 4; ++s) { qf[s] = qn[s]; svc[s] = svn[s]; }
        if (c + 1 < 32) { RET_PREF(c + 1); RET_DMA(c + 1, (c + 1) & 1); }
        const lds_u8* bb = lds + (c & 1) * RET_BUF;
        const size_t tok = rowbase + (size_t)c * 128 + rgp * 32 + r32;
        f32x16 O = f32x16{};
#pragma unroll
        for (int s = 0; s < 4; ++s) { const bf16x8 rt = ldsb128(lds + RET_RT + (2 * s + hi) * 1024 + (eh * 32 + r32) * 16); O = MFMA32(rt, qf[s], O); }
        for (int kb = 0; kb <= rgp; ++kb) {
            f32x16 S = f32x16{};
#pragma unroll
            for (int s = 0; s < 4; ++s) { const bf16x8 ka = ldsb128(bb + koff + s * 4096 + (kb * 32) * 16); S = MFMA32(ka, qf[s], S); }
            if (kb == rgp) {
#pragma unroll
                for (int r = 0; r < 16; ++r) S[r] = (crow(r, hi) > r32) ? 0.f : S[r];
            }
            const u32x4 p0 = (u32x4){pk2(S[0], S[1]), pk2(S[2], S[3]), pk2(S[4], S[5]), pk2(S[6], S[7])};
            const u32x4 p1 = (u32x4){pk2(S[8], S[9]), pk2(S[10], S[11]), pk2(S[12], S[13]), pk2(S[14], S[15])};
            const bf16x8 v0 = vfrag(bb + 32768 + eh * 8192 + troff + (2 * kb) * 1024), v1 = vfrag(bb + 32768 + eh * 8192 + troff + (2 * kb + 1) * 1024);
            O = MFMA32(v0, __builtin_bit_cast(bf16x8, p0), O); O = MFMA32(v1, __builtin_bit_cast(bf16x8, p1), O);
        }
        if (rgp < 2) {
            f32x16 T = f32x16{};
#pragma unroll
            for (int ks = 0; ks < 8; ++ks) { const bf16x8 kt = vfrag(bb + 16384 + rgp * 8192 + troff + ks * 1024), vv = vfrag(bb + 32768 + eh * 8192 + troff + ks * 1024); T = MFMA32(kt, vv, T); }
#pragma unroll
            for (int r = 0; r < 16; ++r) R[r] = R[r] * g128 + T[r] * g127;
        }
        float s1 = 0.f, s2 = 0.f;
#pragma unroll
        for (int r = 0; r < 16; ++r) { s1 += O[r]; s2 += O[r] * O[r]; }
        s1 = swap_sum(s1); s2 = swap_sum(s2);
        LAS f32x2* gx = (LAS f32x2*)(lds + RET_GN);
        if (hi == 0) gx[(rgp * 32 + r32) * 2 + eh] = (f32x2){s1, s2};
        __syncthreads();
        if (rgp < 2) {
#pragma unroll
            for (int g = 0; g < 4; ++g) { u32x2 w; w.x = pk2(R[4 * g] * gam, R[4 * g + 1] * gam); w.y = pk2(R[4 * g + 2] * gam, R[4 * g + 3] * gam);
                *(LAS u32x2*)(lds + RET_RT + (rgp * 4 + g) * 1024 + (eh * 32 + r32) * 16 + hi * 8) = w; }
        }
        const f32x2 ga = gx[(rgp * 32 + r32) * 2], gb = gx[(rgp * 32 + r32) * 2 + 1];
        const float mean = (ga.x + gb.x) * (1.0f / 64.0f), var = (ga.y + gb.y) * (1.0f / 64.0f) - mean * mean;
        const float rstd = 1.0f / sqrtf(__builtin_fmaxf(var, 0.f) + EPSF);
        bf16_t* mixp = (bf16_t*)(a.ws + WS_MIX) + tok * DM + h * 64 + eh * 32;
#pragma unroll
        for (int g = 0; g < 4; ++g) { const int e = 8 * g + 4 * hi; const u32x2 sv = svc[g];
            const float y0 = (O[4 * g] - mean) * rstd * gv[g].x * __uint_as_float(sv.x << 16), y1 = (O[4 * g + 1] - mean) * rstd * gv[g].y * __uint_as_float(sv.x & 0xffff0000u);
            const float y2 = (O[4 * g + 2] - mean) * rstd * gv[g].z * __uint_as_float(sv.y << 16), y3 = (O[4 * g + 3] - mean) * rstd * gv[g].w * __uint_as_float(sv.y & 0xffff0000u);
            wst[g].x = pk2(y0, y1); wst[g].y = pk2(y2, y3); }
        wptr = mixp;
    }
#pragma unroll
    for (int g = 0; g < 4; ++g) *(GAS u32x2*)(wptr + 8 * g + 4 * hi) = wst[g];
    __syncthreads();
#undef RET_DMA
#undef RET_PREF
}


#define CAS_DESC(x, y) do { const float hi_ = __builtin_fmaxf(x, y), lo_ = __builtin_fminf(x, y); x = hi_; y = lo_; } while (0)
#define CAS_ASC(x, y) do { const float hi_ = __builtin_fmaxf(x, y), lo_ = __builtin_fminf(x, y); x = lo_; y = hi_; } while (0)
__device__ __forceinline__ void sort16_desc(float (&v)[16]) {
#pragma unroll
    for (int k = 2; k <= 16; k <<= 1)
#pragma unroll
        for (int j = k >> 1; j > 0; j >>= 1)
#pragma unroll
            for (int i = 0; i < 16; ++i) { const int l = i ^ j; if (l > i) { if ((i & k) == 0) CAS_DESC(v[i], v[l]); else CAS_ASC(v[i], v[l]); } }
}
__device__ __forceinline__ void bitonic_merge16_desc(float (&v)[16]) {
#pragma unroll
    for (int j = 8; j > 0; j >>= 1)
#pragma unroll
        for (int i = 0; i < 16; ++i) { const int l = i ^ j; if (l > i) CAS_DESC(v[i], v[l]); }
}
__device__ __forceinline__ void merge_top16(float (&a)[16], const float (&b)[16]) {
#pragma unroll
    for (int i = 0; i < 16; ++i) a[i] = __builtin_fmaxf(a[i], b[15 - i]);
    bitonic_merge16_desc(a);
}
__device__ __forceinline__ unsigned pack_idx4(const float (&v)[16], int w) {
    return (__float_as_uint(v[4 * w]) & 127u) | ((__float_as_uint(v[4 * w + 1]) & 127u) << 8) | ((__float_as_uint(v[4 * w + 2]) & 127u) << 16) | ((__float_as_uint(v[4 * w + 3]) & 127u) << 24);
}
__device__ __forceinline__ unsigned lookup_idx(const unsigned (&pk)[4], unsigned i) {
    const unsigned w = i >> 2; unsigned s = w == 0 ? pk[0] : (w == 1 ? pk[1] : (w == 2 ? pk[2] : pk[3]));
    return (s >> ((i & 3u) * 8u)) & 127u;
}

constexpr int P5_KEYB = 32768;
__device__ __forceinline__ void p5_topk(const Args& a, lds_u8* lds) {
    const int tid = threadIdx.x, lane = tid & 63, r32 = lane & 31, hi = lane >> 5; const int wid = __builtin_amdgcn_readfirstlane(tid >> 6);
    const int hp = blockIdx.x & 3, wgi = blockIdx.x >> 2, nwg = (gridDim.x + 3 - hp) / 4;
    const bf16_t* keys = (const bf16_t*)(a.ws + WS_KEYS) + (size_t)hp * 4 * 128 * 128;
    {
        static_assert(4 * 128 * 16 == 16 * NTHR, "key image copy");
        u32x4 kv[16];
#pragma unroll
        for (int j = 0; j < 16; ++j) { const int i = tid + j * NTHR, t = i >> 11, key = (i >> 4) & 127, c = i & 15; kv[j] = *(const GAS u32x4*)(keys + ((size_t)t * 128 + key) * 128 + c * 8); }
#pragma unroll
        for (int j = 0; j < 16; ++j) { const int i = tid + j * NTHR, t = i >> 11, key = (i >> 4) & 127, c = i & 15; *(LAS u32x4*)(lds + t * P5_KEYB + c * 2048 + key * 16) = kv[j]; }
    }
    __syncthreads();
    const bf16_t* Q = (const bf16_t*)(a.ws + WS_PROJ);
    int* IDX = (int*)(a.ws + WS_IDX); float* GATE = (float*)(a.ws + WS_GATE);
    const int tg0 = wgi * NWAVES + wid, tgs = nwg * NWAVES;
    const int ntask = (tg0 < MTOK / 32) ? 4 * ((MTOK / 32 - 1 - tg0) / tgs + 1) : 0;
#define P5_QLOAD(QF, k_) do { const int tg_ = tg0 + ((k_) >> 2) * tgs, t_ = (k_) & 3; \
        const bf16_t* qp = Q + (size_t)(tg_ * 32 + r32) * NQ + (2 * hp + (t_ >> 1)) * 256 + (t_ & 1) * 128 + hi * 8; \
        _Pragma("unroll") for (int s = 0; s < 8; ++s) QF[s] = *(const GAS bf16x8*)(qp + s * 16); } while (0)
    float la[16], lb[16];
#pragma unroll
    for (int r = 0; r < 16; ++r) { la[r] = 0.f; lb[r] = 0.f; }
    bf16x8 qf[8], qn[8];
    if (ntask > 0) P5_QLOAD(qf, 0);
#pragma unroll 1
    for (int k = 0; k < ntask; ++k) {
      {
        const int tg = tg0 + (k >> 2) * tgs, t = k & 3;
        P5_QLOAD(qn, (k + 1 < ntask ? k + 1 : k));
        {
            float top[16];
#pragma unroll
            for (int kb = 0; kb < 4; ++kb) {
                f32x16 S = f32x16{};
#pragma unroll
                for (int s = 0; s < 8; ++s) { const bf16x8 kf = ldsb128(lds + t * P5_KEYB + (2 * s + hi) * 2048 + (kb * 32 + r32) * 16); S = MFMA32(kf, qf[s], S); }
                float v[16];
#pragma unroll
                for (int r = 0; r < 16; ++r) v[r] = __uint_as_float((__float_as_uint(S[r]) & ~127u) | (unsigned)(kb * 32 + (r & 3) + 8 * (r >> 2)) | ((unsigned)hi << 2));
                sort16_desc(v);
                if (kb == 0) {
#pragma unroll
                    for (int r = 0; r < 16; ++r) top[r] = v[r];
                } else merge_top16(top, v);
            }
            float oth[16];
#pragma unroll
            for (int r = 0; r < 16; ++r) { auto rr = __builtin_amdgcn_permlane32_swap(__float_as_uint(top[r]), __float_as_uint(top[r]), false, false); top[r] = __uint_as_float(rr[0]); oth[r] = __uint_as_float(rr[1]); }
            merge_top16(top, oth);
            const bool ka = ((t >> 1) == hi) && ((t & 1) == 0), kb2 = ((t >> 1) == hi) && ((t & 1) == 1);
#pragma unroll
            for (int r = 0; r < 16; ++r) { la[r] = ka ? top[r] : la[r]; lb[r] = kb2 ? top[r] : lb[r]; }
        }
#pragma unroll
        for (int s2 = 0; s2 < 8; ++s2) qf[s2] = qn[s2];
        if (t != 3) continue;
        unsigned pa[4], pb[4];
#pragma unroll
        for (int w = 0; w < 4; ++w) { pa[w] = pack_idx4(la, w); pb[w] = pack_idx4(lb, w); }
        float c0[16], c1[16];
#define CAND(i, j) __uint_as_float((__float_as_uint(la[i] + lb[j]) & ~255u) | (unsigned)((i) * 16 + (j)))
        const float NEG = -INFINITY;
        c0[0] = CAND(0, 0); c0[1] = CAND(0, 1); c0[2] = CAND(0, 2); c0[3] = CAND(0, 3); c0[4] = CAND(0, 4); c0[5] = CAND(0, 5); c0[6] = CAND(0, 6); c0[7] = CAND(0, 7);
        c0[8] = CAND(0, 8); c0[9] = CAND(0, 9); c0[10] = CAND(0, 10); c0[11] = CAND(0, 11); c0[12] = CAND(0, 12); c0[13] = CAND(0, 13); c0[14] = CAND(0, 14); c0[15] = CAND(0, 15);
        sort16_desc(c0);
        c1[0] = CAND(1, 0); c1[1] = CAND(1, 1); c1[2] = CAND(1, 2); c1[3] = CAND(1, 3); c1[4] = CAND(1, 4); c1[5] = CAND(1, 5); c1[6] = CAND(1, 6); c1[7] = CAND(1, 7);
        c1[8] = CAND(2, 0); c1[9] = CAND(2, 1); c1[10] = CAND(2, 2); c1[11] = CAND(2, 3); c1[12] = CAND(2, 4); c1[13] = CAND(3, 0); c1[14] = CAND(3, 1); c1[15] = CAND(3, 2);
        sort16_desc(c1); merge_top16(c0, c1);
        asm volatile("" : "+v"(c0[0]), "+v"(c0[15]));
        c1[0] = CAND(3, 3); c1[1] = CAND(4, 0); c1[2] = CAND(4, 1); c1[3] = CAND(4, 2); c1[4] = CAND(5, 0); c1[5] = CAND(5, 1); c1[6] = CAND(6, 0); c1[7] = CAND(6, 1);
        c1[8] = CAND(7, 0); c1[9] = CAND(7, 1); c1[10] = CAND(8, 0); c1[11] = CAND(9, 0); c1[12] = CAND(10, 0); c1[13] = CAND(11, 0); c1[14] = CAND(12, 0); c1[15] = CAND(13, 0);
        sort16_desc(c1); merge_top16(c0, c1);
        asm volatile("" : "+v"(c0[0]), "+v"(c0[15]));
        c1[0] = CAND(14, 0); c1[1] = CAND(15, 0);
#pragma unroll
        for (int r = 2; r < 16; ++r) c1[r] = NEG;
#undef CAND
        sort16_desc(c1); merge_top16(c0, c1);
        float gsum = 0.f, gv[16]; int ex[16];
        const float mx = __uint_as_float(__float_as_uint(c0[0]) & ~255u);
#pragma unroll
        for (int r = 0; r < 16; ++r) { const unsigned bits = __float_as_uint(c0[r]); const float val = __uint_as_float(bits & ~255u);
            gv[r] = __expf(val - mx); gsum += gv[r];
            ex[r] = (int)(lookup_idx(pa, (bits >> 4) & 15u) * 128u + lookup_idx(pb, bits & 15u)); }
        const float ginv = 1.0f / gsum;
        const size_t ob = (size_t)(tg * 32 + r32) * 128 + (2 * hp + hi) * 16;
#pragma unroll
        for (int r = 0; r < 16; r += 4) { *(GAS u32x4*)(IDX + ob + r) = (u32x4){(unsigned)ex[r], (unsigned)ex[r + 1], (unsigned)ex[r + 2], (unsigned)ex[r + 3]};
            *(GAS f32x4*)(GATE + ob + r) = (f32x4){gv[r] * ginv, gv[r + 1] * ginv, gv[r + 2] * ginv, gv[r + 3] * ginv}; }
      }
    }
#undef P5_QLOAD
    __syncthreads();
}

typedef long i64_t;
typedef int v8i_t __attribute__((ext_vector_type(8)));
#define MFMA16F8(a, b, c) __builtin_amdgcn_mfma_f32_16x16x32_fp8_fp8(a, b, c, 0, 0, 0)
constexpr float P6_SD = 64.f, P6_SX = 8.f, P6_SU = 16.f, P6_SA = 64.f, P6_SU4 = 6.f;
constexpr size_t P6_SLICEB = (size_t)NEXP * 128;
__device__ __forceinline__ unsigned pk4_fp8(float a, float b, float c, float d) { int w = __builtin_amdgcn_cvt_pk_fp8_f32(a, b, 0, false); w = __builtin_amdgcn_cvt_pk_fp8_f32(c, d, w, true); return (unsigned)w; }
__device__ __forceinline__ float fp8_byte0(unsigned w) { return __builtin_amdgcn_cvt_f32_fp8((int)w, 0); }
constexpr int P6_WSCR = 3328;
__device__ __forceinline__ void p6_token(const Args& a, lds_u8* wl, int tok, int lane, float* OUTW) {
    const int n = lane & 15, g = lane >> 4;
    const unsigned char* ws = a.ws;
    const unsigned char* WD = ws + WS_WD; const unsigned char* WU = ws + WS_WU;
    const int* IDX = (const int*)(ws + WS_IDX) + (size_t)tok * 128; const float* GATE = (const float*)(ws + WS_GATE) + (size_t)tok * 128;
    const bf16_t* X1 = (const bf16_t*)(ws + WS_X1B) + (size_t)tok * DM;
    {
#pragma unroll
        for (int j = 0; j < 4; ++j) {
            const u32x2 xw_ = *(const GAS u32x2*)(X1 + 256 * j + 4 * lane); const f32x4 v = (f32x4){__uint_as_float(xw_.x << 16), __uint_as_float(xw_.x & 0xffff0000u), __uint_as_float(xw_.y << 16), __uint_as_float(xw_.y & 0xffff0000u)} * P6_SX;
            const unsigned hw = pk4_fp8(v.x, v.y, v.z, v.w);
            const float r0 = v.x - __builtin_amdgcn_cvt_f32_fp8((int)hw, 0), r1 = v.y - __builtin_amdgcn_cvt_f32_fp8((int)hw, 1), r2 = v.z - __builtin_amdgcn_cvt_f32_fp8((int)hw, 2), r3 = v.w - __builtin_amdgcn_cvt_f32_fp8((int)hw, 3);
            const unsigned lw = pk4_fp8(r0 * 16.f, r1 * 16.f, r2 * 16.f, r3 * 16.f);
            *(LAS unsigned*)(wl + 256 * j + 4 * lane) = hw; *(LAS unsigned*)(wl + 1024 + 256 * j + 4 * lane) = lw;
        }
        const u32x2 iv = *(const GAS u32x2*)(IDX + lane * 2); *(LAS u32x2*)(wl + 2048 + lane * 8) = iv;
    }
    const float rs2 = row_rs2((const bf16_t*)(ws + WS_SSQ), tok);
    LDS_WAIT();
    const LAS int* idxl = (const LAS int*)(wl + 2048); LAS unsigned short* actl = (LAS unsigned short*)(wl + 2560);
    const int xoff = (n & 1) * 1024 + 16 * g;
#pragma unroll 1
    for (int eg = 0; eg < 8; ++eg) {
        const int e = idxl[eg * 16 + n];
        const unsigned char* rp = WD + (size_t)e * 128 + 16 * g;
        f32x4 acc = (f32x4){0.f, 0.f, 0.f, 0.f};
        u32x4 bq[16];
#pragma unroll
        for (int sl = 0; sl < 8; ++sl) { bq[2 * sl] = *(const GAS u32x4*)(rp + sl * P6_SLICEB); bq[2 * sl + 1] = *(const GAS u32x4*)(rp + sl * P6_SLICEB + 64); }
#pragma unroll
        for (int sl = 0; sl < 8; ++sl)
#pragma unroll
            for (int hf = 0; hf < 2; ++hf) {
                const u32x4 xa = *(const LAS u32x4*)(wl + xoff + sl * 128 + hf * 64); const u32x4 bb = bq[2 * sl + hf];
                acc = MFMA16F8((i64_t)(((unsigned long long)xa.y << 32) | xa.x), (i64_t)(((unsigned long long)bb.y << 32) | bb.x), acc);
                acc = MFMA16F8((i64_t)(((unsigned long long)xa.w << 32) | xa.z), (i64_t)(((unsigned long long)bb.w << 32) | bb.z), acc);
            }
        const float av = (acc[0] + acc[1] * 0.0625f) * (rs2 * (1.0f / (P6_SD * P6_SX)));
        const float act = 0.5f * av * (1.0f + erff(av * 0.70710678118654752f)) * GATE[eg * 16 + n] * P6_SA;
        const unsigned hb = pk4_fp8(act, 0.f, 0.f, 0.f) & 0xffu;
        const unsigned lb = pk4_fp8((act - fp8_byte0(hb)) * 16.f, 0.f, 0.f, 0.f) & 0xffu;
        if (g == 0) actl[eg * 16 + n] = (unsigned short)(hb | (lb << 8));
    }
    LDS_WAIT();
    const int pos = n & 7, sel = n >> 3;
    float ss = 0.f;
    const bool owner = (n < 8) && (g < 2);
#pragma unroll 1
    for (int sl = 0; sl < 8; ++sl) {
        f32x4 ah[2], al[2];
#pragma unroll
        for (int s = 0; s < 2; ++s) { ah[s] = (f32x4){0.f, 0.f, 0.f, 0.f}; al[s] = (f32x4){0.f, 0.f, 0.f, 0.f}; }
        u32x4 bq[16]; unsigned av[16];
#pragma unroll
        for (int q = 0; q < 16; ++q) { const int ei = 8 * q + 4 * sel + g; const int e = idxl[ei]; av[q] = actl[ei];
            bq[q] = *(const GAS u32x4*)(WU + sl * P6_SLICEB + (size_t)e * 128 + 16 * pos); }
#pragma unroll
        for (int q = 0; q < 16; ++q) {
            const unsigned long long ahv = (unsigned long long)(av[q] & 0xffu) << (8 * pos), alv = (unsigned long long)(av[q] >> 8) << (8 * pos);
            const u32x4 bb = bq[q];
            const i64_t b0 = (i64_t)(((unsigned long long)bb.y << 32) | bb.x), b1 = (i64_t)(((unsigned long long)bb.w << 32) | bb.z);
            ah[0] = MFMA16F8((i64_t)ahv, b0, ah[0]); al[0] = MFMA16F8((i64_t)alv, b0, al[0]);
            ah[1] = MFMA16F8((i64_t)ahv, b1, ah[1]); al[1] = MFMA16F8((i64_t)alv, b1, al[1]);
        }
#pragma unroll
        for (int s = 0; s < 2; ++s) {
            f32x4 t = ah[s] + al[s] * 0.0625f, u;
#pragma unroll
            for (int r = 0; r < 4; ++r) u[r] = __shfl(t[r], (lane + 40) & 63);
            const int col = 128 * sl + 16 * pos + 8 * s + 4 * (g & 1);
            const u32x2 xq_ = *(const GAS u32x2*)(X1 + col); const f32x4 xv = (f32x4){__uint_as_float(xq_.x << 16), __uint_as_float(xq_.x & 0xffff0000u), __uint_as_float(xq_.y << 16), __uint_as_float(xq_.y & 0xffff0000u)};
            const f32x4 x2 = xv + (t + u) * (1.0f / (P6_SA * P6_SU));
            if (owner) { ss += (x2.x * x2.x + x2.y * x2.y) + (x2.z * x2.z + x2.w * x2.w); *(GAS f32x4*)(OUTW + (size_t)tok * DM + col) = x2; }
        }
    }
    ss = wave_sum(ss);
    const float rn = 1.0f / sqrtf(ss * (1.0f / DM) + EPSF);
    const float* nf = a.in[16];
    if (owner) {
#pragma unroll
        for (int sl = 0; sl < 8; ++sl)
#pragma unroll
            for (int s = 0; s < 2; ++s) { const int col = 128 * sl + 16 * pos + 8 * s + 4 * g; const f32x4 gv = *(const GAS f32x4*)(nf + col);
                GAS f32x4* op = (GAS f32x4*)(OUTW + (size_t)tok * DM + col); *op = *op * rn * gv; }
    }
}

constexpr int P6S_WAVE = 16384 + 512 + 128;
static_assert(NWAVES * P6S_WAVE <= LDS_SCRATCH, "P6 LDS");
__device__ __forceinline__ float gelu_as(float v) {
    const float av = __builtin_fabsf(v), t = __builtin_amdgcn_rcpf(av * 0.2316418882f + 1.0f);
    float q = t * 0.5307027145f + (-0.7265760135f); q = q * t + 0.7107068705f; q = q * t + (-0.142248368f); q = q * t + 0.127414796f; q = q * t;
    const float e = __builtin_amdgcn_exp2f((v * v) * (-0.72134752044f));
    const float m = v * (q * e);
    return v < 0.f ? m : v - m;
}
template <int EMASK, int PARTS>
__device__ __forceinline__ void p6_slices(const Args& a, lds_u8* wl, int tok0, int lane) {
    const int n = lane & 15, g = lane >> 4;
    const unsigned char* ws = a.ws;
    const unsigned char* WD = ws + WS_WD; const unsigned char* WU = ws + WS_WU;
    LAS float* aacc = (LAS float*)wl; LAS unsigned short* idl = (LAS unsigned short*)(wl + 8192); LAS unsigned short* actl = (LAS unsigned short*)(wl + 12288);
    lds_u8* xs = wl + 16384; LAS float* ssl = (LAS float*)(wl + 16384 + 512); LAS float* r2l = ssl + 16;
    {
        u32x2 iv[16];
#pragma unroll
        for (int t = 0; t < 16; ++t) iv[t] = *(const GAS u32x2*)((const int*)(ws + WS_IDX) + (size_t)(tok0 + t) * 128 + lane * 2);
#pragma unroll
        for (int t = 0; t < 16; ++t) {
            *(LAS unsigned*)(wl + 8192 + t * 256 + lane * 4) = (iv[t].x & 0xffffu) | (iv[t].y << 16);
            *(LAS f32x2*)(wl + t * 512 + lane * 8) = (f32x2){0.f, 0.f};
        }
    }
    if (lane < 16) { ssl[lane] = 0.f; r2l[lane] = row_rs2((const bf16_t*)(ws + WS_SSQ), tok0 + lane); }
    unsigned char* X4 = (unsigned char*)a.ws + WS_XB;
#pragma unroll 1
    for (int t8 = 0; t8 < 16; t8 += 8) {
    u32x4 xwa[8], xwb[8];
#pragma unroll
    for (int tt = 0; tt < 8; ++tt) { const bf16_t* xr = (const bf16_t*)(ws + WS_X1B) + (size_t)(tok0 + t8 + tt) * DM + 16 * lane; xwa[tt] = *(const GAS u32x4*)xr; xwb[tt] = *(const GAS u32x4*)(xr + 8); }
#pragma unroll
    for (int tt = 0; tt < 8; ++tt) {
        const int t = t8 + tt;
        const u32x4 xw0 = xwa[tt], xw1 = xwb[tt];
        float rr[16];
#pragma unroll
        for (int j = 0; j < 4; ++j) { rr[2 * j] = __uint_as_float(xw0[j] << 16); rr[2 * j + 1] = __uint_as_float(xw0[j] & 0xffff0000u); rr[8 + 2 * j] = __uint_as_float(xw1[j] << 16); rr[9 + 2 * j] = __uint_as_float(xw1[j] & 0xffff0000u); }
#pragma unroll
        for (int st = 0; st < 4; ++st) {
            unsigned w0 = 0u, w1 = 0u;
#define P6_Q4(p_) do { w0 = __builtin_amdgcn_cvt_scalef32_pk_fp4_f32(w0, rr[2 * (p_)], rr[2 * (p_) + 1], 1.0f, p_); w1 = __builtin_amdgcn_cvt_scalef32_pk_fp4_f32(w1, rr[8 + 2 * (p_)], rr[9 + 2 * (p_)], 1.0f, p_); } while (0)
            P6_Q4(0); P6_Q4(1); P6_Q4(2); P6_Q4(3);
#undef P6_Q4
#define P6_D4(p_) do { const f32x2 d0 = __builtin_amdgcn_cvt_scalef32_pk_f32_fp4(w0, 1.0f, p_), d1 = __builtin_amdgcn_cvt_scalef32_pk_f32_fp4(w1, 1.0f, p_); \
                rr[2 * (p_)] = (rr[2 * (p_)] - d0.x) * 4.0f; rr[2 * (p_) + 1] = (rr[2 * (p_) + 1] - d0.y) * 4.0f; rr[8 + 2 * (p_)] = (rr[8 + 2 * (p_)] - d1.x) * 4.0f; rr[9 + 2 * (p_)] = (rr[9 + 2 * (p_)] - d1.y) * 4.0f; } while (0)
            P6_D4(0); P6_D4(1); P6_D4(2); P6_D4(3);
#undef P6_D4
            *(GAS u32x2*)(X4 + (size_t)(tok0 + t) * 2048 + st * 512 + 8 * lane) = (u32x2){w0, w1};
        }
    }
    }
    LDS_WAIT(); VM_WAIT();
    const int xoff = (n & 3) * 128 + 16 * g;
    const int bpa = 4 * (4 * (lane & 15) + (lane >> 4));
#define MFMA4(a_, b_, c_) __builtin_amdgcn_mfma_scale_f32_16x16x128_f8f6f4(a_, b_, c_, 4  , 4  , 0, 0, 0, 0)
#define P6_DLOAD(BQ, XV, it_) do { const int sl_ = (it_) >> 4, t_ = (it_) & 15; \
        _Pragma("unroll") for (int eg = 0; eg < 8; ++eg) { const int e_ = idl[t_ * 128 + eg * 16 + (lane >> 2)] & EMASK; const unsigned char* rp_ = WD + sl_ * P6_SLICEB + (size_t)e_ * 128 + 16 * (lane & 3); \
            BQ[2 * eg] = *(const GAS u32x4*)rp_; BQ[2 * eg + 1] = *(const GAS u32x4*)(rp_ + 64); } \
        XV = *(const GAS u32x2*)(X4 + (size_t)(tok0 + t_) * 2048 + (lane >> 4) * 512 + sl_ * 128 + 8 * (lane & 15)); } while (0)
#define P6_DCOMP(BQ, XV, it_) do { const int t_ = (it_) & 15; \
        *(LAS u32x2*)(xs + (lane >> 4) * 128 + 8 * (lane & 15)) = XV; \
        LDS_WAIT(); \
        const u32x4 xa0 = *(const LAS u32x4*)(xs + xoff), xa1 = *(const LAS u32x4*)(xs + xoff + 64); \
        const v8i_t A0 = (v8i_t){(int)xa0.x, (int)xa0.y, (int)xa0.z, (int)xa0.w, 0, 0, 0, 0}; \
        const v8i_t A1 = (v8i_t){(int)xa1.x, (int)xa1.y, (int)xa1.z, (int)xa1.w, 0, 0, 0, 0}; \
        _Pragma("unroll") for (int eg = 0; eg < 8; ++eg) { f32x4 acc = (f32x4){0.f, 0.f, 0.f, 0.f}; v8i_t b0 = (v8i_t){0, 0, 0, 0, 0, 0, 0, 0}, b1 = (v8i_t){0, 0, 0, 0, 0, 0, 0, 0}; \
            _Pragma("unroll") for (int w_ = 0; w_ < 4; ++w_) { b0[w_] = __builtin_amdgcn_ds_bpermute(bpa, (int)BQ[2 * eg][w_]); b1[w_] = __builtin_amdgcn_ds_bpermute(bpa, (int)BQ[2 * eg + 1][w_]); } \
            acc = MFMA4(A0, b0, acc); acc = MFMA4(A1, b1, acc); \
            float r_ = (acc[0] + acc[1] * 0.25f) + (acc[2] * 0.0625f + acc[3] * 0.015625f); asm volatile("" : "+v"(r_)); \
            if (g == 0) aacc[t_ * 128 + eg * 16 + n] += r_; } \
        LDS_WAIT(); } while (0)
    if (PARTS & 1) {
        u32x4 bqA[16], bqB[16]; u32x2 xvA, xvB;
        P6_DLOAD(bqA, xvA, 0);
#pragma unroll 1
        for (int it = 0; it < 64; it += 2) {
            P6_DLOAD(bqB, xvB, it + 1);
            P6_DCOMP(bqA, xvA, it);
            P6_DLOAD(bqA, xvA, (it + 2 < 64 ? it + 2 : it));
            P6_DCOMP(bqB, xvB, it + 1);
        }
    }
#undef MFMA4
#undef P6_DLOAD
#undef P6_DCOMP
    int lane_g = lane; asm volatile("" : "+v"(lane_g));
    float gts[16][2];
#pragma unroll
    for (int t = 0; t < 16; ++t) { gts[t][0] = ((const float*)(ws + WS_GATE))[(size_t)(tok0 + t) * 128 + lane_g]; gts[t][1] = ((const float*)(ws + WS_GATE))[(size_t)(tok0 + t) * 128 + lane_g + 64]; }
#pragma unroll
    for (int t = 0; t < 16; ++t) {
        const float sc = r2l[t] * (1.0f / P6_SD);
#pragma unroll
        for (int j = 0; j < 2; ++j) { const int ei = lane_g + 64 * j; const float av = aacc[t * 128 + ei] * sc;
            const float act = gelu_as(av) * gts[t][j];
            const unsigned ab = __float_as_uint(act), eb = (ab >> 23) & 255u;
            unsigned pk = 0u;
            if (eb > 4u) {
                const float m = __uint_as_float((ab & 0x807fffffu) | (128u << 23));
                const unsigned w0 = __builtin_amdgcn_cvt_scalef32_pk_fp4_f32(0u, m, 0.f, 1.0f, 0);
                const f32x2 d0 = __builtin_amdgcn_cvt_scalef32_pk_f32_fp4(w0, 1.0f, 0);
                const unsigned w1 = __builtin_amdgcn_cvt_scalef32_pk_fp4_f32(0u, (m - d0.x) * 4.0f, 0.f, 1.0f, 0);
                pk = (w0 & 15u) | ((w1 & 15u) << 4) | ((eb - 1u) << 8);
            }
            actl[t * 128 + ei] = (unsigned short)pk; }
    }
    LDS_WAIT();
    int lane_u = lane; asm volatile("" : "+v"(lane_u));
    const float* nf = a.in[16];
    const int ui = lane_u & 31, ug = lane_u >> 5, ush = 4 * (ui & 7);
    const unsigned uk0 = (ui >> 3) == 0 ? 0xffffffffu : 0u, uk1 = (ui >> 3) == 1 ? 0xffffffffu : 0u, uk2 = (ui >> 3) == 2 ? 0xffffffffu : 0u, uk3 = (ui >> 3) == 3 ? 0xffffffffu : 0u;
#ifndef P6_DIGITS
#define P6_DIGITS 2
#endif
#define MFMA32S(a_, b_, c_, sa_) __builtin_amdgcn_mfma_scale_f32_32x32x64_f8f6f4(a_, b_, c_, 4, 4, 0, sa_, 0, 127)
#ifndef P6_UPROBE
#define P6_UPROBE 0
#endif
#define P6_ULOAD(BQ, sq_) do { const int t_ = (sq_) >> 3, qs_ = (sq_) & 7; \
        if (!((P6_UPROBE & 1) && PARTS == 2 && EMASK != 0xffff)) \
        _Pragma("unroll") for (int q = 0; q < 8; ++q) { const int e_ = idl[t_ * 128 + 2 * (8 * qs_ + q) + ug] & EMASK; \
            BQ[q] = *(const GAS u32x4*)(WU + (size_t)e_ * 512 + 16 * ui); } } while (0)
#define P6_UMMA(BQ, sq_) do { const int t_ = (sq_) >> 3, qs_ = (sq_) & 7; \
        _Pragma("unroll") for (int q = 0; q < 8; ++q) { \
            const unsigned av_ = actl[t_ * 128 + 2 * (8 * qs_ + q) + ug]; \
            const unsigned w0_ = (av_ & 15u) << ush, w1_ = ((av_ >> 4) & 15u) << ush; const int s0_ = (int)(av_ >> 8), s1_ = s0_ - 2; \
            const u32x4 bb = BQ[q]; const v8i_t B_ = (v8i_t){(int)bb.x, (int)bb.y, (int)bb.z, (int)bb.w, 0, 0, 0, 0}; \
            if ((P6_UPROBE & 2) && PARTS == 2) { asm volatile("" :: "v"(w0_ & uk0), "v"(w0_ & uk1), "v"(w0_ & uk2), "v"(w0_ & uk3), "v"(w1_ & uk0), "v"(w1_ & uk1), "v"(w1_ & uk2), "v"(w1_ & uk3), "v"(bb), "v"(s0_), "v"(s1_)); continue; } \
            uacc = MFMA32S(((v8i_t){(int)(w0_ & uk0), (int)(w0_ & uk1), (int)(w0_ & uk2), (int)(w0_ & uk3), 0, 0, 0, 0}), B_, uacc, s0_); \
            if (P6_DIGITS == 2) uacc = MFMA32S(((v8i_t){(int)(w1_ & uk0), (int)(w1_ & uk1), (int)(w1_ & uk2), (int)(w1_ & uk3), 0, 0, 0, 0}), B_, uacc, s1_); } } while (0)
    f32x4 gvu[4];
#pragma unroll
    for (int gq = 0; gq < 4; ++gq) gvu[gq] = *(const GAS f32x4*)(nf + 32 * ui + 4 * ug + 8 * gq);
    u32x2 xqn[4];
#define P6_UXPREF(t_) do { const bf16_t* xrow_ = (const bf16_t*)(ws + WS_X1B) + (size_t)(tok0 + (t_)) * DM + 32 * ui + 4 * ug; \
        _Pragma("unroll") for (int gq = 0; gq < 4; ++gq) xqn[gq] = *(const GAS u32x2*)(xrow_ + 8 * gq); } while (0)
#define P6_UEPI(sq_) do { const int t_ = (sq_) >> 3; \
        f32x4 x2[4]; float ss = 0.f; \
        _Pragma("unroll") for (int gq = 0; gq < 4; ++gq) { \
            const u32x2 xq_ = xqn[gq]; \
            x2[gq] = (f32x4){__uint_as_float(xq_.x << 16), __uint_as_float(xq_.x & 0xffff0000u), __uint_as_float(xq_.y << 16), __uint_as_float(xq_.y & 0xffff0000u)} \
                + (f32x4){uacc[4 * gq], uacc[4 * gq + 1], uacc[4 * gq + 2], uacc[4 * gq + 3]} * (1.0f / P6_SU4); \
            ss += (x2[gq].x * x2[gq].x + x2[gq].y * x2[gq].y) + (x2[gq].z * x2[gq].z + x2[gq].w * x2[gq].w); } \
        const float rn = 1.0f / sqrtf(wave_sum(ss) * (1.0f / DM) + EPSF);     \
          \
        _Pragma("unroll") for (int gq = 0; gq < 4; ++gq) *(LAS f32x4*)(wl + ui * 144 + 32 * gq + 16 * ug) = x2[gq] * rn * gvu[gq]; \
        _Pragma("unroll") for (int k = 0; k < 4; ++k) { const int d_ = 4 * lane_u + 256 * k; const f32x4 ov_ = *(const LAS f32x4*)(wl + (d_ >> 5) * 144 + (d_ & 31) * 4); \
            if ((P6_UPROBE & 8) && PARTS == 2) asm volatile("" :: "v"(ov_)); else __builtin_nontemporal_store(ov_, (GAS f32x4*)(a.out + (size_t)(tok0 + t_) * DM + d_)); } \
        uacc = f32x16{}; } while (0)
    if (PARTS & 2) {
        u32x4 bqA[8], bqB[8]; f32x16 uacc = f32x16{};
        if ((P6_UPROBE & 1) && PARTS == 2 && EMASK != 0xffff) {
#pragma unroll
            for (int q = 0; q < 8; ++q) { bqA[q] = (u32x4){(unsigned)lane, 1u, 2u, 3u}; bqB[q] = bqA[q]; } }
        P6_ULOAD(bqA, 0);
#pragma unroll 1
        for (int sq = 0; sq < 128; sq += 2) {
            if ((sq & 7) == 0) P6_UXPREF(sq >> 3);
            P6_ULOAD(bqB, sq + 1);
            P6_UMMA(bqA, sq);
            P6_ULOAD(bqA, (sq + 2 < 128 ? sq + 2 : sq));
            P6_UMMA(bqB, sq + 1);
            if (((sq + 1) & 7) == 7) { if ((P6_UPROBE & 4) && PARTS == 2) { asm volatile("" : "+v"(uacc)); uacc = f32x16{}; } else P6_UEPI(sq + 1); }
        }
    }
#undef P6_ULOAD
#undef P6_UMMA
#undef P6_UEPI
#undef P6_UXPREF
#undef MFMA32S
}

#ifndef MK_N_LAUNCHES
#define MK_N_LAUNCHES 1
#endif
constexpr int NPHASE = 7;

__device__ __forceinline__ int queue_next(unsigned* ctr, volatile LAS unsigned* slot) {
    __syncthreads();
    if (threadIdx.x == 0) *slot = __hip_atomic_fetch_add(ctr, 1u, __ATOMIC_RELAXED, __HIP_MEMORY_SCOPE_AGENT);
    __syncthreads();
    return (int)*slot;
}

__global__ void __launch_bounds__(NTHR, 2) hymba_fwd(Args a) {
    extern __shared__ __attribute__((aligned(16))) unsigned char lds_raw[];
    lds_u8* lds = (lds_u8*)lds_raw;
    volatile LAS unsigned* MISC = (volatile LAS unsigned*)(lds + MISC_OFF);
    const int tid = threadIdx.x, lane = tid & 63; const int wave = __builtin_amdgcn_readfirstlane(tid >> 6);
    const int G = gridDim.x; const int bx = blockIdx.x;
    const int vcu = (G % 8 == 0) ? (bx % 8) * (G / 8) + bx / 8 : bx;
    const int gw = vcu * NWAVES + wave, NGW = G * NWAVES;
    for (int u = tid; u < (LDS_BYTES - MISC_OFF) / 4; u += NTHR) MISC[u] = 0u;
    __syncthreads();
    const int lo = a.ph_lo, hi = a.ph_hi;
    const bool use_bar = (hi - lo) > 1;
    XcdBarrier bar; bar.bar = (unsigned*)(a.ws + WS_CTL); bar.x = 0; bar.st = MISC + 8;
    if (use_bar) bar = xcd_barrier_post((unsigned*)(a.ws + WS_CTL), MISC + 8);
#ifndef PH_MASK
#define PH_MASK 127
#endif
#define IN(k) (((PH_MASK >> (k)) & 1) && lo <= (k) && (k) < hi)
#ifdef DBL_BAR
#define SEAM(k) do { if (IN(k) && IN((k) + 1)) { xcd_barrier(bar); xcd_barrier(bar); } } while (0)
#else
#define SEAM(k) do { if (IN(k) && IN((k) + 1)) xcd_barrier(bar); } while (0)
#endif
    unsigned char* ws = a.ws;

    if (IN(0)) { p0_prologue(a, lds, gw, NGW, lane, wave);
#ifdef DBL_P0
        __syncthreads(); p0_prologue(a, lds, gw, NGW, lane, wave);
#endif
    }
    SEAM(0);
    if (IN(1)) {
        pg8::Gemm g{(const bf16_t*)(ws + WS_XB), (const bf16_t*)(ws + WS_WIN), MTOK, NIN, DM}; pg8::StaticOrder S; S.init(MTOK, NIN, G, bx);
        EpiProj E{(bf16_t*)(ws + WS_PROJ), (const float*)(ws + WS_R1), (const f32x4*)(ws + WS_ROPE), (const float*)(ws + WS_DECAY)};
        pg8::gemm_phase<EpiProj, pg8::StaticOrder>(lds, g, S, E);
#ifdef DBL_P1
        pg8::gemm_phase<EpiProj, pg8::StaticOrder>(lds, g, S, E);
#endif
    }
    SEAM(1);
    if (IN(2)) {
#ifdef DBL_P2
        for (int rep = 0; rep < 2; ++rep) {
        unsigned* ctr = (unsigned*)(ws + WS_CTL + CTL_Q_ATT + rep * 256);
#else
        {
        unsigned* ctr = (unsigned*)(ws + WS_CTL + CTL_Q_ATT);
#endif
        int tkt = queue_next(ctr, MISC + 16);
        for (;;) {
            int u = tkt;
            if (u >= 64 + 1024 + DEF_ITEMS / 5) break;
            static_assert(DEF_ITEMS % 5 == 0 && DEF_ITEMS / 5 == 1024 / 4, "P2 ticket pattern");
            if (u >= 64) { const int i5 = (u - 64) / 5, r5 = (u - 64) % 5;
                if (r5 == 4) {
#ifdef PROBE_P2
                    if (rep == 0 && !(PROBE_P2 & 4)) { tkt = queue_next(ctr, MISC + 16); continue; }
#endif
                    for (int k = 0; k < 5; ++k) p0_deferred(a, lds, i5 * 5 + k);
                    tkt = queue_next(ctr, MISC + 16); continue; }
                u = 64 + i5 * 4 + r5; }
#ifdef PROBE_P2
            if (rep == 0) { if (u >= 64 && (PROBE_P2 & 2)) { const int v = u - 64;
#ifdef PROBE_ATT2
                    if (wave >= 4) attn_unit<PROBE_ATT2>(a, lds, (v & 31) >> 2, v & 3, 31 - (v >> 5)); else
#endif
                    attn_unit<PROBE_ATT>(a, lds, (v & 31) >> 2, v & 3, 31 - (v >> 5)); tkt = queue_next(ctr, MISC + 16); continue; }
                if (u < 64 && (PROBE_P2 & 1)) ret_unit(a, lds, u >> 3, u & 7);
                tkt = queue_next(ctr, MISC + 16); continue; }
#endif
            if (u < 64) { ret_unit(a, lds, u >> 3, u & 7); tkt = queue_next(ctr, MISC + 16); }
            else { const int v = u - 64; attn_unit<7>(a, lds, (v & 31) >> 2, v & 3, 31 - (v >> 5)); tkt = queue_next(ctr, MISC + 16); }
        }
        }
    }
    SEAM(2);
    if (IN(3)) {
        pg8::Gemm g{(const bf16_t*)(ws + WS_MIX), (const bf16_t*)(ws + WS_WOUT), MTOK, DM, DM}; pg8::StaticOrder S; S.init(MTOK, DM, G, bx);
        EpiX1 E{(const bf16_t*)(ws + WS_XB), (bf16_t*)(ws + WS_X1B), (bf16_t*)(ws + WS_SSQ)};
        pg8::gemm_phase<EpiX1, pg8::StaticOrder>(lds, g, S, E);

    }
    SEAM(3);
    if (IN(4)) {
        pg8::Gemm g{(const bf16_t*)(ws + WS_X1B), (const bf16_t*)(ws + WS_WPQ), MTOK, NQ, DM}; pg8::StaticOrder S; S.init(MTOK, NQ, G, bx);
        EpiQ E{(bf16_t*)(ws + WS_PROJ), (const bf16_t*)(ws + WS_SSQ)};
        pg8::gemm_phase<EpiQ, pg8::StaticOrder>(lds, g, S, E);
#ifdef DBL_P4
        pg8::gemm_phase<EpiQ, pg8::StaticOrder>(lds, g, S, E);
#endif
    }
    SEAM(4);
    if (IN(3)) {
#ifdef DBL_P3
        { unsigned long long w2 = (unsigned long long)ws; asm volatile("" : "+s"(w2)); unsigned char* ws2 = (unsigned char*)w2; int bx2 = bx; asm volatile("" : "+s"(bx2));
          pg8::Gemm g2{(const bf16_t*)(ws2 + WS_MIX), (const bf16_t*)(ws2 + WS_WOUT), MTOK, DM, DM}; pg8::StaticOrder S2; S2.init(MTOK, DM, G, bx2);
          EpiX1 E2{(const bf16_t*)(ws2 + WS_XB), (bf16_t*)(ws2 + WS_X1B), (bf16_t*)(ws2 + WS_SSQ)};
          pg8::gemm_phase<EpiX1, pg8::StaticOrder>(lds, g2, S2, E2); }
#endif
    }
    if (IN(5)) p5_topk(a, lds);
    SEAM(5);
#ifdef DBL_P5
    if (IN(5)) { Args a2 = a; asm volatile("" : "+s"(a2.ws)); p5_topk(a2, lds); }
#endif
    if (IN(6)) {
#ifdef P6_TOKEN_MAJOR
        lds_u8* wl = lds + wave * P6_WSCR;
        for (int tok = gw; tok < MTOK; tok += NGW) p6_token(a, wl, tok, lane, a.out);
#else
#ifdef PROBE_EMASK
        for (int tb = gw; tb < MTOK / 16; tb += NGW) p6_slices<PROBE_EMASK, PROBE_PARTS>(a, lds + wave * P6S_WAVE, tb * 16, lane);
#endif
#ifdef DBL_P6
#pragma unroll 1
        for (int rep6 = 0; rep6 < 2; ++rep6)
#endif
        for (int tb = gw; tb < MTOK / 16; tb += NGW) p6_slices<0xffff, 3>(a, lds + wave * P6S_WAVE, tb * 16, lane);
#endif
    }
#ifdef DBG_DUMP
    if (hi - lo > 1) xcd_barrier(bar);
    {
        for (int m = gw; m < MTOK; m += NGW) {
            for (int c = lane; c < DM; c += 64) {
                float v = 0.f;
#if DBG_DUMP == 1
                v = bf2f(((const bf16_t*)(ws + WS_PROJ))[(size_t)m * NIN + DBG_COL + c]);
#elif DBG_DUMP == 2
                v = (c >= DBG_C0 && c < DBG_C1) ? bf2f(((const bf16_t*)(ws + WS_MIX))[(size_t)m * DM + c]) : 0.f;
#endif
                a.out[(size_t)m * DM + c] = v;
            }
        }
    }
#endif
#undef IN
#undef SEAM
}

extern "C" void kernel_launch(void* const* d_in, const int* in_sizes, int n_in, void* d_out, int out_size, void* d_ws, size_t ws_size, hipStream_t stream) {
    static int grid = 0;
    if (grid == 0) {
        if (n_in != 17 || in_sizes[0] != MTOK * DM || out_size != MTOK * DM || ws_size < WS_END) {
            fprintf(stderr, "kernel_launch: unexpected shapes (n_in %d, in0 %d, out %d, ws %zu < %zu); nothing launched\n", n_in, n_in > 0 ? in_sizes[0] : -1, out_size, ws_size, (size_t)WS_END); grid = -1; return; }
        int dev = 0, cus = 0, per_cu = 0;
        if (hipGetDevice(&dev) != hipSuccess || hipDeviceGetAttribute(&cus, hipDeviceAttributeMultiprocessorCount, dev) != hipSuccess) { fprintf(stderr, "kernel_launch: device query failed\n"); grid = -1; return; }
        if (hipFuncSetAttribute((const void*)hymba_fwd, hipFuncAttributeMaxDynamicSharedMemorySize, LDS_BYTES) != hipSuccess) { fprintf(stderr, "kernel_launch: hipFuncSetAttribute failed\n"); grid = -1; return; }
        if (hipOccupancyMaxActiveBlocksPerMultiprocessor(&per_cu, (const void*)hymba_fwd, NTHR, LDS_BYTES) != hipSuccess || per_cu < 1)
            fprintf(stderr, "kernel_launch: note: occupancy query reports %d workgroups per CU\n", per_cu);
        (void)hipGetLastError();
        grid = cus;
    }
    if (grid < 0) return;
    if (hipMemsetAsync((char*)d_ws + WS_CTL, 0, CTL_BYTES, stream) != hipSuccess) { fprintf(stderr, "kernel_launch: memset failed\n"); return; }
    Args a{};
    for (int i = 0; i < 17; ++i) a.in[i] = (const float*)d_in[i];
    a.out = (float*)d_out; a.ws = (unsigned char*)d_ws;
#if MK_N_LAUNCHES == 1
#ifdef DBG_STOP
    a.ph_lo = 0; a.ph_hi = DBG_STOP + 1;
#else
    a.ph_lo = 0; a.ph_hi = NPHASE;
#endif
    hipLaunchKernelGGL(hymba_fwd, dim3(grid), dim3(NTHR), LDS_BYTES, stream, a);
#else
    for (int p = 0; p < NPHASE; ++p) { a.ph_lo = p; a.ph_hi = p + 1; hipLaunchKernelGGL(hymba_fwd, dim3(grid), dim3(NTHR), LDS_BYTES, stream, a); }
#endif
    const hipError_t le = hipPeekAtLastError();
    if (le != hipSuccess) fprintf(stderr, "kernel_launch: launch failed: %s\n", hipGetErrorName(le));
}
```

```cpp
#include <hip/hip_runtime.h>
#include <cstdio>
#include <cstdint>

namespace pg8 {
#define PG8_LAS __attribute__((address_space(3)))
typedef unsigned short bf16_t;
typedef short bf16x8 __attribute__((ext_vector_type(8)));
typedef float f32x4 __attribute__((ext_vector_type(4)));
typedef unsigned u32x4 __attribute__((ext_vector_type(4)));
constexpr int BM = 256, BK = 64, HALF = 128, HTB = HALF * BK * 2  , STAGE_BYTES = 8 * HTB, NXCD = 8, WGM = 8;

__host__ __device__ __forceinline__ int lds_byte(int r, int c) { const int st = (r >> 4) * 2 + (c >> 5), rr = r & 15, cc = c & 31, ob = rr * 64 + cc * 2; return st * 1024 + (ob ^ (((ob >> 9) & 1) << 5)); }
__host__ __device__ __forceinline__ void stage_rc(int b, int& R, int& C) { const int st = b / 1024, sb = b % 1024, swz = sb ^ (((sb >> 9) & 1) << 5); R = (st >> 1) * 16 + swz / 64; C = (st & 1) * 32 + (swz % 64) / 2; }
__host__ __device__ __forceinline__ int perm32(int rho) { const int n = rho >> 4, i = rho & 15; return 8 * (i >> 2) + 4 * n + (i & 3); }

struct Unit { int pm, pn; };
struct Gemm { const bf16_t* A; const bf16_t* Bt; int M, N, K; };

struct StaticOrder {
    int nM, nN, nwg, G, c;
    __host__ __device__ void init(int M, int N, int G_, int c_) { nM = M / BM; nN = N / BM; nwg = nM * nN; G = G_; c = c_; }
    __host__ __device__ bool next(int i, Unit& u) const {
        const long L = (long)i * G + c; if (L >= nwg) return false;
        int wgid = (int)L; { const int q = nwg / NXCD, r = nwg % NXCD, xcd = wgid % NXCD, off = wgid / NXCD; wgid = (xcd < r ? xcd * (q + 1) : r * (q + 1) + (xcd - r) * q) + off; }
        const int nig = WGM * nN, gid = wgid / nig, fm = gid * WGM, gsz = (nM - fm) < WGM ? (nM - fm) : WGM;
        u.pm = fm + ((wgid % nig) % gsz); u.pn = (wgid % nig) / gsz; return true;
    }
    __device__ __forceinline__ void a_ready(const Unit&) const {}
    __device__ __forceinline__ void done(const Unit&) const {}
};
__device__ __forceinline__ unsigned cvt_pk_bf16(float lo, float hi) { unsigned r; asm volatile("v_cvt_pk_bf16_f32 %0, %1, %2" : "=v"(r) : "v"(lo), "v"(hi)); return r; }
template <class Epi, class Sched>
__device__ __forceinline__ void gemm_phase(PG8_LAS unsigned char* lds, const Gemm g, const Sched& S, const Epi& E) {
    int tid_ = threadIdx.x; asm volatile("" : "+v"(tid_));
    const int tid = tid_, wid = __builtin_amdgcn_readfirstlane(tid >> 6), lane = tid & 63, wr = wid >> 2, wc = wid & 3, fr = lane & 15, fq = lane >> 4;
    const int K = g.K, nt = K / BK;
    unsigned voffA[2], voffB[2];
#pragma unroll
    for (int i = 0; i < 2; ++i) { int R, C; stage_rc(tid * 16 + i * 8192, R, C); const int Rb = Epi::PERM ? ((R & ~31) + perm32(R & 31)) : R;
        voffA[i] = (unsigned)(R * K + C) * 2u; voffB[i] = (unsigned)(Rb * K + C) * 2u; }
    const size_t kstep = (size_t)(BK * 2);
    const size_t hstep = (size_t)HALF * K * 2;
    const size_t tstep = 2 * hstep;
    const unsigned ldsw = (unsigned)wid * 1024u;
    const int aoff = lds_byte(wr * 64 + fr, fq * 8), boff = lds_byte(wc * 32 + fr, fq * 8);
#define PG8_SA(b, h) (((b) * 2 + (h)) * HTB)
#define PG8_SB(b, h) ((4 + (b) * 2 + (h)) * HTB)
#define PG8_STAGE(bufoff, gbase, voff) do { _Pragma("unroll") for (int _i = 0; _i < 2; ++_i) \
        __builtin_amdgcn_global_load_lds((const unsigned*)((const char*)(gbase) + (voff)[_i]), (PG8_LAS unsigned*)(lds + (bufoff) + ldsw + _i * 8192), 16, 0, 0); } while (0)
#define PG8_LDA(dst, b, h) do { _Pragma("unroll") for (int m = 0; m < 4; ++m) _Pragma("unroll") for (int k = 0; k < 2; ++k) dst[m][k] = *(const PG8_LAS bf16x8*)(lds + PG8_SA(b, h) + aoff + m * 2048 + k * 1024); } while (0)
#define PG8_LDB(dst, b, h) do { _Pragma("unroll") for (int n = 0; n < 2; ++n) _Pragma("unroll") for (int k = 0; k < 2; ++k) dst[n][k] = *(const PG8_LAS bf16x8*)(lds + PG8_SB(b, h) + boff + n * 2048 + k * 1024); } while (0)
#define PG8_MMA(ai, bj, At, Bt) do { __builtin_amdgcn_s_setprio(1); _Pragma("unroll") for (int m = 0; m < 4; ++m) _Pragma("unroll") for (int n = 0; n < 2; ++n) _Pragma("unroll") for (int k = 0; k < 2; ++k) \
        acc[ai][bj][m][n] = __builtin_amdgcn_mfma_f32_16x16x32_bf16(Bt[n][k], At[m][k], acc[ai][bj][m][n], 0, 0, 0); __builtin_amdgcn_s_setprio(0); } while (0)
#define PG8_WAIT_V(n) asm volatile("s_waitcnt vmcnt(" #n ")" ::: "memory")
#define PG8_WAIT_L(n) asm volatile("s_waitcnt lgkmcnt(" #n ")" ::: "memory")
#define PG8_BAR __builtin_amdgcn_s_barrier()
#define PG8_SCHED __builtin_amdgcn_sched_barrier(0)
    Unit cur, nxt; int ui = 0;
    if (!S.next(0, cur)) return;
    f32x4 acc[2][2][4][2];
#pragma unroll
    for (int a = 0; a < 2; ++a)
#pragma unroll
        for (int b = 0; b < 2; ++b)
#pragma unroll
            for (int m = 0; m < 4; ++m)
#pragma unroll
                for (int n = 0; n < 2; ++n) acc[a][b][m][n] = (f32x4){0.f, 0.f, 0.f, 0.f};
    bf16x8 At[4][2], B0[2][2], B1[2][2];
    const char* cA = (const char*)g.A + (size_t)cur.pm * tstep; const char* cB = (const char*)g.Bt + (size_t)cur.pn * tstep;
    S.a_ready(cur);
    PG8_STAGE(PG8_SB(0, 0), cB, voffB); PG8_STAGE(PG8_SA(0, 0), cA, voffA); PG8_STAGE(PG8_SB(0, 1), cB + hstep, voffB); PG8_STAGE(PG8_SA(0, 1), cA + hstep, voffA);
    if (wr == 1) PG8_BAR;
    PG8_WAIT_V(4); PG8_BAR;
    PG8_STAGE(PG8_SB(1, 0), cB + kstep, voffB); PG8_STAGE(PG8_SA(1, 0), cA + kstep, voffA); PG8_STAGE(PG8_SB(1, 1), cB + hstep + kstep, voffB);
    PG8_WAIT_V(6); PG8_BAR;
    for (;;) {
        const bool has_next = S.next(ui + 1, nxt);
        const char* nA = has_next ? (const char*)g.A + (size_t)nxt.pm * tstep : cA; const char* nB = has_next ? (const char*)g.Bt + (size_t)nxt.pn * tstep : cB;
        for (int t = 0; t < nt; t += 2) {
            const bool last = (t == nt - 2);
            const char* a1 = cA + (size_t)(t + 1) * kstep;
            const char* a2 = last ? nA : cA + (size_t)(t + 2) * kstep; const char* b2 = last ? nB : cB + (size_t)(t + 2) * kstep;
            const char* a3 = a2 + kstep; const char* b3 = b2 + kstep;
            if (last && has_next) S.a_ready(nxt);
            PG8_LDB(B0, 0, 0); PG8_SCHED; PG8_LDA(At, 0, 0); PG8_STAGE(PG8_SA(1, 1), a1 + hstep, voffA);
            PG8_WAIT_L(8); PG8_BAR; PG8_WAIT_L(0); PG8_MMA(0, 0, At, B0); PG8_BAR; PG8_SCHED;
            PG8_LDB(B1, 0, 1); PG8_STAGE(PG8_SB(0, 0), b2, voffB);
            PG8_BAR; PG8_WAIT_L(0); PG8_MMA(0, 1, At, B1); PG8_BAR;
            PG8_LDA(At, 0, 1); PG8_STAGE(PG8_SA(0, 0), a2, voffA);
            PG8_BAR; PG8_WAIT_L(0); PG8_MMA(1, 0, At, B0); PG8_BAR; PG8_SCHED;
            PG8_STAGE(PG8_SB(0, 1), b2 + hstep, voffB);
            PG8_WAIT_V(6); PG8_BAR; PG8_MMA(1, 1, At, B1); PG8_BAR;
            PG8_LDB(B0, 1, 0); PG8_SCHED; PG8_LDA(At, 1, 0); PG8_STAGE(PG8_SA(0, 1), a2 + hstep, voffA);
            PG8_WAIT_L(8); PG8_BAR; PG8_WAIT_L(0); PG8_MMA(0, 0, At, B0); PG8_BAR; PG8_SCHED;
            PG8_LDB(B1, 1, 1); PG8_STAGE(PG8_SB(1, 0), b3, voffB);
            PG8_BAR; PG8_WAIT_L(0); PG8_MMA(0, 1, At, B1); PG8_BAR;
            PG8_LDA(At, 1, 1); PG8_STAGE(PG8_SA(1, 0), a3, voffA);
            PG8_BAR; PG8_WAIT_L(0); PG8_MMA(1, 0, At, B0); PG8_BAR; PG8_SCHED;
            PG8_STAGE(PG8_SB(1, 1), b3 + hstep, voffB);
            PG8_WAIT_V(6); PG8_BAR; PG8_MMA(1, 1, At, B1); PG8_BAR;
        }
        if constexpr (!Epi::AFTER_DRAIN) { E(acc, cur, wr, wc, fr, fq); S.done(cur); }
        if (!has_next) break;
#pragma unroll
        for (int a = 0; a < 2; ++a)
#pragma unroll
            for (int b = 0; b < 2; ++b)
#pragma unroll
                for (int m = 0; m < 4; ++m)
#pragma unroll
                    for (int n = 0; n < 2; ++n) acc[a][b][m][n] = (f32x4){0.f, 0.f, 0.f, 0.f};
        cur = nxt; cA = nA; cB = nB; ++ui;
    }
    PG8_WAIT_V(0);
    if (wr == 0) PG8_BAR;
    PG8_BAR;
    if constexpr (Epi::AFTER_DRAIN) { E.fused(acc, cur, wr, wc, fr, fq, lds, wid, lane); S.done(cur); }
#undef PG8_SA
#undef PG8_SB
#undef PG8_STAGE
#undef PG8_LDA
#undef PG8_LDB
#undef PG8_MMA
#undef PG8_WAIT_V
#undef PG8_WAIT_L
#undef PG8_BAR
#undef PG8_SCHED
}
}

#define XB_TMO      128
#define XB_XCNT(j)  (256  + 64 * (j))
#define XB_XSUB(j)  (1280 + 64 * (j))
#define XB_XGEN(j)  (2304 + 64 * (j))
#define XB_TOP      3328
#define XB_TOPGEN   3392
#define XCD_BAR_WORDS 3456
#define XB_SPIN_CAP (1u << 18)
#define LAS __attribute__((address_space(3)))

__device__ __forceinline__ unsigned xb_ld(unsigned* p)              { return __hip_atomic_load(p, __ATOMIC_RELAXED, __HIP_MEMORY_SCOPE_AGENT); }
__device__ __forceinline__ unsigned xb_add(unsigned* p, unsigned v) { return __hip_atomic_fetch_add(p, v, __ATOMIC_RELAXED, __HIP_MEMORY_SCOPE_AGENT); }
__device__ __forceinline__ unsigned xb_xcc_id() { return (unsigned)__builtin_amdgcn_s_getreg((3 << 11) | 20) & 0xFu; }
#define XB_SPIN(cond, bar) do { unsigned _sp = 0; while (cond) { __builtin_amdgcn_s_sleep(1); \
    if ((++_sp & 255u) == 0u) { if (xb_ld(&(bar)[XB_TMO])) break; if (_sp > XB_SPIN_CAP) { atomicAdd(&(bar)[XB_TMO], 1u); break; } } } } while (0)

struct XcdBarrier {
    unsigned* bar; unsigned x;
    volatile LAS unsigned* st;
};

__device__ __forceinline__ XcdBarrier xcd_barrier_post(unsigned* bar, volatile LAS unsigned* st) {
    XcdBarrier b; b.bar = bar; b.x = xb_xcc_id(); b.st = st;
    if (threadIdx.x == 0) (void)xb_add(&bar[XB_XCNT(b.x)], 1u);
    return b;
}
__device__ __forceinline__ void xcd_barrier_complete(unsigned* bar, unsigned x, unsigned& nloc, unsigned& nx) {
    const unsigned G = gridDim.x * gridDim.y * gridDim.z;
    unsigned sum, cnt, mine, sp = 0u;
    for (;;) {
        sum = 0u; cnt = 0u; mine = 0u;
#pragma unroll
        for (unsigned j = 0; j < 16; ++j) { const unsigned c = xb_ld(&bar[XB_XCNT(j)]); sum += c; cnt += (c > 0u) ? 1u : 0u; mine = (j == x) ? c : mine; }
        if (sum == G) break;
        __builtin_amdgcn_s_sleep(1);
        if ((++sp & 255u) == 0u) { if (xb_ld(&bar[XB_TMO])) break; if (sp > XB_SPIN_CAP) { atomicAdd(&bar[XB_TMO], 1u); break; } }
    }
    nloc = mine > 0u ? mine : 1u; nx = cnt > 0u ? cnt : 1u;
}

__device__ __forceinline__ void xcd_barrier(const XcdBarrier& b) {
    asm volatile("s_waitcnt vmcnt(0)" ::: "memory");
    __syncthreads();
    if (threadIdx.x == 0) {
        unsigned* bar = b.bar;
        __builtin_amdgcn_s_waitcnt(0);
        unsigned nloc = b.st[0], nx = b.st[1];
        if (nloc == 0u) { xcd_barrier_complete(bar, b.x, nloc, nx); b.st[0] = nloc; b.st[1] = nx; }
        const unsigned old = xb_add(&bar[XB_XSUB(b.x)], 1u);
        const unsigned gen = old / nloc;
        if (old + 1u == (gen + 1u) * nloc) {
            __builtin_amdgcn_fence(__ATOMIC_RELEASE, "agent");
            asm volatile("s_waitcnt vmcnt(0)" ::: "memory");
            const unsigned og = xb_add(&bar[XB_TOP], 1u);
            const unsigned tg = og / nx;
            if (og + 1u == (tg + 1u) * nx) xb_add(&bar[XB_TOPGEN], 1u);
            else XB_SPIN(xb_ld(&bar[XB_TOPGEN]) == tg, bar);
            __builtin_amdgcn_fence(__ATOMIC_ACQUIRE, "agent");
            xb_add(&bar[XB_XGEN(b.x)], 1u);
            asm volatile("s_waitcnt vmcnt(0)" ::: "memory");
        } else {
            XB_SPIN(xb_ld(&bar[XB_XGEN(b.x)]) == gen, bar);
            __builtin_amdgcn_fence(__ATOMIC_ACQUIRE, "agent");
            asm volatile("s_waitcnt vmcnt(0)" ::: "memory");
        }
    }
    __syncthreads();
}

#define GAS __attribute__((address_space(1)))
typedef unsigned short bf16_t;
typedef short bf16x8 __attribute__((ext_vector_type(8)));
typedef short s16x4 __attribute__((ext_vector_type(4)));
typedef float f32x4 __attribute__((ext_vector_type(4)));
typedef float f32x2 __attribute__((ext_vector_type(2)));
typedef float f32x16 __attribute__((ext_vector_type(16)));
typedef unsigned u32x4 __attribute__((ext_vector_type(4)));
typedef unsigned u32x2 __attribute__((ext_vector_type(2)));
typedef LAS unsigned char lds_u8;

constexpr int MTOK = 32768, DM = 1024, SEQ = 4096, NBATCH = 8, NIN = 3584;
constexpr int OFF_RQ = 0, OFF_RK = 512, OFF_RV = 1024, OFF_RG = 1536, OFF_DQ = 2048, OFF_DK = 2560, OFF_DV = 3072;
constexpr int NEXP = 16384, NQ = 2048;
constexpr float EPSF = 1e-6f, LOG2E = 1.4426950408889634f;
constexpr int NWAVES = 8, NTHR = 512;

constexpr size_t WS_CTL = 0, CTL_BYTES = 65536;
constexpr size_t CTL_Q_ATT = 16384, CTL_Q_P6 = 16384 + 1024;
constexpr size_t WS_R1 = WS_CTL + CTL_BYTES;
constexpr size_t WS_SSQ = WS_R1 + (size_t)MTOK * 4;
constexpr size_t WS_ROPE = WS_SSQ + (size_t)MTOK * 16 * 4;
constexpr size_t WS_DECAY = WS_ROPE + (size_t)SEQ * 32 * 8;
constexpr size_t WS_BTAB = WS_DECAY + 2 * 8 * 128 * 4;
constexpr size_t WS_LAM = WS_BTAB + 4 * 128 * 4;
constexpr size_t WS_WIN = 4u << 20;
constexpr size_t WS_WOUT = WS_WIN + (size_t)NIN * DM * 2;
constexpr size_t WS_WPQ = WS_WOUT + (size_t)DM * DM * 2;
constexpr size_t WS_KEYS = WS_WPQ + (size_t)NQ * DM * 2;
constexpr size_t WS_WD = WS_KEYS + (size_t)8 * 2 * 128 * 128 * 2;
constexpr size_t WS_WU = WS_WD + (size_t)NEXP * DM * 2;
constexpr size_t WS_XB = WS_WU + (size_t)NEXP * DM * 2;
constexpr size_t WS_PROJ = WS_XB + (size_t)MTOK * DM * 2;
constexpr size_t WS_MIX = WS_PROJ + (size_t)MTOK * NIN * 2;
constexpr size_t WS_IDX = WS_MIX, WS_GATE = WS_MIX + (size_t)MTOK * 128 * 4;
constexpr size_t WS_X1B = WS_PROJ + (size_t)MTOK * NQ * 2;
static_assert(WS_X1B + (size_t)MTOK * DM * 2 <= WS_MIX, "ws map");
constexpr size_t WS_END = WS_MIX + (size_t)MTOK * DM * 2;
static_assert(WS_LAM + 256 <= WS_WIN, "ws map");
static_assert(WS_END <= (size_t)512 << 20, "ws map");

constexpr int LDS_SCRATCH = 139264;
constexpr int MISC_OFF = LDS_SCRATCH;
constexpr int LDS_BYTES = 147456;

__device__ __forceinline__ float wave_sum(float v) {
    v += __uint_as_float(__builtin_amdgcn_update_dpp(0u, __float_as_uint(v), 0xB1, 0xf, 0xf, true));
    v += __uint_as_float(__builtin_amdgcn_update_dpp(0u, __float_as_uint(v), 0x4E, 0xf, 0xf, true));
    v += __uint_as_float(__builtin_amdgcn_update_dpp(0u, __float_as_uint(v), 0x141, 0xf, 0xf, true));
    v += __uint_as_float(__builtin_amdgcn_update_dpp(0u, __float_as_uint(v), 0x140, 0xf, 0xf, true));
    { auto rr = __builtin_amdgcn_permlane16_swap(__float_as_uint(v), __float_as_uint(v), false, false); v = __uint_as_float(rr[0]) + __uint_as_float(rr[1]); }
    { auto rr = __builtin_amdgcn_permlane32_swap(__float_as_uint(v), __float_as_uint(v), false, false); v = __uint_as_float(rr[0]) + __uint_as_float(rr[1]); }
    return v;
}
typedef __bf16 bf16v2_t __attribute__((ext_vector_type(2)));
__device__ __forceinline__ unsigned pk2(float lo, float hi) { const bf16v2_t v = {(__bf16)lo, (__bf16)hi}; return __builtin_bit_cast(unsigned, v); }
__device__ __forceinline__ float bf2f(unsigned short b) { return __uint_as_float(((unsigned)b) << 16); }
#define LDS_WAIT() asm volatile("s_waitcnt lgkmcnt(0)" ::: "memory")
#define VM_WAIT() asm volatile("s_waitcnt vmcnt(0)" ::: "memory")

struct Args {
    const float* in[17]; float* out; unsigned char* ws; int ph_lo, ph_hi;
};

template <int MODE>
__device__ __forceinline__ void p0_transpose_item(const float* W, const float* scale, int K, int N, bf16_t* WT, LAS float* scr, int item, int lane) {
    const int nblk = N / 32, kb = item / nblk, nb = item % nblk, k0 = 64 * kb, n0 = 32 * nb;
#pragma unroll 8
    for (int i = 0; i < 32; ++i) { const int kk = 2 * i + (lane >> 5); const float sc = scale ? scale[k0 + kk] : 1.0f; scr[kk * 33 + (lane & 31)] = __builtin_nontemporal_load((const GAS float*)(W + (size_t)(k0 + kk) * N + n0 + (lane & 31))) * sc; }
    LDS_WAIT();
    const int c = lane & 7;
#pragma unroll
    for (int j = 0; j < 4; ++j) { const int n = (lane >> 3) + 8 * j; const LAS float* s = scr + (8 * c) * 33 + n;
        u32x4 o; o.x = pk2(s[0 * 33], s[1 * 33]); o.y = pk2(s[2 * 33], s[3 * 33]); o.z = pk2(s[4 * 33], s[5 * 33]); o.w = pk2(s[6 * 33], s[7 * 33]);
        int nn = n0 + n;
        if (MODE == 1 && nn < 1024) { const int d = nn & 63; nn = (nn & ~63) + ((d < 32) ? 2 * d : 2 * (d - 32) + 1); }
        *(GAS u32x4*)(WT + (size_t)nn * K + k0 + 8 * c) = o; }
    LDS_WAIT();
}

__device__ __forceinline__ int t5_bucket(int n) {
    if (n < 16) return n;
    const float v = logf((float)n / 16.0f) / 2.0794415416798357f * 16.0f;
    int b = 16 + (int)v; return b > 31 ? 31 : b;
}

__device__ __forceinline__ void p0_prologue(const Args& a, lds_u8* lds, int gw, int NGW, int lane, int wave) {
    unsigned char* ws = a.ws;
    const float* x = a.in[0];
    bf16_t* xb = (bf16_t*)(ws + WS_XB); float* r1 = (float*)(ws + WS_R1);
    for (int m0 = gw; m0 < MTOK; m0 += 4 * NGW) {
        f32x4 v[4][4];
#pragma unroll
        for (int r = 0; r < 4; ++r) { const int m = m0 + r * NGW; const GAS f32x4* xr = (const GAS f32x4*)(x + (size_t)(m < MTOK ? m : m0) * DM) + lane;
#pragma unroll
            for (int j = 0; j < 4; ++j) v[r][j] = __builtin_nontemporal_load(xr + 64 * j); }
#pragma unroll
        for (int r = 0; r < 4; ++r) { const int m = m0 + r * NGW; if (m >= MTOK) break;
            float s = 0.f;
#pragma unroll
            for (int j = 0; j < 4; ++j) s += (v[r][j].x * v[r][j].x + v[r][j].y * v[r][j].y) + (v[r][j].z * v[r][j].z + v[r][j].w * v[r][j].w);
            s = wave_sum(s);
            const float rms = sqrtf(s * (1.0f / DM) + EPSF), rsc = 1.0f / rms;
            GAS u32x2* o8 = (GAS u32x2*)(xb + (size_t)m * DM) + lane;
#pragma unroll
            for (int j = 0; j < 4; ++j) { u32x2 o; o.x = pk2(v[r][j].x * rsc, v[r][j].y * rsc); o.y = pk2(v[r][j].z * rsc, v[r][j].w * rsc); o8[64 * j] = o; }
            if (lane == 0) r1[m] = rms; }
    }
    {
        LAS float* scr = (LAS float*)(lds + wave * 8704);
        constexpr int I_IN = (DM / 64) * (NIN / 32);
        for (int it = gw; it < I_IN; it += NGW) p0_transpose_item<1>(a.in[2], a.in[1], DM, NIN, (bf16_t*)(ws + WS_WIN), scr, it, lane);
    }
    const int gt = gw * 64 + lane, NGT = NGW * 64;
    {
        unsigned* rope = (unsigned*)(ws + WS_ROPE);
        for (int i = gt; i < SEQ * 32; i += NGT) { const int pos = i >> 5, j = i & 31; const float fr = exp2f((float)j * -0.41524101186092029f);
            const float ang = (float)pos * fr;
            const float kq = rintf(ang * 0.15915494309189535f); float rr = fmaf(-kq, 6.28318548202514648f, ang); rr = fmaf(-kq, -1.7484555e-7f, rr);
            const float rev = rr * 0.15915494309189535f;
            rope[i] = pk2(__builtin_amdgcn_cosf(rev), __builtin_amdgcn_sinf(rev)); }
        float* dec = (float*)(ws + WS_DECAY);
        for (int i = gt; i < 2 * 8 * 128; i += NGT) { const int l = i & 127, h = (i >> 7) & 7, kk = i >> 10; const float lg = log2f(1.0f - exp2f(-5.0f - (float)h));
            dec[i] = kk ? 0.125f * exp2f(-lg * (float)l) : exp2f(lg * (float)l); }
        float* bt = (float*)(ws + WS_BTAB); const float* rb = a.in[9];
        for (int i = gt; i < 4 * 128; i += NGT) { const int n = i & 127, h = i >> 7; bt[i] = rb[t5_bucket(n) * 4 + h] * LOG2E; }
        if (gt == 0) { float s1 = 0.f, s2 = 0.f; for (int i = 0; i < 64; ++i) { s1 += a.in[4][i] * a.in[5][i]; s2 += a.in[6][i] * a.in[7][i]; }
            ((float*)(ws + WS_LAM))[0] = expf(s1) - expf(s2) + 0.2f; }
    }
}


constexpr int DEF_T0 = 192, DEF_T1 = 64, DEF_T2 = 512, DEF_T3 = 512, DEF_ITEMS = DEF_T0 + DEF_T1 + DEF_T2 + DEF_T3;
__device__ __forceinline__ void p0_deferred(const Args& a, lds_u8* lds, int item) {
    unsigned char* ws = a.ws;
    int tid_ = threadIdx.x; asm volatile("" : "+v"(tid_));
    const int tid = tid_, lane = tid & 63; const int wave = __builtin_amdgcn_readfirstlane(tid >> 6);
    if (item < DEF_T0) {
        LAS float* scr = (LAS float*)(lds + wave * 8704);
        constexpr int I_OUT = (DM / 64) * (DM / 32), I_PQ = (DM / 64) * (NQ / 32);
        static_assert(I_OUT + I_PQ == DEF_T0 * 8, "deferred transposes");
        const int r = item * 8 + wave;
        if (r < I_OUT) p0_transpose_item<0>(a.in[10], nullptr, DM, DM, (bf16_t*)(ws + WS_WOUT), scr, r, lane);
        else p0_transpose_item<0>(a.in[12], a.in[11], DM, NQ, (bf16_t*)(ws + WS_WPQ), scr, r - I_OUT, lane);
        return;
    }
    item -= DEF_T0;
    if (item < DEF_T1) {
        const float* pk = a.in[13]; bf16_t* kb = (bf16_t*)(ws + WS_KEYS);
        const int i = item * 512 + tid;
        const GAS f32x4* s = (const GAS f32x4*)(pk + (size_t)i * 8); const f32x4 p = __builtin_nontemporal_load(s), q = __builtin_nontemporal_load(s + 1);
        u32x4 o; o.x = pk2(p.x, p.y); o.y = pk2(p.z, p.w); o.z = pk2(q.x, q.y); o.w = pk2(q.z, q.w); *(GAS u32x4*)(kb + (size_t)i * 8) = o;
        return;
    }
    item -= DEF_T1;
    const float* dn = a.in[14]; const float* up = a.in[15]; const float* gf = a.in[11];
    unsigned char* wd = ws + WS_WD; unsigned char* wu = ws + WS_WU;
    const bool isup = item < DEF_T2; if (!isup) item -= DEF_T2;
    const float* src = (isup ? up : dn) + (size_t)(item * 32 + wave * 4) * DM + lane * 4;
    f32x4 g[4];
#pragma unroll
    for (int k = 0; k < 4; ++k) g[k] = isup ? (f32x4){6.0f, 6.0f, 6.0f, 6.0f} : *(const GAS f32x4*)(gf + k * 256 + lane * 4) * 64.0f;
    f32x4 v[4][4];
#pragma unroll
    for (int r = 0; r < 4; ++r)
#pragma unroll
        for (int k = 0; k < 4; ++k) v[r][k] = __builtin_nontemporal_load((const GAS f32x4*)(src + (size_t)r * DM + k * 256));
#pragma unroll
    for (int r = 0; r < 4; ++r) {
        const int e = item * 32 + wave * 4 + r;
#pragma unroll
        for (int k = 0; k < 4; ++k) {
            const f32x4 p = v[r][k] * g[k];
            unsigned w = __builtin_amdgcn_cvt_scalef32_pk_fp4_f32(0u, p.x, p.y, 1.0f, 0);
            w = __builtin_amdgcn_cvt_scalef32_pk_fp4_f32(w, p.z, p.w, 1.0f, 1);
            unsigned char* dst = isup ? wu + (size_t)e * 512 + k * 128 + lane * 2 : wd + (size_t)k * ((size_t)NEXP * 128) + (size_t)e * 128 + lane * 2;
            *(GAS unsigned short*)dst = (unsigned short)w;
        }
    }
}

__device__ __forceinline__ void p0_tables5(const Args& a, int t0) {
    int tid_ = threadIdx.x; asm volatile("" : "+v"(tid_));
    const int lane = tid_ & 63; const int wave = __builtin_amdgcn_readfirstlane(tid_ >> 6);
    const float* __restrict__ dn = a.in[14]; const float* __restrict__ up = a.in[15]; const float* __restrict__ gf = a.in[11];
    unsigned char* __restrict__ wd = a.ws + WS_WD; unsigned char* __restrict__ wu = a.ws + WS_WU;
    f32x4 gd[4];
#pragma unroll
    for (int k = 0; k < 4; ++k) gd[k] = *(const GAS f32x4*)(gf + k * 256 + lane * 4) * 64.0f;
    f32x4 vA[4][4], vB[4][4];
#define P0_TLOAD(V, it_) do { const int ti_ = (it_); const bool iu_ = ti_ < DEF_T2; const int ii_ = iu_ ? ti_ : ti_ - DEF_T2; \
        const float* sp_ = (iu_ ? up : dn) + (size_t)(ii_ * 32 + wave * 4) * DM + lane * 4; \
        _Pragma("unroll") for (int r = 0; r < 4; ++r) _Pragma("unroll") for (int k = 0; k < 4; ++k) V[r][k] = __builtin_nontemporal_load((const GAS f32x4*)(sp_ + (size_t)r * DM + k * 256)); } while (0)
#define P0_TCONV(V, it_) do { const int ti_ = (it_); const bool iu_ = ti_ < DEF_T2; const int ii_ = iu_ ? ti_ : ti_ - DEF_T2; \
        _Pragma("unroll") for (int r = 0; r < 4; ++r) { const int e_ = ii_ * 32 + wave * 4 + r; \
            _Pragma("unroll") for (int k = 0; k < 4; ++k) { const f32x4 p_ = V[r][k] * (iu_ ? (f32x4){6.0f, 6.0f, 6.0f, 6.0f} : gd[k]); \
                unsigned w_ = __builtin_amdgcn_cvt_scalef32_pk_fp4_f32(0u, p_.x, p_.y, 1.0f, 0); w_ = __builtin_amdgcn_cvt_scalef32_pk_fp4_f32(w_, p_.z, p_.w, 1.0f, 1); \
                unsigned char* dst_ = iu_ ? wu + (size_t)e_ * 512 + k * 128 + lane * 2 : wd + (size_t)k * ((size_t)NEXP * 128) + (size_t)e_ * 128 + lane * 2; \
                *(GAS unsigned short*)dst_ = (unsigned short)w_; } } } while (0)
    P0_TLOAD(vA, t0); P0_TLOAD(vB, t0 + 1);
    P0_TCONV(vA, t0); P0_TLOAD(vA, t0 + 2);
    P0_TCONV(vB, t0 + 1); P0_TLOAD(vB, t0 + 3);
    P0_TCONV(vA, t0 + 2); P0_TLOAD(vA, t0 + 4);
    P0_TCONV(vB, t0 + 3);
    P0_TCONV(vA, t0 + 4);
#undef P0_TLOAD
#undef P0_TCONV
}

__device__ __forceinline__ f32x4 bf4_lo(u32x4 w) { return (f32x4){__uint_as_float(w.x << 16), __uint_as_float(w.x & 0xffff0000u), __uint_as_float(w.y << 16), __uint_as_float(w.y & 0xffff0000u)}; }
__device__ __forceinline__ f32x4 bf4_hi(u32x4 w) { return (f32x4){__uint_as_float(w.z << 16), __uint_as_float(w.z & 0xffff0000u), __uint_as_float(w.w << 16), __uint_as_float(w.w & 0xffff0000u)}; }
__device__ __forceinline__ u32x4 quad_gather(u32x4 w, int bpa) {
    u32x4 r; r.x = (unsigned)__builtin_amdgcn_ds_bpermute(bpa, (int)w.x); r.y = (unsigned)__builtin_amdgcn_ds_bpermute(bpa, (int)w.y);
    r.z = (unsigned)__builtin_amdgcn_ds_bpermute(bpa, (int)w.z); r.w = (unsigned)__builtin_amdgcn_ds_bpermute(bpa, (int)w.w); return r;
}
struct EpiProj {
    static constexpr bool PERM = true, AFTER_DRAIN = false;
    bf16_t* P; const float* r1; const f32x4* rope; const float* decay;
    __device__ __forceinline__ void operator()(const f32x4 (&acc)[2][2][4][2], const pg8::Unit& u, int wr, int wc, int fr, int fq) const {
        int l_ = threadIdx.x & 63; asm volatile("" : "+v"(l_)); fr = l_ & 15; fq = l_ >> 4;
        const int qr = l_ >> 2, qc = l_ & 3, bpa = 4 * (qr + 16 * qc), bpi = 4 * (4 * fr + fq);
        const int row0 = u.pm * 256 + wr * 64 + fr, srow0 = u.pm * 256 + wr * 64 + qr, seg = u.pn >> 1;
        if (seg <= 1) {
            u32x4 rw[2][4][2]; float ff[2][4][2];
#pragma unroll
            for (int ai = 0; ai < 2; ++ai)
#pragma unroll
                for (int m = 0; m < 4; ++m)
#pragma unroll
                    for (int bj = 0; bj < 2; ++bj) {
                        const int row = row0 + ai * 128 + m * 16, c0 = u.pn * 256 + bj * 128 + wc * 32 + 8 * fq;
                        const int l = row & 127, head = (c0 & 511) >> 6;
                        const int pos = (srow0 + ai * 128 + m * 16) & (SEQ - 1), jb = ((u.pn * 256 + bj * 128 + wc * 32 + 8 * qc) & 63) >> 1;
                        rw[ai][m][bj] = *((const GAS u32x4*)rope + ((size_t)pos * 32 + jb) / 4);
                        ff[ai][m][bj] = *(const GAS float*)(decay + (seg * 8 + head) * 128 + l);
                    }
#pragma unroll
            for (int ai = 0; ai < 2; ++ai)
#pragma unroll
                for (int m = 0; m < 4; ++m)
#pragma unroll
                    for (int bj = 0; bj < 2; ++bj) {
                        const int row = row0 + ai * 128 + m * 16, c0 = u.pn * 256 + bj * 128 + wc * 32 + 8 * fq;
                        const f32x4 v0 = acc[ai][bj][m][0], v1 = acc[ai][bj][m][1];
                        const u32x4 rwi = quad_gather(rw[ai][m][bj], bpi);
                        const f32x4 a_ = bf4_lo(rwi), b_ = bf4_hi(rwi); const float f = ff[ai][m][bj];
                        f32x4 w0, w1;
                        w0.x = (v0.x * a_.x - v0.y * a_.y) * f; w0.y = (v0.y * a_.x + v0.x * a_.y) * f;
                        w0.z = (v0.z * a_.z - v0.w * a_.w) * f; w0.w = (v0.w * a_.z + v0.z * a_.w) * f;
                        w1.x = (v1.x * b_.x - v1.y * b_.y) * f; w1.y = (v1.y * b_.x + v1.x * b_.y) * f;
                        w1.z = (v1.z * b_.z - v1.w * b_.w) * f; w1.w = (v1.w * b_.z + v1.z * b_.w) * f;
                        u32x4 w; w.x = pk2(w0.x, w0.y); w.y = pk2(w0.z, w0.w); w.z = pk2(w1.x, w1.y); w.w = pk2(w1.z, w1.w);
                        *(GAS u32x4*)(P + (size_t)(srow0 + ai * 128 + m * 16) * NIN + (u.pn * 256 + bj * 128 + wc * 32 + 8 * qc)) = quad_gather(w, bpa);
                    }
        } else {
#pragma unroll
            for (int ai = 0; ai < 2; ++ai)
#pragma unroll
                for (int m = 0; m < 4; ++m)
#pragma unroll
                    for (int bj = 0; bj < 2; ++bj) {
                        const int row = row0 + ai * 128 + m * 16, c0 = u.pn * 256 + bj * 128 + wc * 32 + 8 * fq;
                        f32x4 v0 = acc[ai][bj][m][0], v1 = acc[ai][bj][m][1];
                        if (seg == 3) {
#pragma unroll
                            for (int j = 0; j < 4; ++j) { v0[j] = v0[j] * __builtin_amdgcn_rcpf(1.0f + __builtin_amdgcn_exp2f(v0[j] * -LOG2E)); v1[j] = v1[j] * __builtin_amdgcn_rcpf(1.0f + __builtin_amdgcn_exp2f(v1[j] * -LOG2E)); }
                        } else if (seg == 4) { v0 = v0 * (0.125f * LOG2E); v1 = v1 * (0.125f * LOG2E); }
                        u32x4 w; w.x = pk2(v0.x, v0.y); w.y = pk2(v0.z, v0.w); w.z = pk2(v1.x, v1.y); w.w = pk2(v1.z, v1.w);
                        *(GAS u32x4*)(P + (size_t)(srow0 + ai * 128 + m * 16) * NIN + (u.pn * 256 + bj * 128 + wc * 32 + 8 * qc)) = quad_gather(w, bpa);
                    }
        }
    }
};
struct EpiX1 {
    static constexpr bool PERM = true, AFTER_DRAIN = false;
    const bf16_t* __restrict__ XB; bf16_t* __restrict__ X1B; bf16_t* __restrict__ ssq; const float* __restrict__ rms1;
    __device__ __forceinline__ void operator()(const f32x4 (&acc)[2][2][4][2], const pg8::Unit& u, int wr, int wc, int fr, int fq) const {
        int l_ = threadIdx.x & 63; asm volatile("" : "+v"(l_)); fr = l_ & 15; fq = l_ >> 4;
        const int qr = l_ >> 2, qc = l_ & 3, bpa = 4 * (qr + 16 * qc), bpi = 4 * (4 * fr + fq);
        const int row0 = u.pm * 256 + wr * 64 + fr, srow0 = u.pm * 256 + wr * 64 + qr, c00 = u.pn * 256 + wc * 32 + 8 * qc;
        u32x4 xin[2][4][2];
#pragma unroll
        for (int ai = 0; ai < 2; ++ai)
#pragma unroll
            for (int m = 0; m < 4; ++m)
#pragma unroll
                for (int bj = 0; bj < 2; ++bj) xin[ai][m][bj] = *(const GAS u32x4*)(XB + (size_t)(srow0 + ai * 128 + m * 16) * DM + c00 + bj * 128);
#pragma unroll
        for (int ai = 0; ai < 2; ++ai) {
            float rmv[4];
#pragma unroll
            for (int m = 0; m < 4; ++m) rmv[m] = *(const GAS float*)(rms1 + row0 + ai * 128 + m * 16);
#pragma unroll
            for (int m = 0; m < 4; ++m) {
                const int row = row0 + ai * 128 + m * 16; float ss = 0.f; const float rmv_ = rmv[m];
#pragma unroll
                for (int bj = 0; bj < 2; ++bj) {
                    const u32x4 xi = quad_gather(xin[ai][m][bj], bpi);
                    const f32x4 o0 = acc[ai][bj][m][0] + bf4_lo(xi) * rmv_, o1 = acc[ai][bj][m][1] + bf4_hi(xi) * rmv_;
                    u32x4 w; w.x = pk2(o0.x, o0.y); w.y = pk2(o0.z, o0.w); w.z = pk2(o1.x, o1.y); w.w = pk2(o1.z, o1.w);
                    *(GAS u32x4*)(X1B + (size_t)(srow0 + ai * 128 + m * 16) * DM + c00 + bj * 128) = quad_gather(w, bpa);
                    ss += ((o0.x * o0.x + o0.y * o0.y) + (o0.z * o0.z + o0.w * o0.w)) + ((o1.x * o1.x + o1.y * o1.y) + (o1.z * o1.z + o1.w * o1.w));
                }
                { auto r16 = __builtin_amdgcn_permlane16_swap(__float_as_uint(ss), __float_as_uint(ss), false, false); ss = __uint_as_float(r16[0]) + __uint_as_float(r16[1]); }
                { auto r32_ = __builtin_amdgcn_permlane32_swap(__float_as_uint(ss), __float_as_uint(ss), false, false); ss = __uint_as_float(r32_[0]) + __uint_as_float(r32_[1]); }
                if (fq == 0) *(GAS bf16_t*)(ssq + (size_t)row * 16 + u.pn * 4 + wc) = (bf16_t)(pk2(ss, 0.f) & 0xffffu);
            }
        }
    }
};
__device__ __forceinline__ float rs2_from(u32x4 a, u32x4 b) {
    const f32x4 p = bf4_lo(a) + bf4_hi(a) + bf4_lo(b) + bf4_hi(b);
    return 1.0f / sqrtf(((p.x + p.y) + (p.z + p.w)) * (1.0f / DM) + EPSF);
}
__device__ __forceinline__ float row_rs2(const bf16_t* ssq, int row) {
    const GAS u32x4* p = (const GAS u32x4*)(ssq + (size_t)row * 16); return rs2_from(p[0], p[1]);
}
struct EpiQ {
    static constexpr bool PERM = true, AFTER_DRAIN = false;
    bf16_t* Q;
    __device__ __forceinline__ void operator()(const f32x4 (&acc)[2][2][4][2], const pg8::Unit& u, int wr, int wc, int fr, int fq) const {
        int l_ = threadIdx.x & 63; asm volatile("" : "+v"(l_));
        const int qr = l_ >> 2, qc = l_ & 3, bpa = 4 * (qr + 16 * qc);
        const int row0 = u.pm * 256 + wr * 64 + qr;
#pragma unroll
        for (int ai = 0; ai < 2; ++ai)
#pragma unroll
            for (int m = 0; m < 4; ++m) {
                const int row = row0 + ai * 128 + m * 16;
#pragma unroll
                for (int bj = 0; bj < 2; ++bj) {
                    const int c0 = u.pn * 256 + bj * 128 + wc * 32 + 8 * qc;
                    const f32x4 v0 = acc[ai][bj][m][0], v1 = acc[ai][bj][m][1];
                    u32x4 w; w.x = pk2(v0.x, v0.y); w.y = pk2(v0.z, v0.w); w.z = pk2(v1.x, v1.y); w.w = pk2(v1.z, v1.w);
                    *(GAS u32x4*)(Q + (size_t)row * NQ + c0) = quad_gather(w, bpa);
                }
            }
    }
};

#define MFMA32(a, b, c) __builtin_amdgcn_mfma_f32_32x32x16_bf16(a, b, c, 0, 0, 0)
typedef short v4i16_t __attribute__((ext_vector_type(4)));
__device__ __forceinline__ s16x4 vtr(const lds_u8* p) { return __builtin_bit_cast(s16x4, __builtin_amdgcn_ds_read_tr16_b64_v4i16((LAS v4i16_t*)p)); }
__device__ __forceinline__ bf16x8 vfrag(const lds_u8* p) { const s16x4 lo = vtr(p), hi = vtr(p + 512); return (bf16x8){lo[0], lo[1], lo[2], lo[3], hi[0], hi[1], hi[2], hi[3]}; }
__device__ __forceinline__ bf16x8 ldsb128(const lds_u8* p) { return *(const LAS bf16x8*)p; }
__device__ __forceinline__ int crow(int r, int hi) { return (r & 3) + 8 * (r >> 2) + 4 * hi; }
__device__ __forceinline__ void glds16(const void* g, lds_u8* l) {
    unsigned sv; const unsigned lb = (unsigned)__builtin_amdgcn_readfirstlane((int)(unsigned)(uintptr_t)l);
    asm volatile("s_mov_b32 %0, m0\n\ts_mov_b32 m0, %2\n\ts_nop 0\n\tglobal_load_lds_dwordx4 %1, off\n\ts_mov_b32 m0, %0" : "=&s"(sv) : "v"(g), "s"(lb) : "memory");
}
__device__ __forceinline__ float swap_sum(float v) { auto rr = __builtin_amdgcn_permlane32_swap(__float_as_uint(v), __float_as_uint(v), false, false); return __uint_as_float(rr[0]) + __uint_as_float(rr[1]); }
__device__ __forceinline__ float swap_max(float v) { auto rr = __builtin_amdgcn_permlane32_swap(__float_as_uint(v), __float_as_uint(v), false, false); return __builtin_fmaxf(__uint_as_float(rr[0]), __uint_as_float(rr[1])); }

constexpr int ATT_SLOT = 32768, ATT_XCH = 65536, ATT_XPITCH = 528, ATT_BTAB = ATT_XCH + 128 * ATT_XPITCH;
constexpr int ATT_SUBG = ATT_BTAB + 1024, ATT_OPITCH = 272;
static_assert(ATT_SUBG + 512 <= LDS_SCRATCH && 128 * ATT_OPITCH <= 2 * ATT_SLOT, "attention LDS");

#ifndef ATT_LMIN
#define ATT_LMIN 1e-30f
#define ATT_LMAX 1e30f
#endif
template <int MODE>
__device__ __forceinline__ int attn_unit(const Args& a, lds_u8* lds, int b, int h, int qb, unsigned* qctr, volatile LAS unsigned* qslot) {
    int tid_ = threadIdx.x; asm volatile("" : "+v"(tid_));
    const int tid = tid_, lane = tid & 63, r32 = lane & 31, hi = lane >> 5; const int wid = __builtin_amdgcn_readfirstlane(tid >> 6);
    const int rgp = wid & 3, map = wid >> 2;
    const bf16_t* proj = (const bf16_t*)(a.ws + WS_PROJ);
    const size_t rowbase = (size_t)b * SEQ; const int q0 = qb * 128, NT = 2 * qb + 2;
    const float lam = ((const float*)(a.ws + WS_LAM))[0];
    const int krow = 8 * wid + (lane >> 3);
    const bf16_t* k1src = proj + (rowbase + krow) * NIN + OFF_DK + h * 128 + ((lane & 7) ^ ((krow >> 1) & 7)) * 8;
    const bf16_t* k2src = k1src + 64;
    const bf16_t* vsrc0 = proj + (rowbase + 16 * ((2 * wid) & 3) + (lane >> 2)) * NIN + OFF_DV + h * 128 + 32 * ((2 * wid) >> 2) + (lane & 3) * 8;
    const bf16_t* vsrc1 = proj + (rowbase + 16 * ((2 * wid + 1) & 3) + (lane >> 2)) * NIN + OFF_DV + h * 128 + 32 * ((2 * wid + 1) >> 2) + (lane & 3) * 8;
#define ATT_DMA(t, slot) do { const size_t go = (size_t)(t) * 64 * NIN; lds_u8* sb = lds + (slot) * ATT_SLOT; \
        glds16(k1src + go, sb + wid * 1024); glds16(k2src + go, sb + 8192 + wid * 1024); \
        glds16(vsrc0 + go, sb + 16384 + (2 * wid) * 1024); glds16(vsrc1 + go, sb + 16384 + (2 * wid + 1) * 1024); } while (0)
    const int koff = map * 8192 + r32 * 128, ksw = (r32 >> 1) & 7;
    const int voff = 16384 + ((lane >> 4) & 1) * 32 + (lane & 3) * 8 + (4 * hi + ((lane & 15) >> 2)) * 64;
    f32x16 o[4]; float mrun, lrun; bool shifted, farpend;
    const int qpos = q0 + rgp * 32 + r32;
    ATT_DMA(0, 0);
    bf16x8 qf[4];
    { const bf16_t* qp = proj + (rowbase + q0 + rgp * 32 + r32) * NIN + OFF_DQ + h * 128 + map * 64 + hi * 8;
#pragma unroll
      for (int s = 0; s < 4; ++s) qf[s] = *(const GAS bf16x8*)(qp + s * 16); }
    float btv = 0.f, sgv = 0.f;
    if (tid < 128) sgv = a.in[8][tid];
    if (tid >= 96 && tid < 224) btv = ((const float*)(a.ws + WS_BTAB))[h * 128 + tid - 96];
    asm volatile("" : "+v"(qf[0]), "+v"(qf[1]), "+v"(qf[2]), "+v"(qf[3]), "+v"(btv), "+v"(sgv));
    if (tid < 128) ((LAS float*)(lds + ATT_SUBG))[tid] = sgv;
    if (tid < 224) ((LAS float*)(lds + ATT_BTAB))[tid] = tid < 96 ? -INFINITY : btv;
    int safe = 0;
    for (;;) {
#pragma unroll
    for (int d = 0; d < 4; ++d) o[d] = f32x16{};
    mrun = 0.f; lrun = 0.f; shifted = false; farpend = !(176 > q0);
    if (safe) ATT_DMA(0, 0);
    for (int t = 0; t < NT; ++t) {
        if (!(MODE & 32) || t < 2) { VM_WAIT(); __syncthreads(); }
        if (t + 1 < NT && (!(MODE & 8) || t + 1 < 2)) ATT_DMA(t + 1, (t + 1) & 1);
        if (64 * t > q0 + rgp * 32 + 31) continue;
        const lds_u8* sb = lds + (t & 1) * ATT_SLOT;
        const bool nearT = (64 * t + 176 > q0);
        f32x16 sA = f32x16{}, sB = f32x16{};
        if (MODE & 1) {
            bf16x8 kf[8];
#pragma unroll
            for (int d0 = 0; d0 < 4; ++d0) { const int kc = koff + (((2 * d0 + hi) ^ ksw) << 4); if (MODE & 16) { kf[2 * d0] = qf[d0]; kf[2 * d0 + 1] = qf[3 - d0]; } else { kf[2 * d0] = ldsb128(sb + kc); kf[2 * d0 + 1] = ldsb128(sb + kc + 4096); } }
            __builtin_amdgcn_sched_group_barrier(0x100, 8, 0);
#pragma unroll
            for (int d0 = 0; d0 < 4; ++d0) { sA = MFMA32(kf[2 * d0], qf[d0], sA); sB = MFMA32(kf[2 * d0 + 1], qf[d0], sB); }
            __builtin_amdgcn_sched_group_barrier(0x8, 8, 0);
        }
        if (!(MODE & 1)) asm volatile("" : "+v"(sA), "+v"(sB));
        if (MODE & 4) {
        if (nearT) {
            if (farpend) { farpend = false; const float fb = __builtin_amdgcn_exp2f(((const LAS float*)(lds + ATT_BTAB))[223]); lrun *= fb;
#pragma unroll
                for (int d = 0; d < 4; ++d)
#pragma unroll
                    for (int r = 0; r < 16; ++r) o[d][r] *= fb; }
            float bA[16], bB[16];
            const int ab = ATT_BTAB + 4 * (qpos - 64 * t + 96 - 4 * hi);
#pragma unroll
            for (int r = 0; r < 16; ++r) { const int a0 = ab - 4 * ((r & 3) + 8 * (r >> 2)), a1 = a0 - 128;
                bA[r] = *(const LAS float*)(lds + (a0 > ATT_BTAB + 892 ? ATT_BTAB + 892 : a0)); bB[r] = *(const LAS float*)(lds + (a1 > ATT_BTAB + 892 ? ATT_BTAB + 892 : a1)); }
            asm volatile("" : "+v"(bA[0]), "+v"(bA[1]), "+v"(bA[2]), "+v"(bA[3]), "+v"(bA[4]), "+v"(bA[5]), "+v"(bA[6]), "+v"(bA[7]), "+v"(bA[8]), "+v"(bA[9]), "+v"(bA[10]), "+v"(bA[11]), "+v"(bA[12]), "+v"(bA[13]), "+v"(bA[14]), "+v"(bA[15]));
            asm volatile("" : "+v"(bB[0]), "+v"(bB[1]), "+v"(bB[2]), "+v"(bB[3]), "+v"(bB[4]), "+v"(bB[5]), "+v"(bB[6]), "+v"(bB[7]), "+v"(bB[8]), "+v"(bB[9]), "+v"(bB[10]), "+v"(bB[11]), "+v"(bB[12]), "+v"(bB[13]), "+v"(bB[14]), "+v"(bB[15]));
#pragma unroll
            for (int r = 0; r < 16; ++r) { sA[r] += bA[r]; sB[r] += bB[r]; }
        }
        if (safe) {
#define MX3(a_, b_, c_) __builtin_fmaxf(__builtin_fmaxf((a_), (b_)), (c_))
        float mxa = MX3(sA[0], sA[1], sB[0]), mxb = MX3(sA[2], sA[3], sB[1]); mxa = MX3(mxa, sB[2], sB[3]);
#pragma unroll
        for (int r = 4; r < 16; r += 4) { mxa = MX3(mxa, sA[r], sA[r + 1]); mxb = MX3(mxb, sA[r + 2], sA[r + 3]); mxa = MX3(mxa, sB[r], sB[r + 1]); mxb = MX3(mxb, sB[r + 2], sB[r + 3]); }
#undef MX3
        const float mx = swap_max(__builtin_fmaxf(mxa, mxb));
        if (shifted) {
#pragma unroll
            for (int r = 0; r < 16; ++r) { asm volatile("v_sub_f32 %0, %0, %1" : "+v"(sA[r]) : "v"(mrun)); asm volatile("v_sub_f32 %0, %0, %1" : "+v"(sB[r]) : "v"(mrun)); }
        }
        const float dmx = mx - mrun;
        if (__any(dmx > 64.0f) || (t == 0 && __any(dmx < -64.0f))) {
            const float up = (t == 0) ? ((dmx > 64.0f || dmx < -64.0f) ? dmx : 0.f) : __builtin_fmaxf(dmx - 32.0f, 0.f) * (dmx > 64.0f ? 1.0f : 0.f);
            const float alpha = (t == 0) ? 0.f : __builtin_amdgcn_exp2f(-up);
            mrun += up; lrun = (up != 0.f) ? lrun * alpha : lrun;
#pragma unroll
            for (int d = 0; d < 4; ++d)
#pragma unroll
                for (int r = 0; r < 16; ++r) o[d][r] = (up != 0.f) ? o[d][r] * alpha : o[d][r];
#pragma unroll
            for (int r = 0; r < 16; ++r) { asm volatile("v_sub_f32 %0, %0, %1" : "+v"(sA[r]) : "v"(up)); asm volatile("v_sub_f32 %0, %0, %1" : "+v"(sB[r]) : "v"(up)); }
            shifted = __any(mrun != 0.f);
        }
        }
#pragma unroll
        for (int r = 0; r < 16; ++r) { if (MODE & 64) { sA[r] = sA[r] * 1.0009765625f; sB[r] = sB[r] * 1.0009765625f; } else { sA[r] = __builtin_amdgcn_exp2f(sA[r]); sB[r] = __builtin_amdgcn_exp2f(sB[r]); } }
#pragma unroll
        for (int r = 0; r < 16; ++r) { lrun += sA[r]; lrun += sB[r]; }
        } else { asm volatile("" : "+v"(sA), "+v"(sB)); }
        u32x4 pw[4];
        pw[0] = (u32x4){pk2(sA[0], sA[1]), pk2(sA[2], sA[3]), pk2(sA[4], sA[5]), pk2(sA[6], sA[7])};
        pw[1] = (u32x4){pk2(sA[8], sA[9]), pk2(sA[10], sA[11]), pk2(sA[12], sA[13]), pk2(sA[14], sA[15])};
        pw[2] = (u32x4){pk2(sB[0], sB[1]), pk2(sB[2], sB[3]), pk2(sB[4], sB[5]), pk2(sB[6], sB[7])};
        pw[3] = (u32x4){pk2(sB[8], sB[9]), pk2(sB[10], sB[11]), pk2(sB[12], sB[13]), pk2(sB[14], sB[15])};
        if (!(MODE & 2)) { asm volatile("" :: "v"(pw[0]), "v"(pw[1]), "v"(pw[2]), "v"(pw[3])); continue; }
        {
            bf16x8 vfa[4], vfb[4];
#pragma unroll
            for (int d = 0; d < 4; ++d) vfa[d] = (MODE & 16) ? qf[d] : vfrag(sb + voff + d * 4096);
            __builtin_amdgcn_sched_group_barrier(0x100, 8, 0);
#pragma unroll
            for (int ks = 0; ks < 4; ks += 2) {
#pragma unroll
                for (int d = 0; d < 4; ++d) vfb[d] = (MODE & 16) ? qf[3 - d] : vfrag(sb + voff + d * 4096 + (ks + 1) * 1024);
                __builtin_amdgcn_sched_group_barrier(0x100, 8, 0);
                { const bf16x8 pb = __builtin_bit_cast(bf16x8, pw[ks]);
#pragma unroll
                  for (int d = 0; d < 4; ++d) o[d] = MFMA32(vfa[d], pb, o[d]); }
                __builtin_amdgcn_sched_group_barrier(0x8, 4, 0);
                if (ks + 2 < 4) {
#pragma unroll
                    for (int d = 0; d < 4; ++d) vfa[d] = (MODE & 16) ? qf[d] : vfrag(sb + voff + d * 4096 + (ks + 2) * 1024);
                    __builtin_amdgcn_sched_group_barrier(0x100, 8, 0);
                }
                { const bf16x8 pb = __builtin_bit_cast(bf16x8, pw[ks + 1]);
#pragma unroll
                  for (int d = 0; d < 4; ++d) o[d] = MFMA32(vfb[d], pb, o[d]); }
                __builtin_amdgcn_sched_group_barrier(0x8, 4, 0);
            }
        }
    }
    if (safe) break;
    { const float ltot = swap_sum(lrun);
      if (!__syncthreads_or((ltot > ATT_LMIN && ltot < ATT_LMAX) ? 0 : 1)) break; }
    safe = 1;
    }
    unsigned ntk = 0u;
    if (tid == 0) ntk = __hip_atomic_fetch_add(qctr, 1u, __ATOMIC_RELAXED, __HIP_MEMORY_SCOPE_AGENT);
    const float inv = 1.0f / swap_sum(lrun);
    LAS float* xch = (LAS float*)(lds + ATT_XCH + (rgp * 32 + r32) * ATT_XPITCH);
    if (map == 1) {
        const float sc = inv * lam;
#pragma unroll
        for (int d = 0; d < 4; ++d)
#pragma unroll
            for (int g = 0; g < 4; ++g) *(LAS f32x4*)(xch + 32 * d + 8 * g + 4 * hi) = (f32x4){o[d][4 * g] * sc, o[d][4 * g + 1] * sc, o[d][4 * g + 2] * sc, o[d][4 * g + 3] * sc};
    }
    __syncthreads();
    if (map == 0) {
        float ss = 0.f;
#pragma unroll
        for (int d = 0; d < 4; ++d)
#pragma unroll
            for (int g = 0; g < 4; ++g) { const f32x4 o2 = *(const LAS f32x4*)(xch + 32 * d + 8 * g + 4 * hi);
#pragma unroll
                for (int j = 0; j < 4; ++j) { const float v = o[d][4 * g + j] * inv - o2[j]; o[d][4 * g + j] = v; ss += v * v; } }
        ss = swap_sum(ss);
        const float rn = 0.8f / sqrtf(ss * (1.0f / 128.0f) + EPSF);
        const LAS float* sub = (const LAS float*)(lds + ATT_SUBG);
        lds_u8* stg = lds + (rgp * 32 + r32) * ATT_OPITCH;
#pragma unroll
        for (int d = 0; d < 4; ++d)
#pragma unroll
            for (int g = 0; g < 4; ++g) { const int dd = 32 * d + 8 * g + 4 * hi; const f32x4 sv = *(const LAS f32x4*)(sub + dd);
                u32x2 w; w.x = pk2(o[d][4 * g] * rn * sv.x, o[d][4 * g + 1] * rn * sv.y); w.y = pk2(o[d][4 * g + 2] * rn * sv.z, o[d][4 * g + 3] * rn * sv.w);
                *(LAS u32x2*)(stg + dd * 2) = w; }
    }
    __syncthreads();
    { bf16_t* mixb = (bf16_t*)(a.ws + WS_MIX) + (rowbase + q0) * DM + 512 + h * 128;
#pragma unroll
      for (int k = 0; k < 4; ++k) { const int idx = tid + k * NTHR, row = idx >> 4, c16 = idx & 15;
          *(GAS u32x4*)(mixb + (size_t)row * DM + c16 * 8) = *(const LAS u32x4*)(lds + row * ATT_OPITCH + c16 * 16); } }
    if (tid == 0) *qslot = ntk;
    __syncthreads();
#undef ATT_DMA
    return (int)*qslot;
}

constexpr int RET_BUF = 49152, RET_RT = 2 * RET_BUF, RET_GN = RET_RT + 8192;
constexpr int RET_QPITCH = 144;
static_assert(16 * RET_QPITCH <= 32 * 80, "retention staging tile");
constexpr int RET_STG = RET_GN + 2048, RET_SPITCH = 80;
static_assert(RET_STG + 8 * 32 * RET_SPITCH <= LDS_SCRATCH, "retention LDS");

template <int RMODE>
__device__ __forceinline__ void ret_unit(const Args& a, lds_u8* lds, int b, int h) {
    int tid_ = threadIdx.x; asm volatile("" : "+v"(tid_));
    const int tid = tid_, lane = tid & 63, r32 = lane & 31, hi = lane >> 5; const int wid = __builtin_amdgcn_readfirstlane(tid >> 6);
    const int rgp = wid & 3, eh = wid >> 2;
    const bf16_t* proj = (const bf16_t*)(a.ws + WS_PROJ);
    const size_t rowbase = (size_t)b * SEQ;
    const float* dect = (const float*)(a.ws + WS_DECAY) + h * 128;
    const float gam = dect[1], g127 = dect[127], g128 = g127 * gam;
#define RET_DMA(c, buf) do { const size_t ro = (rowbase + (size_t)(c) * 128) * NIN; lds_u8* bb = lds + (buf) * RET_BUF; \
        _Pragma("unroll") for (int i_ = 0; i_ < 2; ++i_) { const int p_ = 2 * wid + i_; \
            { const int rw_ = p_ * 8 + (lane >> 3), gp_ = (lane & 7) ^ ((rw_ >> 1) & 7); glds16(proj + ro + (size_t)rw_ * NIN + OFF_RK + h * 64 + gp_ * 8, bb + p_ * 1024); } \
            { const int db = p_ >> 3, rg_ = p_ & 7; glds16(proj + ro + (size_t)(rg_ * 16 + (lane >> 2)) * NIN + OFF_RK + h * 64 + db * 32 + (lane & 3) * 8, bb + 16384 + db * 8192 + rg_ * 1024); \
              glds16(proj + ro + (size_t)(rg_ * 16 + (lane >> 2)) * NIN + OFF_RV + h * 64 + db * 32 + (lane & 3) * 8, bb + 32768 + db * 8192 + rg_ * 1024); } } } while (0)
    const int koff = r32 * 128, ksw = (r32 >> 1) & 7;
    const int troff = ((lane >> 4) & 1) * 32 + (lane & 3) * 8 + (4 * hi + ((lane & 15) >> 2)) * 64;
    f32x16 R = f32x16{};
    for (int i = tid; i < 8192 / 16; i += NTHR) *(LAS u32x4*)(lds + RET_RT + i * 16) = (u32x4){0u, 0u, 0u, 0u};
    const float* gn = a.in[3];
    f32x4 gv[4];
#pragma unroll
    for (int g = 0; g < 4; ++g) gv[g] = *(const GAS f32x4*)(gn + h * 64 + eh * 32 + 8 * g + 4 * hi);
    bf16x8 qn[4]; u32x4 svq[2];
#define RET_PREF(c) do { const bf16_t* qp_ = proj + (rowbase + (size_t)(c) * 128 + rgp * 32 + (lane >> 3)) * NIN + OFF_RQ + h * 64 + (lane & 7) * 8; const bf16_t* sg_ = proj + (rowbase + (size_t)(c) * 128 + rgp * 32 + (lane >> 2)) * NIN + OFF_RG + h * 64 + eh * 32 + 8 * (lane & 3); \
        _Pragma("unroll") for (int j = 0; j < 4; ++j) qn[j] = *(const GAS bf16x8*)(qp_ + (size_t)(8 * j) * NIN); \
        _Pragma("unroll") for (int j = 0; j < 2; ++j) svq[j] = *(const GAS u32x4*)(sg_ + (size_t)(16 * j) * NIN); } while (0)
    RET_PREF(0);
    RET_DMA(0, 0);
    u32x4 wst[2]; bf16_t* wptr = nullptr;
    wst[0] = wst[1] = (u32x4){0u, 0u, 0u, 0u};
    lds_u8* const stg = lds + RET_STG + wid * (32 * RET_SPITCH);
    for (int c = 0; c < 32; ++c) {
        VM_WAIT(); __syncthreads();
        if (c > 0) {
#pragma unroll
            for (int j = 0; j < 2; ++j) *(GAS u32x4*)(wptr + (size_t)(16 * j) * DM) = wst[j];
        }
        bf16x8 qf[4]; u32x2 svc[4];
#pragma unroll
        for (int P = 0; P < 2; ++P) {
#pragma unroll
            for (int j = 0; j < 2; ++j) *(LAS bf16x8*)(stg + (8 * j + (lane >> 3)) * RET_QPITCH + (lane & 7) * 16) = qn[2 * P + j];
#pragma unroll
            for (int s = 0; s < 4; ++s) { const bf16x8 t_ = ldsb128(stg + (r32 & 15) * RET_QPITCH + (2 * s + hi) * 16); if (P == 0) qf[s] = t_; else qf[s] = (r32 < 16) ? qf[s] : t_; }
        }
#pragma unroll
        for (int j = 0; j < 2; ++j) *(LAS u32x4*)(stg + (16 * j + (lane >> 2)) * RET_SPITCH + (lane & 3) * 16) = svq[j];
#pragma unroll
        for (int g = 0; g < 4; ++g) svc[g] = *(const LAS u32x2*)(stg + r32 * RET_SPITCH + g * 16 + hi * 8);
        if (c + 1 < 32 && (!(RMODE & 1) || c + 1 < 2)) { RET_PREF(c + 1); RET_DMA(c + 1, (c + 1) & 1); }
        const lds_u8* bb = lds + (c & 1) * RET_BUF;
        f32x16 O = f32x16{};
#pragma unroll
        for (int s = 0; s < 4; ++s) { const bf16x8 rt = ldsb128(lds + RET_RT + (2 * s + hi) * 1024 + (eh * 32 + r32) * 16); O = MFMA32(rt, qf[s], O); }
        for (int kb = 0; kb <= rgp; ++kb) {
            f32x16 S = f32x16{};
#pragma unroll
            for (int s = 0; s < 4; ++s) { const bf16x8 ka = ldsb128(bb + koff + kb * 4096 + (((2 * s + hi) ^ ksw) << 4)); S = MFMA32(ka, qf[s], S); }
            if (kb == rgp) {
#pragma unroll
                for (int r = 0; r < 16; ++r) S[r] = (crow(r, hi) > r32) ? 0.f : S[r];
            }
            const u32x4 p0 = (u32x4){pk2(S[0], S[1]), pk2(S[2], S[3]), pk2(S[4], S[5]), pk2(S[6], S[7])};
            const u32x4 p1 = (u32x4){pk2(S[8], S[9]), pk2(S[10], S[11]), pk2(S[12], S[13]), pk2(S[14], S[15])};
            const bf16x8 v0 = vfrag(bb + 32768 + eh * 8192 + troff + (2 * kb) * 1024), v1 = vfrag(bb + 32768 + eh * 8192 + troff + (2 * kb + 1) * 1024);
            O = MFMA32(v0, __builtin_bit_cast(bf16x8, p0), O); O = MFMA32(v1, __builtin_bit_cast(bf16x8, p1), O);
        }
        if (rgp < 2) {
            f32x16 T = f32x16{};
#pragma unroll
            for (int ks = 0; ks < 8; ++ks) { const bf16x8 kt = vfrag(bb + 16384 + rgp * 8192 + troff + ks * 1024), vv = vfrag(bb + 32768 + eh * 8192 + troff + ks * 1024); T = MFMA32(kt, vv, T); }
#pragma unroll
            for (int r = 0; r < 16; ++r) R[r] = R[r] * g128 + T[r] * g127;
        }
        float s1 = 0.f, s2 = 0.f;
#pragma unroll
        for (int r = 0; r < 16; ++r) { s1 += O[r]; s2 += O[r] * O[r]; }
        s1 = swap_sum(s1); s2 = swap_sum(s2);
        LAS f32x2* gx = (LAS f32x2*)(lds + RET_GN);
        if (hi == 0) gx[(rgp * 32 + r32) * 2 + eh] = (f32x2){s1, s2};
        __syncthreads();
        if (rgp < 2) {
#pragma unroll
            for (int g = 0; g < 4; ++g) { u32x2 w; w.x = pk2(R[4 * g] * gam, R[4 * g + 1] * gam); w.y = pk2(R[4 * g + 2] * gam, R[4 * g + 3] * gam);
                *(LAS u32x2*)(lds + RET_RT + (rgp * 4 + g) * 1024 + (eh * 32 + r32) * 16 + hi * 8) = w; }
        }
        const f32x2 ga = gx[(rgp * 32 + r32) * 2], gb = gx[(rgp * 32 + r32) * 2 + 1];
        const float mean = (ga.x + gb.x) * (1.0f / 64.0f), var = (ga.y + gb.y) * (1.0f / 64.0f) - mean * mean;
        const float rstd = 1.0f / sqrtf(__builtin_fmaxf(var, 0.f) + EPSF);
        bf16_t* mixp = (bf16_t*)(a.ws + WS_MIX) + (rowbase + (size_t)c * 128 + rgp * 32 + (lane >> 2)) * DM + h * 64 + eh * 32 + 8 * (lane & 3);
#pragma unroll
        for (int g = 0; g < 4; ++g) { const u32x2 sv = svc[g];
            const float y0 = (O[4 * g] - mean) * rstd * gv[g].x * __uint_as_float(sv.x << 16), y1 = (O[4 * g + 1] - mean) * rstd * gv[g].y * __uint_as_float(sv.x & 0xffff0000u);
            const float y2 = (O[4 * g + 2] - mean) * rstd * gv[g].z * __uint_as_float(sv.y << 16), y3 = (O[4 * g + 3] - mean) * rstd * gv[g].w * __uint_as_float(sv.y & 0xffff0000u);
            *(LAS u32x2*)(stg + r32 * RET_SPITCH + g * 16 + hi * 8) = (u32x2){pk2(y0, y1), pk2(y2, y3)}; }
#pragma unroll
        for (int j = 0; j < 2; ++j) wst[j] = *(const LAS u32x4*)(stg + (16 * j + (lane >> 2)) * RET_SPITCH + (lane & 3) * 16);
        wptr = mixp;
    }
#pragma unroll
    for (int j = 0; j < 2; ++j) *(GAS u32x4*)(wptr + (size_t)(16 * j) * DM) = wst[j];
    __syncthreads();
#undef RET_DMA
#undef RET_PREF
}


__device__ __forceinline__ float vmax_(float a, float b) { float r; asm("v_max_f32 %0, %1, %2" : "=v"(r) : "v"(a), "v"(b)); return r; }
__device__ __forceinline__ float vmin_(float a, float b) { float r; asm("v_min_f32 %0, %1, %2" : "=v"(r) : "v"(a), "v"(b)); return r; }
#define CAS_DESC(x, y) do { const float hi_ = vmax_(x, y), lo_ = vmin_(x, y); x = hi_; y = lo_; } while (0)
#define CAS_ASC(x, y) do { const float hi_ = vmax_(x, y), lo_ = vmin_(x, y); x = lo_; y = hi_; } while (0)
__device__ __forceinline__ void sort16_desc(float (&v)[16]) {
#define C_(i, j) CAS_DESC(v[i], v[j])
    C_(0, 13); C_(1, 12); C_(2, 15); C_(3, 14); C_(4, 8); C_(5, 6); C_(7, 11); C_(9, 10);
    C_(0, 5); C_(1, 7); C_(2, 9); C_(3, 4); C_(6, 13); C_(8, 14); C_(10, 15); C_(11, 12);
    C_(0, 1); C_(2, 3); C_(4, 5); C_(6, 8); C_(7, 9); C_(10, 11); C_(12, 13); C_(14, 15);
    C_(0, 2); C_(1, 3); C_(4, 10); C_(5, 11); C_(6, 7); C_(8, 9); C_(12, 14); C_(13, 15);
    C_(1, 2); C_(3, 12); C_(4, 6); C_(5, 7); C_(8, 10); C_(9, 11); C_(13, 14);
    C_(1, 4); C_(2, 6); C_(5, 8); C_(7, 10); C_(9, 13); C_(11, 14);
    C_(2, 4); C_(3, 6); C_(9, 12); C_(11, 13);
    C_(3, 5); C_(6, 8); C_(7, 9); C_(10, 12);
    C_(3, 4); C_(5, 6); C_(7, 8); C_(9, 10); C_(11, 12);
    C_(6, 7); C_(8, 9);
#undef C_
}
__device__ __forceinline__ void bitonic_merge16_desc(float (&v)[16]) {
#pragma unroll
    for (int j = 8; j > 0; j >>= 1)
#pragma unroll
        for (int i = 0; i < 16; ++i) { const int l = i ^ j; if (l > i) CAS_DESC(v[i], v[l]); }
}
__device__ __forceinline__ void merge_top16(float (&a)[16], const float (&b)[16]) {
#pragma unroll
    for (int i = 0; i < 16; ++i) a[i] = vmax_(a[i], b[15 - i]);
    bitonic_merge16_desc(a);
}
__device__ __forceinline__ unsigned pack_idx4(const float (&v)[16], int w) {
    return (__float_as_uint(v[4 * w]) & 127u) | ((__float_as_uint(v[4 * w + 1]) & 127u) << 8) | ((__float_as_uint(v[4 * w + 2]) & 127u) << 16) | ((__float_as_uint(v[4 * w + 3]) & 127u) << 24);
}
__device__ __forceinline__ unsigned lookup_idx(const unsigned (&pk)[4], unsigned i) {
    const unsigned sel = (i & 7u) | 0x0c0c0c00u;
    const unsigned lo = __builtin_amdgcn_perm(pk[1], pk[0], sel), hi_ = __builtin_amdgcn_perm(pk[3], pk[2], sel);
    return (i & 8u) ? hi_ : lo;
}

constexpr int P5_KEYB = 32768;
__device__ __forceinline__ void p5_keys(const Args& a, lds_u8* lds) {
    int tid_ = threadIdx.x; asm volatile("" : "+v"(tid_));
    const int tid = tid_, hp = blockIdx.x & 3;
    const bf16_t* keys = (const bf16_t*)(a.ws + WS_KEYS) + (size_t)hp * 4 * 128 * 128;
    static_assert(4 * 128 * 16 == 16 * NTHR, "key image copy");
    u32x4 kv[16];
#pragma unroll
    for (int j = 0; j < 16; ++j) { const int i = tid + j * NTHR, t = i >> 11, key = (i >> 4) & 127, c = i & 15; kv[j] = *(const GAS u32x4*)(keys + ((size_t)t * 128 + key) * 128 + c * 8); }
#pragma unroll
    for (int j = 0; j < 16; ++j) { const int i = tid + j * NTHR, t = i >> 11, key = (i >> 4) & 127, c = i & 15; *(LAS u32x4*)(lds + t * P5_KEYB + c * 2048 + key * 16) = kv[j]; }
}
__device__ __forceinline__ void p5_topk(const Args& a, lds_u8* lds, bool keys_loaded) {
    int tid_ = threadIdx.x; asm volatile("" : "+v"(tid_));
    const int tid = tid_, lane = tid & 63, r32 = lane & 31, hi = lane >> 5; const int wid = __builtin_amdgcn_readfirstlane(tid >> 6);
    const int hp = blockIdx.x & 3, wgi = blockIdx.x >> 2, nwg = (gridDim.x + 3 - hp) / 4;
    const bf16_t* Q = (const bf16_t*)(a.ws + WS_PROJ);
    int* IDX = (int*)(a.ws + WS_IDX); float* GATE = (float*)(a.ws + WS_GATE);
    const int tg0 = wgi * NWAVES + wid, tgs = nwg * NWAVES;
    const int ntask = (tg0 < MTOK / 32) ? 4 * ((MTOK / 32 - 1 - tg0) / tgs + 1) : 0;
#define P5_TMAP(k_) ((((k_) & 1) << 1) | (((k_) >> 1) & 1))
#define P5_QLOAD(QF, k_) do { const int tg_ = tg0 + ((k_) >> 2) * tgs, t_ = P5_TMAP(k_); \
        const bf16_t* qp = Q + (size_t)(tg_ * 32 + r32) * NQ + (2 * hp + (t_ >> 1)) * 256 + (t_ & 1) * 128 + hi * 8; \
        _Pragma("unroll") for (int s = 0; s < 8; ++s) QF[s] = *(const GAS bf16x8*)(qp + s * 16); } while (0)
    bf16x8 qf[8], qn[8];
    u32x4 sqk0 = (u32x4){0u, 0u, 0u, 0u}, sqk1 = sqk0;
    if (ntask > 0) P5_QLOAD(qf, 0);
    if (!keys_loaded) p5_keys(a, lds);
    __syncthreads();
    float la[16], lb[16], topA[16];
#pragma unroll
    for (int r = 0; r < 16; ++r) { la[r] = 0.f; lb[r] = 0.f; topA[r] = 0.f; }
#pragma unroll 1
    for (int k = 0; k < ntask; ++k) {
      {
        const int tg = tg0 + (k >> 2) * tgs, t = P5_TMAP(k);
        const GAS u32x4* sqp = (const GAS u32x4*)((const bf16_t*)(a.ws + WS_SSQ) + (size_t)(tg * 32 + r32) * 16); const u32x4 sq0 = sqp[0], sq1 = sqp[1];
        P5_QLOAD(qn, (k + 1 < ntask ? k + 1 : k));
        {
            float top[16];
#pragma unroll
            for (int kb = 0; kb < 4; ++kb) {
                f32x16 S = f32x16{}; bf16x8 kfr[8];
#pragma unroll
                for (int s = 0; s < 8; ++s) kfr[s] = ldsb128(lds + t * P5_KEYB + (2 * s + hi) * 2048 + (kb * 32 + r32) * 16);
                __builtin_amdgcn_sched_group_barrier(0x100, 8, 0);
#pragma unroll
                for (int s = 0; s < 8; ++s) S = MFMA32(kfr[s], qf[s], S);
                __builtin_amdgcn_sched_group_barrier(0x8, 8, 0);
                float v[16];
#pragma unroll
                for (int r = 0; r < 16; ++r) v[r] = __uint_as_float((__float_as_uint(S[r]) & ~127u) | (unsigned)(kb * 32 + (r & 3) + 8 * (r >> 2)) | ((unsigned)hi << 2));
                sort16_desc(v);
                if (kb == 0) {
#pragma unroll
                    for (int r = 0; r < 16; ++r) top[r] = v[r];
                } else merge_top16(top, v);
            }
            if ((k & 1) == 0) {
#pragma unroll
                for (int r = 0; r < 16; ++r) topA[r] = top[r];
            } else {
                float oth[16];
#pragma unroll
                for (int r = 0; r < 16; ++r) { auto rr = __builtin_amdgcn_permlane32_swap(__float_as_uint(topA[r]), __float_as_uint(top[r]), false, false); top[r] = __uint_as_float(rr[0]); oth[r] = __uint_as_float(rr[1]); }
                merge_top16(top, oth);
                if ((k & 2) == 0) {
#pragma unroll
                    for (int r = 0; r < 16; ++r) la[r] = top[r];
                } else {
#pragma unroll
                    for (int r = 0; r < 16; ++r) lb[r] = top[r];
                }
            }
        }
#pragma unroll
        for (int s2 = 0; s2 < 8; ++s2) qf[s2] = qn[s2];
        { u32x4 s0_ = sq0, s1_ = sq1; asm volatile("" : "+v"(s0_), "+v"(s1_)); sqk0 = s0_; sqk1 = s1_; }
        if ((k & 3) != 3) continue;
        unsigned pa[4], pb[4];
#pragma unroll
        for (int w = 0; w < 4; ++w) { pa[w] = pack_idx4(la, w); pb[w] = pack_idx4(lb, w); }
        float c0[16], c1[16];
#define CAND(i, j) __uint_as_float((__float_as_uint(la[i] + lb[j]) & ~255u) | (unsigned)((i) * 16 + (j)))
        c0[0] = CAND(0, 0); c0[1] = CAND(0, 1); c0[2] = CAND(0, 2); c0[3] = CAND(0, 3); c0[4] = CAND(0, 4); c0[5] = CAND(0, 5); c0[6] = CAND(0, 6); c0[7] = CAND(0, 7);
        c0[8] = CAND(0, 8); c0[9] = CAND(0, 9); c0[10] = CAND(0, 10); c0[11] = CAND(0, 11); c0[12] = CAND(0, 12); c0[13] = CAND(0, 13); c0[14] = CAND(0, 14); c0[15] = CAND(0, 15);
        c1[0] = CAND(1, 0); c1[1] = CAND(1, 1); c1[2] = CAND(1, 2); c1[3] = CAND(1, 3); c1[4] = CAND(1, 4); c1[5] = CAND(1, 5); c1[6] = CAND(1, 6); c1[7] = CAND(1, 7);
        c1[8] = CAND(2, 0); c1[9] = CAND(2, 1); c1[10] = CAND(2, 2); c1[11] = CAND(2, 3); c1[12] = CAND(2, 4); c1[13] = CAND(3, 0); c1[14] = CAND(3, 1); c1[15] = CAND(3, 2);
        sort16_desc(c1); merge_top16(c0, c1);
        asm volatile("" : "+v"(c0[0]), "+v"(c0[15]));
        c1[0] = CAND(3, 3); c1[1] = CAND(4, 0); c1[2] = CAND(4, 1); c1[3] = CAND(4, 2); c1[4] = CAND(5, 0); c1[5] = CAND(5, 1); c1[6] = CAND(6, 0); c1[7] = CAND(6, 1);
        c1[8] = CAND(7, 0); c1[9] = CAND(7, 1); c1[10] = CAND(8, 0); c1[11] = CAND(9, 0); c1[12] = CAND(10, 0); c1[13] = CAND(11, 0); c1[14] = CAND(12, 0); c1[15] = CAND(13, 0);
        sort16_desc(c1); merge_top16(c0, c1);
        asm volatile("" : "+v"(c0[0]), "+v"(c0[15]));
        c0[15] = vmax_(c0[15], CAND(14, 0)); c0[14] = vmax_(c0[14], CAND(15, 0));
#undef CAND
        bitonic_merge16_desc(c0);
        float gsum = 0.f, gv[16]; int ex[16];
        const float rs2q = rs2_from(sqk0, sqk1);
        const float mx = __uint_as_float(__float_as_uint(c0[0]) & ~255u);
#pragma unroll
        for (int r = 0; r < 16; ++r) { const unsigned bits = __float_as_uint(c0[r]); const float val = __uint_as_float(bits & ~255u);
            gv[r] = __expf((val - mx) * rs2q); gsum += gv[r];
            ex[r] = (int)(lookup_idx(pa, (bits >> 4) & 15u) * 128u + lookup_idx(pb, bits & 15u)); }
        const float ginv = 1.0f / gsum;
        const size_t ob = (size_t)(tg * 32 + r32) * 128 + (2 * hp + hi) * 16;
#pragma unroll
        for (int r = 0; r < 16; r += 4) { *(GAS u32x4*)(IDX + ob + r) = (u32x4){(unsigned)ex[r], (unsigned)ex[r + 1], (unsigned)ex[r + 2], (unsigned)ex[r + 3]};
            *(GAS f32x4*)(GATE + ob + r) = (f32x4){gv[r] * ginv, gv[r + 1] * ginv, gv[r + 2] * ginv, gv[r + 3] * ginv}; }
      }
    }
#undef P5_QLOAD
#undef P5_TMAP
    __syncthreads();
}

typedef long i64_t;
typedef int v8i_t __attribute__((ext_vector_type(8)));
#define MFMA16F8(a, b, c) __builtin_amdgcn_mfma_f32_16x16x32_fp8_fp8(a, b, c, 0, 0, 0)
constexpr float P6_SD = 64.f, P6_SX = 8.f, P6_SU = 16.f, P6_SA = 64.f, P6_SU4 = 6.f;
constexpr size_t P6_SLICEB = (size_t)NEXP * 128;
__device__ __forceinline__ unsigned pk4_fp8(float a, float b, float c, float d) { int w = __builtin_amdgcn_cvt_pk_fp8_f32(a, b, 0, false); w = __builtin_amdgcn_cvt_pk_fp8_f32(c, d, w, true); return (unsigned)w; }
__device__ __forceinline__ float fp8_byte0(unsigned w) { return __builtin_amdgcn_cvt_f32_fp8((int)w, 0); }
constexpr int P6_WSCR = 3328;
__device__ __forceinline__ void p6_token(const Args& a, lds_u8* wl, int tok, int lane, float* OUTW) {
    const int n = lane & 15, g = lane >> 4;
    const unsigned char* ws = a.ws;
    const unsigned char* WD = ws + WS_WD; const unsigned char* WU = ws + WS_WU;
    const int* IDX = (const int*)(ws + WS_IDX) + (size_t)tok * 128; const float* GATE = (const float*)(ws + WS_GATE) + (size_t)tok * 128;
    const bf16_t* X1 = (const bf16_t*)(ws + WS_X1B) + (size_t)tok * DM;
    {
#pragma unroll
        for (int j = 0; j < 4; ++j) {
            const u32x2 xw_ = *(const GAS u32x2*)(X1 + 256 * j + 4 * lane); const f32x4 v = (f32x4){__uint_as_float(xw_.x << 16), __uint_as_float(xw_.x & 0xffff0000u), __uint_as_float(xw_.y << 16), __uint_as_float(xw_.y & 0xffff0000u)} * P6_SX;
            const unsigned hw = pk4_fp8(v.x, v.y, v.z, v.w);
            const float r0 = v.x - __builtin_amdgcn_cvt_f32_fp8((int)hw, 0), r1 = v.y - __builtin_amdgcn_cvt_f32_fp8((int)hw, 1), r2 = v.z - __builtin_amdgcn_cvt_f32_fp8((int)hw, 2), r3 = v.w - __builtin_amdgcn_cvt_f32_fp8((int)hw, 3);
            const unsigned lw = pk4_fp8(r0 * 16.f, r1 * 16.f, r2 * 16.f, r3 * 16.f);
            *(LAS unsigned*)(wl + 256 * j + 4 * lane) = hw; *(LAS unsigned*)(wl + 1024 + 256 * j + 4 * lane) = lw;
        }
        const u32x2 iv = *(const GAS u32x2*)(IDX + lane * 2); *(LAS u32x2*)(wl + 2048 + lane * 8) = iv;
    }
    const float rs2 = row_rs2((const bf16_t*)(ws + WS_SSQ), tok);
    LDS_WAIT();
    const LAS int* idxl = (const LAS int*)(wl + 2048); LAS unsigned short* actl = (LAS unsigned short*)(wl + 2560);
    const int xoff = (n & 1) * 1024 + 16 * g;
#pragma unroll 1
    for (int eg = 0; eg < 8; ++eg) {
        const int e = idxl[eg * 16 + n];
        const unsigned char* rp = WD + (size_t)e * 128 + 16 * g;
        f32x4 acc = (f32x4){0.f, 0.f, 0.f, 0.f};
        u32x4 bq[16];
#pragma unroll
        for (int sl = 0; sl < 8; ++sl) { bq[2 * sl] = *(const GAS u32x4*)(rp + sl * P6_SLICEB); bq[2 * sl + 1] = *(const GAS u32x4*)(rp + sl * P6_SLICEB + 64); }
#pragma unroll
        for (int sl = 0; sl < 8; ++sl)
#pragma unroll
            for (int hf = 0; hf < 2; ++hf) {
                const u32x4 xa = *(const LAS u32x4*)(wl + xoff + sl * 128 + hf * 64); const u32x4 bb = bq[2 * sl + hf];
                acc = MFMA16F8((i64_t)(((unsigned long long)xa.y << 32) | xa.x), (i64_t)(((unsigned long long)bb.y << 32) | bb.x), acc);
                acc = MFMA16F8((i64_t)(((unsigned long long)xa.w << 32) | xa.z), (i64_t)(((unsigned long long)bb.w << 32) | bb.z), acc);
            }
        const float av = (acc[0] + acc[1] * 0.0625f) * (rs2 * (1.0f / (P6_SD * P6_SX)));
        const float act = 0.5f * av * (1.0f + erff(av * 0.70710678118654752f)) * GATE[eg * 16 + n] * P6_SA;
        const unsigned hb = pk4_fp8(act, 0.f, 0.f, 0.f) & 0xffu;
        const unsigned lb = pk4_fp8((act - fp8_byte0(hb)) * 16.f, 0.f, 0.f, 0.f) & 0xffu;
        if (g == 0) actl[eg * 16 + n] = (unsigned short)(hb | (lb << 8));
    }
    LDS_WAIT();
    const int pos = n & 7, sel = n >> 3;
    float ss = 0.f;
    const bool owner = (n < 8) && (g < 2);
#pragma unroll 1
    for (int sl = 0; sl < 8; ++sl) {
        f32x4 ah[2], al[2];
#pragma unroll
        for (int s = 0; s < 2; ++s) { ah[s] = (f32x4){0.f, 0.f, 0.f, 0.f}; al[s] = (f32x4){0.f, 0.f, 0.f, 0.f}; }
        u32x4 bq[16]; unsigned av[16];
#pragma unroll
        for (int q = 0; q < 16; ++q) { const int ei = 8 * q + 4 * sel + g; const int e = idxl[ei]; av[q] = actl[ei];
            bq[q] = *(const GAS u32x4*)(WU + sl * P6_SLICEB + (size_t)e * 128 + 16 * pos); }
#pragma unroll
        for (int q = 0; q < 16; ++q) {
            const unsigned long long ahv = (unsigned long long)(av[q] & 0xffu) << (8 * pos), alv = (unsigned long long)(av[q] >> 8) << (8 * pos);
            const u32x4 bb = bq[q];
            const i64_t b0 = (i64_t)(((unsigned long long)bb.y << 32) | bb.x), b1 = (i64_t)(((unsigned long long)bb.w << 32) | bb.z);
            ah[0] = MFMA16F8((i64_t)ahv, b0, ah[0]); al[0] = MFMA16F8((i64_t)alv, b0, al[0]);
            ah[1] = MFMA16F8((i64_t)ahv, b1, ah[1]); al[1] = MFMA16F8((i64_t)alv, b1, al[1]);
        }
#pragma unroll
        for (int s = 0; s < 2; ++s) {
            f32x4 t = ah[s] + al[s] * 0.0625f, u;
#pragma unroll
            for (int r = 0; r < 4; ++r) u[r] = __shfl(t[r], (lane + 40) & 63);
            const int col = 128 * sl + 16 * pos + 8 * s + 4 * (g & 1);
            const u32x2 xq_ = *(const GAS u32x2*)(X1 + col); const f32x4 xv = (f32x4){__uint_as_float(xq_.x << 16), __uint_as_float(xq_.x & 0xffff0000u), __uint_as_float(xq_.y << 16), __uint_as_float(xq_.y & 0xffff0000u)};
            const f32x4 x2 = xv + (t + u) * (1.0f / (P6_SA * P6_SU));
            if (owner) { ss += (x2.x * x2.x + x2.y * x2.y) + (x2.z * x2.z + x2.w * x2.w); *(GAS f32x4*)(OUTW + (size_t)tok * DM + col) = x2; }
        }
    }
    ss = wave_sum(ss);
    const float rn = 1.0f / sqrtf(ss * (1.0f / DM) + EPSF);
    const float* nf = a.in[16];
    if (owner) {
#pragma unroll
        for (int sl = 0; sl < 8; ++sl)
#pragma unroll
            for (int s = 0; s < 2; ++s) { const int col = 128 * sl + 16 * pos + 8 * s + 4 * g; const f32x4 gv = *(const GAS f32x4*)(nf + col);
                GAS f32x4* op = (GAS f32x4*)(OUTW + (size_t)tok * DM + col); *op = *op * rn * gv; }
    }
}

constexpr int P6S_WAVE = 16384 + 512 + 128;
static_assert(NWAVES * P6S_WAVE <= LDS_SCRATCH, "P6 LDS");
__device__ __forceinline__ float gelu_as(float v) {
    const float av = __builtin_fabsf(v), t = __builtin_amdgcn_rcpf(av * 0.2316418882f + 1.0f);
    float q = t * 0.5307027145f + (-0.7265760135f); q = q * t + 0.7107068705f; q = q * t + (-0.142248368f); q = q * t + 0.127414796f; q = q * t;
    const float e = __builtin_amdgcn_exp2f((v * v) * (-0.72134752044f));
    const float m = v * (q * e);
    return v < 0.f ? m : v - m;
}
template <int EMASK, int PARTS>
__device__ __forceinline__ void p6_slices(const Args& a, lds_u8* wl, int tok0, int lane_in) {
    int lane = lane_in; asm volatile("" : "+v"(lane));
    const int n = lane & 15, g = lane >> 4;
    const unsigned char* ws = a.ws;
    const unsigned char* WD = ws + WS_WD; const unsigned char* WU = ws + WS_WU;
    LAS float* aacc = (LAS float*)wl; LAS unsigned short* idl = (LAS unsigned short*)(wl + 8192); LAS unsigned short* actl = (LAS unsigned short*)(wl + 12288);
    lds_u8* xs = wl + 16384; LAS float* ssl = (LAS float*)(wl + 16384 + 512); LAS float* r2l = ssl + 16;
    {
        u32x2 iv[16];
#pragma unroll
        for (int t = 0; t < 16; ++t) iv[t] = *(const GAS u32x2*)((const int*)(ws + WS_IDX) + (size_t)(tok0 + t) * 128 + lane * 2);
#pragma unroll
        for (int t = 0; t < 16; ++t) {
            *(LAS unsigned*)(wl + 8192 + t * 256 + lane * 4) = (iv[t].x & 0xffffu) | (iv[t].y << 16);
            *(LAS f32x2*)(wl + t * 512 + lane * 8) = (f32x2){0.f, 0.f};
        }
    }
    float r2v = 0.f;
    if (lane < 16) { ssl[lane] = 0.f; r2v = row_rs2((const bf16_t*)(ws + WS_SSQ), tok0 + lane); }
    LDS_WAIT(); VM_WAIT();
    float gts[16][2];
#pragma unroll
    for (int t = 0; t < 16; ++t) { gts[t][0] = ((const float*)(ws + WS_GATE))[(size_t)(tok0 + t) * 128 + lane]; gts[t][1] = ((const float*)(ws + WS_GATE))[(size_t)(tok0 + t) * 128 + lane + 64]; }
    const int xoff = (n & 3) * 128 + 16 * g;
    const int bpa = 4 * (4 * (lane & 15) + (lane >> 4));
#define MFMA4(a_, b_, c_) __builtin_amdgcn_mfma_scale_f32_16x16x128_f8f6f4(a_, b_, c_, 4  , 4  , 0, 0, 0, 0)
#define P6_DLOAD(BQ, XV, it_) do { const int sl_ = (it_) >> 4, t_ = (it_) & 15; \
        _Pragma("unroll") for (int eg = 0; eg < 8; ++eg) { const int e_ = idl[t_ * 128 + eg * 16 + (lane >> 2)] & EMASK; const unsigned char* rp_ = WD + sl_ * P6_SLICEB + (size_t)e_ * 128 + 16 * (lane & 3); \
            BQ[2 * eg] = *(const GAS u32x4*)rp_; BQ[2 * eg + 1] = *(const GAS u32x4*)(rp_ + 64); } \
        XV = __builtin_nontemporal_load((const GAS u32x2*)((const bf16_t*)(ws + WS_X1B) + (size_t)(tok0 + t_) * DM + sl_ * 256 + 4 * lane)); } while (0)
#define P6_DCOMP(BQ, XV, it_) do { const int t_ = (it_) & 15; \
        { float q0_ = __uint_as_float(XV.x << 16), q1_ = __uint_as_float(XV.x & 0xffff0000u), q2_ = __uint_as_float(XV.y << 16), q3_ = __uint_as_float(XV.y & 0xffff0000u); \
          _Pragma("unroll") for (int st = 0; st < 4; ++st) { \
              unsigned w_ = __builtin_amdgcn_cvt_scalef32_pk_fp4_f32(0u, q0_, q1_, 1.0f, 0); w_ = __builtin_amdgcn_cvt_scalef32_pk_fp4_f32(w_, q2_, q3_, 1.0f, 1); \
              *(LAS unsigned short*)(xs + st * 128 + 2 * lane) = (unsigned short)w_; \
              if (st < 3) { const f32x2 d0_ = __builtin_amdgcn_cvt_scalef32_pk_f32_fp4(w_, 1.0f, 0), d1_ = __builtin_amdgcn_cvt_scalef32_pk_f32_fp4(w_, 1.0f, 1); \
                  q0_ = (q0_ - d0_.x) * 4.0f; q1_ = (q1_ - d0_.y) * 4.0f; q2_ = (q2_ - d1_.x) * 4.0f; q3_ = (q3_ - d1_.y) * 4.0f; } } } \
        LDS_WAIT(); \
        const u32x4 xa0 = *(const LAS u32x4*)(xs + xoff), xa1 = *(const LAS u32x4*)(xs + xoff + 64); \
        const v8i_t A0 = (v8i_t){(int)xa0.x, (int)xa0.y, (int)xa0.z, (int)xa0.w, 0, 0, 0, 0}; \
        const v8i_t A1 = (v8i_t){(int)xa1.x, (int)xa1.y, (int)xa1.z, (int)xa1.w, 0, 0, 0, 0}; \
        _Pragma("unroll") for (int eg = 0; eg < 8; ++eg) { f32x4 acc = (f32x4){0.f, 0.f, 0.f, 0.f}; v8i_t b0 = (v8i_t){0, 0, 0, 0, 0, 0, 0, 0}, b1 = (v8i_t){0, 0, 0, 0, 0, 0, 0, 0}; \
            _Pragma("unroll") for (int w_ = 0; w_ < 4; ++w_) { b0[w_] = __builtin_amdgcn_ds_bpermute(bpa, (int)BQ[2 * eg][w_]); b1[w_] = __builtin_amdgcn_ds_bpermute(bpa, (int)BQ[2 * eg + 1][w_]); } \
            acc = MFMA4(A0, b0, acc); acc = MFMA4(A1, b1, acc); \
            float r_ = (acc[0] + acc[1] * 0.25f) + (acc[2] * 0.0625f + acc[3] * 0.015625f); asm volatile("" : "+v"(r_)); \
            if (g == 0) aacc[t_ * 128 + eg * 16 + n] += r_; } \
        LDS_WAIT(); } while (0)
    if (PARTS & 1) {
        u32x4 bqA[16], bqB[16]; u32x2 xvA, xvB;
        P6_DLOAD(bqA, xvA, 0);
#pragma unroll 1
        for (int it = 0; it < 64; it += 2) {
            P6_DLOAD(bqB, xvB, it + 1);
            P6_DCOMP(bqA, xvA, it);
            P6_DLOAD(bqA, xvA, (it + 2 < 64 ? it + 2 : it));
            P6_DCOMP(bqB, xvB, it + 1);
        }
    }
#undef MFMA4
#undef P6_DLOAD
#undef P6_DCOMP
    u32x4 bqF[8];
    if (PARTS & 2) {
#pragma unroll
        for (int q = 0; q < 8; ++q) { const int e_ = idl[2 * q + (lane >> 5)] & EMASK; bqF[q] = *(const GAS u32x4*)(WU + (size_t)e_ * 512 + 16 * (lane & 31)); }
    }
    if (lane < 16) r2l[lane] = r2v;
    LDS_WAIT();
    int lane_g = lane; asm volatile("" : "+v"(lane_g));
#pragma unroll
    for (int t = 0; t < 16; ++t) asm volatile("" : "+v"(gts[t][0]), "+v"(gts[t][1]));
#pragma unroll
    for (int t = 0; t < 16; ++t) {
        const float sc = r2l[t] * (1.0f / P6_SD);
#pragma unroll
        for (int j = 0; j < 2; ++j) { const int ei = lane_g + 64 * j; const float av = aacc[t * 128 + ei] * sc;
            const float act = gelu_as(av) * gts[t][j];
            const unsigned ab = __float_as_uint(act), eb = (ab >> 23) & 255u;
            unsigned pk = 0u;
            if (eb > 4u) {
                const float m = __uint_as_float((ab & 0x807fffffu) | (128u << 23));
                const unsigned w0 = __builtin_amdgcn_cvt_scalef32_pk_fp4_f32(0u, m, 0.f, 1.0f, 0);
                const f32x2 d0 = __builtin_amdgcn_cvt_scalef32_pk_f32_fp4(w0, 1.0f, 0);
                const unsigned w1 = __builtin_amdgcn_cvt_scalef32_pk_fp4_f32(0u, (m - d0.x) * 4.0f, 0.f, 1.0f, 0);
                pk = (w0 & 15u) | ((w1 & 15u) << 4) | ((eb - 1u) << 8);
            }
            actl[t * 128 + ei] = (unsigned short)pk; }
    }
    LDS_WAIT();
    int lane_u = lane; asm volatile("" : "+v"(lane_u));
    const float* nf = a.in[16];
    const int ui = lane_u & 31, ug = lane_u >> 5, ush = 4 * (ui & 7);
    const unsigned nib_ = 0xfu << ush;
    const unsigned mk0 = (ui >> 3) == 0 ? nib_ : 0u, mk1 = (ui >> 3) == 1 ? nib_ : 0u, mk2 = (ui >> 3) == 2 ? nib_ : 0u, mk3 = (ui >> 3) == 3 ? nib_ : 0u;
    lds_u8* const actx = wl + 4608;
    const lds_u8* const actx_l = actx + 16 * ug;
#define P6_UEXPAND(t_) do { _Pragma("unroll") for (int j_ = 0; j_ < 2; ++j_) { const unsigned av_ = actl[(t_) * 128 + lane_u + 64 * j_]; const unsigned s0_ = av_ >> 8; \
            *(LAS u32x4*)(actx + (lane_u + 64 * j_) * 16) = (u32x4){(av_ & 15u) * 0x11111111u, ((av_ >> 4) & 15u) * 0x11111111u, s0_, s0_ - 2u}; } } while (0)
#ifndef P6_DIGITS
#define P6_DIGITS 2
#endif
#define MFMA32S(a_, b_, c_, sa_) __builtin_amdgcn_mfma_scale_f32_32x32x64_f8f6f4(a_, b_, c_, 4, 4, 0, sa_, 0, 127)
#ifndef P6_UPROBE
#define P6_UPROBE 0
#endif
#define P6_ULOAD(BQ, sq_) do { const int t_ = (sq_) >> 3, qs_ = (sq_) & 7; \
        if (!((P6_UPROBE & 1) && PARTS == 2 && EMASK != 0xffff)) \
        _Pragma("unroll") for (int q = 0; q < 8; ++q) { const int e_ = idl[t_ * 128 + 2 * (8 * qs_ + q) + ug] & EMASK; \
            BQ[q] = *(const GAS u32x4*)(WU + (size_t)e_ * 512 + 16 * ui); } } while (0)
#define P6_UMMA(BQ, sq_) do { const int t_ = (sq_) >> 3, qs_ = (sq_) & 7; \
        _Pragma("unroll") for (int q = 0; q < 8; ++q) { \
            const u32x4 ar_ = *(const LAS u32x4*)(actx_l + 32 * (8 * qs_ + q)); (void)t_; \
            const unsigned w0_ = ar_.x, w1_ = ar_.y; const int s0_ = (int)ar_.z, s1_ = (int)ar_.w; \
            const u32x4 bb = BQ[q]; const v8i_t B_ = (v8i_t){(int)bb.x, (int)bb.y, (int)bb.z, (int)bb.w, 0, 0, 0, 0}; \
            if ((P6_UPROBE & 2) && PARTS == 2) { asm volatile("" :: "v"(w0_ & mk0), "v"(w0_ & mk1), "v"(w0_ & mk2), "v"(w0_ & mk3), "v"(w1_ & mk0), "v"(w1_ & mk1), "v"(w1_ & mk2), "v"(w1_ & mk3), "v"(bb), "v"(s0_), "v"(s1_)); continue; } \
            uacc = MFMA32S(((v8i_t){(int)(w0_ & mk0), (int)(w0_ & mk1), (int)(w0_ & mk2), (int)(w0_ & mk3), 0, 0, 0, 0}), B_, uacc, s0_); \
            if (P6_DIGITS == 2) uacc = MFMA32S(((v8i_t){(int)(w1_ & mk0), (int)(w1_ & mk1), (int)(w1_ & mk2), (int)(w1_ & mk3), 0, 0, 0, 0}), B_, uacc, s1_); } } while (0)
    f32x4 gvu[4];
#pragma unroll
    for (int gq = 0; gq < 4; ++gq) gvu[gq] = *(const GAS f32x4*)(nf + 32 * ui + 4 * ug + 8 * gq);
    u32x2 xqn[4];
#define P6_UXPREF(t_) do { const bf16_t* xrow_ = (const bf16_t*)(ws + WS_X1B) + (size_t)(tok0 + (t_)) * DM + 32 * ui + 4 * ug; \
        _Pragma("unroll") for (int gq = 0; gq < 4; ++gq) xqn[gq] = __builtin_nontemporal_load((const GAS u32x2*)(xrow_ + 8 * gq)); } while (0)
#define P6_UEPI(sq_) do { const int t_ = (sq_) >> 3; \
        f32x4 x2[4]; float ss = 0.f; \
        _Pragma("unroll") for (int gq = 0; gq < 4; ++gq) { \
            const u32x2 xq_ = xqn[gq]; \
            x2[gq] = (f32x4){__uint_as_float(xq_.x << 16), __uint_as_float(xq_.x & 0xffff0000u), __uint_as_float(xq_.y << 16), __uint_as_float(xq_.y & 0xffff0000u)} \
                + (f32x4){uacc[4 * gq], uacc[4 * gq + 1], uacc[4 * gq + 2], uacc[4 * gq + 3]} * (1.0f / P6_SU4); \
            ss += (x2[gq].x * x2[gq].x + x2[gq].y * x2[gq].y) + (x2[gq].z * x2[gq].z + x2[gq].w * x2[gq].w); } \
        const float rn = 1.0f / sqrtf(wave_sum(ss) * (1.0f / DM) + EPSF);     \
          \
        _Pragma("unroll") for (int gq = 0; gq < 4; ++gq) *(LAS f32x4*)(wl + ui * 144 + 32 * gq + 16 * ug) = x2[gq] * rn * gvu[gq]; \
        _Pragma("unroll") for (int k = 0; k < 4; ++k) { const int d_ = 4 * lane_u + 256 * k; const f32x4 ov_ = *(const LAS f32x4*)(wl + (d_ >> 5) * 144 + (d_ & 31) * 4); \
            if ((P6_UPROBE & 8) && PARTS == 2) asm volatile("" :: "v"(ov_)); else __builtin_nontemporal_store(ov_, (GAS f32x4*)(a.out + (size_t)(tok0 + t_) * DM + d_)); } \
        uacc = f32x16{}; } while (0)
    if (PARTS & 2) {
        u32x4 bqA[8], bqB[8]; f32x16 uacc = f32x16{};
        if ((P6_UPROBE & 1) && PARTS == 2 && EMASK != 0xffff) {
#pragma unroll
            for (int q = 0; q < 8; ++q) { bqA[q] = (u32x4){(unsigned)lane, 1u, 2u, 3u}; bqB[q] = bqA[q]; } }
#pragma unroll
        for (int q = 0; q < 8; ++q) bqA[q] = bqF[q];
#pragma unroll 1
        for (int sq = 0; sq < 128; sq += 2) {
            if ((sq & 7) == 0) { P6_UXPREF(sq >> 3); P6_UEXPAND(sq >> 3); }
            P6_ULOAD(bqB, sq + 1);
            P6_UMMA(bqA, sq);
            P6_ULOAD(bqA, (sq + 2 < 128 ? sq + 2 : sq));
            P6_UMMA(bqB, sq + 1);
            if (((sq + 1) & 7) == 7) { if ((P6_UPROBE & 4) && PARTS == 2) { asm volatile("" : "+v"(uacc)); uacc = f32x16{}; } else P6_UEPI(sq + 1); }
        }
    }
#undef P6_ULOAD
#undef P6_UMMA
#undef P6_UEPI
#undef P6_UXPREF
#undef P6_UEXPAND
#undef MFMA32S
}

#ifndef MK_N_LAUNCHES
#define MK_N_LAUNCHES 1
#endif
constexpr int NPHASE = 7;

__device__ __forceinline__ int queue_next(unsigned* ctr, volatile LAS unsigned* slot) {
    __syncthreads();
    if (threadIdx.x == 0) *slot = __hip_atomic_fetch_add(ctr, 1u, __ATOMIC_RELAXED, __HIP_MEMORY_SCOPE_AGENT);
    __syncthreads();
    return (int)*slot;
}

struct EpiNull {
    static constexpr bool PERM = true, AFTER_DRAIN = false;
    __device__ __forceinline__ void operator()(const f32x4 (&acc)[2][2][4][2], const pg8::Unit&, int, int, int, int) const {
#pragma unroll
        for (int ai = 0; ai < 2; ++ai)
#pragma unroll
            for (int bj = 0; bj < 2; ++bj)
#pragma unroll
                for (int m = 0; m < 4; ++m) asm volatile("" :: "v"(acc[ai][bj][m][0]), "v"(acc[ai][bj][m][1]));
    }
};
__device__ __forceinline__ int lane_now() { int t = threadIdx.x; asm volatile("" : "+v"(t)); return t & 63; }
__global__ void __launch_bounds__(NTHR, 2) hymba_fwd(Args a) {
    extern __shared__ __attribute__((aligned(16))) unsigned char lds_raw[];
    lds_u8* lds = (lds_u8*)lds_raw;
    volatile LAS unsigned* MISC = (volatile LAS unsigned*)(lds + MISC_OFF);
    const int tid = threadIdx.x; const int wave = __builtin_amdgcn_readfirstlane(tid >> 6);
#define lane lane_now()
    const int G = gridDim.x; const int bx = blockIdx.x;
    const int vcu = (G % 8 == 0) ? (bx % 8) * (G / 8) + bx / 8 : bx;
    const int gw = vcu * NWAVES + wave, NGW = G * NWAVES;
    for (int u = tid; u < (LDS_BYTES - MISC_OFF) / 4; u += NTHR) MISC[u] = 0u;
    __syncthreads();
    const int lo = a.ph_lo, hi = a.ph_hi;
    const bool use_bar = (hi - lo) > 1;
    XcdBarrier bar; bar.bar = (unsigned*)(a.ws + WS_CTL); bar.x = 0; bar.st = MISC + 8;
    if (use_bar) bar = xcd_barrier_post((unsigned*)(a.ws + WS_CTL), MISC + 8);
#ifndef PH_MASK
#define PH_MASK 127
#endif
#define IN(k) (((PH_MASK >> (k)) & 1) && lo <= (k) && (k) < hi)
#ifdef DBL_BAR
#define SEAM(k) do { if (IN(k) && IN((k) + 1)) { xcd_barrier(bar); xcd_barrier(bar); } } while (0)
#else
#define SEAM(k) do { if (IN(k) && IN((k) + 1)) xcd_barrier(bar); } while (0)
#endif
    unsigned char* ws = a.ws;

    if (IN(0)) { p0_prologue(a, lds, gw, NGW, lane, wave);
#ifdef DBL_P0
        __syncthreads(); p0_prologue(a, lds, gw, NGW, lane, wave);
#endif
    }
    SEAM(0);
    if (IN(1)) {
        pg8::Gemm g{(const bf16_t*)(ws + WS_XB), (const bf16_t*)(ws + WS_WIN), MTOK, NIN, DM}; pg8::StaticOrder S; S.init(MTOK, NIN, G, bx);
        EpiProj E{(bf16_t*)(ws + WS_PROJ), (const float*)(ws + WS_R1), (const f32x4*)(ws + WS_ROPE), (const float*)(ws + WS_DECAY)};
        pg8::gemm_phase<EpiProj, pg8::StaticOrder>(lds, g, S, E);
#ifdef DBL_P1
#if DBL_P1 == 2
        { EpiNull EN; pg8::gemm_phase<EpiNull, pg8::StaticOrder>(lds, g, S, EN); }
#else
        pg8::gemm_phase<EpiProj, pg8::StaticOrder>(lds, g, S, E);
#endif
#endif
    }
    unsigned tk_first = 0u;
#ifndef DBL_P2
    if (IN(1) && IN(2) && tid == 0) tk_first = __hip_atomic_fetch_add((unsigned*)(ws + WS_CTL + CTL_Q_ATT), 1u, __ATOMIC_RELAXED, __HIP_MEMORY_SCOPE_AGENT);
#endif
    SEAM(1);
    if (IN(2)) {
#ifdef DBL_P2
        for (int rep = 0; rep < 2; ++rep) {
        unsigned* ctr = (unsigned*)(ws + WS_CTL + CTL_Q_ATT + rep * 256);
#else
        {
        unsigned* ctr = (unsigned*)(ws + WS_CTL + CTL_Q_ATT);
#endif
#ifndef DBL_P2
        int tkt;
        if (IN(1)) { if (tid == 0) MISC[16] = tk_first; __syncthreads(); tkt = (int)MISC[16]; }
        else tkt = queue_next(ctr, MISC + 16);
#else
        int tkt = queue_next(ctr, MISC + 16);
#endif
        for (;;) {
            int u = tkt;
            if (u >= 64 + 1024 + DEF_ITEMS / 5) break;
            static_assert(DEF_ITEMS % 5 == 0 && DEF_ITEMS / 5 == 1024 / 4, "P2 ticket pattern");
            if (u >= 64) { const int i5 = (u - 64) / 5, r5 = (u - 64) % 5;
                if (r5 == 4) {
#ifdef PROBE_P2
                    if (rep == 0 && !(PROBE_P2 & 4)) { tkt = queue_next(ctr, MISC + 16); continue; }
#endif
                    if (i5 * 5 >= DEF_T0 + DEF_T1) p0_tables5(a, i5 * 5 - (DEF_T0 + DEF_T1));
                    else for (int k = 0; k < 5; ++k) p0_deferred(a, lds, i5 * 5 + k);
                    tkt = queue_next(ctr, MISC + 16); continue; }
                u = 64 + i5 * 4 + r5; }
#ifdef PROBE_P2
            if (rep == 0) { if (u >= 64 && (PROBE_P2 & 2)) { const int v = u - 64;
#ifdef PROBE_ATT2
                    if (wave >= 4) tkt = attn_unit<PROBE_ATT2>(a, lds, (v & 31) >> 2, v & 3, 31 - (v >> 5), ctr, MISC + 16); else
#endif
                    tkt = attn_unit<PROBE_ATT>(a, lds, (v & 31) >> 2, v & 3, 31 - (v >> 5), ctr, MISC + 16); continue; }
                if (u < 64 && (PROBE_P2 & 1)) ret_unit<(PROBE_P2 >> 4) & 1>(a, lds, u >> 3, u & 7);
                tkt = queue_next(ctr, MISC + 16); continue; }
#endif
            if (u < 64) { ret_unit<0>(a, lds, u >> 3, u & 7); tkt = queue_next(ctr, MISC + 16); }
            else { const int v = u - 64; tkt = attn_unit<7>(a, lds, (v & 31) >> 2, v & 3, 31 - (v >> 5), ctr, MISC + 16); }
        }
        }
    }
    SEAM(2);
    if (IN(3)) {
        pg8::Gemm g{(const bf16_t*)(ws + WS_MIX), (const bf16_t*)(ws + WS_WOUT), MTOK, DM, DM}; pg8::StaticOrder S; S.init(MTOK, DM, G, bx);
        EpiX1 E{(const bf16_t*)(ws + WS_XB), (bf16_t*)(ws + WS_X1B), (bf16_t*)(ws + WS_SSQ), (const float*)(ws + WS_R1)};
        pg8::gemm_phase<EpiX1, pg8::StaticOrder>(lds, g, S, E);

    }
    SEAM(3);
    if (IN(4)) {
        pg8::Gemm g{(const bf16_t*)(ws + WS_X1B), (const bf16_t*)(ws + WS_WPQ), MTOK, NQ, DM}; pg8::StaticOrder S; S.init(MTOK, NQ, G, bx);
        EpiQ E{(bf16_t*)(ws + WS_PROJ)};
        pg8::gemm_phase<EpiQ, pg8::StaticOrder>(lds, g, S, E);
#ifdef DBL_P4
#if DBL_P4 == 2
        { EpiNull EN; pg8::gemm_phase<EpiNull, pg8::StaticOrder>(lds, g, S, EN); }
#else
        pg8::gemm_phase<EpiQ, pg8::StaticOrder>(lds, g, S, E);
#endif
#endif
    }
    if (IN(4) && IN(5)) p5_keys(a, lds);
    SEAM(4);
    if (IN(3)) {
#ifdef DBL_P3
        { unsigned long long w2 = (unsigned long long)ws; asm volatile("" : "+s"(w2)); unsigned char* ws2 = (unsigned char*)w2; int bx2 = bx; asm volatile("" : "+s"(bx2));
          pg8::Gemm g2{(const bf16_t*)(ws2 + WS_MIX), (const bf16_t*)(ws2 + WS_WOUT), MTOK, DM, DM}; pg8::StaticOrder S2; S2.init(MTOK, DM, G, bx2);
          EpiX1 E2{(const bf16_t*)(ws2 + WS_XB), (bf16_t*)(ws2 + WS_X1B), (bf16_t*)(ws2 + WS_SSQ), (const float*)(ws2 + WS_R1)};
          pg8::gemm_phase<EpiX1, pg8::StaticOrder>(lds, g2, S2, E2); }
#endif
    }
    if (IN(5)) p5_topk(a, lds, IN(4));
    SEAM(5);
#ifdef DBL_P5
    if (IN(5)) { Args a2 = a; asm volatile("" : "+s"(a2.ws)); p5_topk(a2, lds, false); }
#endif
    if (IN(6)) {
#ifdef P6_TOKEN_MAJOR
        lds_u8* wl = lds + wave * P6_WSCR;
        for (int tok = gw; tok < MTOK; tok += NGW) p6_token(a, wl, tok, lane, a.out);
#else
#ifdef PROBE_EMASK
        for (int tb = gw; tb < MTOK / 16; tb += NGW) p6_slices<PROBE_EMASK, PROBE_PARTS>(a, lds + wave * P6S_WAVE, tb * 16, lane);
#endif
#ifdef DBL_P6
#pragma unroll 1
        for (int rep6 = 0; rep6 < 2; ++rep6)
#endif
        for (int tb = gw; tb < MTOK / 16; tb += NGW) p6_slices<0xffff, 3>(a, lds + wave * P6S_WAVE, tb * 16, lane);
#endif
    }
#ifdef DBG_DUMP
    if (hi - lo > 1) xcd_barrier(bar);
    {
        for (int m = gw; m < MTOK; m += NGW) {
            for (int c = lane; c < DM; c += 64) {
                float v = 0.f;
#if DBG_DUMP == 1
                v = bf2f(((const bf16_t*)(ws + WS_PROJ))[(size_t)m * NIN + DBG_COL + c]);
#elif DBG_DUMP == 2
                v = (c >= DBG_C0 && c < DBG_C1) ? bf2f(((const bf16_t*)(ws + WS_MIX))[(size_t)m * DM + c]) : 0.f;
#endif
                a.out[(size_t)m * DM + c] = v;
            }
        }
    }
#endif
#undef IN
#undef SEAM
#undef lane
}

extern "C" void kernel_launch(void* const* d_in, const int* in_sizes, int n_in, void* d_out, int out_size, void* d_ws, size_t ws_size, hipStream_t stream) {
    static int grid = 0;
    if (grid == 0) {
        if (n_in != 17 || in_sizes[0] != MTOK * DM || out_size != MTOK * DM || ws_size < WS_END) {
            fprintf(stderr, "kernel_launch: unexpected shapes (n_in %d, in0 %d, out %d, ws %zu < %zu); nothing launched\n", n_in, n_in > 0 ? in_sizes[0] : -1, out_size, ws_size, (size_t)WS_END); grid = -1; return; }
        int dev = 0, cus = 0, per_cu = 0;
        if (hipGetDevice(&dev) != hipSuccess || hipDeviceGetAttribute(&cus, hipDeviceAttributeMultiprocessorCount, dev) != hipSuccess) { fprintf(stderr, "kernel_launch: device query failed\n"); grid = -1; return; }
        if (hipFuncSetAttribute((const void*)hymba_fwd, hipFuncAttributeMaxDynamicSharedMemorySize, LDS_BYTES) != hipSuccess) { fprintf(stderr, "kernel_launch: hipFuncSetAttribute failed\n"); grid = -1; return; }
        if (hipOccupancyMaxActiveBlocksPerMultiprocessor(&per_cu, (const void*)hymba_fwd, NTHR, LDS_BYTES) != hipSuccess || per_cu < 1)
            fprintf(stderr, "kernel_launch: note: occupancy query reports %d workgroups per CU\n", per_cu);
        (void)hipGetLastError();
        grid = cus;
    }
    if (grid < 0) return;
    if (hipMemsetAsync((char*)d_ws + WS_CTL, 0, CTL_BYTES, stream) != hipSuccess) { fprintf(stderr, "kernel_launch: memset failed\n"); return; }
    Args a{};
    for (int i = 0; i < 17; ++i) a.in[i] = (const float*)d_in[i];
    a.out = (float*)d_out; a.ws = (unsigned char*)d_ws;
#if MK_N_LAUNCHES == 1
#ifdef DBG_STOP
    a.ph_lo = 0; a.ph_hi = DBG_STOP + 1;
#else
    a.ph_lo = 0; a.ph_hi = NPHASE;
#endif
    hipLaunchKernelGGL(hymba_fwd, dim3(grid), dim3(NTHR), LDS_BYTES, stream, a);
#else
    for (int p = 0; p < NPHASE; ++p) { a.ph_lo = p; a.ph_hi = p + 1; hipLaunchKernelGGL(hymba_fwd, dim3(grid), dim3(NTHR), LDS_BYTES, stream, a); }
#endif
    const hipError_t le = hipPeekAtLastError();
    if (le != hipSuccess) fprintf(stderr, "kernel_launch: launch failed: %s\n", hipGetErrorName(le));
}
```
